# Optimizing an MI355X kernel written in HIP

```python
import math
import jax, jax.numpy as jnp
from jax import lax
import numpy as np

D_MODEL = 1024
BATCH = 2
SEQ = 8192
DEPTH = 1

CHUNK = 64
Q_BLOCK = 128
EPS = 1e-6
ROPE_THETA = 10000.0
DIFF_HEADS = 4
DIFF_HEAD_DIM = 64
DIFF_V_DIM = 2 * DIFF_HEAD_DIM
DIFF_WIDTH = DIFF_HEADS * 2 * DIFF_HEAD_DIM
CONV_WIDTH = 512
CONV_K = 3
N_MEM = 256
MEM_HEADS = 4
MEM_HEAD_DIM = 128
MEM_WIDTH = MEM_HEADS * MEM_HEAD_DIM
N_BRANCH = 3
BRANCH_WIDTH = 512
IN_SIZES = (DIFF_WIDTH, DIFF_WIDTH, DIFF_WIDTH,
            CONV_WIDTH, CONV_WIDTH, CONV_WIDTH,
            MEM_WIDTH, N_BRANCH * D_MODEL)
IN_TOTAL = sum(IN_SIZES)
N_EXPERTS = 32
TOP_K = 4
D_FF = D_MODEL
SWIGLU_LIMIT = 7.0
SWIGLU_ALPHA = 1.702
MOE_BLOCK = 256

kernel_name = "hybrid_diffattn_shortconv_memxattn_moe"


def rmsnorm(x, g):
    xf = x.astype(jnp.float32)
    y = xf * lax.rsqrt(jnp.mean(xf * xf, axis=-1, keepdims=True) + EPS)
    return (y * g.astype(jnp.float32)).astype(x.dtype)


def rope(x, cos, sin):
    x1, x2 = jnp.split(x, 2, axis=-1)
    return jnp.concatenate([x1 * cos - x2 * sin, x2 * cos + x1 * sin], axis=-1)


def diff_attention(q, k, v, lam):
    B, S = q.shape[0], q.shape[1]
    n_qb = S // Q_BLOCK
    qb = q.reshape(B, n_qb, Q_BLOCK, DIFF_HEADS, 2, DIFF_HEAD_DIM).swapaxes(0, 1)
    key_chunk = jnp.arange(S) // CHUNK
    scale = DIFF_HEAD_DIM ** -0.5

    def block(args):
        q_blk, bi = args
        q_chunk = (bi * Q_BLOCK + jnp.arange(Q_BLOCK)) // CHUNK
        allowed = key_chunk[None, :] <= q_chunk[:, None]
        s = jnp.einsum('bqhcd,bkhcd->bhcqk', q_blk, k).astype(jnp.float32) * scale
        p = jax.nn.softmax(jnp.where(allowed, s, -jnp.inf), axis=-1)
        a = p[:, :, 0] - lam * p[:, :, 1]
        return jnp.einsum('bhqk,bkhe->bqhe', a.astype(v.dtype), v)

    out = lax.map(block, (qb, jnp.arange(n_qb)))
    return out.swapaxes(0, 1).reshape(B, S, DIFF_HEADS, DIFF_V_DIM)


def causal_depthwise_conv(u, w):
    return lax.conv_general_dilated(
        u, w[:, None, :].astype(u.dtype), window_strides=(1,),
        padding=[(CONV_K - 1, 0)], dimension_numbers=('NWC', 'WIO', 'NWC'),
        feature_group_count=u.shape[-1])


def memory_cross_attention(q, mem, g_mem, w_mem_kv, g_q, g_k):
    B, S = q.shape[0], q.shape[1]
    kv = rmsnorm(mem, g_mem) @ w_mem_kv
    k, v = jnp.split(kv, 2, axis=-1)
    M = mem.shape[1]
    k = rmsnorm(k.reshape(B, M, MEM_HEADS, MEM_HEAD_DIM), g_k)
    v = v.reshape(B, M, MEM_HEADS, MEM_HEAD_DIM)
    q = rmsnorm(q.reshape(B, S, MEM_HEADS, MEM_HEAD_DIM), g_q)
    s = jnp.einsum('bshd,bmhd->bhsm', q, k).astype(jnp.float32) * (MEM_HEAD_DIM ** -0.5)
    p = jax.nn.softmax(s, axis=-1)
    o = jnp.einsum('bhsm,bmhd->bshd', p.astype(v.dtype), v)
    return o.reshape(B, S, MEM_WIDTH)


def moe(h, w_router, b_router, w_gate_up, b_gate_up, w_down, b_down):
    B, S, D = h.shape
    T = B * S
    xt = h.reshape(T, D)
    logits = (xt @ w_router).astype(jnp.float32) + b_router.astype(jnp.float32)
    top_vals, top_idx = lax.top_k(logits, TOP_K)
    gates = jax.nn.softmax(top_vals, axis=-1)
    n_assign = T * TOP_K
    expert_flat = top_idx.reshape(-1)
    token_flat = jnp.arange(n_assign, dtype=jnp.int32) // TOP_K
    gate_flat = gates.reshape(-1)
    order = jnp.argsort(expert_flat)
    sorted_expert = expert_flat[order]
    counts = jnp.bincount(expert_flat, length=N_EXPERTS)
    padded = (counts + MOE_BLOCK - 1) // MOE_BLOCK * MOE_BLOCK
    start = jnp.cumsum(counts) - counts
    pend = jnp.cumsum(padded)
    pstart = pend - padded
    dest = pstart[sorted_expert] + (jnp.arange(n_assign) - start[sorted_expert])
    n_rows = -(-(n_assign + N_EXPERTS * (MOE_BLOCK - 1)) // MOE_BLOCK) * MOE_BLOCK
    n_blocks = n_rows // MOE_BLOCK
    row_token = jnp.zeros((n_rows,), jnp.int32).at[dest].set(token_flat[order])
    row_gate = jnp.zeros((n_rows,), jnp.float32).at[dest].set(gate_flat[order])
    block_expert = jnp.minimum(
        jnp.searchsorted(pend, jnp.arange(n_blocks) * MOE_BLOCK, side='right'),
        N_EXPERTS - 1)
    xs = xt[row_token].reshape(n_blocks, MOE_BLOCK, D)

    def expert_block(args):
        xb, e = args
        gu = xb @ w_gate_up[e] + b_gate_up[e]
        g, u = jnp.split(gu, 2, axis=-1)
        g = jnp.minimum(g, SWIGLU_LIMIT)
        u = jnp.clip(u, -SWIGLU_LIMIT, SWIGLU_LIMIT)
        act = (u + 1.0) * (g * jax.nn.sigmoid(g * SWIGLU_ALPHA))
        return act @ w_down[e] + b_down[e]

    ys = lax.map(expert_block, (xs, block_expert)).reshape(n_rows, D)
    ys = ys * row_gate[:, None].astype(ys.dtype)
    out = jax.ops.segment_sum(ys, row_token, num_segments=T)
    return out.reshape(B, S, D)


def setup_inputs(seed: int = 0) -> dict:
    key = jax.random.key(seed)
    ks = jax.random.split(key, 26)
    f32 = jnp.float32
    L, D, E = DEPTH, D_MODEL, N_EXPERTS

    def nrm(k, shape, scale):
        return jax.random.normal(k, shape, f32) * scale

    def gain(k, shape):
        return 1.0 + 0.02 * jax.random.normal(k, shape, f32)

    return {
        "x": nrm(ks[0], (BATCH, SEQ, D), 1.0),
        "mem": nrm(ks[1], (BATCH, N_MEM, D), 1.0),
        "g_mix": gain(ks[2], (L, D)),
        "w_in": nrm(ks[3], (L, D, IN_TOTAL), D ** -0.5),
        "g_q_diff": gain(ks[4], (L, DIFF_HEAD_DIM)),
        "g_k_diff": gain(ks[5], (L, DIFF_HEAD_DIM)),
        "lambda_q1": nrm(ks[6], (L, DIFF_HEAD_DIM), 0.1),
        "lambda_k1": nrm(ks[7], (L, DIFF_HEAD_DIM), 0.1),
        "lambda_q2": nrm(ks[8], (L, DIFF_HEAD_DIM), 0.1),
        "lambda_k2": nrm(ks[9], (L, DIFF_HEAD_DIM), 0.1),
        "g_subln": gain(ks[10], (L, DIFF_V_DIM)),
        "conv_w": nrm(ks[11], (L, CONV_K, CONV_WIDTH), CONV_K ** -0.5),
        "g_mem": gain(ks[12], (L, D)),
        "w_mem_kv": nrm(ks[13], (L, D, 2 * MEM_WIDTH), D ** -0.5),
        "g_q_mem": gain(ks[14], (L, MEM_HEAD_DIM)),
        "g_k_mem": gain(ks[15], (L, MEM_HEAD_DIM)),
        "w_branch": nrm(ks[16], (L, N_BRANCH, BRANCH_WIDTH, D), BRANCH_WIDTH ** -0.5),
        "w_out": nrm(ks[17], (L, D, D), D ** -0.5),
        "g_ffn": gain(ks[18], (L, D)),
        "w_router": nrm(ks[19], (L, D, E), D ** -0.5),
        "b_router": nrm(ks[20], (L, E), 0.01),
        "w_gate_up": nrm(ks[21], (L, E, D, 2 * D_FF), D ** -0.5),
        "b_gate_up": nrm(ks[22], (L, E, 2 * D_FF), 0.02),
        "w_down": nrm(ks[23], (L, E, D_FF, D), D_FF ** -0.5),
        "b_down": nrm(ks[24], (L, E, D), 0.02),
    }


def reference(x, mem, g_mix, w_in, g_q_diff, g_k_diff, lambda_q1, lambda_k1,
              lambda_q2, lambda_k2, g_subln, conv_w, g_mem, w_mem_kv, g_q_mem,
              g_k_mem, w_branch, w_out, g_ffn, w_router, b_router, w_gate_up,
              b_gate_up, w_down, b_down):
    B, S, D = x.shape
    f32 = jnp.float32
    pos = jnp.arange(S, dtype=f32)
    inv_freq = 1.0 / (ROPE_THETA ** (jnp.arange(0, DIFF_HEAD_DIM, 2, dtype=f32) / DIFF_HEAD_DIM))
    ang = pos[:, None] * inv_freq[None, :]
    cos = jnp.cos(ang)[:, None, None, :].astype(x.dtype)
    sin = jnp.sin(ang)[:, None, None, :].astype(x.dtype)
    split_points = np.cumsum(IN_SIZES)[:-1].tolist()

    for l in range(DEPTH):
        lam_init = 0.8 - 0.6 * math.exp(-0.3 * l)
        h = rmsnorm(x, g_mix[l])
        proj = h @ w_in[l]
        dq, dk, dv, cb, cc, ch, mq, gate_logits = jnp.split(proj, split_points, axis=-1)

        dq = rope(rmsnorm(dq.reshape(B, S, DIFF_HEADS, 2, DIFF_HEAD_DIM), g_q_diff[l]), cos, sin)
        dk = rope(rmsnorm(dk.reshape(B, S, DIFF_HEADS, 2, DIFF_HEAD_DIM), g_k_diff[l]), cos, sin)
        dv = dv.reshape(B, S, DIFF_HEADS, DIFF_V_DIM)
        lam = (jnp.exp(jnp.sum(lambda_q1[l].astype(f32) * lambda_k1[l].astype(f32)))
               - jnp.exp(jnp.sum(lambda_q2[l].astype(f32) * lambda_k2[l].astype(f32)))
               + lam_init)
        a = diff_attention(dq, dk, dv, lam)
        a = rmsnorm(a, g_subln[l]) * (1.0 - lam_init)
        y_diff = a.reshape(B, S, DIFF_WIDTH)

        y_conv = cb * causal_depthwise_conv(cc * ch, conv_w[l])

        y_mem = memory_cross_attention(mq, mem, g_mem[l], w_mem_kv[l], g_q_mem[l], g_k_mem[l])

        branches = jnp.stack([y_diff, y_conv, y_mem], axis=2)
        branch_out = jnp.einsum('bsnc,ncd->bsnd', branches, w_branch[l])
        gates = jax.nn.sigmoid(gate_logits.reshape(B, S, N_BRANCH, D))
        merged = jnp.sum(gates * branch_out, axis=2)
        x = x + merged @ w_out[l]

        x = x + moe(rmsnorm(x, g_ffn[l]), w_router[l], b_router[l], w_gate_up[l],
                    b_gate_up[l], w_down[l], b_down[l])
    return x
```

```cpp
#include <hip/hip_runtime.h>
#include <cstdio>
#include <cstdint>

namespace nv {
constexpr int BATCH = 2, SEQ = 8192, T = BATCH * SEQ, D = 1024;
constexpr int NIN = 6656, NE = 32, TOPK = 4, DFF = 1024, NMEM = 256;
constexpr int OFF_DQ = 0, OFF_DK = 512, OFF_DV = 1024, OFF_CB = 1536, OFF_CC = 2048, OFF_CH = 2560, OFF_MQ = 3072, OFF_GL = 3584;
constexpr int MAXROWS = 65536 + NE * 256;
constexpr float EPS = 1e-6f;

__device__ __forceinline__ float wave_sum(float v) {
#pragma unroll
    for (int o = 1; o < 64; o <<= 1) v += __shfl_xor(v, o);
    return v;
}

__global__ void __launch_bounds__(256) k_rmsnorm_rows(const float* x, const float* g, float* y, int rows) {
    const int w = (blockIdx.x * 256 + threadIdx.x) >> 6, lane = threadIdx.x & 63;
    if (w >= rows) return;
    const float4* xr = (const float4*)(x + (size_t)w * D);
    float4 v[4]; float s = 0.f;
#pragma unroll
    for (int j = 0; j < 4; ++j) { v[j] = xr[64 * j + lane]; s += v[j].x * v[j].x + v[j].y * v[j].y + v[j].z * v[j].z + v[j].w * v[j].w; }
    const float r = rsqrtf(wave_sum(s) * (1.f / D) + EPS);
    float4* yr = (float4*)(y + (size_t)w * D);
#pragma unroll
    for (int j = 0; j < 4; ++j) { const float4 gg = ((const float4*)g)[64 * j + lane]; float4 o; o.x = v[j].x * r * gg.x; o.y = v[j].y * r * gg.y; o.z = v[j].z * r * gg.z; o.w = v[j].w * r * gg.w; yr[64 * j + lane] = o; }
}

struct GemmP {
    const float* A; int lda; const int* rowidx;
    const float* B; int ldb; long strideB;
    const int* tile_expert; const int* nrows_dev;
    int M, N, K; int dual_off;
    float* C; int ldc; const float* aux; int ldaux; const float* bias; long strideBias; const float* rowscale; int flag;
};

template <int EPI, bool DUAL>
__global__ void __launch_bounds__(256) k_gemm(GemmP p) {
    __shared__ float As[16][68];
    __shared__ float Bs[16][68];
    __shared__ float Bs2[DUAL ? 16 : 1][68];
    const int tid = threadIdx.x, ty = tid >> 4, tx = tid & 15;
    const int m0 = blockIdx.y * 64, n0 = blockIdx.x * 64;
    int Mdyn = p.M; if (p.nrows_dev) Mdyn = *p.nrows_dev;
    if (m0 >= Mdyn) return;
    int e = 0; if (p.tile_expert) e = p.tile_expert[m0 >> 8];
    const float* B = p.B + (size_t)e * p.strideB;
    const int lr = tid >> 2, lk = (tid & 3) * 4;
    int arow = m0 + lr; if (p.rowidx) arow = p.rowidx[arow];
    const float* Ap = (arow >= 0) ? p.A + (size_t)arow * p.lda + lk : nullptr;
    const int bk = tid >> 4, bn = (tid & 15) * 4;
    float acc[4][4], acc2[4][4];
#pragma unroll
    for (int i = 0; i < 4; ++i)
#pragma unroll
        for (int j = 0; j < 4; ++j) { acc[i][j] = 0.f; acc2[i][j] = 0.f; }
    for (int k0 = 0; k0 < p.K; k0 += 16) {
        float4 av = make_float4(0.f, 0.f, 0.f, 0.f); if (Ap) av = *(const float4*)(Ap + k0);
        const float4 bv = *(const float4*)(B + (size_t)(k0 + bk) * p.ldb + n0 + bn);
        float4 bv2 = bv; if (DUAL) bv2 = *(const float4*)(B + (size_t)(k0 + bk) * p.ldb + n0 + bn + p.dual_off);
        __syncthreads();
        As[lk + 0][lr] = av.x; As[lk + 1][lr] = av.y; As[lk + 2][lr] = av.z; As[lk + 3][lr] = av.w;
        *(float4*)&Bs[bk][bn] = bv;
        if (DUAL) *(float4*)&Bs2[bk][bn] = bv2;
        __syncthreads();
#pragma unroll
        for (int k = 0; k < 16; ++k) {
            const float4 a4 = *(const float4*)&As[k][ty * 4];
            const float4 b4 = *(const float4*)&Bs[k][tx * 4];
            const float a[4] = {a4.x, a4.y, a4.z, a4.w}, b[4] = {b4.x, b4.y, b4.z, b4.w};
#pragma unroll
            for (int i = 0; i < 4; ++i)
#pragma unroll
                for (int j = 0; j < 4; ++j) acc[i][j] += a[i] * b[j];
            if (DUAL) { const float4 c4 = *(const float4*)&Bs2[k][tx * 4]; const float c[4] = {c4.x, c4.y, c4.z, c4.w};
#pragma unroll
                for (int i = 0; i < 4; ++i)
#pragma unroll
                    for (int j = 0; j < 4; ++j) acc2[i][j] += a[i] * c[j]; }
        }
    }
    const float* bias = p.bias ? p.bias + (size_t)e * p.strideBias : nullptr;
#pragma unroll
    for (int i = 0; i < 4; ++i) {
        const int r = m0 + ty * 4 + i;
#pragma unroll
        for (int j = 0; j < 4; ++j) {
            const int c = n0 + tx * 4 + j; float v = acc[i][j];
            if (EPI == 0) { if (bias) v += bias[c]; p.C[(size_t)r * p.ldc + c] = v; }
            else if (EPI == 1) { const float z = p.aux[(size_t)r * p.ldaux + c]; const float gt = 1.f / (1.f + expf(-z));
                float* cp = p.C + (size_t)r * p.ldc + c; *cp = (p.flag ? *cp : 0.f) + gt * v; }
            else if (EPI == 2) { p.C[(size_t)r * p.ldc + c] = p.aux[(size_t)r * p.ldaux + c] + v; }
            else if (EPI == 3) { float g = v + bias[c], u = acc2[i][j] + bias[c + p.dual_off];
                g = fminf(g, 7.f); u = fminf(fmaxf(u, -7.f), 7.f);
                p.C[(size_t)r * p.ldc + c] = (u + 1.f) * (g * (1.f / (1.f + expf(-1.702f * g)))); }
            else if (EPI == 4) { const int tok = p.rowidx ? 0 : 0; (void)tok; const int t = ((const int*)p.aux)[r];
                if (t >= 0) atomicAdd(p.C + (size_t)t * p.ldc + c, p.rowscale[r] * (v + bias[c])); }
        }
    }
}

__global__ void __launch_bounds__(256) k_qkprep(const float* proj, const float* gq, const float* gk, float* qn, float* kn) {
    const int w = (blockIdx.x * 256 + threadIdx.x) >> 6, lane = threadIdx.x & 63;
    const int grp = w & 7, which = (w >> 3) & 1, t = w >> 4;
    if (t >= T) return;
    const float v = proj[(size_t)t * NIN + (which ? OFF_DK : OFF_DQ) + grp * 64 + lane];
    const float r = rsqrtf(wave_sum(v * v) * (1.f / 64.f) + EPS);
    const float y = v * r * (which ? gk : gq)[lane];
    const float other = __shfl_xor(y, 32);
    const int i = lane & 31, pos = t % SEQ;
    const float inv_freq = 1.0f / powf(10000.0f, (float)(2 * i) / 64.0f);
    const float ang = (float)pos * inv_freq;
    const float c = cosf(ang), s = sinf(ang);
    const float o = (lane < 32) ? (y * c - other * s) : (y * c + other * s);
    (which ? kn : qn)[(size_t)t * 512 + grp * 64 + lane] = o;
}

__global__ void __launch_bounds__(256) k_diffattn(const float* qn, const float* kn, const float* proj, float* omaps) {
    extern __shared__ float sm[];
    float* Qs = sm; float* Ks = Qs + 64 * 65; float* Ps = Ks + 64 * 65; float* Vs = Ps + 64 * 65; float* Ls = Vs + 64 * 128;
    const int tid = threadIdx.x, qc = blockIdx.x, vh = blockIdx.y, b = blockIdx.z, h = vh >> 1;
    const size_t row0 = (size_t)b * SEQ + (size_t)qc * 64;
    for (int i = tid; i < 64 * 64; i += 256) { const int r = i >> 6, d = i & 63; Qs[r * 65 + d] = qn[(row0 + r) * 512 + vh * 64 + d]; }
    const int ti = tid >> 4, tj = tid & 15;
    float o[4][8]; float l = 0.f;
#pragma unroll
    for (int i = 0; i < 4; ++i)
#pragma unroll
        for (int j = 0; j < 8; ++j) o[i][j] = 0.f;
    for (int kt = 0; kt <= qc; ++kt) {
        const size_t k0 = (size_t)b * SEQ + (size_t)kt * 64;
        __syncthreads();
        for (int i = tid; i < 64 * 64; i += 256) { const int r = i >> 6, d = i & 63; Ks[r * 65 + d] = kn[(k0 + r) * 512 + vh * 64 + d]; }
        for (int i = tid; i < 64 * 128; i += 256) { const int r = i >> 7, d = i & 127; Vs[r * 128 + d] = proj[(k0 + r) * NIN + OFF_DV + h * 128 + d]; }
        __syncthreads();
        float s[4][4];
#pragma unroll
        for (int i = 0; i < 4; ++i)
#pragma unroll
            for (int j = 0; j < 4; ++j) s[i][j] = 0.f;
        for (int d = 0; d < 64; ++d) {
            float a[4], c[4];
#pragma unroll
            for (int i = 0; i < 4; ++i) { a[i] = Qs[(ti * 4 + i) * 65 + d]; c[i] = Ks[(tj * 4 + i) * 65 + d]; }
#pragma unroll
            for (int i = 0; i < 4; ++i)
#pragma unroll
                for (int j = 0; j < 4; ++j) s[i][j] += a[i] * c[j];
        }
#pragma unroll
        for (int i = 0; i < 4; ++i)
#pragma unroll
            for (int j = 0; j < 4; ++j) Ps[(ti * 4 + i) * 65 + tj * 4 + j] = expf(s[i][j] * 0.125f - 12.0f);
        __syncthreads();
        if (tid < 64) { float a = 0.f; for (int j = 0; j < 64; ++j) a += Ps[tid * 65 + j]; l += a; }
        for (int j = 0; j < 64; ++j) {
            float pv[4];
#pragma unroll
            for (int i = 0; i < 4; ++i) pv[i] = Ps[(ti * 4 + i) * 65 + j];
            const float4 v0 = *(const float4*)&Vs[j * 128 + tj * 8], v1 = *(const float4*)&Vs[j * 128 + tj * 8 + 4];
            const float vv[8] = {v0.x, v0.y, v0.z, v0.w, v1.x, v1.y, v1.z, v1.w};
#pragma unroll
            for (int i = 0; i < 4; ++i)
#pragma unroll
                for (int c = 0; c < 8; ++c) o[i][c] += pv[i] * vv[c];
        }
    }
    __syncthreads();
    if (tid < 64) Ls[tid] = l;
    __syncthreads();
#pragma unroll
    for (int i = 0; i < 4; ++i) { const int r = ti * 4 + i; const float il = 1.f / Ls[r];
#pragma unroll
        for (int c = 0; c < 8; ++c) omaps[(row0 + r) * 1024 + vh * 128 + tj * 8 + c] = o[i][c] * il; }
}

__global__ void __launch_bounds__(256) k_diff_finish(const float* omaps, const float* lq1, const float* lk1, const float* lq2, const float* lk2, const float* gs, float* yall) {
    const int w = (blockIdx.x * 256 + threadIdx.x) >> 6, lane = threadIdx.x & 63;
    const int h = w & 3, t = w >> 2;
    if (t >= T) return;
    const float lam = expf(wave_sum(lq1[lane] * lk1[lane])) - expf(wave_sum(lq2[lane] * lk2[lane])) + 0.2f;
    const float* o0 = omaps + (size_t)t * 1024 + (h * 2) * 128; const float* o1 = o0 + 128;
    const float a0 = o0[lane] - lam * o1[lane], a1 = o0[lane + 64] - lam * o1[lane + 64];
    const float r = rsqrtf(wave_sum(a0 * a0 + a1 * a1) * (1.f / 128.f) + EPS);
    yall[(size_t)t * 1536 + h * 128 + lane] = a0 * r * gs[lane] * 0.8f;
    yall[(size_t)t * 1536 + h * 128 + lane + 64] = a1 * r * gs[lane + 64] * 0.8f;
}

__global__ void __launch_bounds__(256) k_conv(const float* proj, const float* cw, float* yall) {
    const size_t i = (size_t)blockIdx.x * 256 + threadIdx.x;
    const int c = (int)(i & 511); const size_t t = i >> 9;
    if (t >= (size_t)T) return;
    const int s = (int)(t % SEQ);
    const float* pr = proj + t * NIN;
    float u0 = pr[OFF_CC + c] * pr[OFF_CH + c], u1 = 0.f, u2 = 0.f;
    if (s >= 1) u1 = pr[OFF_CC + c - NIN] * pr[OFF_CH + c - NIN];
    if (s >= 2) u2 = pr[OFF_CC + c - 2 * NIN] * pr[OFF_CH + c - 2 * NIN];
    yall[t * 1536 + 512 + c] = pr[OFF_CB + c] * (cw[c] * u2 + cw[512 + c] * u1 + cw[1024 + c] * u0);
}

__global__ void __launch_bounds__(256) k_memk_prep(const float* kv, const float* gk, float* knm) {
    const int w = (blockIdx.x * 256 + threadIdx.x) >> 6, lane = threadIdx.x & 63;
    const int h = w & 3, m = w >> 2;
    if (m >= BATCH * NMEM) return;
    const float a0 = kv[(size_t)m * 1024 + h * 128 + lane], a1 = kv[(size_t)m * 1024 + h * 128 + lane + 64];
    const float r = rsqrtf(wave_sum(a0 * a0 + a1 * a1) * (1.f / 128.f) + EPS);
    knm[(size_t)m * 512 + h * 128 + lane] = a0 * r * gk[lane];
    knm[(size_t)m * 512 + h * 128 + lane + 64] = a1 * r * gk[lane + 64];
}

__global__ void __launch_bounds__(256) k_memattn(const float* proj, const float* gq, const float* knm, const float* kv, float* yall) {
    __shared__ float qs[8][128];
    __shared__ float ps[8][256];
    __shared__ float ls[8];
    const int tid = threadIdx.x, h = blockIdx.y, t0 = blockIdx.x * 8, b = t0 / SEQ;
    { const int tok = tid >> 5, part = tid & 31;
      const float4 v = *(const float4*)(proj + (size_t)(t0 + tok) * NIN + OFF_MQ + h * 128 + part * 4);
      float s = v.x * v.x + v.y * v.y + v.z * v.z + v.w * v.w;
#pragma unroll
      for (int o = 1; o < 32; o <<= 1) s += __shfl_xor(s, o);
      const float r = rsqrtf(s * (1.f / 128.f) + EPS);
      const float4 g = *(const float4*)(gq + part * 4);
      qs[tok][part * 4 + 0] = v.x * r * g.x; qs[tok][part * 4 + 1] = v.y * r * g.y; qs[tok][part * 4 + 2] = v.z * r * g.z; qs[tok][part * 4 + 3] = v.w * r * g.w; }
    __syncthreads();
    { const float* kr = knm + (size_t)(b * NMEM + tid) * 512 + h * 128;
      float s[8];
#pragma unroll
      for (int i = 0; i < 8; ++i) s[i] = 0.f;
      for (int d = 0; d < 128; ++d) { const float k = kr[d];
#pragma unroll
          for (int i = 0; i < 8; ++i) s[i] += qs[i][d] * k; }
#pragma unroll
      for (int i = 0; i < 8; ++i) ps[i][tid] = expf(s[i] * 0.08838834764831845f - 12.0f); }
    __syncthreads();
    { const int tok = tid >> 5, part = tid & 31; float s = 0.f;
#pragma unroll
      for (int j = 0; j < 8; ++j) s += ps[tok][part * 8 + j];
#pragma unroll
      for (int o = 1; o < 32; o <<= 1) s += __shfl_xor(s, o);
      if (part == 0) ls[tok] = s; }
    __syncthreads();
    { const int tok = tid >> 5, part = tid & 31; float o[4] = {0.f, 0.f, 0.f, 0.f};
      for (int m = 0; m < NMEM; ++m) { const float p = ps[tok][m];
          const float4 v = *(const float4*)(kv + (size_t)(b * NMEM + m) * 1024 + 512 + h * 128 + part * 4);
          o[0] += p * v.x; o[1] += p * v.y; o[2] += p * v.z; o[3] += p * v.w; }
      const float il = 1.f / ls[tok];
      float* yp = yall + (size_t)(t0 + tok) * 1536 + 1024 + h * 128 + part * 4;
      yp[0] = o[0] * il; yp[1] = o[1] * il; yp[2] = o[2] * il; yp[3] = o[3] * il; }
}

__global__ void __launch_bounds__(256) k_router(const float* x1, const float* g, const float* wr, const float* br, float* h2, int* cnt, int* tk_e, int* tk_pos, float* tk_gate) {
    const int t = (blockIdx.x * 256 + threadIdx.x) >> 6, lane = threadIdx.x & 63;
    if (t >= T) return;
    const float4* xr = (const float4*)(x1 + (size_t)t * D);
    float4 v[4]; float s = 0.f;
#pragma unroll
    for (int j = 0; j < 4; ++j) { v[j] = xr[64 * j + lane]; s += v[j].x * v[j].x + v[j].y * v[j].y + v[j].z * v[j].z + v[j].w * v[j].w; }
    const float r = rsqrtf(wave_sum(s) * (1.f / D) + EPS);
    float4* hr = (float4*)(h2 + (size_t)t * D);
#pragma unroll
    for (int j = 0; j < 4; ++j) { const float4 gg = ((const float4*)g)[64 * j + lane]; v[j].x *= r * gg.x; v[j].y *= r * gg.y; v[j].z *= r * gg.z; v[j].w *= r * gg.w; hr[64 * j + lane] = v[j]; }
    float lg[32];
#pragma unroll
    for (int e = 0; e < 32; ++e) { float a = 0.f;
#pragma unroll
        for (int j = 0; j < 4; ++j) { const int d = (64 * j + lane) * 4;
            a += v[j].x * wr[(d + 0) * 32 + e] + v[j].y * wr[(d + 1) * 32 + e] + v[j].z * wr[(d + 2) * 32 + e] + v[j].w * wr[(d + 3) * 32 + e]; }
        lg[e] = wave_sum(a) + br[e]; }
    float tv[4]; int ti[4];
#pragma unroll
    for (int k = 0; k < 4; ++k) { float best = -INFINITY; int bi = 0;
#pragma unroll
        for (int e = 0; e < 32; ++e) if (lg[e] > best) { best = lg[e]; bi = e; }
#pragma unroll
        for (int e = 0; e < 32; ++e) if (e == bi) lg[e] = -INFINITY;
        tv[k] = best; ti[k] = bi; }
    const float e1 = expf(tv[1] - tv[0]), e2 = expf(tv[2] - tv[0]), e3 = expf(tv[3] - tv[0]);
    const float is = 1.f / (1.f + e1 + e2 + e3);
    const float gt[4] = {is, e1 * is, e2 * is, e3 * is};
    if (lane < 4) {
        int e = ti[0]; float gg = gt[0];
        if (lane == 1) { e = ti[1]; gg = gt[1]; } if (lane == 2) { e = ti[2]; gg = gt[2]; } if (lane == 3) { e = ti[3]; gg = gt[3]; }
        const int pos = atomicAdd(cnt + e, 1);
        tk_e[t * 4 + lane] = e; tk_pos[t * 4 + lane] = pos; tk_gate[t * 4 + lane] = gg;
    }
}

__global__ void k_plan(const int* cnt, int* pstart, int* nrows, int* tile_expert) {
    if (threadIdx.x == 0 && blockIdx.x == 0) {
        int acc = 0;
        for (int e = 0; e < NE; ++e) { pstart[e] = acc; const int nt = (cnt[e] + 255) / 256; for (int i = 0; i < nt; ++i) tile_expert[acc / 256 + i] = e; acc += nt * 256; }
        pstart[NE] = acc; *nrows = acc;
    }
}

__global__ void __launch_bounds__(256) k_scatter(const int* tk_e, const int* tk_pos, const float* tk_gate, const int* pstart, int* row_token, float* row_gate) {
    const int i = blockIdx.x * 256 + threadIdx.x;
    if (i >= T * TOPK) return;
    const int dest = pstart[tk_e[i]] + tk_pos[i];
    row_token[dest] = i >> 2; row_gate[dest] = tk_gate[i];
}
}

extern "C" void kernel_launch(void* const* d_in, const int* in_sizes, int n_in, void* d_out, int out_size, void* d_ws, size_t ws_size, hipStream_t stream) {
    using namespace nv;
    const float* x = (const float*)d_in[0]; const float* mem = (const float*)d_in[1]; const float* g_mix = (const float*)d_in[2]; const float* w_in = (const float*)d_in[3];
    const float* g_q_diff = (const float*)d_in[4]; const float* g_k_diff = (const float*)d_in[5];
    const float* lq1 = (const float*)d_in[6]; const float* lk1 = (const float*)d_in[7]; const float* lq2 = (const float*)d_in[8]; const float* lk2 = (const float*)d_in[9];
    const float* g_subln = (const float*)d_in[10]; const float* conv_w = (const float*)d_in[11]; const float* g_mem = (const float*)d_in[12]; const float* w_mem_kv = (const float*)d_in[13];
    const float* g_q_mem = (const float*)d_in[14]; const float* g_k_mem = (const float*)d_in[15]; const float* w_branch = (const float*)d_in[16]; const float* w_out = (const float*)d_in[17];
    const float* g_ffn = (const float*)d_in[18]; const float* w_router = (const float*)d_in[19]; const float* b_router = (const float*)d_in[20];
    const float* w_gate_up = (const float*)d_in[21]; const float* b_gate_up = (const float*)d_in[22]; const float* w_down = (const float*)d_in[23]; const float* b_down = (const float*)d_in[24];
    float* out = (float*)d_out;
    float* ws = (float*)d_ws; size_t o = 0;
    auto take = [&](size_t n) { float* p = ws + o; o += (n + 63) & ~(size_t)63; return p; };
    float* proj = take((size_t)T * NIN); float* act = proj;
    float* h = take((size_t)T * D); float* merged = h;
    float* qn = take((size_t)T * 512); float* kn = take((size_t)T * 512);
    float* omaps = take((size_t)T * 1024);
    float* yall = take((size_t)T * 1536);
    float* h2 = take((size_t)T * D);
    float* hm = take((size_t)512 * 1024); float* kv = take((size_t)512 * 1024); float* knm = take((size_t)512 * 512);
    int* cnt = (int*)take(64); int* pstart = (int*)take(64); int* nrows = (int*)take(64); int* tile_expert = (int*)take(320);
    int* tk_e = (int*)take((size_t)T * 4); int* tk_pos = (int*)take((size_t)T * 4); float* tk_gate = take((size_t)T * 4);
    int* row_token = (int*)take(MAXROWS); float* row_gate = take(MAXROWS);
    if (o * 4 > ws_size) { fprintf(stderr, "ws too small: need %zu have %zu\n", o * 4, ws_size); return; }

    hipMemsetAsync(cnt, 0, 256, stream);
    hipMemsetAsync(row_token, 0xFF, (size_t)MAXROWS * 4, stream);
    hipMemsetAsync(row_gate, 0, (size_t)MAXROWS * 4, stream);

    k_rmsnorm_rows<<<T / 4, 256, 0, stream>>>(x, g_mix, h, T);
    { GemmP p{}; p.A = h; p.lda = D; p.B = w_in; p.ldb = NIN; p.M = T; p.N = NIN; p.K = D; p.C = proj; p.ldc = NIN;
      k_gemm<0, false><<<dim3(NIN / 64, T / 64), 256, 0, stream>>>(p); }
    k_qkprep<<<T * 16 / 4, 256, 0, stream>>>(proj, g_q_diff, g_k_diff, qn, kn);
    { const int smem = (3 * 64 * 65 + 64 * 128 + 64) * 4;
      static bool attr = false; if (!attr) { hipFuncSetAttribute((const void*)k_diffattn, hipFuncAttributeMaxDynamicSharedMemorySize, smem); attr = true; }
      k_diffattn<<<dim3(SEQ / 64, 8, BATCH), 256, smem, stream>>>(qn, kn, proj, omaps); }
    k_diff_finish<<<T * 4 / 4, 256, 0, stream>>>(omaps, lq1, lk1, lq2, lk2, g_subln, yall);
    k_conv<<<T * 512 / 256, 256, 0, stream>>>(proj, conv_w, yall);
    k_rmsnorm_rows<<<512 / 4, 256, 0, stream>>>(mem, g_mem, hm, 512);
    { GemmP p{}; p.A = hm; p.lda = D; p.B = w_mem_kv; p.ldb = 1024; p.M = 512; p.N = 1024; p.K = D; p.C = kv; p.ldc = 1024;
      k_gemm<0, false><<<dim3(1024 / 64, 512 / 64), 256, 0, stream>>>(p); }
    k_memk_prep<<<512 * 4 / 4, 256, 0, stream>>>(kv, g_k_mem, knm);
    k_memattn<<<dim3(T / 8, 4), 256, 0, stream>>>(proj, g_q_mem, knm, kv, yall);
    for (int n = 0; n < 3; ++n) { GemmP p{}; p.A = yall + n * 512; p.lda = 1536; p.B = w_branch + (size_t)n * 512 * 1024; p.ldb = 1024; p.M = T; p.N = 1024; p.K = 512;
      p.C = merged; p.ldc = 1024; p.aux = proj + OFF_GL + n * 1024; p.ldaux = NIN; p.flag = n;
      k_gemm<1, false><<<dim3(1024 / 64, T / 64), 256, 0, stream>>>(p); }
    { GemmP p{}; p.A = merged; p.lda = D; p.B = w_out; p.ldb = 1024; p.M = T; p.N = 1024; p.K = D; p.C = out; p.ldc = 1024; p.aux = x; p.ldaux = 1024;
      k_gemm<2, false><<<dim3(1024 / 64, T / 64), 256, 0, stream>>>(p); }
    k_router<<<T / 4, 256, 0, stream>>>(out, g_ffn, w_router, b_router, h2, cnt, tk_e, tk_pos, tk_gate);
    k_plan<<<1, 64, 0, stream>>>(cnt, pstart, nrows, tile_expert);
    k_scatter<<<T * 4 / 256, 256, 0, stream>>>(tk_e, tk_pos, tk_gate, pstart, row_token, row_gate);
    { GemmP p{}; p.A = h2; p.lda = D; p.rowidx = row_token; p.B = w_gate_up; p.ldb = 2048; p.strideB = (long)1024 * 2048; p.tile_expert = tile_expert; p.nrows_dev = nrows;
      p.M = MAXROWS; p.N = 1024; p.K = D; p.dual_off = 1024; p.C = act; p.ldc = 1024; p.bias = b_gate_up; p.strideBias = 2048;
      k_gemm<3, true><<<dim3(1024 / 64, MAXROWS / 64), 256, 0, stream>>>(p); }
    { GemmP p{}; p.A = act; p.lda = DFF; p.B = w_down; p.ldb = 1024; p.strideB = (long)1024 * 1024; p.tile_expert = tile_expert; p.nrows_dev = nrows;
      p.M = MAXROWS; p.N = 1024; p.K = DFF; p.C = out; p.ldc = 1024; p.aux = (const float*)row_token; p.bias = b_down; p.strideBias = 1024; p.rowscale = row_gate;
      k_gemm<4, false><<<dim3(1024 / 64, MAXROWS / 64), 256, 0, stream>>>(p); }
}
```

```cpp
#include <hip/hip_runtime.h>
#include <hip/hip_bf16.h>
#include <cstdio>
#include <cstdint>
#include <cmath>

namespace cfg {
constexpr int BATCH = 2, SEQ = 8192, T = BATCH * SEQ, D = 1024, NIN = 6656, NE = 32, NMEM = 256;
constexpr int MAXROWS = 65536 + NE * 256;
constexpr float EPS = 1e-6f;
constexpr float C2 = 0.125f * 1.4426950408889634f;
}

namespace pg8 {
#define PG8_LAS __attribute__((address_space(3)))
typedef unsigned short bf16_t;
typedef short bf16x8 __attribute__((ext_vector_type(8)));
typedef float f32x4 __attribute__((ext_vector_type(4)));
typedef unsigned u32x4 __attribute__((ext_vector_type(4)));
typedef unsigned u32x2 __attribute__((ext_vector_type(2)));
constexpr int BM = 256, BK = 64, HALF = 128, HTB = HALF * BK * 2  , STAGE_BYTES = 8 * HTB, NXCD = 8, WGM = 8;

__host__ __device__ __forceinline__ int lds_byte(int r, int c) { const int st = (r >> 4) * 2 + (c >> 5), rr = r & 15, cc = c & 31, ob = rr * 64 + cc * 2; return st * 1024 + (ob ^ (((ob >> 9) & 1) << 5)); }
__host__ __device__ __forceinline__ void stage_rc(int b, int& R, int& C) { const int st = b / 1024, sb = b % 1024, swz = sb ^ (((sb >> 9) & 1) << 5); R = (st >> 1) * 16 + swz / 64; C = (st & 1) * 32 + (swz % 64) / 2; }

struct Unit { int pm, pn, aux; const char* a; const char* b; };
struct Gemm { unsigned lda, ldb; int K; };

__device__ __forceinline__ void static_map(int L, int nM, int nN, int& pm, int& pn) {
    const int nwg = nM * nN; int wgid = L; { const int q = nwg / NXCD, r = nwg % NXCD, xcd = wgid % NXCD, off = wgid / NXCD; wgid = (xcd < r ? xcd * (q + 1) : r * (q + 1) + (xcd - r) * q) + off; }
    const int nig = WGM * nN, gid = wgid / nig, fm = gid * WGM, gsz = (nM - fm) < WGM ? (nM - fm) : WGM;
    pm = fm + ((wgid % nig) % gsz); pn = (wgid % nig) / gsz;
}

typedef float f32x2_cv __attribute__((ext_vector_type(2))); typedef __bf16 bf16x2_cv __attribute__((ext_vector_type(2)));
__device__ __forceinline__ unsigned cvt_pk_bf16(float lo, float hi) { f32x2_cv v = {lo, hi}; bf16x2_cv b = __builtin_convertvector(v, bf16x2_cv); return __builtin_bit_cast(unsigned, b); }
__device__ __forceinline__ u32x4 pack8(const f32x4 v0, const f32x4 v1) { u32x4 w; w.x = cvt_pk_bf16(v0[0], v0[1]); w.y = cvt_pk_bf16(v0[2], v0[3]); w.z = cvt_pk_bf16(v1[0], v1[1]); w.w = cvt_pk_bf16(v1[2], v1[3]); return w; }
__device__ __forceinline__ f32x4 unpk_lo(const u32x4 w) { return (f32x4){__uint_as_float(w.x << 16), __uint_as_float(w.x & 0xffff0000u), __uint_as_float(w.y << 16), __uint_as_float(w.y & 0xffff0000u)}; }
__device__ __forceinline__ f32x4 unpk_hi(const u32x4 w) { return (f32x4){__uint_as_float(w.z << 16), __uint_as_float(w.z & 0xffff0000u), __uint_as_float(w.w << 16), __uint_as_float(w.w & 0xffff0000u)}; }
__device__ __forceinline__ float sigmoidf_fast(float z) { return __builtin_amdgcn_rcpf(1.0f + __builtin_amdgcn_exp2f(-1.4426950408889634f * z)); }

using cfg::T; using cfg::SEQ; using cfg::EPS;

struct EpiProj {
    static constexpr bool AFTER_DRAIN = false;
    bf16_t *Q, *K, *V, *U, *CB, *MQ, *GATES, *KVM; float* ssq; const float *gq, *gk, *rcos, *rsin;
    __device__ __forceinline__ bool keep(const Unit&) const { return false; }
    __device__ __forceinline__ void operator()(f32x4 (&acc)[2][2][4][2], const Unit& u, int wr, int wc, int fr, int fq) const {
        const int pn = u.pn; const int row0 = u.pm * BM + wr * 64 + fr;
        if (pn < 4) {
            const bool isk = pn >= 2; const float* g = isk ? gk : gq; bf16_t* dst = (isk ? K : Q) + (pn & 1) * 256 + wc * 64 + 8 * fq;
            const float post = isk ? 1.0f : cfg::C2;
            f32x4 ga[2][2];
#pragma unroll
            for (int bj = 0; bj < 2; ++bj)
#pragma unroll
                for (int n = 0; n < 2; ++n) ga[bj][n] = *(const f32x4*)(g + 32 * bj + 8 * fq + 4 * n);
#pragma unroll
            for (int ai = 0; ai < 2; ++ai)
#pragma unroll
                for (int m = 0; m < 4; ++m) {
                    const int row = row0 + ai * HALF + m * 16;
                    float ss = 0.f;
#pragma unroll
                    for (int bj = 0; bj < 2; ++bj)
#pragma unroll
                        for (int n = 0; n < 2; ++n) { const f32x4 x = acc[ai][bj][m][n]; ss += (x[0] * x[0] + x[1] * x[1]) + (x[2] * x[2] + x[3] * x[3]); }
                    ss += __shfl_xor(ss, 16); ss += __shfl_xor(ss, 32);
                    const float rinv = __builtin_amdgcn_rsqf(ss * (1.0f / 64.0f) + EPS) * post;
                    const int pos = row & (SEQ - 1);
                    f32x4 o1[2], o2[2];
#pragma unroll
                    for (int n = 0; n < 2; ++n) {
                        const f32x4 c = *(const f32x4*)(rcos + pos * 32 + 8 * fq + 4 * n), s = *(const f32x4*)(rsin + pos * 32 + 8 * fq + 4 * n);
                        const f32x4 x1 = acc[ai][0][m][n] * ga[0][n] * rinv, x2 = acc[ai][1][m][n] * ga[1][n] * rinv;
                        o1[n] = x1 * c - x2 * s; o2[n] = x2 * c + x1 * s;
                    }
                    *(u32x4*)(dst + (size_t)row * 512) = pack8(o1[0], o1[1]);
                    *(u32x4*)(dst + (size_t)row * 512 + 32) = pack8(o2[0], o2[1]);
                }
        } else if (pn >= 6 && pn < 10) {
            bf16_t* dst = U + (pn - 6) * 128 + wc * 32 + 8 * fq;
#pragma unroll
            for (int ai = 0; ai < 2; ++ai)
#pragma unroll
                for (int m = 0; m < 4; ++m) { const int row = row0 + ai * HALF + m * 16;
                    *(u32x4*)(dst + (size_t)row * 512) = pack8(acc[ai][0][m][0] * acc[ai][1][m][0], acc[ai][0][m][1] * acc[ai][1][m][1]); }
        } else if (pn >= 14 && pn < 26) {
            bf16_t* dst = GATES + (pn - 14) * 256 + wc * 32 + 8 * fq;
#pragma unroll
            for (int ai = 0; ai < 2; ++ai)
#pragma unroll
                for (int m = 0; m < 4; ++m) { const int row = row0 + ai * HALF + m * 16;
#pragma unroll
                    for (int bj = 0; bj < 2; ++bj) { f32x4 v0 = acc[ai][bj][m][0], v1 = acc[ai][bj][m][1];
#pragma unroll
                        for (int e = 0; e < 4; ++e) { v0[e] = sigmoidf_fast(v0[e]); v1[e] = sigmoidf_fast(v1[e]); }
                        *(u32x4*)(dst + (size_t)row * 3072 + bj * HALF) = pack8(v0, v1); } }
        } else {
            bf16_t* dst; int ld, rsub = 0; const bool ismq = (pn == 12 || pn == 13);
            if (pn < 6) { dst = V + (pn - 4) * 256; ld = 512; } else if (pn < 12) { dst = CB + (pn - 10) * 256; ld = 512; }
            else if (pn < 14) { dst = MQ + (pn - 12) * 256; ld = 512; } else { dst = KVM + (pn - 26) * 256; ld = 1024; rsub = T; }
            dst += wc * 32 + 8 * fq;
#pragma unroll
            for (int ai = 0; ai < 2; ++ai)
#pragma unroll
                for (int m = 0; m < 4; ++m) { const int row = row0 + ai * HALF + m * 16 - rsub;
#pragma unroll
                    for (int bj = 0; bj < 2; ++bj) { const f32x4 v0 = acc[ai][bj][m][0], v1 = acc[ai][bj][m][1];
                        *(u32x4*)(dst + (size_t)row * ld + bj * HALF) = pack8(v0, v1);
                        if (ismq) { float ss = ((v0[0] * v0[0] + v0[1] * v0[1]) + (v0[2] * v0[2] + v0[3] * v0[3])) + ((v1[0] * v1[0] + v1[1] * v1[1]) + (v1[2] * v1[2] + v1[3] * v1[3]));
                            ss += __shfl_xor(ss, 16); ss += __shfl_xor(ss, 32);
                            if (fq == 0) ssq[(size_t)row * 16 + ((pn - 12) * 2 + bj) * 4 + wc] = ss; } } }
        }
    }
};

struct EpiMerge {
    static constexpr bool AFTER_DRAIN = false;
    const bf16_t* GATES; bf16_t* MERGED;
    __device__ __forceinline__ bool keep(const Unit& u) const { return u.aux < 2; }
    __device__ __forceinline__ void operator()(f32x4 (&acc)[2][2][4][2], const Unit& u, int wr, int wc, int fr, int fq) const {
        const int br = u.aux; const int row0 = u.pm * BM + wr * 64 + fr, col0 = u.pn * BM + wc * 32 + 8 * fq;
#pragma unroll
        for (int ai = 0; ai < 2; ++ai)
#pragma unroll
            for (int m = 0; m < 4; ++m) { const int row = row0 + ai * HALF + m * 16;
#pragma unroll
                for (int bj = 0; bj < 2; ++bj) {
                    const u32x4 ga = *(const u32x4*)(GATES + (size_t)row * 3072 + br * 1024 + col0 + bj * HALF);
                    f32x4 f0 = unpk_lo(ga), f1 = unpk_hi(ga);
                    if (br < 2) { const u32x4 gb = *(const u32x4*)(GATES + (size_t)row * 3072 + (br + 1) * 1024 + col0 + bj * HALF); const f32x4 d0 = unpk_lo(gb), d1 = unpk_hi(gb);
#pragma unroll
                        for (int e = 0; e < 4; ++e) { f0[e] *= __builtin_amdgcn_rcpf(d0[e]); f1[e] *= __builtin_amdgcn_rcpf(d1[e]); } }
                    acc[ai][bj][m][0] *= f0; acc[ai][bj][m][1] *= f1;
                    if (br == 2) *(u32x4*)(MERGED + (size_t)row * 1024 + col0 + bj * HALF) = pack8(acc[ai][bj][m][0], acc[ai][bj][m][1]);
                } }
    }
};

struct EpiResid {
    static constexpr bool AFTER_DRAIN = false;
    const float* base; float* out;
    __device__ __forceinline__ bool keep(const Unit&) const { return false; }
    __device__ __forceinline__ void operator()(f32x4 (&acc)[2][2][4][2], const Unit& u, int wr, int wc, int fr, int fq) const {
        const int row0 = u.pm * BM + wr * 64 + fr, col0 = u.pn * BM + wc * 32 + 4 * fq;
#pragma unroll
        for (int ai = 0; ai < 2; ++ai)
#pragma unroll
            for (int m = 0; m < 4; ++m) { const size_t off = (size_t)(row0 + ai * HALF + m * 16) * 1024 + col0;
#pragma unroll
                for (int bj = 0; bj < 2; ++bj)
#pragma unroll
                    for (int n = 0; n < 2; ++n) *(f32x4*)(out + off + bj * HALF + n * 16) = *(const f32x4*)(base + off + bj * HALF + n * 16) + acc[ai][bj][m][n]; }
    }
};

struct EpiSwiglu {
    static constexpr bool AFTER_DRAIN = false;
    const float* bgu; bf16_t* ACT;
    __device__ __forceinline__ bool keep(const Unit&) const { return false; }
    __device__ __forceinline__ void operator()(f32x4 (&acc)[2][2][4][2], const Unit& u, int wr, int wc, int fr, int fq) const {
        const int e_ = u.pn >> 3, pnl = u.pn & 7; const int row0 = u.pm * BM + wr * 64 + fr, ch0 = pnl * 128 + wc * 32 + 8 * fq;
        f32x4 bg[2], bu[2];
#pragma unroll
        for (int n = 0; n < 2; ++n) { bg[n] = *(const f32x4*)(bgu + (size_t)e_ * 2048 + ch0 + 4 * n); bu[n] = *(const f32x4*)(bgu + (size_t)e_ * 2048 + 1024 + ch0 + 4 * n); }
#pragma unroll
        for (int ai = 0; ai < 2; ++ai)
#pragma unroll
            for (int m = 0; m < 4; ++m) { const int row = row0 + ai * HALF + m * 16; f32x4 a[2];
#pragma unroll
                for (int n = 0; n < 2; ++n) { const f32x4 g = acc[ai][0][m][n] + bg[n], uu = acc[ai][1][m][n] + bu[n];
#pragma unroll
                    for (int e = 0; e < 4; ++e) { const float gm = fminf(g[e], 7.0f), um = fminf(fmaxf(uu[e], -7.0f), 7.0f);
                        a[n][e] = (um + 1.0f) * (gm * sigmoidf_fast(1.702f * gm)); } }
                *(u32x4*)(ACT + (size_t)row * 1024 + ch0) = pack8(a[0], a[1]); }
    }
};

struct EpiDown {
    static constexpr bool AFTER_DRAIN = false;
    const float* bd; const float* row_gate; bf16_t* YS;
    __device__ __forceinline__ bool keep(const Unit&) const { return false; }
    __device__ __forceinline__ void operator()(f32x4 (&acc)[2][2][4][2], const Unit& u, int wr, int wc, int fr, int fq) const {
        const int e_ = u.pn >> 2, pnl = u.pn & 3; const int row0 = u.pm * BM + wr * 64 + fr, col0 = pnl * 256 + wc * 32 + 8 * fq;
        f32x4 bv[2][2];
#pragma unroll
        for (int bj = 0; bj < 2; ++bj)
#pragma unroll
            for (int n = 0; n < 2; ++n) bv[bj][n] = *(const f32x4*)(bd + (size_t)e_ * 1024 + col0 + bj * HALF + 4 * n);
#pragma unroll
        for (int ai = 0; ai < 2; ++ai)
#pragma unroll
            for (int m = 0; m < 4; ++m) { const int row = row0 + ai * HALF + m * 16; const float rg = row_gate[row];
#pragma unroll
                for (int bj = 0; bj < 2; ++bj)
                    *(u32x4*)(YS + (size_t)row * 1024 + col0 + bj * HALF) = pack8((acc[ai][bj][m][0] + bv[bj][0]) * rg, (acc[ai][bj][m][1] + bv[bj][1]) * rg); }
    }
};

template <class Epi, class Sched, bool ALIGN_EPI = false, bool SP2 = false>
__device__ __forceinline__ void gemm_phase(PG8_LAS unsigned char* lds, const Gemm g, const Sched& S, const Epi& E) {
    int tid_ = threadIdx.x; asm volatile("" : "+v"(tid_));
    const int tid = tid_, wid = __builtin_amdgcn_readfirstlane(tid >> 6), lane = tid & 63, wr = wid >> 2, wc = wid & 3, fr = lane & 15, fq = lane >> 4;
    const int K = g.K, nt = K / BK;
    unsigned voffA[2], voffB[2];
#pragma unroll
    for (int i = 0; i < 2; ++i) { int R, C; stage_rc(tid * 16 + i * 8192, R, C);
        voffA[i] = (unsigned)R * g.lda + (unsigned)C * 2u; voffB[i] = (unsigned)R * g.ldb + (unsigned)C * 2u; }
    const size_t kstep = (size_t)(BK * 2);
    const size_t hstepA = (size_t)HALF * g.lda, hstepB = (size_t)HALF * g.ldb;
    const unsigned ldsw = (unsigned)wid * 1024u;
    const int aoff = lds_byte(wr * 64 + fr, fq * 8), boff = lds_byte(wc * 32 + fr, fq * 8);
#define PG8_SA(b, h) (((b) * 2 + (h)) * HTB)
#define PG8_SB(b, h) ((4 + (b) * 2 + (h)) * HTB)
#define PG8_STAGE(bufoff, gbase, voff) do { _Pragma("unroll") for (int _i = 0; _i < 2; ++_i) \
        __builtin_amdgcn_global_load_lds((const unsigned*)((const char*)(gbase) + (voff)[_i]), (PG8_LAS unsigned*)(lds + (bufoff) + ldsw + _i * 8192), 16, 0, 0); } while (0)
#define PG8_LDA(dst, b, h) do { _Pragma("unroll") for (int m = 0; m < 4; ++m) _Pragma("unroll") for (int k = 0; k < 2; ++k) dst[m][k] = *(const PG8_LAS bf16x8*)(lds + PG8_SA(b, h) + aoff + m * 2048 + k * 1024); } while (0)
#define PG8_LDB(dst, b, h) do { _Pragma("unroll") for (int n = 0; n < 2; ++n) _Pragma("unroll") for (int k = 0; k < 2; ++k) dst[n][k] = *(const PG8_LAS bf16x8*)(lds + PG8_SB(b, h) + boff + n * 2048 + k * 1024); } while (0)
#define PG8_MMA(ai, bj, At, Bt) do { __builtin_amdgcn_s_setprio(1); _Pragma("unroll") for (int m = 0; m < 4; ++m) _Pragma("unroll") for (int n = 0; n < 2; ++n) _Pragma("unroll") for (int k = 0; k < 2; ++k) \
        acc[ai][bj][m][n] = __builtin_amdgcn_mfma_f32_16x16x32_bf16(Bt[n][k], At[m][k], acc[ai][bj][m][n], 0, 0, 0); __builtin_amdgcn_s_setprio(0); } while (0)
#define PG8_WAIT_V(n) asm volatile("s_waitcnt vmcnt(" #n ")" ::: "memory")
#define PG8_WAIT_L(n) asm volatile("s_waitcnt lgkmcnt(" #n ")" ::: "memory")
#define PG8_BAR __builtin_amdgcn_s_barrier()
#define PG8_SCHED __builtin_amdgcn_sched_barrier(0)
    Unit cur, nxt; int ui = 0;
    if (!S.next(0, cur)) return;
    f32x4 acc[2][2][4][2];
#pragma unroll
    for (int a = 0; a < 2; ++a)
#pragma unroll
        for (int b = 0; b < 2; ++b)
#pragma unroll
            for (int m = 0; m < 4; ++m)
#pragma unroll
                for (int n = 0; n < 2; ++n) acc[a][b][m][n] = (f32x4){0.f, 0.f, 0.f, 0.f};
    bf16x8 At[4][2], B0[2][2], B1[2][2];
    const char* cA = cur.a; const char* cB = cur.b;
    S.a_ready(cur);
    if constexpr (SP2) {
        PG8_STAGE(PG8_SB(0, 0), cB, voffB); PG8_STAGE(PG8_SB(0, 1), cB + hstepB, voffB); PG8_STAGE(PG8_SA(0, 0), cA, voffA); PG8_STAGE(PG8_SA(0, 1), cA + hstepA, voffA);
        if (wr == 1) PG8_BAR;
        PG8_WAIT_V(2); PG8_BAR;
        PG8_STAGE(PG8_SB(1, 0), cB + kstep, voffB); PG8_STAGE(PG8_SA(1, 0), cA + kstep, voffA); PG8_STAGE(PG8_SB(1, 1), cB + hstepB + kstep, voffB);
        PG8_WAIT_V(6); PG8_BAR;
    } else {
        PG8_STAGE(PG8_SB(0, 0), cB, voffB); PG8_STAGE(PG8_SA(0, 0), cA, voffA); PG8_STAGE(PG8_SB(0, 1), cB + hstepB, voffB); PG8_STAGE(PG8_SA(0, 1), cA + hstepA, voffA);
        if (wr == 1) PG8_BAR;
        PG8_WAIT_V(4); PG8_BAR;
        PG8_STAGE(PG8_SB(1, 0), cB + kstep, voffB); PG8_STAGE(PG8_SA(1, 0), cA + kstep, voffA); PG8_STAGE(PG8_SB(1, 1), cB + hstepB + kstep, voffB);
        PG8_WAIT_V(6); PG8_BAR;
    }
    for (;;) {
        const bool has_next = S.next(ui + 1, nxt);
        const char* nA = has_next ? nxt.a : cA; const char* nB = has_next ? nxt.b : cB;
        for (int t = 0; t < nt; t += 2) {
            const bool last = (t == nt - 2);
            const char* a1 = cA + (size_t)(t + 1) * kstep;
            const char* a2 = last ? nA : cA + (size_t)(t + 2) * kstep; const char* b2 = last ? nB : cB + (size_t)(t + 2) * kstep;
            const char* a3 = a2 + kstep; const char* b3 = b2 + kstep;
            if (last && has_next) S.a_ready(nxt);
            if constexpr (SP2) {
            PG8_LDB(B0, 0, 0); PG8_LDB(B1, 0, 1); PG8_SCHED; PG8_LDA(At, 0, 0); PG8_STAGE(PG8_SA(1, 1), a1 + hstepA, voffA);
            PG8_WAIT_V(8); PG8_WAIT_L(0); PG8_BAR; PG8_MMA(0, 0, At, B0); PG8_MMA(0, 1, At, B1); PG8_BAR; PG8_SCHED;
            PG8_LDA(At, 0, 1); PG8_STAGE(PG8_SB(0, 0), b2, voffB); PG8_STAGE(PG8_SB(0, 1), b2 + hstepB, voffB); PG8_STAGE(PG8_SA(0, 0), a2, voffA);
            PG8_WAIT_V(8); PG8_WAIT_L(0); PG8_BAR; PG8_MMA(1, 0, At, B0); PG8_MMA(1, 1, At, B1); PG8_BAR; PG8_SCHED;
            PG8_LDB(B0, 1, 0); PG8_LDB(B1, 1, 1); PG8_SCHED; PG8_LDA(At, 1, 0); PG8_STAGE(PG8_SA(0, 1), a2 + hstepA, voffA);
            PG8_WAIT_V(8); PG8_WAIT_L(0); PG8_BAR; PG8_MMA(0, 0, At, B0); PG8_MMA(0, 1, At, B1); PG8_BAR; PG8_SCHED;
            PG8_LDA(At, 1, 1); PG8_STAGE(PG8_SB(1, 0), b3, voffB); PG8_STAGE(PG8_SB(1, 1), b3 + hstepB, voffB); PG8_STAGE(PG8_SA(1, 0), a3, voffA);
            PG8_WAIT_V(8); PG8_WAIT_L(0); PG8_BAR; PG8_MMA(1, 0, At, B0); PG8_MMA(1, 1, At, B1); PG8_BAR; PG8_SCHED;
            } else {
            PG8_LDB(B0, 0, 0); PG8_SCHED; PG8_LDA(At, 0, 0); PG8_STAGE(PG8_SA(1, 1), a1 + hstepA, voffA);
            PG8_WAIT_L(8); PG8_BAR; PG8_WAIT_L(0); PG8_MMA(0, 0, At, B0); PG8_BAR; PG8_SCHED;
            PG8_LDB(B1, 0, 1); PG8_STAGE(PG8_SB(0, 0), b2, voffB);
            PG8_BAR; PG8_WAIT_L(0); PG8_MMA(0, 1, At, B1); PG8_BAR;
            PG8_LDA(At, 0, 1); PG8_STAGE(PG8_SA(0, 0), a2, voffA);
            PG8_BAR; PG8_WAIT_L(0); PG8_MMA(1, 0, At, B0); PG8_BAR; PG8_SCHED;
            PG8_STAGE(PG8_SB(0, 1), b2 + hstepB, voffB);
            PG8_WAIT_V(6); PG8_BAR; PG8_MMA(1, 1, At, B1); PG8_BAR;
            PG8_LDB(B0, 1, 0); PG8_SCHED; PG8_LDA(At, 1, 0); PG8_STAGE(PG8_SA(0, 1), a2 + hstepA, voffA);
            PG8_WAIT_L(8); PG8_BAR; PG8_WAIT_L(0); PG8_MMA(0, 0, At, B0); PG8_BAR; PG8_SCHED;
            PG8_LDB(B1, 1, 1); PG8_STAGE(PG8_SB(1, 0), b3, voffB);
            PG8_BAR; PG8_WAIT_L(0); PG8_MMA(0, 1, At, B1); PG8_BAR;
            PG8_LDA(At, 1, 1); PG8_STAGE(PG8_SA(1, 0), a3, voffA);
            PG8_BAR; PG8_WAIT_L(0); PG8_MMA(1, 0, At, B0); PG8_BAR; PG8_SCHED;
            PG8_STAGE(PG8_SB(1, 1), b3 + hstepB, voffB);
            PG8_WAIT_V(6); PG8_BAR; PG8_MMA(1, 1, At, B1); PG8_BAR;
            }
        }
        if constexpr (ALIGN_EPI) { if (wr == 0) PG8_BAR; }
        if constexpr (!Epi::AFTER_DRAIN) { E(acc, cur, wr, wc, fr, fq); S.done(cur); }
        if (!has_next) break;
        if (!E.keep(cur)) {
#pragma unroll
        for (int a = 0; a < 2; ++a)
#pragma unroll
            for (int b = 0; b < 2; ++b)
#pragma unroll
                for (int m = 0; m < 4; ++m)
#pragma unroll
                    for (int n = 0; n < 2; ++n) acc[a][b][m][n] = (f32x4){0.f, 0.f, 0.f, 0.f};
        }
        cur = nxt; cA = nA; cB = nB; ++ui;
        if constexpr (ALIGN_EPI) { if (wr == 1) PG8_BAR; }
    }
    PG8_WAIT_V(0);
    if constexpr (!ALIGN_EPI) { if (wr == 0) PG8_BAR; }
    PG8_BAR;
    if constexpr (Epi::AFTER_DRAIN) { E.fused(acc, cur, wr, wc, fr, fq, lds, wid, lane); S.done(cur); }
#undef PG8_SA
#undef PG8_SB
#undef PG8_STAGE
#undef PG8_LDA
#undef PG8_LDB
#undef PG8_MMA
#undef PG8_WAIT_V
#undef PG8_WAIT_L
#undef PG8_BAR
#undef PG8_SCHED
}
}

#include <hip/hip_bf16.h>
#include <cmath>
namespace attn_body {
using bf16=__hip_bfloat16;
using bf16x8=__attribute__((ext_vector_type(8)))short;
using s16x4=__attribute__((ext_vector_type(4)))short;
using f32x16=__attribute__((ext_vector_type(16)))float;
using u32x4=__attribute__((ext_vector_type(4)))unsigned;
constexpr int SEQ=8192,D=64; constexpr int QP=512,KP=512,VP=512,OP=1024;
constexpr int NW=8,QBLK=32,QB=QBLK*NW,KVBLK=64,NQB=SEQ/QB;
constexpr int ATTN_UNIT_ROWS=QB;
__device__ __forceinline__ int crow(int r,int hi){return (r&3)+8*(r>>2)+4*hi;}
#define SBAR() __builtin_amdgcn_sched_barrier(0)
__device__ __forceinline__ void cmask(f32x16&p0,f32x16&p1,int jb,int qrel,int hi){
  const float NEG=-INFINITY; (void)hi;
  if(jb>(qrel>>6)){
  #pragma unroll
  for(int r=0;r<16;++r){p0[r]=NEG;p1[r]=NEG;} }
}

constexpr int NSLOT=3, SLOTB=8192;
constexpr int LDS_K=0, LDS_V=NSLOT*SLOTB, LDS_WS=2*NSLOT*SLOTB, LDS_OST=LDS_WS+NW*64*4, LDS_BYTES=LDS_OST+NW*4096;
constexpr float C2=0.125f*1.4426950408889634f;
__device__ __forceinline__ void glds16(const void*gsrc,unsigned lds_dst){unsigned keep;
  asm volatile("s_mov_b32 %0, m0\n\ts_mov_b32 m0, %2\n\ts_nop 0\n\tglobal_load_lds_dwordx4 %1, off\n\ts_mov_b32 m0, %0":"=&s"(keep):"v"(gsrc),"s"(lds_dst):"memory");}
__device__ __forceinline__ float max3f(float a,float b,float c){float r;asm("v_max3_f32 %0, %1, %2, %3":"=v"(r):"v"(a),"v"(b),"v"(c));return r;}
__device__ __forceinline__ float max2f(float a,float b){float r;asm("v_max_f32_e32 %0, %1, %2":"=v"(r):"v"(a),"v"(b));return r;}
__device__ __forceinline__ float fadd_s(float a,float b){float r;asm("v_add_f32_e32 %0, %1, %2":"=v"(r):"v"(a),"v"(b));return r;}
__device__ __forceinline__ float fsub_s(float a,float b){float r;asm("v_sub_f32_e32 %0, %1, %2":"=v"(r):"v"(a),"v"(b));return r;}
typedef float f32x2_t __attribute__((ext_vector_type(2))); typedef __bf16 bf16x2_t __attribute__((ext_vector_type(2)));
__device__ __forceinline__ unsigned cvtpk_s(float lo,float hi){f32x2_t v={lo,hi};bf16x2_t b=__builtin_convertvector(v,bf16x2_t);return __builtin_bit_cast(unsigned,b);}
#define WAIT_BAR(N) asm volatile("s_waitcnt vmcnt(" #N ") lgkmcnt(0)\n\ts_barrier":::"memory")

__device__ __forceinline__ void qkt(f32x16&p0,f32x16&p1,const char*Kslot,const bf16x8*qr,const f32x16&negm,int r32,int hi){
  const char*kb=Kslot+hi*1024+r32*16;
  #pragma unroll
  for(int d0=0;d0<4;++d0){
    const bf16x8 b0=*reinterpret_cast<const bf16x8*>(kb+d0*2048);
    const bf16x8 b1=*reinterpret_cast<const bf16x8*>(kb+d0*2048+512);
    if(d0==0){p0=__builtin_amdgcn_mfma_f32_32x32x16_bf16(b0,qr[0],negm,0,0,0);p1=__builtin_amdgcn_mfma_f32_32x32x16_bf16(b1,qr[0],negm,0,0,0);}
    else{p0=__builtin_amdgcn_mfma_f32_32x32x16_bf16(b0,qr[d0],p0,0,0,0);p1=__builtin_amdgcn_mfma_f32_32x32x16_bf16(b1,qr[d0],p1,0,0,0);}}
}
typedef __attribute__((address_space(3))) const char* lds_cptr;
typedef short v4i16_t __attribute__((ext_vector_type(4)));
__device__ __forceinline__ void kload8(bf16x8*kf,lds_cptr kp){
  kf[0]=*(const __attribute__((address_space(3))) bf16x8*)(kp);      kf[1]=*(const __attribute__((address_space(3))) bf16x8*)(kp+512);
  kf[2]=*(const __attribute__((address_space(3))) bf16x8*)(kp+2048); kf[3]=*(const __attribute__((address_space(3))) bf16x8*)(kp+2560);
  kf[4]=*(const __attribute__((address_space(3))) bf16x8*)(kp+4096); kf[5]=*(const __attribute__((address_space(3))) bf16x8*)(kp+4608);
  kf[6]=*(const __attribute__((address_space(3))) bf16x8*)(kp+6144); kf[7]=*(const __attribute__((address_space(3))) bf16x8*)(kp+6656);
}
__device__ __forceinline__ void kload2(bf16x8*kf,lds_cptr kp,int j){ kf[2*j]=*(const __attribute__((address_space(3))) bf16x8*)(kp+j*2048); kf[2*j+1]=*(const __attribute__((address_space(3))) bf16x8*)(kp+j*2048+512); }
__device__ __forceinline__ s16x4 vtr(lds_cptr p){ return __builtin_bit_cast(s16x4,__builtin_amdgcn_ds_read_tr16_b64_v4i16((__attribute__((address_space(3))) v4i16_t*)p)); }
__device__ __forceinline__ float rowmax(const f32x16&p0,const f32x16&p1){
  float a=max3f(p0[0],p0[1],p1[0]),b=max3f(p0[2],p0[3],p1[1]);a=max3f(a,p1[2],p1[3]);
  #pragma unroll
  for(int r=4;r<16;r+=4){a=max3f(a,p0[r],p0[r+1]);b=max3f(b,p0[r+2],p0[r+3]);a=max3f(a,p1[r],p1[r+1]);b=max3f(b,p1[r+2],p1[r+3]);}
  const float m=max2f(a,b);
  auto rr=__builtin_amdgcn_permlane32_swap(__float_as_uint(m),__float_as_uint(m),false,false);
  return max2f(__uint_as_float(rr[0]),__uint_as_float(rr[1]));
}
__device__ __forceinline__ void pv(f32x16*o,int vb,bf16x8 pa0,bf16x8 pa1,bf16x8 pa2,bf16x8 pa3){
  #pragma unroll
  for(int d0=0;d0<2;++d0){s16x4 lo[4],hi[4];
    #pragma unroll
    for(int ks=0;ks<4;++ks){
      asm volatile("ds_read_b64_tr_b16 %0,%1 offset:%c2":"=&v"(lo[ks]):"v"(vb),"i"(d0*4096+ks*1024):"memory");
      asm volatile("ds_read_b64_tr_b16 %0,%1 offset:%c2":"=&v"(hi[ks]):"v"(vb),"i"(d0*4096+ks*1024+512):"memory");}
    asm volatile("s_waitcnt lgkmcnt(0)":::"memory");SBAR();
    #define PK(k) (bf16x8){lo[k][0],lo[k][1],lo[k][2],lo[k][3],hi[k][0],hi[k][1],hi[k][2],hi[k][3]}
    o[d0]=__builtin_amdgcn_mfma_f32_32x32x16_bf16(pa0,PK(0),o[d0],0,0,0);
    o[d0]=__builtin_amdgcn_mfma_f32_32x32x16_bf16(pa1,PK(1),o[d0],0,0,0);
    o[d0]=__builtin_amdgcn_mfma_f32_32x32x16_bf16(pa2,PK(2),o[d0],0,0,0);
    o[d0]=__builtin_amdgcn_mfma_f32_32x32x16_bf16(pa3,PK(3),o[d0],0,0,0);
    #undef PK
  }
}

#ifndef ATTN_STORE16
#define ATTN_STORE16(p,v) (*(u32x4*)(p)=(v))
#endif
template<int THRL> __device__ __forceinline__ void attn_unit(int qb,const bf16*Q,const bf16*__restrict__ K,const bf16*__restrict__ V,bf16*O,char*shm){
  int tid_=threadIdx.x; asm volatile("":"+v"(tid_)); const int tid=tid_,lane=tid&63,r32=lane&31,hi=lane>>5; const int wid=__builtin_amdgcn_readfirstlane(tid>>6);
  const int q0=qb*QB;
  const bf16*Qw=Q+(long)(q0+wid*QBLK)*QP;
  const bf16*Kh=K,*Vh=V;
  const unsigned lds0=(unsigned)(uintptr_t)shm;
  float*wsf=(float*)(shm+LDS_WS)+wid*64;
  const bf16*ksrc=Kh+(long)lane*KP+wid*8;
  const bf16*vsrc=Vh+(long)(16*(wid&3)+(lane>>2))*VP+(wid>>2)*32+(lane&3)*8;
  const unsigned kdst=lds0+LDS_K+wid*1024, vdst=lds0+LDS_V+wid*1024;
  #define DMA_K(t,slot) glds16(ksrc+(long)(t)*KVBLK*KP,(unsigned)__builtin_amdgcn_readfirstlane(kdst+(slot)))
  #define DMA_V(t,slot) glds16(vsrc+(long)(t)*KVBLK*VP,(unsigned)__builtin_amdgcn_readfirstlane(vdst+(slot)))
  const int vb0=(int)(lds0+LDS_V)+((lane>>4)&1)*32+(lane&3)*8+(4*hi+((lane&15)>>2))*64;
  const char*Kbase=shm+LDS_K; bf16x8 kf[8];
  const lds_cptr shm3=(lds_cptr)shm; const lds_cptr kp0=shm3+LDS_K+hi*1024+r32*16; const lds_cptr vp0=shm3+LDS_V+((lane>>4)&1)*32+(lane&3)*8+(4*hi+((lane&15)>>2))*64;
  const int NT=(q0+QB)/KVBLK;
  DMA_K(0,0);DMA_V(0,0);DMA_K(1,SLOTB);
  bf16x8 qr[4];
  #pragma unroll
  for(int d0=0;d0<4;++d0)qr[d0]=*reinterpret_cast<const bf16x8*>(&Qw[(long)r32*QP+d0*16+hi*8]);
  float mhat=0.f,l_reg=0.f;f32x16 o[2];o[0]=f32x16{};o[1]=f32x16{};f32x16 negm=f32x16{};asm volatile("":"+v"(negm));
  const int qrel=wid*QBLK+r32;
  #define CMASK(P0,P1,t) do{int jb_=(t)-(NT-4); if(jb_>=0)cmask(P0,P1,jb_,qrel,hi);}while(0)
  bool resc=false;
  #define START(P0,P1) do{ const float rm=rowmax(P0,P1); resc=false; \
    { const float dl=rm; mhat=fadd_s(mhat,dl); \
      _Pragma("unroll") for(int r=0;r<16;++r){P0[r]=fsub_s(P0[r],dl);P1[r]=fsub_s(P1[r],dl);} \
      _Pragma("unroll") for(int r=0;r<16;++r)negm[r]=-mhat; asm volatile("":"+v"(negm)); } \
    _Pragma("unroll") for(int r=0;r<16;++r)P0[r]=__builtin_amdgcn_exp2f(P0[r]); }while(0)
  #define RESC() do{ if(resc){ asm volatile("s_waitcnt lgkmcnt(0)":::"memory"); \
      _Pragma("unroll") for(int d_=0;d_<2;++d_) _Pragma("unroll") for(int r=0;r<16;++r)o[d_][r]*=wsf[crow(r,hi)]; } }while(0)
  f32x16 pA0,pA1,pB0,pB1;
  int sl_prev=0,sl_cur=0,sl_next=SLOTB;
  #define ROT() do{sl_prev=sl_cur;sl_cur=sl_next;sl_next=(sl_next==(NSLOT-1)*SLOTB)?0:sl_next+SLOTB;}while(0)
  DMA_K(2,2*SLOTB);
  WAIT_BAR(3);
  qkt(pA0,pA1,Kbase,qr,negm,r32,hi);asm volatile("s_nop 15\n\ts_nop 7":"+v"(pA0),"+v"(pA1));CMASK(pA0,pA1,0);
  START(pA0,pA1);
  _Pragma("unroll") for(int r=0;r<16;++r)pA1[r]=__builtin_amdgcn_exp2f(pA1[r]);
  WAIT_BAR(0);
  DMA_K(3,0);DMA_V(1,SLOTB);
  ROT();
  kload8(kf,kp0+sl_cur);
  WAIT_BAR(2);
  s16x4 vlo[8],vhi[8]; u32x4 pw0,pw1,pw2,pw3;
  #define PKW(P,B) cvtpk_s(P[B],P[B+1])
  #define PAF(k) __builtin_bit_cast(bf16x8,pw##k)
  #define VFR(i) (bf16x8){vlo[i][0],vlo[i][1],vlo[i][2],vlo[i][3],vhi[i][0],vhi[i][1],vhi[i][2],vhi[i][3]}
  #define PIN(x) asm volatile("":"+v"(x))
  #define MX3(a,b,c) __builtin_fmaxf(__builtin_fmaxf((a),(b)),(c))
  #define GAPA(MF,A0,A1,A2,A3,W0,W1,PW) do{ MF; sacc+=A0; sacc+=A1; sacc+=A2; sacc+=A3; PIN(sacc); W0; W1; PIN(PW); SBAR(); }while(0)
  #define EX(v) __builtin_amdgcn_exp2f(v)
  #define GAPB(MF,X,B) do{ MF; X[B]=EX(X[B]); X[B+1]=EX(X[B+1]); X[B+2]=EX(X[B+2]); X[B+3]=EX(X[B+3]); PIN(X); SBAR(); }while(0)
  #define VRD(i) do{ vlo[i]=vtr(vp_+(((i)>>2)*4096+((i)&3)*1024)); vhi[i]=vtr(vp_+(((i)>>2)*4096+((i)&3)*1024+512)); }while(0)
  #define KRD(G,j) do{ if(G){ kload2(kf,kp0+sl_next,j); SBAR(); } }while(0)
  #define STEP(C0,C1,P0,P1,t,GK,GV,GL) do{ SBAR(); \
    const lds_cptr vp_=vp0+sl_prev; \
    VRD(0); SBAR(); float sacc=(P0[0]+P0[1]); \
    GAPA(C0=__builtin_amdgcn_mfma_f32_32x32x16_bf16(kf[0],qr[0],negm,0,0,0), P0[2],P0[3],P0[4],P0[5],     pw0[0]=PKW(P0,0), pw0[1]=PKW(P0,2), pw0); \
    VRD(4); SBAR(); GAPA(C1=__builtin_amdgcn_mfma_f32_32x32x16_bf16(kf[1],qr[0],negm,0,0,0), P0[6],P0[7],P0[8],P0[9],     pw0[2]=PKW(P0,4), pw0[3]=PKW(P0,6), pw0); \
    VRD(1); SBAR(); GAPA(C0=__builtin_amdgcn_mfma_f32_32x32x16_bf16(kf[2],qr[1],C0,0,0,0),   P0[10],P0[11],P0[12],P0[13], pw1[0]=PKW(P0,8), pw1[1]=PKW(P0,10), pw1); \
    VRD(5); SBAR(); GAPA(C1=__builtin_amdgcn_mfma_f32_32x32x16_bf16(kf[3],qr[1],C1,0,0,0),   P0[14],P0[15],P1[0],P1[1],   pw1[2]=PKW(P0,12),pw1[3]=PKW(P0,14), pw1); \
    VRD(2); SBAR(); GAPA(C0=__builtin_amdgcn_mfma_f32_32x32x16_bf16(kf[4],qr[2],C0,0,0,0),   P1[2],P1[3],P1[4],P1[5],     pw2[0]=PKW(P1,0), pw2[1]=PKW(P1,2), pw2); \
    VRD(6); SBAR(); GAPA(C1=__builtin_amdgcn_mfma_f32_32x32x16_bf16(kf[5],qr[2],C1,0,0,0),   P1[6],P1[7],P1[8],P1[9],     pw2[2]=PKW(P1,4), pw2[3]=PKW(P1,6), pw2); \
    VRD(3); SBAR(); GAPA(C0=__builtin_amdgcn_mfma_f32_32x32x16_bf16(kf[6],qr[3],C0,0,0,0),   P1[10],P1[11],P1[12],P1[13], pw3[0]=PKW(P1,8), pw3[1]=PKW(P1,10), pw3); \
    VRD(7); SBAR(); GAPA(C1=__builtin_amdgcn_mfma_f32_32x32x16_bf16(kf[7],qr[3],C1,0,0,0),   P1[14],P1[15],0.f,0.f,       pw3[2]=PKW(P1,12),pw3[3]=PKW(P1,14), pw3); \
    l_reg+=sacc; \
    if(GK){DMA_K((t)+3,sl_cur);} if(GV){DMA_V((t)+1,sl_next);} \
    CMASK(C0,C1,t); \
    { float a=MX3(C0[0],C0[1],C1[0]),b=MX3(C0[2],C0[3],C1[1]); a=MX3(a,C1[2],C1[3]); \
      _Pragma("unroll") for(int r=4;r<16;r+=4){a=MX3(a,C0[r],C0[r+1]);b=MX3(b,C0[r+2],C0[r+3]);a=MX3(a,C1[r],C1[r+1]);b=MX3(b,C1[r+2],C1[r+3]);} \
      float rm=__builtin_fmaxf(a,b); { auto rr=__builtin_amdgcn_permlane32_swap(__float_as_uint(rm),__float_as_uint(rm),false,false); rm=__builtin_fmaxf(__uint_as_float(rr[0]),__uint_as_float(rr[1])); } \
      resc=false; \
      if(__builtin_expect(__any(rm>(float)THRL),0)){ const float dl=__builtin_fmaxf(rm,0.f); mhat+=dl; \
        _Pragma("unroll") for(int r=0;r<16;++r){C0[r]-=dl;C1[r]-=dl;} \
        _Pragma("unroll") for(int r=0;r<16;++r)negm[r]=-mhat; asm volatile("":"+v"(negm)); \
        const float f=__builtin_amdgcn_exp2f(-dl); l_reg*=f; if(hi==0)wsf[r32]=f; resc=true; } } \
    SBAR(); \
    GAPB(o[0]=__builtin_amdgcn_mfma_f32_32x32x16_bf16(PAF(0),VFR(0),o[0],0,0,0), C0,0); \
    GAPB(o[1]=__builtin_amdgcn_mfma_f32_32x32x16_bf16(PAF(0),VFR(4),o[1],0,0,0), C0,4); \
    KRD(GL,0); GAPB(o[0]=__builtin_amdgcn_mfma_f32_32x32x16_bf16(PAF(1),VFR(1),o[0],0,0,0), C0,8); \
    KRD(GL,1); GAPB(o[1]=__builtin_amdgcn_mfma_f32_32x32x16_bf16(PAF(1),VFR(5),o[1],0,0,0), C0,12); \
    KRD(GL,2); GAPB(o[0]=__builtin_amdgcn_mfma_f32_32x32x16_bf16(PAF(2),VFR(2),o[0],0,0,0), C1,0); \
    KRD(GL,3); GAPB(o[1]=__builtin_amdgcn_mfma_f32_32x32x16_bf16(PAF(2),VFR(6),o[1],0,0,0), C1,4); \
    GAPB(o[0]=__builtin_amdgcn_mfma_f32_32x32x16_bf16(PAF(3),VFR(3),o[0],0,0,0), C1,8); \
    GAPB(o[1]=__builtin_amdgcn_mfma_f32_32x32x16_bf16(PAF(3),VFR(7),o[1],0,0,0), C1,12); \
    }while(0)
  int t=1;
  #undef CMASK
  #define CMASK(P0,P1,t) do{}while(0)
  for(;t+5<NT;t+=2){
    STEP(pB0,pB1,pA0,pA1,t,true,true,true);     WAIT_BAR(2); RESC(); ROT();
    STEP(pA0,pA1,pB0,pB1,t+1,true,true,true);   WAIT_BAR(2); RESC(); ROT();
  }
  #undef CMASK
  #define CMASK(P0,P1,t) do{int jb_=(t)-(NT-4); if(jb_>=0)cmask(P0,P1,jb_,qrel,hi);}while(0)
  #define ENDW(tt) do{ if((tt)+3<NT){WAIT_BAR(2);} else if((tt)+2<NT){WAIT_BAR(1);} else {WAIT_BAR(0);} }while(0)
  for(;t+1<NT;t+=2){
    STEP(pB0,pB1,pA0,pA1,t,(t+3<NT),(t+1<NT),(t+1<NT));       ENDW(t);   RESC(); ROT();
    STEP(pA0,pA1,pB0,pB1,t+1,(t+4<NT),(t+2<NT),(t+2<NT));     ENDW(t+1); RESC(); ROT();
  }
  STEP(pB0,pB1,pA0,pA1,NT-1,false,false,false); RESC();
  { float sacc=pB0[0]+pB0[1]; _Pragma("unroll") for(int r=2;r<16;++r)sacc+=pB0[r]; _Pragma("unroll") for(int r=0;r<16;++r)sacc+=pB1[r]; l_reg+=sacc;
    pw0=(u32x4){PKW(pB0,0),PKW(pB0,2),PKW(pB0,4),PKW(pB0,6)};pw1=(u32x4){PKW(pB0,8),PKW(pB0,10),PKW(pB0,12),PKW(pB0,14)};pw2=(u32x4){PKW(pB1,0),PKW(pB1,2),PKW(pB1,4),PKW(pB1,6)};pw3=(u32x4){PKW(pB1,8),PKW(pB1,10),PKW(pB1,12),PKW(pB1,14)};
    SBAR(); pv(o,vb0+sl_cur,PAF(0),PAF(1),PAF(2),PAF(3)); }
  #undef PKW
  #undef PAF
  #undef VFR
  #undef PIN
  #undef MX3
  #undef GAPA
  #undef GAPB
  #undef EX
  #undef VRD
  #undef KRD
  #undef STEP
  #undef ENDW
  {auto rr=__builtin_amdgcn_permlane32_swap(__float_as_uint(l_reg),__float_as_uint(l_reg),false,false);l_reg=__uint_as_float(rr[0])+__uint_as_float(rr[1]);}
  if(hi==0)wsf[32+r32]=l_reg;asm volatile("s_waitcnt lgkmcnt(0)":::"memory");
  float rli[16];
  #pragma unroll
  for(int r=0;r<16;++r)rli[r]=__builtin_amdgcn_rcpf(wsf[32+crow(r,hi)]);
  bf16*Ow=O+(long)(q0+wid*QBLK)*OP;
  { bf16*stg=(bf16*)(shm+LDS_OST)+wid*2048;
    #pragma unroll
    for(int r=0;r<16;++r){const int orow=crow(r,hi);
      #pragma unroll
      for(int d0=0;d0<2;++d0)stg[orow*64+d0*32+r32]=__float2bfloat16(o[d0][r]*rli[r]);}
    asm volatile("s_waitcnt lgkmcnt(0)":::"memory");
    #pragma unroll
    for(int i=0;i<4;++i){const int row=i*8+(lane>>3),ch=lane&7; const u32x4 v=*(const u32x4*)(stg+row*64+ch*8); ATTN_STORE16(Ow+(long)row*OP+ch*8,v);} }
  asm volatile("s_waitcnt lgkmcnt(0)\n\ts_barrier":::"memory");
  #undef DMA_K
  #undef DMA_V
  #undef CMASK
  #undef START
  #undef RESC
  #undef ROT
}
constexpr int ATTN_LDS_BYTES=LDS_BYTES;
#undef SBAR
#undef WAIT_BAR
}
constexpr int NWAVES = 8;
using cfg::T; using cfg::SEQ; using cfg::D; using cfg::NIN; using cfg::NE; using cfg::EPS; using cfg::MAXROWS;

constexpr size_t MiB = 1u << 20;
constexpr size_t WS_CTL = 0, CTL_ZERO_BYTES = 1 * MiB;
constexpr size_t WS_RCOS = 1 * MiB, WS_RSIN = 2 * MiB;
constexpr size_t WS_TKE = 3 * MiB, WS_TKP = WS_TKE + 256 * 1024, WS_TKG = WS_TKP + 256 * 1024, WS_TSLOT = WS_TKG + 256 * 1024;
constexpr size_t WS_RGATE = 4 * MiB;
constexpr size_t WS_BLKBASE = 4 * MiB + 512 * 1024;
constexpr size_t WS_SSQ = 5 * MiB;
constexpr size_t WS_WIN = 8 * MiB;
constexpr size_t WS_WBR = 23 * MiB;
constexpr size_t WS_WOUT = 26 * MiB;
constexpr size_t WS_WGU = 28 * MiB;
constexpr size_t WS_WDN = 156 * MiB;
constexpr size_t WS_HN = 220 * MiB;
constexpr size_t WS_KVM = 254 * MiB;
constexpr size_t WS_Q = 256 * MiB, WS_K = 272 * MiB, WS_V = 288 * MiB, WS_U = 304 * MiB, WS_CB = 320 * MiB, WS_MQ = 336 * MiB;
constexpr size_t WS_GATES = 352 * MiB;
constexpr size_t WS_OMAPS = 448 * MiB;
constexpr size_t WS_YALL = 480 * MiB;
constexpr size_t WS_MERGED = 528 * MiB;
constexpr size_t WS_H2 = 560 * MiB;
constexpr size_t WS_XS = 256 * MiB;
constexpr size_t WS_ACT = 400 * MiB;
constexpr size_t WS_END = 592 * MiB;
static_assert(WS_XS + (size_t)MAXROWS * 2048 <= WS_ACT && WS_ACT + (size_t)MAXROWS * 2048 <= WS_H2, "MoE overlays");
constexpr int CW_GCNT = 64;
constexpr int CW_BAR = 4096;
constexpr int RING_OFF = 0, RING_BYTES = 131072;
constexpr int LDSCTL_OFF = RING_BYTES, MISC_OFF = LDSCTL_OFF + 320;
constexpr int L_PREFT = LDSCTL_OFF + 1024, L_PSTART = L_PREFT + 256, L_LCNT = L_PSTART + 256, L_LBASE = L_LCNT + 128;
constexpr int L_WSF = LDSCTL_OFF + 4096;
constexpr int LDS_BYTES = 147456;

struct NoHooks { __device__ __forceinline__ void a_ready(const pg8::Unit&) const {} __device__ __forceinline__ void done(const pg8::Unit&) const {} };
struct ProjOrder : NoHooks {
    const char* A; const char* Bt; int G, c;
    __device__ __forceinline__ bool next(int i, pg8::Unit& u) const {
        const int L = i * G + c; int pm, pn;
        if (L < 64 * 26) pg8::static_map(L, 64, 26, pm, pn); else if (L < 64 * 26 + 8) { pm = 64 + ((L - 64 * 26) >> 2); pn = 26 + ((L - 64 * 26) & 3); } else return false;
        u.pm = pm; u.pn = pn; u.aux = 0; u.a = A + (size_t)pm * (256 * 2048); u.b = Bt + (size_t)pn * (256 * 2048); return true; }
};
struct MergeOrder : NoHooks {
    const char* Y; const char* Bt; int G, c;
    __device__ __forceinline__ bool next(int i, pg8::Unit& u) const {
        const int j = i / 3, br = i - 3 * j; const int L = j * G + c; if (L >= 256) return false; int pm, pn; pg8::static_map(L, 64, 4, pm, pn);
        u.pm = pm; u.pn = pn; u.aux = br; u.a = Y + (size_t)pm * (256 * 3072) + br * 1024; u.b = Bt + (size_t)(br * 1024 + pn * 256) * 1024; return true; }
};
struct OutOrder : NoHooks {
    const char* A; const char* Bt; int G, c;
    __device__ __forceinline__ bool next(int i, pg8::Unit& u) const {
        const int L = i * G + c; if (L >= 256) return false; int pm, pn; pg8::static_map(L, 64, 4, pm, pn);
        u.pm = pm; u.pn = pn; u.aux = 0; u.a = A + (size_t)pm * (256 * 2048); u.b = Bt + (size_t)pn * (256 * 2048); return true; }
};
struct MoeOrder : NoHooks {
    const char* A; const char* Bt; const volatile __attribute__((address_space(3))) int* prefT; int ncol, G, c;
    __device__ __forceinline__ bool next(int i, pg8::Unit& u) const {
        const int L = i * G + c; const int rt = L / ncol, pnl = L - rt * ncol; if (rt >= prefT[32]) return false;
        int e = 0; while (prefT[e + 1] <= rt) ++e;
        u.pm = rt; u.pn = e * ncol + pnl; u.aux = e; u.a = A + (size_t)rt * (256 * 2048); u.b = Bt + (size_t)(e * ncol + pnl) * (256 * 2048); return true; }
};

#define GAS __attribute__((address_space(1)))
#define LAS __attribute__((address_space(3)))
typedef unsigned short bf16;
typedef unsigned v4u __attribute__((ext_vector_type(4)));
typedef unsigned v2u __attribute__((ext_vector_type(2)));
typedef float f32x4 __attribute__((ext_vector_type(4)));
typedef float f32x16 __attribute__((ext_vector_type(16)));
typedef short bf16x8 __attribute__((ext_vector_type(8)));
typedef GAS unsigned gu32;
#define RLX_AGENT __ATOMIC_RELAXED, __HIP_MEMORY_SCOPE_AGENT
#define LDS_WAIT() asm volatile("s_waitcnt lgkmcnt(0)" ::: "memory")
#define VM_WAIT() asm volatile("s_waitcnt vmcnt(0)" ::: "memory")
__device__ __forceinline__ unsigned f2bf(float f) { unsigned u = __builtin_bit_cast(unsigned, f); return (u + 0x7fffu + ((u >> 16) & 1u)) >> 16; }
__device__ __forceinline__ unsigned pk2(float lo, float hi) { return f2bf(lo) | (f2bf(hi) << 16); }
__device__ __forceinline__ float bflo(unsigned w) { return __uint_as_float(w << 16); }
__device__ __forceinline__ float bfhi(unsigned w) { return __uint_as_float(w & 0xffff0000u); }
__device__ __forceinline__ float wave_sum(float v) {
#pragma unroll
    for (int o = 1; o < 64; o <<= 1) v += __shfl_xor(v, o);
    return v;
}

#define XB_TMO      128
#define XB_XCNT(j)  (256  + 64 * (j))
#define XB_XSUB(j)  (1280 + 64 * (j))
#define XB_XGEN(j)  (2304 + 64 * (j))
#define XB_TOP      3328
#define XB_TOPGEN   3392
#define XCD_BAR_WORDS 3456
#define XB_SPIN_CAP (1u << 18)

__device__ __forceinline__ unsigned xb_ld(unsigned* p)              { return __hip_atomic_load(p, __ATOMIC_RELAXED, __HIP_MEMORY_SCOPE_AGENT); }
__device__ __forceinline__ unsigned xb_add(unsigned* p, unsigned v) { return __hip_atomic_fetch_add(p, v, __ATOMIC_RELAXED, __HIP_MEMORY_SCOPE_AGENT); }
__device__ __forceinline__ unsigned xb_xcc_id() { return (unsigned)__builtin_amdgcn_s_getreg((3 << 11) | 20) & 0xFu; }
#define XB_SPIN(cond, bar) do { unsigned _sp = 0; while (cond) { __builtin_amdgcn_s_sleep(1); \
    if ((++_sp & 255u) == 0u) { if (xb_ld(&(bar)[XB_TMO])) break; if (_sp > XB_SPIN_CAP) { atomicAdd(&(bar)[XB_TMO], 1u); break; } } } } while (0)

struct XcdBarrier {
    unsigned* bar; unsigned x;
    volatile LAS unsigned* st;
};

__device__ __forceinline__ XcdBarrier xcd_barrier_post(unsigned* bar, volatile LAS unsigned* st) {
    XcdBarrier b; b.bar = bar; b.x = xb_xcc_id(); b.st = st;
    if (threadIdx.x == 0) (void)xb_add(&bar[XB_XCNT(b.x)], 1u);
    return b;
}
__device__ __forceinline__ void xcd_barrier_complete(unsigned* bar, unsigned x, unsigned& nloc, unsigned& nx) {
    const unsigned G = gridDim.x * gridDim.y * gridDim.z;
    unsigned sum, cnt, mine, sp = 0u;
    for (;;) {
        sum = 0u; cnt = 0u; mine = 0u;
#pragma unroll
        for (unsigned j = 0; j < 16; ++j) { const unsigned c = xb_ld(&bar[XB_XCNT(j)]); sum += c; cnt += (c > 0u) ? 1u : 0u; mine = (j == x) ? c : mine; }
        if (sum == G) break;
        __builtin_amdgcn_s_sleep(1);
        if ((++sp & 255u) == 0u) { if (xb_ld(&bar[XB_TMO])) break; if (sp > XB_SPIN_CAP) { atomicAdd(&bar[XB_TMO], 1u); break; } }
    }
    nloc = mine > 0u ? mine : 1u; nx = cnt > 0u ? cnt : 1u;
}

__device__ __forceinline__ void xcd_barrier(const XcdBarrier& b) {
    asm volatile("s_waitcnt vmcnt(0)" ::: "memory");
    __syncthreads();
    if (threadIdx.x == 0) {
        unsigned* bar = b.bar;
        __builtin_amdgcn_s_waitcnt(0);
        unsigned nloc = b.st[0], nx = b.st[1];
        if (nloc == 0u) { xcd_barrier_complete(bar, b.x, nloc, nx); b.st[0] = nloc; b.st[1] = nx; }
        const unsigned old = xb_add(&bar[XB_XSUB(b.x)], 1u);
        const unsigned gen = old / nloc;
        if (old + 1u == (gen + 1u) * nloc) {
            __builtin_amdgcn_fence(__ATOMIC_RELEASE, "agent");
            asm volatile("s_waitcnt vmcnt(0)" ::: "memory");
            const unsigned og = xb_add(&bar[XB_TOP], 1u);
            const unsigned tg = og / nx;
            if (og + 1u == (tg + 1u) * nx) xb_add(&bar[XB_TOPGEN], 1u);
            else XB_SPIN(xb_ld(&bar[XB_TOPGEN]) == tg, bar);
            __builtin_amdgcn_fence(__ATOMIC_ACQUIRE, "agent");
            xb_add(&bar[XB_XGEN(b.x)], 1u);
            asm volatile("s_waitcnt vmcnt(0)" ::: "memory");
        } else {
            XB_SPIN(xb_ld(&bar[XB_XGEN(b.x)]) == gen, bar);
            __builtin_amdgcn_fence(__ATOMIC_ACQUIRE, "agent");
            asm volatile("s_waitcnt vmcnt(0)" ::: "memory");
        }
    }
    __syncthreads();
}

__device__ __forceinline__ int ip32(int r) { return 16 * ((r >> 2) & 1) + 4 * (r >> 3) + (r & 3); }
__device__ __forceinline__ void p0_transpose_item(const float* W, int ldn, int K, bf16* WT, int k0, int n0, int dst_row_base, bool perm, LAS float* scr, int lane) {
#pragma unroll 8
    for (int i = 0; i < 32; ++i) { const int kk = 2 * i + (lane >> 5); scr[kk * 33 + (lane & 31)] = W[(size_t)(k0 + kk) * ldn + n0 + (lane & 31)]; }
    LDS_WAIT(); asm volatile("" ::: "memory");
    const int c = lane & 7;
#pragma unroll
    for (int j = 0; j < 4; ++j) { const int n = (lane >> 3) + 8 * j; const LAS float* s = scr + (8 * c) * 33 + n;
        v4u o; o.x = pk2(s[0 * 33], s[1 * 33]); o.y = pk2(s[2 * 33], s[3 * 33]); o.z = pk2(s[4 * 33], s[5 * 33]); o.w = pk2(s[6 * 33], s[7 * 33]);
        *(GAS v4u*)(WT + (size_t)(dst_row_base + (perm ? ip32(n) : n)) * K + k0 + 8 * c) = o; }
    LDS_WAIT(); asm volatile("" ::: "memory");
}
__device__ __forceinline__ int win_group_base(int L0) {
    if (L0 < 1024) { const int l = L0 & 255; return (L0 & ~255) + 128 * ((l >> 5) & 1) + 32 * (l >> 6); }
    if (L0 < 1536) return L0;
    if (L0 < 2048) return L0 - 1536 + 2560;
    if (L0 < 3072) { const int which = L0 >= 2560, ch = (L0 - 2048) & 511; return 256 * (6 + (ch >> 7)) + 128 * which + 32 * ((ch >> 5) & 3); }
    return L0;
}
__device__ __forceinline__ void rms_row_to_bf16(const float* xrow, const float* g, bf16* orow, int lane) {
    const GAS f32x4* xr = (const GAS f32x4*)xrow + lane; const GAS f32x4* gr = (const GAS f32x4*)g + lane;
    f32x4 v[4]; float s = 0.f;
#pragma unroll
    for (int j = 0; j < 4; ++j) { v[j] = xr[64 * j]; s += (v[j].x * v[j].x + v[j].y * v[j].y) + (v[j].z * v[j].z + v[j].w * v[j].w); }
    const float r = 1.0f / sqrtf(wave_sum(s) * (1.0f / 1024.0f) + EPS);
    GAS unsigned long long* o8 = (GAS unsigned long long*)orow + lane;
#pragma unroll
    for (int j = 0; j < 4; ++j) { const f32x4 gg = gr[64 * j]; o8[64 * j] = (unsigned long long)pk2(v[j].x * r * gg.x, v[j].y * r * gg.y) | ((unsigned long long)pk2(v[j].z * r * gg.z, v[j].w * r * gg.w) << 32); }
}

struct Args { const float* in[25]; float* out; unsigned char* ws; int ph_lo, ph_hi; };

__device__ __forceinline__ void p0_prologue(const Args& a, LAS unsigned char* lds, int vcu, int G, int wave, int lane, int tid) {
    LAS float* scr = (LAS float*)(lds + RING_OFF + wave * 16384);
    const int gw = vcu * NWAVES + wave, NGW = G * NWAVES;
    unsigned char* ws = a.ws;
    constexpr int I_IN = 16 * 208, I_KV = 16 * 32, I_BR = 3 * 8 * 32, I_OUT = 16 * 32, I_GU = 32 * 16 * 64, I_DN = 32 * 16 * 32;
    constexpr int NITEMS = I_IN + I_KV + I_BR + I_OUT + I_GU + I_DN;
    for (int it = gw; it < NITEMS; it += NGW) {
        int r = it;
        if (r < I_IN) { const int kb = r / 208, nb = r % 208; p0_transpose_item(a.in[3], NIN, 1024, (bf16*)(ws + WS_WIN), 64 * kb, 32 * nb, win_group_base(32 * nb), true, scr, lane); continue; } r -= I_IN;
        if (r < I_KV) { const int kb = r / 32, nb = r % 32; p0_transpose_item(a.in[13], 1024, 1024, (bf16*)(ws + WS_WIN), 64 * kb, 32 * nb, 6656 + 32 * nb, true, scr, lane); continue; } r -= I_KV;
        if (r < I_BR) { const int br = r / 256, q = r % 256, kb = q / 32, nb = q % 32; p0_transpose_item(a.in[16] + (size_t)br * 512 * 1024, 1024, 512, (bf16*)(ws + WS_WBR), 64 * kb, 32 * nb, br * 1024 + 32 * nb, true, scr, lane); continue; } r -= I_BR;
        if (r < I_OUT) { const int kb = r / 32, nb = r % 32; p0_transpose_item(a.in[17], 1024, 1024, (bf16*)(ws + WS_WOUT), 64 * kb, 32 * nb, 32 * nb, false, scr, lane); continue; } r -= I_OUT;
        if (r < I_GU) { const int e = r / 1024, q = r % 1024, kb = q / 64, nb = q % 64; const int L0 = 32 * nb, ch = L0 & 1023;
            p0_transpose_item(a.in[21] + (size_t)e * 1024 * 2048, 2048, 1024, (bf16*)(ws + WS_WGU), 64 * kb, L0, e * 2048 + 256 * (ch >> 7) + 128 * (L0 >> 10) + 32 * ((ch >> 5) & 3), true, scr, lane); continue; } r -= I_GU;
        { const int e = r / 512, q = r % 512, kb = q / 32, nb = q % 32; p0_transpose_item(a.in[23] + (size_t)e * 1024 * 1024, 1024, 1024, (bf16*)(ws + WS_WDN), 64 * kb, 32 * nb, e * 1024 + 32 * nb, true, scr, lane); }
    }
    bf16* HN = (bf16*)(ws + WS_HN);
    for (int m = gw; m < T + 512; m += NGW) {
        if (m < T) rms_row_to_bf16(a.in[0] + (size_t)m * D, a.in[2], HN + (size_t)m * D, lane);
        else rms_row_to_bf16(a.in[1] + (size_t)(m - T) * D, a.in[12], HN + (size_t)m * D, lane);
    }
    float* rc = (float*)(ws + WS_RCOS); float* rs = (float*)(ws + WS_RSIN);
    for (int i = gw * 64 + lane; i < SEQ * 32; i += NGW * 64) { const int pos = i >> 5, f = i & 31;
        const float inv_freq = 1.0f / powf(10000.0f, (float)(2 * f) / 64.0f); const float ang = (float)pos * inv_freq; rc[i] = cosf(ang); rs[i] = sinf(ang); }
}

__device__ __forceinline__ void phase_finish(const Args& a, int vcu, int G, int wave, int lane) {
    unsigned char* ws = a.ws; const int gw = vcu * NWAVES + wave, NGW = G * NWAVES;
    const bf16* OM = (const bf16*)(ws + WS_OMAPS); const bf16* U = (const bf16*)(ws + WS_U); const bf16* CB = (const bf16*)(ws + WS_CB); bf16* Y = (bf16*)(ws + WS_YALL);
    const float lam = expf(wave_sum(a.in[6][lane] * a.in[7][lane])) - expf(wave_sum(a.in[8][lane] * a.in[9][lane])) + 0.2f;
    const int hh = lane >> 4, c8 = (lane & 15) * 8;
    f32x4 gs0 = *(const f32x4*)(a.in[10] + c8), gs1 = *(const f32x4*)(a.in[10] + c8 + 4);
    f32x4 w0a = *(const f32x4*)(a.in[11] + lane * 8), w0b = *(const f32x4*)(a.in[11] + lane * 8 + 4);
    f32x4 w1a = *(const f32x4*)(a.in[11] + 512 + lane * 8), w1b = *(const f32x4*)(a.in[11] + 512 + lane * 8 + 4);
    f32x4 w2a = *(const f32x4*)(a.in[11] + 1024 + lane * 8), w2b = *(const f32x4*)(a.in[11] + 1024 + lane * 8 + 4);
    for (int t = gw; t < T; t += NGW) {
        {
            const v4u o0 = *(const v4u*)(OM + (size_t)t * 1024 + hh * 256 + c8), o1 = *(const v4u*)(OM + (size_t)t * 1024 + hh * 256 + 128 + c8);
            const f32x4 a0 = pg8::unpk_lo(o0) - lam * pg8::unpk_lo(o1), a1 = pg8::unpk_hi(o0) - lam * pg8::unpk_hi(o1);
            float ss = ((a0[0] * a0[0] + a0[1] * a0[1]) + (a0[2] * a0[2] + a0[3] * a0[3])) + ((a1[0] * a1[0] + a1[1] * a1[1]) + (a1[2] * a1[2] + a1[3] * a1[3]));
            ss += __shfl_xor(ss, 1); ss += __shfl_xor(ss, 2); ss += __shfl_xor(ss, 4); ss += __shfl_xor(ss, 8);
            const float r = 0.8f / sqrtf(ss * (1.0f / 128.0f) + EPS);
            *(v4u*)(Y + (size_t)t * 1536 + hh * 128 + c8) = pg8::pack8(a0 * gs0 * r, a1 * gs1 * r);
        }
        {
            const int s = t & (SEQ - 1); const v4u z = {0u, 0u, 0u, 0u};
            const v4u u0 = *(const v4u*)(U + (size_t)t * 512 + lane * 8);
            const v4u u1 = s >= 1 ? *(const v4u*)(U + (size_t)(t - 1) * 512 + lane * 8) : z;
            const v4u u2 = s >= 2 ? *(const v4u*)(U + (size_t)(t - 2) * 512 + lane * 8) : z;
            const v4u cb = *(const v4u*)(CB + (size_t)t * 512 + lane * 8);
            const f32x4 ya = pg8::unpk_lo(cb) * (w0a * pg8::unpk_lo(u2) + w1a * pg8::unpk_lo(u1) + w2a * pg8::unpk_lo(u0));
            const f32x4 yb = pg8::unpk_hi(cb) * (w0b * pg8::unpk_hi(u2) + w1b * pg8::unpk_hi(u1) + w2b * pg8::unpk_hi(u0));
            *(v4u*)(Y + (size_t)t * 1536 + 512 + lane * 8) = pg8::pack8(ya, yb);
        }
    }
}

__device__ __forceinline__ void phase_router(const Args& a, LAS unsigned char* lds, int vcu, int G, int wave, int lane, int tid) {
    unsigned char* ws = a.ws; const int gw = vcu * NWAVES + wave, NGW = G * NWAVES;
    LAS float* Wt = (LAS float*)(lds + RING_OFF);
    volatile LAS int* lcnt = (volatile LAS int*)(lds + L_LCNT);
    const float* wr = a.in[19];
    for (int idx = tid; idx < 8192; idx += NWAVES * 64) { const int d = idx >> 3, q = idx & 7; const f32x4 w = *(const f32x4*)(wr + d * 32 + 4 * q);
        Wt[(4 * q + 0) * 1024 + d] = w.x; Wt[(4 * q + 1) * 1024 + d] = w.y; Wt[(4 * q + 2) * 1024 + d] = w.z; Wt[(4 * q + 3) * 1024 + d] = w.w; }
    if (tid < 32) lcnt[tid] = 0;
    __syncthreads();
    const float* x1 = a.out; const float* g = a.in[18]; bf16* H2 = (bf16*)(ws + WS_H2);
    int* tk_e = (int*)(ws + WS_TKE); int* tk_p = (int*)(ws + WS_TKP); float* tk_g = (float*)(ws + WS_TKG);
    const float bias = a.in[20][lane >> 1];
    for (int t = gw; t < T; t += NGW) {
        const GAS f32x4* xr = (const GAS f32x4*)(x1 + (size_t)t * D) + lane; const GAS f32x4* gr = (const GAS f32x4*)g + lane;
        f32x4 v[4]; float s = 0.f;
#pragma unroll
        for (int j = 0; j < 4; ++j) { v[j] = xr[64 * j]; s += (v[j].x * v[j].x + v[j].y * v[j].y) + (v[j].z * v[j].z + v[j].w * v[j].w); }
        const float r = 1.0f / sqrtf(wave_sum(s) * (1.0f / 1024.0f) + EPS);
        GAS unsigned long long* o8 = (GAS unsigned long long*)(H2 + (size_t)t * D) + lane;
#pragma unroll
        for (int j = 0; j < 4; ++j) { const f32x4 gg = gr[64 * j]; v[j].x *= r * gg.x; v[j].y *= r * gg.y; v[j].z *= r * gg.z; v[j].w *= r * gg.w;
            o8[64 * j] = (unsigned long long)pk2(v[j].x, v[j].y) | ((unsigned long long)pk2(v[j].z, v[j].w) << 32); }
        float p[32];
#pragma unroll
        for (int e = 0; e < 32; ++e) { float acc = 0.f;
#pragma unroll
            for (int j = 0; j < 4; ++j) { const f32x4 w = *(const LAS f32x4*)(Wt + e * 1024 + 4 * (64 * j + lane)); acc += (v[j].x * w.x + v[j].y * w.y) + (v[j].z * w.z + v[j].w * w.w); }
            p[e] = acc; }
#define RRED(HN, MASK) _Pragma("unroll") for (int i = 0; i < HN; ++i) { const bool up = (lane & MASK) != 0; const float keep = up ? p[i + HN] : p[i]; const float send = up ? p[i] : p[i + HN]; p[i] = keep + __shfl_xor(send, MASK); }
        RRED(16, 32) RRED(8, 16) RRED(4, 8) RRED(2, 4) RRED(1, 2)
#undef RRED
        const float logit = p[0] + __shfl_xor(p[0], 1) + bias;
        const int e = lane >> 1;
        int rank = 0; float mx = logit;
#pragma unroll
        for (int j = 0; j < 32; ++j) { const float o = __uint_as_float(__builtin_amdgcn_readlane(__float_as_uint(logit), 2 * j)); rank += (o > logit || (o == logit && j < e)) ? 1 : 0; mx = fmaxf(mx, o); }
        const bool sel = rank < 4 && (lane & 1) == 0;
        const float ex = sel ? expf(logit - mx) : 0.f;
        const float gate = ex / wave_sum(ex);
        if (sel) { const int lp = __hip_atomic_fetch_add((LAS int*)(lds + L_LCNT) + e, 1, __ATOMIC_RELAXED, __HIP_MEMORY_SCOPE_WORKGROUP);
            tk_e[t * 4 + rank] = e; tk_p[t * 4 + rank] = lp; tk_g[t * 4 + rank] = gate; }
    }
    __syncthreads();
    if (tid < 32) ((int*)(ws + WS_BLKBASE))[vcu * 32 + tid] = (int)__hip_atomic_fetch_add((unsigned*)(ws + WS_CTL) + CW_GCNT + tid, (unsigned)lcnt[tid], RLX_AGENT);
    __syncthreads();
}

__device__ __forceinline__ void moe_plan(unsigned char* ws, LAS unsigned char* lds, int tid) {
    volatile LAS int* prefT = (volatile LAS int*)(lds + L_PREFT); volatile LAS int* pstart = (volatile LAS int*)(lds + L_PSTART);
    if (tid < 64) { int nt = 0; if (tid < 32) nt = ((int)__hip_atomic_load((unsigned*)(ws + WS_CTL) + CW_GCNT + tid, RLX_AGENT) + 255) >> 8;
        int inc = nt;
#pragma unroll
        for (int o = 1; o < 32; o <<= 1) { const int y = __shfl_up(inc, o); if ((tid & 63) >= o) inc += y; }
        if (tid < 32) { prefT[tid] = inc - nt; pstart[tid] = (inc - nt) * 256; if (tid == 31) { prefT[32] = inc; pstart[32] = inc * 256; } } }
    __syncthreads();
}

__device__ __forceinline__ void phase_dispatch(const Args& a, LAS unsigned char* lds, int vcu, int G, int wave, int lane, int tid) {
    unsigned char* ws = a.ws; const int gw = vcu * NWAVES + wave, NGW = G * NWAVES;
    volatile LAS int* pstart = (volatile LAS int*)(lds + L_PSTART); volatile LAS int* lbase = (volatile LAS int*)(lds + L_LBASE);
    if (tid < 32) lbase[tid] = ((const int*)(ws + WS_BLKBASE))[vcu * 32 + tid];
    moe_plan(ws, lds, tid);
    const bf16* H2 = (const bf16*)(ws + WS_H2); bf16* XS = (bf16*)(ws + WS_XS);
    const int* tk_e = (const int*)(ws + WS_TKE); const int* tk_p = (const int*)(ws + WS_TKP); const float* tk_g = (const float*)(ws + WS_TKG);
    int* tslot = (int*)(ws + WS_TSLOT); float* rgate = (float*)(ws + WS_RGATE);
    for (int t = gw; t < T; t += NGW) {
        int slot = 0;
        if (lane < 4) { const int e = tk_e[t * 4 + lane]; slot = pstart[e] + lbase[e] + tk_p[t * 4 + lane]; rgate[slot] = tk_g[t * 4 + lane]; tslot[t * 4 + lane] = slot; }
        const v4u r0 = *(const v4u*)(H2 + (size_t)t * D + lane * 8), r1 = *(const v4u*)(H2 + (size_t)t * D + 512 + lane * 8);
#pragma unroll
        for (int k = 0; k < 4; ++k) { const int sk = __builtin_amdgcn_readlane(slot, k); *(v4u*)(XS + (size_t)sk * D + lane * 8) = r0; *(v4u*)(XS + (size_t)sk * D + 512 + lane * 8) = r1; }
    }
}

__device__ __forceinline__ void phase_combine(const Args& a, int vcu, int G, int wave, int lane) {
    unsigned char* ws = a.ws; const int gw = vcu * NWAVES + wave, NGW = G * NWAVES;
    const bf16* YS = (const bf16*)(ws + WS_XS); const int* tslot = (const int*)(ws + WS_TSLOT); float* out = a.out;
    for (int t = gw; t < T; t += NGW) {
        int slot = 0; if (lane < 4) slot = tslot[t * 4 + lane];
#pragma unroll
        for (int j = 0; j < 2; ++j) { float* op = out + (size_t)t * D + j * 512 + lane * 8; f32x4 o0 = *(const f32x4*)op, o1 = *(const f32x4*)(op + 4);
#pragma unroll
            for (int k = 0; k < 4; ++k) { const int sk = __builtin_amdgcn_readlane(slot, k); const v4u y = *(const v4u*)(YS + (size_t)sk * D + j * 512 + lane * 8); o0 += pg8::unpk_lo(y); o1 += pg8::unpk_hi(y); }
            *(f32x4*)op = o0; *(f32x4*)(op + 4) = o1; }
    }
}

__device__ __forceinline__ void memattn_unit(const Args& a, LAS unsigned char* lds, int b, int h, int qb, int wid, int lane, int tid) {
    unsigned char* ws = a.ws;
    const bf16* KVM = (const bf16*)(ws + WS_KVM); const bf16* MQ = (const bf16*)(ws + WS_MQ); const float* ssq = (const float*)(ws + WS_SSQ); bf16* Y = (bf16*)(ws + WS_YALL);
    LAS unsigned char* Ks = lds + RING_OFF;
    LAS unsigned char* Vt = lds + RING_OFF + 65536;
    {
        const int m = tid >> 1, hf = tid & 1;
        const bf16* kr = KVM + (size_t)(b * 256 + m) * 1024 + h * 128 + hf * 64;
        v4u raw[8]; float ss = 0.f;
#pragma unroll
        for (int i = 0; i < 8; ++i) { raw[i] = *(const v4u*)(kr + 8 * i); const f32x4 x0 = pg8::unpk_lo(raw[i]), x1 = pg8::unpk_hi(raw[i]);
            ss += ((x0[0] * x0[0] + x0[1] * x0[1]) + (x0[2] * x0[2] + x0[3] * x0[3])) + ((x1[0] * x1[0] + x1[1] * x1[1]) + (x1[2] * x1[2] + x1[3] * x1[3])); }
        ss += __shfl_xor(ss, 1);
        const float r = 1.0f / sqrtf(ss * (1.0f / 128.0f) + EPS);
#pragma unroll
        for (int i = 0; i < 8; ++i) { const int d0 = hf * 64 + 8 * i; const f32x4 g0 = *(const f32x4*)(a.in[15] + d0) * *(const f32x4*)(a.in[14] + d0), g1 = *(const f32x4*)(a.in[15] + d0 + 4) * *(const f32x4*)(a.in[14] + d0 + 4);
            const int c = hf * 8 + i;
            *(LAS v4u*)(Ks + m * 256 + ((c ^ (m & 15)) << 4)) = pg8::pack8(pg8::unpk_lo(raw[i]) * g0 * r, pg8::unpk_hi(raw[i]) * g1 * r); }
        const bf16* vr = kr + 512;
        const int kk = m & 15, pos = (m & ~15) + 8 * ((kk >> 2) & 1) + 4 * (kk >> 3) + (kk & 3);
#pragma unroll
        for (int i = 0; i < 8; ++i) { const v4u w = *(const v4u*)(vr + 8 * i); const unsigned ww[4] = {w.x, w.y, w.z, w.w};
#pragma unroll
            for (int j = 0; j < 8; ++j) { const int d = hf * 64 + 8 * i + j; const unsigned short val = (unsigned short)((j & 1) ? (ww[j >> 1] >> 16) : (ww[j >> 1] & 0xffffu));
                *(LAS unsigned short*)(Vt + d * 512 + ((((pos >> 3) ^ (d & 15))) << 4) + (pos & 7) * 2) = val; } }
    }
    __syncthreads();
    const int r32 = lane & 31, hi = lane >> 5;
    const size_t qrow = (size_t)b * SEQ + (size_t)qb * 256 + wid * 32 + r32;
    bf16x8 qf[8];
#pragma unroll
    for (int ks = 0; ks < 8; ++ks) qf[ks] = *(const bf16x8*)(MQ + qrow * 512 + h * 128 + 16 * ks + 8 * hi);
    const f32x4 sq = *(const f32x4*)(ssq + qrow * 16 + h * 4);
    const float sc = (1.0f / sqrtf(((sq[0] + sq[1]) + (sq[2] + sq[3])) * (1.0f / 128.0f) + EPS)) * 0.08838834764831845f * 1.4426950408889634f;
    f32x16 o[4]; float l = 0.f;
#pragma unroll
    for (int d0 = 0; d0 < 4; ++d0) o[d0] = f32x16{};
#pragma unroll 1
    for (int kt = 0; kt < 4; ++kt) {
        f32x16 p0 = f32x16{}, p1 = f32x16{};
#pragma unroll
        for (int ks = 0; ks < 8; ++ks) { const int c = 2 * ks + hi; const int k0 = 64 * kt + r32, k1 = k0 + 32;
            const bf16x8 f0 = *(const LAS bf16x8*)(Ks + k0 * 256 + ((c ^ (k0 & 15)) << 4)), f1 = *(const LAS bf16x8*)(Ks + k1 * 256 + ((c ^ (k1 & 15)) << 4));
            p0 = __builtin_amdgcn_mfma_f32_32x32x16_bf16(f0, qf[ks], p0, 0, 0, 0); p1 = __builtin_amdgcn_mfma_f32_32x32x16_bf16(f1, qf[ks], p1, 0, 0, 0); }
#pragma unroll
        for (int r = 0; r < 16; ++r) { p0[r] = __builtin_amdgcn_exp2f(p0[r] * sc); p1[r] = __builtin_amdgcn_exp2f(p1[r] * sc); l += p0[r] + p1[r]; }
        v4u pw[4];
        pw[0] = (v4u){pg8::cvt_pk_bf16(p0[0], p0[1]), pg8::cvt_pk_bf16(p0[2], p0[3]), pg8::cvt_pk_bf16(p0[4], p0[5]), pg8::cvt_pk_bf16(p0[6], p0[7])};
        pw[1] = (v4u){pg8::cvt_pk_bf16(p0[8], p0[9]), pg8::cvt_pk_bf16(p0[10], p0[11]), pg8::cvt_pk_bf16(p0[12], p0[13]), pg8::cvt_pk_bf16(p0[14], p0[15])};
        pw[2] = (v4u){pg8::cvt_pk_bf16(p1[0], p1[1]), pg8::cvt_pk_bf16(p1[2], p1[3]), pg8::cvt_pk_bf16(p1[4], p1[5]), pg8::cvt_pk_bf16(p1[6], p1[7])};
        pw[3] = (v4u){pg8::cvt_pk_bf16(p1[8], p1[9]), pg8::cvt_pk_bf16(p1[10], p1[11]), pg8::cvt_pk_bf16(p1[12], p1[13]), pg8::cvt_pk_bf16(p1[14], p1[15])};
#pragma unroll
        for (int d0 = 0; d0 < 4; ++d0) { const int d = 32 * d0 + r32;
#pragma unroll
            for (int s = 0; s < 4; ++s) { const int c = 8 * kt + 2 * s + hi;
                const bf16x8 vf = *(const LAS bf16x8*)(Vt + d * 512 + ((c ^ (d & 15)) << 4));
                o[d0] = __builtin_amdgcn_mfma_f32_32x32x16_bf16(__builtin_bit_cast(bf16x8, pw[s]), vf, o[d0], 0, 0, 0); } }
    }
    l += __shfl_xor(l, 32);
    LAS float* wsf = (LAS float*)(lds + L_WSF) + wid * 64;
    if (hi == 0) wsf[r32] = l;
    __syncthreads();
    LAS bf16* stg = (LAS bf16*)(lds + RING_OFF) + wid * 4096;
#pragma unroll
    for (int r = 0; r < 16; ++r) { const int orow = (r & 3) + 8 * (r >> 2) + 4 * hi; const float il = 1.0f / wsf[orow];
#pragma unroll
        for (int d0 = 0; d0 < 4; ++d0) stg[orow * 128 + d0 * 32 + r32] = (bf16)f2bf(o[d0][r] * il); }
    LDS_WAIT();
    bf16* Yw = Y + ((size_t)b * SEQ + (size_t)qb * 256 + wid * 32) * 1536 + 1024 + h * 128;
#pragma unroll
    for (int i = 0; i < 8; ++i) { const int row = i * 4 + (lane >> 4), ch = lane & 15; const v4u v = *(const LAS v4u*)(stg + row * 128 + ch * 8); *(v4u*)(Yw + (size_t)row * 1536 + ch * 8) = v; }
    __syncthreads();
}

__global__ void __launch_bounds__(NWAVES * 64, 2) mega_fwd(Args args) {
    extern __shared__ __attribute__((aligned(16))) unsigned char lds_raw[];
    LAS unsigned char* lds = (LAS unsigned char*)lds_raw;
    volatile LAS unsigned* MISC = (volatile LAS unsigned*)(lds + MISC_OFF);
    int tid = threadIdx.x, lane = tid & 63, wave = __builtin_amdgcn_readfirstlane(tid >> 6);
#define PHASE_LOCALS() do { tid = threadIdx.x; asm volatile("" : "+v"(tid)); lane = tid & 63; wave = __builtin_amdgcn_readfirstlane(tid >> 6); } while (0)
    const int G = gridDim.x; const int bx = blockIdx.x; const int vcu = (G % 8 == 0) ? (bx % 8) * (G / 8) + bx / 8 : bx;
    unsigned char* ws = args.ws;
    gu32* ctl = (gu32*)(ws + WS_CTL);
    for (int u = tid; u < (LDS_BYTES - LDSCTL_OFF) / 4; u += NWAVES * 64) ((LAS unsigned*)(lds + LDSCTL_OFF))[u] = 0u;
    __syncthreads();
    const int ph_lo = args.ph_lo, ph_hi = args.ph_hi;
    XcdBarrier bar; bar.bar = (unsigned*)(ctl + CW_BAR); bar.x = 0; bar.st = nullptr;
    if (ph_hi - ph_lo > 1) bar = xcd_barrier_post((unsigned*)(ctl + CW_BAR), MISC + 8);
#define IN(k) (ph_lo <= (k) && (k) < ph_hi)
#define GRID_BAR(k) do { if (IN(k) && IN((k) + 1)) xcd_barrier(bar); } while (0)

    if (IN(0)) {
    PHASE_LOCALS();
    p0_prologue(args, lds, vcu, G, wave, lane, tid);
    }
    GRID_BAR(0);

    if (IN(1)) {
    PHASE_LOCALS();
    {
        pg8::Gemm g{2048u, 2048u, 1024};
        ProjOrder S; S.A = (const char*)(ws + WS_HN); S.Bt = (const char*)(ws + WS_WIN); S.G = G; S.c = bx;
        pg8::EpiProj E{(bf16*)(ws + WS_Q), (bf16*)(ws + WS_K), (bf16*)(ws + WS_V), (bf16*)(ws + WS_U), (bf16*)(ws + WS_CB), (bf16*)(ws + WS_MQ), (bf16*)(ws + WS_GATES), (bf16*)(ws + WS_KVM),
                       (float*)(ws + WS_SSQ), args.in[4], args.in[5], (const float*)(ws + WS_RCOS), (const float*)(ws + WS_RSIN)};
        pg8::gemm_phase<pg8::EpiProj, ProjOrder, true, true>(lds + RING_OFF, g, S, E);
    }
    }
    GRID_BAR(1);

    if (IN(2)) {
    PHASE_LOCALS();
    {
        const int bh = vcu >> 3, s = vcu & 7;
        const int b = bh >> 4, vh = bh & 15, h = vh >> 2, mp = (vh >> 1) & 1, hf = vh & 1;
        const attn_body::bf16* Qp = (const attn_body::bf16*)(ws + WS_Q) + (size_t)b * SEQ * 512 + (h * 2 + mp) * 64;
        const attn_body::bf16* Kp = (const attn_body::bf16*)(ws + WS_K) + (size_t)b * SEQ * 512 + (h * 2 + mp) * 64;
        const attn_body::bf16* Vp = (const attn_body::bf16*)(ws + WS_V) + (size_t)b * SEQ * 512 + h * 128 + hf * 64;
        attn_body::bf16* Op = (attn_body::bf16*)(ws + WS_OMAPS) + (size_t)b * SEQ * 1024 + (h * 2 + mp) * 128 + hf * 64;
#pragma unroll 1
        for (int i = 0; i < 4; ++i) { const int qb = (i == 0) ? s : (i == 1) ? 15 - s : (i == 2) ? 16 + s : 31 - s;
            attn_body::attn_unit<8>(qb, Qp, Kp, Vp, Op, (char*)lds_raw + RING_OFF); }
        memattn_unit(args, lds, vcu >> 7, (vcu >> 5) & 3, vcu & 31, wave, lane, tid);
    }
    }
    GRID_BAR(2);

    if (IN(3)) {
    PHASE_LOCALS();
    phase_finish(args, vcu, G, wave, lane);
    }
    GRID_BAR(3);

    if (IN(4)) {
    PHASE_LOCALS();
    {
        pg8::Gemm g{3072u, 1024u, 512};
        MergeOrder S; S.Y = (const char*)(ws + WS_YALL); S.Bt = (const char*)(ws + WS_WBR); S.G = G; S.c = bx;
        pg8::EpiMerge E{(const bf16*)(ws + WS_GATES), (bf16*)(ws + WS_MERGED)};
        pg8::gemm_phase<pg8::EpiMerge, MergeOrder, false, true>(lds + RING_OFF, g, S, E);
    }
    }
    GRID_BAR(4);

    if (IN(5)) {
    PHASE_LOCALS();
    {
        pg8::Gemm g{2048u, 2048u, 1024};
        OutOrder S; S.A = (const char*)(ws + WS_MERGED); S.Bt = (const char*)(ws + WS_WOUT); S.G = G; S.c = bx;
        pg8::EpiResid E{args.in[0], args.out};
        pg8::gemm_phase<pg8::EpiResid, OutOrder, false, true>(lds + RING_OFF, g, S, E);
    }
    }
    GRID_BAR(5);

    if (IN(6)) {
    PHASE_LOCALS();
    phase_router(args, lds, vcu, G, wave, lane, tid);
    }
    GRID_BAR(6);

    if (IN(7)) {
    PHASE_LOCALS();
    phase_dispatch(args, lds, vcu, G, wave, lane, tid);
    }
    GRID_BAR(7);

    if (IN(8)) {
    PHASE_LOCALS();
    {
        pg8::Gemm g{2048u, 2048u, 1024};
        moe_plan(ws, lds, tid);
        MoeOrder S; S.A = (const char*)(ws + WS_XS); S.Bt = (const char*)(ws + WS_WGU); S.prefT = (const volatile LAS int*)(lds + L_PREFT); S.ncol = 8; S.G = G; S.c = vcu;
        pg8::EpiSwiglu E{args.in[22], (bf16*)(ws + WS_ACT)};
        pg8::gemm_phase<pg8::EpiSwiglu, MoeOrder, true, true>(lds + RING_OFF, g, S, E);
    }
    }
    GRID_BAR(8);

    if (IN(9)) {
    PHASE_LOCALS();
    {
        pg8::Gemm g{2048u, 2048u, 1024};
        moe_plan(ws, lds, tid);
        MoeOrder S; S.A = (const char*)(ws + WS_ACT); S.Bt = (const char*)(ws + WS_WDN); S.prefT = (const volatile LAS int*)(lds + L_PREFT); S.ncol = 4; S.G = G; S.c = vcu;
        pg8::EpiDown E{args.in[24], (const float*)(ws + WS_RGATE), (bf16*)(ws + WS_XS)};
        pg8::gemm_phase<pg8::EpiDown, MoeOrder, true, true>(lds + RING_OFF, g, S, E);
    }
    }
    GRID_BAR(9);

    if (IN(10)) {
    PHASE_LOCALS();
    phase_combine(args, vcu, G, wave, lane);
    }
    GRID_BAR(10);

#undef GRID_BAR
#undef IN
}

extern "C" void kernel_launch(void* const* d_in, const int* in_sizes, int n_in, void* d_out, int out_size, void* d_ws, size_t ws_size, hipStream_t stream) {
    static int grid = 0;
    if (grid == 0) {
        if (n_in != 25 || out_size != T * D || ws_size < WS_END) { fprintf(stderr, "kernel_launch: unexpected problem shape (n_in %d, out %d, ws %zu)\n", n_in, out_size, ws_size); grid = -1; return; }
        int dev = 0, cus = 0;
        if (hipGetDevice(&dev) != hipSuccess || hipDeviceGetAttribute(&cus, hipDeviceAttributeMultiprocessorCount, dev) != hipSuccess) { grid = -1; return; }
        if (hipFuncSetAttribute((const void*)mega_fwd, hipFuncAttributeMaxDynamicSharedMemorySize, LDS_BYTES) != hipSuccess) { fprintf(stderr, "kernel_launch: hipFuncSetAttribute failed\n"); grid = -1; return; }
        int per_cu = 0;
        if (hipOccupancyMaxActiveBlocksPerMultiprocessor(&per_cu, (const void*)mega_fwd, NWAVES * 64, LDS_BYTES) != hipSuccess || per_cu < 1) fprintf(stderr, "kernel_launch: occupancy query says %d\n", per_cu);
        (void)hipGetLastError();
        grid = cus;
        if (grid != 256) fprintf(stderr, "kernel_launch: built for 256 CUs, device has %d\n", grid);
    }
    if (grid < 0) return;
    if (hipMemsetAsync((char*)d_ws + WS_CTL, 0, CTL_ZERO_BYTES, stream) != hipSuccess) return;
    Args a{};
    for (int i = 0; i < 25; ++i) a.in[i] = (const float*)d_in[i];
    a.out = (float*)d_out; a.ws = (unsigned char*)d_ws;
#ifndef MK_PER_PHASE
#define MK_PER_PHASE 0
#endif
    if (MK_PER_PHASE) { for (int k = 0; k < 11; ++k) { a.ph_lo = k; a.ph_hi = k + 1; hipLaunchKernelGGL(mega_fwd, dim3(grid), dim3(NWAVES * 64), LDS_BYTES, stream, a); } }
    else { a.ph_lo = 0; a.ph_hi = 11; hipLaunchKernelGGL(mega_fwd, dim3(grid), dim3(NWAVES * 64), LDS_BYTES, stream, a); }
}
```

```cpp
#include <hip/hip_runtime.h>
#include <hip/hip_bf16.h>
#include <cstdio>
#include <cstdint>
#include <cmath>

namespace cfg {
constexpr int BATCH = 2, SEQ = 8192, T = BATCH * SEQ, D = 1024, NIN = 6656, NE = 32, NMEM = 256;
constexpr int MAXROWS = 65536 + NE * 256;
constexpr float EPS = 1e-6f;
constexpr float C2 = 0.125f * 1.4426950408889634f;
}

namespace pg8 {
#define PG8_LAS __attribute__((address_space(3)))
typedef unsigned short bf16_t;
typedef short bf16x8 __attribute__((ext_vector_type(8)));
typedef float f32x4 __attribute__((ext_vector_type(4)));
typedef unsigned u32x4 __attribute__((ext_vector_type(4)));
typedef unsigned u32x2 __attribute__((ext_vector_type(2)));
constexpr int BM = 256, BK = 64, HALF = 128, HTB = HALF * BK * 2  , STAGE_BYTES = 8 * HTB, NXCD = 8, WGM = 8;

__host__ __device__ __forceinline__ int lds_byte(int r, int c) { const int st = (r >> 4) * 2 + (c >> 5), rr = r & 15, cc = c & 31, ob = rr * 64 + cc * 2; return st * 1024 + (ob ^ (((ob >> 9) & 1) << 5)); }
__host__ __device__ __forceinline__ void stage_rc(int b, int& R, int& C) { const int st = b / 1024, sb = b % 1024, swz = sb ^ (((sb >> 9) & 1) << 5); R = (st >> 1) * 16 + swz / 64; C = (st & 1) * 32 + (swz % 64) / 2; }

struct Unit { int pm, pn, aux; const char* a; const char* b; };
struct Gemm { unsigned lda, ldb; int K; };

__device__ __forceinline__ void static_map(int L, int nM, int nN, int& pm, int& pn) {
    const int nwg = nM * nN; int wgid = L; { const int q = nwg / NXCD, r = nwg % NXCD, xcd = wgid % NXCD, off = wgid / NXCD; wgid = (xcd < r ? xcd * (q + 1) : r * (q + 1) + (xcd - r) * q) + off; }
    const int nig = WGM * nN, gid = wgid / nig, fm = gid * WGM, gsz = (nM - fm) < WGM ? (nM - fm) : WGM;
    pm = fm + ((wgid % nig) % gsz); pn = (wgid % nig) / gsz;
}

typedef float f32x2_cv __attribute__((ext_vector_type(2))); typedef __bf16 bf16x2_cv __attribute__((ext_vector_type(2)));
__device__ __forceinline__ unsigned cvt_pk_bf16(float lo, float hi) { f32x2_cv v = {lo, hi}; bf16x2_cv b = __builtin_convertvector(v, bf16x2_cv); return __builtin_bit_cast(unsigned, b); }
__device__ __forceinline__ u32x4 pack8(const f32x4 v0, const f32x4 v1) { u32x4 w; w.x = cvt_pk_bf16(v0[0], v0[1]); w.y = cvt_pk_bf16(v0[2], v0[3]); w.z = cvt_pk_bf16(v1[0], v1[1]); w.w = cvt_pk_bf16(v1[2], v1[3]); return w; }
__device__ __forceinline__ f32x4 unpk_lo(const u32x4 w) { return (f32x4){__uint_as_float(w.x << 16), __uint_as_float(w.x & 0xffff0000u), __uint_as_float(w.y << 16), __uint_as_float(w.y & 0xffff0000u)}; }
__device__ __forceinline__ f32x4 unpk_hi(const u32x4 w) { return (f32x4){__uint_as_float(w.z << 16), __uint_as_float(w.z & 0xffff0000u), __uint_as_float(w.w << 16), __uint_as_float(w.w & 0xffff0000u)}; }
__device__ __forceinline__ unsigned pk4_fp8(float a, float b, float c, float d) { int w = 0; w = __builtin_amdgcn_cvt_pk_fp8_f32(a, b, w, false); w = __builtin_amdgcn_cvt_pk_fp8_f32(c, d, w, true); return (unsigned)w; }
__device__ __forceinline__ float sigmoidf_fast(float z) { return __builtin_amdgcn_rcpf(1.0f + __builtin_amdgcn_exp2f(-1.4426950408889634f * z)); }

using cfg::T; using cfg::SEQ; using cfg::EPS;

struct EpiProj {
    static constexpr bool AFTER_DRAIN = false;
    bf16_t *Q, *K, *V, *U, *CB, *MQ, *GATES, *KVM; float* ssq; const float *gq, *gk, *rcos, *rsin;
    __device__ __forceinline__ bool keep(const Unit&) const { return false; }
    __device__ __forceinline__ void operator()(f32x4 (&acc)[2][2][4][2], const Unit& u, int wr, int wc, int fr, int fq) const {
        const int pn = u.pn; const int row0 = u.pm * BM + wr * 64 + fr;
        if (pn < 4) {
            const bool isk = pn >= 2; const float* g = isk ? gk : gq; bf16_t* dst = (isk ? K : Q) + (pn & 1) * 256 + wc * 64 + 8 * fq;
            const float post = isk ? 1.0f : cfg::C2;
            f32x4 ga[2][2];
#pragma unroll
            for (int bj = 0; bj < 2; ++bj)
#pragma unroll
                for (int n = 0; n < 2; ++n) ga[bj][n] = *(const f32x4*)(g + 32 * bj + 8 * fq + 4 * n);
#pragma unroll
            for (int ai = 0; ai < 2; ++ai)
#pragma unroll
                for (int m = 0; m < 4; ++m) {
                    const int row = row0 + ai * HALF + m * 16;
                    float ss = 0.f;
#pragma unroll
                    for (int bj = 0; bj < 2; ++bj)
#pragma unroll
                        for (int n = 0; n < 2; ++n) { const f32x4 x = acc[ai][bj][m][n]; ss += (x[0] * x[0] + x[1] * x[1]) + (x[2] * x[2] + x[3] * x[3]); }
                    ss += __shfl_xor(ss, 16); ss += __shfl_xor(ss, 32);
                    const float rinv = __builtin_amdgcn_rsqf(ss * (1.0f / 64.0f) + EPS) * post;
                    const int pos = row & (SEQ - 1);
                    f32x4 o1[2], o2[2];
#pragma unroll
                    for (int n = 0; n < 2; ++n) {
                        const f32x4 c = *(const f32x4*)(rcos + pos * 32 + 8 * fq + 4 * n), s = *(const f32x4*)(rsin + pos * 32 + 8 * fq + 4 * n);
                        const f32x4 x1 = acc[ai][0][m][n] * ga[0][n] * rinv, x2 = acc[ai][1][m][n] * ga[1][n] * rinv;
                        o1[n] = x1 * c - x2 * s; o2[n] = x2 * c + x1 * s;
                    }
                    *(u32x4*)(dst + (size_t)row * 512) = pack8(o1[0], o1[1]);
                    *(u32x4*)(dst + (size_t)row * 512 + 32) = pack8(o2[0], o2[1]);
                }
        } else if (pn >= 6 && pn < 10) {
            bf16_t* dst = U + (pn - 6) * 128 + wc * 32 + 8 * fq;
#pragma unroll
            for (int ai = 0; ai < 2; ++ai)
#pragma unroll
                for (int m = 0; m < 4; ++m) { const int row = row0 + ai * HALF + m * 16;
                    *(u32x4*)(dst + (size_t)row * 512) = pack8(acc[ai][0][m][0] * acc[ai][1][m][0], acc[ai][0][m][1] * acc[ai][1][m][1]); }
        } else if (pn >= 14 && pn < 26) {
            unsigned char* dst = (unsigned char*)GATES + ((size_t)(u.pm * 12 + (pn - 14)) << 16) + (((wr * 4 + wc) * 64 + fq * 16 + fr) << 3);
#pragma unroll
            for (int ai = 0; ai < 2; ++ai)
#pragma unroll
                for (int m = 0; m < 4; ++m) {
#pragma unroll
                    for (int bj = 0; bj < 2; ++bj) { const f32x4 v0 = acc[ai][bj][m][0], v1 = acc[ai][bj][m][1]; unsigned q[8];
#pragma unroll
                        for (int e = 0; e < 4; ++e) { q[e] = (unsigned)(sigmoidf_fast(v0[e]) * 255.0f + 0.5f); q[4 + e] = (unsigned)(sigmoidf_fast(v1[e]) * 255.0f + 0.5f); }
                        u32x2 w8; w8.x = q[0] | (q[1] << 8) | (q[2] << 16) | (q[3] << 24); w8.y = q[4] | (q[5] << 8) | (q[6] << 16) | (q[7] << 24);
                        *(u32x2*)(dst + ((((ai * 4 + m) * 2 + bj) * 512) << 3)) = w8; } }
        } else {
            bf16_t* dst; int ld, rsub = 0; const bool ismq = (pn == 12 || pn == 13);
            if (pn < 6) { dst = V + (pn - 4) * 256; ld = 512; } else if (pn < 12) { dst = CB + (pn - 10) * 256; ld = 512; }
            else if (pn < 14) { dst = MQ + (pn - 12) * 256; ld = 512; } else { dst = KVM + (pn - 26) * 256; ld = 1024; rsub = T; }
            dst += wc * 32 + 8 * fq;
#pragma unroll
            for (int ai = 0; ai < 2; ++ai)
#pragma unroll
                for (int m = 0; m < 4; ++m) { const int row = row0 + ai * HALF + m * 16 - rsub;
#pragma unroll
                    for (int bj = 0; bj < 2; ++bj) { const f32x4 v0 = acc[ai][bj][m][0], v1 = acc[ai][bj][m][1];
                        *(u32x4*)(dst + (size_t)row * ld + bj * HALF) = pack8(v0, v1);
                        if (ismq) { float ss = ((v0[0] * v0[0] + v0[1] * v0[1]) + (v0[2] * v0[2] + v0[3] * v0[3])) + ((v1[0] * v1[0] + v1[1] * v1[1]) + (v1[2] * v1[2] + v1[3] * v1[3]));
                            ss += __shfl_xor(ss, 16); ss += __shfl_xor(ss, 32);
                            if (fq == 0) ssq[(size_t)row * 16 + ((pn - 12) * 2 + bj) * 4 + wc] = ss; } } }
        }
    }
};

struct EpiGates8 {
    static constexpr bool AFTER_DRAIN = false;
    unsigned char* GATES;
    __device__ __forceinline__ bool keep(const Unit&) const { return false; }
    __device__ __forceinline__ void operator()(f32x4 (&acc)[2][2][4][2], const Unit& u, int wr, int wc, int fr, int fq) const {
        {
            unsigned char* dst = (unsigned char*)GATES + ((size_t)(u.pm * 12 + u.pn) << 16) + (((wr * 4 + wc) * 64 + fq * 16 + fr) << 3);
#pragma unroll
            for (int ai = 0; ai < 2; ++ai)
#pragma unroll
                for (int m = 0; m < 4; ++m) {
#pragma unroll
                    for (int bj = 0; bj < 2; ++bj) { const f32x4 v0 = acc[ai][bj][m][0], v1 = acc[ai][bj][m][1]; unsigned q[8];
#pragma unroll
                        for (int e = 0; e < 4; ++e) { q[e] = (unsigned)(sigmoidf_fast(v0[e]) * 255.0f + 0.5f); q[4 + e] = (unsigned)(sigmoidf_fast(v1[e]) * 255.0f + 0.5f); }
                        u32x2 w8; w8.x = q[0] | (q[1] << 8) | (q[2] << 16) | (q[3] << 24); w8.y = q[4] | (q[5] << 8) | (q[6] << 16) | (q[7] << 24);
                        *(u32x2*)(dst + ((((ai * 4 + m) * 2 + bj) * 512) << 3)) = w8; } }
        }
    }
};

struct EpiMerge {
    static constexpr bool AFTER_DRAIN = false;
    const bf16_t* GATES; bf16_t* MERGED;
    __device__ __forceinline__ bool keep(const Unit& u) const { return u.aux < 2; }
    __device__ __forceinline__ void operator()(f32x4 (&acc)[2][2][4][2], const Unit& u, int wr, int wc, int fr, int fq) const {
        const int br = u.aux; const int row0 = u.pm * BM + wr * 64 + fr, col0 = u.pn * BM + wc * 32 + 8 * fq;
        const unsigned char* ga_p = (const unsigned char*)GATES + ((size_t)(u.pm * 12 + br * 4 + u.pn) << 16) + (((wr * 4 + wc) * 64 + fq * 16 + fr) << 3);
        const unsigned char* gb_p = ga_p + ((size_t)4 << 16);
#pragma unroll
        for (int ai = 0; ai < 2; ++ai)
#pragma unroll
            for (int m = 0; m < 4; ++m) { const int row = row0 + ai * HALF + m * 16;
#pragma unroll
                for (int bj = 0; bj < 2; ++bj) { const int blk = (((ai * 4 + m) * 2 + bj) * 512) << 3;
                    const u32x2 ga = *(const u32x2*)(ga_p + blk);
                    f32x4 f0 = {(float)(ga.x & 255u), (float)((ga.x >> 8) & 255u), (float)((ga.x >> 16) & 255u), (float)(ga.x >> 24)}, f1 = {(float)(ga.y & 255u), (float)((ga.y >> 8) & 255u), (float)((ga.y >> 16) & 255u), (float)(ga.y >> 24)};
                    if (br < 2) { const u32x2 gb = *(const u32x2*)(gb_p + blk);
                        const f32x4 d0 = {(float)__builtin_elementwise_max(gb.x & 255u, 1u), (float)__builtin_elementwise_max((gb.x >> 8) & 255u, 1u), (float)__builtin_elementwise_max((gb.x >> 16) & 255u, 1u), (float)__builtin_elementwise_max(gb.x >> 24, 1u)};
                        const f32x4 d1 = {(float)__builtin_elementwise_max(gb.y & 255u, 1u), (float)__builtin_elementwise_max((gb.y >> 8) & 255u, 1u), (float)__builtin_elementwise_max((gb.y >> 16) & 255u, 1u), (float)__builtin_elementwise_max(gb.y >> 24, 1u)};
                        if (br == 1) {
#pragma unroll
                            for (int e = 0; e < 4; ++e) { f0[e] = __builtin_fmaxf(f0[e], 1.0f); f1[e] = __builtin_fmaxf(f1[e], 1.0f); } }
#pragma unroll
                        for (int e = 0; e < 4; ++e) { f0[e] *= __builtin_amdgcn_rcpf(d0[e]); f1[e] *= __builtin_amdgcn_rcpf(d1[e]); } }
                    else {
#pragma unroll
                        for (int e = 0; e < 4; ++e) { f0[e] = __builtin_fmaxf(f0[e], 1.0f) * (1.0f / 255.0f); f1[e] = __builtin_fmaxf(f1[e], 1.0f) * (1.0f / 255.0f); } }
                    acc[ai][bj][m][0] *= f0; acc[ai][bj][m][1] *= f1;
                    if (br == 2) *(u32x4*)(MERGED + (size_t)row * 1024 + col0 + bj * HALF) = pack8(acc[ai][bj][m][0], acc[ai][bj][m][1]);
                } }
    }
};

struct EpiResid {
    static constexpr bool AFTER_DRAIN = false;
    const float* base; float* out;
    __device__ __forceinline__ bool keep(const Unit&) const { return false; }
    __device__ __forceinline__ void operator()(f32x4 (&acc)[2][2][4][2], const Unit& u, int wr, int wc, int fr, int fq) const {
        const int row0 = u.pm * BM + wr * 64 + fr, col0 = u.pn * BM + wc * 32 + 8 * fq;
#pragma unroll
        for (int ai = 0; ai < 2; ++ai)
#pragma unroll
            for (int m = 0; m < 4; ++m) { const size_t off = (size_t)(row0 + ai * HALF + m * 16) * 1024 + col0;
#pragma unroll
                for (int bj = 0; bj < 2; ++bj)
#pragma unroll
                    for (int n = 0; n < 2; ++n) *(f32x4*)(out + off + bj * HALF + n * 4) = *(const f32x4*)(base + off + bj * HALF + n * 4) + acc[ai][bj][m][n]; }
    }
};

struct EpiSwiglu {
    static constexpr bool AFTER_DRAIN = false;
    const float* bgu; unsigned char* ACT;
    __device__ __forceinline__ bool keep(const Unit&) const { return false; }
    __device__ __forceinline__ void operator()(f32x4 (&acc)[2][2][4][2], const Unit& u, int wr, int wc, int fr, int fq) const {
        const int e_ = u.pn >> 3, pnl = u.pn & 7; const int row0 = u.pm * BM + wr * 64 + fr, ch0 = pnl * 128 + wc * 32 + 8 * fq;
        f32x4 bg[2], bu[2];
#pragma unroll
        for (int n = 0; n < 2; ++n) { bg[n] = *(const f32x4*)(bgu + (size_t)e_ * 2048 + ch0 + 4 * n); bu[n] = *(const f32x4*)(bgu + (size_t)e_ * 2048 + 1024 + ch0 + 4 * n); }
#pragma unroll
        for (int ai = 0; ai < 2; ++ai)
#pragma unroll
            for (int m = 0; m < 4; ++m) { const int row = row0 + ai * HALF + m * 16; f32x4 a[2];
#pragma unroll
                for (int n = 0; n < 2; ++n) { const f32x4 g = acc[ai][0][m][n] + bg[n], uu = acc[ai][1][m][n] + bu[n];
#pragma unroll
                    for (int e = 0; e < 4; ++e) { const float gm = fminf(g[e], 7.0f), um = fminf(fmaxf(uu[e], -7.0f), 7.0f);
                        a[n][e] = (um + 1.0f) * (gm * sigmoidf_fast(1.702f * gm)); } }
                u32x2 w8; w8.x = pk4_fp8(a[0][0], a[0][1], a[0][2], a[0][3]); w8.y = pk4_fp8(a[1][0], a[1][1], a[1][2], a[1][3]);
                *(u32x2*)(ACT + (size_t)row * 1024 + ch0) = w8; }
    }
};

struct EpiDown {
    static constexpr bool AFTER_DRAIN = false;
    const float* bd; const float* row_gate; unsigned char* YS;
    __device__ __forceinline__ bool keep(const Unit&) const { return false; }
    __device__ __forceinline__ void operator()(f32x4 (&acc)[2][2][4][2], const Unit& u, int wr, int wc, int fr, int fq) const {
        const int e_ = u.pn >> 2, pnl = u.pn & 3; const int row0 = u.pm * BM + wr * 64 + fr, col0 = pnl * 256 + wc * 32 + 8 * fq;
        f32x4 bv[2][2];
#pragma unroll
        for (int bj = 0; bj < 2; ++bj)
#pragma unroll
            for (int n = 0; n < 2; ++n) bv[bj][n] = *(const f32x4*)(bd + (size_t)e_ * 1024 + col0 + bj * HALF + 4 * n);
#pragma unroll
        for (int ai = 0; ai < 2; ++ai)
#pragma unroll
            for (int m = 0; m < 4; ++m) { const int row = row0 + ai * HALF + m * 16; const float rg = row_gate[row] * 16.0f;
#pragma unroll
                for (int bj = 0; bj < 2; ++bj) { const f32x4 y0 = (acc[ai][bj][m][0] + bv[bj][0]) * rg, y1 = (acc[ai][bj][m][1] + bv[bj][1]) * rg;
                    u32x2 w8; w8.x = pk4_fp8(y0[0], y0[1], y0[2], y0[3]); w8.y = pk4_fp8(y1[0], y1[1], y1[2], y1[3]);
                    *(u32x2*)(YS + (size_t)row * 1024 + col0 + bj * HALF) = w8; } }
    }
};


constexpr int CONV_NSUB = 2 * (32768 + 16384);
struct ConvCtx {
    const float* wgu; const float* wdn; unsigned char* ogu; unsigned char* odn;
    int cw, nseq, jn;
    int sub;
    unsigned slot0;
};
struct ConvItem { const float* W; unsigned char* WT; int ldn, k0, n0, dst; };
__device__ __forceinline__ int conv_ip32(int r) { return 16 * ((r >> 2) & 1) + 4 * (r >> 3) + (r & 3); }
__device__ __forceinline__ ConvItem conv_decode(const ConvCtx& c, int s) {
    ConvItem d; const int it = s >> 1, hf = s & 1;
    if (it < 32768) { const int e = it >> 10, q = it & 1023, kb = q >> 6, nb = q & 63; const int L0 = 32 * nb, ch = L0 & 1023;
        d.W = c.wgu + (size_t)e * 1024 * 2048; d.ldn = 2048; d.k0 = 64 * kb + 32 * hf; d.n0 = L0; d.dst = e * 2048 + 256 * (ch >> 7) + 128 * (L0 >> 10) + 32 * ((ch >> 5) & 3); d.WT = c.ogu; }
    else { const int r = it - 32768, e = r >> 9, q = r & 511, kb = q >> 5, nb = q & 31;
        d.W = c.wdn + (size_t)e * 1024 * 1024; d.ldn = 1024; d.k0 = 64 * kb + 32 * hf; d.n0 = 32 * nb; d.dst = e * 1024 + 32 * nb; d.WT = c.odn; }
    return d;
}
__device__ __forceinline__ void conv_issue(const ConvCtx& c, PG8_LAS unsigned char* lds, unsigned slot, int lane_, int s) {
    int lane = lane_; asm volatile("" : "+v"(lane));
    const ConvItem d = conv_decode(c, s);
    const float* src = d.W + (size_t)(d.k0 + (lane >> 3)) * d.ldn + d.n0 + 4 * (lane & 7);
#pragma unroll
    for (int jj = 0; jj < 4; ++jj) __builtin_amdgcn_global_load_lds((const unsigned*)(src + (size_t)(8 * jj) * d.ldn), (PG8_LAS unsigned*)(lds + slot + jj * 1024), 16, 0, 2);
}
__device__ __forceinline__ void conv_finish(const ConvCtx& c, PG8_LAS unsigned char* lds, unsigned slot, int lane_, int s) {
    int lane = lane_; asm volatile("" : "+v"(lane));
    const ConvItem d = conv_decode(c, s);
    const int n = lane & 31, kh = lane >> 5;
    const PG8_LAS float* p = (const PG8_LAS float*)(lds + slot + kh * 2048 + n * 4);
    float v[16];
#pragma unroll
    for (int kk = 0; kk < 16; ++kk) v[kk] = p[kk * 32];
    asm volatile("s_waitcnt lgkmcnt(0)" ::: "memory");
    u32x4 o;
    o.x = pk4_fp8(32.f * v[0], 32.f * v[1], 32.f * v[2], 32.f * v[3]);   o.y = pk4_fp8(32.f * v[4], 32.f * v[5], 32.f * v[6], 32.f * v[7]);
    o.z = pk4_fp8(32.f * v[8], 32.f * v[9], 32.f * v[10], 32.f * v[11]); o.w = pk4_fp8(32.f * v[12], 32.f * v[13], 32.f * v[14], 32.f * v[15]);
    __builtin_nontemporal_store(o, (u32x4*)(d.WT + (size_t)(d.dst + conv_ip32(n)) * 1024 + d.k0 + 16 * kh));
}
template <class Epi, class Sched, bool ALIGN_EPI = false, bool SP2 = false, bool CONV = false>
__device__ __forceinline__ void gemm_phase(PG8_LAS unsigned char* lds, const Gemm g, const Sched& S, const Epi& E, ConvCtx* cx = nullptr) {
    int tid_ = threadIdx.x; asm volatile("" : "+v"(tid_));
    const int tid = tid_, wid = __builtin_amdgcn_readfirstlane(tid >> 6), lane = tid & 63, wr = wid >> 2, wc = wid & 3, fr = lane & 15, fq = lane >> 4;
    const int K = g.K, nt = K / BK;
    static_assert(!CONV || SP2, "CONV needs the SP2 loop");
    unsigned voffA[2], voffB[2];
#pragma unroll
    for (int i = 0; i < 2; ++i) { int R, C; stage_rc(tid * 16 + i * 8192, R, C);
        voffA[i] = (unsigned)R * g.lda + (unsigned)C * 2u; voffB[i] = (unsigned)R * g.ldb + (unsigned)C * 2u; }
    const size_t kstep = (size_t)(BK * 2);
    const size_t hstepA = (size_t)HALF * g.lda, hstepB = (size_t)HALF * g.ldb;
    const unsigned ldsw = (unsigned)wid * 1024u;
    const int aoff = lds_byte(wr * 64 + fr, fq * 8), boff = lds_byte(wc * 32 + fr, fq * 8);
#define PG8_SA(b, h) (((b) * 2 + (h)) * HTB)
#define PG8_SB(b, h) ((4 + (b) * 2 + (h)) * HTB)
#define PG8_STAGE(bufoff, gbase, voff) do { _Pragma("unroll") for (int _i = 0; _i < 2; ++_i) \
        __builtin_amdgcn_global_load_lds((const unsigned*)((const char*)(gbase) + (voff)[_i]), (PG8_LAS unsigned*)(lds + (bufoff) + ldsw + _i * 8192), 16, 0, 0); } while (0)
#define PG8_LDA(dst, b, h) do { _Pragma("unroll") for (int m = 0; m < 4; ++m) _Pragma("unroll") for (int k = 0; k < 2; ++k) dst[m][k] = *(const PG8_LAS bf16x8*)(lds + PG8_SA(b, h) + aoff + m * 2048 + k * 1024); } while (0)
#define PG8_LDB(dst, b, h) do { _Pragma("unroll") for (int n = 0; n < 2; ++n) _Pragma("unroll") for (int k = 0; k < 2; ++k) dst[n][k] = *(const PG8_LAS bf16x8*)(lds + PG8_SB(b, h) + boff + n * 2048 + k * 1024); } while (0)
#define PG8_MMA(ai, bj, At, Bt) do { __builtin_amdgcn_s_setprio(1); _Pragma("unroll") for (int m = 0; m < 4; ++m) _Pragma("unroll") for (int n = 0; n < 2; ++n) _Pragma("unroll") for (int k = 0; k < 2; ++k) \
        acc[ai][bj][m][n] = __builtin_amdgcn_mfma_f32_16x16x32_bf16(Bt[n][k], At[m][k], acc[ai][bj][m][n], 0, 0, 0); __builtin_amdgcn_s_setprio(0); } while (0)
#define PG8_WAIT_V(n) asm volatile("s_waitcnt vmcnt(" #n ")" ::: "memory")
#define PG8_WAIT_X(n_) do { if constexpr (CONV) { const int x_ = (n_); if (x_ == 5) asm volatile("s_waitcnt vmcnt(13)" ::: "memory"); else if (x_ == 4) asm volatile("s_waitcnt vmcnt(12)" ::: "memory"); \
        else if (x_ == 1) asm volatile("s_waitcnt vmcnt(9)" ::: "memory"); else asm volatile("s_waitcnt vmcnt(8)" ::: "memory"); } else asm volatile("s_waitcnt vmcnt(8)" ::: "memory"); } while (0)
#define PG8_WAIT_L(n) asm volatile("s_waitcnt lgkmcnt(" #n ")" ::: "memory")
#define PG8_BAR __builtin_amdgcn_s_barrier()
#define PG8_SCHED __builtin_amdgcn_sched_barrier(0)
    Unit cur, nxt; int ui = 0;
    if (!S.next(0, cur)) return;
    f32x4 acc[2][2][4][2];
#pragma unroll
    for (int a = 0; a < 2; ++a)
#pragma unroll
        for (int b = 0; b < 2; ++b)
#pragma unroll
            for (int m = 0; m < 4; ++m)
#pragma unroll
                for (int n = 0; n < 2; ++n) acc[a][b][m][n] = (f32x4){0.f, 0.f, 0.f, 0.f};
    bf16x8 At[4][2], B0[2][2], B1[2][2];
    const char* cA = cur.a; const char* cB = cur.b;
    S.a_ready(cur);
    if constexpr (SP2) {
        PG8_STAGE(PG8_SB(0, 0), cB, voffB); PG8_STAGE(PG8_SB(0, 1), cB + hstepB, voffB); PG8_STAGE(PG8_SA(0, 0), cA, voffA); PG8_STAGE(PG8_SA(0, 1), cA + hstepA, voffA);
        if (wr == 1) PG8_BAR;
        PG8_WAIT_V(2); PG8_BAR;
        PG8_STAGE(PG8_SB(1, 0), cB + kstep, voffB); PG8_STAGE(PG8_SA(1, 0), cA + kstep, voffA); PG8_STAGE(PG8_SB(1, 1), cB + hstepB + kstep, voffB);
        PG8_WAIT_V(6); PG8_BAR;
    } else {
        PG8_STAGE(PG8_SB(0, 0), cB, voffB); PG8_STAGE(PG8_SA(0, 0), cA, voffA); PG8_STAGE(PG8_SB(0, 1), cB + hstepB, voffB); PG8_STAGE(PG8_SA(0, 1), cA + hstepA, voffA);
        if (wr == 1) PG8_BAR;
        PG8_WAIT_V(4); PG8_BAR;
        PG8_STAGE(PG8_SB(1, 0), cB + kstep, voffB); PG8_STAGE(PG8_SA(1, 0), cA + kstep, voffA); PG8_STAGE(PG8_SB(1, 1), cB + hstepB + kstep, voffB);
        PG8_WAIT_V(6); PG8_BAR;
    }
    for (;;) {
        const bool has_next = S.next(ui + 1, nxt);
        const char* nA = has_next ? nxt.a : cA; const char* nB = has_next ? nxt.b : cB;
#pragma unroll 1
        for (int t = 0; t < nt; t += 2) {
            const bool last = (t == nt - 2);
            const char* a1 = cA + (size_t)(t + 1) * kstep;
            const char* a2 = last ? nA : cA + (size_t)(t + 2) * kstep; const char* b2 = last ? nB : cB + (size_t)(t + 2) * kstep;
            const char* a3 = a2 + kstep; const char* b3 = b2 + kstep;
            if (last && has_next) S.a_ready(nxt);
            if constexpr (SP2) {
            int cs_ = 0, cc_ = 0;
            if constexpr (CONV) { if (cx->sub >= 0) { conv_finish(*cx, lds, cx->slot0, lane, cx->sub); cx->sub = -1; cs_ = 1; } PG8_SCHED; }
            PG8_LDB(B0, 0, 0); PG8_LDB(B1, 0, 1); PG8_SCHED; PG8_LDA(At, 0, 0); PG8_STAGE(PG8_SA(1, 1), a1 + hstepA, voffA);
            if constexpr (CONV) { const int s_ = cx->cw + cx->nseq * cx->jn; if (s_ < CONV_NSUB) { conv_issue(*cx, lds, cx->slot0, lane, s_); cx->sub = s_; ++cx->jn; cc_ = 4; } }
            PG8_WAIT_X(cs_ + cc_); PG8_WAIT_L(0); PG8_BAR; PG8_MMA(0, 0, At, B0); PG8_MMA(0, 1, At, B1); PG8_BAR; PG8_SCHED;
            PG8_LDA(At, 0, 1); PG8_STAGE(PG8_SB(0, 0), b2, voffB); PG8_STAGE(PG8_SB(0, 1), b2 + hstepB, voffB); PG8_STAGE(PG8_SA(0, 0), a2, voffA);
            PG8_WAIT_X(cs_ + cc_); PG8_WAIT_L(0); PG8_BAR; PG8_MMA(1, 0, At, B0); PG8_MMA(1, 1, At, B1); PG8_BAR; PG8_SCHED;
            PG8_LDB(B0, 1, 0); PG8_LDB(B1, 1, 1); PG8_SCHED; PG8_LDA(At, 1, 0); PG8_STAGE(PG8_SA(0, 1), a2 + hstepA, voffA);
            PG8_WAIT_X(cc_); PG8_WAIT_L(0); PG8_BAR; PG8_MMA(0, 0, At, B0); PG8_MMA(0, 1, At, B1); PG8_BAR; PG8_SCHED;
            PG8_LDA(At, 1, 1); PG8_STAGE(PG8_SB(1, 0), b3, voffB); PG8_STAGE(PG8_SB(1, 1), b3 + hstepB, voffB); PG8_STAGE(PG8_SA(1, 0), a3, voffA);
            PG8_WAIT_V(8); PG8_WAIT_L(0); PG8_BAR; PG8_MMA(1, 0, At, B0); PG8_MMA(1, 1, At, B1); PG8_BAR; PG8_SCHED;
            } else {
            PG8_LDB(B0, 0, 0); PG8_SCHED; PG8_LDA(At, 0, 0); PG8_STAGE(PG8_SA(1, 1), a1 + hstepA, voffA);
            PG8_WAIT_L(8); PG8_BAR; PG8_WAIT_L(0); PG8_MMA(0, 0, At, B0); PG8_BAR; PG8_SCHED;
            PG8_LDB(B1, 0, 1); PG8_STAGE(PG8_SB(0, 0), b2, voffB);
            PG8_BAR; PG8_WAIT_L(0); PG8_MMA(0, 1, At, B1); PG8_BAR;
            PG8_LDA(At, 0, 1); PG8_STAGE(PG8_SA(0, 0), a2, voffA);
            PG8_BAR; PG8_WAIT_L(0); PG8_MMA(1, 0, At, B0); PG8_BAR; PG8_SCHED;
            PG8_STAGE(PG8_SB(0, 1), b2 + hstepB, voffB);
            PG8_WAIT_V(6); PG8_BAR; PG8_MMA(1, 1, At, B1); PG8_BAR;
            PG8_LDB(B0, 1, 0); PG8_SCHED; PG8_LDA(At, 1, 0); PG8_STAGE(PG8_SA(0, 1), a2 + hstepA, voffA);
            PG8_WAIT_L(8); PG8_BAR; PG8_WAIT_L(0); PG8_MMA(0, 0, At, B0); PG8_BAR; PG8_SCHED;
            PG8_LDB(B1, 1, 1); PG8_STAGE(PG8_SB(1, 0), b3, voffB);
            PG8_BAR; PG8_WAIT_L(0); PG8_MMA(0, 1, At, B1); PG8_BAR;
            PG8_LDA(At, 1, 1); PG8_STAGE(PG8_SA(1, 0), a3, voffA);
            PG8_BAR; PG8_WAIT_L(0); PG8_MMA(1, 0, At, B0); PG8_BAR; PG8_SCHED;
            PG8_STAGE(PG8_SB(1, 1), b3 + hstepB, voffB);
            PG8_WAIT_V(6); PG8_BAR; PG8_MMA(1, 1, At, B1); PG8_BAR;
            }
        }
        if constexpr (ALIGN_EPI) { if (wr == 0) PG8_BAR; }
        if constexpr (!Epi::AFTER_DRAIN) { E(acc, cur, wr, wc, fr, fq); S.done(cur); }
        if (!has_next) break;
        if (!E.keep(cur)) {
#pragma unroll
        for (int a = 0; a < 2; ++a)
#pragma unroll
            for (int b = 0; b < 2; ++b)
#pragma unroll
                for (int m = 0; m < 4; ++m)
#pragma unroll
                    for (int n = 0; n < 2; ++n) acc[a][b][m][n] = (f32x4){0.f, 0.f, 0.f, 0.f};
        }
        cur = nxt; cA = nA; cB = nB; ++ui;
        if constexpr (ALIGN_EPI) { if (wr == 1) PG8_BAR; }
    }
    PG8_WAIT_V(0);
    if constexpr (!ALIGN_EPI) { if (wr == 0) PG8_BAR; }
    PG8_BAR;
    if constexpr (Epi::AFTER_DRAIN) { E.fused(acc, cur, wr, wc, fr, fq, lds, wid, lane); S.done(cur); }
#undef PG8_SA
#undef PG8_SB
#undef PG8_STAGE
#undef PG8_LDA
#undef PG8_LDB
#undef PG8_MMA
#undef PG8_WAIT_V
#undef PG8_WAIT_X
#undef PG8_WAIT_L
#undef PG8_BAR
#undef PG8_SCHED
}

typedef unsigned u32x8 __attribute__((ext_vector_type(8))); typedef int i32x8 __attribute__((ext_vector_type(8)));
constexpr int F8_SCALE_W = 122, F8_SCALE_X = 127;
template <class Epi, class Sched, bool ALIGN_EPI = false, bool SP2 = false, bool CONV = false>
__device__ __forceinline__ void gemm_phase_f8(PG8_LAS unsigned char* lds, const Gemm g, const Sched& S, const Epi& E, ConvCtx* cx = nullptr) {
    int tid_ = threadIdx.x; asm volatile("" : "+v"(tid_));
    const int tid = tid_, wid = __builtin_amdgcn_readfirstlane(tid >> 6), lane = tid & 63, wr = wid >> 2, wc = wid & 3, fr = lane & 15, fq = lane >> 4;
    const int K = g.K, nt = K / BK;
    static_assert(!CONV || SP2, "CONV needs the SP2 loop");
    unsigned voffA[2], voffB[2];
#pragma unroll
    for (int i = 0; i < 2; ++i) { int R, C; stage_rc(tid * 16 + i * 8192, R, C);
        voffA[i] = (unsigned)R * g.lda + (unsigned)C * 2u; voffB[i] = (unsigned)R * g.ldb + (unsigned)C * 2u; }
    const size_t kstep = (size_t)(BK * 2);
    const size_t hstepA = (size_t)HALF * g.lda, hstepB = (size_t)HALF * g.ldb;
    const unsigned ldsw = (unsigned)wid * 1024u;
    const int aoff = lds_byte(wr * 64 + fr, fq * 8), boff = lds_byte(wc * 32 + fr, fq * 8);
#define PG8_SA(b, h) (((b) * 2 + (h)) * HTB)
#define PG8_SB(b, h) ((4 + (b) * 2 + (h)) * HTB)
#define PG8_STAGE(bufoff, gbase, voff) do { _Pragma("unroll") for (int _i = 0; _i < 2; ++_i) \
        __builtin_amdgcn_global_load_lds((const unsigned*)((const char*)(gbase) + (voff)[_i]), (PG8_LAS unsigned*)(lds + (bufoff) + ldsw + _i * 8192), 16, 0, 0); } while (0)
#define PG8_LDA(dst, b, h) do { _Pragma("unroll") for (int m = 0; m < 4; ++m) { const u32x4 lo_ = *(const PG8_LAS u32x4*)(lds + PG8_SA(b, h) + aoff + m * 2048), hi_ = *(const PG8_LAS u32x4*)(lds + PG8_SA(b, h) + aoff + m * 2048 + 1024); dst[m] = __builtin_shufflevector(lo_, hi_, 0, 1, 2, 3, 4, 5, 6, 7); } } while (0)
#define PG8_LDB(dst, b, h) do { _Pragma("unroll") for (int n = 0; n < 2; ++n) { const u32x4 lo_ = *(const PG8_LAS u32x4*)(lds + PG8_SB(b, h) + boff + n * 2048), hi_ = *(const PG8_LAS u32x4*)(lds + PG8_SB(b, h) + boff + n * 2048 + 1024); dst[n] = __builtin_shufflevector(lo_, hi_, 0, 1, 2, 3, 4, 5, 6, 7); } } while (0)
#define PG8_MMA(ai, bj, At, Bt) do { __builtin_amdgcn_s_setprio(1); _Pragma("unroll") for (int m = 0; m < 4; ++m) _Pragma("unroll") for (int n = 0; n < 2; ++n) \
        asm volatile("v_mfma_scale_f32_16x16x128_f8f6f4 %0, %1, %2, %0, %3, %4 op_sel_hi:[0,0,0]" : "+v"(acc[ai][bj][m][n]) : "v"(Bt[n]), "v"(At[m]), "v"(sc_w), "v"(sc_x)); __builtin_amdgcn_s_setprio(0); } while (0)
#define PG8_WAIT_V(n) asm volatile("s_waitcnt vmcnt(" #n ")" ::: "memory")
#define PG8_WAIT_X(n_) do { if constexpr (CONV) { const int x_ = (n_); if (x_ == 5) asm volatile("s_waitcnt vmcnt(13)" ::: "memory"); else if (x_ == 4) asm volatile("s_waitcnt vmcnt(12)" ::: "memory"); \
        else if (x_ == 1) asm volatile("s_waitcnt vmcnt(9)" ::: "memory"); else asm volatile("s_waitcnt vmcnt(8)" ::: "memory"); } else asm volatile("s_waitcnt vmcnt(8)" ::: "memory"); } while (0)
#define PG8_WAIT_L(n) asm volatile("s_waitcnt lgkmcnt(" #n ")" ::: "memory")
#define PG8_BAR __builtin_amdgcn_s_barrier()
#define PG8_SCHED __builtin_amdgcn_sched_barrier(0)
    Unit cur, nxt; int ui = 0;
    if (!S.next(0, cur)) return;
    f32x4 acc[2][2][4][2];
#pragma unroll
    for (int a = 0; a < 2; ++a)
#pragma unroll
        for (int b = 0; b < 2; ++b)
#pragma unroll
            for (int m = 0; m < 4; ++m)
#pragma unroll
                for (int n = 0; n < 2; ++n) acc[a][b][m][n] = (f32x4){0.f, 0.f, 0.f, 0.f};
    u32x8 At[4], B0[2], B1[2];
    int sc_w = F8_SCALE_W, sc_x = F8_SCALE_X; asm volatile("" : "+v"(sc_w), "+v"(sc_x));
    const char* cA = cur.a; const char* cB = cur.b;
    S.a_ready(cur);
    if constexpr (SP2) {
        PG8_STAGE(PG8_SB(0, 0), cB, voffB); PG8_STAGE(PG8_SB(0, 1), cB + hstepB, voffB); PG8_STAGE(PG8_SA(0, 0), cA, voffA); PG8_STAGE(PG8_SA(0, 1), cA + hstepA, voffA);
        if (wr == 1) PG8_BAR;
        PG8_WAIT_V(2); PG8_BAR;
        PG8_STAGE(PG8_SB(1, 0), cB + kstep, voffB); PG8_STAGE(PG8_SA(1, 0), cA + kstep, voffA); PG8_STAGE(PG8_SB(1, 1), cB + hstepB + kstep, voffB);
        PG8_WAIT_V(6); PG8_BAR;
    } else {
        PG8_STAGE(PG8_SB(0, 0), cB, voffB); PG8_STAGE(PG8_SA(0, 0), cA, voffA); PG8_STAGE(PG8_SB(0, 1), cB + hstepB, voffB); PG8_STAGE(PG8_SA(0, 1), cA + hstepA, voffA);
        if (wr == 1) PG8_BAR;
        PG8_WAIT_V(4); PG8_BAR;
        PG8_STAGE(PG8_SB(1, 0), cB + kstep, voffB); PG8_STAGE(PG8_SA(1, 0), cA + kstep, voffA); PG8_STAGE(PG8_SB(1, 1), cB + hstepB + kstep, voffB);
        PG8_WAIT_V(6); PG8_BAR;
    }
    for (;;) {
        const bool has_next = S.next(ui + 1, nxt);
        const char* nA = has_next ? nxt.a : cA; const char* nB = has_next ? nxt.b : cB;
#pragma unroll 1
        for (int t = 0; t < nt; t += 2) {
            const bool last = (t == nt - 2);
            const char* a1 = cA + (size_t)(t + 1) * kstep;
            const char* a2 = last ? nA : cA + (size_t)(t + 2) * kstep; const char* b2 = last ? nB : cB + (size_t)(t + 2) * kstep;
            const char* a3 = a2 + kstep; const char* b3 = b2 + kstep;
            if (last && has_next) S.a_ready(nxt);
            if constexpr (SP2) {
            int cs_ = 0, cc_ = 0;
            if constexpr (CONV) { if (cx->sub >= 0) { conv_finish(*cx, lds, cx->slot0, lane, cx->sub); cx->sub = -1; cs_ = 1; } PG8_SCHED; }
            PG8_LDB(B0, 0, 0); PG8_LDB(B1, 0, 1); PG8_SCHED; PG8_LDA(At, 0, 0); PG8_STAGE(PG8_SA(1, 1), a1 + hstepA, voffA);
            if constexpr (CONV) { const int s_ = cx->cw + cx->nseq * cx->jn; if (s_ < CONV_NSUB) { conv_issue(*cx, lds, cx->slot0, lane, s_); cx->sub = s_; ++cx->jn; cc_ = 4; } }
            PG8_WAIT_X(cs_ + cc_); PG8_WAIT_L(0); PG8_BAR; PG8_MMA(0, 0, At, B0); PG8_MMA(0, 1, At, B1); PG8_BAR; PG8_SCHED;
            PG8_LDA(At, 0, 1); PG8_STAGE(PG8_SB(0, 0), b2, voffB); PG8_STAGE(PG8_SB(0, 1), b2 + hstepB, voffB); PG8_STAGE(PG8_SA(0, 0), a2, voffA);
            PG8_WAIT_X(cs_ + cc_); PG8_WAIT_L(0); PG8_BAR; PG8_MMA(1, 0, At, B0); PG8_MMA(1, 1, At, B1); PG8_BAR; PG8_SCHED;
            PG8_LDB(B0, 1, 0); PG8_LDB(B1, 1, 1); PG8_SCHED; PG8_LDA(At, 1, 0); PG8_STAGE(PG8_SA(0, 1), a2 + hstepA, voffA);
            PG8_WAIT_X(cc_); PG8_WAIT_L(0); PG8_BAR; PG8_MMA(0, 0, At, B0); PG8_MMA(0, 1, At, B1); PG8_BAR; PG8_SCHED;
            PG8_LDA(At, 1, 1); PG8_STAGE(PG8_SB(1, 0), b3, voffB); PG8_STAGE(PG8_SB(1, 1), b3 + hstepB, voffB); PG8_STAGE(PG8_SA(1, 0), a3, voffA);
            PG8_WAIT_V(8); PG8_WAIT_L(0); PG8_BAR; PG8_MMA(1, 0, At, B0); PG8_MMA(1, 1, At, B1); PG8_BAR; PG8_SCHED;
            } else {
            PG8_LDB(B0, 0, 0); PG8_SCHED; PG8_LDA(At, 0, 0); PG8_STAGE(PG8_SA(1, 1), a1 + hstepA, voffA);
            PG8_WAIT_L(8); PG8_BAR; PG8_WAIT_L(0); PG8_MMA(0, 0, At, B0); PG8_BAR; PG8_SCHED;
            PG8_LDB(B1, 0, 1); PG8_STAGE(PG8_SB(0, 0), b2, voffB);
            PG8_BAR; PG8_WAIT_L(0); PG8_MMA(0, 1, At, B1); PG8_BAR;
            PG8_LDA(At, 0, 1); PG8_STAGE(PG8_SA(0, 0), a2, voffA);
            PG8_BAR; PG8_WAIT_L(0); PG8_MMA(1, 0, At, B0); PG8_BAR; PG8_SCHED;
            PG8_STAGE(PG8_SB(0, 1), b2 + hstepB, voffB);
            PG8_WAIT_V(6); PG8_BAR; PG8_MMA(1, 1, At, B1); PG8_BAR;
            PG8_LDB(B0, 1, 0); PG8_SCHED; PG8_LDA(At, 1, 0); PG8_STAGE(PG8_SA(0, 1), a2 + hstepA, voffA);
            PG8_WAIT_L(8); PG8_BAR; PG8_WAIT_L(0); PG8_MMA(0, 0, At, B0); PG8_BAR; PG8_SCHED;
            PG8_LDB(B1, 1, 1); PG8_STAGE(PG8_SB(1, 0), b3, voffB);
            PG8_BAR; PG8_WAIT_L(0); PG8_MMA(0, 1, At, B1); PG8_BAR;
            PG8_LDA(At, 1, 1); PG8_STAGE(PG8_SA(1, 0), a3, voffA);
            PG8_BAR; PG8_WAIT_L(0); PG8_MMA(1, 0, At, B0); PG8_BAR; PG8_SCHED;
            PG8_STAGE(PG8_SB(1, 1), b3 + hstepB, voffB);
            PG8_WAIT_V(6); PG8_BAR; PG8_MMA(1, 1, At, B1); PG8_BAR;
            }
        }
        if constexpr (ALIGN_EPI) { if (wr == 0) PG8_BAR; }
        asm volatile("s_nop 15\n\ts_nop 15" ::: "memory");
        if constexpr (!Epi::AFTER_DRAIN) { E(acc, cur, wr, wc, fr, fq); S.done(cur); }
        if (!has_next) break;
        if (!E.keep(cur)) {
#pragma unroll
        for (int a = 0; a < 2; ++a)
#pragma unroll
            for (int b = 0; b < 2; ++b)
#pragma unroll
                for (int m = 0; m < 4; ++m)
#pragma unroll
                    for (int n = 0; n < 2; ++n) acc[a][b][m][n] = (f32x4){0.f, 0.f, 0.f, 0.f};
        }
        cur = nxt; cA = nA; cB = nB; ++ui;
        if constexpr (ALIGN_EPI) { if (wr == 1) PG8_BAR; }
    }
    PG8_WAIT_V(0);
    if constexpr (!ALIGN_EPI) { if (wr == 0) PG8_BAR; }
    PG8_BAR;
    if constexpr (Epi::AFTER_DRAIN) { E.fused(acc, cur, wr, wc, fr, fq, lds, wid, lane); S.done(cur); }
#undef PG8_SA
#undef PG8_SB
#undef PG8_STAGE
#undef PG8_LDA
#undef PG8_LDB
#undef PG8_MMA
#undef PG8_WAIT_V
#undef PG8_WAIT_X
#undef PG8_WAIT_L
#undef PG8_BAR
#undef PG8_SCHED
}
}

#include <hip/hip_bf16.h>
#include <cmath>
namespace attn_body {
using bf16=__hip_bfloat16;
using bf16x8=__attribute__((ext_vector_type(8)))short;
using s16x4=__attribute__((ext_vector_type(4)))short;
using f32x16=__attribute__((ext_vector_type(16)))float;
using u32x4=__attribute__((ext_vector_type(4)))unsigned;
constexpr int SEQ=8192,D=64; constexpr int QP=512,KP=512,VP=512,OP=1024;
constexpr int NW=8,QBLK=32,QB=QBLK*NW,KVBLK=64,NQB=SEQ/QB;
constexpr int ATTN_UNIT_ROWS=QB;
__device__ __forceinline__ int crow(int r,int hi){return (r&3)+8*(r>>2)+4*hi;}
#define SBAR() __builtin_amdgcn_sched_barrier(0)
__device__ __forceinline__ void cmask(f32x16&p0,f32x16&p1,int jb,int qrel,int hi){
  const float NEG=-INFINITY; (void)hi;
  if(jb>(qrel>>6)){
  #pragma unroll
  for(int r=0;r<16;++r){p0[r]=NEG;p1[r]=NEG;} }
}

constexpr int NSLOT=3, SLOTB=8192;
constexpr int LDS_K=0, LDS_V=NSLOT*SLOTB, LDS_WS=2*NSLOT*SLOTB, LDS_OST=LDS_WS+NW*64*4, LDS_BYTES=LDS_OST+NW*4096;
constexpr float C2=0.125f*1.4426950408889634f;
__device__ __forceinline__ void glds16(const void*gsrc,unsigned lds_dst){unsigned keep;
  asm volatile("s_mov_b32 %0, m0\n\ts_mov_b32 m0, %2\n\ts_nop 0\n\tglobal_load_lds_dwordx4 %1, off\n\ts_mov_b32 m0, %0":"=&s"(keep):"v"(gsrc),"s"(lds_dst):"memory");}
__device__ __forceinline__ float max3f(float a,float b,float c){float r;asm("v_max3_f32 %0, %1, %2, %3":"=v"(r):"v"(a),"v"(b),"v"(c));return r;}
__device__ __forceinline__ float max2f(float a,float b){float r;asm("v_max_f32_e32 %0, %1, %2":"=v"(r):"v"(a),"v"(b));return r;}
__device__ __forceinline__ float fadd_s(float a,float b){float r;asm("v_add_f32_e32 %0, %1, %2":"=v"(r):"v"(a),"v"(b));return r;}
__device__ __forceinline__ float fsub_s(float a,float b){float r;asm("v_sub_f32_e32 %0, %1, %2":"=v"(r):"v"(a),"v"(b));return r;}
typedef float f32x2_t __attribute__((ext_vector_type(2))); typedef __bf16 bf16x2_t __attribute__((ext_vector_type(2)));
__device__ __forceinline__ unsigned cvtpk_s(float lo,float hi){f32x2_t v={lo,hi};bf16x2_t b=__builtin_convertvector(v,bf16x2_t);return __builtin_bit_cast(unsigned,b);}
#define WAIT_BAR(N) asm volatile("s_waitcnt vmcnt(" #N ") lgkmcnt(0)\n\ts_barrier":::"memory")

__device__ __forceinline__ void qkt(f32x16&p0,f32x16&p1,const char*Kslot,const bf16x8*qr,const f32x16&negm,int r32,int hi){
  const char*kb=Kslot+hi*1024+r32*16;
  #pragma unroll
  for(int d0=0;d0<4;++d0){
    const bf16x8 b0=*reinterpret_cast<const bf16x8*>(kb+d0*2048);
    const bf16x8 b1=*reinterpret_cast<const bf16x8*>(kb+d0*2048+512);
    if(d0==0){p0=__builtin_amdgcn_mfma_f32_32x32x16_bf16(b0,qr[0],negm,0,0,0);p1=__builtin_amdgcn_mfma_f32_32x32x16_bf16(b1,qr[0],negm,0,0,0);}
    else{p0=__builtin_amdgcn_mfma_f32_32x32x16_bf16(b0,qr[d0],p0,0,0,0);p1=__builtin_amdgcn_mfma_f32_32x32x16_bf16(b1,qr[d0],p1,0,0,0);}}
}
typedef __attribute__((address_space(3))) const char* lds_cptr;
typedef short v4i16_t __attribute__((ext_vector_type(4)));
__device__ __forceinline__ void kload8(bf16x8*kf,lds_cptr kp){
  kf[0]=*(const __attribute__((address_space(3))) bf16x8*)(kp);      kf[1]=*(const __attribute__((address_space(3))) bf16x8*)(kp+512);
  kf[2]=*(const __attribute__((address_space(3))) bf16x8*)(kp+2048); kf[3]=*(const __attribute__((address_space(3))) bf16x8*)(kp+2560);
  kf[4]=*(const __attribute__((address_space(3))) bf16x8*)(kp+4096); kf[5]=*(const __attribute__((address_space(3))) bf16x8*)(kp+4608);
  kf[6]=*(const __attribute__((address_space(3))) bf16x8*)(kp+6144); kf[7]=*(const __attribute__((address_space(3))) bf16x8*)(kp+6656);
}
__device__ __forceinline__ void kload2(bf16x8*kf,lds_cptr kp,int j){ kf[2*j]=*(const __attribute__((address_space(3))) bf16x8*)(kp+j*2048); kf[2*j+1]=*(const __attribute__((address_space(3))) bf16x8*)(kp+j*2048+512); }
__device__ __forceinline__ s16x4 vtr(lds_cptr p){ return __builtin_bit_cast(s16x4,__builtin_amdgcn_ds_read_tr16_b64_v4i16((__attribute__((address_space(3))) v4i16_t*)p)); }
__device__ __forceinline__ float rowmax(const f32x16&p0,const f32x16&p1){
  float a=max3f(p0[0],p0[1],p1[0]),b=max3f(p0[2],p0[3],p1[1]);a=max3f(a,p1[2],p1[3]);
  #pragma unroll
  for(int r=4;r<16;r+=4){a=max3f(a,p0[r],p0[r+1]);b=max3f(b,p0[r+2],p0[r+3]);a=max3f(a,p1[r],p1[r+1]);b=max3f(b,p1[r+2],p1[r+3]);}
  const float m=max2f(a,b);
  auto rr=__builtin_amdgcn_permlane32_swap(__float_as_uint(m),__float_as_uint(m),false,false);
  return max2f(__uint_as_float(rr[0]),__uint_as_float(rr[1]));
}
__device__ __forceinline__ void pv(f32x16*o,int vb,bf16x8 pa0,bf16x8 pa1,bf16x8 pa2,bf16x8 pa3){
  #pragma unroll
  for(int d0=0;d0<2;++d0){s16x4 lo[4],hi[4];
    #pragma unroll
    for(int ks=0;ks<4;++ks){
      asm volatile("ds_read_b64_tr_b16 %0,%1 offset:%c2":"=&v"(lo[ks]):"v"(vb),"i"(d0*4096+ks*1024):"memory");
      asm volatile("ds_read_b64_tr_b16 %0,%1 offset:%c2":"=&v"(hi[ks]):"v"(vb),"i"(d0*4096+ks*1024+512):"memory");}
    asm volatile("s_waitcnt lgkmcnt(0)":::"memory");SBAR();
    #define PK(k) (bf16x8){lo[k][0],lo[k][1],lo[k][2],lo[k][3],hi[k][0],hi[k][1],hi[k][2],hi[k][3]}
    o[d0]=__builtin_amdgcn_mfma_f32_32x32x16_bf16(pa0,PK(0),o[d0],0,0,0);
    o[d0]=__builtin_amdgcn_mfma_f32_32x32x16_bf16(pa1,PK(1),o[d0],0,0,0);
    o[d0]=__builtin_amdgcn_mfma_f32_32x32x16_bf16(pa2,PK(2),o[d0],0,0,0);
    o[d0]=__builtin_amdgcn_mfma_f32_32x32x16_bf16(pa3,PK(3),o[d0],0,0,0);
    #undef PK
  }
}

#ifndef ATTN_STORE16
#define ATTN_STORE16(p,v) (*(u32x4*)(p)=(v))
#endif
template<int THRL> __device__ __forceinline__ void attn_unit(int qb,const bf16*Q,const bf16*__restrict__ K,const bf16*__restrict__ V,bf16*O,char*shm){
  int tid_=threadIdx.x; asm volatile("":"+v"(tid_)); const int tid=tid_,lane=tid&63,r32=lane&31,hi=lane>>5; const int wid=__builtin_amdgcn_readfirstlane(tid>>6);
  const int q0=qb*QB;
  const bf16*Qw=Q+(long)(q0+wid*QBLK)*QP;
  const bf16*Kh=K,*Vh=V;
  const unsigned lds0=(unsigned)(uintptr_t)shm;
  float*wsf=(float*)(shm+LDS_WS)+wid*64;
  const bf16*ksrc=Kh+(long)lane*KP+wid*8;
  const bf16*vsrc=Vh+(long)(16*(wid&3)+(lane>>2))*VP+(wid>>2)*32+(lane&3)*8;
  const unsigned kdst=lds0+LDS_K+wid*1024, vdst=lds0+LDS_V+wid*1024;
  #define DMA_K(t,slot) glds16(ksrc+(long)(t)*KVBLK*KP,(unsigned)__builtin_amdgcn_readfirstlane(kdst+(slot)))
  #define DMA_V(t,slot) glds16(vsrc+(long)(t)*KVBLK*VP,(unsigned)__builtin_amdgcn_readfirstlane(vdst+(slot)))
  const int vb0=(int)(lds0+LDS_V)+((lane>>4)&1)*32+(lane&3)*8+(4*hi+((lane&15)>>2))*64;
  const char*Kbase=shm+LDS_K; bf16x8 kf[8];
  const lds_cptr shm3=(lds_cptr)shm; const lds_cptr kp0=shm3+LDS_K+hi*1024+r32*16; const lds_cptr vp0=shm3+LDS_V+((lane>>4)&1)*32+(lane&3)*8+(4*hi+((lane&15)>>2))*64;
  const int NT=(q0+QB)/KVBLK;
  DMA_K(0,0);DMA_V(0,0);DMA_K(1,SLOTB);
  bf16x8 qr[4];
  #pragma unroll
  for(int d0=0;d0<4;++d0)qr[d0]=*reinterpret_cast<const bf16x8*>(&Qw[(long)r32*QP+d0*16+hi*8]);
  float mhat=0.f,l_reg=0.f;f32x16 o[2];o[0]=f32x16{};o[1]=f32x16{};f32x16 negm=f32x16{};asm volatile("":"+v"(negm));
  const int qrel=wid*QBLK+r32;
  #define CMASK(P0,P1,t) do{int jb_=(t)-(NT-4); if(jb_>=0)cmask(P0,P1,jb_,qrel,hi);}while(0)
  bool resc=false;
  #define START(P0,P1) do{ const float rm=rowmax(P0,P1); resc=false; \
    { const float dl=rm; mhat=fadd_s(mhat,dl); \
      _Pragma("unroll") for(int r=0;r<16;++r){P0[r]=fsub_s(P0[r],dl);P1[r]=fsub_s(P1[r],dl);} \
      _Pragma("unroll") for(int r=0;r<16;++r)negm[r]=-mhat; asm volatile("":"+v"(negm)); } \
    _Pragma("unroll") for(int r=0;r<16;++r)P0[r]=__builtin_amdgcn_exp2f(P0[r]); }while(0)
  #define RESC() do{ if(resc){ asm volatile("s_waitcnt lgkmcnt(0)":::"memory"); \
      _Pragma("unroll") for(int d_=0;d_<2;++d_) _Pragma("unroll") for(int r=0;r<16;++r)o[d_][r]*=wsf[crow(r,hi)]; } }while(0)
  f32x16 pA0,pA1,pB0,pB1;
  int sl_prev=0,sl_cur=0,sl_next=SLOTB;
  #define ROT() do{sl_prev=sl_cur;sl_cur=sl_next;sl_next=(sl_next==(NSLOT-1)*SLOTB)?0:sl_next+SLOTB;}while(0)
  DMA_K(2,2*SLOTB);
  WAIT_BAR(3);
  qkt(pA0,pA1,Kbase,qr,negm,r32,hi);asm volatile("s_nop 15\n\ts_nop 7":"+v"(pA0),"+v"(pA1));CMASK(pA0,pA1,0);
  START(pA0,pA1);
  _Pragma("unroll") for(int r=0;r<16;++r)pA1[r]=__builtin_amdgcn_exp2f(pA1[r]);
  WAIT_BAR(0);
  DMA_K(3,0);DMA_V(1,SLOTB);
  ROT();
  kload8(kf,kp0+sl_cur);
  WAIT_BAR(2);
  s16x4 vlo[8],vhi[8]; u32x4 pw0,pw1,pw2,pw3;
  #define PKW(P,B) cvtpk_s(P[B],P[B+1])
  #define PAF(k) __builtin_bit_cast(bf16x8,pw##k)
  #define VFR(i) (bf16x8){vlo[i][0],vlo[i][1],vlo[i][2],vlo[i][3],vhi[i][0],vhi[i][1],vhi[i][2],vhi[i][3]}
  #define PIN(x) asm volatile("":"+v"(x))
  #define MX3(a,b,c) __builtin_fmaxf(__builtin_fmaxf((a),(b)),(c))
  #define GAPA(MF,A0,A1,A2,A3,W0,W1,PW) do{ MF; sacc+=A0; sacc+=A1; sacc+=A2; sacc+=A3; PIN(sacc); W0; W1; PIN(PW); SBAR(); }while(0)
  #define EX(v) __builtin_amdgcn_exp2f(v)
  #define GAPB(MF,X,B) do{ MF; X[B]=EX(X[B]); X[B+1]=EX(X[B+1]); X[B+2]=EX(X[B+2]); X[B+3]=EX(X[B+3]); PIN(X); SBAR(); }while(0)
  #define VRD(i) do{ vlo[i]=vtr(vp_+(((i)>>2)*4096+((i)&3)*1024)); vhi[i]=vtr(vp_+(((i)>>2)*4096+((i)&3)*1024+512)); }while(0)
  #define KRD(G,j) do{ if(G){ kload2(kf,kp0+sl_next,j); SBAR(); } }while(0)
  #define STEP(C0,C1,P0,P1,t,GK,GV,GL) do{ SBAR(); \
    const lds_cptr vp_=vp0+sl_prev; \
    VRD(0); SBAR(); float sacc=(P0[0]+P0[1]); \
    GAPA(C0=__builtin_amdgcn_mfma_f32_32x32x16_bf16(kf[0],qr[0],negm,0,0,0), P0[2],P0[3],P0[4],P0[5],     pw0[0]=PKW(P0,0), pw0[1]=PKW(P0,2), pw0); \
    VRD(4); SBAR(); GAPA(C1=__builtin_amdgcn_mfma_f32_32x32x16_bf16(kf[1],qr[0],negm,0,0,0), P0[6],P0[7],P0[8],P0[9],     pw0[2]=PKW(P0,4), pw0[3]=PKW(P0,6), pw0); \
    VRD(1); SBAR(); GAPA(C0=__builtin_amdgcn_mfma_f32_32x32x16_bf16(kf[2],qr[1],C0,0,0,0),   P0[10],P0[11],P0[12],P0[13], pw1[0]=PKW(P0,8), pw1[1]=PKW(P0,10), pw1); \
    VRD(5); SBAR(); GAPA(C1=__builtin_amdgcn_mfma_f32_32x32x16_bf16(kf[3],qr[1],C1,0,0,0),   P0[14],P0[15],P1[0],P1[1],   pw1[2]=PKW(P0,12),pw1[3]=PKW(P0,14), pw1); \
    VRD(2); SBAR(); GAPA(C0=__builtin_amdgcn_mfma_f32_32x32x16_bf16(kf[4],qr[2],C0,0,0,0),   P1[2],P1[3],P1[4],P1[5],     pw2[0]=PKW(P1,0), pw2[1]=PKW(P1,2), pw2); \
    VRD(6); SBAR(); GAPA(C1=__builtin_amdgcn_mfma_f32_32x32x16_bf16(kf[5],qr[2],C1,0,0,0),   P1[6],P1[7],P1[8],P1[9],     pw2[2]=PKW(P1,4), pw2[3]=PKW(P1,6), pw2); \
    VRD(3); SBAR(); GAPA(C0=__builtin_amdgcn_mfma_f32_32x32x16_bf16(kf[6],qr[3],C0,0,0,0),   P1[10],P1[11],P1[12],P1[13], pw3[0]=PKW(P1,8), pw3[1]=PKW(P1,10), pw3); \
    VRD(7); SBAR(); GAPA(C1=__builtin_amdgcn_mfma_f32_32x32x16_bf16(kf[7],qr[3],C1,0,0,0),   P1[14],P1[15],0.f,0.f,       pw3[2]=PKW(P1,12),pw3[3]=PKW(P1,14), pw3); \
    l_reg+=sacc; \
    if(GK){DMA_K((t)+3,sl_cur);} if(GV){DMA_V((t)+1,sl_next);} \
    CMASK(C0,C1,t); \
    { float a=MX3(C0[0],C0[1],C1[0]),b=MX3(C0[2],C0[3],C1[1]); a=MX3(a,C1[2],C1[3]); \
      _Pragma("unroll") for(int r=4;r<16;r+=4){a=MX3(a,C0[r],C0[r+1]);b=MX3(b,C0[r+2],C0[r+3]);a=MX3(a,C1[r],C1[r+1]);b=MX3(b,C1[r+2],C1[r+3]);} \
      float rm=__builtin_fmaxf(a,b); { auto rr=__builtin_amdgcn_permlane32_swap(__float_as_uint(rm),__float_as_uint(rm),false,false); rm=__builtin_fmaxf(__uint_as_float(rr[0]),__uint_as_float(rr[1])); } \
      resc=false; \
      if(__builtin_expect(__any(rm>(float)THRL),0)){ const float dl=__builtin_fmaxf(rm,0.f); mhat+=dl; \
        _Pragma("unroll") for(int r=0;r<16;++r){C0[r]-=dl;C1[r]-=dl;} \
        _Pragma("unroll") for(int r=0;r<16;++r)negm[r]=-mhat; asm volatile("":"+v"(negm)); \
        const float f=__builtin_amdgcn_exp2f(-dl); l_reg*=f; if(hi==0)wsf[r32]=f; resc=true; } } \
    SBAR(); \
    GAPB(o[0]=__builtin_amdgcn_mfma_f32_32x32x16_bf16(PAF(0),VFR(0),o[0],0,0,0), C0,0); \
    GAPB(o[1]=__builtin_amdgcn_mfma_f32_32x32x16_bf16(PAF(0),VFR(4),o[1],0,0,0), C0,4); \
    KRD(GL,0); GAPB(o[0]=__builtin_amdgcn_mfma_f32_32x32x16_bf16(PAF(1),VFR(1),o[0],0,0,0), C0,8); \
    KRD(GL,1); GAPB(o[1]=__builtin_amdgcn_mfma_f32_32x32x16_bf16(PAF(1),VFR(5),o[1],0,0,0), C0,12); \
    KRD(GL,2); GAPB(o[0]=__builtin_amdgcn_mfma_f32_32x32x16_bf16(PAF(2),VFR(2),o[0],0,0,0), C1,0); \
    KRD(GL,3); GAPB(o[1]=__builtin_amdgcn_mfma_f32_32x32x16_bf16(PAF(2),VFR(6),o[1],0,0,0), C1,4); \
    GAPB(o[0]=__builtin_amdgcn_mfma_f32_32x32x16_bf16(PAF(3),VFR(3),o[0],0,0,0), C1,8); \
    GAPB(o[1]=__builtin_amdgcn_mfma_f32_32x32x16_bf16(PAF(3),VFR(7),o[1],0,0,0), C1,12); \
    }while(0)
  int t=1;
  #undef CMASK
  #define CMASK(P0,P1,t) do{}while(0)
  for(;t+5<NT;t+=2){
    STEP(pB0,pB1,pA0,pA1,t,true,true,true);     WAIT_BAR(2); RESC(); ROT();
    STEP(pA0,pA1,pB0,pB1,t+1,true,true,true);   WAIT_BAR(2); RESC(); ROT();
  }
  #undef CMASK
  #define CMASK(P0,P1,t) do{int jb_=(t)-(NT-4); if(jb_>=0)cmask(P0,P1,jb_,qrel,hi);}while(0)
  #define ENDW(tt) do{ if((tt)+3<NT){WAIT_BAR(2);} else if((tt)+2<NT){WAIT_BAR(1);} else {WAIT_BAR(0);} }while(0)
  for(;t+1<NT;t+=2){
    STEP(pB0,pB1,pA0,pA1,t,(t+3<NT),(t+1<NT),(t+1<NT));       ENDW(t);   RESC(); ROT();
    STEP(pA0,pA1,pB0,pB1,t+1,(t+4<NT),(t+2<NT),(t+2<NT));     ENDW(t+1); RESC(); ROT();
  }
  STEP(pB0,pB1,pA0,pA1,NT-1,false,false,false); RESC();
  { float sacc=pB0[0]+pB0[1]; _Pragma("unroll") for(int r=2;r<16;++r)sacc+=pB0[r]; _Pragma("unroll") for(int r=0;r<16;++r)sacc+=pB1[r]; l_reg+=sacc;
    pw0=(u32x4){PKW(pB0,0),PKW(pB0,2),PKW(pB0,4),PKW(pB0,6)};pw1=(u32x4){PKW(pB0,8),PKW(pB0,10),PKW(pB0,12),PKW(pB0,14)};pw2=(u32x4){PKW(pB1,0),PKW(pB1,2),PKW(pB1,4),PKW(pB1,6)};pw3=(u32x4){PKW(pB1,8),PKW(pB1,10),PKW(pB1,12),PKW(pB1,14)};
    SBAR(); pv(o,vb0+sl_cur,PAF(0),PAF(1),PAF(2),PAF(3)); }
  #undef PKW
  #undef PAF
  #undef VFR
  #undef PIN
  #undef MX3
  #undef GAPA
  #undef GAPB
  #undef EX
  #undef VRD
  #undef KRD
  #undef STEP
  #undef ENDW
  {auto rr=__builtin_amdgcn_permlane32_swap(__float_as_uint(l_reg),__float_as_uint(l_reg),false,false);l_reg=__uint_as_float(rr[0])+__uint_as_float(rr[1]);}
  if(hi==0)wsf[32+r32]=l_reg;asm volatile("s_waitcnt lgkmcnt(0)":::"memory");
  float rli[16];
  #pragma unroll
  for(int r=0;r<16;++r)rli[r]=__builtin_amdgcn_rcpf(wsf[32+crow(r,hi)]);
  bf16*Ow=O+(long)(q0+wid*QBLK)*OP;
  { bf16*stg=(bf16*)(shm+LDS_OST)+wid*2048;
    #pragma unroll
    for(int r=0;r<16;++r){const int orow=crow(r,hi);
      #pragma unroll
      for(int d0=0;d0<2;++d0)stg[orow*64+d0*32+r32]=__float2bfloat16(o[d0][r]*rli[r]);}
    asm volatile("s_waitcnt lgkmcnt(0)":::"memory");
    #pragma unroll
    for(int i=0;i<4;++i){const int row=i*8+(lane>>3),ch=lane&7; const u32x4 v=*(const u32x4*)(stg+row*64+ch*8); ATTN_STORE16(Ow+(long)row*OP+ch*8,v);} }
  asm volatile("s_waitcnt lgkmcnt(0)\n\ts_barrier":::"memory");
  #undef DMA_K
  #undef DMA_V
  #undef CMASK
  #undef START
  #undef RESC
  #undef ROT
}

constexpr int SLOTV=16384, L2_K=0, L2_V=NSLOT*SLOTB, L2_WS=L2_V+NSLOT*SLOTV, L2_BYTES=L2_WS+NW*64*4;
__device__ __forceinline__ void qkt0(f32x16&p0,f32x16&p1,const char*Kslot,const bf16x8*qr,int r32,int hi){
  const char*kb=Kslot+hi*1024+r32*16; const f32x16 z=f32x16{};
  #pragma unroll
  for(int d0=0;d0<4;++d0){
    const bf16x8 b0=*reinterpret_cast<const bf16x8*>(kb+d0*2048);
    const bf16x8 b1=*reinterpret_cast<const bf16x8*>(kb+d0*2048+512);
    if(d0==0){p0=__builtin_amdgcn_mfma_f32_32x32x16_bf16(b0,qr[0],z,0,0,0);p1=__builtin_amdgcn_mfma_f32_32x32x16_bf16(b1,qr[0],z,0,0,0);}
    else{p0=__builtin_amdgcn_mfma_f32_32x32x16_bf16(b0,qr[d0],p0,0,0,0);p1=__builtin_amdgcn_mfma_f32_32x32x16_bf16(b1,qr[d0],p1,0,0,0);}}
}
__device__ __forceinline__ void pv128(f32x16*o,int vb,bf16x8 pa0,bf16x8 pa1,bf16x8 pa2,bf16x8 pa3){
  #pragma unroll
  for(int d0=0;d0<4;++d0){s16x4 lo[4],hi[4];
    #pragma unroll
    for(int ks=0;ks<4;++ks){
      asm volatile("ds_read_b64_tr_b16 %0,%1 offset:%c2":"=&v"(lo[ks]):"v"(vb),"i"(d0*4096+ks*1024):"memory");
      asm volatile("ds_read_b64_tr_b16 %0,%1 offset:%c2":"=&v"(hi[ks]):"v"(vb),"i"(d0*4096+ks*1024+512):"memory");}
    asm volatile("s_waitcnt lgkmcnt(0)":::"memory");SBAR();
    #define PK(k) (bf16x8){lo[k][0],lo[k][1],lo[k][2],lo[k][3],hi[k][0],hi[k][1],hi[k][2],hi[k][3]}
    o[d0]=__builtin_amdgcn_mfma_f32_32x32x16_bf16(pa0,PK(0),o[d0],0,0,0);
    o[d0]=__builtin_amdgcn_mfma_f32_32x32x16_bf16(pa1,PK(1),o[d0],0,0,0);
    o[d0]=__builtin_amdgcn_mfma_f32_32x32x16_bf16(pa2,PK(2),o[d0],0,0,0);
    o[d0]=__builtin_amdgcn_mfma_f32_32x32x16_bf16(pa3,PK(3),o[d0],0,0,0);
    #undef PK
  }
}
template<int THRL> __device__ __forceinline__ void attn_unit128(int qb,const bf16*Q,const bf16*__restrict__ K,const bf16*__restrict__ V,bf16*O,char*shm){
  int tid_=threadIdx.x; asm volatile("":"+v"(tid_)); const int tid=tid_,lane=tid&63,r32=lane&31,hi=lane>>5; const int wid=__builtin_amdgcn_readfirstlane(tid>>6);
  const int q0=qb*QB;
  const bf16*Qw=Q+(long)(q0+wid*QBLK)*QP;
  const unsigned lds0=(unsigned)(uintptr_t)shm;
  float*wsf=(float*)(shm+L2_WS)+wid*64;
  const bf16*ksrc=K+(long)lane*KP+wid*8;
  const bf16*vsrc=V+(long)(16*(wid&3)+(lane>>2))*VP+(wid>>2)*32+(lane&3)*8;
  const unsigned kdst=lds0+L2_K+wid*1024, vdst=lds0+L2_V+wid*1024;
  #define DMA_K(t,slot) glds16(ksrc+(long)(t)*KVBLK*KP,(unsigned)__builtin_amdgcn_readfirstlane(kdst+(slot)))
  #define DMA_V(t,slot) do{ glds16(vsrc+(long)(t)*KVBLK*VP,(unsigned)__builtin_amdgcn_readfirstlane(vdst+2*(slot))); glds16(vsrc+64+(long)(t)*KVBLK*VP,(unsigned)__builtin_amdgcn_readfirstlane(vdst+2*(slot)+8192)); }while(0)
  const int vb0=(int)(lds0+L2_V)+((lane>>4)&1)*32+(lane&3)*8+(4*hi+((lane&15)>>2))*64;
  const char*Kbase=shm+L2_K; bf16x8 kf[8];
  const lds_cptr shm3=(lds_cptr)shm; const lds_cptr kp0=shm3+L2_K+hi*1024+r32*16; const lds_cptr vp0=shm3+L2_V+((lane>>4)&1)*32+(lane&3)*8+(4*hi+((lane&15)>>2))*64;
  const int NT=(q0+QB)/KVBLK;
  DMA_K(0,0);DMA_V(0,0);DMA_K(1,SLOTB);
  bf16x8 qr[4];
  #pragma unroll
  for(int d0=0;d0<4;++d0)qr[d0]=*reinterpret_cast<const bf16x8*>(&Qw[(long)r32*QP+d0*16+hi*8]);
  float l_reg=0.f;f32x16 o[4];
  ;o[0]=f32x16{};o[1]=f32x16{};o[2]=f32x16{};o[3]=f32x16{};
  const int qrel=wid*QBLK+r32;
  #define CMASK(P0,P1,t) do{int jb_=(t)-(NT-4); if(jb_>=0)cmask(P0,P1,jb_,qrel,hi);}while(0)
  #define RESC() do{}while(0)
  f32x16 pA0,pA1,pB0,pB1;
  int sl_prev=0,sl_cur=0,sl_next=SLOTB;
  #define ROT() do{sl_prev=sl_cur;sl_cur=sl_next;sl_next=(sl_next==(NSLOT-1)*SLOTB)?0:sl_next+SLOTB;}while(0)
  DMA_K(2,2*SLOTB);
  WAIT_BAR(4);
  qkt0(pA0,pA1,Kbase,qr,r32,hi);asm volatile("s_nop 15\n\ts_nop 7":"+v"(pA0),"+v"(pA1));CMASK(pA0,pA1,0);
  { _Pragma("unroll") for(int r=0;r<16;++r){pA0[r]=__builtin_amdgcn_exp2f(pA0[r]);pA1[r]=__builtin_amdgcn_exp2f(pA1[r]);} }
  WAIT_BAR(0);
  DMA_K(3,0);DMA_V(1,SLOTB);
  ROT();
  kload8(kf,kp0+sl_cur);
  WAIT_BAR(3);
  s16x4 vlo[8],vhi[8],vlo2[8],vhi2[8]; u32x4 pw0,pw1,pw2,pw3;
  #define PKW(P,B) cvtpk_s(P[B],P[B+1])
  #define PAF(k) __builtin_bit_cast(bf16x8,pw##k)
  #define VFR(i) (bf16x8){vlo[i][0],vlo[i][1],vlo[i][2],vlo[i][3],vhi[i][0],vhi[i][1],vhi[i][2],vhi[i][3]}
  #define VFR2(i) (bf16x8){vlo2[i][0],vlo2[i][1],vlo2[i][2],vlo2[i][3],vhi2[i][0],vhi2[i][1],vhi2[i][2],vhi2[i][3]}
  #define PIN(x) asm volatile("":"+v"(x))
  #define MX3(a,b,c) __builtin_fmaxf(__builtin_fmaxf((a),(b)),(c))
  #define GAPA(MF,A0,A1,A2,A3,W0,W1,PW) do{ MF; sacc+=A0; sacc+=A1; sacc+=A2; sacc+=A3; PIN(sacc); W0; W1; PIN(PW); SBAR(); }while(0)
  #define EX(v) __builtin_amdgcn_exp2f(v)
  #define GAPB(MF,X,B) do{ MF; X[B]=EX(X[B]); X[B+1]=EX(X[B+1]); PIN(X); SBAR(); }while(0)
  #define VRD(i) do{ vlo[i]=vtr(vp_+(((i)>>2)*4096+((i)&3)*1024)); vhi[i]=vtr(vp_+(((i)>>2)*4096+((i)&3)*1024+512)); }while(0)
  #define VRD2(i) do{ vlo2[i]=vtr(vp_+(8192+((i)>>2)*4096+((i)&3)*1024)); vhi2[i]=vtr(vp_+(8192+((i)>>2)*4096+((i)&3)*1024+512)); SBAR(); }while(0)
  #define KRD(G,j) do{ if(G){ kload2(kf,kp0+sl_next,j); SBAR(); } }while(0)
  #define MF32(a,b,c) __builtin_amdgcn_mfma_f32_32x32x16_bf16(a,b,c,0,0,0)
  #define STEP(C0,C1,P0,P1,t,GK,GV,GL) do{ SBAR(); \
    const lds_cptr vp_=vp0+2*sl_prev; const f32x16 z16_=f32x16{}; \
    VRD(0); SBAR(); float sacc=(P0[0]+P0[1]); \
    GAPA(C0=MF32(kf[0],qr[0],z16_), P0[2],P0[3],P0[4],P0[5],     pw0[0]=PKW(P0,0), pw0[1]=PKW(P0,2), pw0); \
    VRD(4); SBAR(); GAPA(C1=MF32(kf[1],qr[0],z16_), P0[6],P0[7],P0[8],P0[9],     pw0[2]=PKW(P0,4), pw0[3]=PKW(P0,6), pw0); \
    VRD(1); SBAR(); GAPA(C0=MF32(kf[2],qr[1],C0),   P0[10],P0[11],P0[12],P0[13], pw1[0]=PKW(P0,8), pw1[1]=PKW(P0,10), pw1); \
    VRD(5); SBAR(); GAPA(C1=MF32(kf[3],qr[1],C1),   P0[14],P0[15],P1[0],P1[1],   pw1[2]=PKW(P0,12),pw1[3]=PKW(P0,14), pw1); \
    VRD(2); SBAR(); GAPA(C0=MF32(kf[4],qr[2],C0),   P1[2],P1[3],P1[4],P1[5],     pw2[0]=PKW(P1,0), pw2[1]=PKW(P1,2), pw2); \
    VRD(6); SBAR(); GAPA(C1=MF32(kf[5],qr[2],C1),   P1[6],P1[7],P1[8],P1[9],     pw2[2]=PKW(P1,4), pw2[3]=PKW(P1,6), pw2); \
    VRD(3); SBAR(); GAPA(C0=MF32(kf[6],qr[3],C0),   P1[10],P1[11],P1[12],P1[13], pw3[0]=PKW(P1,8), pw3[1]=PKW(P1,10), pw3); \
    VRD(7); SBAR(); GAPA(C1=MF32(kf[7],qr[3],C1),   P1[14],P1[15],0.f,0.f,       pw3[2]=PKW(P1,12),pw3[3]=PKW(P1,14), pw3); \
    l_reg+=sacc; \
    if(GK){DMA_K((t)+3,sl_cur);} if(GV){DMA_V((t)+1,sl_next);} \
    CMASK(C0,C1,t); \
    SBAR(); \
    VRD2(0); GAPB(o[0]=MF32(PAF(0),VFR(0),o[0]), C0,0); \
    VRD2(4); GAPB(o[1]=MF32(PAF(0),VFR(4),o[1]), C0,2); \
    VRD2(1); GAPB(o[0]=MF32(PAF(1),VFR(1),o[0]), C0,4); \
    VRD2(5); GAPB(o[1]=MF32(PAF(1),VFR(5),o[1]), C0,6); \
    VRD2(2); GAPB(o[0]=MF32(PAF(2),VFR(2),o[0]), C0,8); \
    VRD2(6); GAPB(o[1]=MF32(PAF(2),VFR(6),o[1]), C0,10); \
    VRD2(3); GAPB(o[0]=MF32(PAF(3),VFR(3),o[0]), C0,12); \
    VRD2(7); GAPB(o[1]=MF32(PAF(3),VFR(7),o[1]), C0,14); \
    GAPB(o[2]=MF32(PAF(0),VFR2(0),o[2]), C1,0); \
    GAPB(o[3]=MF32(PAF(0),VFR2(4),o[3]), C1,2); \
    KRD(GL,0); GAPB(o[2]=MF32(PAF(1),VFR2(1),o[2]), C1,4); \
    KRD(GL,1); GAPB(o[3]=MF32(PAF(1),VFR2(5),o[3]), C1,6); \
    KRD(GL,2); GAPB(o[2]=MF32(PAF(2),VFR2(2),o[2]), C1,8); \
    KRD(GL,3); GAPB(o[3]=MF32(PAF(2),VFR2(6),o[3]), C1,10); \
    GAPB(o[2]=MF32(PAF(3),VFR2(3),o[2]), C1,12); \
    GAPB(o[3]=MF32(PAF(3),VFR2(7),o[3]), C1,14); \
    }while(0)
  int t=1;
  #undef CMASK
  #define CMASK(P0,P1,t) do{}while(0)
  for(;t+5<NT;t+=2){
    STEP(pB0,pB1,pA0,pA1,t,true,true,true);     WAIT_BAR(3); RESC(); ROT();
    STEP(pA0,pA1,pB0,pB1,t+1,true,true,true);   WAIT_BAR(3); RESC(); ROT();
  }
  #undef CMASK
  #define CMASK(P0,P1,t) do{int jb_=(t)-(NT-4); if(jb_>=0)cmask(P0,P1,jb_,qrel,hi);}while(0)
  #define ENDW(tt) do{ if((tt)+3<NT){WAIT_BAR(3);} else if((tt)+2<NT){WAIT_BAR(2);} else {WAIT_BAR(0);} }while(0)
  for(;t+1<NT;t+=2){
    STEP(pB0,pB1,pA0,pA1,t,(t+3<NT),(t+1<NT),(t+1<NT));       ENDW(t);   RESC(); ROT();
    STEP(pA0,pA1,pB0,pB1,t+1,(t+4<NT),(t+2<NT),(t+2<NT));     ENDW(t+1); RESC(); ROT();
  }
  STEP(pB0,pB1,pA0,pA1,NT-1,false,false,false); RESC();
  { float sacc=pB0[0]+pB0[1]; _Pragma("unroll") for(int r=2;r<16;++r)sacc+=pB0[r]; _Pragma("unroll") for(int r=0;r<16;++r)sacc+=pB1[r]; l_reg+=sacc;
    pw0=(u32x4){PKW(pB0,0),PKW(pB0,2),PKW(pB0,4),PKW(pB0,6)};pw1=(u32x4){PKW(pB0,8),PKW(pB0,10),PKW(pB0,12),PKW(pB0,14)};pw2=(u32x4){PKW(pB1,0),PKW(pB1,2),PKW(pB1,4),PKW(pB1,6)};pw3=(u32x4){PKW(pB1,8),PKW(pB1,10),PKW(pB1,12),PKW(pB1,14)};
    SBAR(); pv128(o,vb0+2*sl_cur,PAF(0),PAF(1),PAF(2),PAF(3)); }
  #undef PKW
  #undef PAF
  #undef VFR
  #undef VFR2
  #undef PIN
  #undef MX3
  #undef GAPA
  #undef GAPB
  #undef EX
  #undef VRD
  #undef VRD2
  #undef KRD
  #undef MF32
  #undef STEP
  #undef ENDW
  {auto rr=__builtin_amdgcn_permlane32_swap(__float_as_uint(l_reg),__float_as_uint(l_reg),false,false);l_reg=__uint_as_float(rr[0])+__uint_as_float(rr[1]);}
  if(hi==0)wsf[32+r32]=l_reg;asm volatile("s_waitcnt lgkmcnt(0)":::"memory");
  float rli[16];
  #pragma unroll
  for(int r=0;r<16;++r)rli[r]=__builtin_amdgcn_rcpf(wsf[32+crow(r,hi)]);
  asm volatile("s_waitcnt lgkmcnt(0)\n\ts_barrier":::"memory");
  bf16*Ow=O+(long)(q0+wid*QBLK)*OP;
  { bf16*stg=(bf16*)(shm)+wid*4096;
    #pragma unroll
    for(int r=0;r<16;++r){const int orow=crow(r,hi);
      #pragma unroll
      for(int d0=0;d0<4;++d0)stg[orow*128+d0*32+r32]=__float2bfloat16(o[d0][r]*rli[r]);}
    asm volatile("s_waitcnt lgkmcnt(0)":::"memory");
    #pragma unroll
    for(int i=0;i<8;++i){const int row=i*4+(lane>>4),ch=lane&15; const u32x4 v=*(const u32x4*)(stg+row*128+ch*8); ATTN_STORE16(Ow+(long)row*OP+ch*8,v);} }
  asm volatile("s_waitcnt lgkmcnt(0)\n\ts_barrier":::"memory");
  #undef DMA_K
  #undef DMA_V
  #undef CMASK
  #undef RESC
  #undef ROT
}
constexpr int ATTN_LDS_BYTES=LDS_BYTES;
#undef SBAR
#undef WAIT_BAR
}
#ifndef REPEAT_PHASE
#define REPEAT_PHASE -1
#endif
constexpr int NWAVES = 8;
using cfg::T; using cfg::SEQ; using cfg::D; using cfg::NIN; using cfg::NE; using cfg::EPS; using cfg::MAXROWS;

constexpr size_t MiB = 1u << 20;
constexpr size_t WS_CTL = 0, CTL_ZERO_BYTES = 1 * MiB;
constexpr size_t WS_RCOS = 1 * MiB, WS_RSIN = 2 * MiB;
constexpr size_t WS_TKE = 3 * MiB, WS_TKP = WS_TKE + 256 * 1024, WS_TKG = WS_TKP + 256 * 1024, WS_TSLOT = WS_TKG + 256 * 1024;
constexpr size_t WS_RGATE = 4 * MiB;
constexpr size_t WS_BLKBASE = 4 * MiB + 512 * 1024;
constexpr size_t WS_SSQ = 5 * MiB;
constexpr size_t WS_WIN = 8 * MiB;
constexpr size_t WS_WBR = 23 * MiB;
constexpr size_t WS_WOUT = 26 * MiB;
constexpr size_t WS_WGU = 28 * MiB;
constexpr size_t WS_WDN = 156 * MiB;
constexpr size_t WS_HN = 220 * MiB;
constexpr size_t WS_KVM = 254 * MiB;
constexpr size_t WS_Q = 256 * MiB, WS_K = 272 * MiB, WS_V = 288 * MiB, WS_U = 304 * MiB, WS_CB = 320 * MiB, WS_MQ = 336 * MiB;
constexpr size_t WS_GATES = 352 * MiB;
constexpr size_t WS_OMAPS = 448 * MiB;
constexpr size_t WS_YALL = 480 * MiB;
constexpr size_t WS_MERGED = 528 * MiB;
constexpr size_t WS_H2 = 560 * MiB;
constexpr size_t WS_XS = 256 * MiB;
constexpr size_t WS_ACT = 400 * MiB;
constexpr size_t WS_HN8 = 576 * MiB;
constexpr size_t WS_WG8 = 592 * MiB;
constexpr size_t WS_END = 596 * MiB;
static_assert(WS_XS + (size_t)MAXROWS * 2048 <= WS_ACT && WS_ACT + (size_t)MAXROWS * 2048 <= WS_H2, "MoE overlays");
constexpr int CW_QUEUE = 1024;
constexpr int CW_GCNT = 64;
constexpr int CW_BAR = 4096;
constexpr int RING_OFF = 0, RING_BYTES = 131072;
constexpr int LDSCTL_OFF = RING_BYTES, MISC_OFF = LDSCTL_OFF + 320;
constexpr int L_PREFT = LDSCTL_OFF + 1024, L_PSTART = L_PREFT + 256, L_LCNT = L_PSTART + 256, L_LBASE = L_LCNT + 128;
constexpr int L_PART = LDSCTL_OFF + 8192;
constexpr int L_WSF = LDSCTL_OFF + 4096;
constexpr int LDS_BYTES = 163840;
constexpr int CONV_SLOTS = LDSCTL_OFF;

struct NoHooks { __device__ __forceinline__ void a_ready(const pg8::Unit&) const {} __device__ __forceinline__ void done(const pg8::Unit&) const {} };
struct ProjOrder : NoHooks {
    const char* A; const char* Bt; int G, c;
    __device__ __forceinline__ bool next(int i, pg8::Unit& u) const {
        const int L = i * G + c; int pm, pn;
        if (L < 64 * 14) pg8::static_map(L, 64, 14, pm, pn); else if (L < 64 * 14 + 8) { pm = 64 + ((L - 64 * 14) >> 2); pn = 26 + ((L - 64 * 14) & 3); } else return false;
        u.pm = pm; u.pn = pn; u.aux = 0; u.a = A + (size_t)pm * (256 * 2048); u.b = Bt + (size_t)pn * (256 * 2048); return true; }
};
struct GateOrder : NoHooks {
    const char* A; const char* Bt; int G, c;
    __device__ __forceinline__ bool next(int i, pg8::Unit& u) const {
        const int L = i * G + c; if (L >= 64 * 12) return false; int pm, pn; pg8::static_map(L, 64, 12, pm, pn);
        u.pm = pm; u.pn = pn; u.aux = 0; u.a = A + (size_t)pm * (256 * 1024); u.b = Bt + (size_t)pn * (256 * 1024); return true; }
};
struct MergeOrder : NoHooks {
    const char* Y; const char* Bt; int G, c;
    __device__ __forceinline__ bool next(int i, pg8::Unit& u) const {
        const int j = i / 3, br = i - 3 * j; const int L = j * G + c; if (L >= 256) return false; int pm, pn; pg8::static_map(L, 64, 4, pm, pn);
        u.pm = pm; u.pn = pn; u.aux = br; u.a = Y + (size_t)pm * (256 * 3072) + br * 1024; u.b = Bt + (size_t)(br * 1024 + pn * 256) * 1024; return true; }
};
struct OutOrder : NoHooks {
    const char* A; const char* Bt; int G, c;
    __device__ __forceinline__ bool next(int i, pg8::Unit& u) const {
        const int L = i * G + c; if (L >= 256) return false; int pm, pn; pg8::static_map(L, 64, 4, pm, pn);
        u.pm = pm; u.pn = pn; u.aux = 0; u.a = A + (size_t)pm * (256 * 2048); u.b = Bt + (size_t)pn * (256 * 2048); return true; }
};
struct MoeOrder : NoHooks {
    const char* A; const char* Bt; const volatile __attribute__((address_space(3))) int* prefT; int ncol, G, c; size_t tile_bytes;
    __device__ __forceinline__ bool next(int i, pg8::Unit& u) const {
        const int L = i * G + c; const int rt = L / ncol, pnl = L - rt * ncol; if (rt >= prefT[32]) return false;
        int e = 0; while (prefT[e + 1] <= rt) ++e;
        u.pm = rt; u.pn = e * ncol + pnl; u.aux = e; u.a = A + (size_t)rt * tile_bytes; u.b = Bt + (size_t)(e * ncol + pnl) * tile_bytes; return true; }
};

#define GAS __attribute__((address_space(1)))
#define LAS __attribute__((address_space(3)))
typedef unsigned short bf16;
typedef unsigned v4u __attribute__((ext_vector_type(4)));
typedef unsigned v2u __attribute__((ext_vector_type(2)));
typedef float f32x4 __attribute__((ext_vector_type(4)));
typedef float f32x16 __attribute__((ext_vector_type(16)));
typedef short bf16x8 __attribute__((ext_vector_type(8)));
typedef GAS unsigned gu32;
#define RLX_AGENT __ATOMIC_RELAXED, __HIP_MEMORY_SCOPE_AGENT
#define LDS_WAIT() asm volatile("s_waitcnt lgkmcnt(0)" ::: "memory")
#define VM_WAIT() asm volatile("s_waitcnt vmcnt(0)" ::: "memory")
__device__ __forceinline__ unsigned f2bf(float f) { unsigned u = __builtin_bit_cast(unsigned, f); return (u + 0x7fffu + ((u >> 16) & 1u)) >> 16; }
__device__ __forceinline__ unsigned pk2(float lo, float hi) { return f2bf(lo) | (f2bf(hi) << 16); }
__device__ __forceinline__ float bflo(unsigned w) { return __uint_as_float(w << 16); }
__device__ __forceinline__ float bfhi(unsigned w) { return __uint_as_float(w & 0xffff0000u); }
__device__ __forceinline__ float wave_sum(float v) {
#pragma unroll
    for (int o = 1; o < 64; o <<= 1) v += __shfl_xor(v, o);
    return v;
}

#define XB_TMO      128
#define XB_XCNT(j)  (256  + 64 * (j))
#define XB_XSUB(j)  (1280 + 64 * (j))
#define XB_XGEN(j)  (2304 + 64 * (j))
#define XB_TOP      3328
#define XB_TOPGEN   3392
#define XCD_BAR_WORDS 3456
#define XB_SPIN_CAP (1u << 18)

__device__ __forceinline__ unsigned xb_ld(unsigned* p)              { return __hip_atomic_load(p, __ATOMIC_RELAXED, __HIP_MEMORY_SCOPE_AGENT); }
__device__ __forceinline__ unsigned xb_add(unsigned* p, unsigned v) { return __hip_atomic_fetch_add(p, v, __ATOMIC_RELAXED, __HIP_MEMORY_SCOPE_AGENT); }
__device__ __forceinline__ unsigned xb_xcc_id() { return (unsigned)__builtin_amdgcn_s_getreg((3 << 11) | 20) & 0xFu; }
#define XB_SPIN(cond, bar) do { unsigned _sp = 0; while (cond) { __builtin_amdgcn_s_sleep(1); \
    if ((++_sp & 255u) == 0u) { if (xb_ld(&(bar)[XB_TMO])) break; if (_sp > XB_SPIN_CAP) { atomicAdd(&(bar)[XB_TMO], 1u); break; } } } } while (0)

struct XcdBarrier {
    unsigned* bar; unsigned x;
    volatile LAS unsigned* st;
};

__device__ __forceinline__ XcdBarrier xcd_barrier_post(unsigned* bar, volatile LAS unsigned* st) {
    XcdBarrier b; b.bar = bar; b.x = xb_xcc_id(); b.st = st;
    if (threadIdx.x == 0) (void)xb_add(&bar[XB_XCNT(b.x)], 1u);
    return b;
}
__device__ __forceinline__ void xcd_barrier_complete(unsigned* bar, unsigned x, unsigned& nloc, unsigned& nx) {
    const unsigned G = gridDim.x * gridDim.y * gridDim.z;
    unsigned sum, cnt, mine, sp = 0u;
    for (;;) {
        sum = 0u; cnt = 0u; mine = 0u;
#pragma unroll
        for (unsigned j = 0; j < 16; ++j) { const unsigned c = xb_ld(&bar[XB_XCNT(j)]); sum += c; cnt += (c > 0u) ? 1u : 0u; mine = (j == x) ? c : mine; }
        if (sum == G) break;
        __builtin_amdgcn_s_sleep(1);
        if ((++sp & 255u) == 0u) { if (xb_ld(&bar[XB_TMO])) break; if (sp > XB_SPIN_CAP) { atomicAdd(&bar[XB_TMO], 1u); break; } }
    }
    nloc = mine > 0u ? mine : 1u; nx = cnt > 0u ? cnt : 1u;
}

__device__ __forceinline__ void xcd_barrier(const XcdBarrier& b) {
    asm volatile("s_waitcnt vmcnt(0)" ::: "memory");
    __syncthreads();
    if (threadIdx.x == 0) {
        unsigned* bar = b.bar;
        __builtin_amdgcn_s_waitcnt(0);
        unsigned nloc = b.st[0], nx = b.st[1];
        if (nloc == 0u) { xcd_barrier_complete(bar, b.x, nloc, nx); b.st[0] = nloc; b.st[1] = nx; }
        const unsigned old = xb_add(&bar[XB_XSUB(b.x)], 1u);
        const unsigned gen = old / nloc;
        if (old + 1u == (gen + 1u) * nloc) {
            __builtin_amdgcn_fence(__ATOMIC_RELEASE, "agent");
            asm volatile("s_waitcnt vmcnt(0)" ::: "memory");
            const unsigned og = xb_add(&bar[XB_TOP], 1u);
            const unsigned tg = og / nx;
            if (og + 1u == (tg + 1u) * nx) xb_add(&bar[XB_TOPGEN], 1u);
            else XB_SPIN(xb_ld(&bar[XB_TOPGEN]) == tg, bar);
            __builtin_amdgcn_fence(__ATOMIC_ACQUIRE, "agent");
            xb_add(&bar[XB_XGEN(b.x)], 1u);
            asm volatile("s_waitcnt vmcnt(0)" ::: "memory");
        } else {
            XB_SPIN(xb_ld(&bar[XB_XGEN(b.x)]) == gen, bar);
            __builtin_amdgcn_fence(__ATOMIC_ACQUIRE, "agent");
            asm volatile("s_waitcnt vmcnt(0)" ::: "memory");
        }
    }
    __syncthreads();
}

struct Args { const float* in[25]; float* out; unsigned char* ws; int ph_lo, ph_hi; };
__device__ __forceinline__ int ip32(int r) { return 16 * ((r >> 2) & 1) + 4 * (r >> 3) + (r & 3); }
__device__ __forceinline__ void p0_transpose_item(const float* W, int ldn, int K, bf16* WT, int k0, int n0, int dst_row_base, bool perm, LAS float* scr, int lane) {
    float rr_[32];
#pragma unroll
    for (int i = 0; i < 32; ++i) rr_[i] = W[(size_t)(k0 + 2 * i + (lane >> 5)) * ldn + n0 + (lane & 31)];
#pragma unroll
    for (int i = 0; i < 32; ++i) scr[(2 * i + (lane >> 5)) * 33 + (lane & 31)] = rr_[i];
    LDS_WAIT(); asm volatile("" ::: "memory");
    const int c = lane & 7;
#pragma unroll
    for (int j = 0; j < 4; ++j) { const int n = (lane >> 3) + 8 * j; const LAS float* s = scr + (8 * c) * 33 + n;
        v4u o; o.x = pk2(s[0 * 33], s[1 * 33]); o.y = pk2(s[2 * 33], s[3 * 33]); o.z = pk2(s[4 * 33], s[5 * 33]); o.w = pk2(s[6 * 33], s[7 * 33]);
        *(GAS v4u*)(WT + (size_t)(dst_row_base + (perm ? ip32(n) : n)) * K + k0 + 8 * c) = o; }
    LDS_WAIT(); asm volatile("" ::: "memory");
}
__device__ __forceinline__ void p0_f8_load(float (&rr_)[32], const float* W, int ldn, int k0, int n0, int lane) {
#pragma unroll
    for (int i = 0; i < 8; ++i) { const f32x4 v = __builtin_nontemporal_load((const f32x4*)(W + (size_t)(k0 + 8 * i + (lane >> 3)) * ldn + n0 + (lane & 7) * 4));
        rr_[4 * i] = v.x; rr_[4 * i + 1] = v.y; rr_[4 * i + 2] = v.z; rr_[4 * i + 3] = v.w; }
}
__device__ __forceinline__ void p0_f8_finish(const float (&rr_)[32], int K, unsigned char* WT, int k0, int dst_row_base, LAS float* scr, int lane) {
#pragma unroll
    for (int i = 0; i < 8; ++i) { LAS float* sp = scr + (8 * i + (lane >> 3)) * 33 + (lane & 7) * 4; sp[0] = rr_[4 * i]; sp[1] = rr_[4 * i + 1]; sp[2] = rr_[4 * i + 2]; sp[3] = rr_[4 * i + 3]; }
    LDS_WAIT(); asm volatile("" ::: "memory");
    const int n = lane >> 1, hf = lane & 1; const LAS float* s = scr + (32 * hf) * 33 + n;
    v4u o0, o1;
    o0.x = pg8::pk4_fp8(32.f * s[0 * 33], 32.f * s[1 * 33], 32.f * s[2 * 33], 32.f * s[3 * 33]); o0.y = pg8::pk4_fp8(32.f * s[4 * 33], 32.f * s[5 * 33], 32.f * s[6 * 33], 32.f * s[7 * 33]);
    o0.z = pg8::pk4_fp8(32.f * s[8 * 33], 32.f * s[9 * 33], 32.f * s[10 * 33], 32.f * s[11 * 33]); o0.w = pg8::pk4_fp8(32.f * s[12 * 33], 32.f * s[13 * 33], 32.f * s[14 * 33], 32.f * s[15 * 33]);
    o1.x = pg8::pk4_fp8(32.f * s[16 * 33], 32.f * s[17 * 33], 32.f * s[18 * 33], 32.f * s[19 * 33]); o1.y = pg8::pk4_fp8(32.f * s[20 * 33], 32.f * s[21 * 33], 32.f * s[22 * 33], 32.f * s[23 * 33]);
    o1.z = pg8::pk4_fp8(32.f * s[24 * 33], 32.f * s[25 * 33], 32.f * s[26 * 33], 32.f * s[27 * 33]); o1.w = pg8::pk4_fp8(32.f * s[28 * 33], 32.f * s[29 * 33], 32.f * s[30 * 33], 32.f * s[31 * 33]);
    GAS v4u* dp = (GAS v4u*)(WT + (size_t)(dst_row_base + ip32(n)) * K + k0 + 32 * hf);
    dp[0] = o0; dp[1] = o1;
    LDS_WAIT(); asm volatile("" ::: "memory");
}
__device__ __forceinline__ void conv_drain(pg8::ConvCtx& c, LAS unsigned char* lds, int wave, int lane) {
    asm volatile("s_waitcnt vmcnt(0)" ::: "memory");
    if (c.sub >= 0) { pg8::conv_finish(c, lds, c.slot0, lane, c.sub); c.sub = -1; }
    __syncthreads();
    const unsigned base = (unsigned)(RING_OFF + wave * 16384);
    int sub[4], aft[4];
#pragma unroll
    for (int i = 0; i < 4; ++i) { sub[i] = -1; aft[i] = 0; }
#pragma unroll
    for (int i = 0; i < 4; ++i) { const int s = c.cw + c.nseq * c.jn;
        if (s < pg8::CONV_NSUB) { pg8::conv_issue(c, lds, base + i * 4096, lane, s); sub[i] = s; ++c.jn;
#pragma unroll
            for (int k = 0; k < 4; ++k) aft[k] += 4;
            aft[i] = 0; } }
    for (;;) {
        bool any = false;
#pragma unroll
        for (int i = 0; i < 4; ++i) {
            if (sub[i] < 0) continue;
            any = true;
            const int a = aft[i];
            if (a >= 15) asm volatile("s_waitcnt vmcnt(15)" ::: "memory"); else if (a >= 12) asm volatile("s_waitcnt vmcnt(12)" ::: "memory");
            else if (a >= 8) asm volatile("s_waitcnt vmcnt(8)" ::: "memory"); else if (a >= 4) asm volatile("s_waitcnt vmcnt(4)" ::: "memory"); else asm volatile("s_waitcnt vmcnt(0)" ::: "memory");
            pg8::conv_finish(c, lds, base + i * 4096, lane, sub[i]); sub[i] = -1;
#pragma unroll
            for (int k = 0; k < 4; ++k) aft[k] += 1;
            const int s = c.cw + c.nseq * c.jn;
            if (s < pg8::CONV_NSUB) { pg8::conv_issue(c, lds, base + i * 4096, lane, s); sub[i] = s; ++c.jn;
#pragma unroll
                for (int k = 0; k < 4; ++k) aft[k] += 4;
                aft[i] = 0; }
        }
        if (!any) break;
    }
}
__device__ __forceinline__ int win_group_base(int L0) {
    if (L0 < 1024) { const int l = L0 & 255; return (L0 & ~255) + 128 * ((l >> 5) & 1) + 32 * (l >> 6); }
    if (L0 < 1536) return L0;
    if (L0 < 2048) return L0 - 1536 + 2560;
    if (L0 < 3072) { const int which = L0 >= 2560, ch = (L0 - 2048) & 511; return 256 * (6 + (ch >> 7)) + 128 * which + 32 * ((ch >> 5) & 3); }
    return L0;
}
__device__ __forceinline__ void rms_row_to_bf16(const float* xrow, const float* g, bf16* orow, int lane, unsigned char* orow8 = nullptr) {
    const GAS f32x4* xr = (const GAS f32x4*)xrow + lane; const GAS f32x4* gr = (const GAS f32x4*)g + lane;
    f32x4 v[4]; float s = 0.f;
#pragma unroll
    for (int j = 0; j < 4; ++j) { v[j] = xr[64 * j]; s += (v[j].x * v[j].x + v[j].y * v[j].y) + (v[j].z * v[j].z + v[j].w * v[j].w); }
    const float r = 1.0f / sqrtf(wave_sum(s) * (1.0f / 1024.0f) + EPS);
    GAS unsigned long long* o8 = (GAS unsigned long long*)orow + lane;
#pragma unroll
    for (int j = 0; j < 4; ++j) { const f32x4 gg = gr[64 * j]; o8[64 * j] = (unsigned long long)pk2(v[j].x * r * gg.x, v[j].y * r * gg.y) | ((unsigned long long)pk2(v[j].z * r * gg.z, v[j].w * r * gg.w) << 32);
        if (orow8) ((GAS unsigned*)orow8)[64 * j + lane] = pg8::pk4_fp8(v[j].x * r * gg.x, v[j].y * r * gg.y, v[j].z * r * gg.z, v[j].w * r * gg.w); }
}


__device__ __forceinline__ void p0_prologue(const Args& a, LAS unsigned char* lds, int vcu, int G, int wave, int lane, int tid) {
    LAS float* scr = (LAS float*)(lds + RING_OFF + wave * 16384);
    const int gw = vcu * NWAVES + wave, NGW = G * NWAVES;
    unsigned char* ws = a.ws;
    constexpr int I_IN = 16 * 112, I_G8 = 16 * 96, I_KV = 16 * 32, I_BR = 3 * 8 * 32, I_OUT = 16 * 32;
    constexpr int NITEMS = I_IN + I_G8 + I_KV + I_BR + I_OUT;
    for (int it = gw; it < NITEMS; it += NGW) {
        int r = it;
        if (r < I_IN) { const int kb = r / 112, nb = r % 112; p0_transpose_item(a.in[3], NIN, 1024, (bf16*)(ws + WS_WIN), 64 * kb, 32 * nb, win_group_base(32 * nb), true, scr, lane); continue; } r -= I_IN;
        if (r < I_G8) { const int kb = r / 96, nb = r % 96; float rr8[32]; p0_f8_load(rr8, a.in[3], NIN, 64 * kb, 3584 + 32 * nb, lane); p0_f8_finish(rr8, 1024, ws + WS_WG8, 64 * kb, 32 * nb, scr, lane); continue; } r -= I_G8;
        if (r < I_KV) { const int kb = r / 32, nb = r % 32; p0_transpose_item(a.in[13], 1024, 1024, (bf16*)(ws + WS_WIN), 64 * kb, 32 * nb, 6656 + 32 * nb, true, scr, lane); continue; } r -= I_KV;
        if (r < I_BR) { const int br = r / 256, q = r % 256, kb = q / 32, nb = q % 32; p0_transpose_item(a.in[16] + (size_t)br * 512 * 1024, 1024, 512, (bf16*)(ws + WS_WBR), 64 * kb, 32 * nb, br * 1024 + 32 * nb, true, scr, lane); continue; } r -= I_BR;
        { const int kb = r / 32, nb = r % 32; p0_transpose_item(a.in[17], 1024, 1024, (bf16*)(ws + WS_WOUT), 64 * kb, 32 * nb, 32 * nb, true, scr, lane); }
    }
    bf16* HN = (bf16*)(ws + WS_HN);
    for (int m = gw; m < T + 512; m += NGW) {
        if (m < T) rms_row_to_bf16(a.in[0] + (size_t)m * D, a.in[2], HN + (size_t)m * D, lane, ws + WS_HN8 + (size_t)m * D);
        else rms_row_to_bf16(a.in[1] + (size_t)(m - T) * D, a.in[12], HN + (size_t)m * D, lane);
    }
    float* rc = (float*)(ws + WS_RCOS); float* rs = (float*)(ws + WS_RSIN);
    for (int i = gw * 64 + lane; i < SEQ * 32; i += NGW * 64) { const int pos = i >> 5, f = i & 31;
        const float inv_freq = 1.0f / powf(10000.0f, (float)(2 * f) / 64.0f); const float ang = (float)pos * inv_freq; rc[i] = cosf(ang); rs[i] = sinf(ang); }
}

__device__ __forceinline__ void phase_finish(const Args& a, int vcu, int G, int wave, int lane) {
    unsigned char* ws = a.ws; const int gw = vcu * NWAVES + wave, NGW = G * NWAVES;
    const bf16* OM = (const bf16*)(ws + WS_OMAPS); const bf16* U = (const bf16*)(ws + WS_U); const bf16* CB = (const bf16*)(ws + WS_CB); bf16* Y = (bf16*)(ws + WS_YALL);
    const float lam = expf(wave_sum(a.in[6][lane] * a.in[7][lane])) - expf(wave_sum(a.in[8][lane] * a.in[9][lane])) + 0.2f;
    const int hh = lane >> 4, c8 = (lane & 15) * 8;
    f32x4 gs0 = *(const f32x4*)(a.in[10] + c8), gs1 = *(const f32x4*)(a.in[10] + c8 + 4);
    f32x4 w0a = *(const f32x4*)(a.in[11] + lane * 8), w0b = *(const f32x4*)(a.in[11] + lane * 8 + 4);
    f32x4 w1a = *(const f32x4*)(a.in[11] + 512 + lane * 8), w1b = *(const f32x4*)(a.in[11] + 512 + lane * 8 + 4);
    f32x4 w2a = *(const f32x4*)(a.in[11] + 1024 + lane * 8), w2b = *(const f32x4*)(a.in[11] + 1024 + lane * 8 + 4);
    for (int t = gw; t < T; t += NGW) {
        {
            const v4u o0 = *(const v4u*)(OM + (size_t)t * 1024 + hh * 256 + c8), o1 = *(const v4u*)(OM + (size_t)t * 1024 + hh * 256 + 128 + c8);
            const f32x4 a0 = pg8::unpk_lo(o0) - lam * pg8::unpk_lo(o1), a1 = pg8::unpk_hi(o0) - lam * pg8::unpk_hi(o1);
            float ss = ((a0[0] * a0[0] + a0[1] * a0[1]) + (a0[2] * a0[2] + a0[3] * a0[3])) + ((a1[0] * a1[0] + a1[1] * a1[1]) + (a1[2] * a1[2] + a1[3] * a1[3]));
            ss += __shfl_xor(ss, 1); ss += __shfl_xor(ss, 2); ss += __shfl_xor(ss, 4); ss += __shfl_xor(ss, 8);
            const float r = 0.8f / sqrtf(ss * (1.0f / 128.0f) + EPS);
            *(v4u*)(Y + (size_t)t * 1536 + hh * 128 + c8) = pg8::pack8(a0 * gs0 * r, a1 * gs1 * r);
        }
        {
            const int s = t & (SEQ - 1); const v4u z = {0u, 0u, 0u, 0u};
            const v4u u0 = *(const v4u*)(U + (size_t)t * 512 + lane * 8);
            const v4u u1 = s >= 1 ? *(const v4u*)(U + (size_t)(t - 1) * 512 + lane * 8) : z;
            const v4u u2 = s >= 2 ? *(const v4u*)(U + (size_t)(t - 2) * 512 + lane * 8) : z;
            const v4u cb = *(const v4u*)(CB + (size_t)t * 512 + lane * 8);
            const f32x4 ya = pg8::unpk_lo(cb) * (w0a * pg8::unpk_lo(u2) + w1a * pg8::unpk_lo(u1) + w2a * pg8::unpk_lo(u0));
            const f32x4 yb = pg8::unpk_hi(cb) * (w0b * pg8::unpk_hi(u2) + w1b * pg8::unpk_hi(u1) + w2b * pg8::unpk_hi(u0));
            *(v4u*)(Y + (size_t)t * 1536 + 512 + lane * 8) = pg8::pack8(ya, yb);
        }
    }
}

#define DPPF(x, ctrl) __uint_as_float(__builtin_amdgcn_update_dpp(0u, __float_as_uint(x), (ctrl), 0xf, 0xf, false))
__device__ __forceinline__ float lane_xor32(float x, int lane) { auto r = __builtin_amdgcn_permlane32_swap(__float_as_uint(x), __float_as_uint(x), false, false); return __uint_as_float((lane & 32) ? r[0] : r[1]); }
__device__ __forceinline__ float lane_xor16(float x, int lane) { auto r = __builtin_amdgcn_permlane16_swap(__float_as_uint(x), __float_as_uint(x), false, false); return __uint_as_float((lane & 16) ? r[0] : r[1]); }
__device__ __forceinline__ float wave_sum_fast(float v, int lane) {
    v += DPPF(v, 0xb1); v += DPPF(v, 0x4e); v += DPPF(v, 0x141); v += DPPF(v, 0x140); v += lane_xor16(v, lane); v += lane_xor32(v, lane); return v; }
__device__ __forceinline__ void router_pick(float (&p)[32], int t, float bias, int lane_in, LAS unsigned char* lds, int* tk_e, int* tk_p, float* tk_g) {
    int lane = lane_in; asm volatile("" : "+v"(lane));
#define RSTEP(HN, MASK, XCHG) _Pragma("unroll") for (int i = 0; i < HN; ++i) { const bool up = (lane & MASK) != 0; const float keep = up ? p[i + HN] : p[i]; const float send = up ? p[i] : p[i + HN]; p[i] = keep + XCHG; }
    RSTEP(16, 32, lane_xor32(send, lane)) RSTEP(8, 16, lane_xor16(send, lane)) RSTEP(4, 8, DPPF(send, 0x140)) RSTEP(2, 4, DPPF(send, 0x141)) RSTEP(1, 2, DPPF(send, 0x4e))
#undef RSTEP
    const float logit = p[0] + DPPF(p[0], 0xb1) + bias;
    float val = (lane & 1) ? -INFINITY : logit;
    float tv[4]; int te[4];
#pragma unroll
    for (int r = 0; r < 4; ++r) {
        float m = val;
        m = fmaxf(m, DPPF(m, 0xb1)); m = fmaxf(m, DPPF(m, 0x4e)); m = fmaxf(m, DPPF(m, 0x141)); m = fmaxf(m, DPPF(m, 0x140)); m = fmaxf(m, lane_xor16(m, lane)); m = fmaxf(m, lane_xor32(m, lane));
        const unsigned long long bal = __ballot(val == m);
        const int first = __builtin_ctzll(bal);
        tv[r] = __uint_as_float(__builtin_amdgcn_readfirstlane(__float_as_uint(m))); te[r] = first >> 1;
        val = (lane == first) ? -INFINITY : val;
    }
    const float e1 = expf(tv[1] - tv[0]), e2 = expf(tv[2] - tv[0]), e3 = expf(tv[3] - tv[0]);
    const float is = 1.0f / (1.0f + e1 + e2 + e3);
    if (lane < 4) { const int e = (lane == 0) ? te[0] : (lane == 1) ? te[1] : (lane == 2) ? te[2] : te[3];
        const float gate = (lane == 0) ? is : (lane == 1) ? e1 * is : (lane == 2) ? e2 * is : e3 * is;
        const int lp = __hip_atomic_fetch_add((LAS int*)(lds + L_LCNT) + e, 1, __ATOMIC_RELAXED, __HIP_MEMORY_SCOPE_WORKGROUP);
        tk_e[t * 4 + lane] = e; tk_p[t * 4 + lane] = lp; tk_g[t * 4 + lane] = gate; }
}

__device__ __forceinline__ void phase_router(const Args& a, LAS unsigned char* lds, int vcu, int G, int wave, int lane, int tid, int dummy) {
    unsigned char* ws = a.ws; const int gw = vcu * NWAVES + wave, NGW = G * NWAVES;
    LAS float* Wt = (LAS float*)(lds + RING_OFF);
    volatile LAS int* lcnt = (volatile LAS int*)(lds + L_LCNT);
    const float* wr = a.in[19];
    const float* x1 = a.out;
    f32x4 vn[2][4];
#pragma unroll
    for (int q = 0; q < 2; ++q) { const GAS f32x4* xr = (const GAS f32x4*)(x1 + (size_t)(gw + q * NGW) * D) + lane;
#pragma unroll
        for (int j = 0; j < 4; ++j) vn[q][j] = xr[64 * j]; }
    { f32x4 wf[16];
#pragma unroll
      for (int i = 0; i < 16; ++i) wf[i] = *(const f32x4*)(wr + (size_t)(lane + 64 * i) * 32 + 4 * wave);
#pragma unroll
      for (int i = 0; i < 16; ++i) { const int d = lane + 64 * i;
          Wt[(4 * wave + 0) * 1024 + d] = wf[i].x; Wt[(4 * wave + 1) * 1024 + d] = wf[i].y; Wt[(4 * wave + 2) * 1024 + d] = wf[i].z; Wt[(4 * wave + 3) * 1024 + d] = wf[i].w; } }
    if (tid < 32) lcnt[tid] = 0;
    __syncthreads();
    const float* g = a.in[18]; unsigned char* H2 = ws + WS_H2;
    int* tk_e = (int*)(ws + WS_TKE); int* tk_p = (int*)(ws + WS_TKP); float* tk_g = (float*)(ws + WS_TKG);
    LAS unsigned char* ldsc = lds;
    const float bias = a.in[20][lane >> 1];
    const GAS f32x4* gr = (const GAS f32x4*)g + lane;
    for (int tb = gw; tb < T; tb += 2 * NGW) {
        f32x4 v[2][4];
#pragma unroll
        for (int q = 0; q < 2; ++q)
#pragma unroll
            for (int j = 0; j < 4; ++j) v[q][j] = vn[q][j];
        if (tb + 2 * NGW < T) {
#pragma unroll
            for (int q = 0; q < 2; ++q) { const GAS f32x4* xr = (const GAS f32x4*)(x1 + (size_t)(tb + 2 * NGW + q * NGW) * D) + lane;
#pragma unroll
                for (int j = 0; j < 4; ++j) vn[q][j] = xr[64 * j]; } }
#pragma unroll
        for (int q = 0; q < 2; ++q) { float s = 0.f;
#pragma unroll
            for (int j = 0; j < 4; ++j) s += (v[q][j].x * v[q][j].x + v[q][j].y * v[q][j].y) + (v[q][j].z * v[q][j].z + v[q][j].w * v[q][j].w);
            const float r = 1.0f / sqrtf(wave_sum_fast(s, lane) * (1.0f / 1024.0f) + EPS);
            GAS unsigned* o4 = (GAS unsigned*)(H2 + (size_t)(tb + q * NGW) * D) + lane;
#pragma unroll
            for (int j = 0; j < 4; ++j) { const f32x4 gg = gr[64 * j]; v[q][j].x *= r * gg.x; v[q][j].y *= r * gg.y; v[q][j].z *= r * gg.z; v[q][j].w *= r * gg.w;
                o4[64 * j] = pg8::pk4_fp8(v[q][j].x, v[q][j].y, v[q][j].z, v[q][j].w); } }
        float p0[32], p1[32];
#pragma unroll
        for (int e = 0; e < 32; ++e) { p0[e] = 0.f; p1[e] = 0.f; }
        for (int ps_ = 0; ps_ < (REPEAT_PHASE == 22 ? 2 : 1); ++ps_) {
        f32x4 w[4], wn[4];
        const LAS float* Wl = Wt + 4 * lane; asm volatile("" : "+v"(Wl));
#pragma unroll
        for (int j = 0; j < 4; ++j) w[j] = *(const LAS f32x4*)(Wl + 256 * j);
#pragma unroll
        for (int e = 0; e < 32; ++e) {
            if (e + 1 < 32) {
#pragma unroll
                for (int j = 0; j < 4; ++j) wn[j] = *(const LAS f32x4*)(Wl + (e + 1) * 1024 + 256 * j); }
            asm volatile("" ::: "memory"); __builtin_amdgcn_sched_barrier(0);
            { float a0 = 0.f, a1 = 0.f, b0 = 0.f, b1 = 0.f;
#pragma unroll
              for (int j = 0; j < 4; ++j) { a0 = fmaf(v[0][j].x, w[j].x, a0); a1 = fmaf(v[0][j].y, w[j].y, a1); a0 = fmaf(v[0][j].z, w[j].z, a0); a1 = fmaf(v[0][j].w, w[j].w, a1);
                                            b0 = fmaf(v[1][j].x, w[j].x, b0); b1 = fmaf(v[1][j].y, w[j].y, b1); b0 = fmaf(v[1][j].z, w[j].z, b0); b1 = fmaf(v[1][j].w, w[j].w, b1); }
              p0[e] += a0 + a1; p1[e] += b0 + b1; asm volatile("" : "+v"(p0[e]), "+v"(p1[e])); }
#pragma unroll
            for (int j = 0; j < 4; ++j) w[j] = wn[j];
        }
        }
        if (REPEAT_PHASE == 22) {
#pragma unroll
            for (int e = 0; e < 32; ++e) { p0[e] *= 0.5f; p1[e] *= 0.5f; } }
        router_pick(p0, tb, bias, lane, ldsc, tk_e, tk_p, tk_g);
        router_pick(p1, tb + NGW, bias, lane, ldsc, tk_e, tk_p, tk_g);
    }
    __syncthreads();
    if (tid < 32) ((int*)(ws + WS_BLKBASE))[(dummy ? 8192 : 0) + vcu * 32 + tid] = lcnt[tid];
    __syncthreads();
}

__device__ __forceinline__ void moe_plan(unsigned char* ws, LAS unsigned char* lds, int tid, int vcu, int G) {
    volatile LAS int* prefT = (volatile LAS int*)(lds + L_PREFT); volatile LAS int* pstart = (volatile LAS int*)(lds + L_PSTART); volatile LAS int* lbase = (volatile LAS int*)(lds + L_LBASE);
    volatile LAS int* part = (volatile LAS int*)(lds + L_PART);
    { const int e = tid & 31, pr = tid >> 5; const int* bc = (const int*)(ws + WS_BLKBASE); int tot = 0, pre = 0;
      for (int b = pr; b < G; b += 16) { const int c = bc[b * 32 + e]; tot += c; pre += (b < vcu) ? c : 0; }
      part[pr * 32 + e] = tot; part[512 + pr * 32 + e] = pre; }
    __syncthreads();
    if (tid < 64) { int nt = 0;
        if (tid < 32) { int tot = 0, pre = 0;
#pragma unroll
            for (int pr = 0; pr < 16; ++pr) { tot += part[pr * 32 + tid]; pre += part[512 + pr * 32 + tid]; }
            lbase[tid] = pre; nt = (tot + 255) >> 8; }
        int inc = nt;
#pragma unroll
        for (int o = 1; o < 32; o <<= 1) { const int y = __shfl_up(inc, o); if ((tid & 63) >= o) inc += y; }
        if (tid < 32) { prefT[tid] = inc - nt; pstart[tid] = (inc - nt) * 256; if (tid == 31) { prefT[32] = inc; pstart[32] = inc * 256; }
            if (vcu == 0) { int* gp = (int*)(ws + WS_BLKBASE) + 16384; gp[tid] = inc - nt; if (tid == 31) gp[32] = inc; } } }
    __syncthreads();
}
__device__ __forceinline__ void moe_plan_load(unsigned char* ws, LAS unsigned char* lds, int tid) {
    volatile LAS int* prefT = (volatile LAS int*)(lds + L_PREFT);
    if (tid < 33) prefT[tid] = ((const int*)(ws + WS_BLKBASE))[16384 + tid];
    __syncthreads();
}

__device__ __forceinline__ void phase_dispatch(const Args& a, LAS unsigned char* lds, int vcu, int G, int wave, int lane, int tid) {
    unsigned char* ws = a.ws; const int gw = vcu * NWAVES + wave, NGW = G * NWAVES;
    volatile LAS int* pstart = (volatile LAS int*)(lds + L_PSTART); volatile LAS int* lbase = (volatile LAS int*)(lds + L_LBASE);
    moe_plan(ws, lds, tid, vcu, G);
    const unsigned char* H2 = ws + WS_H2; unsigned char* XS = ws + WS_XS;
    const int* tk_e = (const int*)(ws + WS_TKE); const int* tk_p = (const int*)(ws + WS_TKP); const float* tk_g = (const float*)(ws + WS_TKG);
    int* tslot = (int*)(ws + WS_TSLOT); float* rgate = (float*)(ws + WS_RGATE);
    for (int t = gw; t < T; t += NGW) {
        int slot = 0;
        if (lane < 4) { const int e = tk_e[t * 4 + lane]; slot = pstart[e] + lbase[e] + tk_p[t * 4 + lane]; rgate[slot] = tk_g[t * 4 + lane]; tslot[t * 4 + lane] = slot; }
        const v4u r0 = *(const v4u*)(H2 + (size_t)t * D + lane * 16);
#pragma unroll
        for (int k = 0; k < 4; ++k) { const int sk = __builtin_amdgcn_readlane(slot, k); *(v4u*)(XS + (size_t)sk * D + lane * 16) = r0; }
    }
}

__device__ __forceinline__ void phase_combine(const Args& a, int vcu, int G, int wave, int lane, float* dst_out) {
    unsigned char* ws = a.ws; const int gw = vcu * NWAVES + wave, NGW = G * NWAVES;
    const unsigned char* YS = ws + WS_XS; const int* tslot = (const int*)(ws + WS_TSLOT); float* out = a.out;
    for (int t = gw; t < T; t += NGW) {
        int slot = 0; if (lane < 4) slot = tslot[t * 4 + lane];
        const float* op = out + (size_t)t * D + lane * 16; f32x4 o[4];
#pragma unroll
        for (int j = 0; j < 4; ++j) o[j] = *(const f32x4*)(op + 4 * j);
#pragma unroll
        for (int k = 0; k < 4; ++k) { const int sk = __builtin_amdgcn_readlane(slot, k); const v4u y = *(const v4u*)(YS + (size_t)sk * D + lane * 16); const unsigned yw[4] = {y.x, y.y, y.z, y.w};
#pragma unroll
            for (int j = 0; j < 4; ++j) { const auto lo = __builtin_amdgcn_cvt_pk_f32_fp8((int)yw[j], false), hi = __builtin_amdgcn_cvt_pk_f32_fp8((int)yw[j], true);
                o[j][0] += lo[0] * 0.0625f; o[j][1] += lo[1] * 0.0625f; o[j][2] += hi[0] * 0.0625f; o[j][3] += hi[1] * 0.0625f; } }
        float* wp = dst_out + (size_t)t * D + lane * 16;
#pragma unroll
        for (int j = 0; j < 4; ++j) *(f32x4*)(wp + 4 * j) = o[j];
    }
}

__device__ __forceinline__ void memattn_unit(const Args& a, LAS unsigned char* lds, int b, int h, int qb, int wid, int lane, int tid) {
    unsigned char* ws = a.ws;
    const bf16* KVM = (const bf16*)(ws + WS_KVM); const bf16* MQ = (const bf16*)(ws + WS_MQ); const float* ssq = (const float*)(ws + WS_SSQ); bf16* Y = (bf16*)(ws + WS_YALL);
    LAS unsigned char* Ks = lds + RING_OFF;
    LAS unsigned char* Vs = lds + RING_OFF + 65536;
    const int r32 = lane & 31, hi = lane >> 5;
    const size_t qrow = (size_t)b * SEQ + (size_t)qb * 256 + wid * 32 + r32;
    bf16x8 qf[8];
#pragma unroll
    for (int ks = 0; ks < 8; ++ks) qf[ks] = *(const bf16x8*)(MQ + qrow * 512 + h * 128 + 16 * ks + 8 * hi);
    const f32x4 sq = *(const f32x4*)(ssq + qrow * 16 + h * 4);
    {
        const int m = tid >> 1, hf = tid & 1;
        const bf16* kr = KVM + (size_t)(b * 256 + m) * 1024 + h * 128 + hf * 64; const bf16* vr = kr + 512;
        v4u raw[8], vraw[8]; float ss = 0.f;
#pragma unroll
        for (int i = 0; i < 8; ++i) { raw[i] = *(const v4u*)(kr + 8 * i); vraw[i] = *(const v4u*)(vr + 8 * i); }
#pragma unroll
        for (int i = 0; i < 8; ++i) { const f32x4 x0 = pg8::unpk_lo(raw[i]), x1 = pg8::unpk_hi(raw[i]);
            ss += ((x0[0] * x0[0] + x0[1] * x0[1]) + (x0[2] * x0[2] + x0[3] * x0[3])) + ((x1[0] * x1[0] + x1[1] * x1[1]) + (x1[2] * x1[2] + x1[3] * x1[3])); }
        ss += __shfl_xor(ss, 1);
        const float r = 1.0f / sqrtf(ss * (1.0f / 128.0f) + EPS);
#pragma unroll
        for (int i = 0; i < 8; ++i) { const int d0 = hf * 64 + 8 * i; const f32x4 g0 = *(const f32x4*)(a.in[15] + d0) * *(const f32x4*)(a.in[14] + d0), g1 = *(const f32x4*)(a.in[15] + d0 + 4) * *(const f32x4*)(a.in[14] + d0 + 4);
            const int c = hf * 8 + i;
            *(LAS v4u*)(Ks + m * 256 + ((c ^ (m & 15)) << 4)) = pg8::pack8(pg8::unpk_lo(raw[i]) * g0 * r, pg8::unpk_hi(raw[i]) * g1 * r); }
        LAS unsigned char* vt = Vs + (m >> 6) * 16384 + ((m >> 4) & 3) * 1024 + (m & 15) * 64;
#pragma unroll
        for (int i = 0; i < 8; ++i) *(LAS v4u*)(vt + (2 * hf + (i >> 2)) * 4096 + (i & 3) * 16) = vraw[i];
    }
    __syncthreads();
    const float sc = (1.0f / sqrtf(((sq[0] + sq[1]) + (sq[2] + sq[3])) * (1.0f / 128.0f) + EPS)) * 0.08838834764831845f * 1.4426950408889634f;
    f32x16 o[4]; float l = 0.f;
#pragma unroll
    for (int d0 = 0; d0 < 4; ++d0) o[d0] = f32x16{};
    const int vb0 = (int)(unsigned)(uintptr_t)(lds + RING_OFF + 65536) + ((lane >> 4) & 1) * 32 + (lane & 3) * 8 + (4 * hi + ((lane & 15) >> 2)) * 64;
#pragma unroll 1
    for (int kt = 0; kt < 4; ++kt) {
        f32x16 p0 = f32x16{}, p1 = f32x16{};
#pragma unroll
        for (int ks = 0; ks < 8; ++ks) { const int c = 2 * ks + hi; const int k0 = 64 * kt + r32, k1 = k0 + 32;
            const bf16x8 f0 = *(const LAS bf16x8*)(Ks + k0 * 256 + ((c ^ (k0 & 15)) << 4)), f1 = *(const LAS bf16x8*)(Ks + k1 * 256 + ((c ^ (k1 & 15)) << 4));
            p0 = __builtin_amdgcn_mfma_f32_32x32x16_bf16(f0, qf[ks], p0, 0, 0, 0); p1 = __builtin_amdgcn_mfma_f32_32x32x16_bf16(f1, qf[ks], p1, 0, 0, 0); }
#pragma unroll
        for (int r = 0; r < 16; ++r) { p0[r] = __builtin_amdgcn_exp2f(p0[r] * sc); p1[r] = __builtin_amdgcn_exp2f(p1[r] * sc); l += p0[r] + p1[r]; }
        v4u pw[4];
        pw[0] = (v4u){pg8::cvt_pk_bf16(p0[0], p0[1]), pg8::cvt_pk_bf16(p0[2], p0[3]), pg8::cvt_pk_bf16(p0[4], p0[5]), pg8::cvt_pk_bf16(p0[6], p0[7])};
        pw[1] = (v4u){pg8::cvt_pk_bf16(p0[8], p0[9]), pg8::cvt_pk_bf16(p0[10], p0[11]), pg8::cvt_pk_bf16(p0[12], p0[13]), pg8::cvt_pk_bf16(p0[14], p0[15])};
        pw[2] = (v4u){pg8::cvt_pk_bf16(p1[0], p1[1]), pg8::cvt_pk_bf16(p1[2], p1[3]), pg8::cvt_pk_bf16(p1[4], p1[5]), pg8::cvt_pk_bf16(p1[6], p1[7])};
        pw[3] = (v4u){pg8::cvt_pk_bf16(p1[8], p1[9]), pg8::cvt_pk_bf16(p1[10], p1[11]), pg8::cvt_pk_bf16(p1[12], p1[13]), pg8::cvt_pk_bf16(p1[14], p1[15])};
        attn_body::pv128(o, vb0 + kt * 16384, __builtin_bit_cast(bf16x8, pw[0]), __builtin_bit_cast(bf16x8, pw[1]), __builtin_bit_cast(bf16x8, pw[2]), __builtin_bit_cast(bf16x8, pw[3]));
    }
    l += __shfl_xor(l, 32);
    LAS float* wsf = (LAS float*)(lds + L_WSF) + wid * 64;
    if (hi == 0) wsf[r32] = l;
    __syncthreads();
    LAS bf16* stg = (LAS bf16*)(lds + RING_OFF) + wid * 4096;
#pragma unroll
    for (int r = 0; r < 16; ++r) { const int orow = (r & 3) + 8 * (r >> 2) + 4 * hi; const float il = 1.0f / wsf[orow];
#pragma unroll
        for (int d0 = 0; d0 < 4; ++d0) stg[orow * 128 + d0 * 32 + r32] = (bf16)f2bf(o[d0][r] * il); }
    LDS_WAIT();
    bf16* Yw = Y + ((size_t)b * SEQ + (size_t)qb * 256 + wid * 32) * 1536 + 1024 + h * 128;
#pragma unroll
    for (int i = 0; i < 8; ++i) { const int row = i * 4 + (lane >> 4), ch = lane & 15; const v4u v = *(const LAS v4u*)(stg + row * 128 + ch * 8); *(v4u*)(Yw + (size_t)row * 1536 + ch * 8) = v; }
    __syncthreads();
}

__global__ void __launch_bounds__(NWAVES * 64, 2) mega_fwd(Args args) {
    extern __shared__ __attribute__((aligned(16))) unsigned char lds_raw[];
    LAS unsigned char* lds = (LAS unsigned char*)lds_raw;
    volatile LAS unsigned* MISC = (volatile LAS unsigned*)(lds + MISC_OFF);
    int tid = threadIdx.x, lane = tid & 63, wave = __builtin_amdgcn_readfirstlane(tid >> 6);
#define PHASE_LOCALS() do { tid = threadIdx.x; asm volatile("" : "+v"(tid)); lane = tid & 63; wave = __builtin_amdgcn_readfirstlane(tid >> 6); } while (0)
    const int G = gridDim.x; const int bx = blockIdx.x; const int vcu = (G % 8 == 0) ? (bx % 8) * (G / 8) + bx / 8 : bx;
    unsigned char* ws = args.ws;
    gu32* ctl = (gu32*)(ws + WS_CTL);
    for (int u = tid; u < (LDS_BYTES - LDSCTL_OFF) / 4; u += NWAVES * 64) ((LAS unsigned*)(lds + LDSCTL_OFF))[u] = 0u;
    __syncthreads();
    const int ph_lo = args.ph_lo, ph_hi = args.ph_hi;
    XcdBarrier bar; bar.bar = (unsigned*)(ctl + CW_BAR); bar.x = 0; bar.st = nullptr;
    if (ph_hi - ph_lo > 1) bar = xcd_barrier_post((unsigned*)(ctl + CW_BAR), MISC + 8);
#define IN(k) (ph_lo <= (k) && (k) < ph_hi)
#ifndef TS_PHASE
#define TS_PHASE -1
#endif
    unsigned long long* const ts = (unsigned long long*)(ws + WS_CTL + 512 * 1024);
#define STAMP(k) do { if (TS_PHASE >= 0 && bx == 0 && threadIdx.x == 0) ts[(k)] = __builtin_amdgcn_s_memrealtime(); } while (0)
#define GRID_BAR(k) do { if (IN(k) && IN((k) + 1)) xcd_barrier(bar); STAMP((k) + 1); } while (0)
    STAMP(0);

    if (IN(0)) { for (int rep_ = 0; rep_ < (REPEAT_PHASE == 0 ? 2 : 1); ++rep_) { if (rep_) xcd_barrier(bar);
    PHASE_LOCALS();
    p0_prologue(args, lds, vcu, G, wave, lane, tid);
    } }
    GRID_BAR(0);

    if (IN(1)) { for (int rep_ = 0; rep_ < (REPEAT_PHASE == 1 ? 2 : 1); ++rep_) { if (rep_) xcd_barrier(bar);
    PHASE_LOCALS();
    {
        pg8::Gemm g{2048u, 2048u, 1024};
        ProjOrder S; S.A = (const char*)(ws + WS_HN); S.Bt = (const char*)(ws + WS_WIN); S.G = G; S.c = bx;
        pg8::EpiProj E{(bf16*)(ws + WS_Q), (bf16*)(ws + WS_K), (bf16*)(ws + WS_V), (bf16*)(ws + WS_U), (bf16*)(ws + WS_CB), (bf16*)(ws + WS_MQ), (bf16*)(ws + WS_GATES), (bf16*)(ws + WS_KVM),
                       (float*)(ws + WS_SSQ), args.in[4], args.in[5], (const float*)(ws + WS_RCOS), (const float*)(ws + WS_RSIN)};
        const unsigned sv0 = __builtin_amdgcn_readfirstlane(MISC[8]), sv1 = __builtin_amdgcn_readfirstlane(MISC[9]);
        __syncthreads();
        pg8::ConvCtx cx; cx.wgu = args.in[21]; cx.wdn = args.in[23]; cx.ogu = ws + WS_WGU; cx.odn = ws + WS_WDN; cx.cw = bx * NWAVES + wave; cx.nseq = NWAVES * G; cx.jn = 0;
        cx.sub = -1; cx.slot0 = (unsigned)(CONV_SLOTS + wave * 4096);
        pg8::gemm_phase<pg8::EpiProj, ProjOrder, true, true, true>(lds + RING_OFF, g, S, E, &cx);
        { pg8::Gemm g8{1024u, 1024u, 512}; GateOrder S8; S8.A = (const char*)(ws + WS_HN8); S8.Bt = (const char*)(ws + WS_WG8); S8.G = G; S8.c = bx;
          pg8::EpiGates8 E8{ws + WS_GATES};
          pg8::gemm_phase_f8<pg8::EpiGates8, GateOrder, true, true, true>(lds + RING_OFF, g8, S8, E8, &cx); }
        conv_drain(cx, lds, wave, lane);
        __syncthreads();
        for (int u = tid; u < (LDS_BYTES - LDSCTL_OFF) / 4; u += NWAVES * 64) ((LAS unsigned*)(lds + LDSCTL_OFF))[u] = 0u;
        __syncthreads();
        if (tid == 0) { MISC[8] = sv0; MISC[9] = sv1; }
        __syncthreads();
    }
    } }
    GRID_BAR(1);

    if (IN(2)) { for (int rep_ = 0; rep_ < (REPEAT_PHASE == 2 ? 2 : 1); ++rep_) { if (rep_) xcd_barrier(bar);
    PHASE_LOCALS();
    {
        const int cmb = vcu >> 4, s = vcu & 15;
        const int b = cmb >> 3, h = (cmb >> 1) & 3, mp = cmb & 1;
        const attn_body::bf16* Qp = (const attn_body::bf16*)(ws + WS_Q) + (size_t)b * SEQ * 512 + (h * 2 + mp) * 64;
        const attn_body::bf16* Kp = (const attn_body::bf16*)(ws + WS_K) + (size_t)b * SEQ * 512 + (h * 2 + mp) * 64;
        const attn_body::bf16* Vp = (const attn_body::bf16*)(ws + WS_V) + (size_t)b * SEQ * 512 + h * 128;
        attn_body::bf16* Op = (attn_body::bf16*)(ws + WS_OMAPS) + (size_t)b * SEQ * 1024 + (h * 2 + mp) * 128;
#pragma unroll 1
        for (int i = 0; i < 2; ++i) { const int qb = (i == 0) ? s : 31 - s;
            attn_body::attn_unit128<8>(qb, Qp, Kp, Vp, Op, (char*)lds_raw + RING_OFF); }
        memattn_unit(args, lds, vcu >> 7, (vcu >> 5) & 3, vcu & 31, wave, lane, tid);
        if (REPEAT_PHASE == 21) memattn_unit(args, lds, vcu >> 7, (vcu >> 5) & 3, vcu & 31, wave, lane, tid);
    }
    } }
    GRID_BAR(2);

    if (IN(3)) { for (int rep_ = 0; rep_ < (REPEAT_PHASE == 3 ? 2 : 1); ++rep_) { if (rep_) xcd_barrier(bar);
    PHASE_LOCALS();
    phase_finish(args, vcu, G, wave, lane);
    } }
    GRID_BAR(3);

    if (REPEAT_PHASE == 20) { for (int i_ = 0; i_ < 10; ++i_) xcd_barrier(bar); }
    if (IN(4)) { for (int rep_ = 0; rep_ < (REPEAT_PHASE == 4 ? 2 : 1); ++rep_) { if (rep_) xcd_barrier(bar);
    PHASE_LOCALS();
    {
        pg8::Gemm g{3072u, 1024u, 512};
        MergeOrder S; S.Y = (const char*)(ws + WS_YALL); S.Bt = (const char*)(ws + WS_WBR); S.G = G; S.c = bx;
        pg8::EpiMerge E{(const bf16*)(ws + WS_GATES), (bf16*)(ws + WS_MERGED)};
        pg8::gemm_phase<pg8::EpiMerge, MergeOrder, true, true>(lds + RING_OFF, g, S, E);
    }
    } }
    GRID_BAR(4);

    if (IN(5)) { for (int rep_ = 0; rep_ < (REPEAT_PHASE == 5 ? 2 : 1); ++rep_) { if (rep_) xcd_barrier(bar);
    PHASE_LOCALS();
    {
        pg8::Gemm g{2048u, 2048u, 1024};
        OutOrder S; S.A = (const char*)(ws + WS_MERGED); S.Bt = (const char*)(ws + WS_WOUT); S.G = G; S.c = bx;
        pg8::EpiResid E{args.in[0], args.out};
        pg8::gemm_phase<pg8::EpiResid, OutOrder, false, true>(lds + RING_OFF, g, S, E);
    }
    } }
    GRID_BAR(5);

    if (IN(6)) { for (int rep_ = 0; rep_ < (REPEAT_PHASE == 6 ? 2 : 1); ++rep_) { if (rep_) xcd_barrier(bar);
    PHASE_LOCALS();
    phase_router(args, lds, vcu, G, wave, lane, tid, rep_ == 0 && REPEAT_PHASE == 6);
    } }
    GRID_BAR(6);

    if (IN(7)) { for (int rep_ = 0; rep_ < (REPEAT_PHASE == 7 ? 2 : 1); ++rep_) { if (rep_) xcd_barrier(bar);
    PHASE_LOCALS();
    phase_dispatch(args, lds, vcu, G, wave, lane, tid);
    } }
    GRID_BAR(7);

    if (IN(8)) { for (int rep_ = 0; rep_ < (REPEAT_PHASE == 8 ? 2 : 1); ++rep_) { if (rep_) xcd_barrier(bar);
    PHASE_LOCALS();
    {
        pg8::Gemm g{1024u, 1024u, 512};
        moe_plan_load(ws, lds, tid);
        MoeOrder S; S.A = (const char*)(ws + WS_XS); S.Bt = (const char*)(ws + WS_WGU); S.prefT = (const volatile LAS int*)(lds + L_PREFT); S.ncol = 8; S.G = G; S.c = vcu; S.tile_bytes = 256 * 1024;
        pg8::EpiSwiglu E{args.in[22], ws + WS_ACT};
        pg8::gemm_phase_f8<pg8::EpiSwiglu, MoeOrder, true, true>(lds + RING_OFF, g, S, E);
    }
    } }
    GRID_BAR(8);

    if (IN(9)) { for (int rep_ = 0; rep_ < (REPEAT_PHASE == 9 ? 2 : 1); ++rep_) { if (rep_) xcd_barrier(bar);
    PHASE_LOCALS();
    {
        pg8::Gemm g{1024u, 1024u, 512};
        moe_plan_load(ws, lds, tid);
        MoeOrder S; S.A = (const char*)(ws + WS_ACT); S.Bt = (const char*)(ws + WS_WDN); S.prefT = (const volatile LAS int*)(lds + L_PREFT); S.ncol = 4; S.G = G; S.c = vcu; S.tile_bytes = 256 * 1024;
        pg8::EpiDown E{args.in[24], (const float*)(ws + WS_RGATE), ws + WS_XS};
        pg8::gemm_phase_f8<pg8::EpiDown, MoeOrder, true, true>(lds + RING_OFF, g, S, E);
    }
    } }
    GRID_BAR(9);

    if (IN(10)) { for (int rep_ = 0; rep_ < 1; ++rep_) { if (rep_) xcd_barrier(bar);
    PHASE_LOCALS();
    if (REPEAT_PHASE == 10) { phase_combine(args, vcu, G, wave, lane, (float*)(ws + WS_WGU)); xcd_barrier(bar); }
    phase_combine(args, vcu, G, wave, lane, args.out);
    } }
    GRID_BAR(10);

    if (TS_PHASE >= 0) {
        STAMP(11); xcd_barrier(bar);
        const unsigned long long t0 = __hip_atomic_load(ts + (TS_PHASE == 11 ? 0 : TS_PHASE), RLX_AGENT), t1 = __hip_atomic_load(ts + (TS_PHASE == 11 ? 11 : TS_PHASE + 1), RLX_AGENT);
        const float v = (float)(t1 - t0) * (TS_PHASE == 11 ? 1e-4f : 1e-3f);
        for (size_t i = (size_t)bx * 512 + threadIdx.x; i < (size_t)T * D; i += (size_t)G * 512) args.out[i] = v;
    }
#undef GRID_BAR
#undef IN
}

extern "C" void kernel_launch(void* const* d_in, const int* in_sizes, int n_in, void* d_out, int out_size, void* d_ws, size_t ws_size, hipStream_t stream) {
    static int grid = 0;
    if (grid == 0) {
        if (n_in != 25 || out_size != T * D || ws_size < WS_END) { fprintf(stderr, "kernel_launch: unexpected problem shape (n_in %d, out %d, ws %zu)\n", n_in, out_size, ws_size); grid = -1; return; }
        int dev = 0, cus = 0;
        if (hipGetDevice(&dev) != hipSuccess || hipDeviceGetAttribute(&cus, hipDeviceAttributeMultiprocessorCount, dev) != hipSuccess) { grid = -1; return; }
        if (hipFuncSetAttribute((const void*)mega_fwd, hipFuncAttributeMaxDynamicSharedMemorySize, LDS_BYTES) != hipSuccess) { fprintf(stderr, "kernel_launch: hipFuncSetAttribute failed\n"); grid = -1; return; }
        int per_cu = 0;
        if (hipOccupancyMaxActiveBlocksPerMultiprocessor(&per_cu, (const void*)mega_fwd, NWAVES * 64, LDS_BYTES) != hipSuccess || per_cu < 1) fprintf(stderr, "kernel_launch: occupancy query says %d\n", per_cu);
        (void)hipGetLastError();
        grid = cus;
        if (grid != 256) fprintf(stderr, "kernel_launch: built for 256 CUs, device has %d\n", grid);
    }
    if (grid < 0) return;
    if (hipMemsetAsync((char*)d_ws + WS_CTL, 0, CTL_ZERO_BYTES, stream) != hipSuccess) return;
    Args a{};
    for (int i = 0; i < 25; ++i) a.in[i] = (const float*)d_in[i];
    a.out = (float*)d_out; a.ws = (unsigned char*)d_ws;
#ifndef MK_PER_PHASE
#define MK_PER_PHASE 0
#endif
    if (MK_PER_PHASE) { for (int k = 0; k < 11; ++k) { a.ph_lo = k; a.ph_hi = k + 1; hipLaunchKernelGGL(mega_fwd, dim3(grid), dim3(NWAVES * 64), LDS_BYTES, stream, a); } }
    else { a.ph_lo = 0; a.ph_hi = 11; hipLaunchKernelGGL(mega_fwd, dim3(grid), dim3(NWAVES * 64), LDS_BYTES, stream, a); }
}
```

```cpp
#include <hip/hip_runtime.h>
#include <hip/hip_bf16.h>
#include <cstdio>
#include <cstdint>
#include <cmath>

namespace cfg {
constexpr int BATCH = 2, SEQ = 8192, T = BATCH * SEQ, D = 1024, NIN = 6656, NE = 32, NMEM = 256;
constexpr int MAXROWS = 65536 + NE * 256;
constexpr float EPS = 1e-6f;
constexpr float C2 = 0.125f * 1.4426950408889634f;
}

namespace pg8 {
#define PG8_LAS __attribute__((address_space(3)))
typedef unsigned short bf16_t;
typedef short bf16x8 __attribute__((ext_vector_type(8)));
typedef float f32x4 __attribute__((ext_vector_type(4)));
typedef unsigned u32x4 __attribute__((ext_vector_type(4)));
typedef unsigned u32x2 __attribute__((ext_vector_type(2)));
constexpr int BM = 256, BK = 64, HALF = 128, HTB = HALF * BK * 2  , STAGE_BYTES = 8 * HTB, NXCD = 8, WGM = 8;

__host__ __device__ __forceinline__ int lds_byte(int r, int c) { const int st = (r >> 4) * 2 + (c >> 5), rr = r & 15, cc = c & 31, ob = rr * 64 + cc * 2; return st * 1024 + (ob ^ (((ob >> 9) & 1) << 5)); }
__host__ __device__ __forceinline__ void stage_rc(int b, int& R, int& C) { const int st = b / 1024, sb = b % 1024, swz = sb ^ (((sb >> 9) & 1) << 5); R = (st >> 1) * 16 + swz / 64; C = (st & 1) * 32 + (swz % 64) / 2; }

struct Unit { int pm, pn, aux; const char* a; const char* b; };
struct Gemm { unsigned lda, ldb; int K; };

__device__ __forceinline__ void static_map(int L, int nM, int nN, int& pm, int& pn) {
    const int nwg = nM * nN; int wgid = L; { const int q = nwg / NXCD, r = nwg % NXCD, xcd = wgid % NXCD, off = wgid / NXCD; wgid = (xcd < r ? xcd * (q + 1) : r * (q + 1) + (xcd - r) * q) + off; }
    const int nig = WGM * nN, gid = wgid / nig, fm = gid * WGM, gsz = (nM - fm) < WGM ? (nM - fm) : WGM;
    pm = fm + ((wgid % nig) % gsz); pn = (wgid % nig) / gsz;
}

typedef float f32x2_cv __attribute__((ext_vector_type(2))); typedef __bf16 bf16x2_cv __attribute__((ext_vector_type(2)));
__device__ __forceinline__ unsigned cvt_pk_bf16(float lo, float hi) { f32x2_cv v = {lo, hi}; bf16x2_cv b = __builtin_convertvector(v, bf16x2_cv); return __builtin_bit_cast(unsigned, b); }
__device__ __forceinline__ u32x4 pack8(const f32x4 v0, const f32x4 v1) { u32x4 w; w.x = cvt_pk_bf16(v0[0], v0[1]); w.y = cvt_pk_bf16(v0[2], v0[3]); w.z = cvt_pk_bf16(v1[0], v1[1]); w.w = cvt_pk_bf16(v1[2], v1[3]); return w; }
__device__ __forceinline__ f32x4 unpk_lo(const u32x4 w) { return (f32x4){__uint_as_float(w.x << 16), __uint_as_float(w.x & 0xffff0000u), __uint_as_float(w.y << 16), __uint_as_float(w.y & 0xffff0000u)}; }
__device__ __forceinline__ f32x4 unpk_hi(const u32x4 w) { return (f32x4){__uint_as_float(w.z << 16), __uint_as_float(w.z & 0xffff0000u), __uint_as_float(w.w << 16), __uint_as_float(w.w & 0xffff0000u)}; }
__device__ __forceinline__ unsigned pk4_fp8(float a, float b, float c, float d) { int w = 0; w = __builtin_amdgcn_cvt_pk_fp8_f32(a, b, w, false); w = __builtin_amdgcn_cvt_pk_fp8_f32(c, d, w, true); return (unsigned)w; }
__device__ __forceinline__ float sigmoidf_fast(float z) { return __builtin_amdgcn_rcpf(1.0f + __builtin_amdgcn_exp2f(-1.4426950408889634f * z)); }

using cfg::T; using cfg::SEQ; using cfg::EPS;

struct EpiProj {
    static constexpr bool AFTER_DRAIN = false;
    bf16_t *Q, *K, *V, *U, *CB, *MQ, *GATES, *KVM; float* ssq; const float *gq, *gk, *rcos, *rsin;
    __device__ __forceinline__ bool keep(const Unit&) const { return false; }
    __device__ __forceinline__ void operator()(f32x4 (&acc)[2][2][4][2], const Unit& u, int wr, int wc, int fr, int fq) const {
        const int pn = u.pn; const int row0 = u.pm * BM + wr * 64 + fr;
        if (pn < 4) {
            const bool isk = pn >= 2; const float* g = isk ? gk : gq; bf16_t* dst = (isk ? K : Q) + (pn & 1) * 256 + wc * 64 + 8 * fq;
            const float post = isk ? 1.0f : cfg::C2;
            f32x4 ga[2][2];
#pragma unroll
            for (int bj = 0; bj < 2; ++bj)
#pragma unroll
                for (int n = 0; n < 2; ++n) ga[bj][n] = *(const f32x4*)(g + 32 * bj + 8 * fq + 4 * n);
#pragma unroll
            for (int ai = 0; ai < 2; ++ai)
#pragma unroll
                for (int m = 0; m < 4; ++m) {
                    const int row = row0 + ai * HALF + m * 16;
                    float ss = 0.f;
#pragma unroll
                    for (int bj = 0; bj < 2; ++bj)
#pragma unroll
                        for (int n = 0; n < 2; ++n) { const f32x4 x = acc[ai][bj][m][n]; ss += (x[0] * x[0] + x[1] * x[1]) + (x[2] * x[2] + x[3] * x[3]); }
                    ss += __shfl_xor(ss, 16); ss += __shfl_xor(ss, 32);
                    const float rinv = __builtin_amdgcn_rsqf(ss * (1.0f / 64.0f) + EPS) * post;
                    const int pos = row & (SEQ - 1);
                    f32x4 o1[2], o2[2];
#pragma unroll
                    for (int n = 0; n < 2; ++n) {
                        const f32x4 c = *(const f32x4*)(rcos + pos * 32 + 8 * fq + 4 * n), s = *(const f32x4*)(rsin + pos * 32 + 8 * fq + 4 * n);
                        const f32x4 x1 = acc[ai][0][m][n] * ga[0][n] * rinv, x2 = acc[ai][1][m][n] * ga[1][n] * rinv;
                        o1[n] = x1 * c - x2 * s; o2[n] = x2 * c + x1 * s;
                    }
                    *(u32x4*)(dst + (size_t)row * 512) = pack8(o1[0], o1[1]);
                    *(u32x4*)(dst + (size_t)row * 512 + 32) = pack8(o2[0], o2[1]);
                }
        } else if (pn >= 6 && pn < 10) {
            bf16_t* dst = U + (pn - 6) * 128 + wc * 32 + 8 * fq;
#pragma unroll
            for (int ai = 0; ai < 2; ++ai)
#pragma unroll
                for (int m = 0; m < 4; ++m) { const int row = row0 + ai * HALF + m * 16;
                    *(u32x4*)(dst + (size_t)row * 512) = pack8(acc[ai][0][m][0] * acc[ai][1][m][0], acc[ai][0][m][1] * acc[ai][1][m][1]); }
        } else if (pn >= 14 && pn < 26) {
            unsigned char* dst = (unsigned char*)GATES + ((size_t)(u.pm * 12 + (pn - 14)) << 16) + (((wr * 4 + wc) * 64 + fq * 16 + fr) << 3);
#pragma unroll
            for (int ai = 0; ai < 2; ++ai)
#pragma unroll
                for (int m = 0; m < 4; ++m) {
#pragma unroll
                    for (int bj = 0; bj < 2; ++bj) { const f32x4 v0 = acc[ai][bj][m][0], v1 = acc[ai][bj][m][1]; unsigned q[8];
#pragma unroll
                        for (int e = 0; e < 4; ++e) { q[e] = (unsigned)(sigmoidf_fast(v0[e]) * 255.0f + 0.5f); q[4 + e] = (unsigned)(sigmoidf_fast(v1[e]) * 255.0f + 0.5f); }
                        u32x2 w8; w8.x = q[0] | (q[1] << 8) | (q[2] << 16) | (q[3] << 24); w8.y = q[4] | (q[5] << 8) | (q[6] << 16) | (q[7] << 24);
                        *(u32x2*)(dst + ((((ai * 4 + m) * 2 + bj) * 512) << 3)) = w8; } }
        } else {
            bf16_t* dst; int ld, rsub = 0; const bool ismq = (pn == 12 || pn == 13);
            if (pn < 6) { dst = V + (pn - 4) * 256; ld = 512; } else if (pn < 12) { dst = CB + (pn - 10) * 256; ld = 512; }
            else if (pn < 14) { dst = MQ + (pn - 12) * 256; ld = 512; } else { dst = KVM + (pn - 26) * 256; ld = 1024; rsub = T; }
            dst += wc * 32 + 8 * fq;
#pragma unroll
            for (int ai = 0; ai < 2; ++ai)
#pragma unroll
                for (int m = 0; m < 4; ++m) { const int row = row0 + ai * HALF + m * 16 - rsub;
#pragma unroll
                    for (int bj = 0; bj < 2; ++bj) { const f32x4 v0 = acc[ai][bj][m][0], v1 = acc[ai][bj][m][1];
                        *(u32x4*)(dst + (size_t)row * ld + bj * HALF) = pack8(v0, v1);
                        if (ismq) { float ss = ((v0[0] * v0[0] + v0[1] * v0[1]) + (v0[2] * v0[2] + v0[3] * v0[3])) + ((v1[0] * v1[0] + v1[1] * v1[1]) + (v1[2] * v1[2] + v1[3] * v1[3]));
                            ss += __shfl_xor(ss, 16); ss += __shfl_xor(ss, 32);
                            if (fq == 0) ssq[(size_t)row * 16 + ((pn - 12) * 2 + bj) * 4 + wc] = ss; } } }
        }
    }
};

struct EpiGates8 {
    static constexpr bool AFTER_DRAIN = false;
    unsigned char* GATES;
    __device__ __forceinline__ bool keep(const Unit&) const { return false; }
    __device__ __forceinline__ void operator()(f32x4 (&acc)[2][2][4][2], const Unit& u, int wr, int wc, int fr, int fq) const {
        {
            unsigned char* dst = (unsigned char*)GATES + ((size_t)(u.pm * 12 + u.pn) << 16) + (((wr * 4 + wc) * 64 + fq * 16 + fr) << 3);
#pragma unroll
            for (int ai = 0; ai < 2; ++ai)
#pragma unroll
                for (int m = 0; m < 4; ++m) {
#pragma unroll
                    for (int bj = 0; bj < 2; ++bj) { const f32x4 v0 = acc[ai][bj][m][0], v1 = acc[ai][bj][m][1]; unsigned q[8];
#pragma unroll
                        for (int e = 0; e < 4; ++e) { q[e] = (unsigned)(sigmoidf_fast(v0[e]) * 255.0f + 0.5f); q[4 + e] = (unsigned)(sigmoidf_fast(v1[e]) * 255.0f + 0.5f); }
                        u32x2 w8; w8.x = q[0] | (q[1] << 8) | (q[2] << 16) | (q[3] << 24); w8.y = q[4] | (q[5] << 8) | (q[6] << 16) | (q[7] << 24);
                        *(u32x2*)(dst + ((((ai * 4 + m) * 2 + bj) * 512) << 3)) = w8; } }
        }
    }
};

struct EpiMerge {
    static constexpr bool AFTER_DRAIN = false;
    const bf16_t* GATES; bf16_t* MERGED;
    __device__ __forceinline__ bool keep(const Unit& u) const { return u.aux < 2; }
    __device__ __forceinline__ void operator()(f32x4 (&acc)[2][2][4][2], const Unit& u, int wr, int wc, int fr, int fq) const {
        const int br = u.aux; const int row0 = u.pm * BM + wr * 64 + fr, col0 = u.pn * BM + wc * 32 + 8 * fq;
        const unsigned char* ga_p = (const unsigned char*)GATES + ((size_t)(u.pm * 12 + br * 4 + u.pn) << 16) + (((wr * 4 + wc) * 64 + fq * 16 + fr) << 3);
        const unsigned char* gb_p = ga_p + ((size_t)4 << 16);
        u32x2 gav[16], gbv[16];
#pragma unroll
        for (int i = 0; i < 16; ++i) gav[i] = __builtin_nontemporal_load((const u32x2*)(ga_p + ((i * 512) << 3)));
        if (br < 2) {
#pragma unroll
            for (int i = 0; i < 16; ++i) gbv[i] = __builtin_nontemporal_load((const u32x2*)(gb_p + ((i * 512) << 3))); }
        else {
#pragma unroll
            for (int i = 0; i < 16; ++i) gbv[i] = (u32x2){0u, 0u}; }
        __builtin_amdgcn_sched_barrier(0);
#pragma unroll
        for (int ai = 0; ai < 2; ++ai)
#pragma unroll
            for (int m = 0; m < 4; ++m) { const int row = row0 + ai * HALF + m * 16;
#pragma unroll
                for (int bj = 0; bj < 2; ++bj) { const u32x2 ga = gav[(ai * 4 + m) * 2 + bj];
                    f32x4 f0 = {(float)(ga.x & 255u), (float)((ga.x >> 8) & 255u), (float)((ga.x >> 16) & 255u), (float)(ga.x >> 24)}, f1 = {(float)(ga.y & 255u), (float)((ga.y >> 8) & 255u), (float)((ga.y >> 16) & 255u), (float)(ga.y >> 24)};
                    if (br < 2) { const u32x2 gb = gbv[(ai * 4 + m) * 2 + bj];
                        const f32x4 d0 = {(float)__builtin_elementwise_max(gb.x & 255u, 1u), (float)__builtin_elementwise_max((gb.x >> 8) & 255u, 1u), (float)__builtin_elementwise_max((gb.x >> 16) & 255u, 1u), (float)__builtin_elementwise_max(gb.x >> 24, 1u)};
                        const f32x4 d1 = {(float)__builtin_elementwise_max(gb.y & 255u, 1u), (float)__builtin_elementwise_max((gb.y >> 8) & 255u, 1u), (float)__builtin_elementwise_max((gb.y >> 16) & 255u, 1u), (float)__builtin_elementwise_max(gb.y >> 24, 1u)};
                        if (br == 1) {
#pragma unroll
                            for (int e = 0; e < 4; ++e) { f0[e] = __builtin_fmaxf(f0[e], 1.0f); f1[e] = __builtin_fmaxf(f1[e], 1.0f); } }
#pragma unroll
                        for (int e = 0; e < 4; ++e) { f0[e] *= __builtin_amdgcn_rcpf(d0[e]); f1[e] *= __builtin_amdgcn_rcpf(d1[e]); } }
                    else {
#pragma unroll
                        for (int e = 0; e < 4; ++e) { f0[e] = __builtin_fmaxf(f0[e], 1.0f) * (1.0f / 255.0f); f1[e] = __builtin_fmaxf(f1[e], 1.0f) * (1.0f / 255.0f); } }
                    acc[ai][bj][m][0] *= f0; acc[ai][bj][m][1] *= f1;
                    if (br == 2) *(u32x4*)(MERGED + (size_t)row * 1024 + col0 + bj * HALF) = pack8(acc[ai][bj][m][0], acc[ai][bj][m][1]);
                } }
    }
};

struct EpiResid {
    static constexpr bool AFTER_DRAIN = false;
    const float* base; float* out;
    __device__ __forceinline__ bool keep(const Unit&) const { return false; }
    __device__ __forceinline__ void operator()(f32x4 (&acc)[2][2][4][2], const Unit& u, int wr, int wc, int fr, int fq) const {
        const int row0 = u.pm * BM + wr * 64 + fr, col0 = u.pn * BM + wc * 32 + 8 * fq;
#pragma unroll
        for (int ai = 0; ai < 2; ++ai)
#pragma unroll
            for (int mp = 0; mp < 2; ++mp) {
                f32x4 xv[2][2][2];
#pragma unroll
                for (int mm = 0; mm < 2; ++mm) { const size_t off = (size_t)(row0 + ai * HALF + (2 * mp + mm) * 16) * 1024 + col0;
#pragma unroll
                    for (int bj = 0; bj < 2; ++bj)
#pragma unroll
                        for (int n = 0; n < 2; ++n) xv[mm][bj][n] = __builtin_nontemporal_load((const f32x4*)(base + off + bj * HALF + n * 4)); }
                __builtin_amdgcn_sched_barrier(0);
#pragma unroll
                for (int mm = 0; mm < 2; ++mm) { const int m = 2 * mp + mm; const size_t off = (size_t)(row0 + ai * HALF + m * 16) * 1024 + col0;
#pragma unroll
                    for (int bj = 0; bj < 2; ++bj)
#pragma unroll
                        for (int n = 0; n < 2; ++n) *(f32x4*)(out + off + bj * HALF + n * 4) = xv[mm][bj][n] + acc[ai][bj][m][n]; }
                __builtin_amdgcn_sched_barrier(0); }
    }
};

struct EpiSwiglu {
    static constexpr bool AFTER_DRAIN = false;
    const float* bgu; unsigned char* ACT;
    __device__ __forceinline__ bool keep(const Unit&) const { return false; }
    __device__ __forceinline__ void operator()(f32x4 (&acc)[2][2][4][2], const Unit& u, int wr, int wc, int fr, int fq) const {
        const int e_ = u.pn >> 3, pnl = u.pn & 7; const int row0 = u.pm * BM + wr * 64 + fr, ch0 = pnl * 128 + wc * 32 + 8 * fq;
        f32x4 bg[2], bu[2];
#pragma unroll
        for (int n = 0; n < 2; ++n) { bg[n] = *(const f32x4*)(bgu + (size_t)e_ * 2048 + ch0 + 4 * n); bu[n] = *(const f32x4*)(bgu + (size_t)e_ * 2048 + 1024 + ch0 + 4 * n); }
#pragma unroll
        for (int ai = 0; ai < 2; ++ai)
#pragma unroll
            for (int m = 0; m < 4; ++m) { const int row = row0 + ai * HALF + m * 16; f32x4 a[2];
#pragma unroll
                for (int n = 0; n < 2; ++n) { const f32x4 g = acc[ai][0][m][n] + bg[n], uu = acc[ai][1][m][n] + bu[n];
#pragma unroll
                    for (int e = 0; e < 4; ++e) { const float gm = fminf(g[e], 7.0f), um = fminf(fmaxf(uu[e], -7.0f), 7.0f);
                        a[n][e] = (um + 1.0f) * (gm * sigmoidf_fast(1.702f * gm)); } }
                u32x2 w8; w8.x = pk4_fp8(a[0][0], a[0][1], a[0][2], a[0][3]); w8.y = pk4_fp8(a[1][0], a[1][1], a[1][2], a[1][3]);
                *(u32x2*)(ACT + (size_t)row * 1024 + ch0) = w8; }
    }
};

struct EpiDown {
    static constexpr bool AFTER_DRAIN = false;
    const float* bd; const float* row_gate; unsigned char* YS;
    __device__ __forceinline__ bool keep(const Unit&) const { return false; }
    __device__ __forceinline__ void operator()(f32x4 (&acc)[2][2][4][2], const Unit& u, int wr, int wc, int fr, int fq) const {
        const int e_ = u.pn >> 2, pnl = u.pn & 3; const int row0 = u.pm * BM + wr * 64 + fr, col0 = pnl * 256 + wc * 32 + 8 * fq;
        f32x4 bv[2][2];
#pragma unroll
        for (int bj = 0; bj < 2; ++bj)
#pragma unroll
            for (int n = 0; n < 2; ++n) bv[bj][n] = *(const f32x4*)(bd + (size_t)e_ * 1024 + col0 + bj * HALF + 4 * n);
        float rgv[8];
#pragma unroll
        for (int i = 0; i < 8; ++i) rgv[i] = row_gate[row0 + (i >> 2) * HALF + (i & 3) * 16];
        __builtin_amdgcn_sched_barrier(0);
#pragma unroll
        for (int ai = 0; ai < 2; ++ai)
#pragma unroll
            for (int m = 0; m < 4; ++m) { const int row = row0 + ai * HALF + m * 16; const float rg = rgv[ai * 4 + m] * 16.0f;
#pragma unroll
                for (int bj = 0; bj < 2; ++bj) { const f32x4 y0 = (acc[ai][bj][m][0] + bv[bj][0]) * rg, y1 = (acc[ai][bj][m][1] + bv[bj][1]) * rg;
                    u32x2 w8; w8.x = pk4_fp8(y0[0], y0[1], y0[2], y0[3]); w8.y = pk4_fp8(y1[0], y1[1], y1[2], y1[3]);
                    *(u32x2*)(YS + (size_t)row * 1024 + col0 + bj * HALF) = w8; } }
    }
};


constexpr int CONV_NSUB = 2 * (32768 + 16384);
struct ConvCtx {
    const float* wgu; const float* wdn; unsigned char* ogu; unsigned char* odn;
    int cw, nseq, jn;
    int sub;
    unsigned slot0;
};
struct ConvItem { const float* W; unsigned char* WT; int ldn, k0, n0, dst; };
__device__ __forceinline__ int conv_ip32(int r) { return 16 * ((r >> 2) & 1) + 4 * (r >> 3) + (r & 3); }
__device__ __forceinline__ ConvItem conv_decode(const ConvCtx& c, int s) {
    ConvItem d; const int it = s >> 1, hf = s & 1;
    if (it < 32768) { const int e = it >> 10, q = it & 1023, kb = q >> 6, nb = q & 63; const int L0 = 32 * nb, ch = L0 & 1023;
        d.W = c.wgu + (size_t)e * 1024 * 2048; d.ldn = 2048; d.k0 = 64 * kb + 32 * hf; d.n0 = L0; d.dst = e * 2048 + 256 * (ch >> 7) + 128 * (L0 >> 10) + 32 * ((ch >> 5) & 3); d.WT = c.ogu; }
    else { const int r = it - 32768, e = r >> 9, q = r & 511, kb = q >> 5, nb = q & 31;
        d.W = c.wdn + (size_t)e * 1024 * 1024; d.ldn = 1024; d.k0 = 64 * kb + 32 * hf; d.n0 = 32 * nb; d.dst = e * 1024 + 32 * nb; d.WT = c.odn; }
    return d;
}
__device__ __forceinline__ void conv_issue(const ConvCtx& c, PG8_LAS unsigned char* lds, unsigned slot, int lane_, int s) {
    int lane = lane_; asm volatile("" : "+v"(lane));
    const ConvItem d = conv_decode(c, s);
    const float* src = d.W + (size_t)(d.k0 + (lane >> 3)) * d.ldn + d.n0 + 4 * (lane & 7);
#pragma unroll
    for (int jj = 0; jj < 4; ++jj) __builtin_amdgcn_global_load_lds((const unsigned*)(src + (size_t)(8 * jj) * d.ldn), (PG8_LAS unsigned*)(lds + slot + jj * 1024), 16, 0, 2);
}
__device__ __forceinline__ void conv_finish(const ConvCtx& c, PG8_LAS unsigned char* lds, unsigned slot, int lane_, int s) {
    int lane = lane_; asm volatile("" : "+v"(lane));
    const ConvItem d = conv_decode(c, s);
    const int n = lane & 31, kh = lane >> 5;
    const PG8_LAS float* p = (const PG8_LAS float*)(lds + slot + kh * 2048 + n * 4);
    float v[16];
#pragma unroll
    for (int kk = 0; kk < 16; ++kk) v[kk] = p[kk * 32];
    asm volatile("s_waitcnt lgkmcnt(0)" ::: "memory");
    u32x4 o;
    o.x = pk4_fp8(32.f * v[0], 32.f * v[1], 32.f * v[2], 32.f * v[3]);   o.y = pk4_fp8(32.f * v[4], 32.f * v[5], 32.f * v[6], 32.f * v[7]);
    o.z = pk4_fp8(32.f * v[8], 32.f * v[9], 32.f * v[10], 32.f * v[11]); o.w = pk4_fp8(32.f * v[12], 32.f * v[13], 32.f * v[14], 32.f * v[15]);
    __builtin_nontemporal_store(o, (u32x4*)(d.WT + (size_t)(d.dst + conv_ip32(n)) * 1024 + d.k0 + 16 * kh));
}
template <class Epi, class Sched, bool ALIGN_EPI = false, bool SP2 = false, bool CONV = false>
__device__ __forceinline__ void gemm_phase(PG8_LAS unsigned char* lds, const Gemm g, const Sched& S, const Epi& E, ConvCtx* cx = nullptr) {
    int tid_ = threadIdx.x; asm volatile("" : "+v"(tid_));
    const int tid = tid_, wid = __builtin_amdgcn_readfirstlane(tid >> 6), lane = tid & 63, wr = wid >> 2, wc = wid & 3, fr = lane & 15, fq = lane >> 4;
    const int K = g.K, nt = K / BK;
    static_assert(!CONV || SP2, "CONV needs the SP2 loop");
    unsigned voffA[2], voffB[2];
#pragma unroll
    for (int i = 0; i < 2; ++i) { int R, C; stage_rc(tid * 16 + i * 8192, R, C);
        voffA[i] = (unsigned)R * g.lda + (unsigned)C * 2u; voffB[i] = (unsigned)R * g.ldb + (unsigned)C * 2u; }
    const size_t kstep = (size_t)(BK * 2);
    const size_t hstepA = (size_t)HALF * g.lda, hstepB = (size_t)HALF * g.ldb;
    const unsigned ldsw = (unsigned)wid * 1024u;
    const int aoff = lds_byte(wr * 64 + fr, fq * 8), boff = lds_byte(wc * 32 + fr, fq * 8);
#define PG8_SA(b, h) (((b) * 2 + (h)) * HTB)
#define PG8_SB(b, h) ((4 + (b) * 2 + (h)) * HTB)
#define PG8_STAGE(bufoff, gbase, voff) do { _Pragma("unroll") for (int _i = 0; _i < 2; ++_i) \
        __builtin_amdgcn_global_load_lds((const unsigned*)((const char*)(gbase) + (voff)[_i]), (PG8_LAS unsigned*)(lds + (bufoff) + ldsw + _i * 8192), 16, 0, 0); } while (0)
#define PG8_LDA(dst, b, h) do { _Pragma("unroll") for (int m = 0; m < 4; ++m) _Pragma("unroll") for (int k = 0; k < 2; ++k) dst[m][k] = *(const PG8_LAS bf16x8*)(lds + PG8_SA(b, h) + aoff + m * 2048 + k * 1024); } while (0)
#define PG8_LDB(dst, b, h) do { _Pragma("unroll") for (int n = 0; n < 2; ++n) _Pragma("unroll") for (int k = 0; k < 2; ++k) dst[n][k] = *(const PG8_LAS bf16x8*)(lds + PG8_SB(b, h) + boff + n * 2048 + k * 1024); } while (0)
#define PG8_MMA(ai, bj, At, Bt) do { __builtin_amdgcn_s_setprio(1); _Pragma("unroll") for (int m = 0; m < 4; ++m) _Pragma("unroll") for (int n = 0; n < 2; ++n) _Pragma("unroll") for (int k = 0; k < 2; ++k) \
        acc[ai][bj][m][n] = __builtin_amdgcn_mfma_f32_16x16x32_bf16(Bt[n][k], At[m][k], acc[ai][bj][m][n], 0, 0, 0); __builtin_amdgcn_s_setprio(0); } while (0)
#define PG8_WAIT_V(n) asm volatile("s_waitcnt vmcnt(" #n ")" ::: "memory")
#define PG8_WAIT_X(n_) do { if constexpr (CONV) { const int x_ = (n_); if (x_ == 5) asm volatile("s_waitcnt vmcnt(13)" ::: "memory"); else if (x_ == 4) asm volatile("s_waitcnt vmcnt(12)" ::: "memory"); \
        else if (x_ == 1) asm volatile("s_waitcnt vmcnt(9)" ::: "memory"); else asm volatile("s_waitcnt vmcnt(8)" ::: "memory"); } else asm volatile("s_waitcnt vmcnt(8)" ::: "memory"); } while (0)
#define PG8_WAIT_L(n) asm volatile("s_waitcnt lgkmcnt(" #n ")" ::: "memory")
#define PG8_BAR __builtin_amdgcn_s_barrier()
#define PG8_SCHED __builtin_amdgcn_sched_barrier(0)
    Unit cur, nxt; int ui = 0;
    if (!S.next(0, cur)) return;
    f32x4 acc[2][2][4][2];
#pragma unroll
    for (int a = 0; a < 2; ++a)
#pragma unroll
        for (int b = 0; b < 2; ++b)
#pragma unroll
            for (int m = 0; m < 4; ++m)
#pragma unroll
                for (int n = 0; n < 2; ++n) acc[a][b][m][n] = (f32x4){0.f, 0.f, 0.f, 0.f};
    bf16x8 At[4][2], B0[2][2], B1[2][2];
    const char* cA = cur.a; const char* cB = cur.b;
    S.a_ready(cur);
    if constexpr (SP2) {
        PG8_STAGE(PG8_SB(0, 0), cB, voffB); PG8_STAGE(PG8_SB(0, 1), cB + hstepB, voffB); PG8_STAGE(PG8_SA(0, 0), cA, voffA); PG8_STAGE(PG8_SA(0, 1), cA + hstepA, voffA);
        if (wr == 1) PG8_BAR;
        PG8_WAIT_V(2); PG8_BAR;
        PG8_STAGE(PG8_SB(1, 0), cB + kstep, voffB); PG8_STAGE(PG8_SA(1, 0), cA + kstep, voffA); PG8_STAGE(PG8_SB(1, 1), cB + hstepB + kstep, voffB);
        PG8_WAIT_V(6); PG8_BAR;
    } else {
        PG8_STAGE(PG8_SB(0, 0), cB, voffB); PG8_STAGE(PG8_SA(0, 0), cA, voffA); PG8_STAGE(PG8_SB(0, 1), cB + hstepB, voffB); PG8_STAGE(PG8_SA(0, 1), cA + hstepA, voffA);
        if (wr == 1) PG8_BAR;
        PG8_WAIT_V(4); PG8_BAR;
        PG8_STAGE(PG8_SB(1, 0), cB + kstep, voffB); PG8_STAGE(PG8_SA(1, 0), cA + kstep, voffA); PG8_STAGE(PG8_SB(1, 1), cB + hstepB + kstep, voffB);
        PG8_WAIT_V(6); PG8_BAR;
    }
    for (;;) {
        const bool has_next = S.next(ui + 1, nxt);
        const char* nA = has_next ? nxt.a : cA; const char* nB = has_next ? nxt.b : cB;
#pragma unroll 1
        for (int t = 0; t < nt; t += 2) {
            const bool last = (t == nt - 2);
            const char* a1 = cA + (size_t)(t + 1) * kstep;
            const char* a2 = last ? nA : cA + (size_t)(t + 2) * kstep; const char* b2 = last ? nB : cB + (size_t)(t + 2) * kstep;
            const char* a3 = a2 + kstep; const char* b3 = b2 + kstep;
            if (last && has_next) S.a_ready(nxt);
            if constexpr (SP2) {
            int cs_ = 0, cc_ = 0;
            if constexpr (CONV) { if (cx->sub >= 0) { conv_finish(*cx, lds, cx->slot0, lane, cx->sub); cx->sub = -1; cs_ = 1; } PG8_SCHED; }
            PG8_LDB(B0, 0, 0); PG8_LDB(B1, 0, 1); PG8_SCHED; PG8_LDA(At, 0, 0); PG8_STAGE(PG8_SA(1, 1), a1 + hstepA, voffA);
            if constexpr (CONV) { const int s_ = cx->cw + cx->nseq * cx->jn; if (s_ < CONV_NSUB) { conv_issue(*cx, lds, cx->slot0, lane, s_); cx->sub = s_; ++cx->jn; cc_ = 4; } }
            PG8_WAIT_X(cs_ + cc_); PG8_WAIT_L(0); PG8_BAR; PG8_MMA(0, 0, At, B0); PG8_MMA(0, 1, At, B1); PG8_BAR; PG8_SCHED;
            PG8_LDA(At, 0, 1); PG8_STAGE(PG8_SB(0, 0), b2, voffB); PG8_STAGE(PG8_SB(0, 1), b2 + hstepB, voffB); PG8_STAGE(PG8_SA(0, 0), a2, voffA);
            PG8_WAIT_X(cs_ + cc_); PG8_WAIT_L(0); PG8_BAR; PG8_MMA(1, 0, At, B0); PG8_MMA(1, 1, At, B1); PG8_BAR; PG8_SCHED;
            PG8_LDB(B0, 1, 0); PG8_LDB(B1, 1, 1); PG8_SCHED; PG8_LDA(At, 1, 0); PG8_STAGE(PG8_SA(0, 1), a2 + hstepA, voffA);
            PG8_WAIT_X(cc_); PG8_WAIT_L(0); PG8_BAR; PG8_MMA(0, 0, At, B0); PG8_MMA(0, 1, At, B1); PG8_BAR; PG8_SCHED;
            PG8_LDA(At, 1, 1); PG8_STAGE(PG8_SB(1, 0), b3, voffB); PG8_STAGE(PG8_SB(1, 1), b3 + hstepB, voffB); PG8_STAGE(PG8_SA(1, 0), a3, voffA);
            PG8_WAIT_V(8); PG8_WAIT_L(0); PG8_BAR; PG8_MMA(1, 0, At, B0); PG8_MMA(1, 1, At, B1); PG8_BAR; PG8_SCHED;
            } else {
            PG8_LDB(B0, 0, 0); PG8_SCHED; PG8_LDA(At, 0, 0); PG8_STAGE(PG8_SA(1, 1), a1 + hstepA, voffA);
            PG8_WAIT_L(8); PG8_BAR; PG8_WAIT_L(0); PG8_MMA(0, 0, At, B0); PG8_BAR; PG8_SCHED;
            PG8_LDB(B1, 0, 1); PG8_STAGE(PG8_SB(0, 0), b2, voffB);
            PG8_BAR; PG8_WAIT_L(0); PG8_MMA(0, 1, At, B1); PG8_BAR;
            PG8_LDA(At, 0, 1); PG8_STAGE(PG8_SA(0, 0), a2, voffA);
            PG8_BAR; PG8_WAIT_L(0); PG8_MMA(1, 0, At, B0); PG8_BAR; PG8_SCHED;
            PG8_STAGE(PG8_SB(0, 1), b2 + hstepB, voffB);
            PG8_WAIT_V(6); PG8_BAR; PG8_MMA(1, 1, At, B1); PG8_BAR;
            PG8_LDB(B0, 1, 0); PG8_SCHED; PG8_LDA(At, 1, 0); PG8_STAGE(PG8_SA(0, 1), a2 + hstepA, voffA);
            PG8_WAIT_L(8); PG8_BAR; PG8_WAIT_L(0); PG8_MMA(0, 0, At, B0); PG8_BAR; PG8_SCHED;
            PG8_LDB(B1, 1, 1); PG8_STAGE(PG8_SB(1, 0), b3, voffB);
            PG8_BAR; PG8_WAIT_L(0); PG8_MMA(0, 1, At, B1); PG8_BAR;
            PG8_LDA(At, 1, 1); PG8_STAGE(PG8_SA(1, 0), a3, voffA);
            PG8_BAR; PG8_WAIT_L(0); PG8_MMA(1, 0, At, B0); PG8_BAR; PG8_SCHED;
            PG8_STAGE(PG8_SB(1, 1), b3 + hstepB, voffB);
            PG8_WAIT_V(6); PG8_BAR; PG8_MMA(1, 1, At, B1); PG8_BAR;
            }
        }
        if constexpr (ALIGN_EPI) { if (wr == 0) PG8_BAR; }
        if constexpr (!Epi::AFTER_DRAIN) { E(acc, cur, wr, wc, fr, fq); S.done(cur); }
        if (!has_next) break;
        if (!E.keep(cur)) {
#pragma unroll
        for (int a = 0; a < 2; ++a)
#pragma unroll
            for (int b = 0; b < 2; ++b)
#pragma unroll
                for (int m = 0; m < 4; ++m)
#pragma unroll
                    for (int n = 0; n < 2; ++n) acc[a][b][m][n] = (f32x4){0.f, 0.f, 0.f, 0.f};
        }
        cur = nxt; cA = nA; cB = nB; ++ui;
        if constexpr (ALIGN_EPI) { if (wr == 1) PG8_BAR; }
    }
    PG8_WAIT_V(0);
    if constexpr (!ALIGN_EPI) { if (wr == 0) PG8_BAR; }
    PG8_BAR;
    if constexpr (Epi::AFTER_DRAIN) { E.fused(acc, cur, wr, wc, fr, fq, lds, wid, lane); S.done(cur); }
#undef PG8_SA
#undef PG8_SB
#undef PG8_STAGE
#undef PG8_LDA
#undef PG8_LDB
#undef PG8_MMA
#undef PG8_WAIT_V
#undef PG8_WAIT_X
#undef PG8_WAIT_L
#undef PG8_BAR
#undef PG8_SCHED
}

typedef unsigned u32x8 __attribute__((ext_vector_type(8))); typedef int i32x8 __attribute__((ext_vector_type(8)));
constexpr int F8_SCALE_W = 122, F8_SCALE_X = 127;
template <class Epi, class Sched, bool ALIGN_EPI = false, bool SP2 = false, bool CONV = false>
__device__ __forceinline__ void gemm_phase_f8(PG8_LAS unsigned char* lds, const Gemm g, const Sched& S, const Epi& E, ConvCtx* cx = nullptr) {
    int tid_ = threadIdx.x; asm volatile("" : "+v"(tid_));
    const int tid = tid_, wid = __builtin_amdgcn_readfirstlane(tid >> 6), lane = tid & 63, wr = wid >> 2, wc = wid & 3, fr = lane & 15, fq = lane >> 4;
    const int K = g.K, nt = K / BK;
    static_assert(!CONV || SP2, "CONV needs the SP2 loop");
    unsigned voffA[2], voffB[2];
#pragma unroll
    for (int i = 0; i < 2; ++i) { int R, C; stage_rc(tid * 16 + i * 8192, R, C);
        voffA[i] = (unsigned)R * g.lda + (unsigned)C * 2u; voffB[i] = (unsigned)R * g.ldb + (unsigned)C * 2u; }
    const size_t kstep = (size_t)(BK * 2);
    const size_t hstepA = (size_t)HALF * g.lda, hstepB = (size_t)HALF * g.ldb;
    const unsigned ldsw = (unsigned)wid * 1024u;
    const int aoff = lds_byte(wr * 64 + fr, fq * 8), boff = lds_byte(wc * 32 + fr, fq * 8);
#define PG8_SA(b, h) (((b) * 2 + (h)) * HTB)
#define PG8_SB(b, h) ((4 + (b) * 2 + (h)) * HTB)
#define PG8_STAGE(bufoff, gbase, voff) do { _Pragma("unroll") for (int _i = 0; _i < 2; ++_i) \
        __builtin_amdgcn_global_load_lds((const unsigned*)((const char*)(gbase) + (voff)[_i]), (PG8_LAS unsigned*)(lds + (bufoff) + ldsw + _i * 8192), 16, 0, 0); } while (0)
#define PG8_LDA(dst, b, h) do { _Pragma("unroll") for (int m = 0; m < 4; ++m) { const u32x4 lo_ = *(const PG8_LAS u32x4*)(lds + PG8_SA(b, h) + aoff + m * 2048), hi_ = *(const PG8_LAS u32x4*)(lds + PG8_SA(b, h) + aoff + m * 2048 + 1024); dst[m] = __builtin_shufflevector(lo_, hi_, 0, 1, 2, 3, 4, 5, 6, 7); } } while (0)
#define PG8_LDB(dst, b, h) do { _Pragma("unroll") for (int n = 0; n < 2; ++n) { const u32x4 lo_ = *(const PG8_LAS u32x4*)(lds + PG8_SB(b, h) + boff + n * 2048), hi_ = *(const PG8_LAS u32x4*)(lds + PG8_SB(b, h) + boff + n * 2048 + 1024); dst[n] = __builtin_shufflevector(lo_, hi_, 0, 1, 2, 3, 4, 5, 6, 7); } } while (0)
#define PG8_MMA(ai, bj, At, Bt) do { __builtin_amdgcn_s_setprio(1); _Pragma("unroll") for (int m = 0; m < 4; ++m) _Pragma("unroll") for (int n = 0; n < 2; ++n) \
        asm volatile("v_mfma_scale_f32_16x16x128_f8f6f4 %0, %1, %2, %0, %3, %4 op_sel_hi:[0,0,0]" : "+v"(acc[ai][bj][m][n]) : "v"(Bt[n]), "v"(At[m]), "v"(sc_w), "v"(sc_x)); __builtin_amdgcn_s_setprio(0); } while (0)
#define PG8_WAIT_V(n) asm volatile("s_waitcnt vmcnt(" #n ")" ::: "memory")
#define PG8_WAIT_X(n_) do { if constexpr (CONV) { const int x_ = (n_); if (x_ == 5) asm volatile("s_waitcnt vmcnt(13)" ::: "memory"); else if (x_ == 4) asm volatile("s_waitcnt vmcnt(12)" ::: "memory"); \
        else if (x_ == 1) asm volatile("s_waitcnt vmcnt(9)" ::: "memory"); else asm volatile("s_waitcnt vmcnt(8)" ::: "memory"); } else asm volatile("s_waitcnt vmcnt(8)" ::: "memory"); } while (0)
#define PG8_WAIT_L(n) asm volatile("s_waitcnt lgkmcnt(" #n ")" ::: "memory")
#define PG8_BAR __builtin_amdgcn_s_barrier()
#define PG8_SCHED __builtin_amdgcn_sched_barrier(0)
    Unit cur, nxt; int ui = 0;
    if (!S.next(0, cur)) return;
    f32x4 acc[2][2][4][2];
#pragma unroll
    for (int a = 0; a < 2; ++a)
#pragma unroll
        for (int b = 0; b < 2; ++b)
#pragma unroll
            for (int m = 0; m < 4; ++m)
#pragma unroll
                for (int n = 0; n < 2; ++n) acc[a][b][m][n] = (f32x4){0.f, 0.f, 0.f, 0.f};
    u32x8 At[4], B0[2], B1[2];
    int sc_w = F8_SCALE_W, sc_x = F8_SCALE_X; asm volatile("" : "+v"(sc_w), "+v"(sc_x));
    const char* cA = cur.a; const char* cB = cur.b;
    S.a_ready(cur);
    if constexpr (SP2) {
        PG8_STAGE(PG8_SB(0, 0), cB, voffB); PG8_STAGE(PG8_SB(0, 1), cB + hstepB, voffB); PG8_STAGE(PG8_SA(0, 0), cA, voffA); PG8_STAGE(PG8_SA(0, 1), cA + hstepA, voffA);
        if (wr == 1) PG8_BAR;
        PG8_WAIT_V(2); PG8_BAR;
        PG8_STAGE(PG8_SB(1, 0), cB + kstep, voffB); PG8_STAGE(PG8_SA(1, 0), cA + kstep, voffA); PG8_STAGE(PG8_SB(1, 1), cB + hstepB + kstep, voffB);
        PG8_WAIT_V(6); PG8_BAR;
    } else {
        PG8_STAGE(PG8_SB(0, 0), cB, voffB); PG8_STAGE(PG8_SA(0, 0), cA, voffA); PG8_STAGE(PG8_SB(0, 1), cB + hstepB, voffB); PG8_STAGE(PG8_SA(0, 1), cA + hstepA, voffA);
        if (wr == 1) PG8_BAR;
        PG8_WAIT_V(4); PG8_BAR;
        PG8_STAGE(PG8_SB(1, 0), cB + kstep, voffB); PG8_STAGE(PG8_SA(1, 0), cA + kstep, voffA); PG8_STAGE(PG8_SB(1, 1), cB + hstepB + kstep, voffB);
        PG8_WAIT_V(6); PG8_BAR;
    }
    for (;;) {
        const bool has_next = S.next(ui + 1, nxt);
        const char* nA = has_next ? nxt.a : cA; const char* nB = has_next ? nxt.b : cB;
#pragma unroll 1
        for (int t = 0; t < nt; t += 2) {
            const bool last = (t == nt - 2);
            const char* a1 = cA + (size_t)(t + 1) * kstep;
            const char* a2 = last ? nA : cA + (size_t)(t + 2) * kstep; const char* b2 = last ? nB : cB + (size_t)(t + 2) * kstep;
            const char* a3 = a2 + kstep; const char* b3 = b2 + kstep;
            if (last && has_next) S.a_ready(nxt);
            if constexpr (SP2) {
            int cs_ = 0, cc_ = 0;
            if constexpr (CONV) { if (cx->sub >= 0) { conv_finish(*cx, lds, cx->slot0, lane, cx->sub); cx->sub = -1; cs_ = 1; } PG8_SCHED; }
            PG8_LDB(B0, 0, 0); PG8_LDB(B1, 0, 1); PG8_SCHED; PG8_LDA(At, 0, 0); PG8_STAGE(PG8_SA(1, 1), a1 + hstepA, voffA);
            if constexpr (CONV) { const int s_ = cx->cw + cx->nseq * cx->jn; if (s_ < CONV_NSUB) { conv_issue(*cx, lds, cx->slot0, lane, s_); cx->sub = s_; ++cx->jn; cc_ = 4; } }
            PG8_WAIT_X(cs_ + cc_); PG8_WAIT_L(0); PG8_BAR; PG8_MMA(0, 0, At, B0); PG8_MMA(0, 1, At, B1); PG8_BAR; PG8_SCHED;
            PG8_LDA(At, 0, 1); PG8_STAGE(PG8_SB(0, 0), b2, voffB); PG8_STAGE(PG8_SB(0, 1), b2 + hstepB, voffB); PG8_STAGE(PG8_SA(0, 0), a2, voffA);
            PG8_WAIT_X(cs_ + cc_); PG8_WAIT_L(0); PG8_BAR; PG8_MMA(1, 0, At, B0); PG8_MMA(1, 1, At, B1); PG8_BAR; PG8_SCHED;
            PG8_LDB(B0, 1, 0); PG8_LDB(B1, 1, 1); PG8_SCHED; PG8_LDA(At, 1, 0); PG8_STAGE(PG8_SA(0, 1), a2 + hstepA, voffA);
            PG8_WAIT_X(cc_); PG8_WAIT_L(0); PG8_BAR; PG8_MMA(0, 0, At, B0); PG8_MMA(0, 1, At, B1); PG8_BAR; PG8_SCHED;
            PG8_LDA(At, 1, 1); PG8_STAGE(PG8_SB(1, 0), b3, voffB); PG8_STAGE(PG8_SB(1, 1), b3 + hstepB, voffB); PG8_STAGE(PG8_SA(1, 0), a3, voffA);
            PG8_WAIT_V(8); PG8_WAIT_L(0); PG8_BAR; PG8_MMA(1, 0, At, B0); PG8_MMA(1, 1, At, B1); PG8_BAR; PG8_SCHED;
            } else {
            PG8_LDB(B0, 0, 0); PG8_SCHED; PG8_LDA(At, 0, 0); PG8_STAGE(PG8_SA(1, 1), a1 + hstepA, voffA);
            PG8_WAIT_L(8); PG8_BAR; PG8_WAIT_L(0); PG8_MMA(0, 0, At, B0); PG8_BAR; PG8_SCHED;
            PG8_LDB(B1, 0, 1); PG8_STAGE(PG8_SB(0, 0), b2, voffB);
            PG8_BAR; PG8_WAIT_L(0); PG8_MMA(0, 1, At, B1); PG8_BAR;
            PG8_LDA(At, 0, 1); PG8_STAGE(PG8_SA(0, 0), a2, voffA);
            PG8_BAR; PG8_WAIT_L(0); PG8_MMA(1, 0, At, B0); PG8_BAR; PG8_SCHED;
            PG8_STAGE(PG8_SB(0, 1), b2 + hstepB, voffB);
            PG8_WAIT_V(6); PG8_BAR; PG8_MMA(1, 1, At, B1); PG8_BAR;
            PG8_LDB(B0, 1, 0); PG8_SCHED; PG8_LDA(At, 1, 0); PG8_STAGE(PG8_SA(0, 1), a2 + hstepA, voffA);
            PG8_WAIT_L(8); PG8_BAR; PG8_WAIT_L(0); PG8_MMA(0, 0, At, B0); PG8_BAR; PG8_SCHED;
            PG8_LDB(B1, 1, 1); PG8_STAGE(PG8_SB(1, 0), b3, voffB);
            PG8_BAR; PG8_WAIT_L(0); PG8_MMA(0, 1, At, B1); PG8_BAR;
            PG8_LDA(At, 1, 1); PG8_STAGE(PG8_SA(1, 0), a3, voffA);
            PG8_BAR; PG8_WAIT_L(0); PG8_MMA(1, 0, At, B0); PG8_BAR; PG8_SCHED;
            PG8_STAGE(PG8_SB(1, 1), b3 + hstepB, voffB);
            PG8_WAIT_V(6); PG8_BAR; PG8_MMA(1, 1, At, B1); PG8_BAR;
            }
        }
        if constexpr (ALIGN_EPI) { if (wr == 0) PG8_BAR; }
        asm volatile("s_nop 15\n\ts_nop 15" ::: "memory");
        if constexpr (!Epi::AFTER_DRAIN) { E(acc, cur, wr, wc, fr, fq); S.done(cur); }
        if (!has_next) break;
        if (!E.keep(cur)) {
#pragma unroll
        for (int a = 0; a < 2; ++a)
#pragma unroll
            for (int b = 0; b < 2; ++b)
#pragma unroll
                for (int m = 0; m < 4; ++m)
#pragma unroll
                    for (int n = 0; n < 2; ++n) acc[a][b][m][n] = (f32x4){0.f, 0.f, 0.f, 0.f};
        }
        cur = nxt; cA = nA; cB = nB; ++ui;
        if constexpr (ALIGN_EPI) { if (wr == 1) PG8_BAR; }
    }
    PG8_WAIT_V(0);
    if constexpr (!ALIGN_EPI) { if (wr == 0) PG8_BAR; }
    PG8_BAR;
    if constexpr (Epi::AFTER_DRAIN) { E.fused(acc, cur, wr, wc, fr, fq, lds, wid, lane); S.done(cur); }
#undef PG8_SA
#undef PG8_SB
#undef PG8_STAGE
#undef PG8_LDA
#undef PG8_LDB
#undef PG8_MMA
#undef PG8_WAIT_V
#undef PG8_WAIT_X
#undef PG8_WAIT_L
#undef PG8_BAR
#undef PG8_SCHED
}
}

#include <hip/hip_bf16.h>
#include <cmath>
namespace attn_body {
using bf16=__hip_bfloat16;
using bf16x8=__attribute__((ext_vector_type(8)))short;
using s16x4=__attribute__((ext_vector_type(4)))short;
using f32x16=__attribute__((ext_vector_type(16)))float;
using u32x4=__attribute__((ext_vector_type(4)))unsigned;
constexpr int SEQ=8192,D=64; constexpr int QP=512,KP=512,VP=512,OP=1024;
constexpr int NW=8,QBLK=32,QB=QBLK*NW,KVBLK=64,NQB=SEQ/QB;
constexpr int ATTN_UNIT_ROWS=QB;
__device__ __forceinline__ int crow(int r,int hi){return (r&3)+8*(r>>2)+4*hi;}
#define SBAR() __builtin_amdgcn_sched_barrier(0)
__device__ __forceinline__ void cmask(f32x16&p0,f32x16&p1,int jb,int qrel,int hi){
  const float NEG=-INFINITY; (void)hi;
  if(jb>(qrel>>6)){
  #pragma unroll
  for(int r=0;r<16;++r){p0[r]=NEG;p1[r]=NEG;} }
}

constexpr int NSLOT=3, SLOTB=8192;
constexpr int LDS_K=0, LDS_V=NSLOT*SLOTB, LDS_WS=2*NSLOT*SLOTB, LDS_OST=LDS_WS+NW*64*4, LDS_BYTES=LDS_OST+NW*4096;
constexpr float C2=0.125f*1.4426950408889634f;
__device__ __forceinline__ void glds16(const void*gsrc,unsigned lds_dst){unsigned keep;
  asm volatile("s_mov_b32 %0, m0\n\ts_mov_b32 m0, %2\n\ts_nop 0\n\tglobal_load_lds_dwordx4 %1, off\n\ts_mov_b32 m0, %0":"=&s"(keep):"v"(gsrc),"s"(lds_dst):"memory");}
__device__ __forceinline__ float max3f(float a,float b,float c){float r;asm("v_max3_f32 %0, %1, %2, %3":"=v"(r):"v"(a),"v"(b),"v"(c));return r;}
__device__ __forceinline__ float max2f(float a,float b){float r;asm("v_max_f32_e32 %0, %1, %2":"=v"(r):"v"(a),"v"(b));return r;}
__device__ __forceinline__ float fadd_s(float a,float b){float r;asm("v_add_f32_e32 %0, %1, %2":"=v"(r):"v"(a),"v"(b));return r;}
__device__ __forceinline__ float fsub_s(float a,float b){float r;asm("v_sub_f32_e32 %0, %1, %2":"=v"(r):"v"(a),"v"(b));return r;}
typedef float f32x2_t __attribute__((ext_vector_type(2))); typedef __bf16 bf16x2_t __attribute__((ext_vector_type(2)));
__device__ __forceinline__ unsigned cvtpk_s(float lo,float hi){f32x2_t v={lo,hi};bf16x2_t b=__builtin_convertvector(v,bf16x2_t);return __builtin_bit_cast(unsigned,b);}
#define WAIT_BAR(N) asm volatile("s_waitcnt vmcnt(" #N ") lgkmcnt(0)\n\ts_barrier":::"memory")

__device__ __forceinline__ void qkt(f32x16&p0,f32x16&p1,const char*Kslot,const bf16x8*qr,const f32x16&negm,int r32,int hi){
  const char*kb=Kslot+hi*1024+r32*16;
  #pragma unroll
  for(int d0=0;d0<4;++d0){
    const bf16x8 b0=*reinterpret_cast<const bf16x8*>(kb+d0*2048);
    const bf16x8 b1=*reinterpret_cast<const bf16x8*>(kb+d0*2048+512);
    if(d0==0){p0=__builtin_amdgcn_mfma_f32_32x32x16_bf16(b0,qr[0],negm,0,0,0);p1=__builtin_amdgcn_mfma_f32_32x32x16_bf16(b1,qr[0],negm,0,0,0);}
    else{p0=__builtin_amdgcn_mfma_f32_32x32x16_bf16(b0,qr[d0],p0,0,0,0);p1=__builtin_amdgcn_mfma_f32_32x32x16_bf16(b1,qr[d0],p1,0,0,0);}}
}
typedef __attribute__((address_space(3))) const char* lds_cptr;
typedef short v4i16_t __attribute__((ext_vector_type(4)));
__device__ __forceinline__ void kload8(bf16x8*kf,lds_cptr kp){
  kf[0]=*(const __attribute__((address_space(3))) bf16x8*)(kp);      kf[1]=*(const __attribute__((address_space(3))) bf16x8*)(kp+512);
  kf[2]=*(const __attribute__((address_space(3))) bf16x8*)(kp+2048); kf[3]=*(const __attribute__((address_space(3))) bf16x8*)(kp+2560);
  kf[4]=*(const __attribute__((address_space(3))) bf16x8*)(kp+4096); kf[5]=*(const __attribute__((address_space(3))) bf16x8*)(kp+4608);
  kf[6]=*(const __attribute__((address_space(3))) bf16x8*)(kp+6144); kf[7]=*(const __attribute__((address_space(3))) bf16x8*)(kp+6656);
}
__device__ __forceinline__ void kload2(bf16x8*kf,lds_cptr kp,int j){ kf[2*j]=*(const __attribute__((address_space(3))) bf16x8*)(kp+j*2048); kf[2*j+1]=*(const __attribute__((address_space(3))) bf16x8*)(kp+j*2048+512); }
__device__ __forceinline__ s16x4 vtr(lds_cptr p){ return __builtin_bit_cast(s16x4,__builtin_amdgcn_ds_read_tr16_b64_v4i16((__attribute__((address_space(3))) v4i16_t*)p)); }
__device__ __forceinline__ float rowmax(const f32x16&p0,const f32x16&p1){
  float a=max3f(p0[0],p0[1],p1[0]),b=max3f(p0[2],p0[3],p1[1]);a=max3f(a,p1[2],p1[3]);
  #pragma unroll
  for(int r=4;r<16;r+=4){a=max3f(a,p0[r],p0[r+1]);b=max3f(b,p0[r+2],p0[r+3]);a=max3f(a,p1[r],p1[r+1]);b=max3f(b,p1[r+2],p1[r+3]);}
  const float m=max2f(a,b);
  auto rr=__builtin_amdgcn_permlane32_swap(__float_as_uint(m),__float_as_uint(m),false,false);
  return max2f(__uint_as_float(rr[0]),__uint_as_float(rr[1]));
}
__device__ __forceinline__ void pv(f32x16*o,int vb,bf16x8 pa0,bf16x8 pa1,bf16x8 pa2,bf16x8 pa3){
  #pragma unroll
  for(int d0=0;d0<2;++d0){s16x4 lo[4],hi[4];
    #pragma unroll
    for(int ks=0;ks<4;++ks){
      asm volatile("ds_read_b64_tr_b16 %0,%1 offset:%c2":"=&v"(lo[ks]):"v"(vb),"i"(d0*4096+ks*1024):"memory");
      asm volatile("ds_read_b64_tr_b16 %0,%1 offset:%c2":"=&v"(hi[ks]):"v"(vb),"i"(d0*4096+ks*1024+512):"memory");}
    asm volatile("s_waitcnt lgkmcnt(0)":::"memory");SBAR();
    #define PK(k) (bf16x8){lo[k][0],lo[k][1],lo[k][2],lo[k][3],hi[k][0],hi[k][1],hi[k][2],hi[k][3]}
    o[d0]=__builtin_amdgcn_mfma_f32_32x32x16_bf16(pa0,PK(0),o[d0],0,0,0);
    o[d0]=__builtin_amdgcn_mfma_f32_32x32x16_bf16(pa1,PK(1),o[d0],0,0,0);
    o[d0]=__builtin_amdgcn_mfma_f32_32x32x16_bf16(pa2,PK(2),o[d0],0,0,0);
    o[d0]=__builtin_amdgcn_mfma_f32_32x32x16_bf16(pa3,PK(3),o[d0],0,0,0);
    #undef PK
  }
}

#ifndef ATTN_STORE16
#define ATTN_STORE16(p,v) (*(u32x4*)(p)=(v))
#endif
template<int THRL> __device__ __forceinline__ void attn_unit(int qb,const bf16*Q,const bf16*__restrict__ K,const bf16*__restrict__ V,bf16*O,char*shm){
  int tid_=threadIdx.x; asm volatile("":"+v"(tid_)); const int tid=tid_,lane=tid&63,r32=lane&31,hi=lane>>5; const int wid=__builtin_amdgcn_readfirstlane(tid>>6);
  const int q0=qb*QB;
  const bf16*Qw=Q+(long)(q0+wid*QBLK)*QP;
  const bf16*Kh=K,*Vh=V;
  const unsigned lds0=(unsigned)(uintptr_t)shm;
  float*wsf=(float*)(shm+LDS_WS)+wid*64;
  const bf16*ksrc=Kh+(long)lane*KP+wid*8;
  const bf16*vsrc=Vh+(long)(16*(wid&3)+(lane>>2))*VP+(wid>>2)*32+(lane&3)*8;
  const unsigned kdst=lds0+LDS_K+wid*1024, vdst=lds0+LDS_V+wid*1024;
  #define DMA_K(t,slot) glds16(ksrc+(long)(t)*KVBLK*KP,(unsigned)__builtin_amdgcn_readfirstlane(kdst+(slot)))
  #define DMA_V(t,slot) glds16(vsrc+(long)(t)*KVBLK*VP,(unsigned)__builtin_amdgcn_readfirstlane(vdst+(slot)))
  const int vb0=(int)(lds0+LDS_V)+((lane>>4)&1)*32+(lane&3)*8+(4*hi+((lane&15)>>2))*64;
  const char*Kbase=shm+LDS_K; bf16x8 kf[8];
  const lds_cptr shm3=(lds_cptr)shm; const lds_cptr kp0=shm3+LDS_K+hi*1024+r32*16; const lds_cptr vp0=shm3+LDS_V+((lane>>4)&1)*32+(lane&3)*8+(4*hi+((lane&15)>>2))*64;
  const int NT=(q0+QB)/KVBLK;
  DMA_K(0,0);DMA_V(0,0);DMA_K(1,SLOTB);
  bf16x8 qr[4];
  #pragma unroll
  for(int d0=0;d0<4;++d0)qr[d0]=*reinterpret_cast<const bf16x8*>(&Qw[(long)r32*QP+d0*16+hi*8]);
  float mhat=0.f,l_reg=0.f;f32x16 o[2];o[0]=f32x16{};o[1]=f32x16{};f32x16 negm=f32x16{};asm volatile("":"+v"(negm));
  const int qrel=wid*QBLK+r32;
  #define CMASK(P0,P1,t) do{int jb_=(t)-(NT-4); if(jb_>=0)cmask(P0,P1,jb_,qrel,hi);}while(0)
  bool resc=false;
  #define START(P0,P1) do{ const float rm=rowmax(P0,P1); resc=false; \
    { const float dl=rm; mhat=fadd_s(mhat,dl); \
      _Pragma("unroll") for(int r=0;r<16;++r){P0[r]=fsub_s(P0[r],dl);P1[r]=fsub_s(P1[r],dl);} \
      _Pragma("unroll") for(int r=0;r<16;++r)negm[r]=-mhat; asm volatile("":"+v"(negm)); } \
    _Pragma("unroll") for(int r=0;r<16;++r)P0[r]=__builtin_amdgcn_exp2f(P0[r]); }while(0)
  #define RESC() do{ if(resc){ asm volatile("s_waitcnt lgkmcnt(0)":::"memory"); \
      _Pragma("unroll") for(int d_=0;d_<2;++d_) _Pragma("unroll") for(int r=0;r<16;++r)o[d_][r]*=wsf[crow(r,hi)]; } }while(0)
  f32x16 pA0,pA1,pB0,pB1;
  int sl_prev=0,sl_cur=0,sl_next=SLOTB;
  #define ROT() do{sl_prev=sl_cur;sl_cur=sl_next;sl_next=(sl_next==(NSLOT-1)*SLOTB)?0:sl_next+SLOTB;}while(0)
  DMA_K(2,2*SLOTB);
  WAIT_BAR(3);
  qkt(pA0,pA1,Kbase,qr,negm,r32,hi);asm volatile("s_nop 15\n\ts_nop 7":"+v"(pA0),"+v"(pA1));CMASK(pA0,pA1,0);
  START(pA0,pA1);
  _Pragma("unroll") for(int r=0;r<16;++r)pA1[r]=__builtin_amdgcn_exp2f(pA1[r]);
  WAIT_BAR(0);
  DMA_K(3,0);DMA_V(1,SLOTB);
  ROT();
  kload8(kf,kp0+sl_cur);
  WAIT_BAR(2);
  s16x4 vlo[8],vhi[8]; u32x4 pw0,pw1,pw2,pw3;
  #define PKW(P,B) cvtpk_s(P[B],P[B+1])
  #define PAF(k) __builtin_bit_cast(bf16x8,pw##k)
  #define VFR(i) (bf16x8){vlo[i][0],vlo[i][1],vlo[i][2],vlo[i][3],vhi[i][0],vhi[i][1],vhi[i][2],vhi[i][3]}
  #define PIN(x) asm volatile("":"+v"(x))
  #define MX3(a,b,c) __builtin_fmaxf(__builtin_fmaxf((a),(b)),(c))
  #define GAPA(MF,A0,A1,A2,A3,W0,W1,PW) do{ MF; sacc+=A0; sacc+=A1; sacc+=A2; sacc+=A3; PIN(sacc); W0; W1; PIN(PW); SBAR(); }while(0)
  #define EX(v) __builtin_amdgcn_exp2f(v)
  #define GAPB(MF,X,B) do{ MF; X[B]=EX(X[B]); X[B+1]=EX(X[B+1]); X[B+2]=EX(X[B+2]); X[B+3]=EX(X[B+3]); PIN(X); SBAR(); }while(0)
  #define VRD(i) do{ vlo[i]=vtr(vp_+(((i)>>2)*4096+((i)&3)*1024)); vhi[i]=vtr(vp_+(((i)>>2)*4096+((i)&3)*1024+512)); }while(0)
  #define KRD(G,j) do{ if(G){ kload2(kf,kp0+sl_next,j); SBAR(); } }while(0)
  #define STEP(C0,C1,P0,P1,t,GK,GV,GL) do{ SBAR(); \
    const lds_cptr vp_=vp0+sl_prev; \
    VRD(0); SBAR(); float sacc=(P0[0]+P0[1]); \
    GAPA(C0=__builtin_amdgcn_mfma_f32_32x32x16_bf16(kf[0],qr[0],negm,0,0,0), P0[2],P0[3],P0[4],P0[5],     pw0[0]=PKW(P0,0), pw0[1]=PKW(P0,2), pw0); \
    VRD(4); SBAR(); GAPA(C1=__builtin_amdgcn_mfma_f32_32x32x16_bf16(kf[1],qr[0],negm,0,0,0), P0[6],P0[7],P0[8],P0[9],     pw0[2]=PKW(P0,4), pw0[3]=PKW(P0,6), pw0); \
    VRD(1); SBAR(); GAPA(C0=__builtin_amdgcn_mfma_f32_32x32x16_bf16(kf[2],qr[1],C0,0,0,0),   P0[10],P0[11],P0[12],P0[13], pw1[0]=PKW(P0,8), pw1[1]=PKW(P0,10), pw1); \
    VRD(5); SBAR(); GAPA(C1=__builtin_amdgcn_mfma_f32_32x32x16_bf16(kf[3],qr[1],C1,0,0,0),   P0[14],P0[15],P1[0],P1[1],   pw1[2]=PKW(P0,12),pw1[3]=PKW(P0,14), pw1); \
    VRD(2); SBAR(); GAPA(C0=__builtin_amdgcn_mfma_f32_32x32x16_bf16(kf[4],qr[2],C0,0,0,0),   P1[2],P1[3],P1[4],P1[5],     pw2[0]=PKW(P1,0), pw2[1]=PKW(P1,2), pw2); \
    VRD(6); SBAR(); GAPA(C1=__builtin_amdgcn_mfma_f32_32x32x16_bf16(kf[5],qr[2],C1,0,0,0),   P1[6],P1[7],P1[8],P1[9],     pw2[2]=PKW(P1,4), pw2[3]=PKW(P1,6), pw2); \
    VRD(3); SBAR(); GAPA(C0=__builtin_amdgcn_mfma_f32_32x32x16_bf16(kf[6],qr[3],C0,0,0,0),   P1[10],P1[11],P1[12],P1[13], pw3[0]=PKW(P1,8), pw3[1]=PKW(P1,10), pw3); \
    VRD(7); SBAR(); GAPA(C1=__builtin_amdgcn_mfma_f32_32x32x16_bf16(kf[7],qr[3],C1,0,0,0),   P1[14],P1[15],0.f,0.f,       pw3[2]=PKW(P1,12),pw3[3]=PKW(P1,14), pw3); \
    l_reg+=sacc; \
    if(GK){DMA_K((t)+3,sl_cur);} if(GV){DMA_V((t)+1,sl_next);} \
    CMASK(C0,C1,t); \
    { float a=MX3(C0[0],C0[1],C1[0]),b=MX3(C0[2],C0[3],C1[1]); a=MX3(a,C1[2],C1[3]); \
      _Pragma("unroll") for(int r=4;r<16;r+=4){a=MX3(a,C0[r],C0[r+1]);b=MX3(b,C0[r+2],C0[r+3]);a=MX3(a,C1[r],C1[r+1]);b=MX3(b,C1[r+2],C1[r+3]);} \
      float rm=__builtin_fmaxf(a,b); { auto rr=__builtin_amdgcn_permlane32_swap(__float_as_uint(rm),__float_as_uint(rm),false,false); rm=__builtin_fmaxf(__uint_as_float(rr[0]),__uint_as_float(rr[1])); } \
      resc=false; \
      if(__builtin_expect(__any(rm>(float)THRL),0)){ const float dl=__builtin_fmaxf(rm,0.f); mhat+=dl; \
        _Pragma("unroll") for(int r=0;r<16;++r){C0[r]-=dl;C1[r]-=dl;} \
        _Pragma("unroll") for(int r=0;r<16;++r)negm[r]=-mhat; asm volatile("":"+v"(negm)); \
        const float f=__builtin_amdgcn_exp2f(-dl); l_reg*=f; if(hi==0)wsf[r32]=f; resc=true; } } \
    SBAR(); \
    GAPB(o[0]=__builtin_amdgcn_mfma_f32_32x32x16_bf16(PAF(0),VFR(0),o[0],0,0,0), C0,0); \
    GAPB(o[1]=__builtin_amdgcn_mfma_f32_32x32x16_bf16(PAF(0),VFR(4),o[1],0,0,0), C0,4); \
    KRD(GL,0); GAPB(o[0]=__builtin_amdgcn_mfma_f32_32x32x16_bf16(PAF(1),VFR(1),o[0],0,0,0), C0,8); \
    KRD(GL,1); GAPB(o[1]=__builtin_amdgcn_mfma_f32_32x32x16_bf16(PAF(1),VFR(5),o[1],0,0,0), C0,12); \
    KRD(GL,2); GAPB(o[0]=__builtin_amdgcn_mfma_f32_32x32x16_bf16(PAF(2),VFR(2),o[0],0,0,0), C1,0); \
    KRD(GL,3); GAPB(o[1]=__builtin_amdgcn_mfma_f32_32x32x16_bf16(PAF(2),VFR(6),o[1],0,0,0), C1,4); \
    GAPB(o[0]=__builtin_amdgcn_mfma_f32_32x32x16_bf16(PAF(3),VFR(3),o[0],0,0,0), C1,8); \
    GAPB(o[1]=__builtin_amdgcn_mfma_f32_32x32x16_bf16(PAF(3),VFR(7),o[1],0,0,0), C1,12); \
    }while(0)
  int t=1;
  #undef CMASK
  #define CMASK(P0,P1,t) do{}while(0)
  for(;t+5<NT;t+=2){
    STEP(pB0,pB1,pA0,pA1,t,true,true,true);     WAIT_BAR(2); RESC(); ROT();
    STEP(pA0,pA1,pB0,pB1,t+1,true,true,true);   WAIT_BAR(2); RESC(); ROT();
  }
  #undef CMASK
  #define CMASK(P0,P1,t) do{int jb_=(t)-(NT-4); if(jb_>=0)cmask(P0,P1,jb_,qrel,hi);}while(0)
  #define ENDW(tt) do{ if((tt)+3<NT){WAIT_BAR(2);} else if((tt)+2<NT){WAIT_BAR(1);} else {WAIT_BAR(0);} }while(0)
  for(;t+1<NT;t+=2){
    STEP(pB0,pB1,pA0,pA1,t,(t+3<NT),(t+1<NT),(t+1<NT));       ENDW(t);   RESC(); ROT();
    STEP(pA0,pA1,pB0,pB1,t+1,(t+4<NT),(t+2<NT),(t+2<NT));     ENDW(t+1); RESC(); ROT();
  }
  STEP(pB0,pB1,pA0,pA1,NT-1,false,false,false); RESC();
  { float sacc=pB0[0]+pB0[1]; _Pragma("unroll") for(int r=2;r<16;++r)sacc+=pB0[r]; _Pragma("unroll") for(int r=0;r<16;++r)sacc+=pB1[r]; l_reg+=sacc;
    pw0=(u32x4){PKW(pB0,0),PKW(pB0,2),PKW(pB0,4),PKW(pB0,6)};pw1=(u32x4){PKW(pB0,8),PKW(pB0,10),PKW(pB0,12),PKW(pB0,14)};pw2=(u32x4){PKW(pB1,0),PKW(pB1,2),PKW(pB1,4),PKW(pB1,6)};pw3=(u32x4){PKW(pB1,8),PKW(pB1,10),PKW(pB1,12),PKW(pB1,14)};
    SBAR(); pv(o,vb0+sl_cur,PAF(0),PAF(1),PAF(2),PAF(3)); }
  #undef PKW
  #undef PAF
  #undef VFR
  #undef PIN
  #undef MX3
  #undef GAPA
  #undef GAPB
  #undef EX
  #undef VRD
  #undef KRD
  #undef STEP
  #undef ENDW
  {auto rr=__builtin_amdgcn_permlane32_swap(__float_as_uint(l_reg),__float_as_uint(l_reg),false,false);l_reg=__uint_as_float(rr[0])+__uint_as_float(rr[1]);}
  if(hi==0)wsf[32+r32]=l_reg;asm volatile("s_waitcnt lgkmcnt(0)":::"memory");
  float rli[16];
  #pragma unroll
  for(int r=0;r<16;++r)rli[r]=__builtin_amdgcn_rcpf(wsf[32+crow(r,hi)]);
  bf16*Ow=O+(long)(q0+wid*QBLK)*OP;
  { bf16*stg=(bf16*)(shm+LDS_OST)+wid*2048;
    #pragma unroll
    for(int r=0;r<16;++r){const int orow=crow(r,hi);
      #pragma unroll
      for(int d0=0;d0<2;++d0)stg[orow*64+d0*32+r32]=__float2bfloat16(o[d0][r]*rli[r]);}
    asm volatile("s_waitcnt lgkmcnt(0)":::"memory");
    #pragma unroll
    for(int i=0;i<4;++i){const int row=i*8+(lane>>3),ch=lane&7; const u32x4 v=*(const u32x4*)(stg+row*64+ch*8); ATTN_STORE16(Ow+(long)row*OP+ch*8,v);} }
  asm volatile("s_waitcnt lgkmcnt(0)\n\ts_barrier":::"memory");
  #undef DMA_K
  #undef DMA_V
  #undef CMASK
  #undef START
  #undef RESC
  #undef ROT
}

constexpr int SLOTV=16384, L2_K=0, L2_V=NSLOT*SLOTB, L2_WS=L2_V+NSLOT*SLOTV, L2_BYTES=L2_WS+NW*64*4;
__device__ __forceinline__ void qkt0(f32x16&p0,f32x16&p1,const char*Kslot,const bf16x8*qr,int r32,int hi){
  const char*kb=Kslot+hi*1024+r32*16; const f32x16 z=f32x16{};
  #pragma unroll
  for(int d0=0;d0<4;++d0){
    const bf16x8 b0=*reinterpret_cast<const bf16x8*>(kb+d0*2048);
    const bf16x8 b1=*reinterpret_cast<const bf16x8*>(kb+d0*2048+512);
    if(d0==0){p0=__builtin_amdgcn_mfma_f32_32x32x16_bf16(b0,qr[0],z,0,0,0);p1=__builtin_amdgcn_mfma_f32_32x32x16_bf16(b1,qr[0],z,0,0,0);}
    else{p0=__builtin_amdgcn_mfma_f32_32x32x16_bf16(b0,qr[d0],p0,0,0,0);p1=__builtin_amdgcn_mfma_f32_32x32x16_bf16(b1,qr[d0],p1,0,0,0);}}
}
__device__ __forceinline__ void pv128(f32x16*o,int vb,bf16x8 pa0,bf16x8 pa1,bf16x8 pa2,bf16x8 pa3){
  #pragma unroll
  for(int d0=0;d0<4;++d0){s16x4 lo[4],hi[4];
    #pragma unroll
    for(int ks=0;ks<4;++ks){
      asm volatile("ds_read_b64_tr_b16 %0,%1 offset:%c2":"=&v"(lo[ks]):"v"(vb),"i"(d0*4096+ks*1024):"memory");
      asm volatile("ds_read_b64_tr_b16 %0,%1 offset:%c2":"=&v"(hi[ks]):"v"(vb),"i"(d0*4096+ks*1024+512):"memory");}
    asm volatile("s_waitcnt lgkmcnt(0)":::"memory");SBAR();
    #define PK(k) (bf16x8){lo[k][0],lo[k][1],lo[k][2],lo[k][3],hi[k][0],hi[k][1],hi[k][2],hi[k][3]}
    o[d0]=__builtin_amdgcn_mfma_f32_32x32x16_bf16(pa0,PK(0),o[d0],0,0,0);
    o[d0]=__builtin_amdgcn_mfma_f32_32x32x16_bf16(pa1,PK(1),o[d0],0,0,0);
    o[d0]=__builtin_amdgcn_mfma_f32_32x32x16_bf16(pa2,PK(2),o[d0],0,0,0);
    o[d0]=__builtin_amdgcn_mfma_f32_32x32x16_bf16(pa3,PK(3),o[d0],0,0,0);
    #undef PK
  }
}
template<int THRL> __device__ __forceinline__ void attn_unit128(int qb,const bf16*Q,const bf16*__restrict__ K,const bf16*__restrict__ V,bf16*O,char*shm){
  int tid_=threadIdx.x; asm volatile("":"+v"(tid_)); const int tid=tid_,lane=tid&63,r32=lane&31,hi=lane>>5; const int wid=__builtin_amdgcn_readfirstlane(tid>>6);
  const int q0=qb*QB;
  const bf16*Qw=Q+(long)(q0+wid*QBLK)*QP;
  const unsigned lds0=(unsigned)(uintptr_t)shm;
  float*wsf=(float*)(shm+L2_WS)+wid*64;
  const bf16*ksrc=K+(long)lane*KP+wid*8;
  const bf16*vsrc=V+(long)(16*(wid&3)+(lane>>2))*VP+(wid>>2)*32+(lane&3)*8;
  const unsigned kdst=lds0+L2_K+wid*1024, vdst=lds0+L2_V+wid*1024;
  #define DMA_K(t,slot) glds16(ksrc+(long)(t)*KVBLK*KP,(unsigned)__builtin_amdgcn_readfirstlane(kdst+(slot)))
  #define DMA_V(t,slot) do{ glds16(vsrc+(long)(t)*KVBLK*VP,(unsigned)__builtin_amdgcn_readfirstlane(vdst+2*(slot))); glds16(vsrc+64+(long)(t)*KVBLK*VP,(unsigned)__builtin_amdgcn_readfirstlane(vdst+2*(slot)+8192)); }while(0)
  const int vb0=(int)(lds0+L2_V)+((lane>>4)&1)*32+(lane&3)*8+(4*hi+((lane&15)>>2))*64;
  const char*Kbase=shm+L2_K; bf16x8 kf[8];
  const lds_cptr shm3=(lds_cptr)shm; const lds_cptr kp0=shm3+L2_K+hi*1024+r32*16; const lds_cptr vp0=shm3+L2_V+((lane>>4)&1)*32+(lane&3)*8+(4*hi+((lane&15)>>2))*64;
  const int NT=(q0+QB)/KVBLK;
  DMA_K(0,0);DMA_V(0,0);DMA_K(1,SLOTB);
  bf16x8 qr[4];
  #pragma unroll
  for(int d0=0;d0<4;++d0)qr[d0]=*reinterpret_cast<const bf16x8*>(&Qw[(long)r32*QP+d0*16+hi*8]);
  float l_reg=0.f;f32x16 o[4];
  ;o[0]=f32x16{};o[1]=f32x16{};o[2]=f32x16{};o[3]=f32x16{};
  const int qrel=wid*QBLK+r32;
  #define CMASK(P0,P1,t) do{int jb_=(t)-(NT-4); if(jb_>=0)cmask(P0,P1,jb_,qrel,hi);}while(0)
  #define RESC() do{}while(0)
  f32x16 pA0,pA1,pB0,pB1;
  int sl_prev=0,sl_cur=0,sl_next=SLOTB;
  #define ROT() do{sl_prev=sl_cur;sl_cur=sl_next;sl_next=(sl_next==(NSLOT-1)*SLOTB)?0:sl_next+SLOTB;}while(0)
  DMA_K(2,2*SLOTB);
  WAIT_BAR(4);
  qkt0(pA0,pA1,Kbase,qr,r32,hi);asm volatile("s_nop 15\n\ts_nop 7":"+v"(pA0),"+v"(pA1));CMASK(pA0,pA1,0);
  { _Pragma("unroll") for(int r=0;r<16;++r){pA0[r]=__builtin_amdgcn_exp2f(pA0[r]);pA1[r]=__builtin_amdgcn_exp2f(pA1[r]);} }
  WAIT_BAR(0);
  DMA_K(3,0);DMA_V(1,SLOTB);
  ROT();
  kload8(kf,kp0+sl_cur);
  WAIT_BAR(3);
  s16x4 vlo[8],vhi[8],vlo2[8],vhi2[8]; u32x4 pw0,pw1,pw2,pw3;
  #define PKW(P,B) cvtpk_s(P[B],P[B+1])
  #define PAF(k) __builtin_bit_cast(bf16x8,pw##k)
  #define VFR(i) (bf16x8){vlo[i][0],vlo[i][1],vlo[i][2],vlo[i][3],vhi[i][0],vhi[i][1],vhi[i][2],vhi[i][3]}
  #define VFR2(i) (bf16x8){vlo2[i][0],vlo2[i][1],vlo2[i][2],vlo2[i][3],vhi2[i][0],vhi2[i][1],vhi2[i][2],vhi2[i][3]}
  #define PIN(x) asm volatile("":"+v"(x))
  #define MX3(a,b,c) __builtin_fmaxf(__builtin_fmaxf((a),(b)),(c))
  #define GAPA(MF,A0,A1,A2,A3,W0,W1,PW) do{ MF; sacc+=A0; sacc+=A1; sacc+=A2; sacc+=A3; PIN(sacc); W0; W1; PIN(PW); SBAR(); }while(0)
  #define EX(v) __builtin_amdgcn_exp2f(v)
  #define GAPB(MF,X,B) do{ MF; X[B]=EX(X[B]); X[B+1]=EX(X[B+1]); PIN(X); SBAR(); }while(0)
  #define VRD(i) do{ vlo[i]=vtr(vp_+(((i)>>2)*4096+((i)&3)*1024)); vhi[i]=vtr(vp_+(((i)>>2)*4096+((i)&3)*1024+512)); }while(0)
  #define VRD2(i) do{ vlo2[i]=vtr(vp_+(8192+((i)>>2)*4096+((i)&3)*1024)); vhi2[i]=vtr(vp_+(8192+((i)>>2)*4096+((i)&3)*1024+512)); SBAR(); }while(0)
  #define KRD(G,j) do{ if(G){ kload2(kf,kp0+sl_next,j); SBAR(); } }while(0)
  #define MF32(a,b,c) __builtin_amdgcn_mfma_f32_32x32x16_bf16(a,b,c,0,0,0)
  #define STEP(C0,C1,P0,P1,t,GK,GV,GL) do{ SBAR(); \
    const lds_cptr vp_=vp0+2*sl_prev; const f32x16 z16_=f32x16{}; \
    VRD(0); SBAR(); float sacc=(P0[0]+P0[1]); \
    GAPA(C0=MF32(kf[0],qr[0],z16_), P0[2],P0[3],P0[4],P0[5],     pw0[0]=PKW(P0,0), pw0[1]=PKW(P0,2), pw0); \
    VRD(4); SBAR(); GAPA(C1=MF32(kf[1],qr[0],z16_), P0[6],P0[7],P0[8],P0[9],     pw0[2]=PKW(P0,4), pw0[3]=PKW(P0,6), pw0); \
    VRD(1); SBAR(); GAPA(C0=MF32(kf[2],qr[1],C0),   P0[10],P0[11],P0[12],P0[13], pw1[0]=PKW(P0,8), pw1[1]=PKW(P0,10), pw1); \
    VRD(5); SBAR(); GAPA(C1=MF32(kf[3],qr[1],C1),   P0[14],P0[15],P1[0],P1[1],   pw1[2]=PKW(P0,12),pw1[3]=PKW(P0,14), pw1); \
    VRD(2); SBAR(); GAPA(C0=MF32(kf[4],qr[2],C0),   P1[2],P1[3],P1[4],P1[5],     pw2[0]=PKW(P1,0), pw2[1]=PKW(P1,2), pw2); \
    VRD(6); SBAR(); GAPA(C1=MF32(kf[5],qr[2],C1),   P1[6],P1[7],P1[8],P1[9],     pw2[2]=PKW(P1,4), pw2[3]=PKW(P1,6), pw2); \
    VRD(3); SBAR(); GAPA(C0=MF32(kf[6],qr[3],C0),   P1[10],P1[11],P1[12],P1[13], pw3[0]=PKW(P1,8), pw3[1]=PKW(P1,10), pw3); \
    VRD(7); SBAR(); GAPA(C1=MF32(kf[7],qr[3],C1),   P1[14],P1[15],0.f,0.f,       pw3[2]=PKW(P1,12),pw3[3]=PKW(P1,14), pw3); \
    l_reg+=sacc; \
    if(GK){DMA_K((t)+3,sl_cur);} if(GV){DMA_V((t)+1,sl_next);} \
    CMASK(C0,C1,t); \
    SBAR(); \
    VRD2(0); GAPB(o[0]=MF32(PAF(0),VFR(0),o[0]), C0,0); \
    VRD2(4); GAPB(o[1]=MF32(PAF(0),VFR(4),o[1]), C0,2); \
    VRD2(1); GAPB(o[0]=MF32(PAF(1),VFR(1),o[0]), C0,4); \
    VRD2(5); GAPB(o[1]=MF32(PAF(1),VFR(5),o[1]), C0,6); \
    VRD2(2); GAPB(o[0]=MF32(PAF(2),VFR(2),o[0]), C0,8); \
    VRD2(6); GAPB(o[1]=MF32(PAF(2),VFR(6),o[1]), C0,10); \
    VRD2(3); GAPB(o[0]=MF32(PAF(3),VFR(3),o[0]), C0,12); \
    VRD2(7); GAPB(o[1]=MF32(PAF(3),VFR(7),o[1]), C0,14); \
    GAPB(o[2]=MF32(PAF(0),VFR2(0),o[2]), C1,0); \
    GAPB(o[3]=MF32(PAF(0),VFR2(4),o[3]), C1,2); \
    KRD(GL,0); GAPB(o[2]=MF32(PAF(1),VFR2(1),o[2]), C1,4); \
    KRD(GL,1); GAPB(o[3]=MF32(PAF(1),VFR2(5),o[3]), C1,6); \
    KRD(GL,2); GAPB(o[2]=MF32(PAF(2),VFR2(2),o[2]), C1,8); \
    KRD(GL,3); GAPB(o[3]=MF32(PAF(2),VFR2(6),o[3]), C1,10); \
    GAPB(o[2]=MF32(PAF(3),VFR2(3),o[2]), C1,12); \
    GAPB(o[3]=MF32(PAF(3),VFR2(7),o[3]), C1,14); \
    }while(0)
  int t=1;
  #undef CMASK
  #define CMASK(P0,P1,t) do{}while(0)
  for(;t+5<NT;t+=2){
    STEP(pB0,pB1,pA0,pA1,t,true,true,true);     WAIT_BAR(3); RESC(); ROT();
    STEP(pA0,pA1,pB0,pB1,t+1,true,true,true);   WAIT_BAR(3); RESC(); ROT();
  }
  #undef CMASK
  #define CMASK(P0,P1,t) do{int jb_=(t)-(NT-4); if(jb_>=0)cmask(P0,P1,jb_,qrel,hi);}while(0)
  #define ENDW(tt) do{ if((tt)+3<NT){WAIT_BAR(3);} else if((tt)+2<NT){WAIT_BAR(2);} else {WAIT_BAR(0);} }while(0)
  for(;t+1<NT;t+=2){
    STEP(pB0,pB1,pA0,pA1,t,(t+3<NT),(t+1<NT),(t+1<NT));       ENDW(t);   RESC(); ROT();
    STEP(pA0,pA1,pB0,pB1,t+1,(t+4<NT),(t+2<NT),(t+2<NT));     ENDW(t+1); RESC(); ROT();
  }
  STEP(pB0,pB1,pA0,pA1,NT-1,false,false,false); RESC();
  { float sacc=pB0[0]+pB0[1]; _Pragma("unroll") for(int r=2;r<16;++r)sacc+=pB0[r]; _Pragma("unroll") for(int r=0;r<16;++r)sacc+=pB1[r]; l_reg+=sacc;
    pw0=(u32x4){PKW(pB0,0),PKW(pB0,2),PKW(pB0,4),PKW(pB0,6)};pw1=(u32x4){PKW(pB0,8),PKW(pB0,10),PKW(pB0,12),PKW(pB0,14)};pw2=(u32x4){PKW(pB1,0),PKW(pB1,2),PKW(pB1,4),PKW(pB1,6)};pw3=(u32x4){PKW(pB1,8),PKW(pB1,10),PKW(pB1,12),PKW(pB1,14)};
    SBAR(); pv128(o,vb0+2*sl_cur,PAF(0),PAF(1),PAF(2),PAF(3)); }
  #undef PKW
  #undef PAF
  #undef VFR
  #undef VFR2
  #undef PIN
  #undef MX3
  #undef GAPA
  #undef GAPB
  #undef EX
  #undef VRD
  #undef VRD2
  #undef KRD
  #undef MF32
  #undef STEP
  #undef ENDW
  {auto rr=__builtin_amdgcn_permlane32_swap(__float_as_uint(l_reg),__float_as_uint(l_reg),false,false);l_reg=__uint_as_float(rr[0])+__uint_as_float(rr[1]);}
  if(hi==0)wsf[32+r32]=l_reg;asm volatile("s_waitcnt lgkmcnt(0)":::"memory");
  float rli[16];
  #pragma unroll
  for(int r=0;r<16;++r)rli[r]=__builtin_amdgcn_rcpf(wsf[32+crow(r,hi)]);
  asm volatile("s_waitcnt lgkmcnt(0)\n\ts_barrier":::"memory");
  bf16*Ow=O+(long)(q0+wid*QBLK)*OP;
  { bf16*stg=(bf16*)(shm)+wid*4096;
    #pragma unroll
    for(int r=0;r<16;++r){const int orow=crow(r,hi);
      #pragma unroll
      for(int d0=0;d0<4;++d0)stg[orow*128+d0*32+r32]=__float2bfloat16(o[d0][r]*rli[r]);}
    asm volatile("s_waitcnt lgkmcnt(0)":::"memory");
    #pragma unroll
    for(int i=0;i<8;++i){const int row=i*4+(lane>>4),ch=lane&15; const u32x4 v=*(const u32x4*)(stg+row*128+ch*8); ATTN_STORE16(Ow+(long)row*OP+ch*8,v);} }
  asm volatile("s_waitcnt lgkmcnt(0)\n\ts_barrier":::"memory");
  #undef DMA_K
  #undef DMA_V
  #undef CMASK
  #undef RESC
  #undef ROT
}
constexpr int ATTN_LDS_BYTES=LDS_BYTES;
#undef SBAR
#undef WAIT_BAR
}
#ifndef REPEAT_PHASE
#define REPEAT_PHASE -1
#endif
constexpr int NWAVES = 8;
using cfg::T; using cfg::SEQ; using cfg::D; using cfg::NIN; using cfg::NE; using cfg::EPS; using cfg::MAXROWS;

constexpr size_t MiB = 1u << 20;
constexpr size_t WS_CTL = 0, CTL_ZERO_BYTES = 1 * MiB;
constexpr size_t WS_RCOS = 1 * MiB, WS_RSIN = 2 * MiB;
constexpr size_t WS_TKE = 3 * MiB, WS_TKP = WS_TKE + 256 * 1024, WS_TKG = WS_TKP + 256 * 1024, WS_TSLOT = WS_TKG + 256 * 1024;
constexpr size_t WS_RGATE = 4 * MiB;
constexpr size_t WS_BLKBASE = 4 * MiB + 512 * 1024;
constexpr size_t WS_SSQ = 5 * MiB;
constexpr size_t WS_WIN = 8 * MiB;
constexpr size_t WS_WBR = 23 * MiB;
constexpr size_t WS_WOUT = 26 * MiB;
constexpr size_t WS_WGU = 28 * MiB;
constexpr size_t WS_WDN = 156 * MiB;
constexpr size_t WS_HN = 220 * MiB;
constexpr size_t WS_KVM = 254 * MiB;
constexpr size_t WS_Q = 256 * MiB, WS_K = 272 * MiB, WS_V = 288 * MiB, WS_U = 304 * MiB, WS_CB = 320 * MiB, WS_MQ = 336 * MiB;
constexpr size_t WS_GATES = 352 * MiB;
constexpr size_t WS_OMAPS = 448 * MiB;
constexpr size_t WS_YALL = 480 * MiB;
constexpr size_t WS_MERGED = 528 * MiB;
constexpr size_t WS_H2 = 560 * MiB;
constexpr size_t WS_XS = 256 * MiB;
constexpr size_t WS_ACT = 400 * MiB;
constexpr size_t WS_HN8 = 576 * MiB;
constexpr size_t WS_WG8 = 592 * MiB;
constexpr size_t WS_END = 596 * MiB;
static_assert(WS_XS + (size_t)MAXROWS * 2048 <= WS_ACT && WS_ACT + (size_t)MAXROWS * 2048 <= WS_H2, "MoE overlays");
constexpr int CW_QUEUE = 1024;
constexpr int CW_GCNT = 64;
constexpr int CW_BAR = 4096;
constexpr int RING_OFF = 0, RING_BYTES = 131072;
constexpr int LDSCTL_OFF = RING_BYTES, MISC_OFF = LDSCTL_OFF + 320;
constexpr int L_PREFT = LDSCTL_OFF + 1024, L_PSTART = L_PREFT + 256, L_LCNT = L_PSTART + 256, L_LBASE = L_LCNT + 128;
constexpr int L_PART = LDSCTL_OFF + 8192;
constexpr int L_WSF = LDSCTL_OFF + 4096;
constexpr int LDS_BYTES = 163840;
constexpr int CONV_SLOTS = LDSCTL_OFF;

struct NoHooks { __device__ __forceinline__ void a_ready(const pg8::Unit&) const {} __device__ __forceinline__ void done(const pg8::Unit&) const {} };
struct ProjOrder : NoHooks {
    const char* A; const char* Bt; int G, c;
    __device__ __forceinline__ bool next(int i, pg8::Unit& u) const {
        const int L = i * G + c; int pm, pn;
        if (L < 64 * 14) pg8::static_map(L, 64, 14, pm, pn); else if (L < 64 * 14 + 8) { pm = 64 + ((L - 64 * 14) >> 2); pn = 26 + ((L - 64 * 14) & 3); } else return false;
        u.pm = pm; u.pn = pn; u.aux = 0; u.a = A + (size_t)pm * (256 * 2048); u.b = Bt + (size_t)pn * (256 * 2048); return true; }
};
struct GateOrder : NoHooks {
    const char* A; const char* Bt; int G, c;
    __device__ __forceinline__ bool next(int i, pg8::Unit& u) const {
        const int L = i * G + c; if (L >= 64 * 12) return false; int pm, pn; pg8::static_map(L, 64, 12, pm, pn);
        u.pm = pm; u.pn = pn; u.aux = 0; u.a = A + (size_t)pm * (256 * 1024); u.b = Bt + (size_t)pn * (256 * 1024); return true; }
};
struct MergeOrder : NoHooks {
    const char* Y; const char* Bt; int G, c;
    __device__ __forceinline__ bool next(int i, pg8::Unit& u) const {
        const int j = i / 3, br = i - 3 * j; const int L = j * G + c; if (L >= 256) return false; int pm, pn; pg8::static_map(L, 64, 4, pm, pn);
        u.pm = pm; u.pn = pn; u.aux = br; u.a = Y + (size_t)pm * (256 * 3072) + br * 1024; u.b = Bt + (size_t)(br * 1024 + pn * 256) * 1024; return true; }
};
struct OutOrder : NoHooks {
    const char* A; const char* Bt; int G, c;
    __device__ __forceinline__ bool next(int i, pg8::Unit& u) const {
        const int L = i * G + c; if (L >= 256) return false; int pm, pn; pg8::static_map(L, 64, 4, pm, pn);
        u.pm = pm; u.pn = pn; u.aux = 0; u.a = A + (size_t)pm * (256 * 2048); u.b = Bt + (size_t)pn * (256 * 2048); return true; }
};
struct MoeOrder : NoHooks {
    const char* A; const char* Bt; const volatile __attribute__((address_space(3))) int* prefT; int ncol, G, c; size_t tile_bytes;
    __device__ __forceinline__ bool next(int i, pg8::Unit& u) const {
        const int L = i * G + c; const int rt = L / ncol, pnl = L - rt * ncol; if (rt >= prefT[32]) return false;
        int e = 0; while (prefT[e + 1] <= rt) ++e;
        u.pm = rt; u.pn = e * ncol + pnl; u.aux = e; u.a = A + (size_t)rt * tile_bytes; u.b = Bt + (size_t)(e * ncol + pnl) * tile_bytes; return true; }
};

#define GAS __attribute__((address_space(1)))
#define LAS __attribute__((address_space(3)))
typedef unsigned short bf16;
typedef unsigned v4u __attribute__((ext_vector_type(4)));
typedef unsigned v2u __attribute__((ext_vector_type(2)));
typedef float f32x4 __attribute__((ext_vector_type(4)));
typedef float f32x16 __attribute__((ext_vector_type(16)));
typedef short bf16x8 __attribute__((ext_vector_type(8)));
typedef GAS unsigned gu32;
#define RLX_AGENT __ATOMIC_RELAXED, __HIP_MEMORY_SCOPE_AGENT
#define LDS_WAIT() asm volatile("s_waitcnt lgkmcnt(0)" ::: "memory")
#define VM_WAIT() asm volatile("s_waitcnt vmcnt(0)" ::: "memory")
__device__ __forceinline__ unsigned f2bf(float f) { unsigned u = __builtin_bit_cast(unsigned, f); return (u + 0x7fffu + ((u >> 16) & 1u)) >> 16; }
__device__ __forceinline__ unsigned pk2(float lo, float hi) { return f2bf(lo) | (f2bf(hi) << 16); }
__device__ __forceinline__ float bflo(unsigned w) { return __uint_as_float(w << 16); }
__device__ __forceinline__ float bfhi(unsigned w) { return __uint_as_float(w & 0xffff0000u); }
__device__ __forceinline__ float wave_sum(float v) {
#pragma unroll
    for (int o = 1; o < 64; o <<= 1) v += __shfl_xor(v, o);
    return v;
}

#define XB_TMO      128
#define XB_XCNT(j)  (256  + 64 * (j))
#define XB_XSUB(j)  (1280 + 64 * (j))
#define XB_XGEN(j)  (2304 + 64 * (j))
#define XB_TOP      3328
#define XB_TOPGEN   3392
#define XCD_BAR_WORDS 3456
#define XB_SPIN_CAP (1u << 18)

__device__ __forceinline__ unsigned xb_ld(unsigned* p)              { return __hip_atomic_load(p, __ATOMIC_RELAXED, __HIP_MEMORY_SCOPE_AGENT); }
__device__ __forceinline__ unsigned xb_add(unsigned* p, unsigned v) { return __hip_atomic_fetch_add(p, v, __ATOMIC_RELAXED, __HIP_MEMORY_SCOPE_AGENT); }
__device__ __forceinline__ unsigned xb_xcc_id() { return (unsigned)__builtin_amdgcn_s_getreg((3 << 11) | 20) & 0xFu; }
#define XB_SPIN(cond, bar) do { unsigned _sp = 0; while (cond) { __builtin_amdgcn_s_sleep(1); \
    if ((++_sp & 255u) == 0u) { if (xb_ld(&(bar)[XB_TMO])) break; if (_sp > XB_SPIN_CAP) { atomicAdd(&(bar)[XB_TMO], 1u); break; } } } } while (0)

struct XcdBarrier {
    unsigned* bar; unsigned x;
    volatile LAS unsigned* st;
};

__device__ __forceinline__ XcdBarrier xcd_barrier_post(unsigned* bar, volatile LAS unsigned* st) {
    XcdBarrier b; b.bar = bar; b.x = xb_xcc_id(); b.st = st;
    if (threadIdx.x == 0) (void)xb_add(&bar[XB_XCNT(b.x)], 1u);
    return b;
}
__device__ __forceinline__ void xcd_barrier_complete(unsigned* bar, unsigned x, unsigned& nloc, unsigned& nx) {
    const unsigned G = gridDim.x * gridDim.y * gridDim.z;
    unsigned sum, cnt, mine, sp = 0u;
    for (;;) {
        sum = 0u; cnt = 0u; mine = 0u;
#pragma unroll
        for (unsigned j = 0; j < 16; ++j) { const unsigned c = xb_ld(&bar[XB_XCNT(j)]); sum += c; cnt += (c > 0u) ? 1u : 0u; mine = (j == x) ? c : mine; }
        if (sum == G) break;
        __builtin_amdgcn_s_sleep(1);
        if ((++sp & 255u) == 0u) { if (xb_ld(&bar[XB_TMO])) break; if (sp > XB_SPIN_CAP) { atomicAdd(&bar[XB_TMO], 1u); break; } }
    }
    nloc = mine > 0u ? mine : 1u; nx = cnt > 0u ? cnt : 1u;
}

__device__ __forceinline__ void xcd_barrier(const XcdBarrier& b) {
    asm volatile("s_waitcnt vmcnt(0)" ::: "memory");
    __syncthreads();
    if (threadIdx.x == 0) {
        unsigned* bar = b.bar;
        __builtin_amdgcn_s_waitcnt(0);
        unsigned nloc = b.st[0], nx = b.st[1];
        if (nloc == 0u) { xcd_barrier_complete(bar, b.x, nloc, nx); b.st[0] = nloc; b.st[1] = nx; }
        const unsigned old = xb_add(&bar[XB_XSUB(b.x)], 1u);
        const unsigned gen = old / nloc;
        if (old + 1u == (gen + 1u) * nloc) {
            __builtin_amdgcn_fence(__ATOMIC_RELEASE, "agent");
            asm volatile("s_waitcnt vmcnt(0)" ::: "memory");
            const unsigned og = xb_add(&bar[XB_TOP], 1u);
            const unsigned tg = og / nx;
            if (og + 1u == (tg + 1u) * nx) xb_add(&bar[XB_TOPGEN], 1u);
            else XB_SPIN(xb_ld(&bar[XB_TOPGEN]) == tg, bar);
            __builtin_amdgcn_fence(__ATOMIC_ACQUIRE, "agent");
            xb_add(&bar[XB_XGEN(b.x)], 1u);
            asm volatile("s_waitcnt vmcnt(0)" ::: "memory");
        } else {
            XB_SPIN(xb_ld(&bar[XB_XGEN(b.x)]) == gen, bar);
            __builtin_amdgcn_fence(__ATOMIC_ACQUIRE, "agent");
            asm volatile("s_waitcnt vmcnt(0)" ::: "memory");
        }
    }
    __syncthreads();
}

struct Args { const float* in[25]; float* out; unsigned char* ws; int ph_lo, ph_hi; };
__device__ __forceinline__ int ip32(int r) { return 16 * ((r >> 2) & 1) + 4 * (r >> 3) + (r & 3); }
__device__ __forceinline__ void p0_transpose_item(const float* W, int ldn, int K, bf16* WT, int k0, int n0, int dst_row_base, bool perm, LAS float* scr, int lane) {
    float rr_[32];
#pragma unroll
    for (int i = 0; i < 32; ++i) rr_[i] = W[(size_t)(k0 + 2 * i + (lane >> 5)) * ldn + n0 + (lane & 31)];
#pragma unroll
    for (int i = 0; i < 32; ++i) scr[(2 * i + (lane >> 5)) * 33 + (lane & 31)] = rr_[i];
    LDS_WAIT(); asm volatile("" ::: "memory");
    const int c = lane & 7;
#pragma unroll
    for (int j = 0; j < 4; ++j) { const int n = (lane >> 3) + 8 * j; const LAS float* s = scr + (8 * c) * 33 + n;
        v4u o; o.x = pk2(s[0 * 33], s[1 * 33]); o.y = pk2(s[2 * 33], s[3 * 33]); o.z = pk2(s[4 * 33], s[5 * 33]); o.w = pk2(s[6 * 33], s[7 * 33]);
        *(GAS v4u*)(WT + (size_t)(dst_row_base + (perm ? ip32(n) : n)) * K + k0 + 8 * c) = o; }
    LDS_WAIT(); asm volatile("" ::: "memory");
}
__device__ __forceinline__ void p0_f8_load(float (&rr_)[32], const float* W, int ldn, int k0, int n0, int lane) {
#pragma unroll
    for (int i = 0; i < 8; ++i) { const f32x4 v = __builtin_nontemporal_load((const f32x4*)(W + (size_t)(k0 + 8 * i + (lane >> 3)) * ldn + n0 + (lane & 7) * 4));
        rr_[4 * i] = v.x; rr_[4 * i + 1] = v.y; rr_[4 * i + 2] = v.z; rr_[4 * i + 3] = v.w; }
}
__device__ __forceinline__ void p0_f8_finish(const float (&rr_)[32], int K, unsigned char* WT, int k0, int dst_row_base, LAS float* scr, int lane) {
#pragma unroll
    for (int i = 0; i < 8; ++i) { LAS float* sp = scr + (8 * i + (lane >> 3)) * 33 + (lane & 7) * 4; sp[0] = rr_[4 * i]; sp[1] = rr_[4 * i + 1]; sp[2] = rr_[4 * i + 2]; sp[3] = rr_[4 * i + 3]; }
    LDS_WAIT(); asm volatile("" ::: "memory");
    const int n = lane >> 1, hf = lane & 1; const LAS float* s = scr + (32 * hf) * 33 + n;
    v4u o0, o1;
    o0.x = pg8::pk4_fp8(32.f * s[0 * 33], 32.f * s[1 * 33], 32.f * s[2 * 33], 32.f * s[3 * 33]); o0.y = pg8::pk4_fp8(32.f * s[4 * 33], 32.f * s[5 * 33], 32.f * s[6 * 33], 32.f * s[7 * 33]);
    o0.z = pg8::pk4_fp8(32.f * s[8 * 33], 32.f * s[9 * 33], 32.f * s[10 * 33], 32.f * s[11 * 33]); o0.w = pg8::pk4_fp8(32.f * s[12 * 33], 32.f * s[13 * 33], 32.f * s[14 * 33], 32.f * s[15 * 33]);
    o1.x = pg8::pk4_fp8(32.f * s[16 * 33], 32.f * s[17 * 33], 32.f * s[18 * 33], 32.f * s[19 * 33]); o1.y = pg8::pk4_fp8(32.f * s[20 * 33], 32.f * s[21 * 33], 32.f * s[22 * 33], 32.f * s[23 * 33]);
    o1.z = pg8::pk4_fp8(32.f * s[24 * 33], 32.f * s[25 * 33], 32.f * s[26 * 33], 32.f * s[27 * 33]); o1.w = pg8::pk4_fp8(32.f * s[28 * 33], 32.f * s[29 * 33], 32.f * s[30 * 33], 32.f * s[31 * 33]);
    GAS v4u* dp = (GAS v4u*)(WT + (size_t)(dst_row_base + ip32(n)) * K + k0 + 32 * hf);
    dp[0] = o0; dp[1] = o1;
    LDS_WAIT(); asm volatile("" ::: "memory");
}
__device__ __forceinline__ void conv_drain(pg8::ConvCtx& c, LAS unsigned char* lds, int wave, int lane) {
    asm volatile("s_waitcnt vmcnt(0)" ::: "memory");
    if (c.sub >= 0) { pg8::conv_finish(c, lds, c.slot0, lane, c.sub); c.sub = -1; }
    __syncthreads();
    const unsigned base = (unsigned)(RING_OFF + wave * 16384);
    int sub[4], aft[4];
#pragma unroll
    for (int i = 0; i < 4; ++i) { sub[i] = -1; aft[i] = 0; }
#pragma unroll
    for (int i = 0; i < 4; ++i) { const int s = c.cw + c.nseq * c.jn;
        if (s < pg8::CONV_NSUB) { pg8::conv_issue(c, lds, base + i * 4096, lane, s); sub[i] = s; ++c.jn;
#pragma unroll
            for (int k = 0; k < 4; ++k) aft[k] += 4;
            aft[i] = 0; } }
    for (;;) {
        bool any = false;
#pragma unroll
        for (int i = 0; i < 4; ++i) {
            if (sub[i] < 0) continue;
            any = true;
            const int a = aft[i];
            if (a >= 15) asm volatile("s_waitcnt vmcnt(15)" ::: "memory"); else if (a >= 12) asm volatile("s_waitcnt vmcnt(12)" ::: "memory");
            else if (a >= 8) asm volatile("s_waitcnt vmcnt(8)" ::: "memory"); else if (a >= 4) asm volatile("s_waitcnt vmcnt(4)" ::: "memory"); else asm volatile("s_waitcnt vmcnt(0)" ::: "memory");
            pg8::conv_finish(c, lds, base + i * 4096, lane, sub[i]); sub[i] = -1;
#pragma unroll
            for (int k = 0; k < 4; ++k) aft[k] += 1;
            const int s = c.cw + c.nseq * c.jn;
            if (s < pg8::CONV_NSUB) { pg8::conv_issue(c, lds, base + i * 4096, lane, s); sub[i] = s; ++c.jn;
#pragma unroll
                for (int k = 0; k < 4; ++k) aft[k] += 4;
                aft[i] = 0; }
        }
        if (!any) break;
    }
}
__device__ __forceinline__ int win_group_base(int L0) {
    if (L0 < 1024) { const int l = L0 & 255; return (L0 & ~255) + 128 * ((l >> 5) & 1) + 32 * (l >> 6); }
    if (L0 < 1536) return L0;
    if (L0 < 2048) return L0 - 1536 + 2560;
    if (L0 < 3072) { const int which = L0 >= 2560, ch = (L0 - 2048) & 511; return 256 * (6 + (ch >> 7)) + 128 * which + 32 * ((ch >> 5) & 3); }
    return L0;
}
__device__ __forceinline__ void rms_row_to_bf16(const float* xrow, const float* g, bf16* orow, int lane, unsigned char* orow8 = nullptr) {
    const GAS f32x4* xr = (const GAS f32x4*)xrow + lane; const GAS f32x4* gr = (const GAS f32x4*)g + lane;
    f32x4 v[4]; float s = 0.f;
#pragma unroll
    for (int j = 0; j < 4; ++j) { v[j] = xr[64 * j]; s += (v[j].x * v[j].x + v[j].y * v[j].y) + (v[j].z * v[j].z + v[j].w * v[j].w); }
    const float r = 1.0f / sqrtf(wave_sum(s) * (1.0f / 1024.0f) + EPS);
    GAS unsigned long long* o8 = (GAS unsigned long long*)orow + lane;
#pragma unroll
    for (int j = 0; j < 4; ++j) { const f32x4 gg = gr[64 * j]; o8[64 * j] = (unsigned long long)pk2(v[j].x * r * gg.x, v[j].y * r * gg.y) | ((unsigned long long)pk2(v[j].z * r * gg.z, v[j].w * r * gg.w) << 32);
        if (orow8) ((GAS unsigned*)orow8)[64 * j + lane] = pg8::pk4_fp8(v[j].x * r * gg.x, v[j].y * r * gg.y, v[j].z * r * gg.z, v[j].w * r * gg.w); }
}


__device__ __forceinline__ void p0_prologue(const Args& a, LAS unsigned char* lds, int vcu, int G, int wave, int lane, int tid) {
    LAS float* scr = (LAS float*)(lds + RING_OFF + wave * 16384);
    const int gw = vcu * NWAVES + wave, NGW = G * NWAVES;
    unsigned char* ws = a.ws;
    constexpr int I_IN = 16 * 112, I_G8 = 16 * 96, I_KV = 16 * 32, I_BR = 3 * 8 * 32, I_OUT = 16 * 32;
    constexpr int NITEMS = I_IN + I_G8 + I_KV + I_BR + I_OUT;
    for (int it = gw; it < NITEMS; it += NGW) {
        int r = it;
        if (r < I_IN) { const int kb = r / 112, nb = r % 112; p0_transpose_item(a.in[3], NIN, 1024, (bf16*)(ws + WS_WIN), 64 * kb, 32 * nb, win_group_base(32 * nb), true, scr, lane); continue; } r -= I_IN;
        if (r < I_G8) { const int kb = r / 96, nb = r % 96; float rr8[32]; p0_f8_load(rr8, a.in[3], NIN, 64 * kb, 3584 + 32 * nb, lane); p0_f8_finish(rr8, 1024, ws + WS_WG8, 64 * kb, 32 * nb, scr, lane); continue; } r -= I_G8;
        if (r < I_KV) { const int kb = r / 32, nb = r % 32; p0_transpose_item(a.in[13], 1024, 1024, (bf16*)(ws + WS_WIN), 64 * kb, 32 * nb, 6656 + 32 * nb, true, scr, lane); continue; } r -= I_KV;
        if (r < I_BR) { const int br = r / 256, q = r % 256, kb = q / 32, nb = q % 32; p0_transpose_item(a.in[16] + (size_t)br * 512 * 1024, 1024, 512, (bf16*)(ws + WS_WBR), 64 * kb, 32 * nb, br * 1024 + 32 * nb, true, scr, lane); continue; } r -= I_BR;
        { const int kb = r / 32, nb = r % 32; p0_transpose_item(a.in[17], 1024, 1024, (bf16*)(ws + WS_WOUT), 64 * kb, 32 * nb, 32 * nb, true, scr, lane); }
    }
    bf16* HN = (bf16*)(ws + WS_HN);
    for (int m = gw; m < T + 512; m += NGW) {
        if (m < T) rms_row_to_bf16(a.in[0] + (size_t)m * D, a.in[2], HN + (size_t)m * D, lane, ws + WS_HN8 + (size_t)m * D);
        else rms_row_to_bf16(a.in[1] + (size_t)(m - T) * D, a.in[12], HN + (size_t)m * D, lane);
    }
    float* rc = (float*)(ws + WS_RCOS); float* rs = (float*)(ws + WS_RSIN);
    for (int i = gw * 64 + lane; i < SEQ * 32; i += NGW * 64) { const int pos = i >> 5, f = i & 31;
        const float inv_freq = 1.0f / powf(10000.0f, (float)(2 * f) / 64.0f); const float ang = (float)pos * inv_freq; rc[i] = cosf(ang); rs[i] = sinf(ang); }
}

__device__ __forceinline__ void phase_finish(const Args& a, int vcu, int G, int wave, int lane) {
    unsigned char* ws = a.ws; const int gw = vcu * NWAVES + wave, NGW = G * NWAVES;
    const bf16* OM = (const bf16*)(ws + WS_OMAPS); const bf16* U = (const bf16*)(ws + WS_U); const bf16* CB = (const bf16*)(ws + WS_CB); bf16* Y = (bf16*)(ws + WS_YALL);
    const float lam = expf(wave_sum(a.in[6][lane] * a.in[7][lane])) - expf(wave_sum(a.in[8][lane] * a.in[9][lane])) + 0.2f;
    const int hh = lane >> 4, c8 = (lane & 15) * 8;
    f32x4 gs0 = *(const f32x4*)(a.in[10] + c8), gs1 = *(const f32x4*)(a.in[10] + c8 + 4);
    f32x4 w0a = *(const f32x4*)(a.in[11] + lane * 8), w0b = *(const f32x4*)(a.in[11] + lane * 8 + 4);
    f32x4 w1a = *(const f32x4*)(a.in[11] + 512 + lane * 8), w1b = *(const f32x4*)(a.in[11] + 512 + lane * 8 + 4);
    f32x4 w2a = *(const f32x4*)(a.in[11] + 1024 + lane * 8), w2b = *(const f32x4*)(a.in[11] + 1024 + lane * 8 + 4);
    for (int t = gw; t < T; t += NGW) {
        {
            const v4u o0 = *(const v4u*)(OM + (size_t)t * 1024 + hh * 256 + c8), o1 = *(const v4u*)(OM + (size_t)t * 1024 + hh * 256 + 128 + c8);
            const f32x4 a0 = pg8::unpk_lo(o0) - lam * pg8::unpk_lo(o1), a1 = pg8::unpk_hi(o0) - lam * pg8::unpk_hi(o1);
            float ss = ((a0[0] * a0[0] + a0[1] * a0[1]) + (a0[2] * a0[2] + a0[3] * a0[3])) + ((a1[0] * a1[0] + a1[1] * a1[1]) + (a1[2] * a1[2] + a1[3] * a1[3]));
            ss += __shfl_xor(ss, 1); ss += __shfl_xor(ss, 2); ss += __shfl_xor(ss, 4); ss += __shfl_xor(ss, 8);
            const float r = 0.8f / sqrtf(ss * (1.0f / 128.0f) + EPS);
            *(v4u*)(Y + (size_t)t * 1536 + hh * 128 + c8) = pg8::pack8(a0 * gs0 * r, a1 * gs1 * r);
        }
        {
            const int s = t & (SEQ - 1); const v4u z = {0u, 0u, 0u, 0u};
            const v4u u0 = *(const v4u*)(U + (size_t)t * 512 + lane * 8);
            const v4u u1 = s >= 1 ? *(const v4u*)(U + (size_t)(t - 1) * 512 + lane * 8) : z;
            const v4u u2 = s >= 2 ? *(const v4u*)(U + (size_t)(t - 2) * 512 + lane * 8) : z;
            const v4u cb = *(const v4u*)(CB + (size_t)t * 512 + lane * 8);
            const f32x4 ya = pg8::unpk_lo(cb) * (w0a * pg8::unpk_lo(u2) + w1a * pg8::unpk_lo(u1) + w2a * pg8::unpk_lo(u0));
            const f32x4 yb = pg8::unpk_hi(cb) * (w0b * pg8::unpk_hi(u2) + w1b * pg8::unpk_hi(u1) + w2b * pg8::unpk_hi(u0));
            *(v4u*)(Y + (size_t)t * 1536 + 512 + lane * 8) = pg8::pack8(ya, yb);
        }
    }
}

#define DPPF(x, ctrl) __uint_as_float(__builtin_amdgcn_update_dpp(0u, __float_as_uint(x), (ctrl), 0xf, 0xf, false))
__device__ __forceinline__ float lane_xor32(float x, int lane) { auto r = __builtin_amdgcn_permlane32_swap(__float_as_uint(x), __float_as_uint(x), false, false); return __uint_as_float((lane & 32) ? r[0] : r[1]); }
__device__ __forceinline__ float lane_xor16(float x, int lane) { auto r = __builtin_amdgcn_permlane16_swap(__float_as_uint(x), __float_as_uint(x), false, false); return __uint_as_float((lane & 16) ? r[0] : r[1]); }
__device__ __forceinline__ float wave_sum_fast(float v, int lane) {
    v += DPPF(v, 0xb1); v += DPPF(v, 0x4e); v += DPPF(v, 0x141); v += DPPF(v, 0x140); v += lane_xor16(v, lane); v += lane_xor32(v, lane); return v; }
__device__ __forceinline__ void router_pick(float (&p)[32], int t, float bias, int lane_in, LAS unsigned char* lds, int* tk_e, int* tk_p, float* tk_g) {
    int lane = lane_in; asm volatile("" : "+v"(lane));
#define RSTEP(HN, MASK, XCHG) _Pragma("unroll") for (int i = 0; i < HN; ++i) { const bool up = (lane & MASK) != 0; const float keep = up ? p[i + HN] : p[i]; const float send = up ? p[i] : p[i + HN]; p[i] = keep + XCHG; }
    RSTEP(16, 32, lane_xor32(send, lane)) RSTEP(8, 16, lane_xor16(send, lane)) RSTEP(4, 8, DPPF(send, 0x140)) RSTEP(2, 4, DPPF(send, 0x141)) RSTEP(1, 2, DPPF(send, 0x4e))
#undef RSTEP
    const float logit = p[0] + DPPF(p[0], 0xb1) + bias;
    float val = (lane & 1) ? -INFINITY : logit;
    float tv[4]; int te[4];
#pragma unroll
    for (int r = 0; r < 4; ++r) {
        float m = val;
        m = fmaxf(m, DPPF(m, 0xb1)); m = fmaxf(m, DPPF(m, 0x4e)); m = fmaxf(m, DPPF(m, 0x141)); m = fmaxf(m, DPPF(m, 0x140)); m = fmaxf(m, lane_xor16(m, lane)); m = fmaxf(m, lane_xor32(m, lane));
        const unsigned long long bal = __ballot(val == m);
        const int first = __builtin_ctzll(bal);
        tv[r] = __uint_as_float(__builtin_amdgcn_readfirstlane(__float_as_uint(m))); te[r] = first >> 1;
        val = (lane == first) ? -INFINITY : val;
    }
    const float e1 = expf(tv[1] - tv[0]), e2 = expf(tv[2] - tv[0]), e3 = expf(tv[3] - tv[0]);
    const float is = 1.0f / (1.0f + e1 + e2 + e3);
    if (lane < 4) { const int e = (lane == 0) ? te[0] : (lane == 1) ? te[1] : (lane == 2) ? te[2] : te[3];
        const float gate = (lane == 0) ? is : (lane == 1) ? e1 * is : (lane == 2) ? e2 * is : e3 * is;
        const int lp = __hip_atomic_fetch_add((LAS int*)(lds + L_LCNT) + e, 1, __ATOMIC_RELAXED, __HIP_MEMORY_SCOPE_WORKGROUP);
        tk_e[t * 4 + lane] = e; tk_p[t * 4 + lane] = lp; tk_g[t * 4 + lane] = gate; }
}

__device__ __forceinline__ void phase_router(const Args& a, LAS unsigned char* lds, int vcu, int G, int wave, int lane, int tid, int dummy) {
    unsigned char* ws = a.ws; const int gw = vcu * NWAVES + wave, NGW = G * NWAVES;
    LAS float* Wt = (LAS float*)(lds + RING_OFF);
    volatile LAS int* lcnt = (volatile LAS int*)(lds + L_LCNT);
    const float* wr = a.in[19];
    const float* x1 = a.out;
    f32x4 vn[2][4];
#pragma unroll
    for (int q = 0; q < 2; ++q) { const GAS f32x4* xr = (const GAS f32x4*)(x1 + (size_t)(gw + q * NGW) * D) + lane;
#pragma unroll
        for (int j = 0; j < 4; ++j) vn[q][j] = xr[64 * j]; }
    { f32x4 wf[16];
#pragma unroll
      for (int i = 0; i < 16; ++i) wf[i] = *(const f32x4*)(wr + (size_t)(lane + 64 * i) * 32 + 4 * wave);
#pragma unroll
      for (int i = 0; i < 16; ++i) { const int d = lane + 64 * i;
          Wt[(4 * wave + 0) * 1024 + d] = wf[i].x; Wt[(4 * wave + 1) * 1024 + d] = wf[i].y; Wt[(4 * wave + 2) * 1024 + d] = wf[i].z; Wt[(4 * wave + 3) * 1024 + d] = wf[i].w; } }
    if (tid < 32) lcnt[tid] = 0;
    __syncthreads();
    const float* g = a.in[18]; unsigned char* H2 = ws + WS_H2;
    int* tk_e = (int*)(ws + WS_TKE); int* tk_p = (int*)(ws + WS_TKP); float* tk_g = (float*)(ws + WS_TKG);
    LAS unsigned char* ldsc = lds;
    const float bias = a.in[20][lane >> 1];
    const GAS f32x4* gr = (const GAS f32x4*)g + lane;
    for (int tb = gw; tb < T; tb += 2 * NGW) {
        f32x4 v[2][4];
#pragma unroll
        for (int q = 0; q < 2; ++q)
#pragma unroll
            for (int j = 0; j < 4; ++j) v[q][j] = vn[q][j];
        if (tb + 2 * NGW < T) {
#pragma unroll
            for (int q = 0; q < 2; ++q) { const GAS f32x4* xr = (const GAS f32x4*)(x1 + (size_t)(tb + 2 * NGW + q * NGW) * D) + lane;
#pragma unroll
                for (int j = 0; j < 4; ++j) vn[q][j] = xr[64 * j]; } }
#pragma unroll
        for (int q = 0; q < 2; ++q) { float s = 0.f;
#pragma unroll
            for (int j = 0; j < 4; ++j) s += (v[q][j].x * v[q][j].x + v[q][j].y * v[q][j].y) + (v[q][j].z * v[q][j].z + v[q][j].w * v[q][j].w);
            const float r = 1.0f / sqrtf(wave_sum_fast(s, lane) * (1.0f / 1024.0f) + EPS);
            GAS unsigned* o4 = (GAS unsigned*)(H2 + (size_t)(tb + q * NGW) * D) + lane;
#pragma unroll
            for (int j = 0; j < 4; ++j) { const f32x4 gg = gr[64 * j]; v[q][j].x *= r * gg.x; v[q][j].y *= r * gg.y; v[q][j].z *= r * gg.z; v[q][j].w *= r * gg.w;
                o4[64 * j] = pg8::pk4_fp8(v[q][j].x, v[q][j].y, v[q][j].z, v[q][j].w); } }
        float p0[32], p1[32];
#pragma unroll
        for (int e = 0; e < 32; ++e) { p0[e] = 0.f; p1[e] = 0.f; }
        for (int ps_ = 0; ps_ < (REPEAT_PHASE == 22 ? 2 : 1); ++ps_) {
        f32x4 w[4], wn[4];
        const LAS float* Wl = Wt + 4 * lane; asm volatile("" : "+v"(Wl));
#pragma unroll
        for (int j = 0; j < 4; ++j) w[j] = *(const LAS f32x4*)(Wl + 256 * j);
#pragma unroll
        for (int e = 0; e < 32; ++e) {
            if (e + 1 < 32) {
#pragma unroll
                for (int j = 0; j < 4; ++j) wn[j] = *(const LAS f32x4*)(Wl + (e + 1) * 1024 + 256 * j); }
            asm volatile("" ::: "memory"); __builtin_amdgcn_sched_barrier(0);
            { float a0 = 0.f, a1 = 0.f, b0 = 0.f, b1 = 0.f;
#pragma unroll
              for (int j = 0; j < 4; ++j) { a0 = fmaf(v[0][j].x, w[j].x, a0); a1 = fmaf(v[0][j].y, w[j].y, a1); a0 = fmaf(v[0][j].z, w[j].z, a0); a1 = fmaf(v[0][j].w, w[j].w, a1);
                                            b0 = fmaf(v[1][j].x, w[j].x, b0); b1 = fmaf(v[1][j].y, w[j].y, b1); b0 = fmaf(v[1][j].z, w[j].z, b0); b1 = fmaf(v[1][j].w, w[j].w, b1); }
              p0[e] += a0 + a1; p1[e] += b0 + b1; asm volatile("" : "+v"(p0[e]), "+v"(p1[e])); }
#pragma unroll
            for (int j = 0; j < 4; ++j) w[j] = wn[j];
        }
        }
        if (REPEAT_PHASE == 22) {
#pragma unroll
            for (int e = 0; e < 32; ++e) { p0[e] *= 0.5f; p1[e] *= 0.5f; } }
        router_pick(p0, tb, bias, lane, ldsc, tk_e, tk_p, tk_g);
        router_pick(p1, tb + NGW, bias, lane, ldsc, tk_e, tk_p, tk_g);
    }
    __syncthreads();
    if (tid < 32) ((int*)(ws + WS_BLKBASE))[(dummy ? 8192 : 0) + vcu * 32 + tid] = lcnt[tid];
    __syncthreads();
}

__device__ __forceinline__ void moe_plan(unsigned char* ws, LAS unsigned char* lds, int tid, int vcu, int G) {
    volatile LAS int* prefT = (volatile LAS int*)(lds + L_PREFT); volatile LAS int* pstart = (volatile LAS int*)(lds + L_PSTART); volatile LAS int* lbase = (volatile LAS int*)(lds + L_LBASE);
    volatile LAS int* part = (volatile LAS int*)(lds + L_PART);
    { const int e = tid & 31, pr = tid >> 5; const int* bc = (const int*)(ws + WS_BLKBASE); int tot = 0, pre = 0;
      for (int b = pr; b < G; b += 16) { const int c = bc[b * 32 + e]; tot += c; pre += (b < vcu) ? c : 0; }
      part[pr * 32 + e] = tot; part[512 + pr * 32 + e] = pre; }
    __syncthreads();
    if (tid < 64) { int nt = 0;
        if (tid < 32) { int tot = 0, pre = 0;
#pragma unroll
            for (int pr = 0; pr < 16; ++pr) { tot += part[pr * 32 + tid]; pre += part[512 + pr * 32 + tid]; }
            lbase[tid] = pre; nt = (tot + 255) >> 8; }
        int inc = nt;
#pragma unroll
        for (int o = 1; o < 32; o <<= 1) { const int y = __shfl_up(inc, o); if ((tid & 63) >= o) inc += y; }
        if (tid < 32) { prefT[tid] = inc - nt; pstart[tid] = (inc - nt) * 256; if (tid == 31) { prefT[32] = inc; pstart[32] = inc * 256; }
            if (vcu == 0) { int* gp = (int*)(ws + WS_BLKBASE) + 16384; gp[tid] = inc - nt; if (tid == 31) gp[32] = inc; } } }
    __syncthreads();
}
__device__ __forceinline__ void moe_plan_load(unsigned char* ws, LAS unsigned char* lds, int tid) {
    volatile LAS int* prefT = (volatile LAS int*)(lds + L_PREFT);
    if (tid < 33) prefT[tid] = ((const int*)(ws + WS_BLKBASE))[16384 + tid];
    __syncthreads();
}

__device__ __forceinline__ void phase_dispatch(const Args& a, LAS unsigned char* lds, int vcu, int G, int wave, int lane, int tid) {
    unsigned char* ws = a.ws; const int gw = vcu * NWAVES + wave, NGW = G * NWAVES;
    volatile LAS int* pstart = (volatile LAS int*)(lds + L_PSTART); volatile LAS int* lbase = (volatile LAS int*)(lds + L_LBASE);
    moe_plan(ws, lds, tid, vcu, G);
    const unsigned char* H2 = ws + WS_H2; unsigned char* XS = ws + WS_XS;
    const int* tk_e = (const int*)(ws + WS_TKE); const int* tk_p = (const int*)(ws + WS_TKP); const float* tk_g = (const float*)(ws + WS_TKG);
    int* tslot = (int*)(ws + WS_TSLOT); float* rgate = (float*)(ws + WS_RGATE);
    for (int t = gw; t < T; t += NGW) {
        int slot = 0;
        if (lane < 4) { const int e = tk_e[t * 4 + lane]; slot = pstart[e] + lbase[e] + tk_p[t * 4 + lane]; rgate[slot] = tk_g[t * 4 + lane]; tslot[t * 4 + lane] = slot; }
        const v4u r0 = *(const v4u*)(H2 + (size_t)t * D + lane * 16);
#pragma unroll
        for (int k = 0; k < 4; ++k) { const int sk = __builtin_amdgcn_readlane(slot, k); *(v4u*)(XS + (size_t)sk * D + lane * 16) = r0; }
    }
}

__device__ __forceinline__ void phase_combine(const Args& a, int vcu, int G, int wave, int lane, float* dst_out) {
    unsigned char* ws = a.ws; const int gw = vcu * NWAVES + wave, NGW = G * NWAVES;
    const unsigned char* YS = ws + WS_XS; const int* tslot = (const int*)(ws + WS_TSLOT); float* out = a.out;
    for (int t = gw; t < T; t += NGW) {
        int slot = 0; if (lane < 4) slot = tslot[t * 4 + lane];
        const float* op = out + (size_t)t * D + lane * 16; f32x4 o[4];
#pragma unroll
        for (int j = 0; j < 4; ++j) o[j] = *(const f32x4*)(op + 4 * j);
#pragma unroll
        for (int k = 0; k < 4; ++k) { const int sk = __builtin_amdgcn_readlane(slot, k); const v4u y = *(const v4u*)(YS + (size_t)sk * D + lane * 16); const unsigned yw[4] = {y.x, y.y, y.z, y.w};
#pragma unroll
            for (int j = 0; j < 4; ++j) { const auto lo = __builtin_amdgcn_cvt_pk_f32_fp8((int)yw[j], false), hi = __builtin_amdgcn_cvt_pk_f32_fp8((int)yw[j], true);
                o[j][0] += lo[0] * 0.0625f; o[j][1] += lo[1] * 0.0625f; o[j][2] += hi[0] * 0.0625f; o[j][3] += hi[1] * 0.0625f; } }
        float* wp = dst_out + (size_t)t * D + lane * 16;
#pragma unroll
        for (int j = 0; j < 4; ++j) *(f32x4*)(wp + 4 * j) = o[j];
    }
}

__device__ __forceinline__ void memattn_unit(const Args& a, LAS unsigned char* lds, int b, int h, int qb, int wid, int lane, int tid) {
    unsigned char* ws = a.ws;
    const bf16* KVM = (const bf16*)(ws + WS_KVM); const bf16* MQ = (const bf16*)(ws + WS_MQ); const float* ssq = (const float*)(ws + WS_SSQ); bf16* Y = (bf16*)(ws + WS_YALL);
    LAS unsigned char* Ks = lds + RING_OFF;
    LAS unsigned char* Vs = lds + RING_OFF + 65536;
    const int r32 = lane & 31, hi = lane >> 5;
    const size_t qrow = (size_t)b * SEQ + (size_t)qb * 256 + wid * 32 + r32;
    bf16x8 qf[8];
#pragma unroll
    for (int ks = 0; ks < 8; ++ks) qf[ks] = *(const bf16x8*)(MQ + qrow * 512 + h * 128 + 16 * ks + 8 * hi);
    const f32x4 sq = *(const f32x4*)(ssq + qrow * 16 + h * 4);
    {
        const int m = tid >> 1, hf = tid & 1;
        const bf16* kr = KVM + (size_t)(b * 256 + m) * 1024 + h * 128 + hf * 64; const bf16* vr = kr + 512;
        v4u raw[8], vraw[8]; float ss = 0.f;
#pragma unroll
        for (int i = 0; i < 8; ++i) { raw[i] = *(const v4u*)(kr + 8 * i); vraw[i] = *(const v4u*)(vr + 8 * i); }
#pragma unroll
        for (int i = 0; i < 8; ++i) { const f32x4 x0 = pg8::unpk_lo(raw[i]), x1 = pg8::unpk_hi(raw[i]);
            ss += ((x0[0] * x0[0] + x0[1] * x0[1]) + (x0[2] * x0[2] + x0[3] * x0[3])) + ((x1[0] * x1[0] + x1[1] * x1[1]) + (x1[2] * x1[2] + x1[3] * x1[3])); }
        ss += __shfl_xor(ss, 1);
        const float r = 1.0f / sqrtf(ss * (1.0f / 128.0f) + EPS);
#pragma unroll
        for (int i = 0; i < 8; ++i) { const int d0 = hf * 64 + 8 * i; const f32x4 g0 = *(const f32x4*)(a.in[15] + d0) * *(const f32x4*)(a.in[14] + d0), g1 = *(const f32x4*)(a.in[15] + d0 + 4) * *(const f32x4*)(a.in[14] + d0 + 4);
            const int c = hf * 8 + i;
            *(LAS v4u*)(Ks + m * 256 + ((c ^ (m & 15)) << 4)) = pg8::pack8(pg8::unpk_lo(raw[i]) * g0 * r, pg8::unpk_hi(raw[i]) * g1 * r); }
        LAS unsigned char* vt = Vs + (m >> 6) * 16384 + ((m >> 4) & 3) * 1024 + (m & 15) * 64;
#pragma unroll
        for (int i = 0; i < 8; ++i) *(LAS v4u*)(vt + (2 * hf + (i >> 2)) * 4096 + (i & 3) * 16) = vraw[i];
    }
    __syncthreads();
    const float sc = (1.0f / sqrtf(((sq[0] + sq[1]) + (sq[2] + sq[3])) * (1.0f / 128.0f) + EPS)) * 0.08838834764831845f * 1.4426950408889634f;
    f32x16 o[4]; float l = 0.f;
#pragma unroll
    for (int d0 = 0; d0 < 4; ++d0) o[d0] = f32x16{};
    const int vb0 = (int)(unsigned)(uintptr_t)(lds + RING_OFF + 65536) + ((lane >> 4) & 1) * 32 + (lane & 3) * 8 + (4 * hi + ((lane & 15) >> 2)) * 64;
#pragma unroll 1
    for (int kt = 0; kt < 4; ++kt) {
        f32x16 p0 = f32x16{}, p1 = f32x16{};
#pragma unroll
        for (int ks = 0; ks < 8; ++ks) { const int c = 2 * ks + hi; const int k0 = 64 * kt + r32, k1 = k0 + 32;
            const bf16x8 f0 = *(const LAS bf16x8*)(Ks + k0 * 256 + ((c ^ (k0 & 15)) << 4)), f1 = *(const LAS bf16x8*)(Ks + k1 * 256 + ((c ^ (k1 & 15)) << 4));
            p0 = __builtin_amdgcn_mfma_f32_32x32x16_bf16(f0, qf[ks], p0, 0, 0, 0); p1 = __builtin_amdgcn_mfma_f32_32x32x16_bf16(f1, qf[ks], p1, 0, 0, 0); }
#pragma unroll
        for (int r = 0; r < 16; ++r) { p0[r] = __builtin_amdgcn_exp2f(p0[r] * sc); p1[r] = __builtin_amdgcn_exp2f(p1[r] * sc); l += p0[r] + p1[r]; }
        v4u pw[4];
        pw[0] = (v4u){pg8::cvt_pk_bf16(p0[0], p0[1]), pg8::cvt_pk_bf16(p0[2], p0[3]), pg8::cvt_pk_bf16(p0[4], p0[5]), pg8::cvt_pk_bf16(p0[6], p0[7])};
        pw[1] = (v4u){pg8::cvt_pk_bf16(p0[8], p0[9]), pg8::cvt_pk_bf16(p0[10], p0[11]), pg8::cvt_pk_bf16(p0[12], p0[13]), pg8::cvt_pk_bf16(p0[14], p0[15])};
        pw[2] = (v4u){pg8::cvt_pk_bf16(p1[0], p1[1]), pg8::cvt_pk_bf16(p1[2], p1[3]), pg8::cvt_pk_bf16(p1[4], p1[5]), pg8::cvt_pk_bf16(p1[6], p1[7])};
        pw[3] = (v4u){pg8::cvt_pk_bf16(p1[8], p1[9]), pg8::cvt_pk_bf16(p1[10], p1[11]), pg8::cvt_pk_bf16(p1[12], p1[13]), pg8::cvt_pk_bf16(p1[14], p1[15])};
        attn_body::pv128(o, vb0 + kt * 16384, __builtin_bit_cast(bf16x8, pw[0]), __builtin_bit_cast(bf16x8, pw[1]), __builtin_bit_cast(bf16x8, pw[2]), __builtin_bit_cast(bf16x8, pw[3]));
    }
    l += __shfl_xor(l, 32);
    LAS float* wsf = (LAS float*)(lds + L_WSF) + wid * 64;
    if (hi == 0) wsf[r32] = l;
    __syncthreads();
    LAS bf16* stg = (LAS bf16*)(lds + RING_OFF) + wid * 4096;
#pragma unroll
    for (int r = 0; r < 16; ++r) { const int orow = (r & 3) + 8 * (r >> 2) + 4 * hi; const float il = 1.0f / wsf[orow];
#pragma unroll
        for (int d0 = 0; d0 < 4; ++d0) stg[orow * 128 + d0 * 32 + r32] = (bf16)f2bf(o[d0][r] * il); }
    LDS_WAIT();
    bf16* Yw = Y + ((size_t)b * SEQ + (size_t)qb * 256 + wid * 32) * 1536 + 1024 + h * 128;
#pragma unroll
    for (int i = 0; i < 8; ++i) { const int row = i * 4 + (lane >> 4), ch = lane & 15; const v4u v = *(const LAS v4u*)(stg + row * 128 + ch * 8); *(v4u*)(Yw + (size_t)row * 1536 + ch * 8) = v; }
    __syncthreads();
}

__global__ void __launch_bounds__(NWAVES * 64, 2) mega_fwd(Args args) {
    extern __shared__ __attribute__((aligned(16))) unsigned char lds_raw[];
    LAS unsigned char* lds = (LAS unsigned char*)lds_raw;
    volatile LAS unsigned* MISC = (volatile LAS unsigned*)(lds + MISC_OFF);
    int tid = threadIdx.x, lane = tid & 63, wave = __builtin_amdgcn_readfirstlane(tid >> 6);
#define PHASE_LOCALS() do { tid = threadIdx.x; asm volatile("" : "+v"(tid)); lane = tid & 63; wave = __builtin_amdgcn_readfirstlane(tid >> 6); } while (0)
    const int G = gridDim.x; const int bx = blockIdx.x; const int vcu = (G % 8 == 0) ? (bx % 8) * (G / 8) + bx / 8 : bx;
    unsigned char* ws = args.ws;
    gu32* ctl = (gu32*)(ws + WS_CTL);
    for (int u = tid; u < (LDS_BYTES - LDSCTL_OFF) / 4; u += NWAVES * 64) ((LAS unsigned*)(lds + LDSCTL_OFF))[u] = 0u;
    __syncthreads();
    const int ph_lo = args.ph_lo, ph_hi = args.ph_hi;
    XcdBarrier bar; bar.bar = (unsigned*)(ctl + CW_BAR); bar.x = 0; bar.st = nullptr;
    if (ph_hi - ph_lo > 1) bar = xcd_barrier_post((unsigned*)(ctl + CW_BAR), MISC + 8);
#define IN(k) (ph_lo <= (k) && (k) < ph_hi)
#ifndef TS_PHASE
#define TS_PHASE -1
#endif
    unsigned long long* const ts = (unsigned long long*)(ws + WS_CTL + 512 * 1024);
#define STAMP(k) do { if (TS_PHASE >= 0 && bx == 0 && threadIdx.x == 0) ts[(k)] = __builtin_amdgcn_s_memrealtime(); } while (0)
#define GRID_BAR(k) do { if (IN(k) && IN((k) + 1)) xcd_barrier(bar); STAMP((k) + 1); } while (0)
    STAMP(0);

    if (IN(0)) { for (int rep_ = 0; rep_ < (REPEAT_PHASE == 0 ? 2 : 1); ++rep_) { if (rep_) xcd_barrier(bar);
    PHASE_LOCALS();
    p0_prologue(args, lds, vcu, G, wave, lane, tid);
    } }
    GRID_BAR(0);

    if (IN(1)) { for (int rep_ = 0; rep_ < (REPEAT_PHASE == 1 ? 2 : 1); ++rep_) { if (rep_) xcd_barrier(bar);
    PHASE_LOCALS();
    {
        pg8::Gemm g{2048u, 2048u, 1024};
        ProjOrder S; S.A = (const char*)(ws + WS_HN); S.Bt = (const char*)(ws + WS_WIN); S.G = G; S.c = bx;
        pg8::EpiProj E{(bf16*)(ws + WS_Q), (bf16*)(ws + WS_K), (bf16*)(ws + WS_V), (bf16*)(ws + WS_U), (bf16*)(ws + WS_CB), (bf16*)(ws + WS_MQ), (bf16*)(ws + WS_GATES), (bf16*)(ws + WS_KVM),
                       (float*)(ws + WS_SSQ), args.in[4], args.in[5], (const float*)(ws + WS_RCOS), (const float*)(ws + WS_RSIN)};
        const unsigned sv0 = __builtin_amdgcn_readfirstlane(MISC[8]), sv1 = __builtin_amdgcn_readfirstlane(MISC[9]);
        __syncthreads();
        pg8::ConvCtx cx; cx.wgu = args.in[21]; cx.wdn = args.in[23]; cx.ogu = ws + WS_WGU; cx.odn = ws + WS_WDN; cx.cw = bx * NWAVES + wave; cx.nseq = NWAVES * G; cx.jn = 0;
        cx.sub = -1; cx.slot0 = (unsigned)(CONV_SLOTS + wave * 4096);
        pg8::gemm_phase<pg8::EpiProj, ProjOrder, true, true, true>(lds + RING_OFF, g, S, E, &cx);
        { pg8::Gemm g8{1024u, 1024u, 512}; GateOrder S8; S8.A = (const char*)(ws + WS_HN8); S8.Bt = (const char*)(ws + WS_WG8); S8.G = G; S8.c = bx;
          pg8::EpiGates8 E8{ws + WS_GATES};
          pg8::gemm_phase_f8<pg8::EpiGates8, GateOrder, true, true, true>(lds + RING_OFF, g8, S8, E8, &cx); }
        conv_drain(cx, lds, wave, lane);
        __syncthreads();
        for (int u = tid; u < (LDS_BYTES - LDSCTL_OFF) / 4; u += NWAVES * 64) ((LAS unsigned*)(lds + LDSCTL_OFF))[u] = 0u;
        __syncthreads();
        if (tid == 0) { MISC[8] = sv0; MISC[9] = sv1; }
        __syncthreads();
    }
    } }
    GRID_BAR(1);

    if (IN(2)) { for (int rep_ = 0; rep_ < (REPEAT_PHASE == 2 ? 2 : 1); ++rep_) { if (rep_) xcd_barrier(bar);
    PHASE_LOCALS();
    {
        const int cmb = vcu >> 4, s = vcu & 15;
        const int b = cmb >> 3, h = (cmb >> 1) & 3, mp = cmb & 1;
        const attn_body::bf16* Qp = (const attn_body::bf16*)(ws + WS_Q) + (size_t)b * SEQ * 512 + (h * 2 + mp) * 64;
        const attn_body::bf16* Kp = (const attn_body::bf16*)(ws + WS_K) + (size_t)b * SEQ * 512 + (h * 2 + mp) * 64;
        const attn_body::bf16* Vp = (const attn_body::bf16*)(ws + WS_V) + (size_t)b * SEQ * 512 + h * 128;
        attn_body::bf16* Op = (attn_body::bf16*)(ws + WS_OMAPS) + (size_t)b * SEQ * 1024 + (h * 2 + mp) * 128;
#pragma unroll 1
        for (int i = 0; i < 2; ++i) { const int qb = (i == 0) ? s : 31 - s;
            attn_body::attn_unit128<8>(qb, Qp, Kp, Vp, Op, (char*)lds_raw + RING_OFF); }
        memattn_unit(args, lds, vcu >> 7, (vcu >> 5) & 3, vcu & 31, wave, lane, tid);
        if (REPEAT_PHASE == 21) memattn_unit(args, lds, vcu >> 7, (vcu >> 5) & 3, vcu & 31, wave, lane, tid);
    }
    } }
    GRID_BAR(2);

    if (IN(3)) { for (int rep_ = 0; rep_ < (REPEAT_PHASE == 3 ? 2 : 1); ++rep_) { if (rep_) xcd_barrier(bar);
    PHASE_LOCALS();
    phase_finish(args, vcu, G, wave, lane);
    } }
    GRID_BAR(3);

    if (REPEAT_PHASE == 20) { for (int i_ = 0; i_ < 10; ++i_) xcd_barrier(bar); }
    if (IN(4)) { for (int rep_ = 0; rep_ < (REPEAT_PHASE == 4 ? 2 : 1); ++rep_) { if (rep_) xcd_barrier(bar);
    PHASE_LOCALS();
    {
        pg8::Gemm g{3072u, 1024u, 512};
        MergeOrder S; S.Y = (const char*)(ws + WS_YALL); S.Bt = (const char*)(ws + WS_WBR); S.G = G; S.c = bx;
        pg8::EpiMerge E{(const bf16*)(ws + WS_GATES), (bf16*)(ws + WS_MERGED)};
        pg8::gemm_phase<pg8::EpiMerge, MergeOrder, true, true>(lds + RING_OFF, g, S, E);
    }
    } }
    GRID_BAR(4);

    if (IN(5)) { for (int rep_ = 0; rep_ < (REPEAT_PHASE == 5 ? 2 : 1); ++rep_) { if (rep_) xcd_barrier(bar);
    PHASE_LOCALS();
    {
        pg8::Gemm g{2048u, 2048u, 1024};
        OutOrder S; S.A = (const char*)(ws + WS_MERGED); S.Bt = (const char*)(ws + WS_WOUT); S.G = G; S.c = bx;
        pg8::EpiResid E{args.in[0], args.out};
        pg8::gemm_phase<pg8::EpiResid, OutOrder, false, true>(lds + RING_OFF, g, S, E);
    }
    } }
    GRID_BAR(5);

    if (IN(6)) { for (int rep_ = 0; rep_ < (REPEAT_PHASE == 6 ? 2 : 1); ++rep_) { if (rep_) xcd_barrier(bar);
    PHASE_LOCALS();
    phase_router(args, lds, vcu, G, wave, lane, tid, rep_ == 0 && REPEAT_PHASE == 6);
    } }
    GRID_BAR(6);

    if (IN(7)) { for (int rep_ = 0; rep_ < (REPEAT_PHASE == 7 ? 2 : 1); ++rep_) { if (rep_) xcd_barrier(bar);
    PHASE_LOCALS();
    phase_dispatch(args, lds, vcu, G, wave, lane, tid);
    } }
    GRID_BAR(7);

    if (IN(8)) { for (int rep_ = 0; rep_ < (REPEAT_PHASE == 8 ? 2 : 1); ++rep_) { if (rep_) xcd_barrier(bar);
    PHASE_LOCALS();
    {
        pg8::Gemm g{1024u, 1024u, 512};
        moe_plan_load(ws, lds, tid);
        MoeOrder S; S.A = (const char*)(ws + WS_XS); S.Bt = (const char*)(ws + WS_WGU); S.prefT = (const volatile LAS int*)(lds + L_PREFT); S.ncol = 8; S.G = G; S.c = vcu; S.tile_bytes = 256 * 1024;
        pg8::EpiSwiglu E{args.in[22], ws + WS_ACT};
        pg8::gemm_phase_f8<pg8::EpiSwiglu, MoeOrder, true, true>(lds + RING_OFF, g, S, E);
    }
    } }
    GRID_BAR(8);

    if (IN(9)) { for (int rep_ = 0; rep_ < (REPEAT_PHASE == 9 ? 2 : 1); ++rep_) { if (rep_) xcd_barrier(bar);
    PHASE_LOCALS();
    {
        pg8::Gemm g{1024u, 1024u, 512};
        moe_plan_load(ws, lds, tid);
        MoeOrder S; S.A = (const char*)(ws + WS_ACT); S.Bt = (const char*)(ws + WS_WDN); S.prefT = (const volatile LAS int*)(lds + L_PREFT); S.ncol = 4; S.G = G; S.c = vcu; S.tile_bytes = 256 * 1024;
        pg8::EpiDown E{args.in[24], (const float*)(ws + WS_RGATE), ws + WS_XS};
        pg8::gemm_phase_f8<pg8::EpiDown, MoeOrder, true, true>(lds + RING_OFF, g, S, E);
    }
    } }
    GRID_BAR(9);

    if (IN(10)) { for (int rep_ = 0; rep_ < 1; ++rep_) { if (rep_) xcd_barrier(bar);
    PHASE_LOCALS();
    if (REPEAT_PHASE == 10) { phase_combine(args, vcu, G, wave, lane, (float*)(ws + WS_WGU)); xcd_barrier(bar); }
    phase_combine(args, vcu, G, wave, lane, args.out);
    } }
    GRID_BAR(10);

    if (TS_PHASE >= 0) {
        STAMP(11); xcd_barrier(bar);
        const unsigned long long t0 = __hip_atomic_load(ts + (TS_PHASE == 11 ? 0 : TS_PHASE), RLX_AGENT), t1 = __hip_atomic_load(ts + (TS_PHASE == 11 ? 11 : TS_PHASE + 1), RLX_AGENT);
        const float v = (float)(t1 - t0) * (TS_PHASE == 11 ? 1e-4f : 1e-3f);
        for (size_t i = (size_t)bx * 512 + threadIdx.x; i < (size_t)T * D; i += (size_t)G * 512) args.out[i] = v;
    }
#undef GRID_BAR
#undef IN
}

extern "C" void kernel_launch(void* const* d_in, const int* in_sizes, int n_in, void* d_out, int out_size, void* d_ws, size_t ws_size, hipStream_t stream) {
    static int grid = 0;
    if (grid == 0) {
        if (n_in != 25 || out_size != T * D || ws_size < WS_END) { fprintf(stderr, "kernel_launch: unexpected problem shape (n_in %d, out %d, ws %zu)\n", n_in, out_size, ws_size); grid = -1; return; }
        int dev = 0, cus = 0;
        if (hipGetDevice(&dev) != hipSuccess || hipDeviceGetAttribute(&cus, hipDeviceAttributeMultiprocessorCount, dev) != hipSuccess) { grid = -1; return; }
        if (hipFuncSetAttribute((const void*)mega_fwd, hipFuncAttributeMaxDynamicSharedMemorySize, LDS_BYTES) != hipSuccess) { fprintf(stderr, "kernel_launch: hipFuncSetAttribute failed\n"); grid = -1; return; }
        int per_cu = 0;
        if (hipOccupancyMaxActiveBlocksPerMultiprocessor(&per_cu, (const void*)mega_fwd, NWAVES * 64, LDS_BYTES) != hipSuccess || per_cu < 1) fprintf(stderr, "kernel_launch: occupancy query says %d\n", per_cu);
        (void)hipGetLastError();
        grid = cus;
        if (grid != 256) fprintf(stderr, "kernel_launch: built for 256 CUs, device has %d\n", grid);
    }
    if (grid < 0) return;
    if (hipMemsetAsync((char*)d_ws + WS_CTL, 0, CTL_ZERO_BYTES, stream) != hipSuccess) return;
    Args a{};
    for (int i = 0; i < 25; ++i) a.in[i] = (const float*)d_in[i];
    a.out = (float*)d_out; a.ws = (unsigned char*)d_ws;
#ifndef MK_PER_PHASE
#define MK_PER_PHASE 0
#endif
    if (MK_PER_PHASE) { for (int k = 0; k < 11; ++k) { a.ph_lo = k; a.ph_hi = k + 1; hipLaunchKernelGGL(mega_fwd, dim3(grid), dim3(NWAVES * 64), LDS_BYTES, stream, a); } }
    else { a.ph_lo = 0; a.ph_hi = 11; hipLaunchKernelGGL(mega_fwd, dim3(grid), dim3(NWAVES * 64), LDS_BYTES, stream, a); }
}
```

```cpp
#include <hip/hip_runtime.h>
#include <hip/hip_bf16.h>
#include <cstdio>
#include <cstdint>
#include <cmath>

namespace cfg {
constexpr int BATCH = 2, SEQ = 8192, T = BATCH * SEQ, D = 1024, NIN = 6656, NE = 32, NMEM = 256;
constexpr int MAXROWS = 65536 + NE * 256;
constexpr float EPS = 1e-6f;
constexpr float C2 = 0.125f * 1.4426950408889634f;
}

namespace pg8 {
#define PG8_LAS __attribute__((address_space(3)))
typedef unsigned short bf16_t;
typedef short bf16x8 __attribute__((ext_vector_type(8)));
typedef float f32x4 __attribute__((ext_vector_type(4)));
typedef unsigned u32x4 __attribute__((ext_vector_type(4)));
typedef unsigned u32x2 __attribute__((ext_vector_type(2)));
constexpr int BM = 256, BK = 64, HALF = 128, HTB = HALF * BK * 2  , STAGE_BYTES = 8 * HTB, NXCD = 8, WGM = 8;

__host__ __device__ __forceinline__ int lds_byte(int r, int c) { const int st = (r >> 4) * 2 + (c >> 5), rr = r & 15, cc = c & 31, ob = rr * 64 + cc * 2; return st * 1024 + (ob ^ (((ob >> 9) & 1) << 5)); }
__host__ __device__ __forceinline__ void stage_rc(int b, int& R, int& C) { const int st = b / 1024, sb = b % 1024, swz = sb ^ (((sb >> 9) & 1) << 5); R = (st >> 1) * 16 + swz / 64; C = (st & 1) * 32 + (swz % 64) / 2; }

struct Unit { int pm, pn, aux; const char* a; const char* b; };
struct Gemm { unsigned lda, ldb; int K; };

__device__ __forceinline__ void static_map(int L, int nM, int nN, int& pm, int& pn) {
    const int nwg = nM * nN; int wgid = L; { const int q = nwg / NXCD, r = nwg % NXCD, xcd = wgid % NXCD, off = wgid / NXCD; wgid = (xcd < r ? xcd * (q + 1) : r * (q + 1) + (xcd - r) * q) + off; }
    const int nig = WGM * nN, gid = wgid / nig, fm = gid * WGM, gsz = (nM - fm) < WGM ? (nM - fm) : WGM;
    pm = fm + ((wgid % nig) % gsz); pn = (wgid % nig) / gsz;
}

typedef float f32x2_cv __attribute__((ext_vector_type(2))); typedef __bf16 bf16x2_cv __attribute__((ext_vector_type(2)));
__device__ __forceinline__ unsigned cvt_pk_bf16(float lo, float hi) { f32x2_cv v = {lo, hi}; bf16x2_cv b = __builtin_convertvector(v, bf16x2_cv); return __builtin_bit_cast(unsigned, b); }
__device__ __forceinline__ u32x4 pack8(const f32x4 v0, const f32x4 v1) { u32x4 w; w.x = cvt_pk_bf16(v0[0], v0[1]); w.y = cvt_pk_bf16(v0[2], v0[3]); w.z = cvt_pk_bf16(v1[0], v1[1]); w.w = cvt_pk_bf16(v1[2], v1[3]); return w; }
__device__ __forceinline__ f32x4 unpk_lo(const u32x4 w) { return (f32x4){__uint_as_float(w.x << 16), __uint_as_float(w.x & 0xffff0000u), __uint_as_float(w.y << 16), __uint_as_float(w.y & 0xffff0000u)}; }
__device__ __forceinline__ f32x4 unpk_hi(const u32x4 w) { return (f32x4){__uint_as_float(w.z << 16), __uint_as_float(w.z & 0xffff0000u), __uint_as_float(w.w << 16), __uint_as_float(w.w & 0xffff0000u)}; }
__device__ __forceinline__ unsigned pk4_fp8(float a, float b, float c, float d) { int w = 0; w = __builtin_amdgcn_cvt_pk_fp8_f32(a, b, w, false); w = __builtin_amdgcn_cvt_pk_fp8_f32(c, d, w, true); return (unsigned)w; }
__device__ __forceinline__ float sigmoidf_fast(float z) { return __builtin_amdgcn_rcpf(1.0f + __builtin_amdgcn_exp2f(-1.4426950408889634f * z)); }

using cfg::T; using cfg::SEQ; using cfg::EPS;

struct EpiProj {
    static constexpr bool AFTER_DRAIN = false;
    bf16_t *Q, *K, *V, *U, *CB, *MQ, *GATES, *KVM; float* ssq; const float *gq, *gk, *rcos, *rsin;
    __device__ __forceinline__ bool keep(const Unit&) const { return false; }
    __device__ __forceinline__ void operator()(f32x4 (&acc)[2][2][4][2], const Unit& u, int wr, int wc, int fr, int fq) const {
        const int pn = u.pn; const int row0 = u.pm * BM + wr * 64 + fr;
        if (pn < 4) {
            const bool isk = pn >= 2; const float* g = isk ? gk : gq; bf16_t* dst = (isk ? K : Q) + (pn & 1) * 256 + wc * 64 + 8 * fq;
            const float post = isk ? 1.0f : cfg::C2;
            f32x4 ga[2][2];
#pragma unroll
            for (int bj = 0; bj < 2; ++bj)
#pragma unroll
                for (int n = 0; n < 2; ++n) ga[bj][n] = *(const f32x4*)(g + 32 * bj + 8 * fq + 4 * n);
#pragma unroll
            for (int ai = 0; ai < 2; ++ai)
#pragma unroll
                for (int m = 0; m < 4; ++m) {
                    const int row = row0 + ai * HALF + m * 16;
                    float ss = 0.f;
#pragma unroll
                    for (int bj = 0; bj < 2; ++bj)
#pragma unroll
                        for (int n = 0; n < 2; ++n) { const f32x4 x = acc[ai][bj][m][n]; ss += (x[0] * x[0] + x[1] * x[1]) + (x[2] * x[2] + x[3] * x[3]); }
                    ss += __shfl_xor(ss, 16); ss += __shfl_xor(ss, 32);
                    const float rinv = __builtin_amdgcn_rsqf(ss * (1.0f / 64.0f) + EPS) * post;
                    const int pos = row & (SEQ - 1);
                    f32x4 o1[2], o2[2];
#pragma unroll
                    for (int n = 0; n < 2; ++n) {
                        const f32x4 c = *(const f32x4*)(rcos + pos * 32 + 8 * fq + 4 * n), s = *(const f32x4*)(rsin + pos * 32 + 8 * fq + 4 * n);
                        const f32x4 x1 = acc[ai][0][m][n] * ga[0][n] * rinv, x2 = acc[ai][1][m][n] * ga[1][n] * rinv;
                        o1[n] = x1 * c - x2 * s; o2[n] = x2 * c + x1 * s;
                    }
                    *(u32x4*)(dst + (size_t)row * 512) = pack8(o1[0], o1[1]);
                    *(u32x4*)(dst + (size_t)row * 512 + 32) = pack8(o2[0], o2[1]);
                }
        } else if (pn >= 6 && pn < 10) {
            bf16_t* dst = U + (pn - 6) * 128 + wc * 32 + 8 * fq;
#pragma unroll
            for (int ai = 0; ai < 2; ++ai)
#pragma unroll
                for (int m = 0; m < 4; ++m) { const int row = row0 + ai * HALF + m * 16;
                    *(u32x4*)(dst + (size_t)row * 512) = pack8(acc[ai][0][m][0] * acc[ai][1][m][0], acc[ai][0][m][1] * acc[ai][1][m][1]); }
        } else if (pn >= 14 && pn < 26) {
            unsigned char* dst = (unsigned char*)GATES + ((size_t)(u.pm * 12 + (pn - 14)) << 16) + (((wr * 4 + wc) * 64 + fq * 16 + fr) << 3);
#pragma unroll
            for (int ai = 0; ai < 2; ++ai)
#pragma unroll
                for (int m = 0; m < 4; ++m) {
#pragma unroll
                    for (int bj = 0; bj < 2; ++bj) { const f32x4 v0 = acc[ai][bj][m][0], v1 = acc[ai][bj][m][1]; unsigned q[8];
#pragma unroll
                        for (int e = 0; e < 4; ++e) { q[e] = (unsigned)(sigmoidf_fast(v0[e]) * 255.0f + 0.5f); q[4 + e] = (unsigned)(sigmoidf_fast(v1[e]) * 255.0f + 0.5f); }
                        u32x2 w8; w8.x = q[0] | (q[1] << 8) | (q[2] << 16) | (q[3] << 24); w8.y = q[4] | (q[5] << 8) | (q[6] << 16) | (q[7] << 24);
                        *(u32x2*)(dst + ((((ai * 4 + m) * 2 + bj) * 512) << 3)) = w8; } }
        } else {
            bf16_t* dst; int ld, rsub = 0; const bool ismq = (pn == 12 || pn == 13);
            if (pn < 6) { dst = V + (pn - 4) * 256; ld = 512; } else if (pn < 12) { dst = CB + (pn - 10) * 256; ld = 512; }
            else if (pn < 14) { dst = MQ + (pn - 12) * 256; ld = 512; } else { dst = KVM + (pn - 26) * 256; ld = 1024; rsub = T; }
            dst += wc * 32 + 8 * fq;
#pragma unroll
            for (int ai = 0; ai < 2; ++ai)
#pragma unroll
                for (int m = 0; m < 4; ++m) { const int row = row0 + ai * HALF + m * 16 - rsub;
#pragma unroll
                    for (int bj = 0; bj < 2; ++bj) { const f32x4 v0 = acc[ai][bj][m][0], v1 = acc[ai][bj][m][1];
                        *(u32x4*)(dst + (size_t)row * ld + bj * HALF) = pack8(v0, v1);
                        if (ismq) { float ss = ((v0[0] * v0[0] + v0[1] * v0[1]) + (v0[2] * v0[2] + v0[3] * v0[3])) + ((v1[0] * v1[0] + v1[1] * v1[1]) + (v1[2] * v1[2] + v1[3] * v1[3]));
                            ss += __shfl_xor(ss, 16); ss += __shfl_xor(ss, 32);
                            if (fq == 0) ssq[(size_t)row * 16 + ((pn - 12) * 2 + bj) * 4 + wc] = ss; } } }
        }
    }
};

struct EpiGates8 {
    static constexpr bool AFTER_DRAIN = false;
    unsigned char* GATES;
    __device__ __forceinline__ bool keep(const Unit&) const { return false; }
    __device__ __forceinline__ void operator()(f32x4 (&acc)[2][2][4][2], const Unit& u, int wr, int wc, int fr, int fq) const {
        {
            unsigned char* dst = (unsigned char*)GATES + ((size_t)(u.pm * 12 + u.pn) << 16) + (((wr * 4 + wc) * 64 + fq * 16 + fr) << 3);
#pragma unroll
            for (int ai = 0; ai < 2; ++ai)
#pragma unroll
                for (int m = 0; m < 4; ++m) {
#pragma unroll
                    for (int bj = 0; bj < 2; ++bj) { const f32x4 v0 = acc[ai][bj][m][0], v1 = acc[ai][bj][m][1]; unsigned q[8];
#pragma unroll
                        for (int e = 0; e < 4; ++e) { q[e] = (unsigned)(sigmoidf_fast(v0[e]) * 255.0f + 0.5f); q[4 + e] = (unsigned)(sigmoidf_fast(v1[e]) * 255.0f + 0.5f); }
                        u32x2 w8; w8.x = q[0] | (q[1] << 8) | (q[2] << 16) | (q[3] << 24); w8.y = q[4] | (q[5] << 8) | (q[6] << 16) | (q[7] << 24);
                        *(u32x2*)(dst + ((((ai * 4 + m) * 2 + bj) * 512) << 3)) = w8; } }
        }
    }
};

struct EpiMerge {
    static constexpr bool AFTER_DRAIN = false;
    const bf16_t* GATES; bf16_t* MERGED;
    __device__ __forceinline__ bool keep(const Unit& u) const { return u.aux < 2; }
    __device__ __forceinline__ void operator()(f32x4 (&acc)[2][2][4][2], const Unit& u, int wr, int wc, int fr, int fq) const {
        const int br = u.aux; const int row0 = u.pm * BM + wr * 64 + fr, col0 = u.pn * BM + wc * 32 + 8 * fq;
        const unsigned char* ga_p = (const unsigned char*)GATES + ((size_t)(u.pm * 12 + br * 4 + u.pn) << 16) + (((wr * 4 + wc) * 64 + fq * 16 + fr) << 3);
        const unsigned char* gb_p = ga_p + ((size_t)4 << 16);
        u32x2 gav[16], gbv[16];
#pragma unroll
        for (int i = 0; i < 16; ++i) gav[i] = __builtin_nontemporal_load((const u32x2*)(ga_p + ((i * 512) << 3)));
        if (br < 2) {
#pragma unroll
            for (int i = 0; i < 16; ++i) gbv[i] = __builtin_nontemporal_load((const u32x2*)(gb_p + ((i * 512) << 3))); }
        else {
#pragma unroll
            for (int i = 0; i < 16; ++i) gbv[i] = (u32x2){0u, 0u}; }
        __builtin_amdgcn_sched_barrier(0);
#pragma unroll
        for (int ai = 0; ai < 2; ++ai)
#pragma unroll
            for (int m = 0; m < 4; ++m) { const int row = row0 + ai * HALF + m * 16;
#pragma unroll
                for (int bj = 0; bj < 2; ++bj) { const u32x2 ga = gav[(ai * 4 + m) * 2 + bj];
                    f32x4 f0 = {(float)(ga.x & 255u), (float)((ga.x >> 8) & 255u), (float)((ga.x >> 16) & 255u), (float)(ga.x >> 24)}, f1 = {(float)(ga.y & 255u), (float)((ga.y >> 8) & 255u), (float)((ga.y >> 16) & 255u), (float)(ga.y >> 24)};
                    if (br < 2) { const u32x2 gb = gbv[(ai * 4 + m) * 2 + bj];
                        const f32x4 d0 = {(float)__builtin_elementwise_max(gb.x & 255u, 1u), (float)__builtin_elementwise_max((gb.x >> 8) & 255u, 1u), (float)__builtin_elementwise_max((gb.x >> 16) & 255u, 1u), (float)__builtin_elementwise_max(gb.x >> 24, 1u)};
                        const f32x4 d1 = {(float)__builtin_elementwise_max(gb.y & 255u, 1u), (float)__builtin_elementwise_max((gb.y >> 8) & 255u, 1u), (float)__builtin_elementwise_max((gb.y >> 16) & 255u, 1u), (float)__builtin_elementwise_max(gb.y >> 24, 1u)};
                        if (br == 1) {
#pragma unroll
                            for (int e = 0; e < 4; ++e) { f0[e] = __builtin_fmaxf(f0[e], 1.0f); f1[e] = __builtin_fmaxf(f1[e], 1.0f); } }
#pragma unroll
                        for (int e = 0; e < 4; ++e) { f0[e] *= __builtin_amdgcn_rcpf(d0[e]); f1[e] *= __builtin_amdgcn_rcpf(d1[e]); } }
                    else {
#pragma unroll
                        for (int e = 0; e < 4; ++e) { f0[e] = __builtin_fmaxf(f0[e], 1.0f) * (1.0f / 255.0f); f1[e] = __builtin_fmaxf(f1[e], 1.0f) * (1.0f / 255.0f); } }
                    acc[ai][bj][m][0] *= f0; acc[ai][bj][m][1] *= f1;
                    if (br == 2) *(u32x4*)(MERGED + (size_t)row * 1024 + col0 + bj * HALF) = pack8(acc[ai][bj][m][0], acc[ai][bj][m][1]);
                } }
    }
};

struct EpiResid {
    static constexpr bool AFTER_DRAIN = false;
    const float* base; float* out;
    __device__ __forceinline__ bool keep(const Unit&) const { return false; }
    __device__ __forceinline__ void operator()(f32x4 (&acc)[2][2][4][2], const Unit& u, int wr, int wc, int fr, int fq) const {
        const int row0 = u.pm * BM + wr * 64 + fr, col0 = u.pn * BM + wc * 32 + 8 * fq;
#pragma unroll
        for (int ai = 0; ai < 2; ++ai)
#pragma unroll
            for (int mp = 0; mp < 2; ++mp) {
                f32x4 xv[2][2][2];
#pragma unroll
                for (int mm = 0; mm < 2; ++mm) { const size_t off = (size_t)(row0 + ai * HALF + (2 * mp + mm) * 16) * 1024 + col0;
#pragma unroll
                    for (int bj = 0; bj < 2; ++bj)
#pragma unroll
                        for (int n = 0; n < 2; ++n) xv[mm][bj][n] = __builtin_nontemporal_load((const f32x4*)(base + off + bj * HALF + n * 4)); }
                __builtin_amdgcn_sched_barrier(0);
#pragma unroll
                for (int mm = 0; mm < 2; ++mm) { const int m = 2 * mp + mm; const size_t off = (size_t)(row0 + ai * HALF + m * 16) * 1024 + col0;
#pragma unroll
                    for (int bj = 0; bj < 2; ++bj)
#pragma unroll
                        for (int n = 0; n < 2; ++n) *(f32x4*)(out + off + bj * HALF + n * 4) = xv[mm][bj][n] + acc[ai][bj][m][n]; }
                __builtin_amdgcn_sched_barrier(0); }
    }
};

struct EpiSwiglu {
    static constexpr bool AFTER_DRAIN = false;
    const float* bgu; unsigned char* ACT;
    __device__ __forceinline__ bool keep(const Unit&) const { return false; }
    __device__ __forceinline__ void operator()(f32x4 (&acc)[2][2][4][2], const Unit& u, int wr, int wc, int fr, int fq) const {
        const int e_ = u.pn >> 3, pnl = u.pn & 7; const int row0 = u.pm * BM + wr * 64 + fr, ch0 = pnl * 128 + wc * 32 + 8 * fq;
        f32x4 bg[2], bu[2];
#pragma unroll
        for (int n = 0; n < 2; ++n) { bg[n] = *(const f32x4*)(bgu + (size_t)e_ * 2048 + ch0 + 4 * n); bu[n] = *(const f32x4*)(bgu + (size_t)e_ * 2048 + 1024 + ch0 + 4 * n); }
#pragma unroll
        for (int ai = 0; ai < 2; ++ai)
#pragma unroll
            for (int m = 0; m < 4; ++m) { const int row = row0 + ai * HALF + m * 16; f32x4 a[2];
#pragma unroll
                for (int n = 0; n < 2; ++n) { const f32x4 g = acc[ai][0][m][n] + bg[n], uu = acc[ai][1][m][n] + bu[n];
#pragma unroll
                    for (int e = 0; e < 4; ++e) { const float gm = fminf(g[e], 7.0f), um = fminf(fmaxf(uu[e], -7.0f), 7.0f);
                        a[n][e] = (um + 1.0f) * (gm * sigmoidf_fast(1.702f * gm)); } }
                u32x2 w8; w8.x = pk4_fp8(a[0][0], a[0][1], a[0][2], a[0][3]); w8.y = pk4_fp8(a[1][0], a[1][1], a[1][2], a[1][3]);
                *(u32x2*)(ACT + (size_t)row * 1024 + ch0) = w8; }
    }
};

struct EpiDown {
    static constexpr bool AFTER_DRAIN = false;
    const float* bd; const float* row_gate; unsigned char* YS;
    __device__ __forceinline__ bool keep(const Unit&) const { return false; }
    __device__ __forceinline__ void operator()(f32x4 (&acc)[2][2][4][2], const Unit& u, int wr, int wc, int fr, int fq) const {
        const int e_ = u.pn >> 2, pnl = u.pn & 3; const int row0 = u.pm * BM + wr * 64 + fr, col0 = pnl * 256 + wc * 32 + 8 * fq;
        f32x4 bv[2][2];
#pragma unroll
        for (int bj = 0; bj < 2; ++bj)
#pragma unroll
            for (int n = 0; n < 2; ++n) bv[bj][n] = *(const f32x4*)(bd + (size_t)e_ * 1024 + col0 + bj * HALF + 4 * n);
        float rgv[8];
#pragma unroll
        for (int i = 0; i < 8; ++i) rgv[i] = row_gate[row0 + (i >> 2) * HALF + (i & 3) * 16];
        __builtin_amdgcn_sched_barrier(0);
#pragma unroll
        for (int ai = 0; ai < 2; ++ai)
#pragma unroll
            for (int m = 0; m < 4; ++m) { const int row = row0 + ai * HALF + m * 16; const float rg = rgv[ai * 4 + m] * 16.0f;
#pragma unroll
                for (int bj = 0; bj < 2; ++bj) { const f32x4 y0 = (acc[ai][bj][m][0] + bv[bj][0]) * rg, y1 = (acc[ai][bj][m][1] + bv[bj][1]) * rg;
                    u32x2 w8; w8.x = pk4_fp8(y0[0], y0[1], y0[2], y0[3]); w8.y = pk4_fp8(y1[0], y1[1], y1[2], y1[3]);
                    *(u32x2*)(YS + (size_t)row * 1024 + col0 + bj * HALF) = w8; } }
    }
};


constexpr int CONV_NSUB = 2 * (32768 + 16384);
struct ConvCtx {
    const float* wgu; const float* wdn; unsigned char* ogu; unsigned char* odn;
    int cw, nseq, jn;
    int sub;
    unsigned slot0;
};
struct ConvItem { const float* W; unsigned char* WT; int ldn, k0, n0, dst; };
__device__ __forceinline__ int conv_ip32(int r) { return 16 * ((r >> 2) & 1) + 4 * (r >> 3) + (r & 3); }
__device__ __forceinline__ ConvItem conv_decode(const ConvCtx& c, int s) {
    ConvItem d; const int it = s >> 1, hf = s & 1;
    if (it < 32768) { const int e = it >> 10, q = it & 1023, kb = q >> 6, nb = q & 63; const int L0 = 32 * nb, ch = L0 & 1023;
        d.W = c.wgu + (size_t)e * 1024 * 2048; d.ldn = 2048; d.k0 = 64 * kb + 32 * hf; d.n0 = L0; d.dst = e * 2048 + 256 * (ch >> 7) + 128 * (L0 >> 10) + 32 * ((ch >> 5) & 3); d.WT = c.ogu; }
    else { const int r = it - 32768, e = r >> 9, q = r & 511, kb = q >> 5, nb = q & 31;
        d.W = c.wdn + (size_t)e * 1024 * 1024; d.ldn = 1024; d.k0 = 64 * kb + 32 * hf; d.n0 = 32 * nb; d.dst = e * 1024 + 32 * nb; d.WT = c.odn; }
    return d;
}
__device__ __forceinline__ void conv_issue(const ConvCtx& c, PG8_LAS unsigned char* lds, unsigned slot, int lane_, int s) {
    int lane = lane_; asm volatile("" : "+v"(lane));
    const ConvItem d = conv_decode(c, s);
    const float* src = d.W + (size_t)(d.k0 + (lane >> 3)) * d.ldn + d.n0 + 4 * (lane & 7);
#pragma unroll
    for (int jj = 0; jj < 4; ++jj) __builtin_amdgcn_global_load_lds((const unsigned*)(src + (size_t)(8 * jj) * d.ldn), (PG8_LAS unsigned*)(lds + slot + jj * 1024), 16, 0, 2);
}
__device__ __forceinline__ void conv_finish(const ConvCtx& c, PG8_LAS unsigned char* lds, unsigned slot, int lane_, int s) {
    int lane = lane_; asm volatile("" : "+v"(lane));
    const ConvItem d = conv_decode(c, s);
    const int n = lane & 31, kh = lane >> 5;
    const PG8_LAS float* p = (const PG8_LAS float*)(lds + slot + kh * 2048 + n * 4);
    float v[16];
#pragma unroll
    for (int kk = 0; kk < 16; ++kk) v[kk] = p[kk * 32];
    asm volatile("s_waitcnt lgkmcnt(0)" ::: "memory");
    u32x4 o;
    o.x = pk4_fp8(32.f * v[0], 32.f * v[1], 32.f * v[2], 32.f * v[3]);   o.y = pk4_fp8(32.f * v[4], 32.f * v[5], 32.f * v[6], 32.f * v[7]);
    o.z = pk4_fp8(32.f * v[8], 32.f * v[9], 32.f * v[10], 32.f * v[11]); o.w = pk4_fp8(32.f * v[12], 32.f * v[13], 32.f * v[14], 32.f * v[15]);
    __builtin_nontemporal_store(o, (u32x4*)(d.WT + (size_t)(d.dst + conv_ip32(n)) * 1024 + d.k0 + 16 * kh));
}
template <class Epi, class Sched, bool ALIGN_EPI = false, bool SP2 = false, bool CONV = false>
__device__ __forceinline__ void gemm_phase(PG8_LAS unsigned char* lds, const Gemm g, const Sched& S, const Epi& E, ConvCtx* cx = nullptr) {
    int tid_ = threadIdx.x; asm volatile("" : "+v"(tid_));
    const int tid = tid_, wid = __builtin_amdgcn_readfirstlane(tid >> 6), lane = tid & 63, wr = wid >> 2, wc = wid & 3, fr = lane & 15, fq = lane >> 4;
    const int K = g.K, nt = K / BK;
    static_assert(!CONV || SP2, "CONV needs the SP2 loop");
    unsigned voffA[2], voffB[2];
#pragma unroll
    for (int i = 0; i < 2; ++i) { int R, C; stage_rc(tid * 16 + i * 8192, R, C);
        voffA[i] = (unsigned)R * g.lda + (unsigned)C * 2u; voffB[i] = (unsigned)R * g.ldb + (unsigned)C * 2u; }
    const size_t kstep = (size_t)(BK * 2);
    const size_t hstepA = (size_t)HALF * g.lda, hstepB = (size_t)HALF * g.ldb;
    const unsigned ldsw = (unsigned)wid * 1024u;
    const int aoff = lds_byte(wr * 64 + fr, fq * 8), boff = lds_byte(wc * 32 + fr, fq * 8);
#define PG8_SA(b, h) (((b) * 2 + (h)) * HTB)
#define PG8_SB(b, h) ((4 + (b) * 2 + (h)) * HTB)
#define PG8_STAGE(bufoff, gbase, voff) do { _Pragma("unroll") for (int _i = 0; _i < 2; ++_i) \
        __builtin_amdgcn_global_load_lds((const unsigned*)((const char*)(gbase) + (voff)[_i]), (PG8_LAS unsigned*)(lds + (bufoff) + ldsw + _i * 8192), 16, 0, 0); } while (0)
#define PG8_LDA(dst, b, h) do { _Pragma("unroll") for (int m = 0; m < 4; ++m) _Pragma("unroll") for (int k = 0; k < 2; ++k) dst[m][k] = *(const PG8_LAS bf16x8*)(lds + PG8_SA(b, h) + aoff + m * 2048 + k * 1024); } while (0)
#define PG8_LDB(dst, b, h) do { _Pragma("unroll") for (int n = 0; n < 2; ++n) _Pragma("unroll") for (int k = 0; k < 2; ++k) dst[n][k] = *(const PG8_LAS bf16x8*)(lds + PG8_SB(b, h) + boff + n * 2048 + k * 1024); } while (0)
#define PG8_MMA(ai, bj, At, Bt) do { __builtin_amdgcn_s_setprio(1); _Pragma("unroll") for (int m = 0; m < 4; ++m) _Pragma("unroll") for (int n = 0; n < 2; ++n) _Pragma("unroll") for (int k = 0; k < 2; ++k) \
        acc[ai][bj][m][n] = __builtin_amdgcn_mfma_f32_16x16x32_bf16(Bt[n][k], At[m][k], acc[ai][bj][m][n], 0, 0, 0); __builtin_amdgcn_s_setprio(0); } while (0)
#define PG8_WAIT_V(n) asm volatile("s_waitcnt vmcnt(" #n ")" ::: "memory")
#define PG8_WAIT_X(n_) do { if constexpr (CONV) { const int x_ = (n_); if (x_ == 5) asm volatile("s_waitcnt vmcnt(13)" ::: "memory"); else if (x_ == 4) asm volatile("s_waitcnt vmcnt(12)" ::: "memory"); \
        else if (x_ == 1) asm volatile("s_waitcnt vmcnt(9)" ::: "memory"); else asm volatile("s_waitcnt vmcnt(8)" ::: "memory"); } else asm volatile("s_waitcnt vmcnt(8)" ::: "memory"); } while (0)
#define PG8_WAIT_L(n) asm volatile("s_waitcnt lgkmcnt(" #n ")" ::: "memory")
#define PG8_BAR __builtin_amdgcn_s_barrier()
#define PG8_SCHED __builtin_amdgcn_sched_barrier(0)
    Unit cur, nxt; int ui = 0;
    if (!S.next(0, cur)) return;
    f32x4 acc[2][2][4][2];
#pragma unroll
    for (int a = 0; a < 2; ++a)
#pragma unroll
        for (int b = 0; b < 2; ++b)
#pragma unroll
            for (int m = 0; m < 4; ++m)
#pragma unroll
                for (int n = 0; n < 2; ++n) acc[a][b][m][n] = (f32x4){0.f, 0.f, 0.f, 0.f};
    bf16x8 At[4][2], B0[2][2], B1[2][2];
    const char* cA = cur.a; const char* cB = cur.b;
    S.a_ready(cur);
    if constexpr (SP2) {
        PG8_STAGE(PG8_SB(0, 0), cB, voffB); PG8_STAGE(PG8_SB(0, 1), cB + hstepB, voffB); PG8_STAGE(PG8_SA(0, 0), cA, voffA); PG8_STAGE(PG8_SA(0, 1), cA + hstepA, voffA);
        if (wr == 1) PG8_BAR;
        PG8_WAIT_V(2); PG8_BAR;
        PG8_STAGE(PG8_SB(1, 0), cB + kstep, voffB); PG8_STAGE(PG8_SA(1, 0), cA + kstep, voffA); PG8_STAGE(PG8_SB(1, 1), cB + hstepB + kstep, voffB);
        PG8_WAIT_V(6); PG8_BAR;
    } else {
        PG8_STAGE(PG8_SB(0, 0), cB, voffB); PG8_STAGE(PG8_SA(0, 0), cA, voffA); PG8_STAGE(PG8_SB(0, 1), cB + hstepB, voffB); PG8_STAGE(PG8_SA(0, 1), cA + hstepA, voffA);
        if (wr == 1) PG8_BAR;
        PG8_WAIT_V(4); PG8_BAR;
        PG8_STAGE(PG8_SB(1, 0), cB + kstep, voffB); PG8_STAGE(PG8_SA(1, 0), cA + kstep, voffA); PG8_STAGE(PG8_SB(1, 1), cB + hstepB + kstep, voffB);
        PG8_WAIT_V(6); PG8_BAR;
    }
    for (;;) {
        const bool has_next = S.next(ui + 1, nxt);
        const char* nA = has_next ? nxt.a : cA; const char* nB = has_next ? nxt.b : cB;
#pragma unroll 1
        for (int t = 0; t < nt; t += 2) {
            const bool last = (t == nt - 2);
            const char* a1 = cA + (size_t)(t + 1) * kstep;
            const char* a2 = last ? nA : cA + (size_t)(t + 2) * kstep; const char* b2 = last ? nB : cB + (size_t)(t + 2) * kstep;
            const char* a3 = a2 + kstep; const char* b3 = b2 + kstep;
            if (last && has_next) S.a_ready(nxt);
            if constexpr (SP2) {
            int cs_ = 0, cc_ = 0;
            if constexpr (CONV) { if (cx->sub >= 0) { conv_finish(*cx, lds, cx->slot0, lane, cx->sub); cx->sub = -1; cs_ = 1; } PG8_SCHED; }
            PG8_LDB(B0, 0, 0); PG8_LDB(B1, 0, 1); PG8_SCHED; PG8_LDA(At, 0, 0); PG8_STAGE(PG8_SA(1, 1), a1 + hstepA, voffA);
            if constexpr (CONV) { const int s_ = cx->cw + cx->nseq * cx->jn; if (s_ < CONV_NSUB) { conv_issue(*cx, lds, cx->slot0, lane, s_); cx->sub = s_; ++cx->jn; cc_ = 4; } }
            PG8_WAIT_X(cs_ + cc_); PG8_WAIT_L(0); PG8_BAR; PG8_MMA(0, 0, At, B0); PG8_MMA(0, 1, At, B1); PG8_BAR; PG8_SCHED;
            PG8_LDA(At, 0, 1); PG8_STAGE(PG8_SB(0, 0), b2, voffB); PG8_STAGE(PG8_SB(0, 1), b2 + hstepB, voffB); PG8_STAGE(PG8_SA(0, 0), a2, voffA);
            PG8_WAIT_X(cs_ + cc_); PG8_WAIT_L(0); PG8_BAR; PG8_MMA(1, 0, At, B0); PG8_MMA(1, 1, At, B1); PG8_BAR; PG8_SCHED;
            PG8_LDB(B0, 1, 0); PG8_LDB(B1, 1, 1); PG8_SCHED; PG8_LDA(At, 1, 0); PG8_STAGE(PG8_SA(0, 1), a2 + hstepA, voffA);
            PG8_WAIT_X(cc_); PG8_WAIT_L(0); PG8_BAR; PG8_MMA(0, 0, At, B0); PG8_MMA(0, 1, At, B1); PG8_BAR; PG8_SCHED;
            PG8_LDA(At, 1, 1); PG8_STAGE(PG8_SB(1, 0), b3, voffB); PG8_STAGE(PG8_SB(1, 1), b3 + hstepB, voffB); PG8_STAGE(PG8_SA(1, 0), a3, voffA);
            PG8_WAIT_V(8); PG8_WAIT_L(0); PG8_BAR; PG8_MMA(1, 0, At, B0); PG8_MMA(1, 1, At, B1); PG8_BAR; PG8_SCHED;
            } else {
            PG8_LDB(B0, 0, 0); PG8_SCHED; PG8_LDA(At, 0, 0); PG8_STAGE(PG8_SA(1, 1), a1 + hstepA, voffA);
            PG8_WAIT_L(8); PG8_BAR; PG8_WAIT_L(0); PG8_MMA(0, 0, At, B0); PG8_BAR; PG8_SCHED;
            PG8_LDB(B1, 0, 1); PG8_STAGE(PG8_SB(0, 0), b2, voffB);
            PG8_BAR; PG8_WAIT_L(0); PG8_MMA(0, 1, At, B1); PG8_BAR;
            PG8_LDA(At, 0, 1); PG8_STAGE(PG8_SA(0, 0), a2, voffA);
            PG8_BAR; PG8_WAIT_L(0); PG8_MMA(1, 0, At, B0); PG8_BAR; PG8_SCHED;
            PG8_STAGE(PG8_SB(0, 1), b2 + hstepB, voffB);
            PG8_WAIT_V(6); PG8_BAR; PG8_MMA(1, 1, At, B1); PG8_BAR;
            PG8_LDB(B0, 1, 0); PG8_SCHED; PG8_LDA(At, 1, 0); PG8_STAGE(PG8_SA(0, 1), a2 + hstepA, voffA);
            PG8_WAIT_L(8); PG8_BAR; PG8_WAIT_L(0); PG8_MMA(0, 0, At, B0); PG8_BAR; PG8_SCHED;
            PG8_LDB(B1, 1, 1); PG8_STAGE(PG8_SB(1, 0), b3, voffB);
            PG8_BAR; PG8_WAIT_L(0); PG8_MMA(0, 1, At, B1); PG8_BAR;
            PG8_LDA(At, 1, 1); PG8_STAGE(PG8_SA(1, 0), a3, voffA);
            PG8_BAR; PG8_WAIT_L(0); PG8_MMA(1, 0, At, B0); PG8_BAR; PG8_SCHED;
            PG8_STAGE(PG8_SB(1, 1), b3 + hstepB, voffB);
            PG8_WAIT_V(6); PG8_BAR; PG8_MMA(1, 1, At, B1); PG8_BAR;
            }
        }
        if constexpr (ALIGN_EPI) { if (wr == 0) PG8_BAR; }
        if constexpr (!Epi::AFTER_DRAIN) { E(acc, cur, wr, wc, fr, fq); S.done(cur); }
        if (!has_next) break;
        if (!E.keep(cur)) {
#pragma unroll
        for (int a = 0; a < 2; ++a)
#pragma unroll
            for (int b = 0; b < 2; ++b)
#pragma unroll
                for (int m = 0; m < 4; ++m)
#pragma unroll
                    for (int n = 0; n < 2; ++n) acc[a][b][m][n] = (f32x4){0.f, 0.f, 0.f, 0.f};
        }
        cur = nxt; cA = nA; cB = nB; ++ui;
        if constexpr (ALIGN_EPI) { if (wr == 1) PG8_BAR; }
    }
    PG8_WAIT_V(0);
    if constexpr (!ALIGN_EPI) { if (wr == 0) PG8_BAR; }
    PG8_BAR;
    if constexpr (Epi::AFTER_DRAIN) { E.fused(acc, cur, wr, wc, fr, fq, lds, wid, lane); S.done(cur); }
#undef PG8_SA
#undef PG8_SB
#undef PG8_STAGE
#undef PG8_LDA
#undef PG8_LDB
#undef PG8_MMA
#undef PG8_WAIT_V
#undef PG8_WAIT_X
#undef PG8_WAIT_L
#undef PG8_BAR
#undef PG8_SCHED
}

typedef unsigned u32x8 __attribute__((ext_vector_type(8))); typedef int i32x8 __attribute__((ext_vector_type(8)));
constexpr int F8_SCALE_W = 122, F8_SCALE_X = 127;
template <class Epi, class Sched, bool ALIGN_EPI = false, bool SP2 = false, bool CONV = false>
__device__ __forceinline__ void gemm_phase_f8(PG8_LAS unsigned char* lds, const Gemm g, const Sched& S, const Epi& E, ConvCtx* cx = nullptr) {
    int tid_ = threadIdx.x; asm volatile("" : "+v"(tid_));
    const int tid = tid_, wid = __builtin_amdgcn_readfirstlane(tid >> 6), lane = tid & 63, wr = wid >> 2, wc = wid & 3, fr = lane & 15, fq = lane >> 4;
    const int K = g.K, nt = K / BK;
    static_assert(!CONV || SP2, "CONV needs the SP2 loop");
    unsigned voffA[2], voffB[2];
#pragma unroll
    for (int i = 0; i < 2; ++i) { int R, C; stage_rc(tid * 16 + i * 8192, R, C);
        voffA[i] = (unsigned)R * g.lda + (unsigned)C * 2u; voffB[i] = (unsigned)R * g.ldb + (unsigned)C * 2u; }
    const size_t kstep = (size_t)(BK * 2);
    const size_t hstepA = (size_t)HALF * g.lda, hstepB = (size_t)HALF * g.ldb;
    const unsigned ldsw = (unsigned)wid * 1024u;
    const int aoff = lds_byte(wr * 64 + fr, fq * 8), boff = lds_byte(wc * 32 + fr, fq * 8);
#define PG8_SA(b, h) (((b) * 2 + (h)) * HTB)
#define PG8_SB(b, h) ((4 + (b) * 2 + (h)) * HTB)
#define PG8_STAGE(bufoff, gbase, voff) do { _Pragma("unroll") for (int _i = 0; _i < 2; ++_i) \
        __builtin_amdgcn_global_load_lds((const unsigned*)((const char*)(gbase) + (voff)[_i]), (PG8_LAS unsigned*)(lds + (bufoff) + ldsw + _i * 8192), 16, 0, 0); } while (0)
#define PG8_LDA(dst, b, h) do { _Pragma("unroll") for (int m = 0; m < 4; ++m) { const u32x4 lo_ = *(const PG8_LAS u32x4*)(lds + PG8_SA(b, h) + aoff + m * 2048), hi_ = *(const PG8_LAS u32x4*)(lds + PG8_SA(b, h) + aoff + m * 2048 + 1024); dst[m] = __builtin_shufflevector(lo_, hi_, 0, 1, 2, 3, 4, 5, 6, 7); } } while (0)
#define PG8_LDB(dst, b, h) do { _Pragma("unroll") for (int n = 0; n < 2; ++n) { const u32x4 lo_ = *(const PG8_LAS u32x4*)(lds + PG8_SB(b, h) + boff + n * 2048), hi_ = *(const PG8_LAS u32x4*)(lds + PG8_SB(b, h) + boff + n * 2048 + 1024); dst[n] = __builtin_shufflevector(lo_, hi_, 0, 1, 2, 3, 4, 5, 6, 7); } } while (0)
#define PG8_MMA(ai, bj, At, Bt) do { __builtin_amdgcn_s_setprio(1); _Pragma("unroll") for (int m = 0; m < 4; ++m) _Pragma("unroll") for (int n = 0; n < 2; ++n) \
        asm volatile("v_mfma_scale_f32_16x16x128_f8f6f4 %0, %1, %2, %0, %3, %4 op_sel_hi:[0,0,0]" : "+v"(acc[ai][bj][m][n]) : "v"(Bt[n]), "v"(At[m]), "v"(sc_w), "v"(sc_x)); __builtin_amdgcn_s_setprio(0); } while (0)
#define PG8_WAIT_V(n) asm volatile("s_waitcnt vmcnt(" #n ")" ::: "memory")
#define PG8_WAIT_X(n_) do { if constexpr (CONV) { const int x_ = (n_); if (x_ == 5) asm volatile("s_waitcnt vmcnt(13)" ::: "memory"); else if (x_ == 4) asm volatile("s_waitcnt vmcnt(12)" ::: "memory"); \
        else if (x_ == 1) asm volatile("s_waitcnt vmcnt(9)" ::: "memory"); else asm volatile("s_waitcnt vmcnt(8)" ::: "memory"); } else asm volatile("s_waitcnt vmcnt(8)" ::: "memory"); } while (0)
#define PG8_WAIT_L(n) asm volatile("s_waitcnt lgkmcnt(" #n ")" ::: "memory")
#define PG8_BAR __builtin_amdgcn_s_barrier()
#define PG8_SCHED __builtin_amdgcn_sched_barrier(0)
    Unit cur, nxt; int ui = 0;
    if (!S.next(0, cur)) return;
    f32x4 acc[2][2][4][2];
#pragma unroll
    for (int a = 0; a < 2; ++a)
#pragma unroll
        for (int b = 0; b < 2; ++b)
#pragma unroll
            for (int m = 0; m < 4; ++m)
#pragma unroll
                for (int n = 0; n < 2; ++n) acc[a][b][m][n] = (f32x4){0.f, 0.f, 0.f, 0.f};
    u32x8 At[4], B0[2], B1[2];
    int sc_w = F8_SCALE_W, sc_x = F8_SCALE_X; asm volatile("" : "+v"(sc_w), "+v"(sc_x));
    const char* cA = cur.a; const char* cB = cur.b;
    S.a_ready(cur);
    if constexpr (SP2) {
        PG8_STAGE(PG8_SB(0, 0), cB, voffB); PG8_STAGE(PG8_SB(0, 1), cB + hstepB, voffB); PG8_STAGE(PG8_SA(0, 0), cA, voffA); PG8_STAGE(PG8_SA(0, 1), cA + hstepA, voffA);
        if (wr == 1) PG8_BAR;
        PG8_WAIT_V(2); PG8_BAR;
        PG8_STAGE(PG8_SB(1, 0), cB + kstep, voffB); PG8_STAGE(PG8_SA(1, 0), cA + kstep, voffA); PG8_STAGE(PG8_SB(1, 1), cB + hstepB + kstep, voffB);
        PG8_WAIT_V(6); PG8_BAR;
    } else {
        PG8_STAGE(PG8_SB(0, 0), cB, voffB); PG8_STAGE(PG8_SA(0, 0), cA, voffA); PG8_STAGE(PG8_SB(0, 1), cB + hstepB, voffB); PG8_STAGE(PG8_SA(0, 1), cA + hstepA, voffA);
        if (wr == 1) PG8_BAR;
        PG8_WAIT_V(4); PG8_BAR;
        PG8_STAGE(PG8_SB(1, 0), cB + kstep, voffB); PG8_STAGE(PG8_SA(1, 0), cA + kstep, voffA); PG8_STAGE(PG8_SB(1, 1), cB + hstepB + kstep, voffB);
        PG8_WAIT_V(6); PG8_BAR;
    }
    for (;;) {
        const bool has_next = S.next(ui + 1, nxt);
        const char* nA = has_next ? nxt.a : cA; const char* nB = has_next ? nxt.b : cB;
#pragma unroll 1
        for (int t = 0; t < nt; t += 2) {
            const bool last = (t == nt - 2);
            const char* a1 = cA + (size_t)(t + 1) * kstep;
            const char* a2 = last ? nA : cA + (size_t)(t + 2) * kstep; const char* b2 = last ? nB : cB + (size_t)(t + 2) * kstep;
            const char* a3 = a2 + kstep; const char* b3 = b2 + kstep;
            if (last && has_next) S.a_ready(nxt);
            if constexpr (SP2) {
            int cs_ = 0, cc_ = 0;
            if constexpr (CONV) { if (cx->sub >= 0) { conv_finish(*cx, lds, cx->slot0, lane, cx->sub); cx->sub = -1; cs_ = 1; } PG8_SCHED; }
            PG8_LDB(B0, 0, 0); PG8_LDB(B1, 0, 1); PG8_SCHED; PG8_LDA(At, 0, 0); PG8_STAGE(PG8_SA(1, 1), a1 + hstepA, voffA);
            if constexpr (CONV) { const int s_ = cx->cw + cx->nseq * cx->jn; if (s_ < CONV_NSUB) { conv_issue(*cx, lds, cx->slot0, lane, s_); cx->sub = s_; ++cx->jn; cc_ = 4; } }
            PG8_WAIT_X(cs_ + cc_); PG8_WAIT_L(0); PG8_BAR; PG8_MMA(0, 0, At, B0); PG8_MMA(0, 1, At, B1); PG8_BAR; PG8_SCHED;
            PG8_LDA(At, 0, 1); PG8_STAGE(PG8_SB(0, 0), b2, voffB); PG8_STAGE(PG8_SB(0, 1), b2 + hstepB, voffB); PG8_STAGE(PG8_SA(0, 0), a2, voffA);
            PG8_WAIT_X(cs_ + cc_); PG8_WAIT_L(0); PG8_BAR; PG8_MMA(1, 0, At, B0); PG8_MMA(1, 1, At, B1); PG8_BAR; PG8_SCHED;
            PG8_LDB(B0, 1, 0); PG8_LDB(B1, 1, 1); PG8_SCHED; PG8_LDA(At, 1, 0); PG8_STAGE(PG8_SA(0, 1), a2 + hstepA, voffA);
            PG8_WAIT_X(cc_); PG8_WAIT_L(0); PG8_BAR; PG8_MMA(0, 0, At, B0); PG8_MMA(0, 1, At, B1); PG8_BAR; PG8_SCHED;
            PG8_LDA(At, 1, 1); PG8_STAGE(PG8_SB(1, 0), b3, voffB); PG8_STAGE(PG8_SB(1, 1), b3 + hstepB, voffB); PG8_STAGE(PG8_SA(1, 0), a3, voffA);
            PG8_WAIT_V(8); PG8_WAIT_L(0); PG8_BAR; PG8_MMA(1, 0, At, B0); PG8_MMA(1, 1, At, B1); PG8_BAR; PG8_SCHED;
            } else {
            PG8_LDB(B0, 0, 0); PG8_SCHED; PG8_LDA(At, 0, 0); PG8_STAGE(PG8_SA(1, 1), a1 + hstepA, voffA);
            PG8_WAIT_L(8); PG8_BAR; PG8_WAIT_L(0); PG8_MMA(0, 0, At, B0); PG8_BAR; PG8_SCHED;
            PG8_LDB(B1, 0, 1); PG8_STAGE(PG8_SB(0, 0), b2, voffB);
            PG8_BAR; PG8_WAIT_L(0); PG8_MMA(0, 1, At, B1); PG8_BAR;
            PG8_LDA(At, 0, 1); PG8_STAGE(PG8_SA(0, 0), a2, voffA);
            PG8_BAR; PG8_WAIT_L(0); PG8_MMA(1, 0, At, B0); PG8_BAR; PG8_SCHED;
            PG8_STAGE(PG8_SB(0, 1), b2 + hstepB, voffB);
            PG8_WAIT_V(6); PG8_BAR; PG8_MMA(1, 1, At, B1); PG8_BAR;
            PG8_LDB(B0, 1, 0); PG8_SCHED; PG8_LDA(At, 1, 0); PG8_STAGE(PG8_SA(0, 1), a2 + hstepA, voffA);
            PG8_WAIT_L(8); PG8_BAR; PG8_WAIT_L(0); PG8_MMA(0, 0, At, B0); PG8_BAR; PG8_SCHED;
            PG8_LDB(B1, 1, 1); PG8_STAGE(PG8_SB(1, 0), b3, voffB);
            PG8_BAR; PG8_WAIT_L(0); PG8_MMA(0, 1, At, B1); PG8_BAR;
            PG8_LDA(At, 1, 1); PG8_STAGE(PG8_SA(1, 0), a3, voffA);
            PG8_BAR; PG8_WAIT_L(0); PG8_MMA(1, 0, At, B0); PG8_BAR; PG8_SCHED;
            PG8_STAGE(PG8_SB(1, 1), b3 + hstepB, voffB);
            PG8_WAIT_V(6); PG8_BAR; PG8_MMA(1, 1, At, B1); PG8_BAR;
            }
        }
        if constexpr (ALIGN_EPI) { if (wr == 0) PG8_BAR; }
        asm volatile("s_nop 15\n\ts_nop 15" ::: "memory");
        if constexpr (!Epi::AFTER_DRAIN) { E(acc, cur, wr, wc, fr, fq); S.done(cur); }
        if (!has_next) break;
        if (!E.keep(cur)) {
#pragma unroll
        for (int a = 0; a < 2; ++a)
#pragma unroll
            for (int b = 0; b < 2; ++b)
#pragma unroll
                for (int m = 0; m < 4; ++m)
#pragma unroll
                    for (int n = 0; n < 2; ++n) acc[a][b][m][n] = (f32x4){0.f, 0.f, 0.f, 0.f};
        }
        cur = nxt; cA = nA; cB = nB; ++ui;
        if constexpr (ALIGN_EPI) { if (wr == 1) PG8_BAR; }
    }
    PG8_WAIT_V(0);
    if constexpr (!ALIGN_EPI) { if (wr == 0) PG8_BAR; }
    PG8_BAR;
    if constexpr (Epi::AFTER_DRAIN) { E.fused(acc, cur, wr, wc, fr, fq, lds, wid, lane); S.done(cur); }
#undef PG8_SA
#undef PG8_SB
#undef PG8_STAGE
#undef PG8_LDA
#undef PG8_LDB
#undef PG8_MMA
#undef PG8_WAIT_V
#undef PG8_WAIT_X
#undef PG8_WAIT_L
#undef PG8_BAR
#undef PG8_SCHED
}
}

#include <hip/hip_bf16.h>
#include <cmath>
namespace attn_body {
using bf16=__hip_bfloat16;
using bf16x8=__attribute__((ext_vector_type(8)))short;
using s16x4=__attribute__((ext_vector_type(4)))short;
using f32x16=__attribute__((ext_vector_type(16)))float;
using u32x4=__attribute__((ext_vector_type(4)))unsigned;
constexpr int SEQ=8192,D=64; constexpr int QP=512,KP=512,VP=512,OP=1024;
constexpr int NW=8,QBLK=32,QB=QBLK*NW,KVBLK=64,NQB=SEQ/QB;
constexpr int ATTN_UNIT_ROWS=QB;
__device__ __forceinline__ int crow(int r,int hi){return (r&3)+8*(r>>2)+4*hi;}
#define SBAR() __builtin_amdgcn_sched_barrier(0)
__device__ __forceinline__ void cmask(f32x16&p0,f32x16&p1,int jb,int qrel,int hi){
  const float NEG=-INFINITY; (void)hi;
  if(jb>(qrel>>6)){
  #pragma unroll
  for(int r=0;r<16;++r){p0[r]=NEG;p1[r]=NEG;} }
}

constexpr int NSLOT=3, SLOTB=8192;
constexpr int LDS_K=0, LDS_V=NSLOT*SLOTB, LDS_WS=2*NSLOT*SLOTB, LDS_OST=LDS_WS+NW*64*4, LDS_BYTES=LDS_OST+NW*4096;
constexpr float C2=0.125f*1.4426950408889634f;
__device__ __forceinline__ void glds16(const void*gsrc,unsigned lds_dst){unsigned keep;
  asm volatile("s_mov_b32 %0, m0\n\ts_mov_b32 m0, %2\n\ts_nop 0\n\tglobal_load_lds_dwordx4 %1, off\n\ts_mov_b32 m0, %0":"=&s"(keep):"v"(gsrc),"s"(lds_dst):"memory");}
__device__ __forceinline__ float max3f(float a,float b,float c){float r;asm("v_max3_f32 %0, %1, %2, %3":"=v"(r):"v"(a),"v"(b),"v"(c));return r;}
__device__ __forceinline__ float max2f(float a,float b){float r;asm("v_max_f32_e32 %0, %1, %2":"=v"(r):"v"(a),"v"(b));return r;}
__device__ __forceinline__ float fadd_s(float a,float b){float r;asm("v_add_f32_e32 %0, %1, %2":"=v"(r):"v"(a),"v"(b));return r;}
__device__ __forceinline__ float fsub_s(float a,float b){float r;asm("v_sub_f32_e32 %0, %1, %2":"=v"(r):"v"(a),"v"(b));return r;}
typedef float f32x2_t __attribute__((ext_vector_type(2))); typedef __bf16 bf16x2_t __attribute__((ext_vector_type(2)));
__device__ __forceinline__ unsigned cvtpk_s(float lo,float hi){f32x2_t v={lo,hi};bf16x2_t b=__builtin_convertvector(v,bf16x2_t);return __builtin_bit_cast(unsigned,b);}
#define WAIT_BAR(N) asm volatile("s_waitcnt vmcnt(" #N ") lgkmcnt(0)\n\ts_barrier":::"memory")

__device__ __forceinline__ void qkt(f32x16&p0,f32x16&p1,const char*Kslot,const bf16x8*qr,const f32x16&negm,int r32,int hi){
  const char*kb=Kslot+hi*1024+r32*16;
  #pragma unroll
  for(int d0=0;d0<4;++d0){
    const bf16x8 b0=*reinterpret_cast<const bf16x8*>(kb+d0*2048);
    const bf16x8 b1=*reinterpret_cast<const bf16x8*>(kb+d0*2048+512);
    if(d0==0){p0=__builtin_amdgcn_mfma_f32_32x32x16_bf16(b0,qr[0],negm,0,0,0);p1=__builtin_amdgcn_mfma_f32_32x32x16_bf16(b1,qr[0],negm,0,0,0);}
    else{p0=__builtin_amdgcn_mfma_f32_32x32x16_bf16(b0,qr[d0],p0,0,0,0);p1=__builtin_amdgcn_mfma_f32_32x32x16_bf16(b1,qr[d0],p1,0,0,0);}}
}
typedef __attribute__((address_space(3))) const char* lds_cptr;
typedef short v4i16_t __attribute__((ext_vector_type(4)));
__device__ __forceinline__ void kload8(bf16x8*kf,lds_cptr kp){
  kf[0]=*(const __attribute__((address_space(3))) bf16x8*)(kp);      kf[1]=*(const __attribute__((address_space(3))) bf16x8*)(kp+512);
  kf[2]=*(const __attribute__((address_space(3))) bf16x8*)(kp+2048); kf[3]=*(const __attribute__((address_space(3))) bf16x8*)(kp+2560);
  kf[4]=*(const __attribute__((address_space(3))) bf16x8*)(kp+4096); kf[5]=*(const __attribute__((address_space(3))) bf16x8*)(kp+4608);
  kf[6]=*(const __attribute__((address_space(3))) bf16x8*)(kp+6144); kf[7]=*(const __attribute__((address_space(3))) bf16x8*)(kp+6656);
}
__device__ __forceinline__ void kload2(bf16x8*kf,lds_cptr kp,int j){ kf[2*j]=*(const __attribute__((address_space(3))) bf16x8*)(kp+j*2048); kf[2*j+1]=*(const __attribute__((address_space(3))) bf16x8*)(kp+j*2048+512); }
__device__ __forceinline__ s16x4 vtr(lds_cptr p){ return __builtin_bit_cast(s16x4,__builtin_amdgcn_ds_read_tr16_b64_v4i16((__attribute__((address_space(3))) v4i16_t*)p)); }
__device__ __forceinline__ float rowmax(const f32x16&p0,const f32x16&p1){
  float a=max3f(p0[0],p0[1],p1[0]),b=max3f(p0[2],p0[3],p1[1]);a=max3f(a,p1[2],p1[3]);
  #pragma unroll
  for(int r=4;r<16;r+=4){a=max3f(a,p0[r],p0[r+1]);b=max3f(b,p0[r+2],p0[r+3]);a=max3f(a,p1[r],p1[r+1]);b=max3f(b,p1[r+2],p1[r+3]);}
  const float m=max2f(a,b);
  auto rr=__builtin_amdgcn_permlane32_swap(__float_as_uint(m),__float_as_uint(m),false,false);
  return max2f(__uint_as_float(rr[0]),__uint_as_float(rr[1]));
}
__device__ __forceinline__ void pv(f32x16*o,int vb,bf16x8 pa0,bf16x8 pa1,bf16x8 pa2,bf16x8 pa3){
  #pragma unroll
  for(int d0=0;d0<2;++d0){s16x4 lo[4],hi[4];
    #pragma unroll
    for(int ks=0;ks<4;++ks){
      asm volatile("ds_read_b64_tr_b16 %0,%1 offset:%c2":"=&v"(lo[ks]):"v"(vb),"i"(d0*4096+ks*1024):"memory");
      asm volatile("ds_read_b64_tr_b16 %0,%1 offset:%c2":"=&v"(hi[ks]):"v"(vb),"i"(d0*4096+ks*1024+512):"memory");}
    asm volatile("s_waitcnt lgkmcnt(0)":::"memory");SBAR();
    #define PK(k) (bf16x8){lo[k][0],lo[k][1],lo[k][2],lo[k][3],hi[k][0],hi[k][1],hi[k][2],hi[k][3]}
    o[d0]=__builtin_amdgcn_mfma_f32_32x32x16_bf16(pa0,PK(0),o[d0],0,0,0);
    o[d0]=__builtin_amdgcn_mfma_f32_32x32x16_bf16(pa1,PK(1),o[d0],0,0,0);
    o[d0]=__builtin_amdgcn_mfma_f32_32x32x16_bf16(pa2,PK(2),o[d0],0,0,0);
    o[d0]=__builtin_amdgcn_mfma_f32_32x32x16_bf16(pa3,PK(3),o[d0],0,0,0);
    #undef PK
  }
}

#ifndef ATTN_STORE16
#define ATTN_STORE16(p,v) (*(u32x4*)(p)=(v))
#endif
template<int THRL> __device__ __forceinline__ void attn_unit(int qb,const bf16*Q,const bf16*__restrict__ K,const bf16*__restrict__ V,bf16*O,char*shm){
  int tid_=threadIdx.x; asm volatile("":"+v"(tid_)); const int tid=tid_,lane=tid&63,r32=lane&31,hi=lane>>5; const int wid=__builtin_amdgcn_readfirstlane(tid>>6);
  const int q0=qb*QB;
  const bf16*Qw=Q+(long)(q0+wid*QBLK)*QP;
  const bf16*Kh=K,*Vh=V;
  const unsigned lds0=(unsigned)(uintptr_t)shm;
  float*wsf=(float*)(shm+LDS_WS)+wid*64;
  const bf16*ksrc=Kh+(long)lane*KP+wid*8;
  const bf16*vsrc=Vh+(long)(16*(wid&3)+(lane>>2))*VP+(wid>>2)*32+(lane&3)*8;
  const unsigned kdst=lds0+LDS_K+wid*1024, vdst=lds0+LDS_V+wid*1024;
  #define DMA_K(t,slot) glds16(ksrc+(long)(t)*KVBLK*KP,(unsigned)__builtin_amdgcn_readfirstlane(kdst+(slot)))
  #define DMA_V(t,slot) glds16(vsrc+(long)(t)*KVBLK*VP,(unsigned)__builtin_amdgcn_readfirstlane(vdst+(slot)))
  const int vb0=(int)(lds0+LDS_V)+((lane>>4)&1)*32+(lane&3)*8+(4*hi+((lane&15)>>2))*64;
  const char*Kbase=shm+LDS_K; bf16x8 kf[8];
  const lds_cptr shm3=(lds_cptr)shm; const lds_cptr kp0=shm3+LDS_K+hi*1024+r32*16; const lds_cptr vp0=shm3+LDS_V+((lane>>4)&1)*32+(lane&3)*8+(4*hi+((lane&15)>>2))*64;
  const int NT=(q0+QB)/KVBLK;
  DMA_K(0,0);DMA_V(0,0);DMA_K(1,SLOTB);
  bf16x8 qr[4];
  #pragma unroll
  for(int d0=0;d0<4;++d0)qr[d0]=*reinterpret_cast<const bf16x8*>(&Qw[(long)r32*QP+d0*16+hi*8]);
  float mhat=0.f,l_reg=0.f;f32x16 o[2];o[0]=f32x16{};o[1]=f32x16{};f32x16 negm=f32x16{};asm volatile("":"+v"(negm));
  const int qrel=wid*QBLK+r32;
  #define CMASK(P0,P1,t) do{int jb_=(t)-(NT-4); if(jb_>=0)cmask(P0,P1,jb_,qrel,hi);}while(0)
  bool resc=false;
  #define START(P0,P1) do{ const float rm=rowmax(P0,P1); resc=false; \
    { const float dl=rm; mhat=fadd_s(mhat,dl); \
      _Pragma("unroll") for(int r=0;r<16;++r){P0[r]=fsub_s(P0[r],dl);P1[r]=fsub_s(P1[r],dl);} \
      _Pragma("unroll") for(int r=0;r<16;++r)negm[r]=-mhat; asm volatile("":"+v"(negm)); } \
    _Pragma("unroll") for(int r=0;r<16;++r)P0[r]=__builtin_amdgcn_exp2f(P0[r]); }while(0)
  #define RESC() do{ if(resc){ asm volatile("s_waitcnt lgkmcnt(0)":::"memory"); \
      _Pragma("unroll") for(int d_=0;d_<2;++d_) _Pragma("unroll") for(int r=0;r<16;++r)o[d_][r]*=wsf[crow(r,hi)]; } }while(0)
  f32x16 pA0,pA1,pB0,pB1;
  int sl_prev=0,sl_cur=0,sl_next=SLOTB;
  #define ROT() do{sl_prev=sl_cur;sl_cur=sl_next;sl_next=(sl_next==(NSLOT-1)*SLOTB)?0:sl_next+SLOTB;}while(0)
  DMA_K(2,2*SLOTB);
  WAIT_BAR(3);
  qkt(pA0,pA1,Kbase,qr,negm,r32,hi);asm volatile("s_nop 15\n\ts_nop 7":"+v"(pA0),"+v"(pA1));CMASK(pA0,pA1,0);
  START(pA0,pA1);
  _Pragma("unroll") for(int r=0;r<16;++r)pA1[r]=__builtin_amdgcn_exp2f(pA1[r]);
  WAIT_BAR(0);
  DMA_K(3,0);DMA_V(1,SLOTB);
  ROT();
  kload8(kf,kp0+sl_cur);
  WAIT_BAR(2);
  s16x4 vlo[8],vhi[8]; u32x4 pw0,pw1,pw2,pw3;
  #define PKW(P,B) cvtpk_s(P[B],P[B+1])
  #define PAF(k) __builtin_bit_cast(bf16x8,pw##k)
  #define VFR(i) (bf16x8){vlo[i][0],vlo[i][1],vlo[i][2],vlo[i][3],vhi[i][0],vhi[i][1],vhi[i][2],vhi[i][3]}
  #define PIN(x) asm volatile("":"+v"(x))
  #define MX3(a,b,c) __builtin_fmaxf(__builtin_fmaxf((a),(b)),(c))
  #define GAPA(MF,A0,A1,A2,A3,W0,W1,PW) do{ MF; sacc+=A0; sacc+=A1; sacc+=A2; sacc+=A3; PIN(sacc); W0; W1; PIN(PW); SBAR(); }while(0)
  #define EX(v) __builtin_amdgcn_exp2f(v)
  #define GAPB(MF,X,B) do{ MF; X[B]=EX(X[B]); X[B+1]=EX(X[B+1]); X[B+2]=EX(X[B+2]); X[B+3]=EX(X[B+3]); PIN(X); SBAR(); }while(0)
  #define VRD(i) do{ vlo[i]=vtr(vp_+(((i)>>2)*4096+((i)&3)*1024)); vhi[i]=vtr(vp_+(((i)>>2)*4096+((i)&3)*1024+512)); }while(0)
  #define KRD(G,j) do{ if(G){ kload2(kf,kp0+sl_next,j); SBAR(); } }while(0)
  #define STEP(C0,C1,P0,P1,t,GK,GV,GL) do{ SBAR(); \
    const lds_cptr vp_=vp0+sl_prev; \
    VRD(0); SBAR(); float sacc=(P0[0]+P0[1]); \
    GAPA(C0=__builtin_amdgcn_mfma_f32_32x32x16_bf16(kf[0],qr[0],negm,0,0,0), P0[2],P0[3],P0[4],P0[5],     pw0[0]=PKW(P0,0), pw0[1]=PKW(P0,2), pw0); \
    VRD(4); SBAR(); GAPA(C1=__builtin_amdgcn_mfma_f32_32x32x16_bf16(kf[1],qr[0],negm,0,0,0), P0[6],P0[7],P0[8],P0[9],     pw0[2]=PKW(P0,4), pw0[3]=PKW(P0,6), pw0); \
    VRD(1); SBAR(); GAPA(C0=__builtin_amdgcn_mfma_f32_32x32x16_bf16(kf[2],qr[1],C0,0,0,0),   P0[10],P0[11],P0[12],P0[13], pw1[0]=PKW(P0,8), pw1[1]=PKW(P0,10), pw1); \
    VRD(5); SBAR(); GAPA(C1=__builtin_amdgcn_mfma_f32_32x32x16_bf16(kf[3],qr[1],C1,0,0,0),   P0[14],P0[15],P1[0],P1[1],   pw1[2]=PKW(P0,12),pw1[3]=PKW(P0,14), pw1); \
    VRD(2); SBAR(); GAPA(C0=__builtin_amdgcn_mfma_f32_32x32x16_bf16(kf[4],qr[2],C0,0,0,0),   P1[2],P1[3],P1[4],P1[5],     pw2[0]=PKW(P1,0), pw2[1]=PKW(P1,2), pw2); \
    VRD(6); SBAR(); GAPA(C1=__builtin_amdgcn_mfma_f32_32x32x16_bf16(kf[5],qr[2],C1,0,0,0),   P1[6],P1[7],P1[8],P1[9],     pw2[2]=PKW(P1,4), pw2[3]=PKW(P1,6), pw2); \
    VRD(3); SBAR(); GAPA(C0=__builtin_amdgcn_mfma_f32_32x32x16_bf16(kf[6],qr[3],C0,0,0,0),   P1[10],P1[11],P1[12],P1[13], pw3[0]=PKW(P1,8), pw3[1]=PKW(P1,10), pw3); \
    VRD(7); SBAR(); GAPA(C1=__builtin_amdgcn_mfma_f32_32x32x16_bf16(kf[7],qr[3],C1,0,0,0),   P1[14],P1[15],0.f,0.f,       pw3[2]=PKW(P1,12),pw3[3]=PKW(P1,14), pw3); \
    l_reg+=sacc; \
    if(GK){DMA_K((t)+3,sl_cur);} if(GV){DMA_V((t)+1,sl_next);} \
    CMASK(C0,C1,t); \
    { float a=MX3(C0[0],C0[1],C1[0]),b=MX3(C0[2],C0[3],C1[1]); a=MX3(a,C1[2],C1[3]); \
      _Pragma("unroll") for(int r=4;r<16;r+=4){a=MX3(a,C0[r],C0[r+1]);b=MX3(b,C0[r+2],C0[r+3]);a=MX3(a,C1[r],C1[r+1]);b=MX3(b,C1[r+2],C1[r+3]);} \
      float rm=__builtin_fmaxf(a,b); { auto rr=__builtin_amdgcn_permlane32_swap(__float_as_uint(rm),__float_as_uint(rm),false,false); rm=__builtin_fmaxf(__uint_as_float(rr[0]),__uint_as_float(rr[1])); } \
      resc=false; \
      if(__builtin_expect(__any(rm>(float)THRL),0)){ const float dl=__builtin_fmaxf(rm,0.f); mhat+=dl; \
        _Pragma("unroll") for(int r=0;r<16;++r){C0[r]-=dl;C1[r]-=dl;} \
        _Pragma("unroll") for(int r=0;r<16;++r)negm[r]=-mhat; asm volatile("":"+v"(negm)); \
        const float f=__builtin_amdgcn_exp2f(-dl); l_reg*=f; if(hi==0)wsf[r32]=f; resc=true; } } \
    SBAR(); \
    GAPB(o[0]=__builtin_amdgcn_mfma_f32_32x32x16_bf16(PAF(0),VFR(0),o[0],0,0,0), C0,0); \
    GAPB(o[1]=__builtin_amdgcn_mfma_f32_32x32x16_bf16(PAF(0),VFR(4),o[1],0,0,0), C0,4); \
    KRD(GL,0); GAPB(o[0]=__builtin_amdgcn_mfma_f32_32x32x16_bf16(PAF(1),VFR(1),o[0],0,0,0), C0,8); \
    KRD(GL,1); GAPB(o[1]=__builtin_amdgcn_mfma_f32_32x32x16_bf16(PAF(1),VFR(5),o[1],0,0,0), C0,12); \
    KRD(GL,2); GAPB(o[0]=__builtin_amdgcn_mfma_f32_32x32x16_bf16(PAF(2),VFR(2),o[0],0,0,0), C1,0); \
    KRD(GL,3); GAPB(o[1]=__builtin_amdgcn_mfma_f32_32x32x16_bf16(PAF(2),VFR(6),o[1],0,0,0), C1,4); \
    GAPB(o[0]=__builtin_amdgcn_mfma_f32_32x32x16_bf16(PAF(3),VFR(3),o[0],0,0,0), C1,8); \
    GAPB(o[1]=__builtin_amdgcn_mfma_f32_32x32x16_bf16(PAF(3),VFR(7),o[1],0,0,0), C1,12); \
    }while(0)
  int t=1;
  #undef CMASK
  #define CMASK(P0,P1,t) do{}while(0)
  for(;t+5<NT;t+=2){
    STEP(pB0,pB1,pA0,pA1,t,true,true,true);     WAIT_BAR(2); RESC(); ROT();
    STEP(pA0,pA1,pB0,pB1,t+1,true,true,true);   WAIT_BAR(2); RESC(); ROT();
  }
  #undef CMASK
  #define CMASK(P0,P1,t) do{int jb_=(t)-(NT-4); if(jb_>=0)cmask(P0,P1,jb_,qrel,hi);}while(0)
  #define ENDW(tt) do{ if((tt)+3<NT){WAIT_BAR(2);} else if((tt)+2<NT){WAIT_BAR(1);} else {WAIT_BAR(0);} }while(0)
  for(;t+1<NT;t+=2){
    STEP(pB0,pB1,pA0,pA1,t,(t+3<NT),(t+1<NT),(t+1<NT));       ENDW(t);   RESC(); ROT();
    STEP(pA0,pA1,pB0,pB1,t+1,(t+4<NT),(t+2<NT),(t+2<NT));     ENDW(t+1); RESC(); ROT();
  }
  STEP(pB0,pB1,pA0,pA1,NT-1,false,false,false); RESC();
  { float sacc=pB0[0]+pB0[1]; _Pragma("unroll") for(int r=2;r<16;++r)sacc+=pB0[r]; _Pragma("unroll") for(int r=0;r<16;++r)sacc+=pB1[r]; l_reg+=sacc;
    pw0=(u32x4){PKW(pB0,0),PKW(pB0,2),PKW(pB0,4),PKW(pB0,6)};pw1=(u32x4){PKW(pB0,8),PKW(pB0,10),PKW(pB0,12),PKW(pB0,14)};pw2=(u32x4){PKW(pB1,0),PKW(pB1,2),PKW(pB1,4),PKW(pB1,6)};pw3=(u32x4){PKW(pB1,8),PKW(pB1,10),PKW(pB1,12),PKW(pB1,14)};
    SBAR(); pv(o,vb0+sl_cur,PAF(0),PAF(1),PAF(2),PAF(3)); }
  #undef PKW
  #undef PAF
  #undef VFR
  #undef PIN
  #undef MX3
  #undef GAPA
  #undef GAPB
  #undef EX
  #undef VRD
  #undef KRD
  #undef STEP
  #undef ENDW
  {auto rr=__builtin_amdgcn_permlane32_swap(__float_as_uint(l_reg),__float_as_uint(l_reg),false,false);l_reg=__uint_as_float(rr[0])+__uint_as_float(rr[1]);}
  if(hi==0)wsf[32+r32]=l_reg;asm volatile("s_waitcnt lgkmcnt(0)":::"memory");
  float rli[16];
  #pragma unroll
  for(int r=0;r<16;++r)rli[r]=__builtin_amdgcn_rcpf(wsf[32+crow(r,hi)]);
  bf16*Ow=O+(long)(q0+wid*QBLK)*OP;
  { bf16*stg=(bf16*)(shm+LDS_OST)+wid*2048;
    #pragma unroll
    for(int r=0;r<16;++r){const int orow=crow(r,hi);
      #pragma unroll
      for(int d0=0;d0<2;++d0)stg[orow*64+d0*32+r32]=__float2bfloat16(o[d0][r]*rli[r]);}
    asm volatile("s_waitcnt lgkmcnt(0)":::"memory");
    #pragma unroll
    for(int i=0;i<4;++i){const int row=i*8+(lane>>3),ch=lane&7; const u32x4 v=*(const u32x4*)(stg+row*64+ch*8); ATTN_STORE16(Ow+(long)row*OP+ch*8,v);} }
  asm volatile("s_waitcnt lgkmcnt(0)\n\ts_barrier":::"memory");
  #undef DMA_K
  #undef DMA_V
  #undef CMASK
  #undef START
  #undef RESC
  #undef ROT
}

constexpr int SLOTV=16384, L2_K=0, L2_V=NSLOT*SLOTB, L2_WS=L2_V+NSLOT*SLOTV, L2_BYTES=L2_WS+NW*64*4;
__device__ __forceinline__ void qkt0(f32x16&p0,f32x16&p1,const char*Kslot,const bf16x8*qr,int r32,int hi){
  const char*kb=Kslot+hi*1024+r32*16; const f32x16 z=f32x16{};
  #pragma unroll
  for(int d0=0;d0<4;++d0){
    const bf16x8 b0=*reinterpret_cast<const bf16x8*>(kb+d0*2048);
    const bf16x8 b1=*reinterpret_cast<const bf16x8*>(kb+d0*2048+512);
    if(d0==0){p0=__builtin_amdgcn_mfma_f32_32x32x16_bf16(b0,qr[0],z,0,0,0);p1=__builtin_amdgcn_mfma_f32_32x32x16_bf16(b1,qr[0],z,0,0,0);}
    else{p0=__builtin_amdgcn_mfma_f32_32x32x16_bf16(b0,qr[d0],p0,0,0,0);p1=__builtin_amdgcn_mfma_f32_32x32x16_bf16(b1,qr[d0],p1,0,0,0);}}
}
__device__ __forceinline__ void pv128(f32x16*o,int vb,bf16x8 pa0,bf16x8 pa1,bf16x8 pa2,bf16x8 pa3){
  #pragma unroll
  for(int d0=0;d0<4;++d0){s16x4 lo[4],hi[4];
    #pragma unroll
    for(int ks=0;ks<4;++ks){
      asm volatile("ds_read_b64_tr_b16 %0,%1 offset:%c2":"=&v"(lo[ks]):"v"(vb),"i"(d0*4096+ks*1024):"memory");
      asm volatile("ds_read_b64_tr_b16 %0,%1 offset:%c2":"=&v"(hi[ks]):"v"(vb),"i"(d0*4096+ks*1024+512):"memory");}
    asm volatile("s_waitcnt lgkmcnt(0)":::"memory");SBAR();
    #define PK(k) (bf16x8){lo[k][0],lo[k][1],lo[k][2],lo[k][3],hi[k][0],hi[k][1],hi[k][2],hi[k][3]}
    o[d0]=__builtin_amdgcn_mfma_f32_32x32x16_bf16(pa0,PK(0),o[d0],0,0,0);
    o[d0]=__builtin_amdgcn_mfma_f32_32x32x16_bf16(pa1,PK(1),o[d0],0,0,0);
    o[d0]=__builtin_amdgcn_mfma_f32_32x32x16_bf16(pa2,PK(2),o[d0],0,0,0);
    o[d0]=__builtin_amdgcn_mfma_f32_32x32x16_bf16(pa3,PK(3),o[d0],0,0,0);
    #undef PK
  }
}
template<int THRL> __device__ __forceinline__ void attn_unit128(int qb,const bf16*Q,const bf16*__restrict__ K,const bf16*__restrict__ V,bf16*O,char*shm){
  int tid_=threadIdx.x; asm volatile("":"+v"(tid_)); const int tid=tid_,lane=tid&63,r32=lane&31,hi=lane>>5; const int wid=__builtin_amdgcn_readfirstlane(tid>>6);
  const int q0=qb*QB;
  const bf16*Qw=Q+(long)(q0+wid*QBLK)*QP;
  const unsigned lds0=(unsigned)(uintptr_t)shm;
  float*wsf=(float*)(shm+L2_WS)+wid*64;
  const bf16*ksrc=K+(long)lane*KP+wid*8;
  const bf16*vsrc=V+(long)(16*(wid&3)+(lane>>2))*VP+(wid>>2)*32+(lane&3)*8;
  const unsigned kdst=lds0+L2_K+wid*1024, vdst=lds0+L2_V+wid*1024;
  #define DMA_K(t,slot) glds16(ksrc+(long)(t)*KVBLK*KP,(unsigned)__builtin_amdgcn_readfirstlane(kdst+(slot)))
  #define DMA_V(t,slot) do{ glds16(vsrc+(long)(t)*KVBLK*VP,(unsigned)__builtin_amdgcn_readfirstlane(vdst+2*(slot))); glds16(vsrc+64+(long)(t)*KVBLK*VP,(unsigned)__builtin_amdgcn_readfirstlane(vdst+2*(slot)+8192)); }while(0)
  const int vb0=(int)(lds0+L2_V)+((lane>>4)&1)*32+(lane&3)*8+(4*hi+((lane&15)>>2))*64;
  const char*Kbase=shm+L2_K; bf16x8 kf[8];
  const lds_cptr shm3=(lds_cptr)shm; const lds_cptr kp0=shm3+L2_K+hi*1024+r32*16; const lds_cptr vp0=shm3+L2_V+((lane>>4)&1)*32+(lane&3)*8+(4*hi+((lane&15)>>2))*64;
  const int NT=(q0+QB)/KVBLK;
  DMA_K(0,0);DMA_V(0,0);DMA_K(1,SLOTB);
  bf16x8 qr[4];
  #pragma unroll
  for(int d0=0;d0<4;++d0)qr[d0]=*reinterpret_cast<const bf16x8*>(&Qw[(long)r32*QP+d0*16+hi*8]);
  float l_reg=0.f;f32x16 o[4];
  ;o[0]=f32x16{};o[1]=f32x16{};o[2]=f32x16{};o[3]=f32x16{};
  const int qrel=wid*QBLK+r32;
  #define CMASK(P0,P1,t) do{int jb_=(t)-(NT-4); if(jb_>=0)cmask(P0,P1,jb_,qrel,hi);}while(0)
  #define RESC() do{}while(0)
  f32x16 pA0,pA1,pB0,pB1;
  int sl_prev=0,sl_cur=0,sl_next=SLOTB;
  #define ROT() do{sl_prev=sl_cur;sl_cur=sl_next;sl_next=(sl_next==(NSLOT-1)*SLOTB)?0:sl_next+SLOTB;}while(0)
  DMA_K(2,2*SLOTB);
  WAIT_BAR(4);
  qkt0(pA0,pA1,Kbase,qr,r32,hi);asm volatile("s_nop 15\n\ts_nop 7":"+v"(pA0),"+v"(pA1));CMASK(pA0,pA1,0);
  { _Pragma("unroll") for(int r=0;r<16;++r){pA0[r]=__builtin_amdgcn_exp2f(pA0[r]);pA1[r]=__builtin_amdgcn_exp2f(pA1[r]);} }
  WAIT_BAR(0);
  DMA_K(3,0);DMA_V(1,SLOTB);
  ROT();
  kload8(kf,kp0+sl_cur);
  WAIT_BAR(3);
  s16x4 vlo[8],vhi[8],vlo2[8],vhi2[8]; u32x4 pw0,pw1,pw2,pw3;
  #define PKW(P,B) cvtpk_s(P[B],P[B+1])
  #define PAF(k) __builtin_bit_cast(bf16x8,pw##k)
  #define VFR(i) (bf16x8){vlo[i][0],vlo[i][1],vlo[i][2],vlo[i][3],vhi[i][0],vhi[i][1],vhi[i][2],vhi[i][3]}
  #define VFR2(i) (bf16x8){vlo2[i][0],vlo2[i][1],vlo2[i][2],vlo2[i][3],vhi2[i][0],vhi2[i][1],vhi2[i][2],vhi2[i][3]}
  #define PIN(x) asm volatile("":"+v"(x))
  #define MX3(a,b,c) __builtin_fmaxf(__builtin_fmaxf((a),(b)),(c))
  #define GAPA(MF,A0,A1,A2,A3,W0,W1,PW) do{ MF; sacc+=A0; sacc+=A1; sacc+=A2; sacc+=A3; PIN(sacc); W0; W1; PIN(PW); SBAR(); }while(0)
  #define EX(v) __builtin_amdgcn_exp2f(v)
  #define GAPB(MF,X,B) do{ MF; X[B]=EX(X[B]); X[B+1]=EX(X[B+1]); PIN(X); SBAR(); }while(0)
  #define VRD(i) do{ vlo[i]=vtr(vp_+(((i)>>2)*4096+((i)&3)*1024)); vhi[i]=vtr(vp_+(((i)>>2)*4096+((i)&3)*1024+512)); }while(0)
  #define VRD2(i) do{ vlo2[i]=vtr(vp_+(8192+((i)>>2)*4096+((i)&3)*1024)); vhi2[i]=vtr(vp_+(8192+((i)>>2)*4096+((i)&3)*1024+512)); SBAR(); }while(0)
  #define KRD(G,j) do{ if(G){ kload2(kf,kp0+sl_next,j); SBAR(); } }while(0)
  #define MF32(a,b,c) __builtin_amdgcn_mfma_f32_32x32x16_bf16(a,b,c,0,0,0)
  #define STEP(C0,C1,P0,P1,t,GK,GV,GL) do{ SBAR(); \
    const lds_cptr vp_=vp0+2*sl_prev; const f32x16 z16_=f32x16{}; \
    VRD(0); SBAR(); float sacc=(P0[0]+P0[1]); \
    GAPA(C0=MF32(kf[0],qr[0],z16_), P0[2],P0[3],P0[4],P0[5],     pw0[0]=PKW(P0,0), pw0[1]=PKW(P0,2), pw0); \
    VRD(4); SBAR(); GAPA(C1=MF32(kf[1],qr[0],z16_), P0[6],P0[7],P0[8],P0[9],     pw0[2]=PKW(P0,4), pw0[3]=PKW(P0,6), pw0); \
    VRD(1); SBAR(); GAPA(C0=MF32(kf[2],qr[1],C0),   P0[10],P0[11],P0[12],P0[13], pw1[0]=PKW(P0,8), pw1[1]=PKW(P0,10), pw1); \
    VRD(5); SBAR(); GAPA(C1=MF32(kf[3],qr[1],C1),   P0[14],P0[15],P1[0],P1[1],   pw1[2]=PKW(P0,12),pw1[3]=PKW(P0,14), pw1); \
    VRD(2); SBAR(); GAPA(C0=MF32(kf[4],qr[2],C0),   P1[2],P1[3],P1[4],P1[5],     pw2[0]=PKW(P1,0), pw2[1]=PKW(P1,2), pw2); \
    VRD(6); SBAR(); GAPA(C1=MF32(kf[5],qr[2],C1),   P1[6],P1[7],P1[8],P1[9],     pw2[2]=PKW(P1,4), pw2[3]=PKW(P1,6), pw2); \
    VRD(3); SBAR(); GAPA(C0=MF32(kf[6],qr[3],C0),   P1[10],P1[11],P1[12],P1[13], pw3[0]=PKW(P1,8), pw3[1]=PKW(P1,10), pw3); \
    VRD(7); SBAR(); GAPA(C1=MF32(kf[7],qr[3],C1),   P1[14],P1[15],0.f,0.f,       pw3[2]=PKW(P1,12),pw3[3]=PKW(P1,14), pw3); \
    l_reg+=sacc; \
    if(GK){DMA_K((t)+3,sl_cur);} if(GV){DMA_V((t)+1,sl_next);} \
    CMASK(C0,C1,t); \
    SBAR(); \
    VRD2(0); GAPB(o[0]=MF32(PAF(0),VFR(0),o[0]), C0,0); \
    VRD2(4); GAPB(o[1]=MF32(PAF(0),VFR(4),o[1]), C0,2); \
    VRD2(1); GAPB(o[0]=MF32(PAF(1),VFR(1),o[0]), C0,4); \
    VRD2(5); GAPB(o[1]=MF32(PAF(1),VFR(5),o[1]), C0,6); \
    VRD2(2); GAPB(o[0]=MF32(PAF(2),VFR(2),o[0]), C0,8); \
    VRD2(6); GAPB(o[1]=MF32(PAF(2),VFR(6),o[1]), C0,10); \
    VRD2(3); GAPB(o[0]=MF32(PAF(3),VFR(3),o[0]), C0,12); \
    VRD2(7); GAPB(o[1]=MF32(PAF(3),VFR(7),o[1]), C0,14); \
    GAPB(o[2]=MF32(PAF(0),VFR2(0),o[2]), C1,0); \
    GAPB(o[3]=MF32(PAF(0),VFR2(4),o[3]), C1,2); \
    KRD(GL,0); GAPB(o[2]=MF32(PAF(1),VFR2(1),o[2]), C1,4); \
    KRD(GL,1); GAPB(o[3]=MF32(PAF(1),VFR2(5),o[3]), C1,6); \
    KRD(GL,2); GAPB(o[2]=MF32(PAF(2),VFR2(2),o[2]), C1,8); \
    KRD(GL,3); GAPB(o[3]=MF32(PAF(2),VFR2(6),o[3]), C1,10); \
    GAPB(o[2]=MF32(PAF(3),VFR2(3),o[2]), C1,12); \
    GAPB(o[3]=MF32(PAF(3),VFR2(7),o[3]), C1,14); \
    }while(0)
  int t=1;
  #undef CMASK
  #define CMASK(P0,P1,t) do{}while(0)
  for(;t+5<NT;t+=2){
    STEP(pB0,pB1,pA0,pA1,t,true,true,true);     WAIT_BAR(3); RESC(); ROT();
    STEP(pA0,pA1,pB0,pB1,t+1,true,true,true);   WAIT_BAR(3); RESC(); ROT();
  }
  #undef CMASK
  #define CMASK(P0,P1,t) do{int jb_=(t)-(NT-4); if(jb_>=0)cmask(P0,P1,jb_,qrel,hi);}while(0)
  #define ENDW(tt) do{ if((tt)+3<NT){WAIT_BAR(3);} else if((tt)+2<NT){WAIT_BAR(2);} else {WAIT_BAR(0);} }while(0)
  for(;t+1<NT;t+=2){
    STEP(pB0,pB1,pA0,pA1,t,(t+3<NT),(t+1<NT),(t+1<NT));       ENDW(t);   RESC(); ROT();
    STEP(pA0,pA1,pB0,pB1,t+1,(t+4<NT),(t+2<NT),(t+2<NT));     ENDW(t+1); RESC(); ROT();
  }
  STEP(pB0,pB1,pA0,pA1,NT-1,false,false,false); RESC();
  { float sacc=pB0[0]+pB0[1]; _Pragma("unroll") for(int r=2;r<16;++r)sacc+=pB0[r]; _Pragma("unroll") for(int r=0;r<16;++r)sacc+=pB1[r]; l_reg+=sacc;
    pw0=(u32x4){PKW(pB0,0),PKW(pB0,2),PKW(pB0,4),PKW(pB0,6)};pw1=(u32x4){PKW(pB0,8),PKW(pB0,10),PKW(pB0,12),PKW(pB0,14)};pw2=(u32x4){PKW(pB1,0),PKW(pB1,2),PKW(pB1,4),PKW(pB1,6)};pw3=(u32x4){PKW(pB1,8),PKW(pB1,10),PKW(pB1,12),PKW(pB1,14)};
    SBAR(); pv128(o,vb0+2*sl_cur,PAF(0),PAF(1),PAF(2),PAF(3)); }
  #undef PKW
  #undef PAF
  #undef VFR
  #undef VFR2
  #undef PIN
  #undef MX3
  #undef GAPA
  #undef GAPB
  #undef EX
  #undef VRD
  #undef VRD2
  #undef KRD
  #undef MF32
  #undef STEP
  #undef ENDW
  {auto rr=__builtin_amdgcn_permlane32_swap(__float_as_uint(l_reg),__float_as_uint(l_reg),false,false);l_reg=__uint_as_float(rr[0])+__uint_as_float(rr[1]);}
  if(hi==0)wsf[32+r32]=l_reg;asm volatile("s_waitcnt lgkmcnt(0)":::"memory");
  float rli[16];
  #pragma unroll
  for(int r=0;r<16;++r)rli[r]=__builtin_amdgcn_rcpf(wsf[32+crow(r,hi)]);
  asm volatile("s_waitcnt lgkmcnt(0)\n\ts_barrier":::"memory");
  bf16*Ow=O+(long)(q0+wid*QBLK)*OP;
  { bf16*stg=(bf16*)(shm)+wid*4096;
    #pragma unroll
    for(int r=0;r<16;++r){const int orow=crow(r,hi);
      #pragma unroll
      for(int d0=0;d0<4;++d0)stg[orow*128+d0*32+r32]=__float2bfloat16(o[d0][r]*rli[r]);}
    asm volatile("s_waitcnt lgkmcnt(0)":::"memory");
    #pragma unroll
    for(int i=0;i<8;++i){const int row=i*4+(lane>>4),ch=lane&15; const u32x4 v=*(const u32x4*)(stg+row*128+ch*8); ATTN_STORE16(Ow+(long)row*OP+ch*8,v);} }
  asm volatile("s_waitcnt lgkmcnt(0)\n\ts_barrier":::"memory");
  #undef DMA_K
  #undef DMA_V
  #undef CMASK
  #undef RESC
  #undef ROT
}
constexpr int ATTN_LDS_BYTES=LDS_BYTES;
#undef SBAR
#undef WAIT_BAR
}
#ifndef REPEAT_PHASE
#define REPEAT_PHASE -1
#endif
constexpr int NWAVES = 8;
using cfg::T; using cfg::SEQ; using cfg::D; using cfg::NIN; using cfg::NE; using cfg::EPS; using cfg::MAXROWS;

constexpr size_t MiB = 1u << 20;
constexpr size_t WS_CTL = 0, CTL_ZERO_BYTES = 1 * MiB;
constexpr size_t WS_RCOS = 1 * MiB, WS_RSIN = 2 * MiB;
constexpr size_t WS_TKE = 3 * MiB, WS_TKP = WS_TKE + 256 * 1024, WS_TKG = WS_TKP + 256 * 1024, WS_TSLOT = WS_TKG + 256 * 1024;
constexpr size_t WS_RGATE = 4 * MiB;
constexpr size_t WS_BLKBASE = 4 * MiB + 512 * 1024;
constexpr size_t WS_SSQ = 5 * MiB;
constexpr size_t WS_WIN = 8 * MiB;
constexpr size_t WS_WBR = 23 * MiB;
constexpr size_t WS_WOUT = 26 * MiB;
constexpr size_t WS_WGU = 28 * MiB;
constexpr size_t WS_WDN = 156 * MiB;
constexpr size_t WS_HN = 220 * MiB;
constexpr size_t WS_KVM = 254 * MiB;
constexpr size_t WS_Q = 256 * MiB, WS_K = 272 * MiB, WS_V = 288 * MiB, WS_U = 304 * MiB, WS_CB = 320 * MiB, WS_MQ = 336 * MiB;
constexpr size_t WS_GATES = 352 * MiB;
constexpr size_t WS_OMAPS = 448 * MiB;
constexpr size_t WS_YALL = 480 * MiB;
constexpr size_t WS_MERGED = 528 * MiB;
constexpr size_t WS_H2 = 560 * MiB;
constexpr size_t WS_XS = 256 * MiB;
constexpr size_t WS_ACT = 400 * MiB;
constexpr size_t WS_HN8 = 576 * MiB;
constexpr size_t WS_WG8 = 592 * MiB;
constexpr size_t WS_END = 596 * MiB;
static_assert(WS_XS + (size_t)MAXROWS * 2048 <= WS_ACT && WS_ACT + (size_t)MAXROWS * 2048 <= WS_H2, "MoE overlays");
constexpr int CW_QUEUE = 1024;
constexpr int CW_GCNT = 64;
constexpr int CW_BAR = 4096;
constexpr int RING_OFF = 0, RING_BYTES = 131072;
constexpr int LDSCTL_OFF = RING_BYTES, MISC_OFF = LDSCTL_OFF + 320;
constexpr int L_PREFT = LDSCTL_OFF + 1024, L_PSTART = L_PREFT + 256, L_LCNT = L_PSTART + 256, L_LBASE = L_LCNT + 128;
constexpr int L_PART = LDSCTL_OFF + 8192;
constexpr int MOE_ETAB = (L_PART - L_PREFT) / 4;
constexpr int L_WSF = LDSCTL_OFF + 4096;
constexpr int LDS_BYTES = 163840;
constexpr int CONV_SLOTS = LDSCTL_OFF;

struct NoHooks { __device__ __forceinline__ void a_ready(const pg8::Unit&) const {} __device__ __forceinline__ void done(const pg8::Unit&) const {} };
struct ProjOrder : NoHooks {
    const char* A; const char* Bt; int G, c;
    __device__ __forceinline__ bool next(int i, pg8::Unit& u) const {
        const int L = i * G + c; int pm, pn;
        if (L < 64 * 14) pg8::static_map(L, 64, 14, pm, pn); else if (L < 64 * 14 + 8) { pm = 64 + ((L - 64 * 14) >> 2); pn = 26 + ((L - 64 * 14) & 3); } else return false;
        u.pm = pm; u.pn = pn; u.aux = 0; u.a = A + (size_t)pm * (256 * 2048); u.b = Bt + (size_t)pn * (256 * 2048); return true; }
};
struct GateOrder : NoHooks {
    const char* A; const char* Bt; int G, c;
    __device__ __forceinline__ bool next(int i, pg8::Unit& u) const {
        const int L = i * G + c; if (L >= 64 * 12) return false; int pm, pn; pg8::static_map(L, 64, 12, pm, pn);
        u.pm = pm; u.pn = pn; u.aux = 0; u.a = A + (size_t)pm * (256 * 1024); u.b = Bt + (size_t)pn * (256 * 1024); return true; }
};
struct MergeOrder : NoHooks {
    const char* Y; const char* Bt; int G, c;
    __device__ __forceinline__ bool next(int i, pg8::Unit& u) const {
        const int j = i / 3, br = i - 3 * j; const int L = j * G + c; if (L >= 256) return false; int pm, pn; pg8::static_map(L, 64, 4, pm, pn);
        u.pm = pm; u.pn = pn; u.aux = br; u.a = Y + (size_t)pm * (256 * 3072) + br * 1024; u.b = Bt + (size_t)(br * 1024 + pn * 256) * 1024; return true; }
};
struct OutOrder : NoHooks {
    const char* A; const char* Bt; int G, c;
    __device__ __forceinline__ bool next(int i, pg8::Unit& u) const {
        const int L = i * G + c; if (L >= 256) return false; int pm, pn; pg8::static_map(L, 64, 4, pm, pn);
        u.pm = pm; u.pn = pn; u.aux = 0; u.a = A + (size_t)pm * (256 * 2048); u.b = Bt + (size_t)pn * (256 * 2048); return true; }
};
struct MoeOrder : NoHooks {
    const char* A; const char* Bt; const volatile __attribute__((address_space(3))) int* prefT; int ncol, G, c; size_t tile_bytes;
    __device__ __forceinline__ bool next(int i, pg8::Unit& u) const {
        const int L = i * G + c; const int rt = L / ncol, pnl = L - rt * ncol; if (rt >= prefT[32]) return false;
        const int e = prefT[MOE_ETAB + rt];
        u.pm = rt; u.pn = e * ncol + pnl; u.aux = e; u.a = A + (size_t)rt * tile_bytes; u.b = Bt + (size_t)(e * ncol + pnl) * tile_bytes; return true; }
};

#define GAS __attribute__((address_space(1)))
#define LAS __attribute__((address_space(3)))
typedef unsigned short bf16;
typedef unsigned v4u __attribute__((ext_vector_type(4)));
typedef unsigned v2u __attribute__((ext_vector_type(2)));
typedef float f32x4 __attribute__((ext_vector_type(4)));
typedef float f32x16 __attribute__((ext_vector_type(16)));
typedef short bf16x8 __attribute__((ext_vector_type(8)));
typedef GAS unsigned gu32;
#define RLX_AGENT __ATOMIC_RELAXED, __HIP_MEMORY_SCOPE_AGENT
#define LDS_WAIT() asm volatile("s_waitcnt lgkmcnt(0)" ::: "memory")
#define VM_WAIT() asm volatile("s_waitcnt vmcnt(0)" ::: "memory")
__device__ __forceinline__ unsigned f2bf(float f) { unsigned u = __builtin_bit_cast(unsigned, f); return (u + 0x7fffu + ((u >> 16) & 1u)) >> 16; }
__device__ __forceinline__ unsigned pk2(float lo, float hi) { return f2bf(lo) | (f2bf(hi) << 16); }
__device__ __forceinline__ float bflo(unsigned w) { return __uint_as_float(w << 16); }
__device__ __forceinline__ float bfhi(unsigned w) { return __uint_as_float(w & 0xffff0000u); }
__device__ __forceinline__ float wave_sum(float v) {
#pragma unroll
    for (int o = 1; o < 64; o <<= 1) v += __shfl_xor(v, o);
    return v;
}

#define XB_TMO      128
#define XB_XCNT(j)  (256  + 64 * (j))
#define XB_XSUB(j)  (1280 + 64 * (j))
#define XB_XGEN(j)  (2304 + 64 * (j))
#define XB_TOP      3328
#define XB_TOPGEN   3392
#define XCD_BAR_WORDS 3456
#define XB_SPIN_CAP (1u << 18)

__device__ __forceinline__ unsigned xb_ld(unsigned* p)              { return __hip_atomic_load(p, __ATOMIC_RELAXED, __HIP_MEMORY_SCOPE_AGENT); }
__device__ __forceinline__ unsigned xb_add(unsigned* p, unsigned v) { return __hip_atomic_fetch_add(p, v, __ATOMIC_RELAXED, __HIP_MEMORY_SCOPE_AGENT); }
__device__ __forceinline__ unsigned xb_xcc_id() { return (unsigned)__builtin_amdgcn_s_getreg((3 << 11) | 20) & 0xFu; }
#define XB_SPIN(cond, bar) do { unsigned _sp = 0; while (cond) { __builtin_amdgcn_s_sleep(1); \
    if ((++_sp & 255u) == 0u) { if (xb_ld(&(bar)[XB_TMO])) break; if (_sp > XB_SPIN_CAP) { atomicAdd(&(bar)[XB_TMO], 1u); break; } } } } while (0)

struct XcdBarrier {
    unsigned* bar; unsigned x;
    volatile LAS unsigned* st;
};

__device__ __forceinline__ XcdBarrier xcd_barrier_post(unsigned* bar, volatile LAS unsigned* st) {
    XcdBarrier b; b.bar = bar; b.x = xb_xcc_id(); b.st = st;
    if (threadIdx.x == 0) (void)xb_add(&bar[XB_XCNT(b.x)], 1u);
    return b;
}
__device__ __forceinline__ void xcd_barrier_complete(unsigned* bar, unsigned x, unsigned& nloc, unsigned& nx) {
    const unsigned G = gridDim.x * gridDim.y * gridDim.z;
    unsigned sum, cnt, mine, sp = 0u;
    for (;;) {
        sum = 0u; cnt = 0u; mine = 0u;
#pragma unroll
        for (unsigned j = 0; j < 16; ++j) { const unsigned c = xb_ld(&bar[XB_XCNT(j)]); sum += c; cnt += (c > 0u) ? 1u : 0u; mine = (j == x) ? c : mine; }
        if (sum == G) break;
        __builtin_amdgcn_s_sleep(1);
        if ((++sp & 255u) == 0u) { if (xb_ld(&bar[XB_TMO])) break; if (sp > XB_SPIN_CAP) { atomicAdd(&bar[XB_TMO], 1u); break; } }
    }
    nloc = mine > 0u ? mine : 1u; nx = cnt > 0u ? cnt : 1u;
}

__device__ __forceinline__ void xcd_barrier(const XcdBarrier& b) {
    asm volatile("s_waitcnt vmcnt(0)" ::: "memory");
    __syncthreads();
    if (threadIdx.x == 0) {
        unsigned* bar = b.bar;
        __builtin_amdgcn_s_waitcnt(0);
        unsigned nloc = b.st[0], nx = b.st[1];
        if (nloc == 0u) { xcd_barrier_complete(bar, b.x, nloc, nx); b.st[0] = nloc; b.st[1] = nx; }
        const unsigned old = xb_add(&bar[XB_XSUB(b.x)], 1u);
        const unsigned gen = old / nloc;
        if (old + 1u == (gen + 1u) * nloc) {
            __builtin_amdgcn_fence(__ATOMIC_RELEASE, "agent");
            asm volatile("s_waitcnt vmcnt(0)" ::: "memory");
            const unsigned og = xb_add(&bar[XB_TOP], 1u);
            const unsigned tg = og / nx;
            if (og + 1u == (tg + 1u) * nx) xb_add(&bar[XB_TOPGEN], 1u);
            else XB_SPIN(xb_ld(&bar[XB_TOPGEN]) == tg, bar);
            __builtin_amdgcn_fence(__ATOMIC_ACQUIRE, "agent");
            xb_add(&bar[XB_XGEN(b.x)], 1u);
            asm volatile("s_waitcnt vmcnt(0)" ::: "memory");
        } else {
            XB_SPIN(xb_ld(&bar[XB_XGEN(b.x)]) == gen, bar);
            __builtin_amdgcn_fence(__ATOMIC_ACQUIRE, "agent");
            asm volatile("s_waitcnt vmcnt(0)" ::: "memory");
        }
    }
    __syncthreads();
}

struct Args { const float* in[25]; float* out; unsigned char* ws; int ph_lo, ph_hi; };
__device__ __forceinline__ int ip32(int r) { return 16 * ((r >> 2) & 1) + 4 * (r >> 3) + (r & 3); }
__device__ __forceinline__ void p0_transpose_item(const float* W, int ldn, int K, bf16* WT, int k0, int n0, int dst_row_base, bool perm, LAS float* scr, int lane) {
    float rr_[32];
#pragma unroll
    for (int i = 0; i < 32; ++i) rr_[i] = W[(size_t)(k0 + 2 * i + (lane >> 5)) * ldn + n0 + (lane & 31)];
#pragma unroll
    for (int i = 0; i < 32; ++i) scr[(2 * i + (lane >> 5)) * 33 + (lane & 31)] = rr_[i];
    LDS_WAIT(); asm volatile("" ::: "memory");
    const int c = lane & 7;
#pragma unroll
    for (int j = 0; j < 4; ++j) { const int n = (lane >> 3) + 8 * j; const LAS float* s = scr + (8 * c) * 33 + n;
        v4u o; o.x = pk2(s[0 * 33], s[1 * 33]); o.y = pk2(s[2 * 33], s[3 * 33]); o.z = pk2(s[4 * 33], s[5 * 33]); o.w = pk2(s[6 * 33], s[7 * 33]);
        *(GAS v4u*)(WT + (size_t)(dst_row_base + (perm ? ip32(n) : n)) * K + k0 + 8 * c) = o; }
    LDS_WAIT(); asm volatile("" ::: "memory");
}
__device__ __forceinline__ void p0_f8_load(float (&rr_)[32], const float* W, int ldn, int k0, int n0, int lane) {
#pragma unroll
    for (int i = 0; i < 8; ++i) { const f32x4 v = __builtin_nontemporal_load((const f32x4*)(W + (size_t)(k0 + 8 * i + (lane >> 3)) * ldn + n0 + (lane & 7) * 4));
        rr_[4 * i] = v.x; rr_[4 * i + 1] = v.y; rr_[4 * i + 2] = v.z; rr_[4 * i + 3] = v.w; }
}
__device__ __forceinline__ void p0_f8_finish(const float (&rr_)[32], int K, unsigned char* WT, int k0, int dst_row_base, LAS float* scr, int lane) {
#pragma unroll
    for (int i = 0; i < 8; ++i) { LAS float* sp = scr + (8 * i + (lane >> 3)) * 33 + (lane & 7) * 4; sp[0] = rr_[4 * i]; sp[1] = rr_[4 * i + 1]; sp[2] = rr_[4 * i + 2]; sp[3] = rr_[4 * i + 3]; }
    LDS_WAIT(); asm volatile("" ::: "memory");
    const int n = lane >> 1, hf = lane & 1; const LAS float* s = scr + (32 * hf) * 33 + n;
    v4u o0, o1;
    o0.x = pg8::pk4_fp8(32.f * s[0 * 33], 32.f * s[1 * 33], 32.f * s[2 * 33], 32.f * s[3 * 33]); o0.y = pg8::pk4_fp8(32.f * s[4 * 33], 32.f * s[5 * 33], 32.f * s[6 * 33], 32.f * s[7 * 33]);
    o0.z = pg8::pk4_fp8(32.f * s[8 * 33], 32.f * s[9 * 33], 32.f * s[10 * 33], 32.f * s[11 * 33]); o0.w = pg8::pk4_fp8(32.f * s[12 * 33], 32.f * s[13 * 33], 32.f * s[14 * 33], 32.f * s[15 * 33]);
    o1.x = pg8::pk4_fp8(32.f * s[16 * 33], 32.f * s[17 * 33], 32.f * s[18 * 33], 32.f * s[19 * 33]); o1.y = pg8::pk4_fp8(32.f * s[20 * 33], 32.f * s[21 * 33], 32.f * s[22 * 33], 32.f * s[23 * 33]);
    o1.z = pg8::pk4_fp8(32.f * s[24 * 33], 32.f * s[25 * 33], 32.f * s[26 * 33], 32.f * s[27 * 33]); o1.w = pg8::pk4_fp8(32.f * s[28 * 33], 32.f * s[29 * 33], 32.f * s[30 * 33], 32.f * s[31 * 33]);
    GAS v4u* dp = (GAS v4u*)(WT + (size_t)(dst_row_base + ip32(n)) * K + k0 + 32 * hf);
    dp[0] = o0; dp[1] = o1;
    LDS_WAIT(); asm volatile("" ::: "memory");
}
__device__ __forceinline__ void conv_drain(pg8::ConvCtx& c, LAS unsigned char* lds, int wave, int lane) {
    asm volatile("s_waitcnt vmcnt(0)" ::: "memory");
    if (c.sub >= 0) { pg8::conv_finish(c, lds, c.slot0, lane, c.sub); c.sub = -1; }
    __syncthreads();
    const unsigned base = (unsigned)(RING_OFF + wave * 16384);
    int sub[4], aft[4];
#pragma unroll
    for (int i = 0; i < 4; ++i) { sub[i] = -1; aft[i] = 0; }
#pragma unroll
    for (int i = 0; i < 4; ++i) { const int s = c.cw + c.nseq * c.jn;
        if (s < pg8::CONV_NSUB) { pg8::conv_issue(c, lds, base + i * 4096, lane, s); sub[i] = s; ++c.jn;
#pragma unroll
            for (int k = 0; k < 4; ++k) aft[k] += 4;
            aft[i] = 0; } }
    for (;;) {
        bool any = false;
#pragma unroll
        for (int i = 0; i < 4; ++i) {
            if (sub[i] < 0) continue;
            any = true;
            const int a = aft[i];
            if (a >= 15) asm volatile("s_waitcnt vmcnt(15)" ::: "memory"); else if (a >= 12) asm volatile("s_waitcnt vmcnt(12)" ::: "memory");
            else if (a >= 8) asm volatile("s_waitcnt vmcnt(8)" ::: "memory"); else if (a >= 4) asm volatile("s_waitcnt vmcnt(4)" ::: "memory"); else asm volatile("s_waitcnt vmcnt(0)" ::: "memory");
            pg8::conv_finish(c, lds, base + i * 4096, lane, sub[i]); sub[i] = -1;
#pragma unroll
            for (int k = 0; k < 4; ++k) aft[k] += 1;
            const int s = c.cw + c.nseq * c.jn;
            if (s < pg8::CONV_NSUB) { pg8::conv_issue(c, lds, base + i * 4096, lane, s); sub[i] = s; ++c.jn;
#pragma unroll
                for (int k = 0; k < 4; ++k) aft[k] += 4;
                aft[i] = 0; }
        }
        if (!any) break;
    }
}
__device__ __forceinline__ int win_group_base(int L0) {
    if (L0 < 1024) { const int l = L0 & 255; return (L0 & ~255) + 128 * ((l >> 5) & 1) + 32 * (l >> 6); }
    if (L0 < 1536) return L0;
    if (L0 < 2048) return L0 - 1536 + 2560;
    if (L0 < 3072) { const int which = L0 >= 2560, ch = (L0 - 2048) & 511; return 256 * (6 + (ch >> 7)) + 128 * which + 32 * ((ch >> 5) & 3); }
    return L0;
}
__device__ __forceinline__ void rms_row_to_bf16(const float* xrow, const float* g, bf16* orow, int lane, unsigned char* orow8 = nullptr) {
    const GAS f32x4* xr = (const GAS f32x4*)xrow + lane; const GAS f32x4* gr = (const GAS f32x4*)g + lane;
    f32x4 v[4]; float s = 0.f;
#pragma unroll
    for (int j = 0; j < 4; ++j) { v[j] = xr[64 * j]; s += (v[j].x * v[j].x + v[j].y * v[j].y) + (v[j].z * v[j].z + v[j].w * v[j].w); }
    const float r = 1.0f / sqrtf(wave_sum(s) * (1.0f / 1024.0f) + EPS);
    GAS unsigned long long* o8 = (GAS unsigned long long*)orow + lane;
#pragma unroll
    for (int j = 0; j < 4; ++j) { const f32x4 gg = gr[64 * j]; o8[64 * j] = (unsigned long long)pk2(v[j].x * r * gg.x, v[j].y * r * gg.y) | ((unsigned long long)pk2(v[j].z * r * gg.z, v[j].w * r * gg.w) << 32);
        if (orow8) ((GAS unsigned*)orow8)[64 * j + lane] = pg8::pk4_fp8(v[j].x * r * gg.x, v[j].y * r * gg.y, v[j].z * r * gg.z, v[j].w * r * gg.w); }
}


__device__ __forceinline__ void p0_prologue(const Args& a, LAS unsigned char* lds, int vcu, int G, int wave, int lane, int tid) {
    LAS float* scr = (LAS float*)(lds + RING_OFF + wave * 16384);
    const int gw = vcu * NWAVES + wave, NGW = G * NWAVES;
    unsigned char* ws = a.ws;
    constexpr int I_IN = 16 * 112, I_G8 = 16 * 96, I_KV = 16 * 32, I_BR = 3 * 8 * 32, I_OUT = 16 * 32;
    constexpr int NITEMS = I_IN + I_G8 + I_KV + I_BR + I_OUT;
    for (int it = gw; it < NITEMS; it += NGW) {
        int r = it;
        if (r < I_IN) { const int kb = r / 112, nb = r % 112; p0_transpose_item(a.in[3], NIN, 1024, (bf16*)(ws + WS_WIN), 64 * kb, 32 * nb, win_group_base(32 * nb), true, scr, lane); continue; } r -= I_IN;
        if (r < I_G8) { const int kb = r / 96, nb = r % 96; float rr8[32]; p0_f8_load(rr8, a.in[3], NIN, 64 * kb, 3584 + 32 * nb, lane); p0_f8_finish(rr8, 1024, ws + WS_WG8, 64 * kb, 32 * nb, scr, lane); continue; } r -= I_G8;
        if (r < I_KV) { const int kb = r / 32, nb = r % 32; p0_transpose_item(a.in[13], 1024, 1024, (bf16*)(ws + WS_WIN), 64 * kb, 32 * nb, 6656 + 32 * nb, true, scr, lane); continue; } r -= I_KV;
        if (r < I_BR) { const int br = r / 256, q = r % 256, kb = q / 32, nb = q % 32; p0_transpose_item(a.in[16] + (size_t)br * 512 * 1024, 1024, 512, (bf16*)(ws + WS_WBR), 64 * kb, 32 * nb, br * 1024 + 32 * nb, true, scr, lane); continue; } r -= I_BR;
        { const int kb = r / 32, nb = r % 32; p0_transpose_item(a.in[17], 1024, 1024, (bf16*)(ws + WS_WOUT), 64 * kb, 32 * nb, 32 * nb, true, scr, lane); }
    }
    bf16* HN = (bf16*)(ws + WS_HN);
    for (int m = gw; m < T + 512; m += NGW) {
        if (m < T) rms_row_to_bf16(a.in[0] + (size_t)m * D, a.in[2], HN + (size_t)m * D, lane, ws + WS_HN8 + (size_t)m * D);
        else rms_row_to_bf16(a.in[1] + (size_t)(m - T) * D, a.in[12], HN + (size_t)m * D, lane);
    }
    float* rc = (float*)(ws + WS_RCOS); float* rs = (float*)(ws + WS_RSIN);
    for (int i = gw * 64 + lane; i < SEQ * 32; i += NGW * 64) { const int pos = i >> 5, f = i & 31;
        const float inv_freq = 1.0f / powf(10000.0f, (float)(2 * f) / 64.0f); const float ang = (float)pos * inv_freq; rc[i] = cosf(ang); rs[i] = sinf(ang); }
}

__device__ __forceinline__ void phase_finish(const Args& a, int vcu, int G, int wave, int lane) {
    unsigned char* ws = a.ws; const int gw = vcu * NWAVES + wave, NGW = G * NWAVES;
    const bf16* OM = (const bf16*)(ws + WS_OMAPS); const bf16* U = (const bf16*)(ws + WS_U); const bf16* CB = (const bf16*)(ws + WS_CB); bf16* Y = (bf16*)(ws + WS_YALL);
    const float lam = expf(wave_sum(a.in[6][lane] * a.in[7][lane])) - expf(wave_sum(a.in[8][lane] * a.in[9][lane])) + 0.2f;
    const int hh = lane >> 4, c8 = (lane & 15) * 8;
    f32x4 gs0 = *(const f32x4*)(a.in[10] + c8), gs1 = *(const f32x4*)(a.in[10] + c8 + 4);
    f32x4 w0a = *(const f32x4*)(a.in[11] + lane * 8), w0b = *(const f32x4*)(a.in[11] + lane * 8 + 4);
    f32x4 w1a = *(const f32x4*)(a.in[11] + 512 + lane * 8), w1b = *(const f32x4*)(a.in[11] + 512 + lane * 8 + 4);
    f32x4 w2a = *(const f32x4*)(a.in[11] + 1024 + lane * 8), w2b = *(const f32x4*)(a.in[11] + 1024 + lane * 8 + 4);
    for (int t = gw; t < T; t += NGW) {
        {
            const v4u o0 = *(const v4u*)(OM + (size_t)t * 1024 + hh * 256 + c8), o1 = *(const v4u*)(OM + (size_t)t * 1024 + hh * 256 + 128 + c8);
            const f32x4 a0 = pg8::unpk_lo(o0) - lam * pg8::unpk_lo(o1), a1 = pg8::unpk_hi(o0) - lam * pg8::unpk_hi(o1);
            float ss = ((a0[0] * a0[0] + a0[1] * a0[1]) + (a0[2] * a0[2] + a0[3] * a0[3])) + ((a1[0] * a1[0] + a1[1] * a1[1]) + (a1[2] * a1[2] + a1[3] * a1[3]));
            ss += __shfl_xor(ss, 1); ss += __shfl_xor(ss, 2); ss += __shfl_xor(ss, 4); ss += __shfl_xor(ss, 8);
            const float r = 0.8f / sqrtf(ss * (1.0f / 128.0f) + EPS);
            *(v4u*)(Y + (size_t)t * 1536 + hh * 128 + c8) = pg8::pack8(a0 * gs0 * r, a1 * gs1 * r);
        }
        {
            const int s = t & (SEQ - 1); const v4u z = {0u, 0u, 0u, 0u};
            const v4u u0 = *(const v4u*)(U + (size_t)t * 512 + lane * 8);
            const v4u u1 = s >= 1 ? *(const v4u*)(U + (size_t)(t - 1) * 512 + lane * 8) : z;
            const v4u u2 = s >= 2 ? *(const v4u*)(U + (size_t)(t - 2) * 512 + lane * 8) : z;
            const v4u cb = *(const v4u*)(CB + (size_t)t * 512 + lane * 8);
            const f32x4 ya = pg8::unpk_lo(cb) * (w0a * pg8::unpk_lo(u2) + w1a * pg8::unpk_lo(u1) + w2a * pg8::unpk_lo(u0));
            const f32x4 yb = pg8::unpk_hi(cb) * (w0b * pg8::unpk_hi(u2) + w1b * pg8::unpk_hi(u1) + w2b * pg8::unpk_hi(u0));
            *(v4u*)(Y + (size_t)t * 1536 + 512 + lane * 8) = pg8::pack8(ya, yb);
        }
    }
}

#define DPPF(x, ctrl) __uint_as_float(__builtin_amdgcn_update_dpp(0u, __float_as_uint(x), (ctrl), 0xf, 0xf, false))
__device__ __forceinline__ float lane_xor32(float x, int lane) { auto r = __builtin_amdgcn_permlane32_swap(__float_as_uint(x), __float_as_uint(x), false, false); return __uint_as_float((lane & 32) ? r[0] : r[1]); }
__device__ __forceinline__ float lane_xor16(float x, int lane) { auto r = __builtin_amdgcn_permlane16_swap(__float_as_uint(x), __float_as_uint(x), false, false); return __uint_as_float((lane & 16) ? r[0] : r[1]); }
__device__ __forceinline__ float wave_sum_fast(float v, int lane) {
    v += DPPF(v, 0xb1); v += DPPF(v, 0x4e); v += DPPF(v, 0x141); v += DPPF(v, 0x140); v += lane_xor16(v, lane); v += lane_xor32(v, lane); return v; }
__device__ __forceinline__ void router_pick(float (&p)[32], int t, float bias, int lane_in, LAS unsigned char* lds, int* tk_e, int* tk_p, float* tk_g) {
    int lane = lane_in; asm volatile("" : "+v"(lane));
#define RSTEP(HN, MASK, XCHG) _Pragma("unroll") for (int i = 0; i < HN; ++i) { const bool up = (lane & MASK) != 0; const float keep = up ? p[i + HN] : p[i]; const float send = up ? p[i] : p[i + HN]; p[i] = keep + XCHG; }
    RSTEP(16, 32, lane_xor32(send, lane)) RSTEP(8, 16, lane_xor16(send, lane)) RSTEP(4, 8, DPPF(send, 0x140)) RSTEP(2, 4, DPPF(send, 0x141)) RSTEP(1, 2, DPPF(send, 0x4e))
#undef RSTEP
    const float logit = p[0] + DPPF(p[0], 0xb1) + bias;
    float val = (lane & 1) ? -INFINITY : logit;
    float tv[4]; int te[4];
#pragma unroll
    for (int r = 0; r < 4; ++r) {
        float m = val;
        m = fmaxf(m, DPPF(m, 0xb1)); m = fmaxf(m, DPPF(m, 0x4e)); m = fmaxf(m, DPPF(m, 0x141)); m = fmaxf(m, DPPF(m, 0x140)); m = fmaxf(m, lane_xor16(m, lane)); m = fmaxf(m, lane_xor32(m, lane));
        const unsigned long long bal = __ballot(val == m);
        const int first = __builtin_ctzll(bal);
        tv[r] = __uint_as_float(__builtin_amdgcn_readfirstlane(__float_as_uint(m))); te[r] = first >> 1;
        val = (lane == first) ? -INFINITY : val;
    }
    const float e1 = expf(tv[1] - tv[0]), e2 = expf(tv[2] - tv[0]), e3 = expf(tv[3] - tv[0]);
    const float is = 1.0f / (1.0f + e1 + e2 + e3);
    if (lane < 4) { const int e = (lane == 0) ? te[0] : (lane == 1) ? te[1] : (lane == 2) ? te[2] : te[3];
        const float gate = (lane == 0) ? is : (lane == 1) ? e1 * is : (lane == 2) ? e2 * is : e3 * is;
        const int lp = __hip_atomic_fetch_add((LAS int*)(lds + L_LCNT) + e, 1, __ATOMIC_RELAXED, __HIP_MEMORY_SCOPE_WORKGROUP);
        tk_e[t * 4 + lane] = e; tk_p[t * 4 + lane] = lp; tk_g[t * 4 + lane] = gate; }
}

__device__ __forceinline__ void phase_router(const Args& a, LAS unsigned char* lds, int vcu, int G, int wave, int lane, int tid, int dummy) {
    unsigned char* ws = a.ws; const int gw = vcu * NWAVES + wave, NGW = G * NWAVES;
    LAS float* Wt = (LAS float*)(lds + RING_OFF);
    volatile LAS int* lcnt = (volatile LAS int*)(lds + L_LCNT);
    const float* wr = a.in[19];
    const float* x1 = a.out;
    f32x4 vn[2][4];
#pragma unroll
    for (int q = 0; q < 2; ++q) { const GAS f32x4* xr = (const GAS f32x4*)(x1 + (size_t)(gw + q * NGW) * D) + lane;
#pragma unroll
        for (int j = 0; j < 4; ++j) vn[q][j] = xr[64 * j]; }
    { f32x4 wf[16];
#pragma unroll
      for (int i = 0; i < 16; ++i) wf[i] = *(const f32x4*)(wr + (size_t)(lane + 64 * i) * 32 + 4 * wave);
#pragma unroll
      for (int i = 0; i < 16; ++i) { const int d = lane + 64 * i;
          Wt[(4 * wave + 0) * 1024 + d] = wf[i].x; Wt[(4 * wave + 1) * 1024 + d] = wf[i].y; Wt[(4 * wave + 2) * 1024 + d] = wf[i].z; Wt[(4 * wave + 3) * 1024 + d] = wf[i].w; } }
    if (tid < 32) lcnt[tid] = 0;
    __syncthreads();
    const float* g = a.in[18]; unsigned char* H2 = ws + WS_H2;
    int* tk_e = (int*)(ws + WS_TKE); int* tk_p = (int*)(ws + WS_TKP); float* tk_g = (float*)(ws + WS_TKG);
    LAS unsigned char* ldsc = lds;
    const float bias = a.in[20][lane >> 1];
    const GAS f32x4* gr = (const GAS f32x4*)g + lane;
    for (int tb = gw; tb < T; tb += 2 * NGW) {
        f32x4 v[2][4];
#pragma unroll
        for (int q = 0; q < 2; ++q)
#pragma unroll
            for (int j = 0; j < 4; ++j) v[q][j] = vn[q][j];
        if (tb + 2 * NGW < T) {
#pragma unroll
            for (int q = 0; q < 2; ++q) { const GAS f32x4* xr = (const GAS f32x4*)(x1 + (size_t)(tb + 2 * NGW + q * NGW) * D) + lane;
#pragma unroll
                for (int j = 0; j < 4; ++j) vn[q][j] = xr[64 * j]; } }
#pragma unroll
        for (int q = 0; q < 2; ++q) { float s = 0.f;
#pragma unroll
            for (int j = 0; j < 4; ++j) s += (v[q][j].x * v[q][j].x + v[q][j].y * v[q][j].y) + (v[q][j].z * v[q][j].z + v[q][j].w * v[q][j].w);
            const float r = 1.0f / sqrtf(wave_sum_fast(s, lane) * (1.0f / 1024.0f) + EPS);
            GAS unsigned* o4 = (GAS unsigned*)(H2 + (size_t)(tb + q * NGW) * D) + lane;
#pragma unroll
            for (int j = 0; j < 4; ++j) { const f32x4 gg = gr[64 * j]; v[q][j].x *= r * gg.x; v[q][j].y *= r * gg.y; v[q][j].z *= r * gg.z; v[q][j].w *= r * gg.w;
                o4[64 * j] = pg8::pk4_fp8(v[q][j].x, v[q][j].y, v[q][j].z, v[q][j].w); } }
        float p0[32], p1[32];
#pragma unroll
        for (int e = 0; e < 32; ++e) { p0[e] = 0.f; p1[e] = 0.f; }
        for (int ps_ = 0; ps_ < (REPEAT_PHASE == 22 ? 2 : 1); ++ps_) {
        f32x4 w[4], wn[4];
        const LAS float* Wl = Wt + 4 * lane; asm volatile("" : "+v"(Wl));
#pragma unroll
        for (int j = 0; j < 4; ++j) w[j] = *(const LAS f32x4*)(Wl + 256 * j);
#pragma unroll
        for (int e = 0; e < 32; ++e) {
            if (e + 1 < 32) {
#pragma unroll
                for (int j = 0; j < 4; ++j) wn[j] = *(const LAS f32x4*)(Wl + (e + 1) * 1024 + 256 * j); }
            asm volatile("" ::: "memory"); __builtin_amdgcn_sched_barrier(0);
            { float a0 = 0.f, a1 = 0.f, b0 = 0.f, b1 = 0.f;
#pragma unroll
              for (int j = 0; j < 4; ++j) { a0 = fmaf(v[0][j].x, w[j].x, a0); a1 = fmaf(v[0][j].y, w[j].y, a1); a0 = fmaf(v[0][j].z, w[j].z, a0); a1 = fmaf(v[0][j].w, w[j].w, a1);
                                            b0 = fmaf(v[1][j].x, w[j].x, b0); b1 = fmaf(v[1][j].y, w[j].y, b1); b0 = fmaf(v[1][j].z, w[j].z, b0); b1 = fmaf(v[1][j].w, w[j].w, b1); }
              p0[e] += a0 + a1; p1[e] += b0 + b1; asm volatile("" : "+v"(p0[e]), "+v"(p1[e])); }
#pragma unroll
            for (int j = 0; j < 4; ++j) w[j] = wn[j];
        }
        }
        if (REPEAT_PHASE == 22) {
#pragma unroll
            for (int e = 0; e < 32; ++e) { p0[e] *= 0.5f; p1[e] *= 0.5f; } }
        router_pick(p0, tb, bias, lane, ldsc, tk_e, tk_p, tk_g);
        router_pick(p1, tb + NGW, bias, lane, ldsc, tk_e, tk_p, tk_g);
    }
    __syncthreads();
    if (tid < 32) ((int*)(ws + WS_BLKBASE))[(dummy ? 8192 : 0) + vcu * 32 + tid] = lcnt[tid];
    __syncthreads();
}

__device__ __forceinline__ void moe_plan(unsigned char* ws, LAS unsigned char* lds, int tid, int vcu, int G) {
    volatile LAS int* prefT = (volatile LAS int*)(lds + L_PREFT); volatile LAS int* pstart = (volatile LAS int*)(lds + L_PSTART); volatile LAS int* lbase = (volatile LAS int*)(lds + L_LBASE);
    volatile LAS int* part = (volatile LAS int*)(lds + L_PART);
    { const int e = tid & 31, pr = tid >> 5; const int* bc = (const int*)(ws + WS_BLKBASE); int tot = 0, pre = 0;
      for (int b = pr; b < G; b += 16) { const int c = bc[b * 32 + e]; tot += c; pre += (b < vcu) ? c : 0; }
      part[pr * 32 + e] = tot; part[512 + pr * 32 + e] = pre; }
    __syncthreads();
    if (tid < 64) { int nt = 0;
        if (tid < 32) { int tot = 0, pre = 0;
#pragma unroll
            for (int pr = 0; pr < 16; ++pr) { tot += part[pr * 32 + tid]; pre += part[512 + pr * 32 + tid]; }
            lbase[tid] = pre; nt = (tot + 255) >> 8; }
        int inc = nt;
#pragma unroll
        for (int o = 1; o < 32; o <<= 1) { const int y = __shfl_up(inc, o); if ((tid & 63) >= o) inc += y; }
        if (tid < 32) { prefT[tid] = inc - nt; pstart[tid] = (inc - nt) * 256; if (tid == 31) { prefT[32] = inc; pstart[32] = inc * 256; }
            if (vcu == 0) { int* gp = (int*)(ws + WS_BLKBASE) + 16384; gp[tid] = inc - nt; if (tid == 31) gp[32] = inc; } } }
    __syncthreads();
}
__device__ __forceinline__ void moe_plan_load(unsigned char* ws, LAS unsigned char* lds, int tid) {
    volatile LAS int* prefT = (volatile LAS int*)(lds + L_PREFT);
    if (tid < 33) prefT[tid] = ((const int*)(ws + WS_BLKBASE))[16384 + tid];
    __syncthreads();
    for (int rt = tid; rt < prefT[32]; rt += NWAVES * 64) { int e = 0; while (prefT[e + 1] <= rt) ++e; prefT[MOE_ETAB + rt] = e; }
    __syncthreads();
}

__device__ __forceinline__ void phase_dispatch(const Args& a, LAS unsigned char* lds, int vcu, int G, int wave, int lane, int tid) {
    unsigned char* ws = a.ws; const int gw = vcu * NWAVES + wave, NGW = G * NWAVES;
    volatile LAS int* pstart = (volatile LAS int*)(lds + L_PSTART); volatile LAS int* lbase = (volatile LAS int*)(lds + L_LBASE);
    moe_plan(ws, lds, tid, vcu, G);
    const unsigned char* H2 = ws + WS_H2; unsigned char* XS = ws + WS_XS;
    const int* tk_e = (const int*)(ws + WS_TKE); const int* tk_p = (const int*)(ws + WS_TKP); const float* tk_g = (const float*)(ws + WS_TKG);
    int* tslot = (int*)(ws + WS_TSLOT); float* rgate = (float*)(ws + WS_RGATE);
    for (int t = gw; t < T; t += NGW) {
        int slot = 0;
        if (lane < 4) { const int e = tk_e[t * 4 + lane]; slot = pstart[e] + lbase[e] + tk_p[t * 4 + lane]; rgate[slot] = tk_g[t * 4 + lane]; tslot[t * 4 + lane] = slot; }
        const v4u r0 = *(const v4u*)(H2 + (size_t)t * D + lane * 16);
#pragma unroll
        for (int k = 0; k < 4; ++k) { const int sk = __builtin_amdgcn_readlane(slot, k); *(v4u*)(XS + (size_t)sk * D + lane * 16) = r0; }
    }
}

__device__ __forceinline__ void phase_combine(const Args& a, int vcu, int G, int wave, int lane, float* dst_out) {
    unsigned char* ws = a.ws; const int gw = vcu * NWAVES + wave, NGW = G * NWAVES;
    const unsigned char* YS = ws + WS_XS; const int* tslot = (const int*)(ws + WS_TSLOT); float* out = a.out;
    for (int t = gw; t < T; t += NGW) {
        int slot = 0; if (lane < 4) slot = tslot[t * 4 + lane];
        const float* op = out + (size_t)t * D + lane * 16; f32x4 o[4];
#pragma unroll
        for (int j = 0; j < 4; ++j) o[j] = *(const f32x4*)(op + 4 * j);
#pragma unroll
        for (int k = 0; k < 4; ++k) { const int sk = __builtin_amdgcn_readlane(slot, k); const v4u y = *(const v4u*)(YS + (size_t)sk * D + lane * 16); const unsigned yw[4] = {y.x, y.y, y.z, y.w};
#pragma unroll
            for (int j = 0; j < 4; ++j) { const auto lo = __builtin_amdgcn_cvt_pk_f32_fp8((int)yw[j], false), hi = __builtin_amdgcn_cvt_pk_f32_fp8((int)yw[j], true);
                o[j][0] += lo[0] * 0.0625f; o[j][1] += lo[1] * 0.0625f; o[j][2] += hi[0] * 0.0625f; o[j][3] += hi[1] * 0.0625f; } }
        float* wp = dst_out + (size_t)t * D + lane * 16;
#pragma unroll
        for (int j = 0; j < 4; ++j) *(f32x4*)(wp + 4 * j) = o[j];
    }
}

__device__ __forceinline__ void memattn_unit(const Args& a, LAS unsigned char* lds, int b, int h, int qb, int wid, int lane, int tid) {
    unsigned char* ws = a.ws;
    const bf16* KVM = (const bf16*)(ws + WS_KVM); const bf16* MQ = (const bf16*)(ws + WS_MQ); const float* ssq = (const float*)(ws + WS_SSQ); bf16* Y = (bf16*)(ws + WS_YALL);
    LAS unsigned char* Ks = lds + RING_OFF;
    LAS unsigned char* Vs = lds + RING_OFF + 65536;
    const int r32 = lane & 31, hi = lane >> 5;
    const size_t qrow = (size_t)b * SEQ + (size_t)qb * 256 + wid * 32 + r32;
    bf16x8 qf[8];
#pragma unroll
    for (int ks = 0; ks < 8; ++ks) qf[ks] = *(const bf16x8*)(MQ + qrow * 512 + h * 128 + 16 * ks + 8 * hi);
    const f32x4 sq = *(const f32x4*)(ssq + qrow * 16 + h * 4);
    {
        const int m = tid >> 1, hf = tid & 1;
        const bf16* kr = KVM + (size_t)(b * 256 + m) * 1024 + h * 128 + hf * 64; const bf16* vr = kr + 512;
        v4u raw[8], vraw[8]; float ss = 0.f;
#pragma unroll
        for (int i = 0; i < 8; ++i) { raw[i] = *(const v4u*)(kr + 8 * i); vraw[i] = *(const v4u*)(vr + 8 * i); }
#pragma unroll
        for (int i = 0; i < 8; ++i) { const f32x4 x0 = pg8::unpk_lo(raw[i]), x1 = pg8::unpk_hi(raw[i]);
            ss += ((x0[0] * x0[0] + x0[1] * x0[1]) + (x0[2] * x0[2] + x0[3] * x0[3])) + ((x1[0] * x1[0] + x1[1] * x1[1]) + (x1[2] * x1[2] + x1[3] * x1[3])); }
        ss += __shfl_xor(ss, 1);
        const float r = 1.0f / sqrtf(ss * (1.0f / 128.0f) + EPS);
#pragma unroll
        for (int i = 0; i < 8; ++i) { const int d0 = hf * 64 + 8 * i; const f32x4 g0 = *(const f32x4*)(a.in[15] + d0) * *(const f32x4*)(a.in[14] + d0), g1 = *(const f32x4*)(a.in[15] + d0 + 4) * *(const f32x4*)(a.in[14] + d0 + 4);
            const int c = hf * 8 + i;
            *(LAS v4u*)(Ks + m * 256 + ((c ^ (m & 15)) << 4)) = pg8::pack8(pg8::unpk_lo(raw[i]) * g0 * r, pg8::unpk_hi(raw[i]) * g1 * r); }
        LAS unsigned char* vt = Vs + (m >> 6) * 16384 + ((m >> 4) & 3) * 1024 + (m & 15) * 64;
#pragma unroll
        for (int i = 0; i < 8; ++i) *(LAS v4u*)(vt + (2 * hf + (i >> 2)) * 4096 + (i & 3) * 16) = vraw[i];
    }
    __syncthreads();
    const float sc = (1.0f / sqrtf(((sq[0] + sq[1]) + (sq[2] + sq[3])) * (1.0f / 128.0f) + EPS)) * 0.08838834764831845f * 1.4426950408889634f;
    f32x16 o[4]; float l = 0.f;
#pragma unroll
    for (int d0 = 0; d0 < 4; ++d0) o[d0] = f32x16{};
    const int vb0 = (int)(unsigned)(uintptr_t)(lds + RING_OFF + 65536) + ((lane >> 4) & 1) * 32 + (lane & 3) * 8 + (4 * hi + ((lane & 15) >> 2)) * 64;
#pragma unroll 1
    for (int kt = 0; kt < 4; ++kt) {
        f32x16 p0 = f32x16{}, p1 = f32x16{};
#pragma unroll
        for (int ks = 0; ks < 8; ++ks) { const int c = 2 * ks + hi; const int k0 = 64 * kt + r32, k1 = k0 + 32;
            const bf16x8 f0 = *(const LAS bf16x8*)(Ks + k0 * 256 + ((c ^ (k0 & 15)) << 4)), f1 = *(const LAS bf16x8*)(Ks + k1 * 256 + ((c ^ (k1 & 15)) << 4));
            p0 = __builtin_amdgcn_mfma_f32_32x32x16_bf16(f0, qf[ks], p0, 0, 0, 0); p1 = __builtin_amdgcn_mfma_f32_32x32x16_bf16(f1, qf[ks], p1, 0, 0, 0); }
#pragma unroll
        for (int r = 0; r < 16; ++r) { p0[r] = __builtin_amdgcn_exp2f(p0[r] * sc); p1[r] = __builtin_amdgcn_exp2f(p1[r] * sc); l += p0[r] + p1[r]; }
        v4u pw[4];
        pw[0] = (v4u){pg8::cvt_pk_bf16(p0[0], p0[1]), pg8::cvt_pk_bf16(p0[2], p0[3]), pg8::cvt_pk_bf16(p0[4], p0[5]), pg8::cvt_pk_bf16(p0[6], p0[7])};
        pw[1] = (v4u){pg8::cvt_pk_bf16(p0[8], p0[9]), pg8::cvt_pk_bf16(p0[10], p0[11]), pg8::cvt_pk_bf16(p0[12], p0[13]), pg8::cvt_pk_bf16(p0[14], p0[15])};
        pw[2] = (v4u){pg8::cvt_pk_bf16(p1[0], p1[1]), pg8::cvt_pk_bf16(p1[2], p1[3]), pg8::cvt_pk_bf16(p1[4], p1[5]), pg8::cvt_pk_bf16(p1[6], p1[7])};
        pw[3] = (v4u){pg8::cvt_pk_bf16(p1[8], p1[9]), pg8::cvt_pk_bf16(p1[10], p1[11]), pg8::cvt_pk_bf16(p1[12], p1[13]), pg8::cvt_pk_bf16(p1[14], p1[15])};
        attn_body::pv128(o, vb0 + kt * 16384, __builtin_bit_cast(bf16x8, pw[0]), __builtin_bit_cast(bf16x8, pw[1]), __builtin_bit_cast(bf16x8, pw[2]), __builtin_bit_cast(bf16x8, pw[3]));
    }
    l += __shfl_xor(l, 32);
    LAS float* wsf = (LAS float*)(lds + L_WSF) + wid * 64;
    if (hi == 0) wsf[r32] = l;
    __syncthreads();
    LAS bf16* stg = (LAS bf16*)(lds + RING_OFF) + wid * 4096;
#pragma unroll
    for (int r = 0; r < 16; ++r) { const int orow = (r & 3) + 8 * (r >> 2) + 4 * hi; const float il = 1.0f / wsf[orow];
#pragma unroll
        for (int d0 = 0; d0 < 4; ++d0) stg[orow * 128 + d0 * 32 + r32] = (bf16)f2bf(o[d0][r] * il); }
    LDS_WAIT();
    bf16* Yw = Y + ((size_t)b * SEQ + (size_t)qb * 256 + wid * 32) * 1536 + 1024 + h * 128;
#pragma unroll
    for (int i = 0; i < 8; ++i) { const int row = i * 4 + (lane >> 4), ch = lane & 15; const v4u v = *(const LAS v4u*)(stg + row * 128 + ch * 8); *(v4u*)(Yw + (size_t)row * 1536 + ch * 8) = v; }
    __syncthreads();
}

__global__ void __launch_bounds__(NWAVES * 64, 2) mega_fwd(Args args) {
    extern __shared__ __attribute__((aligned(16))) unsigned char lds_raw[];
    LAS unsigned char* lds = (LAS unsigned char*)lds_raw;
    volatile LAS unsigned* MISC = (volatile LAS unsigned*)(lds + MISC_OFF);
    int tid = threadIdx.x, lane = tid & 63, wave = __builtin_amdgcn_readfirstlane(tid >> 6);
#define PHASE_LOCALS() do { tid = threadIdx.x; asm volatile("" : "+v"(tid)); lane = tid & 63; wave = __builtin_amdgcn_readfirstlane(tid >> 6); } while (0)
    const int G = gridDim.x; const int bx = blockIdx.x; const int vcu = (G % 8 == 0) ? (bx % 8) * (G / 8) + bx / 8 : bx;
    unsigned char* ws = args.ws;
    gu32* ctl = (gu32*)(ws + WS_CTL);
    for (int u = tid; u < (LDS_BYTES - LDSCTL_OFF) / 4; u += NWAVES * 64) ((LAS unsigned*)(lds + LDSCTL_OFF))[u] = 0u;
    __syncthreads();
    const int ph_lo = args.ph_lo, ph_hi = args.ph_hi;
    XcdBarrier bar; bar.bar = (unsigned*)(ctl + CW_BAR); bar.x = 0; bar.st = nullptr;
    if (ph_hi - ph_lo > 1) bar = xcd_barrier_post((unsigned*)(ctl + CW_BAR), MISC + 8);
#define IN(k) (ph_lo <= (k) && (k) < ph_hi)
#ifndef TS_PHASE
#define TS_PHASE -1
#endif
    unsigned long long* const ts = (unsigned long long*)(ws + WS_CTL + 512 * 1024);
#define STAMP(k) do { if (TS_PHASE >= 0 && bx == 0 && threadIdx.x == 0) ts[(k)] = __builtin_amdgcn_s_memrealtime(); } while (0)
#define GRID_BAR(k) do { if (IN(k) && IN((k) + 1)) xcd_barrier(bar); STAMP((k) + 1); } while (0)
    STAMP(0);

    if (IN(0)) { for (int rep_ = 0; rep_ < (REPEAT_PHASE == 0 ? 2 : 1); ++rep_) { if (rep_) xcd_barrier(bar);
    PHASE_LOCALS();
    p0_prologue(args, lds, vcu, G, wave, lane, tid);
    } }
    GRID_BAR(0);

    if (IN(1)) { for (int rep_ = 0; rep_ < (REPEAT_PHASE == 1 ? 2 : 1); ++rep_) { if (rep_) xcd_barrier(bar);
    PHASE_LOCALS();
    {
        pg8::Gemm g{2048u, 2048u, 1024};
        ProjOrder S; S.A = (const char*)(ws + WS_HN); S.Bt = (const char*)(ws + WS_WIN); S.G = G; S.c = bx;
        pg8::EpiProj E{(bf16*)(ws + WS_Q), (bf16*)(ws + WS_K), (bf16*)(ws + WS_V), (bf16*)(ws + WS_U), (bf16*)(ws + WS_CB), (bf16*)(ws + WS_MQ), (bf16*)(ws + WS_GATES), (bf16*)(ws + WS_KVM),
                       (float*)(ws + WS_SSQ), args.in[4], args.in[5], (const float*)(ws + WS_RCOS), (const float*)(ws + WS_RSIN)};
        const unsigned sv0 = __builtin_amdgcn_readfirstlane(MISC[8]), sv1 = __builtin_amdgcn_readfirstlane(MISC[9]);
        __syncthreads();
        pg8::ConvCtx cx; cx.wgu = args.in[21]; cx.wdn = args.in[23]; cx.ogu = ws + WS_WGU; cx.odn = ws + WS_WDN; cx.cw = bx * NWAVES + wave; cx.nseq = NWAVES * G; cx.jn = 0;
        cx.sub = -1; cx.slot0 = (unsigned)(CONV_SLOTS + wave * 4096);
        pg8::gemm_phase<pg8::EpiProj, ProjOrder, true, true, true>(lds + RING_OFF, g, S, E, &cx);
        { pg8::Gemm g8{1024u, 1024u, 512}; GateOrder S8; S8.A = (const char*)(ws + WS_HN8); S8.Bt = (const char*)(ws + WS_WG8); S8.G = G; S8.c = bx;
          pg8::EpiGates8 E8{ws + WS_GATES};
          pg8::gemm_phase_f8<pg8::EpiGates8, GateOrder, true, true, true>(lds + RING_OFF, g8, S8, E8, &cx); }
        conv_drain(cx, lds, wave, lane);
        __syncthreads();
        for (int u = tid; u < (LDS_BYTES - LDSCTL_OFF) / 4; u += NWAVES * 64) ((LAS unsigned*)(lds + LDSCTL_OFF))[u] = 0u;
        __syncthreads();
        if (tid == 0) { MISC[8] = sv0; MISC[9] = sv1; }
        __syncthreads();
    }
    } }
    GRID_BAR(1);

    if (IN(2)) { for (int rep_ = 0; rep_ < (REPEAT_PHASE == 2 ? 2 : 1); ++rep_) { if (rep_) xcd_barrier(bar);
    PHASE_LOCALS();
    {
        const int cmb = vcu >> 4, s = vcu & 15;
        const int b = cmb >> 3, h = (cmb >> 1) & 3, mp = cmb & 1;
        const attn_body::bf16* Qp = (const attn_body::bf16*)(ws + WS_Q) + (size_t)b * SEQ * 512 + (h * 2 + mp) * 64;
        const attn_body::bf16* Kp = (const attn_body::bf16*)(ws + WS_K) + (size_t)b * SEQ * 512 + (h * 2 + mp) * 64;
        const attn_body::bf16* Vp = (const attn_body::bf16*)(ws + WS_V) + (size_t)b * SEQ * 512 + h * 128;
        attn_body::bf16* Op = (attn_body::bf16*)(ws + WS_OMAPS) + (size_t)b * SEQ * 1024 + (h * 2 + mp) * 128;
#pragma unroll 1
        for (int i = 0; i < 2; ++i) { const int qb = (i == 0) ? s : 31 - s;
            attn_body::attn_unit128<8>(qb, Qp, Kp, Vp, Op, (char*)lds_raw + RING_OFF); }
        memattn_unit(args, lds, vcu >> 7, (vcu >> 5) & 3, vcu & 31, wave, lane, tid);
        if (REPEAT_PHASE == 21) memattn_unit(args, lds, vcu >> 7, (vcu >> 5) & 3, vcu & 31, wave, lane, tid);
    }
    } }
    GRID_BAR(2);

    if (IN(3)) { for (int rep_ = 0; rep_ < (REPEAT_PHASE == 3 ? 2 : 1); ++rep_) { if (rep_) xcd_barrier(bar);
    PHASE_LOCALS();
    phase_finish(args, vcu, G, wave, lane);
    } }
    GRID_BAR(3);

    if (REPEAT_PHASE == 20) { for (int i_ = 0; i_ < 10; ++i_) xcd_barrier(bar); }
    if (IN(4)) { for (int rep_ = 0; rep_ < (REPEAT_PHASE == 4 ? 2 : 1); ++rep_) { if (rep_) xcd_barrier(bar);
    PHASE_LOCALS();
    {
        pg8::Gemm g{3072u, 1024u, 512};
        MergeOrder S; S.Y = (const char*)(ws + WS_YALL); S.Bt = (const char*)(ws + WS_WBR); S.G = G; S.c = bx;
        pg8::EpiMerge E{(const bf16*)(ws + WS_GATES), (bf16*)(ws + WS_MERGED)};
        pg8::gemm_phase<pg8::EpiMerge, MergeOrder, true, true>(lds + RING_OFF, g, S, E);
    }
    } }
    GRID_BAR(4);

    if (IN(5)) { for (int rep_ = 0; rep_ < (REPEAT_PHASE == 5 ? 2 : 1); ++rep_) { if (rep_) xcd_barrier(bar);
    PHASE_LOCALS();
    {
        pg8::Gemm g{2048u, 2048u, 1024};
        OutOrder S; S.A = (const char*)(ws + WS_MERGED); S.Bt = (const char*)(ws + WS_WOUT); S.G = G; S.c = bx;
        pg8::EpiResid E{args.in[0], args.out};
        pg8::gemm_phase<pg8::EpiResid, OutOrder, false, true>(lds + RING_OFF, g, S, E);
    }
    } }
    GRID_BAR(5);

    if (IN(6)) { for (int rep_ = 0; rep_ < (REPEAT_PHASE == 6 ? 2 : 1); ++rep_) { if (rep_) xcd_barrier(bar);
    PHASE_LOCALS();
    phase_router(args, lds, vcu, G, wave, lane, tid, rep_ == 0 && REPEAT_PHASE == 6);
    } }
    GRID_BAR(6);

    if (IN(7)) { for (int rep_ = 0; rep_ < (REPEAT_PHASE == 7 ? 2 : 1); ++rep_) { if (rep_) xcd_barrier(bar);
    PHASE_LOCALS();
    phase_dispatch(args, lds, vcu, G, wave, lane, tid);
    } }
    GRID_BAR(7);

    if (IN(8)) { for (int rep_ = 0; rep_ < (REPEAT_PHASE == 8 ? 2 : 1); ++rep_) { if (rep_) xcd_barrier(bar);
    PHASE_LOCALS();
    {
        pg8::Gemm g{1024u, 1024u, 512};
        moe_plan_load(ws, lds, tid);
        MoeOrder S; S.A = (const char*)(ws + WS_XS); S.Bt = (const char*)(ws + WS_WGU); S.prefT = (const volatile LAS int*)(lds + L_PREFT); S.ncol = 8; S.G = G; S.c = vcu; S.tile_bytes = 256 * 1024;
        pg8::EpiSwiglu E{args.in[22], ws + WS_ACT};
        pg8::gemm_phase_f8<pg8::EpiSwiglu, MoeOrder, true, true>(lds + RING_OFF, g, S, E);
    }
    } }
    GRID_BAR(8);

    if (IN(9)) { for (int rep_ = 0; rep_ < (REPEAT_PHASE == 9 ? 2 : 1); ++rep_) { if (rep_) xcd_barrier(bar);
    PHASE_LOCALS();
    {
        pg8::Gemm g{1024u, 1024u, 512};
        moe_plan_load(ws, lds, tid);
        MoeOrder S; S.A = (const char*)(ws + WS_ACT); S.Bt = (const char*)(ws + WS_WDN); S.prefT = (const volatile LAS int*)(lds + L_PREFT); S.ncol = 4; S.G = G; S.c = vcu; S.tile_bytes = 256 * 1024;
        pg8::EpiDown E{args.in[24], (const float*)(ws + WS_RGATE), ws + WS_XS};
        pg8::gemm_phase_f8<pg8::EpiDown, MoeOrder, true, true>(lds + RING_OFF, g, S, E);
    }
    } }
    GRID_BAR(9);

    if (IN(10)) { for (int rep_ = 0; rep_ < 1; ++rep_) { if (rep_) xcd_barrier(bar);
    PHASE_LOCALS();
    if (REPEAT_PHASE == 10) { phase_combine(args, vcu, G, wave, lane, (float*)(ws + WS_WGU)); xcd_barrier(bar); }
    phase_combine(args, vcu, G, wave, lane, args.out);
    } }
    GRID_BAR(10);

    if (TS_PHASE >= 0) {
        STAMP(11); xcd_barrier(bar);
        const unsigned long long t0 = __hip_atomic_load(ts + (TS_PHASE == 11 ? 0 : TS_PHASE), RLX_AGENT), t1 = __hip_atomic_load(ts + (TS_PHASE == 11 ? 11 : TS_PHASE + 1), RLX_AGENT);
        const float v = (float)(t1 - t0) * (TS_PHASE == 11 ? 1e-4f : 1e-3f);
        for (size_t i = (size_t)bx * 512 + threadIdx.x; i < (size_t)T * D; i += (size_t)G * 512) args.out[i] = v;
    }
#undef GRID_BAR
#undef IN
}

extern "C" void kernel_launch(void* const* d_in, const int* in_sizes, int n_in, void* d_out, int out_size, void* d_ws, size_t ws_size, hipStream_t stream) {
    static int grid = 0;
    if (grid == 0) {
        if (n_in != 25 || out_size != T * D || ws_size < WS_END) { fprintf(stderr, "kernel_launch: unexpected problem shape (n_in %d, out %d, ws %zu)\n", n_in, out_size, ws_size); grid = -1; return; }
        int dev = 0, cus = 0;
        if (hipGetDevice(&dev) != hipSuccess || hipDeviceGetAttribute(&cus, hipDeviceAttributeMultiprocessorCount, dev) != hipSuccess) { grid = -1; return; }
        if (hipFuncSetAttribute((const void*)mega_fwd, hipFuncAttributeMaxDynamicSharedMemorySize, LDS_BYTES) != hipSuccess) { fprintf(stderr, "kernel_launch: hipFuncSetAttribute failed\n"); grid = -1; return; }
        int per_cu = 0;
        if (hipOccupancyMaxActiveBlocksPerMultiprocessor(&per_cu, (const void*)mega_fwd, NWAVES * 64, LDS_BYTES) != hipSuccess || per_cu < 1) fprintf(stderr, "kernel_launch: occupancy query says %d\n", per_cu);
        (void)hipGetLastError();
        grid = cus;
        if (grid != 256) fprintf(stderr, "kernel_launch: built for 256 CUs, device has %d\n", grid);
    }
    if (grid < 0) return;
    if (hipMemsetAsync((char*)d_ws + WS_CTL, 0, CTL_ZERO_BYTES, stream) != hipSuccess) return;
    Args a{};
    for (int i = 0; i < 25; ++i) a.in[i] = (const float*)d_in[i];
    a.out = (float*)d_out; a.ws = (unsigned char*)d_ws;
#ifndef MK_PER_PHASE
#define MK_PER_PHASE 0
#endif
    if (MK_PER_PHASE) { for (int k = 0; k < 11; ++k) { a.ph_lo = k; a.ph_hi = k + 1; hipLaunchKernelGGL(mega_fwd, dim3(grid), dim3(NWAVES * 64), LDS_BYTES, stream, a); } }
    else { a.ph_lo = 0; a.ph_hi = 11; hipLaunchKernelGGL(mega_fwd, dim3(grid), dim3(NWAVES * 64), LDS_BYTES, stream, a); }
}
```

```cpp
#include <hip/hip_runtime.h>
#include <hip/hip_bf16.h>
#include <cstdio>
#include <cstdint>
#include <cmath>

namespace cfg {
constexpr int BATCH = 2, SEQ = 8192, T = BATCH * SEQ, D = 1024, NIN = 6656, NE = 32, NMEM = 256;
constexpr int MAXROWS = 65536 + NE * 256;
constexpr float EPS = 1e-6f;
constexpr float C2 = 0.125f * 1.4426950408889634f;
}

namespace pg8 {
#define PG8_LAS __attribute__((address_space(3)))
typedef unsigned short bf16_t;
typedef short bf16x8 __attribute__((ext_vector_type(8)));
typedef float f32x4 __attribute__((ext_vector_type(4)));
typedef unsigned u32x4 __attribute__((ext_vector_type(4)));
typedef unsigned u32x2 __attribute__((ext_vector_type(2)));
constexpr int BM = 256, BK = 64, HALF = 128, HTB = HALF * BK * 2  , STAGE_BYTES = 8 * HTB, NXCD = 8, WGM = 8;

__host__ __device__ __forceinline__ int lds_byte(int r, int c) { const int st = (r >> 4) * 2 + (c >> 5), rr = r & 15, cc = c & 31, ob = rr * 64 + cc * 2; return st * 1024 + (ob ^ (((ob >> 9) & 1) << 5)); }
__host__ __device__ __forceinline__ void stage_rc(int b, int& R, int& C) { const int st = b / 1024, sb = b % 1024, swz = sb ^ (((sb >> 9) & 1) << 5); R = (st >> 1) * 16 + swz / 64; C = (st & 1) * 32 + (swz % 64) / 2; }

struct Unit { int pm, pn, aux; const char* a; const char* b; };
struct Gemm { unsigned lda, ldb; int K; };

__device__ __forceinline__ void static_map(int L, int nM, int nN, int& pm, int& pn) {
    const int nwg = nM * nN; int wgid = L; { const int q = nwg / NXCD, r = nwg % NXCD, xcd = wgid % NXCD, off = wgid / NXCD; wgid = (xcd < r ? xcd * (q + 1) : r * (q + 1) + (xcd - r) * q) + off; }
    const int nig = WGM * nN, gid = wgid / nig, fm = gid * WGM, gsz = (nM - fm) < WGM ? (nM - fm) : WGM;
    pm = fm + ((wgid % nig) % gsz); pn = (wgid % nig) / gsz;
}

typedef float f32x2_cv __attribute__((ext_vector_type(2))); typedef __bf16 bf16x2_cv __attribute__((ext_vector_type(2)));
__device__ __forceinline__ unsigned cvt_pk_bf16(float lo, float hi) { f32x2_cv v = {lo, hi}; bf16x2_cv b = __builtin_convertvector(v, bf16x2_cv); return __builtin_bit_cast(unsigned, b); }
__device__ __forceinline__ u32x4 pack8(const f32x4 v0, const f32x4 v1) { u32x4 w; w.x = cvt_pk_bf16(v0[0], v0[1]); w.y = cvt_pk_bf16(v0[2], v0[3]); w.z = cvt_pk_bf16(v1[0], v1[1]); w.w = cvt_pk_bf16(v1[2], v1[3]); return w; }
__device__ __forceinline__ f32x4 unpk_lo(const u32x4 w) { return (f32x4){__uint_as_float(w.x << 16), __uint_as_float(w.x & 0xffff0000u), __uint_as_float(w.y << 16), __uint_as_float(w.y & 0xffff0000u)}; }
__device__ __forceinline__ f32x4 unpk_hi(const u32x4 w) { return (f32x4){__uint_as_float(w.z << 16), __uint_as_float(w.z & 0xffff0000u), __uint_as_float(w.w << 16), __uint_as_float(w.w & 0xffff0000u)}; }
__device__ __forceinline__ unsigned pk4_fp8(float a, float b, float c, float d) { int w = 0; w = __builtin_amdgcn_cvt_pk_fp8_f32(a, b, w, false); w = __builtin_amdgcn_cvt_pk_fp8_f32(c, d, w, true); return (unsigned)w; }
__device__ __forceinline__ float sigmoidf_fast(float z) { return __builtin_amdgcn_rcpf(1.0f + __builtin_amdgcn_exp2f(-1.4426950408889634f * z)); }

using cfg::T; using cfg::SEQ; using cfg::EPS;

struct EpiProj {
    static constexpr bool AFTER_DRAIN = false;
    bf16_t *Q, *K, *V, *U, *CB, *MQ, *GATES, *KVM; float* ssq; const float *gq, *gk, *rcos, *rsin;
    __device__ __forceinline__ bool keep(const Unit&) const { return false; }
    __device__ __forceinline__ void operator()(f32x4 (&acc)[2][2][4][2], const Unit& u, int wr, int wc, int fr, int fq) const {
        const int pn = u.pn; const int row0 = u.pm * BM + wr * 64 + fr;
        if (pn < 4) {
            const bool isk = pn >= 2; const float* g = isk ? gk : gq; bf16_t* dst = (isk ? K : Q) + (pn & 1) * 256 + wc * 64 + 8 * fq;
            const float post = isk ? 1.0f : cfg::C2;
            f32x4 ga[2][2];
#pragma unroll
            for (int bj = 0; bj < 2; ++bj)
#pragma unroll
                for (int n = 0; n < 2; ++n) ga[bj][n] = *(const f32x4*)(g + 32 * bj + 8 * fq + 4 * n);
#pragma unroll
            for (int ai = 0; ai < 2; ++ai)
#pragma unroll
                for (int m = 0; m < 4; ++m) {
                    const int row = row0 + ai * HALF + m * 16;
                    float ss = 0.f;
#pragma unroll
                    for (int bj = 0; bj < 2; ++bj)
#pragma unroll
                        for (int n = 0; n < 2; ++n) { const f32x4 x = acc[ai][bj][m][n]; ss += (x[0] * x[0] + x[1] * x[1]) + (x[2] * x[2] + x[3] * x[3]); }
                    ss += __shfl_xor(ss, 16); ss += __shfl_xor(ss, 32);
                    const float rinv = __builtin_amdgcn_rsqf(ss * (1.0f / 64.0f) + EPS) * post;
                    const int pos = row & (SEQ - 1);
                    f32x4 o1[2], o2[2];
#pragma unroll
                    for (int n = 0; n < 2; ++n) {
                        const f32x4 c = *(const f32x4*)(rcos + pos * 32 + 8 * fq + 4 * n), s = *(const f32x4*)(rsin + pos * 32 + 8 * fq + 4 * n);
                        const f32x4 x1 = acc[ai][0][m][n] * ga[0][n] * rinv, x2 = acc[ai][1][m][n] * ga[1][n] * rinv;
                        o1[n] = x1 * c - x2 * s; o2[n] = x2 * c + x1 * s;
                    }
                    *(u32x4*)(dst + (size_t)row * 512) = pack8(o1[0], o1[1]);
                    *(u32x4*)(dst + (size_t)row * 512 + 32) = pack8(o2[0], o2[1]);
                }
        } else if (pn >= 6 && pn < 10) {
            bf16_t* dst = U + (pn - 6) * 128 + wc * 32 + 8 * fq;
#pragma unroll
            for (int ai = 0; ai < 2; ++ai)
#pragma unroll
                for (int m = 0; m < 4; ++m) { const int row = row0 + ai * HALF + m * 16;
                    *(u32x4*)(dst + (size_t)row * 512) = pack8(acc[ai][0][m][0] * acc[ai][1][m][0], acc[ai][0][m][1] * acc[ai][1][m][1]); }
        } else if (pn >= 14 && pn < 26) {
            unsigned char* dst = (unsigned char*)GATES + ((size_t)(u.pm * 12 + (pn - 14)) << 16) + (((wr * 4 + wc) * 64 + fq * 16 + fr) << 3);
#pragma unroll
            for (int ai = 0; ai < 2; ++ai)
#pragma unroll
                for (int m = 0; m < 4; ++m) {
#pragma unroll
                    for (int bj = 0; bj < 2; ++bj) { const f32x4 v0 = acc[ai][bj][m][0], v1 = acc[ai][bj][m][1]; unsigned q[8];
#pragma unroll
                        for (int e = 0; e < 4; ++e) { q[e] = (unsigned)(sigmoidf_fast(v0[e]) * 255.0f + 0.5f); q[4 + e] = (unsigned)(sigmoidf_fast(v1[e]) * 255.0f + 0.5f); }
                        u32x2 w8; w8.x = q[0] | (q[1] << 8) | (q[2] << 16) | (q[3] << 24); w8.y = q[4] | (q[5] << 8) | (q[6] << 16) | (q[7] << 24);
                        *(u32x2*)(dst + ((((ai * 4 + m) * 2 + bj) * 512) << 3)) = w8; } }
        } else {
            bf16_t* dst; int ld, rsub = 0; const bool ismq = (pn == 12 || pn == 13);
            if (pn < 6) { dst = V + (pn - 4) * 256; ld = 512; } else if (pn < 12) { dst = CB + (pn - 10) * 256; ld = 512; }
            else if (pn < 14) { dst = MQ + (pn - 12) * 256; ld = 512; } else { dst = KVM + (pn - 26) * 256; ld = 1024; rsub = T; }
            dst += wc * 32 + 8 * fq;
#pragma unroll
            for (int ai = 0; ai < 2; ++ai)
#pragma unroll
                for (int m = 0; m < 4; ++m) { const int row = row0 + ai * HALF + m * 16 - rsub;
#pragma unroll
                    for (int bj = 0; bj < 2; ++bj) { const f32x4 v0 = acc[ai][bj][m][0], v1 = acc[ai][bj][m][1];
                        *(u32x4*)(dst + (size_t)row * ld + bj * HALF) = pack8(v0, v1);
                        if (ismq) { float ss = ((v0[0] * v0[0] + v0[1] * v0[1]) + (v0[2] * v0[2] + v0[3] * v0[3])) + ((v1[0] * v1[0] + v1[1] * v1[1]) + (v1[2] * v1[2] + v1[3] * v1[3]));
                            ss += __shfl_xor(ss, 16); ss += __shfl_xor(ss, 32);
                            if (fq == 0) ssq[(size_t)row * 16 + ((pn - 12) * 2 + bj) * 4 + wc] = ss; } } }
        }
    }
};

struct EpiGates8 {
    static constexpr bool AFTER_DRAIN = false, HAS_BIAS = false;
    unsigned char* GATES;
    __device__ __forceinline__ bool keep(const Unit&) const { return false; }
    __device__ __forceinline__ void bias(f32x4 (&nb)[2][2], const Unit&, int, int) const { nb[0][0] = nb[0][1] = nb[1][0] = nb[1][1] = (f32x4){0.f, 0.f, 0.f, 0.f}; }
    __device__ __forceinline__ void operator()(f32x4 (&acc)[2][2][4][2], const Unit& u, int wr, int wc, int fr, int fq) const {
        {
            float t_ = 0.75f; asm volatile("" : "+v"(t_)); const float half = ((__builtin_amdgcn_cvt_pk_u8_f32(t_, 0, 0u) & 255u) == 0u) ? 0.5f : 0.0f;
            unsigned char* dst = (unsigned char*)GATES + ((size_t)(u.pm * 12 + u.pn) << 16) + (((wr * 4 + wc) * 64 + fq * 16 + fr) << 3);
#pragma unroll
            for (int ai = 0; ai < 2; ++ai)
#pragma unroll
                for (int m = 0; m < 4; ++m) {
#pragma unroll
                    for (int bj = 0; bj < 2; ++bj) { const f32x4 v0 = acc[ai][bj][m][0], v1 = acc[ai][bj][m][1]; u32x2 w8 = {0u, 0u};
#pragma unroll
                        for (int e = 0; e < 4; ++e) {
                            w8.x = __builtin_amdgcn_cvt_pk_u8_f32(__builtin_amdgcn_rcpf(__builtin_fmaf(__builtin_amdgcn_exp2f(v0[e]), 1.0f / 255.0f, 1.0f / 255.0f)) + half, e, w8.x);
                            w8.y = __builtin_amdgcn_cvt_pk_u8_f32(__builtin_amdgcn_rcpf(__builtin_fmaf(__builtin_amdgcn_exp2f(v1[e]), 1.0f / 255.0f, 1.0f / 255.0f)) + half, e, w8.y); }
                        *(u32x2*)(dst + ((((ai * 4 + m) * 2 + bj) * 512) << 3)) = w8; } }
        }
    }
};

struct EpiMerge {
    static constexpr bool AFTER_DRAIN = false;
    const bf16_t* GATES; bf16_t* MERGED;
    __device__ __forceinline__ bool keep(const Unit& u) const { return u.aux < 2; }
    __device__ __forceinline__ void operator()(f32x4 (&acc)[2][2][4][2], const Unit& u, int wr, int wc, int fr, int fq) const {
        const int br = u.aux; const int row0 = u.pm * BM + wr * 64 + fr, col0 = u.pn * BM + wc * 32 + 8 * fq;
        const unsigned char* ga_p = (const unsigned char*)GATES + ((size_t)(u.pm * 12 + br * 4 + u.pn) << 16) + (((wr * 4 + wc) * 64 + fq * 16 + fr) << 3);
        const unsigned char* gb_p = ga_p + ((size_t)4 << 16);
        u32x2 gav[16], gbv[16];
#pragma unroll
        for (int i = 0; i < 16; ++i) gav[i] = __builtin_nontemporal_load((const u32x2*)(ga_p + ((i * 512) << 3)));
        if (br < 2) {
#pragma unroll
            for (int i = 0; i < 16; ++i) gbv[i] = __builtin_nontemporal_load((const u32x2*)(gb_p + ((i * 512) << 3))); }
        else {
#pragma unroll
            for (int i = 0; i < 16; ++i) gbv[i] = (u32x2){0u, 0u}; }
        __builtin_amdgcn_sched_barrier(0);
#pragma unroll
        for (int ai = 0; ai < 2; ++ai)
#pragma unroll
            for (int m = 0; m < 4; ++m) { const int row = row0 + ai * HALF + m * 16;
#pragma unroll
                for (int bj = 0; bj < 2; ++bj) { const u32x2 ga = gav[(ai * 4 + m) * 2 + bj];
                    f32x4 f0 = {(float)(ga.x & 255u), (float)((ga.x >> 8) & 255u), (float)((ga.x >> 16) & 255u), (float)(ga.x >> 24)}, f1 = {(float)(ga.y & 255u), (float)((ga.y >> 8) & 255u), (float)((ga.y >> 16) & 255u), (float)(ga.y >> 24)};
                    if (br < 2) { const u32x2 gb = gbv[(ai * 4 + m) * 2 + bj];
                        const f32x4 d0 = {(float)__builtin_elementwise_max(gb.x & 255u, 1u), (float)__builtin_elementwise_max((gb.x >> 8) & 255u, 1u), (float)__builtin_elementwise_max((gb.x >> 16) & 255u, 1u), (float)__builtin_elementwise_max(gb.x >> 24, 1u)};
                        const f32x4 d1 = {(float)__builtin_elementwise_max(gb.y & 255u, 1u), (float)__builtin_elementwise_max((gb.y >> 8) & 255u, 1u), (float)__builtin_elementwise_max((gb.y >> 16) & 255u, 1u), (float)__builtin_elementwise_max(gb.y >> 24, 1u)};
                        if (br == 1) {
#pragma unroll
                            for (int e = 0; e < 4; ++e) { f0[e] = __builtin_fmaxf(f0[e], 1.0f); f1[e] = __builtin_fmaxf(f1[e], 1.0f); } }
#pragma unroll
                        for (int e = 0; e < 4; ++e) { f0[e] *= __builtin_amdgcn_rcpf(d0[e]); f1[e] *= __builtin_amdgcn_rcpf(d1[e]); } }
                    else {
#pragma unroll
                        for (int e = 0; e < 4; ++e) { f0[e] = __builtin_fmaxf(f0[e], 1.0f) * (1.0f / 255.0f); f1[e] = __builtin_fmaxf(f1[e], 1.0f) * (1.0f / 255.0f); } }
                    acc[ai][bj][m][0] *= f0; acc[ai][bj][m][1] *= f1;
                    if (br == 2) *(u32x4*)(MERGED + (size_t)row * 1024 + col0 + bj * HALF) = pack8(acc[ai][bj][m][0], acc[ai][bj][m][1]);
                } }
    }
};

struct EpiResid {
    static constexpr bool AFTER_DRAIN = false;
    const float* base; float* out;
    __device__ __forceinline__ bool keep(const Unit&) const { return false; }
    __device__ __forceinline__ void operator()(f32x4 (&acc)[2][2][4][2], const Unit& u, int wr, int wc, int fr, int fq) const {
        const int row0 = u.pm * BM + wr * 64 + fr, col0 = u.pn * BM + wc * 32 + 8 * fq;
#pragma unroll
        for (int ai = 0; ai < 2; ++ai)
#pragma unroll
            for (int mp = 0; mp < 2; ++mp) {
                f32x4 xv[2][2][2];
#pragma unroll
                for (int mm = 0; mm < 2; ++mm) { const size_t off = (size_t)(row0 + ai * HALF + (2 * mp + mm) * 16) * 1024 + col0;
#pragma unroll
                    for (int bj = 0; bj < 2; ++bj)
#pragma unroll
                        for (int n = 0; n < 2; ++n) xv[mm][bj][n] = __builtin_nontemporal_load((const f32x4*)(base + off + bj * HALF + n * 4)); }
                __builtin_amdgcn_sched_barrier(0);
#pragma unroll
                for (int mm = 0; mm < 2; ++mm) { const int m = 2 * mp + mm; const size_t off = (size_t)(row0 + ai * HALF + m * 16) * 1024 + col0;
#pragma unroll
                    for (int bj = 0; bj < 2; ++bj)
#pragma unroll
                        for (int n = 0; n < 2; ++n) *(f32x4*)(out + off + bj * HALF + n * 4) = xv[mm][bj][n] + acc[ai][bj][m][n]; }
                __builtin_amdgcn_sched_barrier(0); }
    }
};

struct EpiSwiglu {
    static constexpr bool AFTER_DRAIN = false, HAS_BIAS = true;
    const float* bgu; unsigned char* ACT;
    __device__ __forceinline__ bool keep(const Unit&) const { return false; }
    __device__ __forceinline__ void bias(f32x4 (&nb)[2][2], const Unit& u, int wc, int fq) const {
        const int e_ = u.pn >> 3, ch0 = (u.pn & 7) * 128 + wc * 32 + 8 * fq;
#pragma unroll
        for (int n = 0; n < 2; ++n) { nb[0][n] = *(const f32x4*)(bgu + (size_t)e_ * 2048 + ch0 + 4 * n); nb[1][n] = *(const f32x4*)(bgu + (size_t)e_ * 2048 + 1024 + ch0 + 4 * n); } }
    __device__ __forceinline__ void operator()(f32x4 (&acc)[2][2][4][2], const Unit& u, int wr, int wc, int fr, int fq) const {
        const int e_ = u.pn >> 3, pnl = u.pn & 7; const int row0 = u.pm * BM + wr * 64 + fr, ch0 = pnl * 128 + wc * 32 + 8 * fq;
        (void)e_;
#pragma unroll
        for (int ai = 0; ai < 2; ++ai)
#pragma unroll
            for (int m = 0; m < 4; ++m) { const int row = row0 + ai * HALF + m * 16; f32x4 a[2];
#pragma unroll
                for (int n = 0; n < 2; ++n) { const f32x4 g = acc[ai][0][m][n], uu = acc[ai][1][m][n];
#pragma unroll
                    for (int e = 0; e < 4; ++e) { const float gm = fminf(g[e], 7.0f), um = fminf(fmaxf(uu[e], -7.0f), 7.0f);
                        a[n][e] = (um + 1.0f) * (gm * sigmoidf_fast(1.702f * gm)); } }
                u32x2 w8; w8.x = pk4_fp8(a[0][0], a[0][1], a[0][2], a[0][3]); w8.y = pk4_fp8(a[1][0], a[1][1], a[1][2], a[1][3]);
                *(u32x2*)(ACT + (size_t)row * 1024 + ch0) = w8; }
    }
};

struct EpiDown {
    static constexpr bool AFTER_DRAIN = false, HAS_BIAS = true;
    const float* bd; const float* row_gate; unsigned char* YS;
    __device__ __forceinline__ bool keep(const Unit&) const { return false; }
    __device__ __forceinline__ void bias(f32x4 (&nb)[2][2], const Unit& u, int wc, int fq) const {
        const int e_ = u.pn >> 2, col0 = (u.pn & 3) * 256 + wc * 32 + 8 * fq;
#pragma unroll
        for (int bj = 0; bj < 2; ++bj)
#pragma unroll
            for (int n = 0; n < 2; ++n) nb[bj][n] = *(const f32x4*)(bd + (size_t)e_ * 1024 + col0 + bj * HALF + 4 * n); }
    __device__ __forceinline__ void operator()(f32x4 (&acc)[2][2][4][2], const Unit& u, int wr, int wc, int fr, int fq) const {
        const int e_ = u.pn >> 2, pnl = u.pn & 3; const int row0 = u.pm * BM + wr * 64 + fr, col0 = pnl * 256 + wc * 32 + 8 * fq;
        (void)e_;
        float rgv[8];
#pragma unroll
        for (int i = 0; i < 8; ++i) rgv[i] = row_gate[row0 + (i >> 2) * HALF + (i & 3) * 16];
        __builtin_amdgcn_sched_barrier(0);
#pragma unroll
        for (int ai = 0; ai < 2; ++ai)
#pragma unroll
            for (int m = 0; m < 4; ++m) { const int row = row0 + ai * HALF + m * 16; const float rg = rgv[ai * 4 + m] * 16.0f;
#pragma unroll
                for (int bj = 0; bj < 2; ++bj) { const f32x4 y0 = acc[ai][bj][m][0] * rg, y1 = acc[ai][bj][m][1] * rg;
                    u32x2 w8; w8.x = pk4_fp8(y0[0], y0[1], y0[2], y0[3]); w8.y = pk4_fp8(y1[0], y1[1], y1[2], y1[3]);
                    *(u32x2*)(YS + (size_t)row * 1024 + col0 + bj * HALF) = w8; } }
    }
};


constexpr int CONV_NSUB = 2 * (32768 + 16384);
struct ConvCtx {
    const float* wgu; const float* wdn; unsigned char* ogu; unsigned char* odn;
    int cw, nseq, jn;
    int sub;
    unsigned slot0;
};
struct ConvItem { const float* W; unsigned char* WT; int ldn, k0, n0, dst; };
__device__ __forceinline__ int conv_ip32(int r) { return 16 * ((r >> 2) & 1) + 4 * (r >> 3) + (r & 3); }
__device__ __forceinline__ ConvItem conv_decode(const ConvCtx& c, int s) {
    ConvItem d; const int it = s >> 1, hf = s & 1;
    if (it < 32768) { const int e = it >> 10, q = it & 1023, kb = q >> 6, nb = q & 63; const int L0 = 32 * nb, ch = L0 & 1023;
        d.W = c.wgu + (size_t)e * 1024 * 2048; d.ldn = 2048; d.k0 = 64 * kb + 32 * hf; d.n0 = L0; d.dst = e * 2048 + 256 * (ch >> 7) + 128 * (L0 >> 10) + 32 * ((ch >> 5) & 3); d.WT = c.ogu; }
    else { const int r = it - 32768, e = r >> 9, q = r & 511, kb = q >> 5, nb = q & 31;
        d.W = c.wdn + (size_t)e * 1024 * 1024; d.ldn = 1024; d.k0 = 64 * kb + 32 * hf; d.n0 = 32 * nb; d.dst = e * 1024 + 32 * nb; d.WT = c.odn; }
    return d;
}
__device__ __forceinline__ void conv_issue(const ConvCtx& c, PG8_LAS unsigned char* lds, unsigned slot, int lane_, int s) {
    int lane = lane_; asm volatile("" : "+v"(lane));
    const ConvItem d = conv_decode(c, s);
    const float* src = d.W + (size_t)(d.k0 + (lane >> 3)) * d.ldn + d.n0 + 4 * (lane & 7);
#pragma unroll
    for (int jj = 0; jj < 4; ++jj) __builtin_amdgcn_global_load_lds((const unsigned*)(src + (size_t)(8 * jj) * d.ldn), (PG8_LAS unsigned*)(lds + slot + jj * 1024), 16, 0, 2);
}
__device__ __forceinline__ void conv_finish(const ConvCtx& c, PG8_LAS unsigned char* lds, unsigned slot, int lane_, int s) {
    int lane = lane_; asm volatile("" : "+v"(lane));
    const ConvItem d = conv_decode(c, s);
    const int n = lane & 31, kh = lane >> 5;
    const PG8_LAS float* p = (const PG8_LAS float*)(lds + slot + kh * 2048 + n * 4);
    float v[16];
#pragma unroll
    for (int kk = 0; kk < 16; ++kk) v[kk] = p[kk * 32];
    asm volatile("s_waitcnt lgkmcnt(0)" ::: "memory");
    u32x4 o;
    o.x = pk4_fp8(32.f * v[0], 32.f * v[1], 32.f * v[2], 32.f * v[3]);   o.y = pk4_fp8(32.f * v[4], 32.f * v[5], 32.f * v[6], 32.f * v[7]);
    o.z = pk4_fp8(32.f * v[8], 32.f * v[9], 32.f * v[10], 32.f * v[11]); o.w = pk4_fp8(32.f * v[12], 32.f * v[13], 32.f * v[14], 32.f * v[15]);
    __builtin_nontemporal_store(o, (u32x4*)(d.WT + (size_t)(d.dst + conv_ip32(n)) * 1024 + d.k0 + 16 * kh));
}
template <class Epi, class Sched, bool ALIGN_EPI = false, bool SP2 = false, bool CONV = false>
__device__ __forceinline__ void gemm_phase(PG8_LAS unsigned char* lds, const Gemm g, const Sched& S, const Epi& E, ConvCtx* cx = nullptr) {
    int tid_ = threadIdx.x; asm volatile("" : "+v"(tid_));
    const int tid = tid_, wid = __builtin_amdgcn_readfirstlane(tid >> 6), lane = tid & 63, wr = wid >> 2, wc = wid & 3, fr = lane & 15, fq = lane >> 4;
    const int K = g.K, nt = K / BK;
    static_assert(!CONV || SP2, "CONV needs the SP2 loop");
    unsigned voffA[2], voffB[2];
#pragma unroll
    for (int i = 0; i < 2; ++i) { int R, C; stage_rc(tid * 16 + i * 8192, R, C);
        voffA[i] = (unsigned)R * g.lda + (unsigned)C * 2u; voffB[i] = (unsigned)R * g.ldb + (unsigned)C * 2u; }
    const size_t kstep = (size_t)(BK * 2);
    const size_t hstepA = (size_t)HALF * g.lda, hstepB = (size_t)HALF * g.ldb;
    const unsigned ldsw = (unsigned)wid * 1024u;
    const int aoff = lds_byte(wr * 64 + fr, fq * 8), boff = lds_byte(wc * 32 + fr, fq * 8);
#define PG8_SA(b, h) (((b) * 2 + (h)) * HTB)
#define PG8_SB(b, h) ((4 + (b) * 2 + (h)) * HTB)
#define PG8_STAGE(bufoff, gbase, voff) do { _Pragma("unroll") for (int _i = 0; _i < 2; ++_i) \
        __builtin_amdgcn_global_load_lds((const unsigned*)((const char*)(gbase) + (voff)[_i]), (PG8_LAS unsigned*)(lds + (bufoff) + ldsw + _i * 8192), 16, 0, 0); } while (0)
#define PG8_LDA(dst, b, h) do { _Pragma("unroll") for (int m = 0; m < 4; ++m) _Pragma("unroll") for (int k = 0; k < 2; ++k) dst[m][k] = *(const PG8_LAS bf16x8*)(lds + PG8_SA(b, h) + aoff + m * 2048 + k * 1024); } while (0)
#define PG8_LDB(dst, b, h) do { _Pragma("unroll") for (int n = 0; n < 2; ++n) _Pragma("unroll") for (int k = 0; k < 2; ++k) dst[n][k] = *(const PG8_LAS bf16x8*)(lds + PG8_SB(b, h) + boff + n * 2048 + k * 1024); } while (0)
#define PG8_MMA(ai, bj, At, Bt) do { __builtin_amdgcn_s_setprio(1); _Pragma("unroll") for (int m = 0; m < 4; ++m) _Pragma("unroll") for (int n = 0; n < 2; ++n) _Pragma("unroll") for (int k = 0; k < 2; ++k) \
        acc[ai][bj][m][n] = __builtin_amdgcn_mfma_f32_16x16x32_bf16(Bt[n][k], At[m][k], acc[ai][bj][m][n], 0, 0, 0); __builtin_amdgcn_s_setprio(0); } while (0)
#define PG8_WAIT_V(n) asm volatile("s_waitcnt vmcnt(" #n ")" ::: "memory")
#define PG8_WAIT_X(n_) do { if constexpr (CONV) { const int x_ = (n_); if (x_ == 5) asm volatile("s_waitcnt vmcnt(13)" ::: "memory"); else if (x_ == 4) asm volatile("s_waitcnt vmcnt(12)" ::: "memory"); \
        else if (x_ == 1) asm volatile("s_waitcnt vmcnt(9)" ::: "memory"); else asm volatile("s_waitcnt vmcnt(8)" ::: "memory"); } else asm volatile("s_waitcnt vmcnt(8)" ::: "memory"); } while (0)
#define PG8_WAIT_L(n) asm volatile("s_waitcnt lgkmcnt(" #n ")" ::: "memory")
#define PG8_BAR __builtin_amdgcn_s_barrier()
#define PG8_SCHED __builtin_amdgcn_sched_barrier(0)
    Unit cur, nxt; int ui = 0;
    if (!S.next(0, cur)) return;
    f32x4 acc[2][2][4][2];
#pragma unroll
    for (int a = 0; a < 2; ++a)
#pragma unroll
        for (int b = 0; b < 2; ++b)
#pragma unroll
            for (int m = 0; m < 4; ++m)
#pragma unroll
                for (int n = 0; n < 2; ++n) acc[a][b][m][n] = (f32x4){0.f, 0.f, 0.f, 0.f};
    bf16x8 At[4][2], B0[2][2], B1[2][2];
    const char* cA = cur.a; const char* cB = cur.b;
    S.a_ready(cur);
    if constexpr (SP2) {
        PG8_STAGE(PG8_SB(0, 0), cB, voffB); PG8_STAGE(PG8_SB(0, 1), cB + hstepB, voffB); PG8_STAGE(PG8_SA(0, 0), cA, voffA); PG8_STAGE(PG8_SA(0, 1), cA + hstepA, voffA);
        if (wr == 1) PG8_BAR;
        PG8_WAIT_V(2); PG8_BAR;
        PG8_STAGE(PG8_SB(1, 0), cB + kstep, voffB); PG8_STAGE(PG8_SA(1, 0), cA + kstep, voffA); PG8_STAGE(PG8_SB(1, 1), cB + hstepB + kstep, voffB);
        PG8_WAIT_V(6); PG8_BAR;
    } else {
        PG8_STAGE(PG8_SB(0, 0), cB, voffB); PG8_STAGE(PG8_SA(0, 0), cA, voffA); PG8_STAGE(PG8_SB(0, 1), cB + hstepB, voffB); PG8_STAGE(PG8_SA(0, 1), cA + hstepA, voffA);
        if (wr == 1) PG8_BAR;
        PG8_WAIT_V(4); PG8_BAR;
        PG8_STAGE(PG8_SB(1, 0), cB + kstep, voffB); PG8_STAGE(PG8_SA(1, 0), cA + kstep, voffA); PG8_STAGE(PG8_SB(1, 1), cB + hstepB + kstep, voffB);
        PG8_WAIT_V(6); PG8_BAR;
    }
    for (;;) {
        const bool has_next = S.next(ui + 1, nxt);
        const char* nA = has_next ? nxt.a : cA; const char* nB = has_next ? nxt.b : cB;
#pragma unroll 1
        for (int t = 0; t < nt; t += 2) {
            const bool last = (t == nt - 2);
            const char* a1 = cA + (size_t)(t + 1) * kstep;
            const char* a2 = last ? nA : cA + (size_t)(t + 2) * kstep; const char* b2 = last ? nB : cB + (size_t)(t + 2) * kstep;
            const char* a3 = a2 + kstep; const char* b3 = b2 + kstep;
            if (last && has_next) S.a_ready(nxt);
            if constexpr (SP2) {
            int cs_ = 0, cc_ = 0;
            if constexpr (CONV) { if (cx->sub >= 0) { conv_finish(*cx, lds, cx->slot0, lane, cx->sub); cx->sub = -1; cs_ = 1; } PG8_SCHED; }
            PG8_LDB(B0, 0, 0); PG8_LDB(B1, 0, 1); PG8_SCHED; PG8_LDA(At, 0, 0); PG8_STAGE(PG8_SA(1, 1), a1 + hstepA, voffA);
            if constexpr (CONV) { const int s_ = cx->cw + cx->nseq * cx->jn; if (s_ < CONV_NSUB) { conv_issue(*cx, lds, cx->slot0, lane, s_); cx->sub = s_; ++cx->jn; cc_ = 4; } }
            PG8_WAIT_X(cs_ + cc_); PG8_WAIT_L(0); PG8_BAR; PG8_MMA(0, 0, At, B0); PG8_MMA(0, 1, At, B1); PG8_BAR; PG8_SCHED;
            PG8_LDA(At, 0, 1); PG8_STAGE(PG8_SB(0, 0), b2, voffB); PG8_STAGE(PG8_SB(0, 1), b2 + hstepB, voffB); PG8_STAGE(PG8_SA(0, 0), a2, voffA);
            PG8_WAIT_X(cs_ + cc_); PG8_WAIT_L(0); PG8_BAR; PG8_MMA(1, 0, At, B0); PG8_MMA(1, 1, At, B1); PG8_BAR; PG8_SCHED;
            PG8_LDB(B0, 1, 0); PG8_LDB(B1, 1, 1); PG8_SCHED; PG8_LDA(At, 1, 0); PG8_STAGE(PG8_SA(0, 1), a2 + hstepA, voffA);
            PG8_WAIT_X(cc_); PG8_WAIT_L(0); PG8_BAR; PG8_MMA(0, 0, At, B0); PG8_MMA(0, 1, At, B1); PG8_BAR; PG8_SCHED;
            PG8_LDA(At, 1, 1); PG8_STAGE(PG8_SB(1, 0), b3, voffB); PG8_STAGE(PG8_SB(1, 1), b3 + hstepB, voffB); PG8_STAGE(PG8_SA(1, 0), a3, voffA);
            PG8_WAIT_V(8); PG8_WAIT_L(0); PG8_BAR; PG8_MMA(1, 0, At, B0); PG8_MMA(1, 1, At, B1); PG8_BAR; PG8_SCHED;
            } else {
            PG8_LDB(B0, 0, 0); PG8_SCHED; PG8_LDA(At, 0, 0); PG8_STAGE(PG8_SA(1, 1), a1 + hstepA, voffA);
            PG8_WAIT_L(8); PG8_BAR; PG8_WAIT_L(0); PG8_MMA(0, 0, At, B0); PG8_BAR; PG8_SCHED;
            PG8_LDB(B1, 0, 1); PG8_STAGE(PG8_SB(0, 0), b2, voffB);
            PG8_BAR; PG8_WAIT_L(0); PG8_MMA(0, 1, At, B1); PG8_BAR;
            PG8_LDA(At, 0, 1); PG8_STAGE(PG8_SA(0, 0), a2, voffA);
            PG8_BAR; PG8_WAIT_L(0); PG8_MMA(1, 0, At, B0); PG8_BAR; PG8_SCHED;
            PG8_STAGE(PG8_SB(0, 1), b2 + hstepB, voffB);
            PG8_WAIT_V(6); PG8_BAR; PG8_MMA(1, 1, At, B1); PG8_BAR;
            PG8_LDB(B0, 1, 0); PG8_SCHED; PG8_LDA(At, 1, 0); PG8_STAGE(PG8_SA(0, 1), a2 + hstepA, voffA);
            PG8_WAIT_L(8); PG8_BAR; PG8_WAIT_L(0); PG8_MMA(0, 0, At, B0); PG8_BAR; PG8_SCHED;
            PG8_LDB(B1, 1, 1); PG8_STAGE(PG8_SB(1, 0), b3, voffB);
            PG8_BAR; PG8_WAIT_L(0); PG8_MMA(0, 1, At, B1); PG8_BAR;
            PG8_LDA(At, 1, 1); PG8_STAGE(PG8_SA(1, 0), a3, voffA);
            PG8_BAR; PG8_WAIT_L(0); PG8_MMA(1, 0, At, B0); PG8_BAR; PG8_SCHED;
            PG8_STAGE(PG8_SB(1, 1), b3 + hstepB, voffB);
            PG8_WAIT_V(6); PG8_BAR; PG8_MMA(1, 1, At, B1); PG8_BAR;
            }
        }
        if constexpr (ALIGN_EPI) { if (wr == 0) PG8_BAR; }
        if constexpr (!Epi::AFTER_DRAIN) { E(acc, cur, wr, wc, fr, fq); S.done(cur); }
        if (!has_next) break;
        if (!E.keep(cur)) {
#pragma unroll
        for (int a = 0; a < 2; ++a)
#pragma unroll
            for (int b = 0; b < 2; ++b)
#pragma unroll
                for (int m = 0; m < 4; ++m)
#pragma unroll
                    for (int n = 0; n < 2; ++n) acc[a][b][m][n] = (f32x4){0.f, 0.f, 0.f, 0.f};
        }
        cur = nxt; cA = nA; cB = nB; ++ui;
        if constexpr (ALIGN_EPI) { if (wr == 1) PG8_BAR; }
    }
    PG8_WAIT_V(0);
    if constexpr (!ALIGN_EPI) { if (wr == 0) PG8_BAR; }
    PG8_BAR;
    if constexpr (Epi::AFTER_DRAIN) { E.fused(acc, cur, wr, wc, fr, fq, lds, wid, lane); S.done(cur); }
#undef PG8_SA
#undef PG8_SB
#undef PG8_STAGE
#undef PG8_LDA
#undef PG8_LDB
#undef PG8_MMA
#undef PG8_WAIT_V
#undef PG8_WAIT_X
#undef PG8_WAIT_L
#undef PG8_BAR
#undef PG8_SCHED
}

typedef unsigned u32x8 __attribute__((ext_vector_type(8))); typedef int i32x8 __attribute__((ext_vector_type(8)));
constexpr int F8_SCALE_W = 122, F8_SCALE_X = 127;
template <class Epi, class Sched, bool ALIGN_EPI = false, bool SP2 = false, bool CONV = false>
__device__ __forceinline__ void gemm_phase_f8(PG8_LAS unsigned char* lds, const Gemm g, const Sched& S, const Epi& E, ConvCtx* cx = nullptr) {
    int tid_ = threadIdx.x; asm volatile("" : "+v"(tid_));
    const int tid = tid_, wid = __builtin_amdgcn_readfirstlane(tid >> 6), lane = tid & 63, wr = wid >> 2, wc = wid & 3, fr = lane & 15, fq = lane >> 4;
    const int K = g.K, nt = K / BK;
    static_assert(!CONV || SP2, "CONV needs the SP2 loop");
    unsigned voffA[2], voffB[2];
#pragma unroll
    for (int i = 0; i < 2; ++i) { int R, C; stage_rc(tid * 16 + i * 8192, R, C);
        voffA[i] = (unsigned)R * g.lda + (unsigned)C * 2u; voffB[i] = (unsigned)R * g.ldb + (unsigned)C * 2u; }
    const size_t kstep = (size_t)(BK * 2);
    const size_t hstepA = (size_t)HALF * g.lda, hstepB = (size_t)HALF * g.ldb;
    const unsigned ldsw = (unsigned)wid * 1024u;
    const int aoff = lds_byte(wr * 64 + fr, fq * 8), boff = lds_byte(wc * 32 + fr, fq * 8);
#define PG8_SA(b, h) (((b) * 2 + (h)) * HTB)
#define PG8_SB(b, h) ((4 + (b) * 2 + (h)) * HTB)
#define PG8_STAGE(bufoff, gbase, voff) do { _Pragma("unroll") for (int _i = 0; _i < 2; ++_i) \
        __builtin_amdgcn_global_load_lds((const unsigned*)((const char*)(gbase) + (voff)[_i]), (PG8_LAS unsigned*)(lds + (bufoff) + ldsw + _i * 8192), 16, 0, 0); } while (0)
#define PG8_LDA(dst, b, h) do { _Pragma("unroll") for (int m = 0; m < 4; ++m) { const u32x4 lo_ = *(const PG8_LAS u32x4*)(lds + PG8_SA(b, h) + aoff + m * 2048), hi_ = *(const PG8_LAS u32x4*)(lds + PG8_SA(b, h) + aoff + m * 2048 + 1024); dst[m] = __builtin_shufflevector(lo_, hi_, 0, 1, 2, 3, 4, 5, 6, 7); } } while (0)
#define PG8_LDB(dst, b, h) do { _Pragma("unroll") for (int n = 0; n < 2; ++n) { const u32x4 lo_ = *(const PG8_LAS u32x4*)(lds + PG8_SB(b, h) + boff + n * 2048), hi_ = *(const PG8_LAS u32x4*)(lds + PG8_SB(b, h) + boff + n * 2048 + 1024); dst[n] = __builtin_shufflevector(lo_, hi_, 0, 1, 2, 3, 4, 5, 6, 7); } } while (0)
#define PG8_MMA(ai, bj, At, Bt) do { __builtin_amdgcn_s_setprio(1); _Pragma("unroll") for (int m = 0; m < 4; ++m) _Pragma("unroll") for (int n = 0; n < 2; ++n) \
        asm volatile("v_mfma_scale_f32_16x16x128_f8f6f4 %0, %1, %2, %0, %3, %4 op_sel_hi:[0,0,0]" : "+v"(acc[ai][bj][m][n]) : "v"(Bt[n]), "v"(At[m]), "v"(sc_w), "v"(sc_x)); __builtin_amdgcn_s_setprio(0); } while (0)
#define PG8_WAIT_V(n) asm volatile("s_waitcnt vmcnt(" #n ")" ::: "memory")
#define PG8_WAIT_X(n_) do { if constexpr (CONV) { const int x_ = (n_); if (x_ == 5) asm volatile("s_waitcnt vmcnt(13)" ::: "memory"); else if (x_ == 4) asm volatile("s_waitcnt vmcnt(12)" ::: "memory"); \
        else if (x_ == 1) asm volatile("s_waitcnt vmcnt(9)" ::: "memory"); else asm volatile("s_waitcnt vmcnt(8)" ::: "memory"); } else asm volatile("s_waitcnt vmcnt(8)" ::: "memory"); } while (0)
#define PG8_WAIT_L(n) asm volatile("s_waitcnt lgkmcnt(" #n ")" ::: "memory")
#define PG8_BAR __builtin_amdgcn_s_barrier()
#define PG8_SCHED __builtin_amdgcn_sched_barrier(0)
    Unit cur, nxt; int ui = 0;
    if (!S.next(0, cur)) return;
    f32x4 acc[2][2][4][2], nb[2][2];
    E.bias(nb, cur, wc, fq);
#pragma unroll
    for (int a = 0; a < 2; ++a)
#pragma unroll
        for (int b = 0; b < 2; ++b)
#pragma unroll
            for (int m = 0; m < 4; ++m)
#pragma unroll
                for (int n = 0; n < 2; ++n) acc[a][b][m][n] = nb[b][n];
    u32x8 At[4], B0[2], B1[2];
    int sc_w = F8_SCALE_W, sc_x = F8_SCALE_X; asm volatile("" : "+v"(sc_w), "+v"(sc_x));
    const char* cA = cur.a; const char* cB = cur.b;
    S.a_ready(cur);
    if constexpr (SP2) {
        PG8_STAGE(PG8_SB(0, 0), cB, voffB); PG8_STAGE(PG8_SB(0, 1), cB + hstepB, voffB); PG8_STAGE(PG8_SA(0, 0), cA, voffA); PG8_STAGE(PG8_SA(0, 1), cA + hstepA, voffA);
        if (wr == 1) PG8_BAR;
        PG8_WAIT_V(2); PG8_BAR;
        PG8_STAGE(PG8_SB(1, 0), cB + kstep, voffB); PG8_STAGE(PG8_SA(1, 0), cA + kstep, voffA); PG8_STAGE(PG8_SB(1, 1), cB + hstepB + kstep, voffB);
        PG8_WAIT_V(6); PG8_BAR;
    } else {
        PG8_STAGE(PG8_SB(0, 0), cB, voffB); PG8_STAGE(PG8_SA(0, 0), cA, voffA); PG8_STAGE(PG8_SB(0, 1), cB + hstepB, voffB); PG8_STAGE(PG8_SA(0, 1), cA + hstepA, voffA);
        if (wr == 1) PG8_BAR;
        PG8_WAIT_V(4); PG8_BAR;
        PG8_STAGE(PG8_SB(1, 0), cB + kstep, voffB); PG8_STAGE(PG8_SA(1, 0), cA + kstep, voffA); PG8_STAGE(PG8_SB(1, 1), cB + hstepB + kstep, voffB);
        PG8_WAIT_V(6); PG8_BAR;
    }
    for (;;) {
        const bool has_next = S.next(ui + 1, nxt);
        const char* nA = has_next ? nxt.a : cA; const char* nB = has_next ? nxt.b : cB;
        if (has_next) E.bias(nb, nxt, wc, fq);
#pragma unroll 1
        for (int t = 0; t < nt; t += 2) {
            const bool last = (t == nt - 2);
            const char* a1 = cA + (size_t)(t + 1) * kstep;
            const char* a2 = last ? nA : cA + (size_t)(t + 2) * kstep; const char* b2 = last ? nB : cB + (size_t)(t + 2) * kstep;
            const char* a3 = a2 + kstep; const char* b3 = b2 + kstep;
            if (last && has_next) S.a_ready(nxt);
            if constexpr (SP2) {
            int cs_ = 0, cc_ = 0;
            if constexpr (CONV) { if (cx->sub >= 0) { conv_finish(*cx, lds, cx->slot0, lane, cx->sub); cx->sub = -1; cs_ = 1; } PG8_SCHED; }
            PG8_LDB(B0, 0, 0); PG8_LDB(B1, 0, 1); PG8_SCHED; PG8_LDA(At, 0, 0); PG8_STAGE(PG8_SA(1, 1), a1 + hstepA, voffA);
            if constexpr (CONV) { const int s_ = cx->cw + cx->nseq * cx->jn; if (s_ < CONV_NSUB) { conv_issue(*cx, lds, cx->slot0, lane, s_); cx->sub = s_; ++cx->jn; cc_ = 4; } }
            PG8_WAIT_X(cs_ + cc_); PG8_WAIT_L(0); PG8_BAR; PG8_MMA(0, 0, At, B0); PG8_MMA(0, 1, At, B1); PG8_BAR; PG8_SCHED;
            PG8_LDA(At, 0, 1); PG8_STAGE(PG8_SB(0, 0), b2, voffB); PG8_STAGE(PG8_SB(0, 1), b2 + hstepB, voffB); PG8_STAGE(PG8_SA(0, 0), a2, voffA);
            PG8_WAIT_X(cs_ + cc_); PG8_WAIT_L(0); PG8_BAR; PG8_MMA(1, 0, At, B0); PG8_MMA(1, 1, At, B1); PG8_BAR; PG8_SCHED;
            PG8_LDB(B0, 1, 0); PG8_LDB(B1, 1, 1); PG8_SCHED; PG8_LDA(At, 1, 0); PG8_STAGE(PG8_SA(0, 1), a2 + hstepA, voffA);
            PG8_WAIT_X(cc_); PG8_WAIT_L(0); PG8_BAR; PG8_MMA(0, 0, At, B0); PG8_MMA(0, 1, At, B1); PG8_BAR; PG8_SCHED;
            PG8_LDA(At, 1, 1); PG8_STAGE(PG8_SB(1, 0), b3, voffB); PG8_STAGE(PG8_SB(1, 1), b3 + hstepB, voffB); PG8_STAGE(PG8_SA(1, 0), a3, voffA);
            PG8_WAIT_V(8); PG8_WAIT_L(0); PG8_BAR; PG8_MMA(1, 0, At, B0); PG8_MMA(1, 1, At, B1); PG8_BAR; PG8_SCHED;
            } else {
            PG8_LDB(B0, 0, 0); PG8_SCHED; PG8_LDA(At, 0, 0); PG8_STAGE(PG8_SA(1, 1), a1 + hstepA, voffA);
            PG8_WAIT_L(8); PG8_BAR; PG8_WAIT_L(0); PG8_MMA(0, 0, At, B0); PG8_BAR; PG8_SCHED;
            PG8_LDB(B1, 0, 1); PG8_STAGE(PG8_SB(0, 0), b2, voffB);
            PG8_BAR; PG8_WAIT_L(0); PG8_MMA(0, 1, At, B1); PG8_BAR;
            PG8_LDA(At, 0, 1); PG8_STAGE(PG8_SA(0, 0), a2, voffA);
            PG8_BAR; PG8_WAIT_L(0); PG8_MMA(1, 0, At, B0); PG8_BAR; PG8_SCHED;
            PG8_STAGE(PG8_SB(0, 1), b2 + hstepB, voffB);
            PG8_WAIT_V(6); PG8_BAR; PG8_MMA(1, 1, At, B1); PG8_BAR;
            PG8_LDB(B0, 1, 0); PG8_SCHED; PG8_LDA(At, 1, 0); PG8_STAGE(PG8_SA(0, 1), a2 + hstepA, voffA);
            PG8_WAIT_L(8); PG8_BAR; PG8_WAIT_L(0); PG8_MMA(0, 0, At, B0); PG8_BAR; PG8_SCHED;
            PG8_LDB(B1, 1, 1); PG8_STAGE(PG8_SB(1, 0), b3, voffB);
            PG8_BAR; PG8_WAIT_L(0); PG8_MMA(0, 1, At, B1); PG8_BAR;
            PG8_LDA(At, 1, 1); PG8_STAGE(PG8_SA(1, 0), a3, voffA);
            PG8_BAR; PG8_WAIT_L(0); PG8_MMA(1, 0, At, B0); PG8_BAR; PG8_SCHED;
            PG8_STAGE(PG8_SB(1, 1), b3 + hstepB, voffB);
            PG8_WAIT_V(6); PG8_BAR; PG8_MMA(1, 1, At, B1); PG8_BAR;
            }
        }
        if constexpr (ALIGN_EPI) { if (wr == 0) PG8_BAR; }
        if constexpr (Epi::HAS_BIAS) asm volatile("" : "+v"(nb[0][0]), "+v"(nb[0][1]), "+v"(nb[1][0]), "+v"(nb[1][1]));
        asm volatile("s_nop 15\n\ts_nop 15" ::: "memory");
        if constexpr (!Epi::AFTER_DRAIN) { E(acc, cur, wr, wc, fr, fq); S.done(cur); }
        if (!has_next) break;
        if (!E.keep(cur)) {
#pragma unroll
        for (int a = 0; a < 2; ++a)
#pragma unroll
            for (int b = 0; b < 2; ++b)
#pragma unroll
                for (int m = 0; m < 4; ++m)
#pragma unroll
                    for (int n = 0; n < 2; ++n) acc[a][b][m][n] = nb[b][n];
        }
        cur = nxt; cA = nA; cB = nB; ++ui;
        if constexpr (ALIGN_EPI) { if (wr == 1) PG8_BAR; }
    }
    PG8_WAIT_V(0);
    if constexpr (!ALIGN_EPI) { if (wr == 0) PG8_BAR; }
    PG8_BAR;
    if constexpr (Epi::AFTER_DRAIN) { E.fused(acc, cur, wr, wc, fr, fq, lds, wid, lane); S.done(cur); }
#undef PG8_SA
#undef PG8_SB
#undef PG8_STAGE
#undef PG8_LDA
#undef PG8_LDB
#undef PG8_MMA
#undef PG8_WAIT_V
#undef PG8_WAIT_X
#undef PG8_WAIT_L
#undef PG8_BAR
#undef PG8_SCHED
}
}

#include <hip/hip_bf16.h>
#include <cmath>
namespace attn_body {
using bf16=__hip_bfloat16;
using bf16x8=__attribute__((ext_vector_type(8)))short;
using s16x4=__attribute__((ext_vector_type(4)))short;
using f32x16=__attribute__((ext_vector_type(16)))float;
using u32x4=__attribute__((ext_vector_type(4)))unsigned;
constexpr int SEQ=8192,D=64; constexpr int QP=512,KP=512,VP=512,OP=1024;
constexpr int NW=8,QBLK=32,QB=QBLK*NW,KVBLK=64,NQB=SEQ/QB;
constexpr int ATTN_UNIT_ROWS=QB;
__device__ __forceinline__ int crow(int r,int hi){return (r&3)+8*(r>>2)+4*hi;}
#define SBAR() __builtin_amdgcn_sched_barrier(0)
__device__ __forceinline__ void cmask(f32x16&p0,f32x16&p1,int jb,int qrel,int hi){
  const float NEG=-INFINITY; (void)hi;
  if(jb>(qrel>>6)){
  #pragma unroll
  for(int r=0;r<16;++r){p0[r]=NEG;p1[r]=NEG;} }
}

constexpr int NSLOT=3, SLOTB=8192;
constexpr int LDS_K=0, LDS_V=NSLOT*SLOTB, LDS_WS=2*NSLOT*SLOTB, LDS_OST=LDS_WS+NW*64*4, LDS_BYTES=LDS_OST+NW*4096;
constexpr float C2=0.125f*1.4426950408889634f;
__device__ __forceinline__ void glds16(const void*gsrc,unsigned lds_dst){unsigned keep;
  asm volatile("s_mov_b32 %0, m0\n\ts_mov_b32 m0, %2\n\ts_nop 0\n\tglobal_load_lds_dwordx4 %1, off\n\ts_mov_b32 m0, %0":"=&s"(keep):"v"(gsrc),"s"(lds_dst):"memory");}
__device__ __forceinline__ float max3f(float a,float b,float c){float r;asm("v_max3_f32 %0, %1, %2, %3":"=v"(r):"v"(a),"v"(b),"v"(c));return r;}
__device__ __forceinline__ float max2f(float a,float b){float r;asm("v_max_f32_e32 %0, %1, %2":"=v"(r):"v"(a),"v"(b));return r;}
__device__ __forceinline__ float fadd_s(float a,float b){float r;asm("v_add_f32_e32 %0, %1, %2":"=v"(r):"v"(a),"v"(b));return r;}
__device__ __forceinline__ float fsub_s(float a,float b){float r;asm("v_sub_f32_e32 %0, %1, %2":"=v"(r):"v"(a),"v"(b));return r;}
typedef float f32x2_t __attribute__((ext_vector_type(2))); typedef __bf16 bf16x2_t __attribute__((ext_vector_type(2)));
__device__ __forceinline__ unsigned cvtpk_s(float lo,float hi){f32x2_t v={lo,hi};bf16x2_t b=__builtin_convertvector(v,bf16x2_t);return __builtin_bit_cast(unsigned,b);}
#define WAIT_BAR(N) asm volatile("s_waitcnt vmcnt(" #N ") lgkmcnt(0)\n\ts_barrier":::"memory")

__device__ __forceinline__ void qkt(f32x16&p0,f32x16&p1,const char*Kslot,const bf16x8*qr,const f32x16&negm,int r32,int hi){
  const char*kb=Kslot+hi*1024+r32*16;
  #pragma unroll
  for(int d0=0;d0<4;++d0){
    const bf16x8 b0=*reinterpret_cast<const bf16x8*>(kb+d0*2048);
    const bf16x8 b1=*reinterpret_cast<const bf16x8*>(kb+d0*2048+512);
    if(d0==0){p0=__builtin_amdgcn_mfma_f32_32x32x16_bf16(b0,qr[0],negm,0,0,0);p1=__builtin_amdgcn_mfma_f32_32x32x16_bf16(b1,qr[0],negm,0,0,0);}
    else{p0=__builtin_amdgcn_mfma_f32_32x32x16_bf16(b0,qr[d0],p0,0,0,0);p1=__builtin_amdgcn_mfma_f32_32x32x16_bf16(b1,qr[d0],p1,0,0,0);}}
}
typedef __attribute__((address_space(3))) const char* lds_cptr;
typedef short v4i16_t __attribute__((ext_vector_type(4)));
__device__ __forceinline__ void kload8(bf16x8*kf,lds_cptr kp){
  kf[0]=*(const __attribute__((address_space(3))) bf16x8*)(kp);      kf[1]=*(const __attribute__((address_space(3))) bf16x8*)(kp+512);
  kf[2]=*(const __attribute__((address_space(3))) bf16x8*)(kp+2048); kf[3]=*(const __attribute__((address_space(3))) bf16x8*)(kp+2560);
  kf[4]=*(const __attribute__((address_space(3))) bf16x8*)(kp+4096); kf[5]=*(const __attribute__((address_space(3))) bf16x8*)(kp+4608);
  kf[6]=*(const __attribute__((address_space(3))) bf16x8*)(kp+6144); kf[7]=*(const __attribute__((address_space(3))) bf16x8*)(kp+6656);
}
__device__ __forceinline__ void kload2(bf16x8*kf,lds_cptr kp,int j){ kf[2*j]=*(const __attribute__((address_space(3))) bf16x8*)(kp+j*2048); kf[2*j+1]=*(const __attribute__((address_space(3))) bf16x8*)(kp+j*2048+512); }
__device__ __forceinline__ s16x4 vtr(lds_cptr p){ return __builtin_bit_cast(s16x4,__builtin_amdgcn_ds_read_tr16_b64_v4i16((__attribute__((address_space(3))) v4i16_t*)p)); }
__device__ __forceinline__ float rowmax(const f32x16&p0,const f32x16&p1){
  float a=max3f(p0[0],p0[1],p1[0]),b=max3f(p0[2],p0[3],p1[1]);a=max3f(a,p1[2],p1[3]);
  #pragma unroll
  for(int r=4;r<16;r+=4){a=max3f(a,p0[r],p0[r+1]);b=max3f(b,p0[r+2],p0[r+3]);a=max3f(a,p1[r],p1[r+1]);b=max3f(b,p1[r+2],p1[r+3]);}
  const float m=max2f(a,b);
  auto rr=__builtin_amdgcn_permlane32_swap(__float_as_uint(m),__float_as_uint(m),false,false);
  return max2f(__uint_as_float(rr[0]),__uint_as_float(rr[1]));
}
__device__ __forceinline__ void pv(f32x16*o,int vb,bf16x8 pa0,bf16x8 pa1,bf16x8 pa2,bf16x8 pa3){
  #pragma unroll
  for(int d0=0;d0<2;++d0){s16x4 lo[4],hi[4];
    #pragma unroll
    for(int ks=0;ks<4;++ks){
      asm volatile("ds_read_b64_tr_b16 %0,%1 offset:%c2":"=&v"(lo[ks]):"v"(vb),"i"(d0*4096+ks*1024):"memory");
      asm volatile("ds_read_b64_tr_b16 %0,%1 offset:%c2":"=&v"(hi[ks]):"v"(vb),"i"(d0*4096+ks*1024+512):"memory");}
    asm volatile("s_waitcnt lgkmcnt(0)":::"memory");SBAR();
    #define PK(k) (bf16x8){lo[k][0],lo[k][1],lo[k][2],lo[k][3],hi[k][0],hi[k][1],hi[k][2],hi[k][3]}
    o[d0]=__builtin_amdgcn_mfma_f32_32x32x16_bf16(pa0,PK(0),o[d0],0,0,0);
    o[d0]=__builtin_amdgcn_mfma_f32_32x32x16_bf16(pa1,PK(1),o[d0],0,0,0);
    o[d0]=__builtin_amdgcn_mfma_f32_32x32x16_bf16(pa2,PK(2),o[d0],0,0,0);
    o[d0]=__builtin_amdgcn_mfma_f32_32x32x16_bf16(pa3,PK(3),o[d0],0,0,0);
    #undef PK
  }
}

#ifndef ATTN_STORE16
#define ATTN_STORE16(p,v) (*(u32x4*)(p)=(v))
#endif
template<int THRL> __device__ __forceinline__ void attn_unit(int qb,const bf16*Q,const bf16*__restrict__ K,const bf16*__restrict__ V,bf16*O,char*shm){
  int tid_=threadIdx.x; asm volatile("":"+v"(tid_)); const int tid=tid_,lane=tid&63,r32=lane&31,hi=lane>>5; const int wid=__builtin_amdgcn_readfirstlane(tid>>6);
  const int q0=qb*QB;
  const bf16*Qw=Q+(long)(q0+wid*QBLK)*QP;
  const bf16*Kh=K,*Vh=V;
  const unsigned lds0=(unsigned)(uintptr_t)shm;
  float*wsf=(float*)(shm+LDS_WS)+wid*64;
  const bf16*ksrc=Kh+(long)lane*KP+wid*8;
  const bf16*vsrc=Vh+(long)(16*(wid&3)+(lane>>2))*VP+(wid>>2)*32+(lane&3)*8;
  const unsigned kdst=lds0+LDS_K+wid*1024, vdst=lds0+LDS_V+wid*1024;
  #define DMA_K(t,slot) glds16(ksrc+(long)(t)*KVBLK*KP,(unsigned)__builtin_amdgcn_readfirstlane(kdst+(slot)))
  #define DMA_V(t,slot) glds16(vsrc+(long)(t)*KVBLK*VP,(unsigned)__builtin_amdgcn_readfirstlane(vdst+(slot)))
  const int vb0=(int)(lds0+LDS_V)+((lane>>4)&1)*32+(lane&3)*8+(4*hi+((lane&15)>>2))*64;
  const char*Kbase=shm+LDS_K; bf16x8 kf[8];
  const lds_cptr shm3=(lds_cptr)shm; const lds_cptr kp0=shm3+LDS_K+hi*1024+r32*16; const lds_cptr vp0=shm3+LDS_V+((lane>>4)&1)*32+(lane&3)*8+(4*hi+((lane&15)>>2))*64;
  const int NT=(q0+QB)/KVBLK;
  DMA_K(0,0);DMA_V(0,0);DMA_K(1,SLOTB);
  bf16x8 qr[4];
  #pragma unroll
  for(int d0=0;d0<4;++d0)qr[d0]=*reinterpret_cast<const bf16x8*>(&Qw[(long)r32*QP+d0*16+hi*8]);
  float mhat=0.f,l_reg=0.f;f32x16 o[2];o[0]=f32x16{};o[1]=f32x16{};f32x16 negm=f32x16{};asm volatile("":"+v"(negm));
  const int qrel=wid*QBLK+r32;
  #define CMASK(P0,P1,t) do{int jb_=(t)-(NT-4); if(jb_>=0)cmask(P0,P1,jb_,qrel,hi);}while(0)
  bool resc=false;
  #define START(P0,P1) do{ const float rm=rowmax(P0,P1); resc=false; \
    { const float dl=rm; mhat=fadd_s(mhat,dl); \
      _Pragma("unroll") for(int r=0;r<16;++r){P0[r]=fsub_s(P0[r],dl);P1[r]=fsub_s(P1[r],dl);} \
      _Pragma("unroll") for(int r=0;r<16;++r)negm[r]=-mhat; asm volatile("":"+v"(negm)); } \
    _Pragma("unroll") for(int r=0;r<16;++r)P0[r]=__builtin_amdgcn_exp2f(P0[r]); }while(0)
  #define RESC() do{ if(resc){ asm volatile("s_waitcnt lgkmcnt(0)":::"memory"); \
      _Pragma("unroll") for(int d_=0;d_<2;++d_) _Pragma("unroll") for(int r=0;r<16;++r)o[d_][r]*=wsf[crow(r,hi)]; } }while(0)
  f32x16 pA0,pA1,pB0,pB1;
  int sl_prev=0,sl_cur=0,sl_next=SLOTB;
  #define ROT() do{sl_prev=sl_cur;sl_cur=sl_next;sl_next=(sl_next==(NSLOT-1)*SLOTB)?0:sl_next+SLOTB;}while(0)
  DMA_K(2,2*SLOTB);
  WAIT_BAR(3);
  qkt(pA0,pA1,Kbase,qr,negm,r32,hi);asm volatile("s_nop 15\n\ts_nop 7":"+v"(pA0),"+v"(pA1));CMASK(pA0,pA1,0);
  START(pA0,pA1);
  _Pragma("unroll") for(int r=0;r<16;++r)pA1[r]=__builtin_amdgcn_exp2f(pA1[r]);
  WAIT_BAR(0);
  DMA_K(3,0);DMA_V(1,SLOTB);
  ROT();
  kload8(kf,kp0+sl_cur);
  WAIT_BAR(2);
  s16x4 vlo[8],vhi[8]; u32x4 pw0,pw1,pw2,pw3;
  #define PKW(P,B) cvtpk_s(P[B],P[B+1])
  #define PAF(k) __builtin_bit_cast(bf16x8,pw##k)
  #define VFR(i) (bf16x8){vlo[i][0],vlo[i][1],vlo[i][2],vlo[i][3],vhi[i][0],vhi[i][1],vhi[i][2],vhi[i][3]}
  #define PIN(x) asm volatile("":"+v"(x))
  #define MX3(a,b,c) __builtin_fmaxf(__builtin_fmaxf((a),(b)),(c))
  #define GAPA(MF,A0,A1,A2,A3,W0,W1,PW) do{ MF; sacc+=A0; sacc+=A1; sacc+=A2; sacc+=A3; PIN(sacc); W0; W1; PIN(PW); SBAR(); }while(0)
  #define EX(v) __builtin_amdgcn_exp2f(v)
  #define GAPB(MF,X,B) do{ MF; X[B]=EX(X[B]); X[B+1]=EX(X[B+1]); X[B+2]=EX(X[B+2]); X[B+3]=EX(X[B+3]); PIN(X); SBAR(); }while(0)
  #define VRD(i) do{ vlo[i]=vtr(vp_+(((i)>>2)*4096+((i)&3)*1024)); vhi[i]=vtr(vp_+(((i)>>2)*4096+((i)&3)*1024+512)); }while(0)
  #define KRD(G,j) do{ if(G){ kload2(kf,kp0+sl_next,j); SBAR(); } }while(0)
  #define STEP(C0,C1,P0,P1,t,GK,GV,GL) do{ SBAR(); \
    const lds_cptr vp_=vp0+sl_prev; \
    VRD(0); SBAR(); float sacc=(P0[0]+P0[1]); \
    GAPA(C0=__builtin_amdgcn_mfma_f32_32x32x16_bf16(kf[0],qr[0],negm,0,0,0), P0[2],P0[3],P0[4],P0[5],     pw0[0]=PKW(P0,0), pw0[1]=PKW(P0,2), pw0); \
    VRD(4); SBAR(); GAPA(C1=__builtin_amdgcn_mfma_f32_32x32x16_bf16(kf[1],qr[0],negm,0,0,0), P0[6],P0[7],P0[8],P0[9],     pw0[2]=PKW(P0,4), pw0[3]=PKW(P0,6), pw0); \
    VRD(1); SBAR(); GAPA(C0=__builtin_amdgcn_mfma_f32_32x32x16_bf16(kf[2],qr[1],C0,0,0,0),   P0[10],P0[11],P0[12],P0[13], pw1[0]=PKW(P0,8), pw1[1]=PKW(P0,10), pw1); \
    VRD(5); SBAR(); GAPA(C1=__builtin_amdgcn_mfma_f32_32x32x16_bf16(kf[3],qr[1],C1,0,0,0),   P0[14],P0[15],P1[0],P1[1],   pw1[2]=PKW(P0,12),pw1[3]=PKW(P0,14), pw1); \
    VRD(2); SBAR(); GAPA(C0=__builtin_amdgcn_mfma_f32_32x32x16_bf16(kf[4],qr[2],C0,0,0,0),   P1[2],P1[3],P1[4],P1[5],     pw2[0]=PKW(P1,0), pw2[1]=PKW(P1,2), pw2); \
    VRD(6); SBAR(); GAPA(C1=__builtin_amdgcn_mfma_f32_32x32x16_bf16(kf[5],qr[2],C1,0,0,0),   P1[6],P1[7],P1[8],P1[9],     pw2[2]=PKW(P1,4), pw2[3]=PKW(P1,6), pw2); \
    VRD(3); SBAR(); GAPA(C0=__builtin_amdgcn_mfma_f32_32x32x16_bf16(kf[6],qr[3],C0,0,0,0),   P1[10],P1[11],P1[12],P1[13], pw3[0]=PKW(P1,8), pw3[1]=PKW(P1,10), pw3); \
    VRD(7); SBAR(); GAPA(C1=__builtin_amdgcn_mfma_f32_32x32x16_bf16(kf[7],qr[3],C1,0,0,0),   P1[14],P1[15],0.f,0.f,       pw3[2]=PKW(P1,12),pw3[3]=PKW(P1,14), pw3); \
    l_reg+=sacc; \
    if(GK){DMA_K((t)+3,sl_cur);} if(GV){DMA_V((t)+1,sl_next);} \
    CMASK(C0,C1,t); \
    { float a=MX3(C0[0],C0[1],C1[0]),b=MX3(C0[2],C0[3],C1[1]); a=MX3(a,C1[2],C1[3]); \
      _Pragma("unroll") for(int r=4;r<16;r+=4){a=MX3(a,C0[r],C0[r+1]);b=MX3(b,C0[r+2],C0[r+3]);a=MX3(a,C1[r],C1[r+1]);b=MX3(b,C1[r+2],C1[r+3]);} \
      float rm=__builtin_fmaxf(a,b); { auto rr=__builtin_amdgcn_permlane32_swap(__float_as_uint(rm),__float_as_uint(rm),false,false); rm=__builtin_fmaxf(__uint_as_float(rr[0]),__uint_as_float(rr[1])); } \
      resc=false; \
      if(__builtin_expect(__any(rm>(float)THRL),0)){ const float dl=__builtin_fmaxf(rm,0.f); mhat+=dl; \
        _Pragma("unroll") for(int r=0;r<16;++r){C0[r]-=dl;C1[r]-=dl;} \
        _Pragma("unroll") for(int r=0;r<16;++r)negm[r]=-mhat; asm volatile("":"+v"(negm)); \
        const float f=__builtin_amdgcn_exp2f(-dl); l_reg*=f; if(hi==0)wsf[r32]=f; resc=true; } } \
    SBAR(); \
    GAPB(o[0]=__builtin_amdgcn_mfma_f32_32x32x16_bf16(PAF(0),VFR(0),o[0],0,0,0), C0,0); \
    GAPB(o[1]=__builtin_amdgcn_mfma_f32_32x32x16_bf16(PAF(0),VFR(4),o[1],0,0,0), C0,4); \
    KRD(GL,0); GAPB(o[0]=__builtin_amdgcn_mfma_f32_32x32x16_bf16(PAF(1),VFR(1),o[0],0,0,0), C0,8); \
    KRD(GL,1); GAPB(o[1]=__builtin_amdgcn_mfma_f32_32x32x16_bf16(PAF(1),VFR(5),o[1],0,0,0), C0,12); \
    KRD(GL,2); GAPB(o[0]=__builtin_amdgcn_mfma_f32_32x32x16_bf16(PAF(2),VFR(2),o[0],0,0,0), C1,0); \
    KRD(GL,3); GAPB(o[1]=__builtin_amdgcn_mfma_f32_32x32x16_bf16(PAF(2),VFR(6),o[1],0,0,0), C1,4); \
    GAPB(o[0]=__builtin_amdgcn_mfma_f32_32x32x16_bf16(PAF(3),VFR(3),o[0],0,0,0), C1,8); \
    GAPB(o[1]=__builtin_amdgcn_mfma_f32_32x32x16_bf16(PAF(3),VFR(7),o[1],0,0,0), C1,12); \
    }while(0)
  int t=1;
  #undef CMASK
  #define CMASK(P0,P1,t) do{}while(0)
  for(;t+5<NT;t+=2){
    STEP(pB0,pB1,pA0,pA1,t,true,true,true);     WAIT_BAR(2); RESC(); ROT();
    STEP(pA0,pA1,pB0,pB1,t+1,true,true,true);   WAIT_BAR(2); RESC(); ROT();
  }
  #undef CMASK
  #define CMASK(P0,P1,t) do{int jb_=(t)-(NT-4); if(jb_>=0)cmask(P0,P1,jb_,qrel,hi);}while(0)
  #define ENDW(tt) do{ if((tt)+3<NT){WAIT_BAR(2);} else if((tt)+2<NT){WAIT_BAR(1);} else {WAIT_BAR(0);} }while(0)
  for(;t+1<NT;t+=2){
    STEP(pB0,pB1,pA0,pA1,t,(t+3<NT),(t+1<NT),(t+1<NT));       ENDW(t);   RESC(); ROT();
    STEP(pA0,pA1,pB0,pB1,t+1,(t+4<NT),(t+2<NT),(t+2<NT));     ENDW(t+1); RESC(); ROT();
  }
  STEP(pB0,pB1,pA0,pA1,NT-1,false,false,false); RESC();
  { float sacc=pB0[0]+pB0[1]; _Pragma("unroll") for(int r=2;r<16;++r)sacc+=pB0[r]; _Pragma("unroll") for(int r=0;r<16;++r)sacc+=pB1[r]; l_reg+=sacc;
    pw0=(u32x4){PKW(pB0,0),PKW(pB0,2),PKW(pB0,4),PKW(pB0,6)};pw1=(u32x4){PKW(pB0,8),PKW(pB0,10),PKW(pB0,12),PKW(pB0,14)};pw2=(u32x4){PKW(pB1,0),PKW(pB1,2),PKW(pB1,4),PKW(pB1,6)};pw3=(u32x4){PKW(pB1,8),PKW(pB1,10),PKW(pB1,12),PKW(pB1,14)};
    SBAR(); pv(o,vb0+sl_cur,PAF(0),PAF(1),PAF(2),PAF(3)); }
  #undef PKW
  #undef PAF
  #undef VFR
  #undef PIN
  #undef MX3
  #undef GAPA
  #undef GAPB
  #undef EX
  #undef VRD
  #undef KRD
  #undef STEP
  #undef ENDW
  {auto rr=__builtin_amdgcn_permlane32_swap(__float_as_uint(l_reg),__float_as_uint(l_reg),false,false);l_reg=__uint_as_float(rr[0])+__uint_as_float(rr[1]);}
  if(hi==0)wsf[32+r32]=l_reg;asm volatile("s_waitcnt lgkmcnt(0)":::"memory");
  float rli[16];
  #pragma unroll
  for(int r=0;r<16;++r)rli[r]=__builtin_amdgcn_rcpf(wsf[32+crow(r,hi)]);
  bf16*Ow=O+(long)(q0+wid*QBLK)*OP;
  { bf16*stg=(bf16*)(shm+LDS_OST)+wid*2048;
    #pragma unroll
    for(int r=0;r<16;++r){const int orow=crow(r,hi);
      #pragma unroll
      for(int d0=0;d0<2;++d0)stg[orow*64+d0*32+r32]=__float2bfloat16(o[d0][r]*rli[r]);}
    asm volatile("s_waitcnt lgkmcnt(0)":::"memory");
    #pragma unroll
    for(int i=0;i<4;++i){const int row=i*8+(lane>>3),ch=lane&7; const u32x4 v=*(const u32x4*)(stg+row*64+ch*8); ATTN_STORE16(Ow+(long)row*OP+ch*8,v);} }
  asm volatile("s_waitcnt lgkmcnt(0)\n\ts_barrier":::"memory");
  #undef DMA_K
  #undef DMA_V
  #undef CMASK
  #undef START
  #undef RESC
  #undef ROT
}

constexpr int SLOTV=16384, L2_K=0, L2_V=NSLOT*SLOTB, L2_WS=L2_V+NSLOT*SLOTV, L2_BYTES=L2_WS+NW*64*4;
__device__ __forceinline__ void qkt0(f32x16&p0,f32x16&p1,const char*Kslot,const bf16x8*qr,int r32,int hi){
  const char*kb=Kslot+hi*1024+r32*16; const f32x16 z=f32x16{};
  #pragma unroll
  for(int d0=0;d0<4;++d0){
    const bf16x8 b0=*reinterpret_cast<const bf16x8*>(kb+d0*2048);
    const bf16x8 b1=*reinterpret_cast<const bf16x8*>(kb+d0*2048+512);
    if(d0==0){p0=__builtin_amdgcn_mfma_f32_32x32x16_bf16(b0,qr[0],z,0,0,0);p1=__builtin_amdgcn_mfma_f32_32x32x16_bf16(b1,qr[0],z,0,0,0);}
    else{p0=__builtin_amdgcn_mfma_f32_32x32x16_bf16(b0,qr[d0],p0,0,0,0);p1=__builtin_amdgcn_mfma_f32_32x32x16_bf16(b1,qr[d0],p1,0,0,0);}}
}
__device__ __forceinline__ void pv128(f32x16*o,int vb,bf16x8 pa0,bf16x8 pa1,bf16x8 pa2,bf16x8 pa3){
  #pragma unroll
  for(int d0=0;d0<4;++d0){s16x4 lo[4],hi[4];
    #pragma unroll
    for(int ks=0;ks<4;++ks){
      asm volatile("ds_read_b64_tr_b16 %0,%1 offset:%c2":"=&v"(lo[ks]):"v"(vb),"i"(d0*4096+ks*1024):"memory");
      asm volatile("ds_read_b64_tr_b16 %0,%1 offset:%c2":"=&v"(hi[ks]):"v"(vb),"i"(d0*4096+ks*1024+512):"memory");}
    asm volatile("s_waitcnt lgkmcnt(0)":::"memory");SBAR();
    #define PK(k) (bf16x8){lo[k][0],lo[k][1],lo[k][2],lo[k][3],hi[k][0],hi[k][1],hi[k][2],hi[k][3]}
    o[d0]=__builtin_amdgcn_mfma_f32_32x32x16_bf16(pa0,PK(0),o[d0],0,0,0);
    o[d0]=__builtin_amdgcn_mfma_f32_32x32x16_bf16(pa1,PK(1),o[d0],0,0,0);
    o[d0]=__builtin_amdgcn_mfma_f32_32x32x16_bf16(pa2,PK(2),o[d0],0,0,0);
    o[d0]=__builtin_amdgcn_mfma_f32_32x32x16_bf16(pa3,PK(3),o[d0],0,0,0);
    #undef PK
  }
}
template<int THRL> __device__ __forceinline__ void attn_unit128(int qb,const bf16*Q,const bf16*__restrict__ K,const bf16*__restrict__ V,bf16*O,char*shm){
  int tid_=threadIdx.x; asm volatile("":"+v"(tid_)); const int tid=tid_,lane=tid&63,r32=lane&31,hi=lane>>5; const int wid=__builtin_amdgcn_readfirstlane(tid>>6);
  const int q0=qb*QB;
  const bf16*Qw=Q+(long)(q0+wid*QBLK)*QP;
  const unsigned lds0=(unsigned)(uintptr_t)shm;
  float*wsf=(float*)(shm+L2_WS)+wid*64;
  const bf16*ksrc=K+(long)lane*KP+wid*8;
  const bf16*vsrc=V+(long)(16*(wid&3)+(lane>>2))*VP+(wid>>2)*32+(lane&3)*8;
  const unsigned kdst=lds0+L2_K+wid*1024, vdst=lds0+L2_V+wid*1024;
  #define DMA_K(t,slot) glds16(ksrc+(long)(t)*KVBLK*KP,(unsigned)__builtin_amdgcn_readfirstlane(kdst+(slot)))
  #define DMA_V(t,slot) do{ glds16(vsrc+(long)(t)*KVBLK*VP,(unsigned)__builtin_amdgcn_readfirstlane(vdst+2*(slot))); glds16(vsrc+64+(long)(t)*KVBLK*VP,(unsigned)__builtin_amdgcn_readfirstlane(vdst+2*(slot)+8192)); }while(0)
  const int vb0=(int)(lds0+L2_V)+((lane>>4)&1)*32+(lane&3)*8+(4*hi+((lane&15)>>2))*64;
  const char*Kbase=shm+L2_K; bf16x8 kf[8];
  const lds_cptr shm3=(lds_cptr)shm; const lds_cptr kp0=shm3+L2_K+hi*1024+r32*16; const lds_cptr vp0=shm3+L2_V+((lane>>4)&1)*32+(lane&3)*8+(4*hi+((lane&15)>>2))*64;
  const int NT=(q0+QB)/KVBLK;
  DMA_K(0,0);DMA_V(0,0);DMA_K(1,SLOTB);
  bf16x8 qr[4];
  #pragma unroll
  for(int d0=0;d0<4;++d0)qr[d0]=*reinterpret_cast<const bf16x8*>(&Qw[(long)r32*QP+d0*16+hi*8]);
  float l_reg=0.f;f32x16 o[4];
  ;o[0]=f32x16{};o[1]=f32x16{};o[2]=f32x16{};o[3]=f32x16{};
  const int qrel=wid*QBLK+r32;
  #define CMASK(P0,P1,t) do{int jb_=(t)-(NT-4); if(jb_>=0)cmask(P0,P1,jb_,qrel,hi);}while(0)
  #define RESC() do{}while(0)
  f32x16 pA0,pA1,pB0,pB1;
  int sl_prev=0,sl_cur=0,sl_next=SLOTB;
  #define ROT() do{sl_prev=sl_cur;sl_cur=sl_next;sl_next=(sl_next==(NSLOT-1)*SLOTB)?0:sl_next+SLOTB;}while(0)
  DMA_K(2,2*SLOTB);
  WAIT_BAR(4);
  qkt0(pA0,pA1,Kbase,qr,r32,hi);asm volatile("s_nop 15\n\ts_nop 7":"+v"(pA0),"+v"(pA1));CMASK(pA0,pA1,0);
  { _Pragma("unroll") for(int r=0;r<16;++r){pA0[r]=__builtin_amdgcn_exp2f(pA0[r]);pA1[r]=__builtin_amdgcn_exp2f(pA1[r]);} }
  WAIT_BAR(0);
  DMA_K(3,0);DMA_V(1,SLOTB);
  ROT();
  kload8(kf,kp0+sl_cur);
  WAIT_BAR(3);
  s16x4 vlo[8],vhi[8],vlo2[8],vhi2[8]; u32x4 pw0,pw1,pw2,pw3;
  #define PKW(P,B) cvtpk_s(P[B],P[B+1])
  #define PAF(k) __builtin_bit_cast(bf16x8,pw##k)
  #define VFR(i) (bf16x8){vlo[i][0],vlo[i][1],vlo[i][2],vlo[i][3],vhi[i][0],vhi[i][1],vhi[i][2],vhi[i][3]}
  #define VFR2(i) (bf16x8){vlo2[i][0],vlo2[i][1],vlo2[i][2],vlo2[i][3],vhi2[i][0],vhi2[i][1],vhi2[i][2],vhi2[i][3]}
  #define PIN(x) asm volatile("":"+v"(x))
  #define MX3(a,b,c) __builtin_fmaxf(__builtin_fmaxf((a),(b)),(c))
  #define GAPA(MF,A0,A1,A2,A3,W0,W1,PW) do{ MF; sacc+=A0; sacc+=A1; sacc+=A2; sacc+=A3; PIN(sacc); W0; W1; PIN(PW); SBAR(); }while(0)
  #define EX(v) __builtin_amdgcn_exp2f(v)
  #define GAPB(MF,X,B) do{ MF; X[B]=EX(X[B]); X[B+1]=EX(X[B+1]); PIN(X); SBAR(); }while(0)
  #define VRD(i) do{ vlo[i]=vtr(vp_+(((i)>>2)*4096+((i)&3)*1024)); vhi[i]=vtr(vp_+(((i)>>2)*4096+((i)&3)*1024+512)); }while(0)
  #define VRD2(i) do{ vlo2[i]=vtr(vp_+(8192+((i)>>2)*4096+((i)&3)*1024)); vhi2[i]=vtr(vp_+(8192+((i)>>2)*4096+((i)&3)*1024+512)); SBAR(); }while(0)
  #define KRD(G,j) do{ if(G){ kload2(kf,kp0+sl_next,j); SBAR(); } }while(0)
  #define MF32(a,b,c) __builtin_amdgcn_mfma_f32_32x32x16_bf16(a,b,c,0,0,0)
  #define STEP(C0,C1,P0,P1,t,GK,GV,GL) do{ SBAR(); \
    const lds_cptr vp_=vp0+2*sl_prev; const f32x16 z16_=f32x16{}; \
    VRD(0); SBAR(); float sacc=(P0[0]+P0[1]); \
    GAPA(C0=MF32(kf[0],qr[0],z16_), P0[2],P0[3],P0[4],P0[5],     pw0[0]=PKW(P0,0), pw0[1]=PKW(P0,2), pw0); \
    VRD(4); SBAR(); GAPA(C1=MF32(kf[1],qr[0],z16_), P0[6],P0[7],P0[8],P0[9],     pw0[2]=PKW(P0,4), pw0[3]=PKW(P0,6), pw0); \
    VRD(1); SBAR(); GAPA(C0=MF32(kf[2],qr[1],C0),   P0[10],P0[11],P0[12],P0[13], pw1[0]=PKW(P0,8), pw1[1]=PKW(P0,10), pw1); \
    VRD(5); SBAR(); GAPA(C1=MF32(kf[3],qr[1],C1),   P0[14],P0[15],P1[0],P1[1],   pw1[2]=PKW(P0,12),pw1[3]=PKW(P0,14), pw1); \
    VRD(2); SBAR(); GAPA(C0=MF32(kf[4],qr[2],C0),   P1[2],P1[3],P1[4],P1[5],     pw2[0]=PKW(P1,0), pw2[1]=PKW(P1,2), pw2); \
    VRD(6); SBAR(); GAPA(C1=MF32(kf[5],qr[2],C1),   P1[6],P1[7],P1[8],P1[9],     pw2[2]=PKW(P1,4), pw2[3]=PKW(P1,6), pw2); \
    VRD(3); SBAR(); GAPA(C0=MF32(kf[6],qr[3],C0),   P1[10],P1[11],P1[12],P1[13], pw3[0]=PKW(P1,8), pw3[1]=PKW(P1,10), pw3); \
    VRD(7); SBAR(); GAPA(C1=MF32(kf[7],qr[3],C1),   P1[14],P1[15],0.f,0.f,       pw3[2]=PKW(P1,12),pw3[3]=PKW(P1,14), pw3); \
    l_reg+=sacc; \
    if(GK){DMA_K((t)+3,sl_cur);} if(GV){DMA_V((t)+1,sl_next);} \
    CMASK(C0,C1,t); \
    SBAR(); \
    VRD2(0); GAPB(o[0]=MF32(PAF(0),VFR(0),o[0]), C0,0); \
    VRD2(4); GAPB(o[1]=MF32(PAF(0),VFR(4),o[1]), C0,2); \
    VRD2(1); GAPB(o[0]=MF32(PAF(1),VFR(1),o[0]), C0,4); \
    VRD2(5); GAPB(o[1]=MF32(PAF(1),VFR(5),o[1]), C0,6); \
    VRD2(2); GAPB(o[0]=MF32(PAF(2),VFR(2),o[0]), C0,8); \
    VRD2(6); GAPB(o[1]=MF32(PAF(2),VFR(6),o[1]), C0,10); \
    VRD2(3); GAPB(o[0]=MF32(PAF(3),VFR(3),o[0]), C0,12); \
    VRD2(7); GAPB(o[1]=MF32(PAF(3),VFR(7),o[1]), C0,14); \
    GAPB(o[2]=MF32(PAF(0),VFR2(0),o[2]), C1,0); \
    GAPB(o[3]=MF32(PAF(0),VFR2(4),o[3]), C1,2); \
    KRD(GL,0); GAPB(o[2]=MF32(PAF(1),VFR2(1),o[2]), C1,4); \
    KRD(GL,1); GAPB(o[3]=MF32(PAF(1),VFR2(5),o[3]), C1,6); \
    KRD(GL,2); GAPB(o[2]=MF32(PAF(2),VFR2(2),o[2]), C1,8); \
    KRD(GL,3); GAPB(o[3]=MF32(PAF(2),VFR2(6),o[3]), C1,10); \
    GAPB(o[2]=MF32(PAF(3),VFR2(3),o[2]), C1,12); \
    GAPB(o[3]=MF32(PAF(3),VFR2(7),o[3]), C1,14); \
    }while(0)
  int t=1;
  #undef CMASK
  #define CMASK(P0,P1,t) do{}while(0)
  for(;t+5<NT;t+=2){
    STEP(pB0,pB1,pA0,pA1,t,true,true,true);     WAIT_BAR(3); RESC(); ROT();
    STEP(pA0,pA1,pB0,pB1,t+1,true,true,true);   WAIT_BAR(3); RESC(); ROT();
  }
  #undef CMASK
  #define CMASK(P0,P1,t) do{int jb_=(t)-(NT-4); if(jb_>=0)cmask(P0,P1,jb_,qrel,hi);}while(0)
  #define ENDW(tt) do{ if((tt)+3<NT){WAIT_BAR(3);} else if((tt)+2<NT){WAIT_BAR(2);} else {WAIT_BAR(0);} }while(0)
  for(;t+1<NT;t+=2){
    STEP(pB0,pB1,pA0,pA1,t,(t+3<NT),(t+1<NT),(t+1<NT));       ENDW(t);   RESC(); ROT();
    STEP(pA0,pA1,pB0,pB1,t+1,(t+4<NT),(t+2<NT),(t+2<NT));     ENDW(t+1); RESC(); ROT();
  }
  STEP(pB0,pB1,pA0,pA1,NT-1,false,false,false); RESC();
  { float sacc=pB0[0]+pB0[1]; _Pragma("unroll") for(int r=2;r<16;++r)sacc+=pB0[r]; _Pragma("unroll") for(int r=0;r<16;++r)sacc+=pB1[r]; l_reg+=sacc;
    pw0=(u32x4){PKW(pB0,0),PKW(pB0,2),PKW(pB0,4),PKW(pB0,6)};pw1=(u32x4){PKW(pB0,8),PKW(pB0,10),PKW(pB0,12),PKW(pB0,14)};pw2=(u32x4){PKW(pB1,0),PKW(pB1,2),PKW(pB1,4),PKW(pB1,6)};pw3=(u32x4){PKW(pB1,8),PKW(pB1,10),PKW(pB1,12),PKW(pB1,14)};
    SBAR(); pv128(o,vb0+2*sl_cur,PAF(0),PAF(1),PAF(2),PAF(3)); }
  #undef PKW
  #undef PAF
  #undef VFR
  #undef VFR2
  #undef PIN
  #undef MX3
  #undef GAPA
  #undef GAPB
  #undef EX
  #undef VRD
  #undef VRD2
  #undef KRD
  #undef MF32
  #undef STEP
  #undef ENDW
  {auto rr=__builtin_amdgcn_permlane32_swap(__float_as_uint(l_reg),__float_as_uint(l_reg),false,false);l_reg=__uint_as_float(rr[0])+__uint_as_float(rr[1]);}
  if(hi==0)wsf[32+r32]=l_reg;asm volatile("s_waitcnt lgkmcnt(0)":::"memory");
  float rli[16];
  #pragma unroll
  for(int r=0;r<16;++r)rli[r]=__builtin_amdgcn_rcpf(wsf[32+crow(r,hi)]);
  asm volatile("s_waitcnt lgkmcnt(0)\n\ts_barrier":::"memory");
  bf16*Ow=O+(long)(q0+wid*QBLK)*OP;
  { bf16*stg=(bf16*)(shm)+wid*4096;
    #pragma unroll
    for(int r=0;r<16;++r){const int orow=crow(r,hi);
      #pragma unroll
      for(int d0=0;d0<4;++d0)stg[orow*128+d0*32+r32]=__float2bfloat16(o[d0][r]*rli[r]);}
    asm volatile("s_waitcnt lgkmcnt(0)":::"memory");
    #pragma unroll
    for(int i=0;i<8;++i){const int row=i*4+(lane>>4),ch=lane&15; const u32x4 v=*(const u32x4*)(stg+row*128+ch*8); ATTN_STORE16(Ow+(long)row*OP+ch*8,v);} }
  asm volatile("s_waitcnt lgkmcnt(0)\n\ts_barrier":::"memory");
  #undef DMA_K
  #undef DMA_V
  #undef CMASK
  #undef RESC
  #undef ROT
}
constexpr int ATTN_LDS_BYTES=LDS_BYTES;
#undef SBAR
#undef WAIT_BAR
}
#ifndef REPEAT_PHASE
#define REPEAT_PHASE -1
#endif
constexpr int NWAVES = 8;
using cfg::T; using cfg::SEQ; using cfg::D; using cfg::NIN; using cfg::NE; using cfg::EPS; using cfg::MAXROWS;

constexpr size_t MiB = 1u << 20;
constexpr size_t WS_CTL = 0, CTL_ZERO_BYTES = 1 * MiB;
constexpr size_t WS_RCOS = 1 * MiB, WS_RSIN = 2 * MiB;
constexpr size_t WS_TKE = 3 * MiB, WS_TKP = WS_TKE + 256 * 1024, WS_TKG = WS_TKP + 256 * 1024, WS_TSLOT = WS_TKG + 256 * 1024;
constexpr size_t WS_RGATE = 4 * MiB;
constexpr size_t WS_BLKBASE = 4 * MiB + 512 * 1024;
constexpr size_t WS_SSQ = 5 * MiB;
constexpr size_t WS_WIN = 8 * MiB;
constexpr size_t WS_WBR = 23 * MiB;
constexpr size_t WS_WOUT = 26 * MiB;
constexpr size_t WS_WGU = 28 * MiB;
constexpr size_t WS_WDN = 156 * MiB;
constexpr size_t WS_HN = 220 * MiB;
constexpr size_t WS_KVM = 254 * MiB;
constexpr size_t WS_Q = 256 * MiB, WS_K = 272 * MiB, WS_V = 288 * MiB, WS_U = 304 * MiB, WS_CB = 320 * MiB, WS_MQ = 336 * MiB;
constexpr size_t WS_GATES = 352 * MiB;
constexpr size_t WS_OMAPS = 448 * MiB;
constexpr size_t WS_YALL = 480 * MiB;
constexpr size_t WS_MERGED = 528 * MiB;
constexpr size_t WS_H2 = 560 * MiB;
constexpr size_t WS_XS = 256 * MiB;
constexpr size_t WS_ACT = 400 * MiB;
constexpr size_t WS_HN8 = 576 * MiB;
constexpr size_t WS_WG8 = 592 * MiB;
constexpr size_t WS_END = 596 * MiB;
static_assert(WS_XS + (size_t)MAXROWS * 2048 <= WS_ACT && WS_ACT + (size_t)MAXROWS * 2048 <= WS_H2, "MoE overlays");
constexpr int CW_QUEUE = 1024;
constexpr int CW_GCNT = 64;
constexpr int CW_BAR = 4096;
constexpr int RING_OFF = 0, RING_BYTES = 131072;
constexpr int LDSCTL_OFF = RING_BYTES, MISC_OFF = LDSCTL_OFF + 320;
constexpr int L_PREFT = LDSCTL_OFF + 1024, L_PSTART = L_PREFT + 256, L_LCNT = L_PSTART + 256, L_LBASE = L_LCNT + 128;
constexpr int L_PART = LDSCTL_OFF + 8192;
constexpr int MOE_ETAB = (L_PART - L_PREFT) / 4;
constexpr int L_WSF = LDSCTL_OFF + 4096;
constexpr int LDS_BYTES = 163840;
constexpr int CONV_SLOTS = LDSCTL_OFF;

struct NoHooks { __device__ __forceinline__ void a_ready(const pg8::Unit&) const {} __device__ __forceinline__ void done(const pg8::Unit&) const {} };
struct ProjOrder : NoHooks {
    const char* A; const char* Bt; int G, c;
    __device__ __forceinline__ bool next(int i, pg8::Unit& u) const {
        const int L = i * G + c; int pm, pn;
        if (L < 64 * 14) pg8::static_map(L, 64, 14, pm, pn); else if (L < 64 * 14 + 8) { pm = 64 + ((L - 64 * 14) >> 2); pn = 26 + ((L - 64 * 14) & 3); } else return false;
        u.pm = pm; u.pn = pn; u.aux = 0; u.a = A + (size_t)pm * (256 * 2048); u.b = Bt + (size_t)pn * (256 * 2048); return true; }
};
struct GateOrder : NoHooks {
    const char* A; const char* Bt; int G, c;
    __device__ __forceinline__ bool next(int i, pg8::Unit& u) const {
        const int L = i * G + c; if (L >= 64 * 12) return false; int pm, pn; pg8::static_map(L, 64, 12, pm, pn);
        u.pm = pm; u.pn = pn; u.aux = 0; u.a = A + (size_t)pm * (256 * 1024); u.b = Bt + (size_t)pn * (256 * 1024); return true; }
};
struct MergeOrder : NoHooks {
    const char* Y; const char* Bt; int G, c;
    __device__ __forceinline__ bool next(int i, pg8::Unit& u) const {
        const int j = i / 3, br = i - 3 * j; const int L = j * G + c; if (L >= 256) return false; int pm, pn; pg8::static_map(L, 64, 4, pm, pn);
        u.pm = pm; u.pn = pn; u.aux = br; u.a = Y + (size_t)pm * (256 * 3072) + br * 1024; u.b = Bt + (size_t)(br * 1024 + pn * 256) * 1024; return true; }
};
struct OutOrder : NoHooks {
    const char* A; const char* Bt; int G, c;
    __device__ __forceinline__ bool next(int i, pg8::Unit& u) const {
        const int L = i * G + c; if (L >= 256) return false; int pm, pn; pg8::static_map(L, 64, 4, pm, pn);
        u.pm = pm; u.pn = pn; u.aux = 0; u.a = A + (size_t)pm * (256 * 2048); u.b = Bt + (size_t)pn * (256 * 2048); return true; }
};
struct MoeOrder : NoHooks {
    const char* A; const char* Bt; const volatile __attribute__((address_space(3))) int* prefT; int ncol, G, c; size_t tile_bytes;
    __device__ __forceinline__ bool next(int i, pg8::Unit& u) const {
        const int L = i * G + c; const int rt = L / ncol, pnl = L - rt * ncol; if (rt >= prefT[32]) return false;
        const int e = prefT[MOE_ETAB + rt];
        u.pm = rt; u.pn = e * ncol + pnl; u.aux = e; u.a = A + (size_t)rt * tile_bytes; u.b = Bt + (size_t)(e * ncol + pnl) * tile_bytes; return true; }
};

#define GAS __attribute__((address_space(1)))
#define LAS __attribute__((address_space(3)))
typedef unsigned short bf16;
typedef unsigned v4u __attribute__((ext_vector_type(4)));
typedef unsigned v2u __attribute__((ext_vector_type(2)));
typedef float f32x4 __attribute__((ext_vector_type(4)));
typedef float f32x16 __attribute__((ext_vector_type(16)));
typedef short bf16x8 __attribute__((ext_vector_type(8)));
typedef GAS unsigned gu32;
#define RLX_AGENT __ATOMIC_RELAXED, __HIP_MEMORY_SCOPE_AGENT
#define LDS_WAIT() asm volatile("s_waitcnt lgkmcnt(0)" ::: "memory")
#define VM_WAIT() asm volatile("s_waitcnt vmcnt(0)" ::: "memory")
__device__ __forceinline__ unsigned f2bf(float f) { unsigned u = __builtin_bit_cast(unsigned, f); return (u + 0x7fffu + ((u >> 16) & 1u)) >> 16; }
__device__ __forceinline__ unsigned pk2(float lo, float hi) { return f2bf(lo) | (f2bf(hi) << 16); }
__device__ __forceinline__ float bflo(unsigned w) { return __uint_as_float(w << 16); }
__device__ __forceinline__ float bfhi(unsigned w) { return __uint_as_float(w & 0xffff0000u); }
__device__ __forceinline__ float wave_sum(float v) {
#pragma unroll
    for (int o = 1; o < 64; o <<= 1) v += __shfl_xor(v, o);
    return v;
}

#define XB_TMO      128
#define XB_XCNT(j)  (256  + 64 * (j))
#define XB_XSUB(j)  (1280 + 64 * (j))
#define XB_XGEN(j)  (2304 + 64 * (j))
#define XB_TOP      3328
#define XB_TOPGEN   3392
#define XCD_BAR_WORDS 3456
#define XB_SPIN_CAP (1u << 18)

__device__ __forceinline__ unsigned xb_ld(unsigned* p)              { return __hip_atomic_load(p, __ATOMIC_RELAXED, __HIP_MEMORY_SCOPE_AGENT); }
__device__ __forceinline__ unsigned xb_add(unsigned* p, unsigned v) { return __hip_atomic_fetch_add(p, v, __ATOMIC_RELAXED, __HIP_MEMORY_SCOPE_AGENT); }
__device__ __forceinline__ unsigned xb_xcc_id() { return (unsigned)__builtin_amdgcn_s_getreg((3 << 11) | 20) & 0xFu; }
#define XB_SPIN(cond, bar) do { unsigned _sp = 0; while (cond) { __builtin_amdgcn_s_sleep(1); \
    if ((++_sp & 255u) == 0u) { if (xb_ld(&(bar)[XB_TMO])) break; if (_sp > XB_SPIN_CAP) { atomicAdd(&(bar)[XB_TMO], 1u); break; } } } } while (0)

struct XcdBarrier {
    unsigned* bar; unsigned x;
    volatile LAS unsigned* st;
};

__device__ __forceinline__ XcdBarrier xcd_barrier_post(unsigned* bar, volatile LAS unsigned* st) {
    XcdBarrier b; b.bar = bar; b.x = xb_xcc_id(); b.st = st;
    if (threadIdx.x == 0) (void)xb_add(&bar[XB_XCNT(b.x)], 1u);
    return b;
}
__device__ __forceinline__ void xcd_barrier_complete(unsigned* bar, unsigned x, unsigned& nloc, unsigned& nx) {
    const unsigned G = gridDim.x * gridDim.y * gridDim.z;
    unsigned sum, cnt, mine, sp = 0u;
    for (;;) {
        sum = 0u; cnt = 0u; mine = 0u;
#pragma unroll
        for (unsigned j = 0; j < 16; ++j) { const unsigned c = xb_ld(&bar[XB_XCNT(j)]); sum += c; cnt += (c > 0u) ? 1u : 0u; mine = (j == x) ? c : mine; }
        if (sum == G) break;
        __builtin_amdgcn_s_sleep(1);
        if ((++sp & 255u) == 0u) { if (xb_ld(&bar[XB_TMO])) break; if (sp > XB_SPIN_CAP) { atomicAdd(&bar[XB_TMO], 1u); break; } }
    }
    nloc = mine > 0u ? mine : 1u; nx = cnt > 0u ? cnt : 1u;
}

__device__ __forceinline__ void xcd_barrier(const XcdBarrier& b) {
    asm volatile("s_waitcnt vmcnt(0)" ::: "memory");
    __syncthreads();
    if (threadIdx.x == 0) {
        unsigned* bar = b.bar;
        __builtin_amdgcn_s_waitcnt(0);
        unsigned nloc = b.st[0], nx = b.st[1];
        if (nloc == 0u) { xcd_barrier_complete(bar, b.x, nloc, nx); b.st[0] = nloc; b.st[1] = nx; }
        const unsigned old = xb_add(&bar[XB_XSUB(b.x)], 1u);
        const unsigned gen = old / nloc;
        if (old + 1u == (gen + 1u) * nloc) {
            __builtin_amdgcn_fence(__ATOMIC_RELEASE, "agent");
            asm volatile("s_waitcnt vmcnt(0)" ::: "memory");
            const unsigned og = xb_add(&bar[XB_TOP], 1u);
            const unsigned tg = og / nx;
            if (og + 1u == (tg + 1u) * nx) xb_add(&bar[XB_TOPGEN], 1u);
            else XB_SPIN(xb_ld(&bar[XB_TOPGEN]) == tg, bar);
            __builtin_amdgcn_fence(__ATOMIC_ACQUIRE, "agent");
            xb_add(&bar[XB_XGEN(b.x)], 1u);
            asm volatile("s_waitcnt vmcnt(0)" ::: "memory");
        } else {
            XB_SPIN(xb_ld(&bar[XB_XGEN(b.x)]) == gen, bar);
            __builtin_amdgcn_fence(__ATOMIC_ACQUIRE, "agent");
            asm volatile("s_waitcnt vmcnt(0)" ::: "memory");
        }
    }
    __syncthreads();
}

struct Args { const float* in[25]; float* out; unsigned char* ws; int ph_lo, ph_hi; };
__device__ __forceinline__ int ip32(int r) { return 16 * ((r >> 2) & 1) + 4 * (r >> 3) + (r & 3); }
__device__ __forceinline__ void p0_transpose_item(const float* W, int ldn, int K, bf16* WT, int k0, int n0, int dst_row_base, bool perm, LAS float* scr, int lane) {
    float rr_[32];
#pragma unroll
    for (int i = 0; i < 32; ++i) rr_[i] = W[(size_t)(k0 + 2 * i + (lane >> 5)) * ldn + n0 + (lane & 31)];
#pragma unroll
    for (int i = 0; i < 32; ++i) scr[(2 * i + (lane >> 5)) * 33 + (lane & 31)] = rr_[i];
    LDS_WAIT(); asm volatile("" ::: "memory");
    const int c = lane & 7;
#pragma unroll
    for (int j = 0; j < 4; ++j) { const int n = (lane >> 3) + 8 * j; const LAS float* s = scr + (8 * c) * 33 + n;
        v4u o; o.x = pk2(s[0 * 33], s[1 * 33]); o.y = pk2(s[2 * 33], s[3 * 33]); o.z = pk2(s[4 * 33], s[5 * 33]); o.w = pk2(s[6 * 33], s[7 * 33]);
        *(GAS v4u*)(WT + (size_t)(dst_row_base + (perm ? ip32(n) : n)) * K + k0 + 8 * c) = o; }
    LDS_WAIT(); asm volatile("" ::: "memory");
}
__device__ __forceinline__ void p0_f8_load(float (&rr_)[32], const float* W, int ldn, int k0, int n0, int lane) {
#pragma unroll
    for (int i = 0; i < 8; ++i) { const f32x4 v = __builtin_nontemporal_load((const f32x4*)(W + (size_t)(k0 + 8 * i + (lane >> 3)) * ldn + n0 + (lane & 7) * 4));
        rr_[4 * i] = v.x; rr_[4 * i + 1] = v.y; rr_[4 * i + 2] = v.z; rr_[4 * i + 3] = v.w; }
}
__device__ __forceinline__ void p0_f8_finish(const float (&rr_)[32], int K, unsigned char* WT, int k0, int dst_row_base, LAS float* scr, int lane, const float S32) {
#pragma unroll
    for (int i = 0; i < 8; ++i) { LAS float* sp = scr + (8 * i + (lane >> 3)) * 33 + (lane & 7) * 4; sp[0] = rr_[4 * i]; sp[1] = rr_[4 * i + 1]; sp[2] = rr_[4 * i + 2]; sp[3] = rr_[4 * i + 3]; }
    LDS_WAIT(); asm volatile("" ::: "memory");
    const int n = lane >> 1, hf = lane & 1; const LAS float* s = scr + (32 * hf) * 33 + n;
    v4u o0, o1;
    o0.x = pg8::pk4_fp8(S32 * s[0 * 33], S32 * s[1 * 33], S32 * s[2 * 33], S32 * s[3 * 33]); o0.y = pg8::pk4_fp8(S32 * s[4 * 33], S32 * s[5 * 33], S32 * s[6 * 33], S32 * s[7 * 33]);
    o0.z = pg8::pk4_fp8(S32 * s[8 * 33], S32 * s[9 * 33], S32 * s[10 * 33], S32 * s[11 * 33]); o0.w = pg8::pk4_fp8(S32 * s[12 * 33], S32 * s[13 * 33], S32 * s[14 * 33], S32 * s[15 * 33]);
    o1.x = pg8::pk4_fp8(S32 * s[16 * 33], S32 * s[17 * 33], S32 * s[18 * 33], S32 * s[19 * 33]); o1.y = pg8::pk4_fp8(S32 * s[20 * 33], S32 * s[21 * 33], S32 * s[22 * 33], S32 * s[23 * 33]);
    o1.z = pg8::pk4_fp8(S32 * s[24 * 33], S32 * s[25 * 33], S32 * s[26 * 33], S32 * s[27 * 33]); o1.w = pg8::pk4_fp8(S32 * s[28 * 33], S32 * s[29 * 33], S32 * s[30 * 33], S32 * s[31 * 33]);
    GAS v4u* dp = (GAS v4u*)(WT + (size_t)(dst_row_base + ip32(n)) * K + k0 + 32 * hf);
    dp[0] = o0; dp[1] = o1;
    LDS_WAIT(); asm volatile("" ::: "memory");
}
__device__ __forceinline__ void conv_drain(pg8::ConvCtx& c, LAS unsigned char* lds, int wave, int lane) {
    asm volatile("s_waitcnt vmcnt(0)" ::: "memory");
    if (c.sub >= 0) { pg8::conv_finish(c, lds, c.slot0, lane, c.sub); c.sub = -1; }
    __syncthreads();
    const unsigned base = (unsigned)(RING_OFF + wave * 16384);
    int sub[4], aft[4];
#pragma unroll
    for (int i = 0; i < 4; ++i) { sub[i] = -1; aft[i] = 0; }
#pragma unroll
    for (int i = 0; i < 4; ++i) { const int s = c.cw + c.nseq * c.jn;
        if (s < pg8::CONV_NSUB) { pg8::conv_issue(c, lds, base + i * 4096, lane, s); sub[i] = s; ++c.jn;
#pragma unroll
            for (int k = 0; k < 4; ++k) aft[k] += 4;
            aft[i] = 0; } }
    for (;;) {
        bool any = false;
#pragma unroll
        for (int i = 0; i < 4; ++i) {
            if (sub[i] < 0) continue;
            any = true;
            const int a = aft[i];
            if (a >= 15) asm volatile("s_waitcnt vmcnt(15)" ::: "memory"); else if (a >= 12) asm volatile("s_waitcnt vmcnt(12)" ::: "memory");
            else if (a >= 8) asm volatile("s_waitcnt vmcnt(8)" ::: "memory"); else if (a >= 4) asm volatile("s_waitcnt vmcnt(4)" ::: "memory"); else asm volatile("s_waitcnt vmcnt(0)" ::: "memory");
            pg8::conv_finish(c, lds, base + i * 4096, lane, sub[i]); sub[i] = -1;
#pragma unroll
            for (int k = 0; k < 4; ++k) aft[k] += 1;
            const int s = c.cw + c.nseq * c.jn;
            if (s < pg8::CONV_NSUB) { pg8::conv_issue(c, lds, base + i * 4096, lane, s); sub[i] = s; ++c.jn;
#pragma unroll
                for (int k = 0; k < 4; ++k) aft[k] += 4;
                aft[i] = 0; }
        }
        if (!any) break;
    }
}
__device__ __forceinline__ int win_group_base(int L0) {
    if (L0 < 1024) { const int l = L0 & 255; return (L0 & ~255) + 128 * ((l >> 5) & 1) + 32 * (l >> 6); }
    if (L0 < 1536) return L0;
    if (L0 < 2048) return L0 - 1536 + 2560;
    if (L0 < 3072) { const int which = L0 >= 2560, ch = (L0 - 2048) & 511; return 256 * (6 + (ch >> 7)) + 128 * which + 32 * ((ch >> 5) & 3); }
    return L0;
}
__device__ __forceinline__ void rms_row_to_bf16(const float* xrow, const float* g, bf16* orow, int lane, unsigned char* orow8 = nullptr) {
    const GAS f32x4* xr = (const GAS f32x4*)xrow + lane; const GAS f32x4* gr = (const GAS f32x4*)g + lane;
    f32x4 v[4]; float s = 0.f;
#pragma unroll
    for (int j = 0; j < 4; ++j) { v[j] = xr[64 * j]; s += (v[j].x * v[j].x + v[j].y * v[j].y) + (v[j].z * v[j].z + v[j].w * v[j].w); }
    const float r = 1.0f / sqrtf(wave_sum(s) * (1.0f / 1024.0f) + EPS);
    GAS unsigned long long* o8 = (GAS unsigned long long*)orow + lane;
#pragma unroll
    for (int j = 0; j < 4; ++j) { const f32x4 gg = gr[64 * j]; o8[64 * j] = (unsigned long long)pk2(v[j].x * r * gg.x, v[j].y * r * gg.y) | ((unsigned long long)pk2(v[j].z * r * gg.z, v[j].w * r * gg.w) << 32);
        if (orow8) ((GAS unsigned*)orow8)[64 * j + lane] = pg8::pk4_fp8(v[j].x * r * gg.x, v[j].y * r * gg.y, v[j].z * r * gg.z, v[j].w * r * gg.w); }
}


__device__ __forceinline__ void p0_prologue(const Args& a, LAS unsigned char* lds, int vcu, int G, int wave, int lane, int tid) {
    LAS float* scr = (LAS float*)(lds + RING_OFF + wave * 16384);
    const int gw = vcu * NWAVES + wave, NGW = G * NWAVES;
    unsigned char* ws = a.ws;
    constexpr int I_IN = 16 * 112, I_G8 = 16 * 96, I_KV = 16 * 32, I_BR = 3 * 8 * 32, I_OUT = 16 * 32;
    constexpr int NITEMS = I_IN + I_G8 + I_KV + I_BR + I_OUT;
    for (int it = gw; it < NITEMS; it += NGW) {
        int r = it;
        if (r < I_IN) { const int kb = r / 112, nb = r % 112; p0_transpose_item(a.in[3], NIN, 1024, (bf16*)(ws + WS_WIN), 64 * kb, 32 * nb, win_group_base(32 * nb), true, scr, lane); continue; } r -= I_IN;
        if (r < I_G8) { const int kb = r / 96, nb = r % 96; float rr8[32]; p0_f8_load(rr8, a.in[3], NIN, 64 * kb, 3584 + 32 * nb, lane); p0_f8_finish(rr8, 1024, ws + WS_WG8, 64 * kb, 32 * nb, scr, lane, -32.0f * 1.4426950408889634f); continue; } r -= I_G8;
        if (r < I_KV) { const int kb = r / 32, nb = r % 32; p0_transpose_item(a.in[13], 1024, 1024, (bf16*)(ws + WS_WIN), 64 * kb, 32 * nb, 6656 + 32 * nb, true, scr, lane); continue; } r -= I_KV;
        if (r < I_BR) { const int br = r / 256, q = r % 256, kb = q / 32, nb = q % 32; p0_transpose_item(a.in[16] + (size_t)br * 512 * 1024, 1024, 512, (bf16*)(ws + WS_WBR), 64 * kb, 32 * nb, br * 1024 + 32 * nb, true, scr, lane); continue; } r -= I_BR;
        { const int kb = r / 32, nb = r % 32; p0_transpose_item(a.in[17], 1024, 1024, (bf16*)(ws + WS_WOUT), 64 * kb, 32 * nb, 32 * nb, true, scr, lane); }
    }
    bf16* HN = (bf16*)(ws + WS_HN);
    for (int m = gw; m < T + 512; m += NGW) {
        if (m < T) rms_row_to_bf16(a.in[0] + (size_t)m * D, a.in[2], HN + (size_t)m * D, lane, ws + WS_HN8 + (size_t)m * D);
        else rms_row_to_bf16(a.in[1] + (size_t)(m - T) * D, a.in[12], HN + (size_t)m * D, lane);
    }
    float* rc = (float*)(ws + WS_RCOS); float* rs = (float*)(ws + WS_RSIN);
    for (int i = gw * 64 + lane; i < SEQ * 32; i += NGW * 64) { const int pos = i >> 5, f = i & 31;
        const float inv_freq = 1.0f / powf(10000.0f, (float)(2 * f) / 64.0f); const float ang = (float)pos * inv_freq; rc[i] = cosf(ang); rs[i] = sinf(ang); }
}

__device__ __forceinline__ void phase_finish(const Args& a, int vcu, int G, int wave, int lane) {
    unsigned char* ws = a.ws; const int gw = vcu * NWAVES + wave, NGW = G * NWAVES;
    const bf16* OM = (const bf16*)(ws + WS_OMAPS); const bf16* U = (const bf16*)(ws + WS_U); const bf16* CB = (const bf16*)(ws + WS_CB); bf16* Y = (bf16*)(ws + WS_YALL);
    const float lam = expf(wave_sum(a.in[6][lane] * a.in[7][lane])) - expf(wave_sum(a.in[8][lane] * a.in[9][lane])) + 0.2f;
    const int hh = lane >> 4, c8 = (lane & 15) * 8;
    f32x4 gs0 = *(const f32x4*)(a.in[10] + c8), gs1 = *(const f32x4*)(a.in[10] + c8 + 4);
    f32x4 w0a = *(const f32x4*)(a.in[11] + lane * 8), w0b = *(const f32x4*)(a.in[11] + lane * 8 + 4);
    f32x4 w1a = *(const f32x4*)(a.in[11] + 512 + lane * 8), w1b = *(const f32x4*)(a.in[11] + 512 + lane * 8 + 4);
    f32x4 w2a = *(const f32x4*)(a.in[11] + 1024 + lane * 8), w2b = *(const f32x4*)(a.in[11] + 1024 + lane * 8 + 4);
    for (int t = gw; t < T; t += NGW) {
        {
            const v4u o0 = *(const v4u*)(OM + (size_t)t * 1024 + hh * 256 + c8), o1 = *(const v4u*)(OM + (size_t)t * 1024 + hh * 256 + 128 + c8);
            const f32x4 a0 = pg8::unpk_lo(o0) - lam * pg8::unpk_lo(o1), a1 = pg8::unpk_hi(o0) - lam * pg8::unpk_hi(o1);
            float ss = ((a0[0] * a0[0] + a0[1] * a0[1]) + (a0[2] * a0[2] + a0[3] * a0[3])) + ((a1[0] * a1[0] + a1[1] * a1[1]) + (a1[2] * a1[2] + a1[3] * a1[3]));
            ss += __shfl_xor(ss, 1); ss += __shfl_xor(ss, 2); ss += __shfl_xor(ss, 4); ss += __shfl_xor(ss, 8);
            const float r = 0.8f / sqrtf(ss * (1.0f / 128.0f) + EPS);
            *(v4u*)(Y + (size_t)t * 1536 + hh * 128 + c8) = pg8::pack8(a0 * gs0 * r, a1 * gs1 * r);
        }
        {
            const int s = t & (SEQ - 1); const v4u z = {0u, 0u, 0u, 0u};
            const v4u u0 = *(const v4u*)(U + (size_t)t * 512 + lane * 8);
            const v4u u1 = s >= 1 ? *(const v4u*)(U + (size_t)(t - 1) * 512 + lane * 8) : z;
            const v4u u2 = s >= 2 ? *(const v4u*)(U + (size_t)(t - 2) * 512 + lane * 8) : z;
            const v4u cb = *(const v4u*)(CB + (size_t)t * 512 + lane * 8);
            const f32x4 ya = pg8::unpk_lo(cb) * (w0a * pg8::unpk_lo(u2) + w1a * pg8::unpk_lo(u1) + w2a * pg8::unpk_lo(u0));
            const f32x4 yb = pg8::unpk_hi(cb) * (w0b * pg8::unpk_hi(u2) + w1b * pg8::unpk_hi(u1) + w2b * pg8::unpk_hi(u0));
            *(v4u*)(Y + (size_t)t * 1536 + 512 + lane * 8) = pg8::pack8(ya, yb);
        }
    }
}

#define DPPF(x, ctrl) __uint_as_float(__builtin_amdgcn_update_dpp(0u, __float_as_uint(x), (ctrl), 0xf, 0xf, false))
__device__ __forceinline__ float lane_xor32(float x, int lane) { auto r = __builtin_amdgcn_permlane32_swap(__float_as_uint(x), __float_as_uint(x), false, false); return __uint_as_float((lane & 32) ? r[0] : r[1]); }
__device__ __forceinline__ float lane_xor16(float x, int lane) { auto r = __builtin_amdgcn_permlane16_swap(__float_as_uint(x), __float_as_uint(x), false, false); return __uint_as_float((lane & 16) ? r[0] : r[1]); }
__device__ __forceinline__ float wave_sum_fast(float v, int lane) {
    v += DPPF(v, 0xb1); v += DPPF(v, 0x4e); v += DPPF(v, 0x141); v += DPPF(v, 0x140); v += lane_xor16(v, lane); v += lane_xor32(v, lane); return v; }
__device__ __forceinline__ void router_pick(float (&p)[32], int t, float bias, int lane_in, LAS unsigned char* lds, int* tk_e, int* tk_p, float* tk_g) {
    int lane = lane_in; asm volatile("" : "+v"(lane));
#define RSTEP(HN, MASK, XCHG) _Pragma("unroll") for (int i = 0; i < HN; ++i) { const bool up = (lane & MASK) != 0; const float keep = up ? p[i + HN] : p[i]; const float send = up ? p[i] : p[i + HN]; p[i] = keep + XCHG; }
    RSTEP(16, 32, lane_xor32(send, lane)) RSTEP(8, 16, lane_xor16(send, lane)) RSTEP(4, 8, DPPF(send, 0x140)) RSTEP(2, 4, DPPF(send, 0x141)) RSTEP(1, 2, DPPF(send, 0x4e))
#undef RSTEP
    const float logit = p[0] + DPPF(p[0], 0xb1) + bias;
    float val = (lane & 1) ? -INFINITY : logit;
    float tv[4]; int te[4];
#pragma unroll
    for (int r = 0; r < 4; ++r) {
        float m = val;
        m = fmaxf(m, DPPF(m, 0xb1)); m = fmaxf(m, DPPF(m, 0x4e)); m = fmaxf(m, DPPF(m, 0x141)); m = fmaxf(m, DPPF(m, 0x140)); m = fmaxf(m, lane_xor16(m, lane)); m = fmaxf(m, lane_xor32(m, lane));
        const unsigned long long bal = __ballot(val == m);
        const int first = __builtin_ctzll(bal);
        tv[r] = __uint_as_float(__builtin_amdgcn_readfirstlane(__float_as_uint(m))); te[r] = first >> 1;
        val = (lane == first) ? -INFINITY : val;
    }
    const float e1 = expf(tv[1] - tv[0]), e2 = expf(tv[2] - tv[0]), e3 = expf(tv[3] - tv[0]);
    const float is = 1.0f / (1.0f + e1 + e2 + e3);
    if (lane < 4) { const int e = (lane == 0) ? te[0] : (lane == 1) ? te[1] : (lane == 2) ? te[2] : te[3];
        const float gate = (lane == 0) ? is : (lane == 1) ? e1 * is : (lane == 2) ? e2 * is : e3 * is;
        const int lp = __hip_atomic_fetch_add((LAS int*)(lds + L_LCNT) + e, 1, __ATOMIC_RELAXED, __HIP_MEMORY_SCOPE_WORKGROUP);
        tk_e[t * 4 + lane] = e; tk_p[t * 4 + lane] = lp; tk_g[t * 4 + lane] = gate; }
}

__device__ __forceinline__ void phase_router(const Args& a, LAS unsigned char* lds, int vcu, int G, int wave, int lane, int tid, int dummy) {
    unsigned char* ws = a.ws; const int gw = vcu * NWAVES + wave, NGW = G * NWAVES;
    LAS float* Wt = (LAS float*)(lds + RING_OFF);
    volatile LAS int* lcnt = (volatile LAS int*)(lds + L_LCNT);
    const float* wr = a.in[19];
    const float* x1 = a.out;
    f32x4 vn[2][4];
#pragma unroll
    for (int q = 0; q < 2; ++q) { const GAS f32x4* xr = (const GAS f32x4*)(x1 + (size_t)(gw + q * NGW) * D) + lane;
#pragma unroll
        for (int j = 0; j < 4; ++j) vn[q][j] = xr[64 * j]; }
    { f32x4 wf[16];
#pragma unroll
      for (int i = 0; i < 16; ++i) wf[i] = *(const f32x4*)(wr + (size_t)(lane + 64 * i) * 32 + 4 * wave);
#pragma unroll
      for (int i = 0; i < 16; ++i) { const int d = lane + 64 * i;
          Wt[(4 * wave + 0) * 1024 + d] = wf[i].x; Wt[(4 * wave + 1) * 1024 + d] = wf[i].y; Wt[(4 * wave + 2) * 1024 + d] = wf[i].z; Wt[(4 * wave + 3) * 1024 + d] = wf[i].w; } }
    if (tid < 32) lcnt[tid] = 0;
    __syncthreads();
    const float* g = a.in[18]; unsigned char* H2 = ws + WS_H2;
    int* tk_e = (int*)(ws + WS_TKE); int* tk_p = (int*)(ws + WS_TKP); float* tk_g = (float*)(ws + WS_TKG);
    LAS unsigned char* ldsc = lds;
    const float bias = a.in[20][lane >> 1];
    const GAS f32x4* gr = (const GAS f32x4*)g + lane;
    for (int tb = gw; tb < T; tb += 2 * NGW) {
        f32x4 v[2][4];
#pragma unroll
        for (int q = 0; q < 2; ++q)
#pragma unroll
            for (int j = 0; j < 4; ++j) v[q][j] = vn[q][j];
        if (tb + 2 * NGW < T) {
#pragma unroll
            for (int q = 0; q < 2; ++q) { const GAS f32x4* xr = (const GAS f32x4*)(x1 + (size_t)(tb + 2 * NGW + q * NGW) * D) + lane;
#pragma unroll
                for (int j = 0; j < 4; ++j) vn[q][j] = xr[64 * j]; } }
#pragma unroll
        for (int q = 0; q < 2; ++q) { float s = 0.f;
#pragma unroll
            for (int j = 0; j < 4; ++j) s += (v[q][j].x * v[q][j].x + v[q][j].y * v[q][j].y) + (v[q][j].z * v[q][j].z + v[q][j].w * v[q][j].w);
            const float r = 1.0f / sqrtf(wave_sum_fast(s, lane) * (1.0f / 1024.0f) + EPS);
            GAS unsigned* o4 = (GAS unsigned*)(H2 + (size_t)(tb + q * NGW) * D) + lane;
#pragma unroll
            for (int j = 0; j < 4; ++j) { const f32x4 gg = gr[64 * j]; v[q][j].x *= r * gg.x; v[q][j].y *= r * gg.y; v[q][j].z *= r * gg.z; v[q][j].w *= r * gg.w;
                o4[64 * j] = pg8::pk4_fp8(v[q][j].x, v[q][j].y, v[q][j].z, v[q][j].w); } }
        float p0[32], p1[32];
#pragma unroll
        for (int e = 0; e < 32; ++e) { p0[e] = 0.f; p1[e] = 0.f; }
        for (int ps_ = 0; ps_ < (REPEAT_PHASE == 22 ? 2 : 1); ++ps_) {
        f32x4 w[4], wn[4];
        const LAS float* Wl = Wt + 4 * lane; asm volatile("" : "+v"(Wl));
#pragma unroll
        for (int j = 0; j < 4; ++j) w[j] = *(const LAS f32x4*)(Wl + 256 * j);
#pragma unroll
        for (int e = 0; e < 32; ++e) {
            if (e + 1 < 32) {
#pragma unroll
                for (int j = 0; j < 4; ++j) wn[j] = *(const LAS f32x4*)(Wl + (e + 1) * 1024 + 256 * j); }
            asm volatile("" ::: "memory"); __builtin_amdgcn_sched_barrier(0);
            { float a0 = 0.f, a1 = 0.f, b0 = 0.f, b1 = 0.f;
#pragma unroll
              for (int j = 0; j < 4; ++j) { a0 = fmaf(v[0][j].x, w[j].x, a0); a1 = fmaf(v[0][j].y, w[j].y, a1); a0 = fmaf(v[0][j].z, w[j].z, a0); a1 = fmaf(v[0][j].w, w[j].w, a1);
                                            b0 = fmaf(v[1][j].x, w[j].x, b0); b1 = fmaf(v[1][j].y, w[j].y, b1); b0 = fmaf(v[1][j].z, w[j].z, b0); b1 = fmaf(v[1][j].w, w[j].w, b1); }
              p0[e] += a0 + a1; p1[e] += b0 + b1; asm volatile("" : "+v"(p0[e]), "+v"(p1[e])); }
#pragma unroll
            for (int j = 0; j < 4; ++j) w[j] = wn[j];
        }
        }
        if (REPEAT_PHASE == 22) {
#pragma unroll
            for (int e = 0; e < 32; ++e) { p0[e] *= 0.5f; p1[e] *= 0.5f; } }
        router_pick(p0, tb, bias, lane, ldsc, tk_e, tk_p, tk_g);
        router_pick(p1, tb + NGW, bias, lane, ldsc, tk_e, tk_p, tk_g);
    }
    __syncthreads();
    if (tid < 32) ((int*)(ws + WS_BLKBASE))[(dummy ? 8192 : 0) + vcu * 32 + tid] = lcnt[tid];
    __syncthreads();
}

__device__ __forceinline__ void moe_plan(unsigned char* ws, LAS unsigned char* lds, int tid, int vcu, int G) {
    volatile LAS int* prefT = (volatile LAS int*)(lds + L_PREFT); volatile LAS int* pstart = (volatile LAS int*)(lds + L_PSTART); volatile LAS int* lbase = (volatile LAS int*)(lds + L_LBASE);
    volatile LAS int* part = (volatile LAS int*)(lds + L_PART);
    { const int e = tid & 31, pr = tid >> 5; const int* bc = (const int*)(ws + WS_BLKBASE); int tot = 0, pre = 0;
      for (int b = pr; b < G; b += 16) { const int c = bc[b * 32 + e]; tot += c; pre += (b < vcu) ? c : 0; }
      part[pr * 32 + e] = tot; part[512 + pr * 32 + e] = pre; }
    __syncthreads();
    if (tid < 64) { int nt = 0;
        if (tid < 32) { int tot = 0, pre = 0;
#pragma unroll
            for (int pr = 0; pr < 16; ++pr) { tot += part[pr * 32 + tid]; pre += part[512 + pr * 32 + tid]; }
            lbase[tid] = pre; nt = (tot + 255) >> 8; }
        int inc = nt;
#pragma unroll
        for (int o = 1; o < 32; o <<= 1) { const int y = __shfl_up(inc, o); if ((tid & 63) >= o) inc += y; }
        if (tid < 32) { prefT[tid] = inc - nt; pstart[tid] = (inc - nt) * 256; if (tid == 31) { prefT[32] = inc; pstart[32] = inc * 256; }
            if (vcu == 0) { int* gp = (int*)(ws + WS_BLKBASE) + 16384; gp[tid] = inc - nt; if (tid == 31) gp[32] = inc; } } }
    __syncthreads();
}
__device__ __forceinline__ void moe_plan_load(unsigned char* ws, LAS unsigned char* lds, int tid) {
    volatile LAS int* prefT = (volatile LAS int*)(lds + L_PREFT);
    if (tid < 33) prefT[tid] = ((const int*)(ws + WS_BLKBASE))[16384 + tid];
    __syncthreads();
    for (int rt = tid; rt < prefT[32]; rt += NWAVES * 64) { int e = 0; while (prefT[e + 1] <= rt) ++e; prefT[MOE_ETAB + rt] = e; }
    __syncthreads();
}

__device__ __forceinline__ void phase_dispatch(const Args& a, LAS unsigned char* lds, int vcu, int G, int wave, int lane, int tid) {
    unsigned char* ws = a.ws; const int gw = vcu * NWAVES + wave, NGW = G * NWAVES;
    volatile LAS int* pstart = (volatile LAS int*)(lds + L_PSTART); volatile LAS int* lbase = (volatile LAS int*)(lds + L_LBASE);
    moe_plan(ws, lds, tid, vcu, G);
    const unsigned char* H2 = ws + WS_H2; unsigned char* XS = ws + WS_XS;
    const int* tk_e = (const int*)(ws + WS_TKE); const int* tk_p = (const int*)(ws + WS_TKP); const float* tk_g = (const float*)(ws + WS_TKG);
    int* tslot = (int*)(ws + WS_TSLOT); float* rgate = (float*)(ws + WS_RGATE);
    for (int t = gw; t < T; t += NGW) {
        int slot = 0;
        if (lane < 4) { const int e = tk_e[t * 4 + lane]; slot = pstart[e] + lbase[e] + tk_p[t * 4 + lane]; rgate[slot] = tk_g[t * 4 + lane]; tslot[t * 4 + lane] = slot; }
        const v4u r0 = *(const v4u*)(H2 + (size_t)t * D + lane * 16);
#pragma unroll
        for (int k = 0; k < 4; ++k) { const int sk = __builtin_amdgcn_readlane(slot, k); *(v4u*)(XS + (size_t)sk * D + lane * 16) = r0; }
    }
}

__device__ __forceinline__ void phase_combine(const Args& a, int vcu, int G, int wave, int lane, float* dst_out) {
    unsigned char* ws = a.ws; const int gw = vcu * NWAVES + wave, NGW = G * NWAVES;
    const unsigned char* YS = ws + WS_XS; const int* tslot = (const int*)(ws + WS_TSLOT); float* out = a.out;
    for (int t = gw; t < T; t += NGW) {
        int slot = 0; if (lane < 4) slot = tslot[t * 4 + lane];
        const float* op = out + (size_t)t * D + lane * 16; f32x4 o[4];
#pragma unroll
        for (int j = 0; j < 4; ++j) o[j] = *(const f32x4*)(op + 4 * j);
#pragma unroll
        for (int k = 0; k < 4; ++k) { const int sk = __builtin_amdgcn_readlane(slot, k); const v4u y = *(const v4u*)(YS + (size_t)sk * D + lane * 16); const unsigned yw[4] = {y.x, y.y, y.z, y.w};
#pragma unroll
            for (int j = 0; j < 4; ++j) { const auto lo = __builtin_amdgcn_cvt_pk_f32_fp8((int)yw[j], false), hi = __builtin_amdgcn_cvt_pk_f32_fp8((int)yw[j], true);
                o[j][0] += lo[0] * 0.0625f; o[j][1] += lo[1] * 0.0625f; o[j][2] += hi[0] * 0.0625f; o[j][3] += hi[1] * 0.0625f; } }
        float* wp = dst_out + (size_t)t * D + lane * 16;
#pragma unroll
        for (int j = 0; j < 4; ++j) *(f32x4*)(wp + 4 * j) = o[j];
    }
}

__device__ __forceinline__ void memattn_unit(const Args& a, LAS unsigned char* lds, int b, int h, int qb, int wid, int lane, int tid) {
    unsigned char* ws = a.ws;
    const bf16* KVM = (const bf16*)(ws + WS_KVM); const bf16* MQ = (const bf16*)(ws + WS_MQ); const float* ssq = (const float*)(ws + WS_SSQ); bf16* Y = (bf16*)(ws + WS_YALL);
    LAS unsigned char* Ks = lds + RING_OFF;
    LAS unsigned char* Vs = lds + RING_OFF + 65536;
    const int r32 = lane & 31, hi = lane >> 5;
    const size_t qrow = (size_t)b * SEQ + (size_t)qb * 256 + wid * 32 + r32;
    bf16x8 qf[8];
#pragma unroll
    for (int ks = 0; ks < 8; ++ks) qf[ks] = *(const bf16x8*)(MQ + qrow * 512 + h * 128 + 16 * ks + 8 * hi);
    const f32x4 sq = *(const f32x4*)(ssq + qrow * 16 + h * 4);
    {
        const int m = tid >> 1, hf = tid & 1;
        const bf16* kr = KVM + (size_t)(b * 256 + m) * 1024 + h * 128 + hf * 64; const bf16* vr = kr + 512;
        v4u raw[8], vraw[8]; float ss = 0.f;
#pragma unroll
        for (int i = 0; i < 8; ++i) { raw[i] = *(const v4u*)(kr + 8 * i); vraw[i] = *(const v4u*)(vr + 8 * i); }
#pragma unroll
        for (int i = 0; i < 8; ++i) { const f32x4 x0 = pg8::unpk_lo(raw[i]), x1 = pg8::unpk_hi(raw[i]);
            ss += ((x0[0] * x0[0] + x0[1] * x0[1]) + (x0[2] * x0[2] + x0[3] * x0[3])) + ((x1[0] * x1[0] + x1[1] * x1[1]) + (x1[2] * x1[2] + x1[3] * x1[3])); }
        ss += __shfl_xor(ss, 1);
        const float r = 1.0f / sqrtf(ss * (1.0f / 128.0f) + EPS);
#pragma unroll
        for (int i = 0; i < 8; ++i) { const int d0 = hf * 64 + 8 * i; const f32x4 g0 = *(const f32x4*)(a.in[15] + d0) * *(const f32x4*)(a.in[14] + d0), g1 = *(const f32x4*)(a.in[15] + d0 + 4) * *(const f32x4*)(a.in[14] + d0 + 4);
            const int c = hf * 8 + i;
            *(LAS v4u*)(Ks + m * 256 + ((c ^ (m & 15)) << 4)) = pg8::pack8(pg8::unpk_lo(raw[i]) * g0 * r, pg8::unpk_hi(raw[i]) * g1 * r); }
        LAS unsigned char* vt = Vs + (m >> 6) * 16384 + ((m >> 4) & 3) * 1024 + (m & 15) * 64;
#pragma unroll
        for (int i = 0; i < 8; ++i) *(LAS v4u*)(vt + (2 * hf + (i >> 2)) * 4096 + (i & 3) * 16) = vraw[i];
    }
    __syncthreads();
    const float sc = (1.0f / sqrtf(((sq[0] + sq[1]) + (sq[2] + sq[3])) * (1.0f / 128.0f) + EPS)) * 0.08838834764831845f * 1.4426950408889634f;
    f32x16 o[4]; float l = 0.f;
#pragma unroll
    for (int d0 = 0; d0 < 4; ++d0) o[d0] = f32x16{};
    const int vb0 = (int)(unsigned)(uintptr_t)(lds + RING_OFF + 65536) + ((lane >> 4) & 1) * 32 + (lane & 3) * 8 + (4 * hi + ((lane & 15) >> 2)) * 64;
#pragma unroll 1
    for (int kt = 0; kt < 4; ++kt) {
        f32x16 p0 = f32x16{}, p1 = f32x16{};
#pragma unroll
        for (int ks = 0; ks < 8; ++ks) { const int c = 2 * ks + hi; const int k0 = 64 * kt + r32, k1 = k0 + 32;
            const bf16x8 f0 = *(const LAS bf16x8*)(Ks + k0 * 256 + ((c ^ (k0 & 15)) << 4)), f1 = *(const LAS bf16x8*)(Ks + k1 * 256 + ((c ^ (k1 & 15)) << 4));
            p0 = __builtin_amdgcn_mfma_f32_32x32x16_bf16(f0, qf[ks], p0, 0, 0, 0); p1 = __builtin_amdgcn_mfma_f32_32x32x16_bf16(f1, qf[ks], p1, 0, 0, 0); }
#pragma unroll
        for (int r = 0; r < 16; ++r) { p0[r] = __builtin_amdgcn_exp2f(p0[r] * sc); p1[r] = __builtin_amdgcn_exp2f(p1[r] * sc); l += p0[r] + p1[r]; }
        v4u pw[4];
        pw[0] = (v4u){pg8::cvt_pk_bf16(p0[0], p0[1]), pg8::cvt_pk_bf16(p0[2], p0[3]), pg8::cvt_pk_bf16(p0[4], p0[5]), pg8::cvt_pk_bf16(p0[6], p0[7])};
        pw[1] = (v4u){pg8::cvt_pk_bf16(p0[8], p0[9]), pg8::cvt_pk_bf16(p0[10], p0[11]), pg8::cvt_pk_bf16(p0[12], p0[13]), pg8::cvt_pk_bf16(p0[14], p0[15])};
        pw[2] = (v4u){pg8::cvt_pk_bf16(p1[0], p1[1]), pg8::cvt_pk_bf16(p1[2], p1[3]), pg8::cvt_pk_bf16(p1[4], p1[5]), pg8::cvt_pk_bf16(p1[6], p1[7])};
        pw[3] = (v4u){pg8::cvt_pk_bf16(p1[8], p1[9]), pg8::cvt_pk_bf16(p1[10], p1[11]), pg8::cvt_pk_bf16(p1[12], p1[13]), pg8::cvt_pk_bf16(p1[14], p1[15])};
        attn_body::pv128(o, vb0 + kt * 16384, __builtin_bit_cast(bf16x8, pw[0]), __builtin_bit_cast(bf16x8, pw[1]), __builtin_bit_cast(bf16x8, pw[2]), __builtin_bit_cast(bf16x8, pw[3]));
    }
    l += __shfl_xor(l, 32);
    LAS float* wsf = (LAS float*)(lds + L_WSF) + wid * 64;
    if (hi == 0) wsf[r32] = l;
    __syncthreads();
    LAS bf16* stg = (LAS bf16*)(lds + RING_OFF) + wid * 4096;
#pragma unroll
    for (int r = 0; r < 16; ++r) { const int orow = (r & 3) + 8 * (r >> 2) + 4 * hi; const float il = 1.0f / wsf[orow];
#pragma unroll
        for (int d0 = 0; d0 < 4; ++d0) stg[orow * 128 + d0 * 32 + r32] = (bf16)f2bf(o[d0][r] * il); }
    LDS_WAIT();
    bf16* Yw = Y + ((size_t)b * SEQ + (size_t)qb * 256 + wid * 32) * 1536 + 1024 + h * 128;
#pragma unroll
    for (int i = 0; i < 8; ++i) { const int row = i * 4 + (lane >> 4), ch = lane & 15; const v4u v = *(const LAS v4u*)(stg + row * 128 + ch * 8); *(v4u*)(Yw + (size_t)row * 1536 + ch * 8) = v; }
    __syncthreads();
}

__global__ void __launch_bounds__(NWAVES * 64, 2) mega_fwd(Args args) {
    extern __shared__ __attribute__((aligned(16))) unsigned char lds_raw[];
    LAS unsigned char* lds = (LAS unsigned char*)lds_raw;
    volatile LAS unsigned* MISC = (volatile LAS unsigned*)(lds + MISC_OFF);
    int tid = threadIdx.x, lane = tid & 63, wave = __builtin_amdgcn_readfirstlane(tid >> 6);
#define PHASE_LOCALS() do { tid = threadIdx.x; asm volatile("" : "+v"(tid)); lane = tid & 63; wave = __builtin_amdgcn_readfirstlane(tid >> 6); } while (0)
    const int G = gridDim.x; const int bx = blockIdx.x; const int vcu = (G % 8 == 0) ? (bx % 8) * (G / 8) + bx / 8 : bx;
    unsigned char* ws = args.ws;
    gu32* ctl = (gu32*)(ws + WS_CTL);
    for (int u = tid; u < (LDS_BYTES - LDSCTL_OFF) / 4; u += NWAVES * 64) ((LAS unsigned*)(lds + LDSCTL_OFF))[u] = 0u;
    __syncthreads();
    const int ph_lo = args.ph_lo, ph_hi = args.ph_hi;
    XcdBarrier bar; bar.bar = (unsigned*)(ctl + CW_BAR); bar.x = 0; bar.st = nullptr;
    if (ph_hi - ph_lo > 1) bar = xcd_barrier_post((unsigned*)(ctl + CW_BAR), MISC + 8);
#define IN(k) (ph_lo <= (k) && (k) < ph_hi)
#ifndef TS_PHASE
#define TS_PHASE -1
#endif
    unsigned long long* const ts = (unsigned long long*)(ws + WS_CTL + 512 * 1024);
#define STAMP(k) do { if (TS_PHASE >= 0 && bx == 0 && threadIdx.x == 0) ts[(k)] = __builtin_amdgcn_s_memrealtime(); } while (0)
#define GRID_BAR(k) do { if (IN(k) && IN((k) + 1)) xcd_barrier(bar); STAMP((k) + 1); } while (0)
    STAMP(0);

    if (IN(0)) { for (int rep_ = 0; rep_ < (REPEAT_PHASE == 0 ? 2 : 1); ++rep_) { if (rep_) xcd_barrier(bar);
    PHASE_LOCALS();
    p0_prologue(args, lds, vcu, G, wave, lane, tid);
    } }
    GRID_BAR(0);

    if (IN(1)) { for (int rep_ = 0; rep_ < (REPEAT_PHASE == 1 ? 2 : 1); ++rep_) { if (rep_) xcd_barrier(bar);
    PHASE_LOCALS();
    {
        pg8::Gemm g{2048u, 2048u, 1024};
        ProjOrder S; S.A = (const char*)(ws + WS_HN); S.Bt = (const char*)(ws + WS_WIN); S.G = G; S.c = bx;
        pg8::EpiProj E{(bf16*)(ws + WS_Q), (bf16*)(ws + WS_K), (bf16*)(ws + WS_V), (bf16*)(ws + WS_U), (bf16*)(ws + WS_CB), (bf16*)(ws + WS_MQ), (bf16*)(ws + WS_GATES), (bf16*)(ws + WS_KVM),
                       (float*)(ws + WS_SSQ), args.in[4], args.in[5], (const float*)(ws + WS_RCOS), (const float*)(ws + WS_RSIN)};
        const unsigned sv0 = __builtin_amdgcn_readfirstlane(MISC[8]), sv1 = __builtin_amdgcn_readfirstlane(MISC[9]);
        __syncthreads();
        pg8::ConvCtx cx; cx.wgu = args.in[21]; cx.wdn = args.in[23]; cx.ogu = ws + WS_WGU; cx.odn = ws + WS_WDN; cx.cw = bx * NWAVES + wave; cx.nseq = NWAVES * G; cx.jn = 0;
        cx.sub = -1; cx.slot0 = (unsigned)(CONV_SLOTS + wave * 4096);
        pg8::gemm_phase<pg8::EpiProj, ProjOrder, true, true, true>(lds + RING_OFF, g, S, E, &cx);
        { pg8::Gemm g8{1024u, 1024u, 512}; GateOrder S8; S8.A = (const char*)(ws + WS_HN8); S8.Bt = (const char*)(ws + WS_WG8); S8.G = G; S8.c = bx;
          pg8::EpiGates8 E8{ws + WS_GATES};
          pg8::gemm_phase_f8<pg8::EpiGates8, GateOrder, true, true, true>(lds + RING_OFF, g8, S8, E8, &cx); }
        conv_drain(cx, lds, wave, lane);
        __syncthreads();
        for (int u = tid; u < (LDS_BYTES - LDSCTL_OFF) / 4; u += NWAVES * 64) ((LAS unsigned*)(lds + LDSCTL_OFF))[u] = 0u;
        __syncthreads();
        if (tid == 0) { MISC[8] = sv0; MISC[9] = sv1; }
        __syncthreads();
    }
    } }
    GRID_BAR(1);

    if (IN(2)) { for (int rep_ = 0; rep_ < (REPEAT_PHASE == 2 ? 2 : 1); ++rep_) { if (rep_) xcd_barrier(bar);
    PHASE_LOCALS();
    {
        const int cmb = vcu >> 4, s = vcu & 15;
        const int b = cmb >> 3, h = (cmb >> 1) & 3, mp = cmb & 1;
        const attn_body::bf16* Qp = (const attn_body::bf16*)(ws + WS_Q) + (size_t)b * SEQ * 512 + (h * 2 + mp) * 64;
        const attn_body::bf16* Kp = (const attn_body::bf16*)(ws + WS_K) + (size_t)b * SEQ * 512 + (h * 2 + mp) * 64;
        const attn_body::bf16* Vp = (const attn_body::bf16*)(ws + WS_V) + (size_t)b * SEQ * 512 + h * 128;
        attn_body::bf16* Op = (attn_body::bf16*)(ws + WS_OMAPS) + (size_t)b * SEQ * 1024 + (h * 2 + mp) * 128;
#pragma unroll 1
        for (int i = 0; i < 2; ++i) { const int qb = (i == 0) ? s : 31 - s;
            attn_body::attn_unit128<8>(qb, Qp, Kp, Vp, Op, (char*)lds_raw + RING_OFF); }
        memattn_unit(args, lds, vcu >> 7, (vcu >> 5) & 3, vcu & 31, wave, lane, tid);
        if (REPEAT_PHASE == 21) memattn_unit(args, lds, vcu >> 7, (vcu >> 5) & 3, vcu & 31, wave, lane, tid);
    }
    } }
    GRID_BAR(2);

    if (IN(3)) { for (int rep_ = 0; rep_ < (REPEAT_PHASE == 3 ? 2 : 1); ++rep_) { if (rep_) xcd_barrier(bar);
    PHASE_LOCALS();
    phase_finish(args, vcu, G, wave, lane);
    } }
    GRID_BAR(3);

    if (REPEAT_PHASE == 20) { for (int i_ = 0; i_ < 10; ++i_) xcd_barrier(bar); }
    if (IN(4)) { for (int rep_ = 0; rep_ < (REPEAT_PHASE == 4 ? 2 : 1); ++rep_) { if (rep_) xcd_barrier(bar);
    PHASE_LOCALS();
    {
        pg8::Gemm g{3072u, 1024u, 512};
        MergeOrder S; S.Y = (const char*)(ws + WS_YALL); S.Bt = (const char*)(ws + WS_WBR); S.G = G; S.c = bx;
        pg8::EpiMerge E{(const bf16*)(ws + WS_GATES), (bf16*)(ws + WS_MERGED)};
        pg8::gemm_phase<pg8::EpiMerge, MergeOrder, true, true>(lds + RING_OFF, g, S, E);
    }
    } }
    GRID_BAR(4);

    if (IN(5)) { for (int rep_ = 0; rep_ < (REPEAT_PHASE == 5 ? 2 : 1); ++rep_) { if (rep_) xcd_barrier(bar);
    PHASE_LOCALS();
    {
        pg8::Gemm g{2048u, 2048u, 1024};
        OutOrder S; S.A = (const char*)(ws + WS_MERGED); S.Bt = (const char*)(ws + WS_WOUT); S.G = G; S.c = bx;
        pg8::EpiResid E{args.in[0], args.out};
        pg8::gemm_phase<pg8::EpiResid, OutOrder, false, true>(lds + RING_OFF, g, S, E);
    }
    } }
    GRID_BAR(5);

    if (IN(6)) { for (int rep_ = 0; rep_ < (REPEAT_PHASE == 6 ? 2 : 1); ++rep_) { if (rep_) xcd_barrier(bar);
    PHASE_LOCALS();
    phase_router(args, lds, vcu, G, wave, lane, tid, rep_ == 0 && REPEAT_PHASE == 6);
    } }
    GRID_BAR(6);

    if (IN(7)) { for (int rep_ = 0; rep_ < (REPEAT_PHASE == 7 ? 2 : 1); ++rep_) { if (rep_) xcd_barrier(bar);
    PHASE_LOCALS();
    phase_dispatch(args, lds, vcu, G, wave, lane, tid);
    } }
    GRID_BAR(7);

    if (IN(8)) { for (int rep_ = 0; rep_ < (REPEAT_PHASE == 8 ? 2 : 1); ++rep_) { if (rep_) xcd_barrier(bar);
    PHASE_LOCALS();
    {
        pg8::Gemm g{1024u, 1024u, 512};
        moe_plan_load(ws, lds, tid);
        MoeOrder S; S.A = (const char*)(ws + WS_XS); S.Bt = (const char*)(ws + WS_WGU); S.prefT = (const volatile LAS int*)(lds + L_PREFT); S.ncol = 8; S.G = G; S.c = vcu; S.tile_bytes = 256 * 1024;
        pg8::EpiSwiglu E{args.in[22], ws + WS_ACT};
        pg8::gemm_phase_f8<pg8::EpiSwiglu, MoeOrder, true, true>(lds + RING_OFF, g, S, E);
    }
    } }
    GRID_BAR(8);

    if (IN(9)) { for (int rep_ = 0; rep_ < (REPEAT_PHASE == 9 ? 2 : 1); ++rep_) { if (rep_) xcd_barrier(bar);
    PHASE_LOCALS();
    {
        pg8::Gemm g{1024u, 1024u, 512};
        moe_plan_load(ws, lds, tid);
        MoeOrder S; S.A = (const char*)(ws + WS_ACT); S.Bt = (const char*)(ws + WS_WDN); S.prefT = (const volatile LAS int*)(lds + L_PREFT); S.ncol = 4; S.G = G; S.c = vcu; S.tile_bytes = 256 * 1024;
        pg8::EpiDown E{args.in[24], (const float*)(ws + WS_RGATE), ws + WS_XS};
        pg8::gemm_phase_f8<pg8::EpiDown, MoeOrder, true, true>(lds + RING_OFF, g, S, E);
    }
    } }
    GRID_BAR(9);

    if (IN(10)) { for (int rep_ = 0; rep_ < 1; ++rep_) { if (rep_) xcd_barrier(bar);
    PHASE_LOCALS();
    if (REPEAT_PHASE == 10) { phase_combine(args, vcu, G, wave, lane, (float*)(ws + WS_WGU)); xcd_barrier(bar); }
    phase_combine(args, vcu, G, wave, lane, args.out);
    } }
    GRID_BAR(10);

    if (TS_PHASE >= 0) {
        STAMP(11); xcd_barrier(bar);
        const unsigned long long t0 = __hip_atomic_load(ts + (TS_PHASE == 11 ? 0 : TS_PHASE), RLX_AGENT), t1 = __hip_atomic_load(ts + (TS_PHASE == 11 ? 11 : TS_PHASE + 1), RLX_AGENT);
        const float v = (float)(t1 - t0) * (TS_PHASE == 11 ? 1e-4f : 1e-3f);
        for (size_t i = (size_t)bx * 512 + threadIdx.x; i < (size_t)T * D; i += (size_t)G * 512) args.out[i] = v;
    }
#undef GRID_BAR
#undef IN
}

extern "C" void kernel_launch(void* const* d_in, const int* in_sizes, int n_in, void* d_out, int out_size, void* d_ws, size_t ws_size, hipStream_t stream) {
    static int grid = 0;
    if (grid == 0) {
        if (n_in != 25 || out_size != T * D || ws_size < WS_END) { fprintf(stderr, "kernel_launch: unexpected problem shape (n_in %d, out %d, ws %zu)\n", n_in, out_size, ws_size); grid = -1; return; }
        int dev = 0, cus = 0;
        if (hipGetDevice(&dev) != hipSuccess || hipDeviceGetAttribute(&cus, hipDeviceAttributeMultiprocessorCount, dev) != hipSuccess) { grid = -1; return; }
        if (hipFuncSetAttribute((const void*)mega_fwd, hipFuncAttributeMaxDynamicSharedMemorySize, LDS_BYTES) != hipSuccess) { fprintf(stderr, "kernel_launch: hipFuncSetAttribute failed\n"); grid = -1; return; }
        int per_cu = 0;
        if (hipOccupancyMaxActiveBlocksPerMultiprocessor(&per_cu, (const void*)mega_fwd, NWAVES * 64, LDS_BYTES) != hipSuccess || per_cu < 1) fprintf(stderr, "kernel_launch: occupancy query says %d\n", per_cu);
        (void)hipGetLastError();
        grid = cus;
        if (grid != 256) fprintf(stderr, "kernel_launch: built for 256 CUs, device has %d\n", grid);
    }
    if (grid < 0) return;
    if (hipMemsetAsync((char*)d_ws + WS_CTL, 0, CTL_ZERO_BYTES, stream) != hipSuccess) return;
    Args a{};
    for (int i = 0; i < 25; ++i) a.in[i] = (const float*)d_in[i];
    a.out = (float*)d_out; a.ws = (unsigned char*)d_ws;
#ifndef MK_PER_PHASE
#define MK_PER_PHASE 0
#endif
    if (MK_PER_PHASE) { for (int k = 0; k < 11; ++k) { a.ph_lo = k; a.ph_hi = k + 1; hipLaunchKernelGGL(mega_fwd, dim3(grid), dim3(NWAVES * 64), LDS_BYTES, stream, a); } }
    else { a.ph_lo = 0; a.ph_hi = 11; hipLaunchKernelGGL(mega_fwd, dim3(grid), dim3(NWAVES * 64), LDS_BYTES, stream, a); }
}
```

```cpp
#include <hip/hip_runtime.h>
#include <hip/hip_bf16.h>
#include <cstdio>
#include <cstdint>
#include <cmath>

namespace cfg {
constexpr int BATCH = 2, SEQ = 8192, T = BATCH * SEQ, D = 1024, NIN = 6656, NE = 32, NMEM = 256;
constexpr int MAXROWS = 65536 + NE * 256;
constexpr float EPS = 1e-6f;
constexpr float C2 = 0.125f * 1.4426950408889634f;
}

namespace pg8 {
#define PG8_LAS __attribute__((address_space(3)))
typedef unsigned short bf16_t;
typedef short bf16x8 __attribute__((ext_vector_type(8)));
typedef float f32x4 __attribute__((ext_vector_type(4)));
typedef unsigned u32x4 __attribute__((ext_vector_type(4)));
typedef unsigned u32x2 __attribute__((ext_vector_type(2)));
constexpr int BM = 256, BK = 64, HALF = 128, HTB = HALF * BK * 2  , STAGE_BYTES = 8 * HTB, NXCD = 8, WGM = 8;

__host__ __device__ __forceinline__ int lds_byte(int r, int c) { const int st = (r >> 4) * 2 + (c >> 5), rr = r & 15, cc = c & 31, ob = rr * 64 + cc * 2; return st * 1024 + (ob ^ (((ob >> 9) & 1) << 5)); }
__host__ __device__ __forceinline__ void stage_rc(int b, int& R, int& C) { const int st = b / 1024, sb = b % 1024, swz = sb ^ (((sb >> 9) & 1) << 5); R = (st >> 1) * 16 + swz / 64; C = (st & 1) * 32 + (swz % 64) / 2; }

struct Unit { int pm, pn, aux; const char* a; const char* b; };
struct Gemm { unsigned lda, ldb; int K; };

__device__ __forceinline__ void static_map(int L, int nM, int nN, int& pm, int& pn) {
    const int nwg = nM * nN; int wgid = L; { const int q = nwg / NXCD, r = nwg % NXCD, xcd = wgid % NXCD, off = wgid / NXCD; wgid = (xcd < r ? xcd * (q + 1) : r * (q + 1) + (xcd - r) * q) + off; }
    const int nig = WGM * nN, gid = wgid / nig, fm = gid * WGM, gsz = (nM - fm) < WGM ? (nM - fm) : WGM;
    pm = fm + ((wgid % nig) % gsz); pn = (wgid % nig) / gsz;
}

typedef float f32x2_cv __attribute__((ext_vector_type(2))); typedef __bf16 bf16x2_cv __attribute__((ext_vector_type(2)));
__device__ __forceinline__ unsigned cvt_pk_bf16(float lo, float hi) { f32x2_cv v = {lo, hi}; bf16x2_cv b = __builtin_convertvector(v, bf16x2_cv); return __builtin_bit_cast(unsigned, b); }
__device__ __forceinline__ u32x4 pack8(const f32x4 v0, const f32x4 v1) { u32x4 w; w.x = cvt_pk_bf16(v0[0], v0[1]); w.y = cvt_pk_bf16(v0[2], v0[3]); w.z = cvt_pk_bf16(v1[0], v1[1]); w.w = cvt_pk_bf16(v1[2], v1[3]); return w; }
__device__ __forceinline__ f32x4 unpk_lo(const u32x4 w) { return (f32x4){__uint_as_float(w.x << 16), __uint_as_float(w.x & 0xffff0000u), __uint_as_float(w.y << 16), __uint_as_float(w.y & 0xffff0000u)}; }
__device__ __forceinline__ f32x4 unpk_hi(const u32x4 w) { return (f32x4){__uint_as_float(w.z << 16), __uint_as_float(w.z & 0xffff0000u), __uint_as_float(w.w << 16), __uint_as_float(w.w & 0xffff0000u)}; }
__device__ __forceinline__ unsigned pk4_fp8(float a, float b, float c, float d) { int w = 0; w = __builtin_amdgcn_cvt_pk_fp8_f32(a, b, w, false); w = __builtin_amdgcn_cvt_pk_fp8_f32(c, d, w, true); return (unsigned)w; }
__device__ __forceinline__ float sigmoidf_fast(float z) { return __builtin_amdgcn_rcpf(1.0f + __builtin_amdgcn_exp2f(-1.4426950408889634f * z)); }

using cfg::T; using cfg::SEQ; using cfg::EPS;

struct EpiProj {
    static constexpr bool AFTER_DRAIN = false;
    bf16_t *Q, *K, *V, *U, *CB, *MQ, *GATES, *KVM; float* ssq; const float *gq, *gk, *rcos, *rsin;
    __device__ __forceinline__ bool keep(const Unit&) const { return false; }
    __device__ __forceinline__ void operator()(f32x4 (&acc)[2][2][4][2], const Unit& u, int wr, int wc, int fr, int fq) const {
        const int pn = u.pn; const int row0 = u.pm * BM + wr * 64 + fr;
        if (pn < 4) {
            const bool isk = pn >= 2; const float* g = isk ? gk : gq; bf16_t* dst = (isk ? K : Q) + (pn & 1) * 256 + wc * 64 + 8 * fq;
            const float post = isk ? 1.0f : cfg::C2;
            f32x4 ga[2][2];
#pragma unroll
            for (int bj = 0; bj < 2; ++bj)
#pragma unroll
                for (int n = 0; n < 2; ++n) ga[bj][n] = *(const f32x4*)(g + 32 * bj + 8 * fq + 4 * n);
#pragma unroll
            for (int ai = 0; ai < 2; ++ai)
#pragma unroll
                for (int m = 0; m < 4; ++m) {
                    const int row = row0 + ai * HALF + m * 16;
                    float ss = 0.f;
#pragma unroll
                    for (int bj = 0; bj < 2; ++bj)
#pragma unroll
                        for (int n = 0; n < 2; ++n) { const f32x4 x = acc[ai][bj][m][n]; ss += (x[0] * x[0] + x[1] * x[1]) + (x[2] * x[2] + x[3] * x[3]); }
                    ss += __shfl_xor(ss, 16); ss += __shfl_xor(ss, 32);
                    const float rinv = __builtin_amdgcn_rsqf(ss * (1.0f / 64.0f) + EPS) * post;
                    const int pos = row & (SEQ - 1);
                    f32x4 o1[2], o2[2];
#pragma unroll
                    for (int n = 0; n < 2; ++n) {
                        const f32x4 c = *(const f32x4*)(rcos + pos * 32 + 8 * fq + 4 * n), s = *(const f32x4*)(rsin + pos * 32 + 8 * fq + 4 * n);
                        const f32x4 x1 = acc[ai][0][m][n] * ga[0][n] * rinv, x2 = acc[ai][1][m][n] * ga[1][n] * rinv;
                        o1[n] = x1 * c - x2 * s; o2[n] = x2 * c + x1 * s;
                    }
                    *(u32x4*)(dst + (size_t)row * 512) = pack8(o1[0], o1[1]);
                    *(u32x4*)(dst + (size_t)row * 512 + 32) = pack8(o2[0], o2[1]);
                }
        } else if (pn >= 6 && pn < 10) {
            bf16_t* dst = U + (pn - 6) * 128 + wc * 32 + 8 * fq;
#pragma unroll
            for (int ai = 0; ai < 2; ++ai)
#pragma unroll
                for (int m = 0; m < 4; ++m) { const int row = row0 + ai * HALF + m * 16;
                    *(u32x4*)(dst + (size_t)row * 512) = pack8(acc[ai][0][m][0] * acc[ai][1][m][0], acc[ai][0][m][1] * acc[ai][1][m][1]); }
        } else if (pn >= 14 && pn < 26) {
            unsigned char* dst = (unsigned char*)GATES + ((size_t)(u.pm * 12 + (pn - 14)) << 16) + (((wr * 4 + wc) * 64 + fq * 16 + fr) << 3);
#pragma unroll
            for (int ai = 0; ai < 2; ++ai)
#pragma unroll
                for (int m = 0; m < 4; ++m) {
#pragma unroll
                    for (int bj = 0; bj < 2; ++bj) { const f32x4 v0 = acc[ai][bj][m][0], v1 = acc[ai][bj][m][1]; unsigned q[8];
#pragma unroll
                        for (int e = 0; e < 4; ++e) { q[e] = (unsigned)(sigmoidf_fast(v0[e]) * 255.0f + 0.5f); q[4 + e] = (unsigned)(sigmoidf_fast(v1[e]) * 255.0f + 0.5f); }
                        u32x2 w8; w8.x = q[0] | (q[1] << 8) | (q[2] << 16) | (q[3] << 24); w8.y = q[4] | (q[5] << 8) | (q[6] << 16) | (q[7] << 24);
                        *(u32x2*)(dst + ((((ai * 4 + m) * 2 + bj) * 512) << 3)) = w8; } }
        } else {
            bf16_t* dst; int ld, rsub = 0; const bool ismq = (pn == 12 || pn == 13);
            if (pn < 6) { dst = V + (pn - 4) * 256; ld = 512; } else if (pn < 12) { dst = CB + (pn - 10) * 256; ld = 512; }
            else if (pn < 14) { dst = MQ + (pn - 12) * 256; ld = 512; } else { dst = KVM + (pn - 26) * 256; ld = 1024; rsub = T; }
            dst += wc * 32 + 8 * fq;
#pragma unroll
            for (int ai = 0; ai < 2; ++ai)
#pragma unroll
                for (int m = 0; m < 4; ++m) { const int row = row0 + ai * HALF + m * 16 - rsub;
#pragma unroll
                    for (int bj = 0; bj < 2; ++bj) { const f32x4 v0 = acc[ai][bj][m][0], v1 = acc[ai][bj][m][1];
                        *(u32x4*)(dst + (size_t)row * ld + bj * HALF) = pack8(v0, v1);
                        if (ismq) { float ss = ((v0[0] * v0[0] + v0[1] * v0[1]) + (v0[2] * v0[2] + v0[3] * v0[3])) + ((v1[0] * v1[0] + v1[1] * v1[1]) + (v1[2] * v1[2] + v1[3] * v1[3]));
                            ss += __shfl_xor(ss, 16); ss += __shfl_xor(ss, 32);
                            if (fq == 0) ssq[(size_t)row * 16 + ((pn - 12) * 2 + bj) * 4 + wc] = ss; } } }
        }
    }
};

struct EpiGates8 {
    static constexpr bool AFTER_DRAIN = false, HAS_BIAS = false;
    unsigned char* GATES;
    __device__ __forceinline__ bool keep(const Unit&) const { return false; }
    __device__ __forceinline__ void bias(f32x4 (&nb)[2][2], const Unit&, int, int) const { nb[0][0] = nb[0][1] = nb[1][0] = nb[1][1] = (f32x4){0.f, 0.f, 0.f, 0.f}; }
    __device__ __forceinline__ void operator()(f32x4 (&acc)[2][2][4][2], const Unit& u, int wr, int wc, int fr, int fq) const {
        {
            float t_ = 0.75f; asm volatile("" : "+v"(t_)); const float half = ((__builtin_amdgcn_cvt_pk_u8_f32(t_, 0, 0u) & 255u) == 0u) ? 0.5f : 0.0f;
            unsigned char* dst = (unsigned char*)GATES + ((size_t)(u.pm * 12 + u.pn) << 16) + (((wr * 4 + wc) * 64 + fq * 16 + fr) << 3);
#pragma unroll
            for (int ai = 0; ai < 2; ++ai)
#pragma unroll
                for (int m = 0; m < 4; ++m) {
#pragma unroll
                    for (int bj = 0; bj < 2; ++bj) { const f32x4 v0 = acc[ai][bj][m][0], v1 = acc[ai][bj][m][1]; u32x2 w8 = {0u, 0u};
#pragma unroll
                        for (int e = 0; e < 4; ++e) {
                            w8.x = __builtin_amdgcn_cvt_pk_u8_f32(__builtin_amdgcn_rcpf(__builtin_fmaf(__builtin_amdgcn_exp2f(v0[e]), 1.0f / 255.0f, 1.0f / 255.0f)) + half, e, w8.x);
                            w8.y = __builtin_amdgcn_cvt_pk_u8_f32(__builtin_amdgcn_rcpf(__builtin_fmaf(__builtin_amdgcn_exp2f(v1[e]), 1.0f / 255.0f, 1.0f / 255.0f)) + half, e, w8.y); }
                        *(u32x2*)(dst + ((((ai * 4 + m) * 2 + bj) * 512) << 3)) = w8; } }
        }
    }
};

struct EpiMerge {
    static constexpr bool AFTER_DRAIN = false;
    const bf16_t* GATES; bf16_t* MERGED;
    __device__ __forceinline__ bool keep(const Unit& u) const { return u.aux < 2; }
    __device__ __forceinline__ void operator()(f32x4 (&acc)[2][2][4][2], const Unit& u, int wr, int wc, int fr, int fq) const {
        const int br = u.aux; const int row0 = u.pm * BM + wr * 64 + fr, col0 = u.pn * BM + wc * 32 + 8 * fq;
        const unsigned char* ga_p = (const unsigned char*)GATES + ((size_t)(u.pm * 12 + br * 4 + u.pn) << 16) + (((wr * 4 + wc) * 64 + fq * 16 + fr) << 3);
        const unsigned char* gb_p = ga_p + ((size_t)4 << 16);
        u32x2 gav[16], gbv[16];
#pragma unroll
        for (int i = 0; i < 16; ++i) gav[i] = __builtin_nontemporal_load((const u32x2*)(ga_p + ((i * 512) << 3)));
        if (br < 2) {
#pragma unroll
            for (int i = 0; i < 16; ++i) gbv[i] = __builtin_nontemporal_load((const u32x2*)(gb_p + ((i * 512) << 3))); }
        else {
#pragma unroll
            for (int i = 0; i < 16; ++i) gbv[i] = (u32x2){0u, 0u}; }
        __builtin_amdgcn_sched_barrier(0);
#pragma unroll
        for (int ai = 0; ai < 2; ++ai)
#pragma unroll
            for (int m = 0; m < 4; ++m) { const int row = row0 + ai * HALF + m * 16;
#pragma unroll
                for (int bj = 0; bj < 2; ++bj) { const u32x2 ga = gav[(ai * 4 + m) * 2 + bj];
                    f32x4 f0 = {(float)(ga.x & 255u), (float)((ga.x >> 8) & 255u), (float)((ga.x >> 16) & 255u), (float)(ga.x >> 24)}, f1 = {(float)(ga.y & 255u), (float)((ga.y >> 8) & 255u), (float)((ga.y >> 16) & 255u), (float)(ga.y >> 24)};
                    if (br < 2) { const u32x2 gb = gbv[(ai * 4 + m) * 2 + bj];
                        const f32x4 d0 = {(float)__builtin_elementwise_max(gb.x & 255u, 1u), (float)__builtin_elementwise_max((gb.x >> 8) & 255u, 1u), (float)__builtin_elementwise_max((gb.x >> 16) & 255u, 1u), (float)__builtin_elementwise_max(gb.x >> 24, 1u)};
                        const f32x4 d1 = {(float)__builtin_elementwise_max(gb.y & 255u, 1u), (float)__builtin_elementwise_max((gb.y >> 8) & 255u, 1u), (float)__builtin_elementwise_max((gb.y >> 16) & 255u, 1u), (float)__builtin_elementwise_max(gb.y >> 24, 1u)};
                        if (br == 1) {
#pragma unroll
                            for (int e = 0; e < 4; ++e) { f0[e] = __builtin_fmaxf(f0[e], 1.0f); f1[e] = __builtin_fmaxf(f1[e], 1.0f); } }
#pragma unroll
                        for (int e = 0; e < 4; ++e) { f0[e] *= __builtin_amdgcn_rcpf(d0[e]); f1[e] *= __builtin_amdgcn_rcpf(d1[e]); } }
                    else {
#pragma unroll
                        for (int e = 0; e < 4; ++e) { f0[e] = __builtin_fmaxf(f0[e], 1.0f) * (1.0f / 255.0f); f1[e] = __builtin_fmaxf(f1[e], 1.0f) * (1.0f / 255.0f); } }
                    acc[ai][bj][m][0] *= f0; acc[ai][bj][m][1] *= f1;
                    if (br == 2) *(u32x4*)(MERGED + (size_t)row * 1024 + col0 + bj * HALF) = pack8(acc[ai][bj][m][0], acc[ai][bj][m][1]);
                } }
    }
};

struct EpiResid {
    static constexpr bool AFTER_DRAIN = false;
    const float* base; float* out;
    __device__ __forceinline__ bool keep(const Unit&) const { return false; }
    __device__ __forceinline__ void operator()(f32x4 (&acc)[2][2][4][2], const Unit& u, int wr, int wc, int fr, int fq) const {
        const int row0 = u.pm * BM + wr * 64 + fr, col0 = u.pn * BM + wc * 32 + 8 * fq;
#pragma unroll
        for (int ai = 0; ai < 2; ++ai)
#pragma unroll
            for (int mp = 0; mp < 2; ++mp) {
                f32x4 xv[2][2][2];
#pragma unroll
                for (int mm = 0; mm < 2; ++mm) { const size_t off = (size_t)(row0 + ai * HALF + (2 * mp + mm) * 16) * 1024 + col0;
#pragma unroll
                    for (int bj = 0; bj < 2; ++bj)
#pragma unroll
                        for (int n = 0; n < 2; ++n) xv[mm][bj][n] = __builtin_nontemporal_load((const f32x4*)(base + off + bj * HALF + n * 4)); }
                __builtin_amdgcn_sched_barrier(0);
#pragma unroll
                for (int mm = 0; mm < 2; ++mm) { const int m = 2 * mp + mm; const size_t off = (size_t)(row0 + ai * HALF + m * 16) * 1024 + col0;
#pragma unroll
                    for (int bj = 0; bj < 2; ++bj)
#pragma unroll
                        for (int n = 0; n < 2; ++n) *(f32x4*)(out + off + bj * HALF + n * 4) = xv[mm][bj][n] + acc[ai][bj][m][n]; }
                __builtin_amdgcn_sched_barrier(0); }
    }
};

struct EpiSwiglu {
    static constexpr bool AFTER_DRAIN = false, HAS_BIAS = true;
    const float* bgu; unsigned char* ACT;
    __device__ __forceinline__ bool keep(const Unit&) const { return false; }
    __device__ __forceinline__ void bias(f32x4 (&nb)[2][2], const Unit& u, int wc, int fq) const {
        const int e_ = u.pn >> 3, ch0 = (u.pn & 7) * 128 + wc * 32 + 8 * fq;
#pragma unroll
        for (int n = 0; n < 2; ++n) { nb[0][n] = *(const f32x4*)(bgu + (size_t)e_ * 2048 + ch0 + 4 * n); nb[1][n] = *(const f32x4*)(bgu + (size_t)e_ * 2048 + 1024 + ch0 + 4 * n); } }
    __device__ __forceinline__ void operator()(f32x4 (&acc)[2][2][4][2], const Unit& u, int wr, int wc, int fr, int fq) const {
        const int e_ = u.pn >> 3, pnl = u.pn & 7; const int row0 = u.pm * BM + wr * 64 + fr, ch0 = pnl * 128 + wc * 32 + 8 * fq;
        (void)e_;
        const int odd = fq & 1; const int chs = ch0 - 8 * odd;
#pragma unroll
        for (int ai = 0; ai < 2; ++ai)
#pragma unroll
            for (int mp = 0; mp < 2; ++mp) { u32x2 w8[2];
#pragma unroll
                for (int mm = 0; mm < 2; ++mm) { const int m = 2 * mp + mm; f32x4 a[2];
#pragma unroll
                    for (int n = 0; n < 2; ++n) { const f32x4 g = acc[ai][0][m][n], uu = acc[ai][1][m][n];
#pragma unroll
                        for (int e = 0; e < 4; ++e) { const float gm = fminf(g[e], 7.0f), um = fminf(fmaxf(uu[e], -7.0f), 7.0f);
                            a[n][e] = (um + 1.0f) * (gm * sigmoidf_fast(1.702f * gm)); } }
                    w8[mm].x = pk4_fp8(a[0][0], a[0][1], a[0][2], a[0][3]); w8[mm].y = pk4_fp8(a[1][0], a[1][1], a[1][2], a[1][3]); }
                const auto rx = __builtin_amdgcn_permlane16_swap(w8[0].x, w8[1].x, false, false), ry = __builtin_amdgcn_permlane16_swap(w8[0].y, w8[1].y, false, false);
                const u32x4 v = {rx[0], ry[0], rx[1], ry[1]};
                *(u32x4*)(ACT + (size_t)(row0 + ai * HALF + (2 * mp + odd) * 16) * 1024 + chs) = v; }
    }
};

struct EpiDown {
    static constexpr bool AFTER_DRAIN = false, HAS_BIAS = true;
    const float* bd; const float* row_gate; unsigned char* YS;
    __device__ __forceinline__ bool keep(const Unit&) const { return false; }
    __device__ __forceinline__ void bias(f32x4 (&nb)[2][2], const Unit& u, int wc, int fq) const {
        const int e_ = u.pn >> 2, col0 = (u.pn & 3) * 256 + wc * 32 + 8 * fq;
#pragma unroll
        for (int bj = 0; bj < 2; ++bj)
#pragma unroll
            for (int n = 0; n < 2; ++n) nb[bj][n] = *(const f32x4*)(bd + (size_t)e_ * 1024 + col0 + bj * HALF + 4 * n); }
    __device__ __forceinline__ void operator()(f32x4 (&acc)[2][2][4][2], const Unit& u, int wr, int wc, int fr, int fq) const {
        const int e_ = u.pn >> 2, pnl = u.pn & 3; const int row0 = u.pm * BM + wr * 64 + fr, col0 = pnl * 256 + wc * 32 + 8 * fq;
        (void)e_;
        float rgv[8];
#pragma unroll
        for (int i = 0; i < 8; ++i) rgv[i] = row_gate[row0 + (i >> 2) * HALF + (i & 3) * 16];
        __builtin_amdgcn_sched_barrier(0);
        const int odd = fq & 1; const int cols = col0 - 8 * odd;
#pragma unroll
        for (int ai = 0; ai < 2; ++ai)
#pragma unroll
            for (int mp = 0; mp < 2; ++mp)
#pragma unroll
                for (int bj = 0; bj < 2; ++bj) { u32x2 w8[2];
#pragma unroll
                    for (int mm = 0; mm < 2; ++mm) { const int m = 2 * mp + mm; const float rg = rgv[ai * 4 + m] * 16.0f;
                        const f32x4 y0 = acc[ai][bj][m][0] * rg, y1 = acc[ai][bj][m][1] * rg;
                        w8[mm].x = pk4_fp8(y0[0], y0[1], y0[2], y0[3]); w8[mm].y = pk4_fp8(y1[0], y1[1], y1[2], y1[3]); }
                    const auto rx = __builtin_amdgcn_permlane16_swap(w8[0].x, w8[1].x, false, false), ry = __builtin_amdgcn_permlane16_swap(w8[0].y, w8[1].y, false, false);
                    const u32x4 v = {rx[0], ry[0], rx[1], ry[1]};
                    *(u32x4*)(YS + (size_t)(row0 + ai * HALF + (2 * mp + odd) * 16) * 1024 + cols + bj * HALF) = v; }
    }
};


constexpr int CONV_NSUB = 2 * (32768 + 16384);
struct ConvCtx {
    const float* wgu; const float* wdn; unsigned char* ogu; unsigned char* odn;
    int cw, nseq, jn;
    int sub;
    unsigned slot0;
};
struct ConvItem { const float* W; unsigned char* WT; int ldn, k0, n0, dst; };
__device__ __forceinline__ int conv_ip32(int r) { return 16 * ((r >> 2) & 1) + 4 * (r >> 3) + (r & 3); }
__device__ __forceinline__ ConvItem conv_decode(const ConvCtx& c, int s) {
    ConvItem d; const int it = s >> 1, hf = s & 1;
    if (it < 32768) { const int e = it >> 10, q = it & 1023, kb = q >> 6, nb = q & 63; const int L0 = 32 * nb, ch = L0 & 1023;
        d.W = c.wgu + (size_t)e * 1024 * 2048; d.ldn = 2048; d.k0 = 64 * kb + 32 * hf; d.n0 = L0; d.dst = e * 2048 + 256 * (ch >> 7) + 128 * (L0 >> 10) + 32 * ((ch >> 5) & 3); d.WT = c.ogu; }
    else { const int r = it - 32768, e = r >> 9, q = r & 511, kb = q >> 5, nb = q & 31;
        d.W = c.wdn + (size_t)e * 1024 * 1024; d.ldn = 1024; d.k0 = 64 * kb + 32 * hf; d.n0 = 32 * nb; d.dst = e * 1024 + 32 * nb; d.WT = c.odn; }
    return d;
}
__device__ __forceinline__ void conv_issue(const ConvCtx& c, PG8_LAS unsigned char* lds, unsigned slot, int lane_, int s) {
    int lane = lane_; asm volatile("" : "+v"(lane));
    const ConvItem d = conv_decode(c, s);
    const float* src = d.W + (size_t)(d.k0 + (lane >> 3)) * d.ldn + d.n0 + 4 * (lane & 7);
#pragma unroll
    for (int jj = 0; jj < 4; ++jj) __builtin_amdgcn_global_load_lds((const unsigned*)(src + (size_t)(8 * jj) * d.ldn), (PG8_LAS unsigned*)(lds + slot + jj * 1024), 16, 0, 2);
}
__device__ __forceinline__ void conv_finish(const ConvCtx& c, PG8_LAS unsigned char* lds, unsigned slot, int lane_, int s) {
    int lane = lane_; asm volatile("" : "+v"(lane));
    const ConvItem d = conv_decode(c, s);
    const int n = lane & 31, kh = lane >> 5;
    const PG8_LAS float* p = (const PG8_LAS float*)(lds + slot + kh * 2048 + n * 4);
    float v[16];
#pragma unroll
    for (int kk = 0; kk < 16; ++kk) v[kk] = p[kk * 32];
    asm volatile("s_waitcnt lgkmcnt(0)" ::: "memory");
    u32x4 o;
    o.x = pk4_fp8(32.f * v[0], 32.f * v[1], 32.f * v[2], 32.f * v[3]);   o.y = pk4_fp8(32.f * v[4], 32.f * v[5], 32.f * v[6], 32.f * v[7]);
    o.z = pk4_fp8(32.f * v[8], 32.f * v[9], 32.f * v[10], 32.f * v[11]); o.w = pk4_fp8(32.f * v[12], 32.f * v[13], 32.f * v[14], 32.f * v[15]);
    __builtin_nontemporal_store(o, (u32x4*)(d.WT + (size_t)(d.dst + conv_ip32(n)) * 1024 + d.k0 + 16 * kh));
}
template <class Epi, class Sched, bool ALIGN_EPI = false, bool SP2 = false, bool CONV = false>
__device__ __forceinline__ void gemm_phase(PG8_LAS unsigned char* lds, const Gemm g, const Sched& S, const Epi& E, ConvCtx* cx = nullptr) {
    int tid_ = threadIdx.x; asm volatile("" : "+v"(tid_));
    const int tid = tid_, wid = __builtin_amdgcn_readfirstlane(tid >> 6), lane = tid & 63, wr = wid >> 2, wc = wid & 3, fr = lane & 15, fq = lane >> 4;
    const int K = g.K, nt = K / BK;
    static_assert(!CONV || SP2, "CONV needs the SP2 loop");
    unsigned voffA[2], voffB[2];
#pragma unroll
    for (int i = 0; i < 2; ++i) { int R, C; stage_rc(tid * 16 + i * 8192, R, C);
        voffA[i] = (unsigned)R * g.lda + (unsigned)C * 2u; voffB[i] = (unsigned)R * g.ldb + (unsigned)C * 2u; }
    const size_t kstep = (size_t)(BK * 2);
    const size_t hstepA = (size_t)HALF * g.lda, hstepB = (size_t)HALF * g.ldb;
    const unsigned ldsw = (unsigned)wid * 1024u;
    const int aoff = lds_byte(wr * 64 + fr, fq * 8), boff = lds_byte(wc * 32 + fr, fq * 8);
#define PG8_SA(b, h) (((b) * 2 + (h)) * HTB)
#define PG8_SB(b, h) ((4 + (b) * 2 + (h)) * HTB)
#define PG8_STAGE(bufoff, gbase, voff) do { _Pragma("unroll") for (int _i = 0; _i < 2; ++_i) \
        __builtin_amdgcn_global_load_lds((const unsigned*)((const char*)(gbase) + (voff)[_i]), (PG8_LAS unsigned*)(lds + (bufoff) + ldsw + _i * 8192), 16, 0, 0); } while (0)
#define PG8_LDA(dst, b, h) do { _Pragma("unroll") for (int m = 0; m < 4; ++m) _Pragma("unroll") for (int k = 0; k < 2; ++k) dst[m][k] = *(const PG8_LAS bf16x8*)(lds + PG8_SA(b, h) + aoff + m * 2048 + k * 1024); } while (0)
#define PG8_LDB(dst, b, h) do { _Pragma("unroll") for (int n = 0; n < 2; ++n) _Pragma("unroll") for (int k = 0; k < 2; ++k) dst[n][k] = *(const PG8_LAS bf16x8*)(lds + PG8_SB(b, h) + boff + n * 2048 + k * 1024); } while (0)
#define PG8_MMA(ai, bj, At, Bt) do { __builtin_amdgcn_s_setprio(1); _Pragma("unroll") for (int m = 0; m < 4; ++m) _Pragma("unroll") for (int n = 0; n < 2; ++n) _Pragma("unroll") for (int k = 0; k < 2; ++k) \
        acc[ai][bj][m][n] = __builtin_amdgcn_mfma_f32_16x16x32_bf16(Bt[n][k], At[m][k], acc[ai][bj][m][n], 0, 0, 0); __builtin_amdgcn_s_setprio(0); } while (0)
#define PG8_WAIT_V(n) asm volatile("s_waitcnt vmcnt(" #n ")" ::: "memory")
#define PG8_WAIT_X(n_) do { if constexpr (CONV) { const int x_ = (n_); if (x_ == 5) asm volatile("s_waitcnt vmcnt(13)" ::: "memory"); else if (x_ == 4) asm volatile("s_waitcnt vmcnt(12)" ::: "memory"); \
        else if (x_ == 1) asm volatile("s_waitcnt vmcnt(9)" ::: "memory"); else asm volatile("s_waitcnt vmcnt(8)" ::: "memory"); } else asm volatile("s_waitcnt vmcnt(8)" ::: "memory"); } while (0)
#define PG8_WAIT_L(n) asm volatile("s_waitcnt lgkmcnt(" #n ")" ::: "memory")
#define PG8_BAR __builtin_amdgcn_s_barrier()
#define PG8_SCHED __builtin_amdgcn_sched_barrier(0)
    Unit cur, nxt; int ui = 0;
    if (!S.next(0, cur)) return;
    f32x4 acc[2][2][4][2];
#pragma unroll
    for (int a = 0; a < 2; ++a)
#pragma unroll
        for (int b = 0; b < 2; ++b)
#pragma unroll
            for (int m = 0; m < 4; ++m)
#pragma unroll
                for (int n = 0; n < 2; ++n) acc[a][b][m][n] = (f32x4){0.f, 0.f, 0.f, 0.f};
    bf16x8 At[4][2], B0[2][2], B1[2][2];
    const char* cA = cur.a; const char* cB = cur.b;
    S.a_ready(cur);
    if constexpr (SP2) {
        PG8_STAGE(PG8_SB(0, 0), cB, voffB); PG8_STAGE(PG8_SB(0, 1), cB + hstepB, voffB); PG8_STAGE(PG8_SA(0, 0), cA, voffA); PG8_STAGE(PG8_SA(0, 1), cA + hstepA, voffA);
        if (wr == 1) PG8_BAR;
        PG8_WAIT_V(2); PG8_BAR;
        PG8_STAGE(PG8_SB(1, 0), cB + kstep, voffB); PG8_STAGE(PG8_SA(1, 0), cA + kstep, voffA); PG8_STAGE(PG8_SB(1, 1), cB + hstepB + kstep, voffB);
        PG8_WAIT_V(6); PG8_BAR;
    } else {
        PG8_STAGE(PG8_SB(0, 0), cB, voffB); PG8_STAGE(PG8_SA(0, 0), cA, voffA); PG8_STAGE(PG8_SB(0, 1), cB + hstepB, voffB); PG8_STAGE(PG8_SA(0, 1), cA + hstepA, voffA);
        if (wr == 1) PG8_BAR;
        PG8_WAIT_V(4); PG8_BAR;
        PG8_STAGE(PG8_SB(1, 0), cB + kstep, voffB); PG8_STAGE(PG8_SA(1, 0), cA + kstep, voffA); PG8_STAGE(PG8_SB(1, 1), cB + hstepB + kstep, voffB);
        PG8_WAIT_V(6); PG8_BAR;
    }
    for (;;) {
        const bool has_next = S.next(ui + 1, nxt);
        const char* nA = has_next ? nxt.a : cA; const char* nB = has_next ? nxt.b : cB;
#pragma unroll 1
        for (int t = 0; t < nt; t += 2) {
            const bool last = (t == nt - 2);
            const char* a1 = cA + (size_t)(t + 1) * kstep;
            const char* a2 = last ? nA : cA + (size_t)(t + 2) * kstep; const char* b2 = last ? nB : cB + (size_t)(t + 2) * kstep;
            const char* a3 = a2 + kstep; const char* b3 = b2 + kstep;
            if (last && has_next) S.a_ready(nxt);
            if constexpr (SP2) {
            int cs_ = 0, cc_ = 0;
            if constexpr (CONV) { if (cx->sub >= 0) { conv_finish(*cx, lds, cx->slot0, lane, cx->sub); cx->sub = -1; cs_ = 1; } PG8_SCHED; }
            PG8_LDB(B0, 0, 0); PG8_LDB(B1, 0, 1); PG8_SCHED; PG8_LDA(At, 0, 0); PG8_STAGE(PG8_SA(1, 1), a1 + hstepA, voffA);
            if constexpr (CONV) { const int s_ = cx->cw + cx->nseq * cx->jn; if (s_ < CONV_NSUB) { conv_issue(*cx, lds, cx->slot0, lane, s_); cx->sub = s_; ++cx->jn; cc_ = 4; } }
            PG8_WAIT_X(cs_ + cc_); PG8_WAIT_L(0); PG8_BAR; PG8_MMA(0, 0, At, B0); PG8_MMA(0, 1, At, B1); PG8_BAR; PG8_SCHED;
            PG8_LDA(At, 0, 1); PG8_STAGE(PG8_SB(0, 0), b2, voffB); PG8_STAGE(PG8_SB(0, 1), b2 + hstepB, voffB); PG8_STAGE(PG8_SA(0, 0), a2, voffA);
            PG8_WAIT_X(cs_ + cc_); PG8_WAIT_L(0); PG8_BAR; PG8_MMA(1, 0, At, B0); PG8_MMA(1, 1, At, B1); PG8_BAR; PG8_SCHED;
            PG8_LDB(B0, 1, 0); PG8_LDB(B1, 1, 1); PG8_SCHED; PG8_LDA(At, 1, 0); PG8_STAGE(PG8_SA(0, 1), a2 + hstepA, voffA);
            PG8_WAIT_X(cc_); PG8_WAIT_L(0); PG8_BAR; PG8_MMA(0, 0, At, B0); PG8_MMA(0, 1, At, B1); PG8_BAR; PG8_SCHED;
            PG8_LDA(At, 1, 1); PG8_STAGE(PG8_SB(1, 0), b3, voffB); PG8_STAGE(PG8_SB(1, 1), b3 + hstepB, voffB); PG8_STAGE(PG8_SA(1, 0), a3, voffA);
            PG8_WAIT_V(8); PG8_WAIT_L(0); PG8_BAR; PG8_MMA(1, 0, At, B0); PG8_MMA(1, 1, At, B1); PG8_BAR; PG8_SCHED;
            } else {
            PG8_LDB(B0, 0, 0); PG8_SCHED; PG8_LDA(At, 0, 0); PG8_STAGE(PG8_SA(1, 1), a1 + hstepA, voffA);
            PG8_WAIT_L(8); PG8_BAR; PG8_WAIT_L(0); PG8_MMA(0, 0, At, B0); PG8_BAR; PG8_SCHED;
            PG8_LDB(B1, 0, 1); PG8_STAGE(PG8_SB(0, 0), b2, voffB);
            PG8_BAR; PG8_WAIT_L(0); PG8_MMA(0, 1, At, B1); PG8_BAR;
            PG8_LDA(At, 0, 1); PG8_STAGE(PG8_SA(0, 0), a2, voffA);
            PG8_BAR; PG8_WAIT_L(0); PG8_MMA(1, 0, At, B0); PG8_BAR; PG8_SCHED;
            PG8_STAGE(PG8_SB(0, 1), b2 + hstepB, voffB);
            PG8_WAIT_V(6); PG8_BAR; PG8_MMA(1, 1, At, B1); PG8_BAR;
            PG8_LDB(B0, 1, 0); PG8_SCHED; PG8_LDA(At, 1, 0); PG8_STAGE(PG8_SA(0, 1), a2 + hstepA, voffA);
            PG8_WAIT_L(8); PG8_BAR; PG8_WAIT_L(0); PG8_MMA(0, 0, At, B0); PG8_BAR; PG8_SCHED;
            PG8_LDB(B1, 1, 1); PG8_STAGE(PG8_SB(1, 0), b3, voffB);
            PG8_BAR; PG8_WAIT_L(0); PG8_MMA(0, 1, At, B1); PG8_BAR;
            PG8_LDA(At, 1, 1); PG8_STAGE(PG8_SA(1, 0), a3, voffA);
            PG8_BAR; PG8_WAIT_L(0); PG8_MMA(1, 0, At, B0); PG8_BAR; PG8_SCHED;
            PG8_STAGE(PG8_SB(1, 1), b3 + hstepB, voffB);
            PG8_WAIT_V(6); PG8_BAR; PG8_MMA(1, 1, At, B1); PG8_BAR;
            }
        }
        if constexpr (ALIGN_EPI) { if (wr == 0) PG8_BAR; }
        if constexpr (!Epi::AFTER_DRAIN) { E(acc, cur, wr, wc, fr, fq); S.done(cur); }
        if (!has_next) break;
        if (!E.keep(cur)) {
#pragma unroll
        for (int a = 0; a < 2; ++a)
#pragma unroll
            for (int b = 0; b < 2; ++b)
#pragma unroll
                for (int m = 0; m < 4; ++m)
#pragma unroll
                    for (int n = 0; n < 2; ++n) acc[a][b][m][n] = (f32x4){0.f, 0.f, 0.f, 0.f};
        }
        cur = nxt; cA = nA; cB = nB; ++ui;
        if constexpr (ALIGN_EPI) { if (wr == 1) PG8_BAR; }
    }
    PG8_WAIT_V(0);
    if constexpr (!ALIGN_EPI) { if (wr == 0) PG8_BAR; }
    PG8_BAR;
    if constexpr (Epi::AFTER_DRAIN) { E.fused(acc, cur, wr, wc, fr, fq, lds, wid, lane); S.done(cur); }
#undef PG8_SA
#undef PG8_SB
#undef PG8_STAGE
#undef PG8_LDA
#undef PG8_LDB
#undef PG8_MMA
#undef PG8_WAIT_V
#undef PG8_WAIT_X
#undef PG8_WAIT_L
#undef PG8_BAR
#undef PG8_SCHED
}

typedef unsigned u32x8 __attribute__((ext_vector_type(8))); typedef int i32x8 __attribute__((ext_vector_type(8)));
constexpr int F8_SCALE_W = 122, F8_SCALE_X = 127;
template <class Epi, class Sched, bool ALIGN_EPI = false, bool SP2 = false, bool CONV = false>
__device__ __forceinline__ void gemm_phase_f8(PG8_LAS unsigned char* lds, const Gemm g, const Sched& S, const Epi& E, ConvCtx* cx = nullptr) {
    int tid_ = threadIdx.x; asm volatile("" : "+v"(tid_));
    const int tid = tid_, wid = __builtin_amdgcn_readfirstlane(tid >> 6), lane = tid & 63, wr = wid >> 2, wc = wid & 3, fr = lane & 15, fq = lane >> 4;
    const int K = g.K, nt = K / BK;
    static_assert(!CONV || SP2, "CONV needs the SP2 loop");
    unsigned voffA[2], voffB[2];
#pragma unroll
    for (int i = 0; i < 2; ++i) { int R, C; stage_rc(tid * 16 + i * 8192, R, C);
        voffA[i] = (unsigned)R * g.lda + (unsigned)C * 2u; voffB[i] = (unsigned)R * g.ldb + (unsigned)C * 2u; }
    const size_t kstep = (size_t)(BK * 2);
    const size_t hstepA = (size_t)HALF * g.lda, hstepB = (size_t)HALF * g.ldb;
    const unsigned ldsw = (unsigned)wid * 1024u;
    const int aoff = lds_byte(wr * 64 + fr, fq * 8), boff = lds_byte(wc * 32 + fr, fq * 8);
#define PG8_SA(b, h) (((b) * 2 + (h)) * HTB)
#define PG8_SB(b, h) ((4 + (b) * 2 + (h)) * HTB)
#define PG8_STAGE(bufoff, gbase, voff) do { _Pragma("unroll") for (int _i = 0; _i < 2; ++_i) \
        __builtin_amdgcn_global_load_lds((const unsigned*)((const char*)(gbase) + (voff)[_i]), (PG8_LAS unsigned*)(lds + (bufoff) + ldsw + _i * 8192), 16, 0, 0); } while (0)
#define PG8_LDA(dst, b, h) do { _Pragma("unroll") for (int m = 0; m < 4; ++m) { const u32x4 lo_ = *(const PG8_LAS u32x4*)(lds + PG8_SA(b, h) + aoff + m * 2048), hi_ = *(const PG8_LAS u32x4*)(lds + PG8_SA(b, h) + aoff + m * 2048 + 1024); dst[m] = __builtin_shufflevector(lo_, hi_, 0, 1, 2, 3, 4, 5, 6, 7); } } while (0)
#define PG8_LDB(dst, b, h) do { _Pragma("unroll") for (int n = 0; n < 2; ++n) { const u32x4 lo_ = *(const PG8_LAS u32x4*)(lds + PG8_SB(b, h) + boff + n * 2048), hi_ = *(const PG8_LAS u32x4*)(lds + PG8_SB(b, h) + boff + n * 2048 + 1024); dst[n] = __builtin_shufflevector(lo_, hi_, 0, 1, 2, 3, 4, 5, 6, 7); } } while (0)
#define PG8_MMA(ai, bj, At, Bt) do { __builtin_amdgcn_s_setprio(1); _Pragma("unroll") for (int m = 0; m < 4; ++m) _Pragma("unroll") for (int n = 0; n < 2; ++n) \
        asm volatile("v_mfma_scale_f32_16x16x128_f8f6f4 %0, %1, %2, %0, %3, %4 op_sel_hi:[0,0,0]" : "+v"(acc[ai][bj][m][n]) : "v"(Bt[n]), "v"(At[m]), "v"(sc_w), "v"(sc_x)); __builtin_amdgcn_s_setprio(0); } while (0)
#define PG8_WAIT_V(n) asm volatile("s_waitcnt vmcnt(" #n ")" ::: "memory")
#define PG8_WAIT_X(n_) do { if constexpr (CONV) { const int x_ = (n_); if (x_ == 5) asm volatile("s_waitcnt vmcnt(13)" ::: "memory"); else if (x_ == 4) asm volatile("s_waitcnt vmcnt(12)" ::: "memory"); \
        else if (x_ == 1) asm volatile("s_waitcnt vmcnt(9)" ::: "memory"); else asm volatile("s_waitcnt vmcnt(8)" ::: "memory"); } else asm volatile("s_waitcnt vmcnt(8)" ::: "memory"); } while (0)
#define PG8_WAIT_L(n) asm volatile("s_waitcnt lgkmcnt(" #n ")" ::: "memory")
#define PG8_BAR __builtin_amdgcn_s_barrier()
#define PG8_SCHED __builtin_amdgcn_sched_barrier(0)
    Unit cur, nxt; int ui = 0;
    if (!S.next(0, cur)) return;
    f32x4 acc[2][2][4][2], nb[2][2];
    E.bias(nb, cur, wc, fq);
#pragma unroll
    for (int a = 0; a < 2; ++a)
#pragma unroll
        for (int b = 0; b < 2; ++b)
#pragma unroll
            for (int m = 0; m < 4; ++m)
#pragma unroll
                for (int n = 0; n < 2; ++n) acc[a][b][m][n] = nb[b][n];
    u32x8 At[4], B0[2], B1[2];
    int sc_w = F8_SCALE_W, sc_x = F8_SCALE_X; asm volatile("" : "+v"(sc_w), "+v"(sc_x));
    const char* cA = cur.a; const char* cB = cur.b;
    S.a_ready(cur);
    if constexpr (SP2) {
        PG8_STAGE(PG8_SB(0, 0), cB, voffB); PG8_STAGE(PG8_SB(0, 1), cB + hstepB, voffB); PG8_STAGE(PG8_SA(0, 0), cA, voffA); PG8_STAGE(PG8_SA(0, 1), cA + hstepA, voffA);
        if (wr == 1) PG8_BAR;
        PG8_WAIT_V(2); PG8_BAR;
        PG8_STAGE(PG8_SB(1, 0), cB + kstep, voffB); PG8_STAGE(PG8_SA(1, 0), cA + kstep, voffA); PG8_STAGE(PG8_SB(1, 1), cB + hstepB + kstep, voffB);
        PG8_WAIT_V(6); PG8_BAR;
    } else {
        PG8_STAGE(PG8_SB(0, 0), cB, voffB); PG8_STAGE(PG8_SA(0, 0), cA, voffA); PG8_STAGE(PG8_SB(0, 1), cB + hstepB, voffB); PG8_STAGE(PG8_SA(0, 1), cA + hstepA, voffA);
        if (wr == 1) PG8_BAR;
        PG8_WAIT_V(4); PG8_BAR;
        PG8_STAGE(PG8_SB(1, 0), cB + kstep, voffB); PG8_STAGE(PG8_SA(1, 0), cA + kstep, voffA); PG8_STAGE(PG8_SB(1, 1), cB + hstepB + kstep, voffB);
        PG8_WAIT_V(6); PG8_BAR;
    }
    for (;;) {
        const bool has_next = S.next(ui + 1, nxt);
        const char* nA = has_next ? nxt.a : cA; const char* nB = has_next ? nxt.b : cB;
        if (has_next) E.bias(nb, nxt, wc, fq);
#pragma unroll 1
        for (int t = 0; t < nt; t += 2) {
            const bool last = (t == nt - 2);
            const char* a1 = cA + (size_t)(t + 1) * kstep;
            const char* a2 = last ? nA : cA + (size_t)(t + 2) * kstep; const char* b2 = last ? nB : cB + (size_t)(t + 2) * kstep;
            const char* a3 = a2 + kstep; const char* b3 = b2 + kstep;
            if (last && has_next) S.a_ready(nxt);
            if constexpr (SP2) {
            int cs_ = 0, cc_ = 0;
            if constexpr (CONV) { if (cx->sub >= 0) { conv_finish(*cx, lds, cx->slot0, lane, cx->sub); cx->sub = -1; cs_ = 1; } PG8_SCHED; }
            PG8_LDB(B0, 0, 0); PG8_LDB(B1, 0, 1); PG8_SCHED; PG8_LDA(At, 0, 0); PG8_STAGE(PG8_SA(1, 1), a1 + hstepA, voffA);
            if constexpr (CONV) { const int s_ = cx->cw + cx->nseq * cx->jn; if (s_ < CONV_NSUB) { conv_issue(*cx, lds, cx->slot0, lane, s_); cx->sub = s_; ++cx->jn; cc_ = 4; } }
            PG8_WAIT_X(cs_ + cc_); PG8_WAIT_L(0); PG8_BAR; PG8_MMA(0, 0, At, B0); PG8_MMA(0, 1, At, B1); PG8_BAR; PG8_SCHED;
            PG8_LDA(At, 0, 1); PG8_STAGE(PG8_SB(0, 0), b2, voffB); PG8_STAGE(PG8_SB(0, 1), b2 + hstepB, voffB); PG8_STAGE(PG8_SA(0, 0), a2, voffA);
            PG8_WAIT_X(cs_ + cc_); PG8_WAIT_L(0); PG8_BAR; PG8_MMA(1, 0, At, B0); PG8_MMA(1, 1, At, B1); PG8_BAR; PG8_SCHED;
            PG8_LDB(B0, 1, 0); PG8_LDB(B1, 1, 1); PG8_SCHED; PG8_LDA(At, 1, 0); PG8_STAGE(PG8_SA(0, 1), a2 + hstepA, voffA);
            PG8_WAIT_X(cc_); PG8_WAIT_L(0); PG8_BAR; PG8_MMA(0, 0, At, B0); PG8_MMA(0, 1, At, B1); PG8_BAR; PG8_SCHED;
            PG8_LDA(At, 1, 1); PG8_STAGE(PG8_SB(1, 0), b3, voffB); PG8_STAGE(PG8_SB(1, 1), b3 + hstepB, voffB); PG8_STAGE(PG8_SA(1, 0), a3, voffA);
            PG8_WAIT_V(8); PG8_WAIT_L(0); PG8_BAR; PG8_MMA(1, 0, At, B0); PG8_MMA(1, 1, At, B1); PG8_BAR; PG8_SCHED;
            } else {
            PG8_LDB(B0, 0, 0); PG8_SCHED; PG8_LDA(At, 0, 0); PG8_STAGE(PG8_SA(1, 1), a1 + hstepA, voffA);
            PG8_WAIT_L(8); PG8_BAR; PG8_WAIT_L(0); PG8_MMA(0, 0, At, B0); PG8_BAR; PG8_SCHED;
            PG8_LDB(B1, 0, 1); PG8_STAGE(PG8_SB(0, 0), b2, voffB);
            PG8_BAR; PG8_WAIT_L(0); PG8_MMA(0, 1, At, B1); PG8_BAR;
            PG8_LDA(At, 0, 1); PG8_STAGE(PG8_SA(0, 0), a2, voffA);
            PG8_BAR; PG8_WAIT_L(0); PG8_MMA(1, 0, At, B0); PG8_BAR; PG8_SCHED;
            PG8_STAGE(PG8_SB(0, 1), b2 + hstepB, voffB);
            PG8_WAIT_V(6); PG8_BAR; PG8_MMA(1, 1, At, B1); PG8_BAR;
            PG8_LDB(B0, 1, 0); PG8_SCHED; PG8_LDA(At, 1, 0); PG8_STAGE(PG8_SA(0, 1), a2 + hstepA, voffA);
            PG8_WAIT_L(8); PG8_BAR; PG8_WAIT_L(0); PG8_MMA(0, 0, At, B0); PG8_BAR; PG8_SCHED;
            PG8_LDB(B1, 1, 1); PG8_STAGE(PG8_SB(1, 0), b3, voffB);
            PG8_BAR; PG8_WAIT_L(0); PG8_MMA(0, 1, At, B1); PG8_BAR;
            PG8_LDA(At, 1, 1); PG8_STAGE(PG8_SA(1, 0), a3, voffA);
            PG8_BAR; PG8_WAIT_L(0); PG8_MMA(1, 0, At, B0); PG8_BAR; PG8_SCHED;
            PG8_STAGE(PG8_SB(1, 1), b3 + hstepB, voffB);
            PG8_WAIT_V(6); PG8_BAR; PG8_MMA(1, 1, At, B1); PG8_BAR;
            }
        }
        if constexpr (ALIGN_EPI) { if (wr == 0) PG8_BAR; }
        if constexpr (Epi::HAS_BIAS) asm volatile("" : "+v"(nb[0][0]), "+v"(nb[0][1]), "+v"(nb[1][0]), "+v"(nb[1][1]));
        asm volatile("s_nop 15\n\ts_nop 15" ::: "memory");
        if constexpr (!Epi::AFTER_DRAIN) { E(acc, cur, wr, wc, fr, fq); S.done(cur); }
        if (!has_next) break;
        if (!E.keep(cur)) {
#pragma unroll
        for (int a = 0; a < 2; ++a)
#pragma unroll
            for (int b = 0; b < 2; ++b)
#pragma unroll
                for (int m = 0; m < 4; ++m)
#pragma unroll
                    for (int n = 0; n < 2; ++n) acc[a][b][m][n] = nb[b][n];
        }
        cur = nxt; cA = nA; cB = nB; ++ui;
        if constexpr (ALIGN_EPI) { if (wr == 1) PG8_BAR; }
    }
    PG8_WAIT_V(0);
    if constexpr (!ALIGN_EPI) { if (wr == 0) PG8_BAR; }
    PG8_BAR;
    if constexpr (Epi::AFTER_DRAIN) { E.fused(acc, cur, wr, wc, fr, fq, lds, wid, lane); S.done(cur); }
#undef PG8_SA
#undef PG8_SB
#undef PG8_STAGE
#undef PG8_LDA
#undef PG8_LDB
#undef PG8_MMA
#undef PG8_WAIT_V
#undef PG8_WAIT_X
#undef PG8_WAIT_L
#undef PG8_BAR
#undef PG8_SCHED
}
}

#include <hip/hip_bf16.h>
#include <cmath>
namespace attn_body {
using bf16=__hip_bfloat16;
using bf16x8=__attribute__((ext_vector_type(8)))short;
using s16x4=__attribute__((ext_vector_type(4)))short;
using f32x16=__attribute__((ext_vector_type(16)))float;
using u32x4=__attribute__((ext_vector_type(4)))unsigned;
constexpr int SEQ=8192,D=64; constexpr int QP=512,KP=512,VP=512,OP=1024;
constexpr int NW=8,QBLK=32,QB=QBLK*NW,KVBLK=64,NQB=SEQ/QB;
constexpr int ATTN_UNIT_ROWS=QB;
__device__ __forceinline__ int crow(int r,int hi){return (r&3)+8*(r>>2)+4*hi;}
#define SBAR() __builtin_amdgcn_sched_barrier(0)
__device__ __forceinline__ void cmask(f32x16&p0,f32x16&p1,int jb,int qrel,int hi){
  const float NEG=-INFINITY; (void)hi;
  if(jb>(qrel>>6)){
  #pragma unroll
  for(int r=0;r<16;++r){p0[r]=NEG;p1[r]=NEG;} }
}

constexpr int NSLOT=3, SLOTB=8192;
constexpr int LDS_K=0, LDS_V=NSLOT*SLOTB, LDS_WS=2*NSLOT*SLOTB, LDS_OST=LDS_WS+NW*64*4, LDS_BYTES=LDS_OST+NW*4096;
constexpr float C2=0.125f*1.4426950408889634f;
__device__ __forceinline__ void glds16(const void*gsrc,unsigned lds_dst){unsigned keep;
  asm volatile("s_mov_b32 %0, m0\n\ts_mov_b32 m0, %2\n\ts_nop 0\n\tglobal_load_lds_dwordx4 %1, off\n\ts_mov_b32 m0, %0":"=&s"(keep):"v"(gsrc),"s"(lds_dst):"memory");}
__device__ __forceinline__ float max3f(float a,float b,float c){float r;asm("v_max3_f32 %0, %1, %2, %3":"=v"(r):"v"(a),"v"(b),"v"(c));return r;}
__device__ __forceinline__ float max2f(float a,float b){float r;asm("v_max_f32_e32 %0, %1, %2":"=v"(r):"v"(a),"v"(b));return r;}
__device__ __forceinline__ float fadd_s(float a,float b){float r;asm("v_add_f32_e32 %0, %1, %2":"=v"(r):"v"(a),"v"(b));return r;}
__device__ __forceinline__ float fsub_s(float a,float b){float r;asm("v_sub_f32_e32 %0, %1, %2":"=v"(r):"v"(a),"v"(b));return r;}
typedef float f32x2_t __attribute__((ext_vector_type(2))); typedef __bf16 bf16x2_t __attribute__((ext_vector_type(2)));
__device__ __forceinline__ unsigned cvtpk_s(float lo,float hi){f32x2_t v={lo,hi};bf16x2_t b=__builtin_convertvector(v,bf16x2_t);return __builtin_bit_cast(unsigned,b);}
#define WAIT_BAR(N) asm volatile("s_waitcnt vmcnt(" #N ") lgkmcnt(0)\n\ts_barrier":::"memory")

__device__ __forceinline__ void qkt(f32x16&p0,f32x16&p1,const char*Kslot,const bf16x8*qr,const f32x16&negm,int r32,int hi){
  const char*kb=Kslot+hi*1024+r32*16;
  #pragma unroll
  for(int d0=0;d0<4;++d0){
    const bf16x8 b0=*reinterpret_cast<const bf16x8*>(kb+d0*2048);
    const bf16x8 b1=*reinterpret_cast<const bf16x8*>(kb+d0*2048+512);
    if(d0==0){p0=__builtin_amdgcn_mfma_f32_32x32x16_bf16(b0,qr[0],negm,0,0,0);p1=__builtin_amdgcn_mfma_f32_32x32x16_bf16(b1,qr[0],negm,0,0,0);}
    else{p0=__builtin_amdgcn_mfma_f32_32x32x16_bf16(b0,qr[d0],p0,0,0,0);p1=__builtin_amdgcn_mfma_f32_32x32x16_bf16(b1,qr[d0],p1,0,0,0);}}
}
typedef __attribute__((address_space(3))) const char* lds_cptr;
typedef short v4i16_t __attribute__((ext_vector_type(4)));
__device__ __forceinline__ void kload8(bf16x8*kf,lds_cptr kp){
  kf[0]=*(const __attribute__((address_space(3))) bf16x8*)(kp);      kf[1]=*(const __attribute__((address_space(3))) bf16x8*)(kp+512);
  kf[2]=*(const __attribute__((address_space(3))) bf16x8*)(kp+2048); kf[3]=*(const __attribute__((address_space(3))) bf16x8*)(kp+2560);
  kf[4]=*(const __attribute__((address_space(3))) bf16x8*)(kp+4096); kf[5]=*(const __attribute__((address_space(3))) bf16x8*)(kp+4608);
  kf[6]=*(const __attribute__((address_space(3))) bf16x8*)(kp+6144); kf[7]=*(const __attribute__((address_space(3))) bf16x8*)(kp+6656);
}
__device__ __forceinline__ void kload2(bf16x8*kf,lds_cptr kp,int j){ kf[2*j]=*(const __attribute__((address_space(3))) bf16x8*)(kp+j*2048); kf[2*j+1]=*(const __attribute__((address_space(3))) bf16x8*)(kp+j*2048+512); }
__device__ __forceinline__ s16x4 vtr(lds_cptr p){ return __builtin_bit_cast(s16x4,__builtin_amdgcn_ds_read_tr16_b64_v4i16((__attribute__((address_space(3))) v4i16_t*)p)); }
__device__ __forceinline__ float rowmax(const f32x16&p0,const f32x16&p1){
  float a=max3f(p0[0],p0[1],p1[0]),b=max3f(p0[2],p0[3],p1[1]);a=max3f(a,p1[2],p1[3]);
  #pragma unroll
  for(int r=4;r<16;r+=4){a=max3f(a,p0[r],p0[r+1]);b=max3f(b,p0[r+2],p0[r+3]);a=max3f(a,p1[r],p1[r+1]);b=max3f(b,p1[r+2],p1[r+3]);}
  const float m=max2f(a,b);
  auto rr=__builtin_amdgcn_permlane32_swap(__float_as_uint(m),__float_as_uint(m),false,false);
  return max2f(__uint_as_float(rr[0]),__uint_as_float(rr[1]));
}
__device__ __forceinline__ void pv(f32x16*o,int vb,bf16x8 pa0,bf16x8 pa1,bf16x8 pa2,bf16x8 pa3){
  #pragma unroll
  for(int d0=0;d0<2;++d0){s16x4 lo[4],hi[4];
    #pragma unroll
    for(int ks=0;ks<4;++ks){
      asm volatile("ds_read_b64_tr_b16 %0,%1 offset:%c2":"=&v"(lo[ks]):"v"(vb),"i"(d0*4096+ks*1024):"memory");
      asm volatile("ds_read_b64_tr_b16 %0,%1 offset:%c2":"=&v"(hi[ks]):"v"(vb),"i"(d0*4096+ks*1024+512):"memory");}
    asm volatile("s_waitcnt lgkmcnt(0)":::"memory");SBAR();
    #define PK(k) (bf16x8){lo[k][0],lo[k][1],lo[k][2],lo[k][3],hi[k][0],hi[k][1],hi[k][2],hi[k][3]}
    o[d0]=__builtin_amdgcn_mfma_f32_32x32x16_bf16(pa0,PK(0),o[d0],0,0,0);
    o[d0]=__builtin_amdgcn_mfma_f32_32x32x16_bf16(pa1,PK(1),o[d0],0,0,0);
    o[d0]=__builtin_amdgcn_mfma_f32_32x32x16_bf16(pa2,PK(2),o[d0],0,0,0);
    o[d0]=__builtin_amdgcn_mfma_f32_32x32x16_bf16(pa3,PK(3),o[d0],0,0,0);
    #undef PK
  }
}

#ifndef ATTN_STORE16
#define ATTN_STORE16(p,v) (*(u32x4*)(p)=(v))
#endif
template<int THRL> __device__ __forceinline__ void attn_unit(int qb,const bf16*Q,const bf16*__restrict__ K,const bf16*__restrict__ V,bf16*O,char*shm){
  int tid_=threadIdx.x; asm volatile("":"+v"(tid_)); const int tid=tid_,lane=tid&63,r32=lane&31,hi=lane>>5; const int wid=__builtin_amdgcn_readfirstlane(tid>>6);
  const int q0=qb*QB;
  const bf16*Qw=Q+(long)(q0+wid*QBLK)*QP;
  const bf16*Kh=K,*Vh=V;
  const unsigned lds0=(unsigned)(uintptr_t)shm;
  float*wsf=(float*)(shm+LDS_WS)+wid*64;
  const bf16*ksrc=Kh+(long)lane*KP+wid*8;
  const bf16*vsrc=Vh+(long)(16*(wid&3)+(lane>>2))*VP+(wid>>2)*32+(lane&3)*8;
  const unsigned kdst=lds0+LDS_K+wid*1024, vdst=lds0+LDS_V+wid*1024;
  #define DMA_K(t,slot) glds16(ksrc+(long)(t)*KVBLK*KP,(unsigned)__builtin_amdgcn_readfirstlane(kdst+(slot)))
  #define DMA_V(t,slot) glds16(vsrc+(long)(t)*KVBLK*VP,(unsigned)__builtin_amdgcn_readfirstlane(vdst+(slot)))
  const int vb0=(int)(lds0+LDS_V)+((lane>>4)&1)*32+(lane&3)*8+(4*hi+((lane&15)>>2))*64;
  const char*Kbase=shm+LDS_K; bf16x8 kf[8];
  const lds_cptr shm3=(lds_cptr)shm; const lds_cptr kp0=shm3+LDS_K+hi*1024+r32*16; const lds_cptr vp0=shm3+LDS_V+((lane>>4)&1)*32+(lane&3)*8+(4*hi+((lane&15)>>2))*64;
  const int NT=(q0+QB)/KVBLK;
  DMA_K(0,0);DMA_V(0,0);DMA_K(1,SLOTB);
  bf16x8 qr[4];
  #pragma unroll
  for(int d0=0;d0<4;++d0)qr[d0]=*reinterpret_cast<const bf16x8*>(&Qw[(long)r32*QP+d0*16+hi*8]);
  float mhat=0.f,l_reg=0.f;f32x16 o[2];o[0]=f32x16{};o[1]=f32x16{};f32x16 negm=f32x16{};asm volatile("":"+v"(negm));
  const int qrel=wid*QBLK+r32;
  #define CMASK(P0,P1,t) do{int jb_=(t)-(NT-4); if(jb_>=0)cmask(P0,P1,jb_,qrel,hi);}while(0)
  bool resc=false;
  #define START(P0,P1) do{ const float rm=rowmax(P0,P1); resc=false; \
    { const float dl=rm; mhat=fadd_s(mhat,dl); \
      _Pragma("unroll") for(int r=0;r<16;++r){P0[r]=fsub_s(P0[r],dl);P1[r]=fsub_s(P1[r],dl);} \
      _Pragma("unroll") for(int r=0;r<16;++r)negm[r]=-mhat; asm volatile("":"+v"(negm)); } \
    _Pragma("unroll") for(int r=0;r<16;++r)P0[r]=__builtin_amdgcn_exp2f(P0[r]); }while(0)
  #define RESC() do{ if(resc){ asm volatile("s_waitcnt lgkmcnt(0)":::"memory"); \
      _Pragma("unroll") for(int d_=0;d_<2;++d_) _Pragma("unroll") for(int r=0;r<16;++r)o[d_][r]*=wsf[crow(r,hi)]; } }while(0)
  f32x16 pA0,pA1,pB0,pB1;
  int sl_prev=0,sl_cur=0,sl_next=SLOTB;
  #define ROT() do{sl_prev=sl_cur;sl_cur=sl_next;sl_next=(sl_next==(NSLOT-1)*SLOTB)?0:sl_next+SLOTB;}while(0)
  DMA_K(2,2*SLOTB);
  WAIT_BAR(3);
  qkt(pA0,pA1,Kbase,qr,negm,r32,hi);asm volatile("s_nop 15\n\ts_nop 7":"+v"(pA0),"+v"(pA1));CMASK(pA0,pA1,0);
  START(pA0,pA1);
  _Pragma("unroll") for(int r=0;r<16;++r)pA1[r]=__builtin_amdgcn_exp2f(pA1[r]);
  WAIT_BAR(0);
  DMA_K(3,0);DMA_V(1,SLOTB);
  ROT();
  kload8(kf,kp0+sl_cur);
  WAIT_BAR(2);
  s16x4 vlo[8],vhi[8]; u32x4 pw0,pw1,pw2,pw3;
  #define PKW(P,B) cvtpk_s(P[B],P[B+1])
  #define PAF(k) __builtin_bit_cast(bf16x8,pw##k)
  #define VFR(i) (bf16x8){vlo[i][0],vlo[i][1],vlo[i][2],vlo[i][3],vhi[i][0],vhi[i][1],vhi[i][2],vhi[i][3]}
  #define PIN(x) asm volatile("":"+v"(x))
  #define MX3(a,b,c) __builtin_fmaxf(__builtin_fmaxf((a),(b)),(c))
  #define GAPA(MF,A0,A1,A2,A3,W0,W1,PW) do{ MF; sacc+=A0; sacc+=A1; sacc+=A2; sacc+=A3; PIN(sacc); W0; W1; PIN(PW); SBAR(); }while(0)
  #define EX(v) __builtin_amdgcn_exp2f(v)
  #define GAPB(MF,X,B) do{ MF; X[B]=EX(X[B]); X[B+1]=EX(X[B+1]); X[B+2]=EX(X[B+2]); X[B+3]=EX(X[B+3]); PIN(X); SBAR(); }while(0)
  #define VRD(i) do{ vlo[i]=vtr(vp_+(((i)>>2)*4096+((i)&3)*1024)); vhi[i]=vtr(vp_+(((i)>>2)*4096+((i)&3)*1024+512)); }while(0)
  #define KRD(G,j) do{ if(G){ kload2(kf,kp0+sl_next,j); SBAR(); } }while(0)
  #define STEP(C0,C1,P0,P1,t,GK,GV,GL) do{ SBAR(); \
    const lds_cptr vp_=vp0+sl_prev; \
    VRD(0); SBAR(); float sacc=(P0[0]+P0[1]); \
    GAPA(C0=__builtin_amdgcn_mfma_f32_32x32x16_bf16(kf[0],qr[0],negm,0,0,0), P0[2],P0[3],P0[4],P0[5],     pw0[0]=PKW(P0,0), pw0[1]=PKW(P0,2), pw0); \
    VRD(4); SBAR(); GAPA(C1=__builtin_amdgcn_mfma_f32_32x32x16_bf16(kf[1],qr[0],negm,0,0,0), P0[6],P0[7],P0[8],P0[9],     pw0[2]=PKW(P0,4), pw0[3]=PKW(P0,6), pw0); \
    VRD(1); SBAR(); GAPA(C0=__builtin_amdgcn_mfma_f32_32x32x16_bf16(kf[2],qr[1],C0,0,0,0),   P0[10],P0[11],P0[12],P0[13], pw1[0]=PKW(P0,8), pw1[1]=PKW(P0,10), pw1); \
    VRD(5); SBAR(); GAPA(C1=__builtin_amdgcn_mfma_f32_32x32x16_bf16(kf[3],qr[1],C1,0,0,0),   P0[14],P0[15],P1[0],P1[1],   pw1[2]=PKW(P0,12),pw1[3]=PKW(P0,14), pw1); \
    VRD(2); SBAR(); GAPA(C0=__builtin_amdgcn_mfma_f32_32x32x16_bf16(kf[4],qr[2],C0,0,0,0),   P1[2],P1[3],P1[4],P1[5],     pw2[0]=PKW(P1,0), pw2[1]=PKW(P1,2), pw2); \
    VRD(6); SBAR(); GAPA(C1=__builtin_amdgcn_mfma_f32_32x32x16_bf16(kf[5],qr[2],C1,0,0,0),   P1[6],P1[7],P1[8],P1[9],     pw2[2]=PKW(P1,4), pw2[3]=PKW(P1,6), pw2); \
    VRD(3); SBAR(); GAPA(C0=__builtin_amdgcn_mfma_f32_32x32x16_bf16(kf[6],qr[3],C0,0,0,0),   P1[10],P1[11],P1[12],P1[13], pw3[0]=PKW(P1,8), pw3[1]=PKW(P1,10), pw3); \
    VRD(7); SBAR(); GAPA(C1=__builtin_amdgcn_mfma_f32_32x32x16_bf16(kf[7],qr[3],C1,0,0,0),   P1[14],P1[15],0.f,0.f,       pw3[2]=PKW(P1,12),pw3[3]=PKW(P1,14), pw3); \
    l_reg+=sacc; \
    if(GK){DMA_K((t)+3,sl_cur);} if(GV){DMA_V((t)+1,sl_next);} \
    CMASK(C0,C1,t); \
    { float a=MX3(C0[0],C0[1],C1[0]),b=MX3(C0[2],C0[3],C1[1]); a=MX3(a,C1[2],C1[3]); \
      _Pragma("unroll") for(int r=4;r<16;r+=4){a=MX3(a,C0[r],C0[r+1]);b=MX3(b,C0[r+2],C0[r+3]);a=MX3(a,C1[r],C1[r+1]);b=MX3(b,C1[r+2],C1[r+3]);} \
      float rm=__builtin_fmaxf(a,b); { auto rr=__builtin_amdgcn_permlane32_swap(__float_as_uint(rm),__float_as_uint(rm),false,false); rm=__builtin_fmaxf(__uint_as_float(rr[0]),__uint_as_float(rr[1])); } \
      resc=false; \
      if(__builtin_expect(__any(rm>(float)THRL),0)){ const float dl=__builtin_fmaxf(rm,0.f); mhat+=dl; \
        _Pragma("unroll") for(int r=0;r<16;++r){C0[r]-=dl;C1[r]-=dl;} \
        _Pragma("unroll") for(int r=0;r<16;++r)negm[r]=-mhat; asm volatile("":"+v"(negm)); \
        const float f=__builtin_amdgcn_exp2f(-dl); l_reg*=f; if(hi==0)wsf[r32]=f; resc=true; } } \
    SBAR(); \
    GAPB(o[0]=__builtin_amdgcn_mfma_f32_32x32x16_bf16(PAF(0),VFR(0),o[0],0,0,0), C0,0); \
    GAPB(o[1]=__builtin_amdgcn_mfma_f32_32x32x16_bf16(PAF(0),VFR(4),o[1],0,0,0), C0,4); \
    KRD(GL,0); GAPB(o[0]=__builtin_amdgcn_mfma_f32_32x32x16_bf16(PAF(1),VFR(1),o[0],0,0,0), C0,8); \
    KRD(GL,1); GAPB(o[1]=__builtin_amdgcn_mfma_f32_32x32x16_bf16(PAF(1),VFR(5),o[1],0,0,0), C0,12); \
    KRD(GL,2); GAPB(o[0]=__builtin_amdgcn_mfma_f32_32x32x16_bf16(PAF(2),VFR(2),o[0],0,0,0), C1,0); \
    KRD(GL,3); GAPB(o[1]=__builtin_amdgcn_mfma_f32_32x32x16_bf16(PAF(2),VFR(6),o[1],0,0,0), C1,4); \
    GAPB(o[0]=__builtin_amdgcn_mfma_f32_32x32x16_bf16(PAF(3),VFR(3),o[0],0,0,0), C1,8); \
    GAPB(o[1]=__builtin_amdgcn_mfma_f32_32x32x16_bf16(PAF(3),VFR(7),o[1],0,0,0), C1,12); \
    }while(0)
  int t=1;
  #undef CMASK
  #define CMASK(P0,P1,t) do{}while(0)
  for(;t+5<NT;t+=2){
    STEP(pB0,pB1,pA0,pA1,t,true,true,true);     WAIT_BAR(2); RESC(); ROT();
    STEP(pA0,pA1,pB0,pB1,t+1,true,true,true);   WAIT_BAR(2); RESC(); ROT();
  }
  #undef CMASK
  #define CMASK(P0,P1,t) do{int jb_=(t)-(NT-4); if(jb_>=0)cmask(P0,P1,jb_,qrel,hi);}while(0)
  #define ENDW(tt) do{ if((tt)+3<NT){WAIT_BAR(2);} else if((tt)+2<NT){WAIT_BAR(1);} else {WAIT_BAR(0);} }while(0)
  for(;t+1<NT;t+=2){
    STEP(pB0,pB1,pA0,pA1,t,(t+3<NT),(t+1<NT),(t+1<NT));       ENDW(t);   RESC(); ROT();
    STEP(pA0,pA1,pB0,pB1,t+1,(t+4<NT),(t+2<NT),(t+2<NT));     ENDW(t+1); RESC(); ROT();
  }
  STEP(pB0,pB1,pA0,pA1,NT-1,false,false,false); RESC();
  { float sacc=pB0[0]+pB0[1]; _Pragma("unroll") for(int r=2;r<16;++r)sacc+=pB0[r]; _Pragma("unroll") for(int r=0;r<16;++r)sacc+=pB1[r]; l_reg+=sacc;
    pw0=(u32x4){PKW(pB0,0),PKW(pB0,2),PKW(pB0,4),PKW(pB0,6)};pw1=(u32x4){PKW(pB0,8),PKW(pB0,10),PKW(pB0,12),PKW(pB0,14)};pw2=(u32x4){PKW(pB1,0),PKW(pB1,2),PKW(pB1,4),PKW(pB1,6)};pw3=(u32x4){PKW(pB1,8),PKW(pB1,10),PKW(pB1,12),PKW(pB1,14)};
    SBAR(); pv(o,vb0+sl_cur,PAF(0),PAF(1),PAF(2),PAF(3)); }
  #undef PKW
  #undef PAF
  #undef VFR
  #undef PIN
  #undef MX3
  #undef GAPA
  #undef GAPB
  #undef EX
  #undef VRD
  #undef KRD
  #undef STEP
  #undef ENDW
  {auto rr=__builtin_amdgcn_permlane32_swap(__float_as_uint(l_reg),__float_as_uint(l_reg),false,false);l_reg=__uint_as_float(rr[0])+__uint_as_float(rr[1]);}
  if(hi==0)wsf[32+r32]=l_reg;asm volatile("s_waitcnt lgkmcnt(0)":::"memory");
  float rli[16];
  #pragma unroll
  for(int r=0;r<16;++r)rli[r]=__builtin_amdgcn_rcpf(wsf[32+crow(r,hi)]);
  bf16*Ow=O+(long)(q0+wid*QBLK)*OP;
  { bf16*stg=(bf16*)(shm+LDS_OST)+wid*2048;
    #pragma unroll
    for(int r=0;r<16;++r){const int orow=crow(r,hi);
      #pragma unroll
      for(int d0=0;d0<2;++d0)stg[orow*64+d0*32+r32]=__float2bfloat16(o[d0][r]*rli[r]);}
    asm volatile("s_waitcnt lgkmcnt(0)":::"memory");
    #pragma unroll
    for(int i=0;i<4;++i){const int row=i*8+(lane>>3),ch=lane&7; const u32x4 v=*(const u32x4*)(stg+row*64+ch*8); ATTN_STORE16(Ow+(long)row*OP+ch*8,v);} }
  asm volatile("s_waitcnt lgkmcnt(0)\n\ts_barrier":::"memory");
  #undef DMA_K
  #undef DMA_V
  #undef CMASK
  #undef START
  #undef RESC
  #undef ROT
}

constexpr int SLOTV=16384, L2_K=0, L2_V=NSLOT*SLOTB, L2_WS=L2_V+NSLOT*SLOTV, L2_BYTES=L2_WS+NW*64*4;
__device__ __forceinline__ void qkt0(f32x16&p0,f32x16&p1,const char*Kslot,const bf16x8*qr,int r32,int hi){
  const char*kb=Kslot+hi*1024+r32*16; const f32x16 z=f32x16{};
  #pragma unroll
  for(int d0=0;d0<4;++d0){
    const bf16x8 b0=*reinterpret_cast<const bf16x8*>(kb+d0*2048);
    const bf16x8 b1=*reinterpret_cast<const bf16x8*>(kb+d0*2048+512);
    if(d0==0){p0=__builtin_amdgcn_mfma_f32_32x32x16_bf16(b0,qr[0],z,0,0,0);p1=__builtin_amdgcn_mfma_f32_32x32x16_bf16(b1,qr[0],z,0,0,0);}
    else{p0=__builtin_amdgcn_mfma_f32_32x32x16_bf16(b0,qr[d0],p0,0,0,0);p1=__builtin_amdgcn_mfma_f32_32x32x16_bf16(b1,qr[d0],p1,0,0,0);}}
}
__device__ __forceinline__ void pv128(f32x16*o,int vb,bf16x8 pa0,bf16x8 pa1,bf16x8 pa2,bf16x8 pa3){
  #pragma unroll
  for(int d0=0;d0<4;++d0){s16x4 lo[4],hi[4];
    #pragma unroll
    for(int ks=0;ks<4;++ks){
      asm volatile("ds_read_b64_tr_b16 %0,%1 offset:%c2":"=&v"(lo[ks]):"v"(vb),"i"(d0*4096+ks*1024):"memory");
      asm volatile("ds_read_b64_tr_b16 %0,%1 offset:%c2":"=&v"(hi[ks]):"v"(vb),"i"(d0*4096+ks*1024+512):"memory");}
    asm volatile("s_waitcnt lgkmcnt(0)":::"memory");SBAR();
    #define PK(k) (bf16x8){lo[k][0],lo[k][1],lo[k][2],lo[k][3],hi[k][0],hi[k][1],hi[k][2],hi[k][3]}
    o[d0]=__builtin_amdgcn_mfma_f32_32x32x16_bf16(pa0,PK(0),o[d0],0,0,0);
    o[d0]=__builtin_amdgcn_mfma_f32_32x32x16_bf16(pa1,PK(1),o[d0],0,0,0);
    o[d0]=__builtin_amdgcn_mfma_f32_32x32x16_bf16(pa2,PK(2),o[d0],0,0,0);
    o[d0]=__builtin_amdgcn_mfma_f32_32x32x16_bf16(pa3,PK(3),o[d0],0,0,0);
    #undef PK
  }
}
template<int THRL> __device__ __forceinline__ void attn_unit128(int qb,const bf16*Q,const bf16*__restrict__ K,const bf16*__restrict__ V,bf16*O,char*shm){
  int tid_=threadIdx.x; asm volatile("":"+v"(tid_)); const int tid=tid_,lane=tid&63,r32=lane&31,hi=lane>>5; const int wid=__builtin_amdgcn_readfirstlane(tid>>6);
  const int q0=qb*QB;
  const bf16*Qw=Q+(long)(q0+wid*QBLK)*QP;
  const unsigned lds0=(unsigned)(uintptr_t)shm;
  float*wsf=(float*)(shm+L2_WS)+wid*64;
  const bf16*ksrc=K+(long)lane*KP+wid*8;
  const bf16*vsrc=V+(long)(16*(wid&3)+(lane>>2))*VP+(wid>>2)*32+(lane&3)*8;
  const unsigned kdst=lds0+L2_K+wid*1024, vdst=lds0+L2_V+wid*1024;
  #define DMA_K(t,slot) glds16(ksrc+(long)(t)*KVBLK*KP,(unsigned)__builtin_amdgcn_readfirstlane(kdst+(slot)))
  #define DMA_V(t,slot) do{ glds16(vsrc+(long)(t)*KVBLK*VP,(unsigned)__builtin_amdgcn_readfirstlane(vdst+2*(slot))); glds16(vsrc+64+(long)(t)*KVBLK*VP,(unsigned)__builtin_amdgcn_readfirstlane(vdst+2*(slot)+8192)); }while(0)
  const int vb0=(int)(lds0+L2_V)+((lane>>4)&1)*32+(lane&3)*8+(4*hi+((lane&15)>>2))*64;
  const char*Kbase=shm+L2_K; bf16x8 kf[8];
  const lds_cptr shm3=(lds_cptr)shm; const lds_cptr kp0=shm3+L2_K+hi*1024+r32*16; const lds_cptr vp0=shm3+L2_V+((lane>>4)&1)*32+(lane&3)*8+(4*hi+((lane&15)>>2))*64;
  const int NT=(q0+QB)/KVBLK;
  DMA_K(0,0);DMA_V(0,0);DMA_K(1,SLOTB);
  bf16x8 qr[4];
  #pragma unroll
  for(int d0=0;d0<4;++d0)qr[d0]=*reinterpret_cast<const bf16x8*>(&Qw[(long)r32*QP+d0*16+hi*8]);
  float l_reg=0.f;f32x16 o[4];
  ;o[0]=f32x16{};o[1]=f32x16{};o[2]=f32x16{};o[3]=f32x16{};
  const int qrel=wid*QBLK+r32;
  #define CMASK(P0,P1,t) do{int jb_=(t)-(NT-4); if(jb_>=0)cmask(P0,P1,jb_,qrel,hi);}while(0)
  #define RESC() do{}while(0)
  f32x16 pA0,pA1,pB0,pB1;
  int sl_prev=0,sl_cur=0,sl_next=SLOTB;
  #define ROT() do{sl_prev=sl_cur;sl_cur=sl_next;sl_next=(sl_next==(NSLOT-1)*SLOTB)?0:sl_next+SLOTB;}while(0)
  DMA_K(2,2*SLOTB);
  WAIT_BAR(4);
  qkt0(pA0,pA1,Kbase,qr,r32,hi);asm volatile("s_nop 15\n\ts_nop 7":"+v"(pA0),"+v"(pA1));CMASK(pA0,pA1,0);
  { _Pragma("unroll") for(int r=0;r<16;++r){pA0[r]=__builtin_amdgcn_exp2f(pA0[r]);pA1[r]=__builtin_amdgcn_exp2f(pA1[r]);} }
  WAIT_BAR(0);
  DMA_K(3,0);DMA_V(1,SLOTB);
  ROT();
  kload8(kf,kp0+sl_cur);
  WAIT_BAR(3);
  s16x4 vlo[8],vhi[8],vlo2[8],vhi2[8]; u32x4 pw0,pw1,pw2,pw3;
  #define PKW(P,B) cvtpk_s(P[B],P[B+1])
  #define PAF(k) __builtin_bit_cast(bf16x8,pw##k)
  #define VFR(i) (bf16x8){vlo[i][0],vlo[i][1],vlo[i][2],vlo[i][3],vhi[i][0],vhi[i][1],vhi[i][2],vhi[i][3]}
  #define VFR2(i) (bf16x8){vlo2[i][0],vlo2[i][1],vlo2[i][2],vlo2[i][3],vhi2[i][0],vhi2[i][1],vhi2[i][2],vhi2[i][3]}
  #define PIN(x) asm volatile("":"+v"(x))
  #define MX3(a,b,c) __builtin_fmaxf(__builtin_fmaxf((a),(b)),(c))
  #define GAPA(MF,A0,A1,A2,A3,W0,W1,PW) do{ MF; sacc+=A0; sacc+=A1; sacc+=A2; sacc+=A3; PIN(sacc); W0; W1; PIN(PW); SBAR(); }while(0)
  #define EX(v) __builtin_amdgcn_exp2f(v)
  #define GAPB(MF,X,B) do{ MF; X[B]=EX(X[B]); X[B+1]=EX(X[B+1]); PIN(X); SBAR(); }while(0)
  #define VRD(i) do{ vlo[i]=vtr(vp_+(((i)>>2)*4096+((i)&3)*1024)); vhi[i]=vtr(vp_+(((i)>>2)*4096+((i)&3)*1024+512)); }while(0)
  #define VRD2(i) do{ vlo2[i]=vtr(vp_+(8192+((i)>>2)*4096+((i)&3)*1024)); vhi2[i]=vtr(vp_+(8192+((i)>>2)*4096+((i)&3)*1024+512)); SBAR(); }while(0)
  #define KRD(G,j) do{ if(G){ kload2(kf,kp0+sl_next,j); SBAR(); } }while(0)
  #define MF32(a,b,c) __builtin_amdgcn_mfma_f32_32x32x16_bf16(a,b,c,0,0,0)
  #define STEP(C0,C1,P0,P1,t,GK,GV,GL) do{ SBAR(); \
    const lds_cptr vp_=vp0+2*sl_prev; const f32x16 z16_=f32x16{}; \
    VRD(0); SBAR(); float sacc=(P0[0]+P0[1]); \
    GAPA(C0=MF32(kf[0],qr[0],z16_), P0[2],P0[3],P0[4],P0[5],     pw0[0]=PKW(P0,0), pw0[1]=PKW(P0,2), pw0); \
    VRD(4); SBAR(); GAPA(C1=MF32(kf[1],qr[0],z16_), P0[6],P0[7],P0[8],P0[9],     pw0[2]=PKW(P0,4), pw0[3]=PKW(P0,6), pw0); \
    VRD(1); SBAR(); GAPA(C0=MF32(kf[2],qr[1],C0),   P0[10],P0[11],P0[12],P0[13], pw1[0]=PKW(P0,8), pw1[1]=PKW(P0,10), pw1); \
    VRD(5); SBAR(); GAPA(C1=MF32(kf[3],qr[1],C1),   P0[14],P0[15],P1[0],P1[1],   pw1[2]=PKW(P0,12),pw1[3]=PKW(P0,14), pw1); \
    VRD(2); SBAR(); GAPA(C0=MF32(kf[4],qr[2],C0),   P1[2],P1[3],P1[4],P1[5],     pw2[0]=PKW(P1,0), pw2[1]=PKW(P1,2), pw2); \
    VRD(6); SBAR(); GAPA(C1=MF32(kf[5],qr[2],C1),   P1[6],P1[7],P1[8],P1[9],     pw2[2]=PKW(P1,4), pw2[3]=PKW(P1,6), pw2); \
    VRD(3); SBAR(); GAPA(C0=MF32(kf[6],qr[3],C0),   P1[10],P1[11],P1[12],P1[13], pw3[0]=PKW(P1,8), pw3[1]=PKW(P1,10), pw3); \
    VRD(7); SBAR(); GAPA(C1=MF32(kf[7],qr[3],C1),   P1[14],P1[15],0.f,0.f,       pw3[2]=PKW(P1,12),pw3[3]=PKW(P1,14), pw3); \
    l_reg+=sacc; \
    if(GK){DMA_K((t)+3,sl_cur);} if(GV){DMA_V((t)+1,sl_next);} \
    CMASK(C0,C1,t); \
    SBAR(); \
    VRD2(0); GAPB(o[0]=MF32(PAF(0),VFR(0),o[0]), C0,0); \
    VRD2(4); GAPB(o[1]=MF32(PAF(0),VFR(4),o[1]), C0,2); \
    VRD2(1); GAPB(o[0]=MF32(PAF(1),VFR(1),o[0]), C0,4); \
    VRD2(5); GAPB(o[1]=MF32(PAF(1),VFR(5),o[1]), C0,6); \
    VRD2(2); GAPB(o[0]=MF32(PAF(2),VFR(2),o[0]), C0,8); \
    VRD2(6); GAPB(o[1]=MF32(PAF(2),VFR(6),o[1]), C0,10); \
    VRD2(3); GAPB(o[0]=MF32(PAF(3),VFR(3),o[0]), C0,12); \
    VRD2(7); GAPB(o[1]=MF32(PAF(3),VFR(7),o[1]), C0,14); \
    GAPB(o[2]=MF32(PAF(0),VFR2(0),o[2]), C1,0); \
    GAPB(o[3]=MF32(PAF(0),VFR2(4),o[3]), C1,2); \
    KRD(GL,0); GAPB(o[2]=MF32(PAF(1),VFR2(1),o[2]), C1,4); \
    KRD(GL,1); GAPB(o[3]=MF32(PAF(1),VFR2(5),o[3]), C1,6); \
    KRD(GL,2); GAPB(o[2]=MF32(PAF(2),VFR2(2),o[2]), C1,8); \
    KRD(GL,3); GAPB(o[3]=MF32(PAF(2),VFR2(6),o[3]), C1,10); \
    GAPB(o[2]=MF32(PAF(3),VFR2(3),o[2]), C1,12); \
    GAPB(o[3]=MF32(PAF(3),VFR2(7),o[3]), C1,14); \
    }while(0)
  int t=1;
  #undef CMASK
  #define CMASK(P0,P1,t) do{}while(0)
  for(;t+5<NT;t+=2){
    STEP(pB0,pB1,pA0,pA1,t,true,true,true);     WAIT_BAR(3); RESC(); ROT();
    STEP(pA0,pA1,pB0,pB1,t+1,true,true,true);   WAIT_BAR(3); RESC(); ROT();
  }
  #undef CMASK
  #define CMASK(P0,P1,t) do{int jb_=(t)-(NT-4); if(jb_>=0)cmask(P0,P1,jb_,qrel,hi);}while(0)
  #define ENDW(tt) do{ if((tt)+3<NT){WAIT_BAR(3);} else if((tt)+2<NT){WAIT_BAR(2);} else {WAIT_BAR(0);} }while(0)
  for(;t+1<NT;t+=2){
    STEP(pB0,pB1,pA0,pA1,t,(t+3<NT),(t+1<NT),(t+1<NT));       ENDW(t);   RESC(); ROT();
    STEP(pA0,pA1,pB0,pB1,t+1,(t+4<NT),(t+2<NT),(t+2<NT));     ENDW(t+1); RESC(); ROT();
  }
  STEP(pB0,pB1,pA0,pA1,NT-1,false,false,false); RESC();
  { float sacc=pB0[0]+pB0[1]; _Pragma("unroll") for(int r=2;r<16;++r)sacc+=pB0[r]; _Pragma("unroll") for(int r=0;r<16;++r)sacc+=pB1[r]; l_reg+=sacc;
    pw0=(u32x4){PKW(pB0,0),PKW(pB0,2),PKW(pB0,4),PKW(pB0,6)};pw1=(u32x4){PKW(pB0,8),PKW(pB0,10),PKW(pB0,12),PKW(pB0,14)};pw2=(u32x4){PKW(pB1,0),PKW(pB1,2),PKW(pB1,4),PKW(pB1,6)};pw3=(u32x4){PKW(pB1,8),PKW(pB1,10),PKW(pB1,12),PKW(pB1,14)};
    SBAR(); pv128(o,vb0+2*sl_cur,PAF(0),PAF(1),PAF(2),PAF(3)); }
  #undef PKW
  #undef PAF
  #undef VFR
  #undef VFR2
  #undef PIN
  #undef MX3
  #undef GAPA
  #undef GAPB
  #undef EX
  #undef VRD
  #undef VRD2
  #undef KRD
  #undef MF32
  #undef STEP
  #undef ENDW
  {auto rr=__builtin_amdgcn_permlane32_swap(__float_as_uint(l_reg),__float_as_uint(l_reg),false,false);l_reg=__uint_as_float(rr[0])+__uint_as_float(rr[1]);}
  if(hi==0)wsf[32+r32]=l_reg;asm volatile("s_waitcnt lgkmcnt(0)":::"memory");
  float rli[16];
  #pragma unroll
  for(int r=0;r<16;++r)rli[r]=__builtin_amdgcn_rcpf(wsf[32+crow(r,hi)]);
  asm volatile("s_waitcnt lgkmcnt(0)\n\ts_barrier":::"memory");
  bf16*Ow=O+(long)(q0+wid*QBLK)*OP;
  { bf16*stg=(bf16*)(shm)+wid*4096;
    #pragma unroll
    for(int r=0;r<16;++r){const int orow=crow(r,hi);
      #pragma unroll
      for(int d0=0;d0<4;++d0)stg[orow*128+d0*32+r32]=__float2bfloat16(o[d0][r]*rli[r]);}
    asm volatile("s_waitcnt lgkmcnt(0)":::"memory");
    #pragma unroll
    for(int i=0;i<8;++i){const int row=i*4+(lane>>4),ch=lane&15; const u32x4 v=*(const u32x4*)(stg+row*128+ch*8); ATTN_STORE16(Ow+(long)row*OP+ch*8,v);} }
  asm volatile("s_waitcnt lgkmcnt(0)\n\ts_barrier":::"memory");
  #undef DMA_K
  #undef DMA_V
  #undef CMASK
  #undef RESC
  #undef ROT
}
constexpr int ATTN_LDS_BYTES=LDS_BYTES;
#undef SBAR
#undef WAIT_BAR
}
#ifndef REPEAT_PHASE
#define REPEAT_PHASE -1
#endif
constexpr int NWAVES = 8;
using cfg::T; using cfg::SEQ; using cfg::D; using cfg::NIN; using cfg::NE; using cfg::EPS; using cfg::MAXROWS;

constexpr size_t MiB = 1u << 20;
constexpr size_t WS_CTL = 0, CTL_ZERO_BYTES = 1 * MiB;
constexpr size_t WS_RCOS = 1 * MiB, WS_RSIN = 2 * MiB;
constexpr size_t WS_TKE = 3 * MiB, WS_TKP = WS_TKE + 256 * 1024, WS_TKG = WS_TKP + 256 * 1024, WS_TSLOT = WS_TKG + 256 * 1024;
constexpr size_t WS_RGATE = 4 * MiB;
constexpr size_t WS_BLKBASE = 4 * MiB + 512 * 1024;
constexpr size_t WS_SSQ = 5 * MiB;
constexpr size_t WS_WIN = 8 * MiB;
constexpr size_t WS_WBR = 23 * MiB;
constexpr size_t WS_WOUT = 26 * MiB;
constexpr size_t WS_WGU = 28 * MiB;
constexpr size_t WS_WDN = 156 * MiB;
constexpr size_t WS_HN = 220 * MiB;
constexpr size_t WS_KVM = 254 * MiB;
constexpr size_t WS_Q = 256 * MiB, WS_K = 272 * MiB, WS_V = 288 * MiB, WS_U = 304 * MiB, WS_CB = 320 * MiB, WS_MQ = 336 * MiB;
constexpr size_t WS_GATES = 352 * MiB;
constexpr size_t WS_OMAPS = 448 * MiB;
constexpr size_t WS_YALL = 480 * MiB;
constexpr size_t WS_MERGED = 528 * MiB;
constexpr size_t WS_H2 = 560 * MiB;
constexpr size_t WS_XS = 256 * MiB;
constexpr size_t WS_ACT = 400 * MiB;
constexpr size_t WS_HN8 = 576 * MiB;
constexpr size_t WS_WG8 = 592 * MiB;
constexpr size_t WS_END = 596 * MiB;
static_assert(WS_XS + (size_t)MAXROWS * 2048 <= WS_ACT && WS_ACT + (size_t)MAXROWS * 2048 <= WS_H2, "MoE overlays");
constexpr int CW_QUEUE = 1024;
constexpr int CW_GCNT = 64;
constexpr int CW_BAR = 4096;
constexpr int RING_OFF = 0, RING_BYTES = 131072;
constexpr int LDSCTL_OFF = RING_BYTES, MISC_OFF = LDSCTL_OFF + 320;
constexpr int L_PREFT = LDSCTL_OFF + 1024, L_PSTART = L_PREFT + 256, L_LCNT = L_PSTART + 256, L_LBASE = L_LCNT + 128;
constexpr int L_PART = LDSCTL_OFF + 8192;
constexpr int MOE_ETAB = (L_PART - L_PREFT) / 4;
constexpr int L_WSF = LDSCTL_OFF + 4096;
constexpr int LDS_BYTES = 163840;
constexpr int CONV_SLOTS = LDSCTL_OFF;

struct NoHooks { __device__ __forceinline__ void a_ready(const pg8::Unit&) const {} __device__ __forceinline__ void done(const pg8::Unit&) const {} };
struct ProjOrder : NoHooks {
    const char* A; const char* Bt; int G, c;
    __device__ __forceinline__ bool next(int i, pg8::Unit& u) const {
        const int L = i * G + c; int pm, pn;
        if (L < 64 * 14) pg8::static_map(L, 64, 14, pm, pn); else if (L < 64 * 14 + 8) { pm = 64 + ((L - 64 * 14) >> 2); pn = 26 + ((L - 64 * 14) & 3); } else return false;
        u.pm = pm; u.pn = pn; u.aux = 0; u.a = A + (size_t)pm * (256 * 2048); u.b = Bt + (size_t)pn * (256 * 2048); return true; }
};
struct GateOrder : NoHooks {
    const char* A; const char* Bt; int G, c;
    __device__ __forceinline__ bool next(int i, pg8::Unit& u) const {
        const int L = i * G + c; if (L >= 64 * 12) return false; int pm, pn; pg8::static_map(L, 64, 12, pm, pn);
        u.pm = pm; u.pn = pn; u.aux = 0; u.a = A + (size_t)pm * (256 * 1024); u.b = Bt + (size_t)pn * (256 * 1024); return true; }
};
struct MergeOrder : NoHooks {
    const char* Y; const char* Bt; int G, c;
    __device__ __forceinline__ bool next(int i, pg8::Unit& u) const {
        const int j = i / 3, br = i - 3 * j; const int L = j * G + c; if (L >= 256) return false; int pm, pn; pg8::static_map(L, 64, 4, pm, pn);
        u.pm = pm; u.pn = pn; u.aux = br; u.a = Y + (size_t)pm * (256 * 3072) + br * 1024; u.b = Bt + (size_t)(br * 1024 + pn * 256) * 1024; return true; }
};
struct OutOrder : NoHooks {
    const char* A; const char* Bt; int G, c;
    __device__ __forceinline__ bool next(int i, pg8::Unit& u) const {
        const int L = i * G + c; if (L >= 256) return false; int pm, pn; pg8::static_map(L, 64, 4, pm, pn);
        u.pm = pm; u.pn = pn; u.aux = 0; u.a = A + (size_t)pm * (256 * 2048); u.b = Bt + (size_t)pn * (256 * 2048); return true; }
};
struct MoeOrder : NoHooks {
    const char* A; const char* Bt; const volatile __attribute__((address_space(3))) int* prefT; int ncol, G, c; size_t tile_bytes;
    __device__ __forceinline__ bool next(int i, pg8::Unit& u) const {
        const int L = i * G + c; const int rt = L / ncol, pnl = L - rt * ncol; if (rt >= prefT[32]) return false;
        const int e = prefT[MOE_ETAB + rt];
        u.pm = rt; u.pn = e * ncol + pnl; u.aux = e; u.a = A + (size_t)rt * tile_bytes; u.b = Bt + (size_t)(e * ncol + pnl) * tile_bytes; return true; }
};

#define GAS __attribute__((address_space(1)))
#define LAS __attribute__((address_space(3)))
typedef unsigned short bf16;
typedef unsigned v4u __attribute__((ext_vector_type(4)));
typedef unsigned v2u __attribute__((ext_vector_type(2)));
typedef float f32x4 __attribute__((ext_vector_type(4)));
typedef float f32x16 __attribute__((ext_vector_type(16)));
typedef short bf16x8 __attribute__((ext_vector_type(8)));
typedef GAS unsigned gu32;
#define RLX_AGENT __ATOMIC_RELAXED, __HIP_MEMORY_SCOPE_AGENT
#define LDS_WAIT() asm volatile("s_waitcnt lgkmcnt(0)" ::: "memory")
#define VM_WAIT() asm volatile("s_waitcnt vmcnt(0)" ::: "memory")
__device__ __forceinline__ unsigned f2bf(float f) { unsigned u = __builtin_bit_cast(unsigned, f); return (u + 0x7fffu + ((u >> 16) & 1u)) >> 16; }
__device__ __forceinline__ unsigned pk2(float lo, float hi) { return f2bf(lo) | (f2bf(hi) << 16); }
__device__ __forceinline__ float bflo(unsigned w) { return __uint_as_float(w << 16); }
__device__ __forceinline__ float bfhi(unsigned w) { return __uint_as_float(w & 0xffff0000u); }
__device__ __forceinline__ float wave_sum(float v) {
#pragma unroll
    for (int o = 1; o < 64; o <<= 1) v += __shfl_xor(v, o);
    return v;
}

#define XB_TMO      128
#define XB_XCNT(j)  (256  + 64 * (j))
#define XB_XSUB(j)  (1280 + 64 * (j))
#define XB_XGEN(j)  (2304 + 64 * (j))
#define XB_TOP      3328
#define XB_TOPGEN   3392
#define XCD_BAR_WORDS 3456
#define XB_SPIN_CAP (1u << 18)

__device__ __forceinline__ unsigned xb_ld(unsigned* p)              { return __hip_atomic_load(p, __ATOMIC_RELAXED, __HIP_MEMORY_SCOPE_AGENT); }
__device__ __forceinline__ unsigned xb_add(unsigned* p, unsigned v) { return __hip_atomic_fetch_add(p, v, __ATOMIC_RELAXED, __HIP_MEMORY_SCOPE_AGENT); }
__device__ __forceinline__ unsigned xb_xcc_id() { return (unsigned)__builtin_amdgcn_s_getreg((3 << 11) | 20) & 0xFu; }
#define XB_SPIN(cond, bar) do { unsigned _sp = 0; while (cond) { __builtin_amdgcn_s_sleep(1); \
    if ((++_sp & 255u) == 0u) { if (xb_ld(&(bar)[XB_TMO])) break; if (_sp > XB_SPIN_CAP) { atomicAdd(&(bar)[XB_TMO], 1u); break; } } } } while (0)

struct XcdBarrier {
    unsigned* bar; unsigned x;
    volatile LAS unsigned* st;
};

__device__ __forceinline__ XcdBarrier xcd_barrier_post(unsigned* bar, volatile LAS unsigned* st) {
    XcdBarrier b; b.bar = bar; b.x = xb_xcc_id(); b.st = st;
    if (threadIdx.x == 0) (void)xb_add(&bar[XB_XCNT(b.x)], 1u);
    return b;
}
__device__ __forceinline__ void xcd_barrier_complete(unsigned* bar, unsigned x, unsigned& nloc, unsigned& nx) {
    const unsigned G = gridDim.x * gridDim.y * gridDim.z;
    unsigned sum, cnt, mine, sp = 0u;
    for (;;) {
        sum = 0u; cnt = 0u; mine = 0u;
#pragma unroll
        for (unsigned j = 0; j < 16; ++j) { const unsigned c = xb_ld(&bar[XB_XCNT(j)]); sum += c; cnt += (c > 0u) ? 1u : 0u; mine = (j == x) ? c : mine; }
        if (sum == G) break;
        __builtin_amdgcn_s_sleep(1);
        if ((++sp & 255u) == 0u) { if (xb_ld(&bar[XB_TMO])) break; if (sp > XB_SPIN_CAP) { atomicAdd(&bar[XB_TMO], 1u); break; } }
    }
    nloc = mine > 0u ? mine : 1u; nx = cnt > 0u ? cnt : 1u;
}

__device__ __forceinline__ void xcd_barrier(const XcdBarrier& b) {
    asm volatile("s_waitcnt vmcnt(0)" ::: "memory");
    __syncthreads();
    if (threadIdx.x == 0) {
        unsigned* bar = b.bar;
        __builtin_amdgcn_s_waitcnt(0);
        unsigned nloc = b.st[0], nx = b.st[1];
        if (nloc == 0u) { xcd_barrier_complete(bar, b.x, nloc, nx); b.st[0] = nloc; b.st[1] = nx; }
        const unsigned old = xb_add(&bar[XB_XSUB(b.x)], 1u);
        const unsigned gen = old / nloc;
        if (old + 1u == (gen + 1u) * nloc) {
            __builtin_amdgcn_fence(__ATOMIC_RELEASE, "agent");
            asm volatile("s_waitcnt vmcnt(0)" ::: "memory");
            const unsigned og = xb_add(&bar[XB_TOP], 1u);
            const unsigned tg = og / nx;
            if (og + 1u == (tg + 1u) * nx) xb_add(&bar[XB_TOPGEN], 1u);
            else XB_SPIN(xb_ld(&bar[XB_TOPGEN]) == tg, bar);
            __builtin_amdgcn_fence(__ATOMIC_ACQUIRE, "agent");
            xb_add(&bar[XB_XGEN(b.x)], 1u);
            asm volatile("s_waitcnt vmcnt(0)" ::: "memory");
        } else {
            XB_SPIN(xb_ld(&bar[XB_XGEN(b.x)]) == gen, bar);
            __builtin_amdgcn_fence(__ATOMIC_ACQUIRE, "agent");
            asm volatile("s_waitcnt vmcnt(0)" ::: "memory");
        }
    }
    __syncthreads();
}

struct Args { const float* in[25]; float* out; unsigned char* ws; int ph_lo, ph_hi; };
__device__ __forceinline__ int ip32(int r) { return 16 * ((r >> 2) & 1) + 4 * (r >> 3) + (r & 3); }
__device__ __forceinline__ void p0_transpose_item(const float* W, int ldn, int K, bf16* WT, int k0, int n0, int dst_row_base, bool perm, LAS float* scr, int lane) {
    float rr_[32];
#pragma unroll
    for (int i = 0; i < 32; ++i) rr_[i] = W[(size_t)(k0 + 2 * i + (lane >> 5)) * ldn + n0 + (lane & 31)];
#pragma unroll
    for (int i = 0; i < 32; ++i) scr[(2 * i + (lane >> 5)) * 33 + (lane & 31)] = rr_[i];
    LDS_WAIT(); asm volatile("" ::: "memory");
    const int c = lane & 7;
#pragma unroll
    for (int j = 0; j < 4; ++j) { const int n = (lane >> 3) + 8 * j; const LAS float* s = scr + (8 * c) * 33 + n;
        v4u o; o.x = pk2(s[0 * 33], s[1 * 33]); o.y = pk2(s[2 * 33], s[3 * 33]); o.z = pk2(s[4 * 33], s[5 * 33]); o.w = pk2(s[6 * 33], s[7 * 33]);
        *(GAS v4u*)(WT + (size_t)(dst_row_base + (perm ? ip32(n) : n)) * K + k0 + 8 * c) = o; }
    LDS_WAIT(); asm volatile("" ::: "memory");
}
__device__ __forceinline__ void p0_f8_load(float (&rr_)[32], const float* W, int ldn, int k0, int n0, int lane) {
#pragma unroll
    for (int i = 0; i < 8; ++i) { const f32x4 v = __builtin_nontemporal_load((const f32x4*)(W + (size_t)(k0 + 8 * i + (lane >> 3)) * ldn + n0 + (lane & 7) * 4));
        rr_[4 * i] = v.x; rr_[4 * i + 1] = v.y; rr_[4 * i + 2] = v.z; rr_[4 * i + 3] = v.w; }
}
__device__ __forceinline__ void p0_f8_finish(const float (&rr_)[32], int K, unsigned char* WT, int k0, int dst_row_base, LAS float* scr, int lane, const float S32) {
#pragma unroll
    for (int i = 0; i < 8; ++i) { LAS float* sp = scr + (8 * i + (lane >> 3)) * 33 + (lane & 7) * 4; sp[0] = rr_[4 * i]; sp[1] = rr_[4 * i + 1]; sp[2] = rr_[4 * i + 2]; sp[3] = rr_[4 * i + 3]; }
    LDS_WAIT(); asm volatile("" ::: "memory");
    const int n = lane >> 1, hf = lane & 1; const LAS float* s = scr + (32 * hf) * 33 + n;
    v4u o0, o1;
    o0.x = pg8::pk4_fp8(S32 * s[0 * 33], S32 * s[1 * 33], S32 * s[2 * 33], S32 * s[3 * 33]); o0.y = pg8::pk4_fp8(S32 * s[4 * 33], S32 * s[5 * 33], S32 * s[6 * 33], S32 * s[7 * 33]);
    o0.z = pg8::pk4_fp8(S32 * s[8 * 33], S32 * s[9 * 33], S32 * s[10 * 33], S32 * s[11 * 33]); o0.w = pg8::pk4_fp8(S32 * s[12 * 33], S32 * s[13 * 33], S32 * s[14 * 33], S32 * s[15 * 33]);
    o1.x = pg8::pk4_fp8(S32 * s[16 * 33], S32 * s[17 * 33], S32 * s[18 * 33], S32 * s[19 * 33]); o1.y = pg8::pk4_fp8(S32 * s[20 * 33], S32 * s[21 * 33], S32 * s[22 * 33], S32 * s[23 * 33]);
    o1.z = pg8::pk4_fp8(S32 * s[24 * 33], S32 * s[25 * 33], S32 * s[26 * 33], S32 * s[27 * 33]); o1.w = pg8::pk4_fp8(S32 * s[28 * 33], S32 * s[29 * 33], S32 * s[30 * 33], S32 * s[31 * 33]);
    GAS v4u* dp = (GAS v4u*)(WT + (size_t)(dst_row_base + ip32(n)) * K + k0 + 32 * hf);
    dp[0] = o0; dp[1] = o1;
    LDS_WAIT(); asm volatile("" ::: "memory");
}
__device__ __forceinline__ void conv_drain(pg8::ConvCtx& c, LAS unsigned char* lds, int wave, int lane) {
    asm volatile("s_waitcnt vmcnt(0)" ::: "memory");
    if (c.sub >= 0) { pg8::conv_finish(c, lds, c.slot0, lane, c.sub); c.sub = -1; }
    __syncthreads();
    const unsigned base = (unsigned)(RING_OFF + wave * 16384);
    int sub[4], aft[4];
#pragma unroll
    for (int i = 0; i < 4; ++i) { sub[i] = -1; aft[i] = 0; }
#pragma unroll
    for (int i = 0; i < 4; ++i) { const int s = c.cw + c.nseq * c.jn;
        if (s < pg8::CONV_NSUB) { pg8::conv_issue(c, lds, base + i * 4096, lane, s); sub[i] = s; ++c.jn;
#pragma unroll
            for (int k = 0; k < 4; ++k) aft[k] += 4;
            aft[i] = 0; } }
    for (;;) {
        bool any = false;
#pragma unroll
        for (int i = 0; i < 4; ++i) {
            if (sub[i] < 0) continue;
            any = true;
            const int a = aft[i];
            if (a >= 15) asm volatile("s_waitcnt vmcnt(15)" ::: "memory"); else if (a >= 12) asm volatile("s_waitcnt vmcnt(12)" ::: "memory");
            else if (a >= 8) asm volatile("s_waitcnt vmcnt(8)" ::: "memory"); else if (a >= 4) asm volatile("s_waitcnt vmcnt(4)" ::: "memory"); else asm volatile("s_waitcnt vmcnt(0)" ::: "memory");
            pg8::conv_finish(c, lds, base + i * 4096, lane, sub[i]); sub[i] = -1;
#pragma unroll
            for (int k = 0; k < 4; ++k) aft[k] += 1;
            const int s = c.cw + c.nseq * c.jn;
            if (s < pg8::CONV_NSUB) { pg8::conv_issue(c, lds, base + i * 4096, lane, s); sub[i] = s; ++c.jn;
#pragma unroll
                for (int k = 0; k < 4; ++k) aft[k] += 4;
                aft[i] = 0; }
        }
        if (!any) break;
    }
}
__device__ __forceinline__ int win_group_base(int L0) {
    if (L0 < 1024) { const int l = L0 & 255; return (L0 & ~255) + 128 * ((l >> 5) & 1) + 32 * (l >> 6); }
    if (L0 < 1536) return L0;
    if (L0 < 2048) return L0 - 1536 + 2560;
    if (L0 < 3072) { const int which = L0 >= 2560, ch = (L0 - 2048) & 511; return 256 * (6 + (ch >> 7)) + 128 * which + 32 * ((ch >> 5) & 3); }
    return L0;
}
__device__ __forceinline__ void rms_row_to_bf16(const float* xrow, const float* g, bf16* orow, int lane, unsigned char* orow8 = nullptr) {
    const GAS f32x4* xr = (const GAS f32x4*)xrow + lane; const GAS f32x4* gr = (const GAS f32x4*)g + lane;
    f32x4 v[4]; float s = 0.f;
#pragma unroll
    for (int j = 0; j < 4; ++j) { v[j] = xr[64 * j]; s += (v[j].x * v[j].x + v[j].y * v[j].y) + (v[j].z * v[j].z + v[j].w * v[j].w); }
    const float r = 1.0f / sqrtf(wave_sum(s) * (1.0f / 1024.0f) + EPS);
    GAS unsigned long long* o8 = (GAS unsigned long long*)orow + lane;
#pragma unroll
    for (int j = 0; j < 4; ++j) { const f32x4 gg = gr[64 * j]; o8[64 * j] = (unsigned long long)pk2(v[j].x * r * gg.x, v[j].y * r * gg.y) | ((unsigned long long)pk2(v[j].z * r * gg.z, v[j].w * r * gg.w) << 32);
        if (orow8) ((GAS unsigned*)orow8)[64 * j + lane] = pg8::pk4_fp8(v[j].x * r * gg.x, v[j].y * r * gg.y, v[j].z * r * gg.z, v[j].w * r * gg.w); }
}


__device__ __forceinline__ void p0_prologue(const Args& a, LAS unsigned char* lds, int vcu, int G, int wave, int lane, int tid) {
    LAS float* scr = (LAS float*)(lds + RING_OFF + wave * 16384);
    const int gw = vcu * NWAVES + wave, NGW = G * NWAVES;
    unsigned char* ws = a.ws;
    constexpr int I_IN = 16 * 112, I_G8 = 16 * 96, I_KV = 16 * 32, I_BR = 3 * 8 * 32, I_OUT = 16 * 32;
    constexpr int NITEMS = I_IN + I_G8 + I_KV + I_BR + I_OUT;
    for (int it = gw; it < NITEMS; it += NGW) {
        int r = it;
        if (r < I_IN) { const int kb = r / 112, nb = r % 112; p0_transpose_item(a.in[3], NIN, 1024, (bf16*)(ws + WS_WIN), 64 * kb, 32 * nb, win_group_base(32 * nb), true, scr, lane); continue; } r -= I_IN;
        if (r < I_G8) { const int kb = r / 96, nb = r % 96; float rr8[32]; p0_f8_load(rr8, a.in[3], NIN, 64 * kb, 3584 + 32 * nb, lane); p0_f8_finish(rr8, 1024, ws + WS_WG8, 64 * kb, 32 * nb, scr, lane, -32.0f * 1.4426950408889634f); continue; } r -= I_G8;
        if (r < I_KV) { const int kb = r / 32, nb = r % 32; p0_transpose_item(a.in[13], 1024, 1024, (bf16*)(ws + WS_WIN), 64 * kb, 32 * nb, 6656 + 32 * nb, true, scr, lane); continue; } r -= I_KV;
        if (r < I_BR) { const int br = r / 256, q = r % 256, kb = q / 32, nb = q % 32; p0_transpose_item(a.in[16] + (size_t)br * 512 * 1024, 1024, 512, (bf16*)(ws + WS_WBR), 64 * kb, 32 * nb, br * 1024 + 32 * nb, true, scr, lane); continue; } r -= I_BR;
        { const int kb = r / 32, nb = r % 32; p0_transpose_item(a.in[17], 1024, 1024, (bf16*)(ws + WS_WOUT), 64 * kb, 32 * nb, 32 * nb, true, scr, lane); }
    }
    bf16* HN = (bf16*)(ws + WS_HN);
    for (int m = gw; m < T + 512; m += NGW) {
        if (m < T) rms_row_to_bf16(a.in[0] + (size_t)m * D, a.in[2], HN + (size_t)m * D, lane, ws + WS_HN8 + (size_t)m * D);
        else rms_row_to_bf16(a.in[1] + (size_t)(m - T) * D, a.in[12], HN + (size_t)m * D, lane);
    }
    float* rc = (float*)(ws + WS_RCOS); float* rs = (float*)(ws + WS_RSIN);
    for (int i = gw * 64 + lane; i < SEQ * 32; i += NGW * 64) { const int pos = i >> 5, f = i & 31;
        const float inv_freq = 1.0f / powf(10000.0f, (float)(2 * f) / 64.0f); const float ang = (float)pos * inv_freq; rc[i] = cosf(ang); rs[i] = sinf(ang); }
}

__device__ __forceinline__ void phase_finish(const Args& a, int vcu, int G, int wave, int lane) {
    unsigned char* ws = a.ws; const int gw = vcu * NWAVES + wave, NGW = G * NWAVES;
    const bf16* OM = (const bf16*)(ws + WS_OMAPS); const bf16* U = (const bf16*)(ws + WS_U); const bf16* CB = (const bf16*)(ws + WS_CB); bf16* Y = (bf16*)(ws + WS_YALL);
    const float lam = expf(wave_sum(a.in[6][lane] * a.in[7][lane])) - expf(wave_sum(a.in[8][lane] * a.in[9][lane])) + 0.2f;
    const int hh = lane >> 4, c8 = (lane & 15) * 8;
    f32x4 gs0 = *(const f32x4*)(a.in[10] + c8), gs1 = *(const f32x4*)(a.in[10] + c8 + 4);
    f32x4 w0a = *(const f32x4*)(a.in[11] + lane * 8), w0b = *(const f32x4*)(a.in[11] + lane * 8 + 4);
    f32x4 w1a = *(const f32x4*)(a.in[11] + 512 + lane * 8), w1b = *(const f32x4*)(a.in[11] + 512 + lane * 8 + 4);
    f32x4 w2a = *(const f32x4*)(a.in[11] + 1024 + lane * 8), w2b = *(const f32x4*)(a.in[11] + 1024 + lane * 8 + 4);
    for (int t = gw; t < T; t += NGW) {
        {
            const v4u o0 = *(const v4u*)(OM + (size_t)t * 1024 + hh * 256 + c8), o1 = *(const v4u*)(OM + (size_t)t * 1024 + hh * 256 + 128 + c8);
            const f32x4 a0 = pg8::unpk_lo(o0) - lam * pg8::unpk_lo(o1), a1 = pg8::unpk_hi(o0) - lam * pg8::unpk_hi(o1);
            float ss = ((a0[0] * a0[0] + a0[1] * a0[1]) + (a0[2] * a0[2] + a0[3] * a0[3])) + ((a1[0] * a1[0] + a1[1] * a1[1]) + (a1[2] * a1[2] + a1[3] * a1[3]));
            ss += __shfl_xor(ss, 1); ss += __shfl_xor(ss, 2); ss += __shfl_xor(ss, 4); ss += __shfl_xor(ss, 8);
            const float r = 0.8f / sqrtf(ss * (1.0f / 128.0f) + EPS);
            *(v4u*)(Y + (size_t)t * 1536 + hh * 128 + c8) = pg8::pack8(a0 * gs0 * r, a1 * gs1 * r);
        }
        {
            const int s = t & (SEQ - 1); const v4u z = {0u, 0u, 0u, 0u};
            const v4u u0 = *(const v4u*)(U + (size_t)t * 512 + lane * 8);
            const v4u u1 = s >= 1 ? *(const v4u*)(U + (size_t)(t - 1) * 512 + lane * 8) : z;
            const v4u u2 = s >= 2 ? *(const v4u*)(U + (size_t)(t - 2) * 512 + lane * 8) : z;
            const v4u cb = *(const v4u*)(CB + (size_t)t * 512 + lane * 8);
            const f32x4 ya = pg8::unpk_lo(cb) * (w0a * pg8::unpk_lo(u2) + w1a * pg8::unpk_lo(u1) + w2a * pg8::unpk_lo(u0));
            const f32x4 yb = pg8::unpk_hi(cb) * (w0b * pg8::unpk_hi(u2) + w1b * pg8::unpk_hi(u1) + w2b * pg8::unpk_hi(u0));
            *(v4u*)(Y + (size_t)t * 1536 + 512 + lane * 8) = pg8::pack8(ya, yb);
        }
    }
}

#define DPPF(x, ctrl) __uint_as_float(__builtin_amdgcn_update_dpp(0u, __float_as_uint(x), (ctrl), 0xf, 0xf, false))
__device__ __forceinline__ float lane_xor32(float x, int lane) { auto r = __builtin_amdgcn_permlane32_swap(__float_as_uint(x), __float_as_uint(x), false, false); return __uint_as_float((lane & 32) ? r[0] : r[1]); }
__device__ __forceinline__ float lane_xor16(float x, int lane) { auto r = __builtin_amdgcn_permlane16_swap(__float_as_uint(x), __float_as_uint(x), false, false); return __uint_as_float((lane & 16) ? r[0] : r[1]); }
__device__ __forceinline__ float wave_sum_fast(float v, int lane) {
    v += DPPF(v, 0xb1); v += DPPF(v, 0x4e); v += DPPF(v, 0x141); v += DPPF(v, 0x140); v += lane_xor16(v, lane); v += lane_xor32(v, lane); return v; }
__device__ __forceinline__ void router_pick(float (&p)[32], int t, float bias, int lane_in, LAS unsigned char* lds, int* tk_e, int* tk_p, float* tk_g) {
    int lane = lane_in; asm volatile("" : "+v"(lane));
#define RSTEP(HN, MASK, XCHG) _Pragma("unroll") for (int i = 0; i < HN; ++i) { const bool up = (lane & MASK) != 0; const float keep = up ? p[i + HN] : p[i]; const float send = up ? p[i] : p[i + HN]; p[i] = keep + XCHG; }
    RSTEP(16, 32, lane_xor32(send, lane)) RSTEP(8, 16, lane_xor16(send, lane)) RSTEP(4, 8, DPPF(send, 0x140)) RSTEP(2, 4, DPPF(send, 0x141)) RSTEP(1, 2, DPPF(send, 0x4e))
#undef RSTEP
    const float logit = p[0] + DPPF(p[0], 0xb1) + bias;
    float val = (lane & 1) ? -INFINITY : logit;
    float tv[4]; int te[4];
#pragma unroll
    for (int r = 0; r < 4; ++r) {
        float m = val;
        m = fmaxf(m, DPPF(m, 0xb1)); m = fmaxf(m, DPPF(m, 0x4e)); m = fmaxf(m, DPPF(m, 0x141)); m = fmaxf(m, DPPF(m, 0x140)); m = fmaxf(m, lane_xor16(m, lane)); m = fmaxf(m, lane_xor32(m, lane));
        const unsigned long long bal = __ballot(val == m);
        const int first = __builtin_ctzll(bal);
        tv[r] = __uint_as_float(__builtin_amdgcn_readfirstlane(__float_as_uint(m))); te[r] = first >> 1;
        val = (lane == first) ? -INFINITY : val;
    }
    const float e1 = expf(tv[1] - tv[0]), e2 = expf(tv[2] - tv[0]), e3 = expf(tv[3] - tv[0]);
    const float is = 1.0f / (1.0f + e1 + e2 + e3);
    if (lane < 4) { const int e = (lane == 0) ? te[0] : (lane == 1) ? te[1] : (lane == 2) ? te[2] : te[3];
        const float gate = (lane == 0) ? is : (lane == 1) ? e1 * is : (lane == 2) ? e2 * is : e3 * is;
        const int lp = __hip_atomic_fetch_add((LAS int*)(lds + L_LCNT) + e, 1, __ATOMIC_RELAXED, __HIP_MEMORY_SCOPE_WORKGROUP);
        tk_e[t * 4 + lane] = e; tk_p[t * 4 + lane] = lp; tk_g[t * 4 + lane] = gate; }
}

__device__ __forceinline__ void phase_router(const Args& a, LAS unsigned char* lds, int vcu, int G, int wave, int lane, int tid, int dummy) {
    unsigned char* ws = a.ws; const int gw = vcu * NWAVES + wave, NGW = G * NWAVES;
    LAS float* Wt = (LAS float*)(lds + RING_OFF);
    volatile LAS int* lcnt = (volatile LAS int*)(lds + L_LCNT);
    const float* wr = a.in[19];
    const float* x1 = a.out;
    f32x4 vn[2][4];
#pragma unroll
    for (int q = 0; q < 2; ++q) { const GAS f32x4* xr = (const GAS f32x4*)(x1 + (size_t)(gw + q * NGW) * D) + lane;
#pragma unroll
        for (int j = 0; j < 4; ++j) vn[q][j] = xr[64 * j]; }
    { f32x4 wf[16];
#pragma unroll
      for (int i = 0; i < 16; ++i) wf[i] = *(const f32x4*)(wr + (size_t)(lane + 64 * i) * 32 + 4 * wave);
#pragma unroll
      for (int i = 0; i < 16; ++i) { const int d = lane + 64 * i;
          Wt[(4 * wave + 0) * 1024 + d] = wf[i].x; Wt[(4 * wave + 1) * 1024 + d] = wf[i].y; Wt[(4 * wave + 2) * 1024 + d] = wf[i].z; Wt[(4 * wave + 3) * 1024 + d] = wf[i].w; } }
    if (tid < 32) lcnt[tid] = 0;
    __syncthreads();
    const float* g = a.in[18]; unsigned char* H2 = ws + WS_H2;
    int* tk_e = (int*)(ws + WS_TKE); int* tk_p = (int*)(ws + WS_TKP); float* tk_g = (float*)(ws + WS_TKG);
    LAS unsigned char* ldsc = lds;
    const float bias = a.in[20][lane >> 1];
    const GAS f32x4* gr = (const GAS f32x4*)g + lane;
    for (int tb = gw; tb < T; tb += 2 * NGW) {
        f32x4 v[2][4];
#pragma unroll
        for (int q = 0; q < 2; ++q)
#pragma unroll
            for (int j = 0; j < 4; ++j) v[q][j] = vn[q][j];
        if (tb + 2 * NGW < T) {
#pragma unroll
            for (int q = 0; q < 2; ++q) { const GAS f32x4* xr = (const GAS f32x4*)(x1 + (size_t)(tb + 2 * NGW + q * NGW) * D) + lane;
#pragma unroll
                for (int j = 0; j < 4; ++j) vn[q][j] = xr[64 * j]; } }
#pragma unroll
        for (int q = 0; q < 2; ++q) { float s = 0.f;
#pragma unroll
            for (int j = 0; j < 4; ++j) s += (v[q][j].x * v[q][j].x + v[q][j].y * v[q][j].y) + (v[q][j].z * v[q][j].z + v[q][j].w * v[q][j].w);
            const float r = 1.0f / sqrtf(wave_sum_fast(s, lane) * (1.0f / 1024.0f) + EPS);
            GAS unsigned* o4 = (GAS unsigned*)(H2 + (size_t)(tb + q * NGW) * D) + lane;
#pragma unroll
            for (int j = 0; j < 4; ++j) { const f32x4 gg = gr[64 * j]; v[q][j].x *= r * gg.x; v[q][j].y *= r * gg.y; v[q][j].z *= r * gg.z; v[q][j].w *= r * gg.w;
                o4[64 * j] = pg8::pk4_fp8(v[q][j].x, v[q][j].y, v[q][j].z, v[q][j].w); } }
        float p0[32], p1[32];
#pragma unroll
        for (int e = 0; e < 32; ++e) { p0[e] = 0.f; p1[e] = 0.f; }
        for (int ps_ = 0; ps_ < (REPEAT_PHASE == 22 ? 2 : 1); ++ps_) {
        f32x4 w[4], wn[4];
        const LAS float* Wl = Wt + 4 * lane; asm volatile("" : "+v"(Wl));
#pragma unroll
        for (int j = 0; j < 4; ++j) w[j] = *(const LAS f32x4*)(Wl + 256 * j);
#pragma unroll
        for (int e = 0; e < 32; ++e) {
            if (e + 1 < 32) {
#pragma unroll
                for (int j = 0; j < 4; ++j) wn[j] = *(const LAS f32x4*)(Wl + (e + 1) * 1024 + 256 * j); }
            asm volatile("" ::: "memory"); __builtin_amdgcn_sched_barrier(0);
            { float a0 = 0.f, a1 = 0.f, b0 = 0.f, b1 = 0.f;
#pragma unroll
              for (int j = 0; j < 4; ++j) { a0 = fmaf(v[0][j].x, w[j].x, a0); a1 = fmaf(v[0][j].y, w[j].y, a1); a0 = fmaf(v[0][j].z, w[j].z, a0); a1 = fmaf(v[0][j].w, w[j].w, a1);
                                            b0 = fmaf(v[1][j].x, w[j].x, b0); b1 = fmaf(v[1][j].y, w[j].y, b1); b0 = fmaf(v[1][j].z, w[j].z, b0); b1 = fmaf(v[1][j].w, w[j].w, b1); }
              p0[e] += a0 + a1; p1[e] += b0 + b1; asm volatile("" : "+v"(p0[e]), "+v"(p1[e])); }
#pragma unroll
            for (int j = 0; j < 4; ++j) w[j] = wn[j];
        }
        }
        if (REPEAT_PHASE == 22) {
#pragma unroll
            for (int e = 0; e < 32; ++e) { p0[e] *= 0.5f; p1[e] *= 0.5f; } }
        router_pick(p0, tb, bias, lane, ldsc, tk_e, tk_p, tk_g);
        router_pick(p1, tb + NGW, bias, lane, ldsc, tk_e, tk_p, tk_g);
    }
    __syncthreads();
    if (tid < 32) ((int*)(ws + WS_BLKBASE))[(dummy ? 8192 : 0) + vcu * 32 + tid] = lcnt[tid];
    __syncthreads();
}

__device__ __forceinline__ void moe_plan(unsigned char* ws, LAS unsigned char* lds, int tid, int vcu, int G) {
    volatile LAS int* prefT = (volatile LAS int*)(lds + L_PREFT); volatile LAS int* pstart = (volatile LAS int*)(lds + L_PSTART); volatile LAS int* lbase = (volatile LAS int*)(lds + L_LBASE);
    volatile LAS int* part = (volatile LAS int*)(lds + L_PART);
    { const int e = tid & 31, pr = tid >> 5; const int* bc = (const int*)(ws + WS_BLKBASE); int tot = 0, pre = 0;
      for (int b = pr; b < G; b += 16) { const int c = bc[b * 32 + e]; tot += c; pre += (b < vcu) ? c : 0; }
      part[pr * 32 + e] = tot; part[512 + pr * 32 + e] = pre; }
    __syncthreads();
    if (tid < 64) { int nt = 0;
        if (tid < 32) { int tot = 0, pre = 0;
#pragma unroll
            for (int pr = 0; pr < 16; ++pr) { tot += part[pr * 32 + tid]; pre += part[512 + pr * 32 + tid]; }
            lbase[tid] = pre; nt = (tot + 255) >> 8; }
        int inc = nt;
#pragma unroll
        for (int o = 1; o < 32; o <<= 1) { const int y = __shfl_up(inc, o); if ((tid & 63) >= o) inc += y; }
        if (tid < 32) { prefT[tid] = inc - nt; pstart[tid] = (inc - nt) * 256; if (tid == 31) { prefT[32] = inc; pstart[32] = inc * 256; }
            if (vcu == 0) { int* gp = (int*)(ws + WS_BLKBASE) + 16384; gp[tid] = inc - nt; if (tid == 31) gp[32] = inc; } } }
    __syncthreads();
}
__device__ __forceinline__ void moe_plan_load(unsigned char* ws, LAS unsigned char* lds, int tid) {
    volatile LAS int* prefT = (volatile LAS int*)(lds + L_PREFT);
    if (tid < 33) prefT[tid] = ((const int*)(ws + WS_BLKBASE))[16384 + tid];
    __syncthreads();
    for (int rt = tid; rt < prefT[32]; rt += NWAVES * 64) { int e = 0; while (prefT[e + 1] <= rt) ++e; prefT[MOE_ETAB + rt] = e; }
    __syncthreads();
}

__device__ __forceinline__ void phase_dispatch(const Args& a, LAS unsigned char* lds, int vcu, int G, int wave, int lane, int tid) {
    unsigned char* ws = a.ws; const int gw = vcu * NWAVES + wave, NGW = G * NWAVES;
    volatile LAS int* pstart = (volatile LAS int*)(lds + L_PSTART); volatile LAS int* lbase = (volatile LAS int*)(lds + L_LBASE);
    moe_plan(ws, lds, tid, vcu, G);
    const unsigned char* H2 = ws + WS_H2; unsigned char* XS = ws + WS_XS;
    const int* tk_e = (const int*)(ws + WS_TKE); const int* tk_p = (const int*)(ws + WS_TKP); const float* tk_g = (const float*)(ws + WS_TKG);
    int* tslot = (int*)(ws + WS_TSLOT); float* rgate = (float*)(ws + WS_RGATE);
    for (int t = gw; t < T; t += NGW) {
        int slot = 0;
        if (lane < 4) { const int e = tk_e[t * 4 + lane]; slot = pstart[e] + lbase[e] + tk_p[t * 4 + lane]; rgate[slot] = tk_g[t * 4 + lane]; tslot[t * 4 + lane] = slot; }
        const v4u r0 = *(const v4u*)(H2 + (size_t)t * D + lane * 16);
#pragma unroll
        for (int k = 0; k < 4; ++k) { const int sk = __builtin_amdgcn_readlane(slot, k); *(v4u*)(XS + (size_t)sk * D + lane * 16) = r0; }
    }
}

__device__ __forceinline__ void phase_combine(const Args& a, int vcu, int G, int wave, int lane, float* dst_out) {
    unsigned char* ws = a.ws; const int gw = vcu * NWAVES + wave, NGW = G * NWAVES;
    const unsigned char* YS = ws + WS_XS; const int* tslot = (const int*)(ws + WS_TSLOT); float* out = a.out;
    for (int t = gw; t < T; t += NGW) {
        int slot = 0; if (lane < 4) slot = tslot[t * 4 + lane];
        const float* op = out + (size_t)t * D + lane * 16; f32x4 o[4];
#pragma unroll
        for (int j = 0; j < 4; ++j) o[j] = *(const f32x4*)(op + 4 * j);
#pragma unroll
        for (int k = 0; k < 4; ++k) { const int sk = __builtin_amdgcn_readlane(slot, k); const v4u y = *(const v4u*)(YS + (size_t)sk * D + lane * 16); const unsigned yw[4] = {y.x, y.y, y.z, y.w};
#pragma unroll
            for (int j = 0; j < 4; ++j) { const auto lo = __builtin_amdgcn_cvt_pk_f32_fp8((int)yw[j], false), hi = __builtin_amdgcn_cvt_pk_f32_fp8((int)yw[j], true);
                o[j][0] += lo[0] * 0.0625f; o[j][1] += lo[1] * 0.0625f; o[j][2] += hi[0] * 0.0625f; o[j][3] += hi[1] * 0.0625f; } }
        float* wp = dst_out + (size_t)t * D + lane * 16;
#pragma unroll
        for (int j = 0; j < 4; ++j) *(f32x4*)(wp + 4 * j) = o[j];
    }
}

__device__ __forceinline__ void memattn_unit(const Args& a, LAS unsigned char* lds, int b, int h, int qb, int wid, int lane, int tid) {
    unsigned char* ws = a.ws;
    const bf16* KVM = (const bf16*)(ws + WS_KVM); const bf16* MQ = (const bf16*)(ws + WS_MQ); const float* ssq = (const float*)(ws + WS_SSQ); bf16* Y = (bf16*)(ws + WS_YALL);
    LAS unsigned char* Ks = lds + RING_OFF;
    LAS unsigned char* Vs = lds + RING_OFF + 65536;
    const int r32 = lane & 31, hi = lane >> 5;
    const size_t qrow = (size_t)b * SEQ + (size_t)qb * 256 + wid * 32 + r32;
    bf16x8 qf[8];
#pragma unroll
    for (int ks = 0; ks < 8; ++ks) qf[ks] = *(const bf16x8*)(MQ + qrow * 512 + h * 128 + 16 * ks + 8 * hi);
    const f32x4 sq = *(const f32x4*)(ssq + qrow * 16 + h * 4);
    {
        const int m = tid >> 1, hf = tid & 1;
        const bf16* kr = KVM + (size_t)(b * 256 + m) * 1024 + h * 128 + hf * 64; const bf16* vr = kr + 512;
        v4u raw[8], vraw[8]; float ss = 0.f;
#pragma unroll
        for (int i = 0; i < 8; ++i) { raw[i] = *(const v4u*)(kr + 8 * i); vraw[i] = *(const v4u*)(vr + 8 * i); }
#pragma unroll
        for (int i = 0; i < 8; ++i) { const f32x4 x0 = pg8::unpk_lo(raw[i]), x1 = pg8::unpk_hi(raw[i]);
            ss += ((x0[0] * x0[0] + x0[1] * x0[1]) + (x0[2] * x0[2] + x0[3] * x0[3])) + ((x1[0] * x1[0] + x1[1] * x1[1]) + (x1[2] * x1[2] + x1[3] * x1[3])); }
        ss += __shfl_xor(ss, 1);
        const float r = 1.0f / sqrtf(ss * (1.0f / 128.0f) + EPS);
#pragma unroll
        for (int i = 0; i < 8; ++i) { const int d0 = hf * 64 + 8 * i; const f32x4 g0 = *(const f32x4*)(a.in[15] + d0) * *(const f32x4*)(a.in[14] + d0), g1 = *(const f32x4*)(a.in[15] + d0 + 4) * *(const f32x4*)(a.in[14] + d0 + 4);
            const int c = hf * 8 + i;
            *(LAS v4u*)(Ks + m * 256 + ((c ^ (m & 15)) << 4)) = pg8::pack8(pg8::unpk_lo(raw[i]) * g0 * r, pg8::unpk_hi(raw[i]) * g1 * r); }
        LAS unsigned char* vt = Vs + (m >> 6) * 16384 + ((m >> 4) & 3) * 1024 + (m & 15) * 64;
#pragma unroll
        for (int i = 0; i < 8; ++i) *(LAS v4u*)(vt + (2 * hf + (i >> 2)) * 4096 + (i & 3) * 16) = vraw[i];
    }
    __syncthreads();
    const float sc = (1.0f / sqrtf(((sq[0] + sq[1]) + (sq[2] + sq[3])) * (1.0f / 128.0f) + EPS)) * 0.08838834764831845f * 1.4426950408889634f;
    f32x16 o[4]; float l = 0.f;
#pragma unroll
    for (int d0 = 0; d0 < 4; ++d0) o[d0] = f32x16{};
    const int vb0 = (int)(unsigned)(uintptr_t)(lds + RING_OFF + 65536) + ((lane >> 4) & 1) * 32 + (lane & 3) * 8 + (4 * hi + ((lane & 15) >> 2)) * 64;
#pragma unroll 1
    for (int kt = 0; kt < 4; ++kt) {
        f32x16 p0 = f32x16{}, p1 = f32x16{};
#pragma unroll
        for (int ks = 0; ks < 8; ++ks) { const int c = 2 * ks + hi; const int k0 = 64 * kt + r32, k1 = k0 + 32;
            const bf16x8 f0 = *(const LAS bf16x8*)(Ks + k0 * 256 + ((c ^ (k0 & 15)) << 4)), f1 = *(const LAS bf16x8*)(Ks + k1 * 256 + ((c ^ (k1 & 15)) << 4));
            p0 = __builtin_amdgcn_mfma_f32_32x32x16_bf16(f0, qf[ks], p0, 0, 0, 0); p1 = __builtin_amdgcn_mfma_f32_32x32x16_bf16(f1, qf[ks], p1, 0, 0, 0); }
#pragma unroll
        for (int r = 0; r < 16; ++r) { p0[r] = __builtin_amdgcn_exp2f(p0[r] * sc); p1[r] = __builtin_amdgcn_exp2f(p1[r] * sc); l += p0[r] + p1[r]; }
        v4u pw[4];
        pw[0] = (v4u){pg8::cvt_pk_bf16(p0[0], p0[1]), pg8::cvt_pk_bf16(p0[2], p0[3]), pg8::cvt_pk_bf16(p0[4], p0[5]), pg8::cvt_pk_bf16(p0[6], p0[7])};
        pw[1] = (v4u){pg8::cvt_pk_bf16(p0[8], p0[9]), pg8::cvt_pk_bf16(p0[10], p0[11]), pg8::cvt_pk_bf16(p0[12], p0[13]), pg8::cvt_pk_bf16(p0[14], p0[15])};
        pw[2] = (v4u){pg8::cvt_pk_bf16(p1[0], p1[1]), pg8::cvt_pk_bf16(p1[2], p1[3]), pg8::cvt_pk_bf16(p1[4], p1[5]), pg8::cvt_pk_bf16(p1[6], p1[7])};
        pw[3] = (v4u){pg8::cvt_pk_bf16(p1[8], p1[9]), pg8::cvt_pk_bf16(p1[10], p1[11]), pg8::cvt_pk_bf16(p1[12], p1[13]), pg8::cvt_pk_bf16(p1[14], p1[15])};
        attn_body::pv128(o, vb0 + kt * 16384, __builtin_bit_cast(bf16x8, pw[0]), __builtin_bit_cast(bf16x8, pw[1]), __builtin_bit_cast(bf16x8, pw[2]), __builtin_bit_cast(bf16x8, pw[3]));
    }
    l += __shfl_xor(l, 32);
    LAS float* wsf = (LAS float*)(lds + L_WSF) + wid * 64;
    if (hi == 0) wsf[r32] = l;
    __syncthreads();
    LAS bf16* stg = (LAS bf16*)(lds + RING_OFF) + wid * 4096;
#pragma unroll
    for (int r = 0; r < 16; ++r) { const int orow = (r & 3) + 8 * (r >> 2) + 4 * hi; const float il = 1.0f / wsf[orow];
#pragma unroll
        for (int d0 = 0; d0 < 4; ++d0) stg[orow * 128 + d0 * 32 + r32] = (bf16)f2bf(o[d0][r] * il); }
    LDS_WAIT();
    bf16* Yw = Y + ((size_t)b * SEQ + (size_t)qb * 256 + wid * 32) * 1536 + 1024 + h * 128;
#pragma unroll
    for (int i = 0; i < 8; ++i) { const int row = i * 4 + (lane >> 4), ch = lane & 15; const v4u v = *(const LAS v4u*)(stg + row * 128 + ch * 8); *(v4u*)(Yw + (size_t)row * 1536 + ch * 8) = v; }
    __syncthreads();
}

__global__ void __launch_bounds__(NWAVES * 64, 2) mega_fwd(Args args) {
    extern __shared__ __attribute__((aligned(16))) unsigned char lds_raw[];
    LAS unsigned char* lds = (LAS unsigned char*)lds_raw;
    volatile LAS unsigned* MISC = (volatile LAS unsigned*)(lds + MISC_OFF);
    int tid = threadIdx.x, lane = tid & 63, wave = __builtin_amdgcn_readfirstlane(tid >> 6);
#define PHASE_LOCALS() do { tid = threadIdx.x; asm volatile("" : "+v"(tid)); lane = tid & 63; wave = __builtin_amdgcn_readfirstlane(tid >> 6); } while (0)
    const int G = gridDim.x; const int bx = blockIdx.x; const int vcu = (G % 8 == 0) ? (bx % 8) * (G / 8) + bx / 8 : bx;
    unsigned char* ws = args.ws;
    gu32* ctl = (gu32*)(ws + WS_CTL);
    for (int u = tid; u < (LDS_BYTES - LDSCTL_OFF) / 4; u += NWAVES * 64) ((LAS unsigned*)(lds + LDSCTL_OFF))[u] = 0u;
    __syncthreads();
    const int ph_lo = args.ph_lo, ph_hi = args.ph_hi;
    XcdBarrier bar; bar.bar = (unsigned*)(ctl + CW_BAR); bar.x = 0; bar.st = nullptr;
    if (ph_hi - ph_lo > 1) bar = xcd_barrier_post((unsigned*)(ctl + CW_BAR), MISC + 8);
#define IN(k) (ph_lo <= (k) && (k) < ph_hi)
#ifndef TS_PHASE
#define TS_PHASE -1
#endif
    unsigned long long* const ts = (unsigned long long*)(ws + WS_CTL + 512 * 1024);
#define STAMP(k) do { if (TS_PHASE >= 0 && bx == 0 && threadIdx.x == 0) ts[(k)] = __builtin_amdgcn_s_memrealtime(); } while (0)
#define GRID_BAR(k) do { if (IN(k) && IN((k) + 1)) xcd_barrier(bar); STAMP((k) + 1); } while (0)
    STAMP(0);

    if (IN(0)) { for (int rep_ = 0; rep_ < (REPEAT_PHASE == 0 ? 2 : 1); ++rep_) { if (rep_) xcd_barrier(bar);
    PHASE_LOCALS();
    p0_prologue(args, lds, vcu, G, wave, lane, tid);
    } }
    GRID_BAR(0);

    if (IN(1)) { for (int rep_ = 0; rep_ < (REPEAT_PHASE == 1 ? 2 : 1); ++rep_) { if (rep_) xcd_barrier(bar);
    PHASE_LOCALS();
    {
        pg8::Gemm g{2048u, 2048u, 1024};
        ProjOrder S; S.A = (const char*)(ws + WS_HN); S.Bt = (const char*)(ws + WS_WIN); S.G = G; S.c = bx;
        pg8::EpiProj E{(bf16*)(ws + WS_Q), (bf16*)(ws + WS_K), (bf16*)(ws + WS_V), (bf16*)(ws + WS_U), (bf16*)(ws + WS_CB), (bf16*)(ws + WS_MQ), (bf16*)(ws + WS_GATES), (bf16*)(ws + WS_KVM),
                       (float*)(ws + WS_SSQ), args.in[4], args.in[5], (const float*)(ws + WS_RCOS), (const float*)(ws + WS_RSIN)};
        const unsigned sv0 = __builtin_amdgcn_readfirstlane(MISC[8]), sv1 = __builtin_amdgcn_readfirstlane(MISC[9]);
        __syncthreads();
        pg8::ConvCtx cx; cx.wgu = args.in[21]; cx.wdn = args.in[23]; cx.ogu = ws + WS_WGU; cx.odn = ws + WS_WDN; cx.cw = bx * NWAVES + wave; cx.nseq = NWAVES * G; cx.jn = 0;
        cx.sub = -1; cx.slot0 = (unsigned)(CONV_SLOTS + wave * 4096);
        pg8::gemm_phase<pg8::EpiProj, ProjOrder, true, true, true>(lds + RING_OFF, g, S, E, &cx);
        { pg8::Gemm g8{1024u, 1024u, 512}; GateOrder S8; S8.A = (const char*)(ws + WS_HN8); S8.Bt = (const char*)(ws + WS_WG8); S8.G = G; S8.c = bx;
          pg8::EpiGates8 E8{ws + WS_GATES};
          pg8::gemm_phase_f8<pg8::EpiGates8, GateOrder, true, true, true>(lds + RING_OFF, g8, S8, E8, &cx); }
        conv_drain(cx, lds, wave, lane);
        __syncthreads();
        for (int u = tid; u < (LDS_BYTES - LDSCTL_OFF) / 4; u += NWAVES * 64) ((LAS unsigned*)(lds + LDSCTL_OFF))[u] = 0u;
        __syncthreads();
        if (tid == 0) { MISC[8] = sv0; MISC[9] = sv1; }
        __syncthreads();
    }
    } }
    GRID_BAR(1);

    if (IN(2)) { for (int rep_ = 0; rep_ < (REPEAT_PHASE == 2 ? 2 : 1); ++rep_) { if (rep_) xcd_barrier(bar);
    PHASE_LOCALS();
    {
        const int cmb = vcu >> 4, s = vcu & 15;
        const int b = cmb >> 3, h = (cmb >> 1) & 3, mp = cmb & 1;
        const attn_body::bf16* Qp = (const attn_body::bf16*)(ws + WS_Q) + (size_t)b * SEQ * 512 + (h * 2 + mp) * 64;
        const attn_body::bf16* Kp = (const attn_body::bf16*)(ws + WS_K) + (size_t)b * SEQ * 512 + (h * 2 + mp) * 64;
        const attn_body::bf16* Vp = (const attn_body::bf16*)(ws + WS_V) + (size_t)b * SEQ * 512 + h * 128;
        attn_body::bf16* Op = (attn_body::bf16*)(ws + WS_OMAPS) + (size_t)b * SEQ * 1024 + (h * 2 + mp) * 128;
#pragma unroll 1
        for (int i = 0; i < 2; ++i) { const int qb = (i == 0) ? s : 31 - s;
            attn_body::attn_unit128<8>(qb, Qp, Kp, Vp, Op, (char*)lds_raw + RING_OFF); }
        memattn_unit(args, lds, vcu >> 7, (vcu >> 5) & 3, vcu & 31, wave, lane, tid);
        if (REPEAT_PHASE == 21) memattn_unit(args, lds, vcu >> 7, (vcu >> 5) & 3, vcu & 31, wave, lane, tid);
    }
    } }
    GRID_BAR(2);

    if (IN(3)) { for (int rep_ = 0; rep_ < (REPEAT_PHASE == 3 ? 2 : 1); ++rep_) { if (rep_) xcd_barrier(bar);
    PHASE_LOCALS();
    phase_finish(args, vcu, G, wave, lane);
    } }
    GRID_BAR(3);

    if (REPEAT_PHASE == 20) { for (int i_ = 0; i_ < 10; ++i_) xcd_barrier(bar); }
    if (IN(4)) { for (int rep_ = 0; rep_ < (REPEAT_PHASE == 4 ? 2 : 1); ++rep_) { if (rep_) xcd_barrier(bar);
    PHASE_LOCALS();
    {
        pg8::Gemm g{3072u, 1024u, 512};
        MergeOrder S; S.Y = (const char*)(ws + WS_YALL); S.Bt = (const char*)(ws + WS_WBR); S.G = G; S.c = bx;
        pg8::EpiMerge E{(const bf16*)(ws + WS_GATES), (bf16*)(ws + WS_MERGED)};
        pg8::gemm_phase<pg8::EpiMerge, MergeOrder, true, true>(lds + RING_OFF, g, S, E);
    }
    } }
    GRID_BAR(4);

    if (IN(5)) { for (int rep_ = 0; rep_ < (REPEAT_PHASE == 5 ? 2 : 1); ++rep_) { if (rep_) xcd_barrier(bar);
    PHASE_LOCALS();
    {
        pg8::Gemm g{2048u, 2048u, 1024};
        OutOrder S; S.A = (const char*)(ws + WS_MERGED); S.Bt = (const char*)(ws + WS_WOUT); S.G = G; S.c = bx;
        pg8::EpiResid E{args.in[0], args.out};
        pg8::gemm_phase<pg8::EpiResid, OutOrder, false, true>(lds + RING_OFF, g, S, E);
    }
    } }
    GRID_BAR(5);

    if (IN(6)) { for (int rep_ = 0; rep_ < (REPEAT_PHASE == 6 ? 2 : 1); ++rep_) { if (rep_) xcd_barrier(bar);
    PHASE_LOCALS();
    phase_router(args, lds, vcu, G, wave, lane, tid, rep_ == 0 && REPEAT_PHASE == 6);
    } }
    GRID_BAR(6);

    if (IN(7)) { for (int rep_ = 0; rep_ < (REPEAT_PHASE == 7 ? 2 : 1); ++rep_) { if (rep_) xcd_barrier(bar);
    PHASE_LOCALS();
    phase_dispatch(args, lds, vcu, G, wave, lane, tid);
    } }
    GRID_BAR(7);

    if (IN(8)) { for (int rep_ = 0; rep_ < (REPEAT_PHASE == 8 ? 2 : 1); ++rep_) { if (rep_) xcd_barrier(bar);
    PHASE_LOCALS();
    {
        pg8::Gemm g{1024u, 1024u, 512};
        moe_plan_load(ws, lds, tid);
        MoeOrder S; S.A = (const char*)(ws + WS_XS); S.Bt = (const char*)(ws + WS_WGU); S.prefT = (const volatile LAS int*)(lds + L_PREFT); S.ncol = 8; S.G = G; S.c = vcu; S.tile_bytes = 256 * 1024;
        pg8::EpiSwiglu E{args.in[22], ws + WS_ACT};
        pg8::gemm_phase_f8<pg8::EpiSwiglu, MoeOrder, true, true>(lds + RING_OFF, g, S, E);
    }
    } }
    GRID_BAR(8);

    if (IN(9)) { for (int rep_ = 0; rep_ < (REPEAT_PHASE == 9 ? 2 : 1); ++rep_) { if (rep_) xcd_barrier(bar);
    PHASE_LOCALS();
    {
        pg8::Gemm g{1024u, 1024u, 512};
        moe_plan_load(ws, lds, tid);
        MoeOrder S; S.A = (const char*)(ws + WS_ACT); S.Bt = (const char*)(ws + WS_WDN); S.prefT = (const volatile LAS int*)(lds + L_PREFT); S.ncol = 4; S.G = G; S.c = vcu; S.tile_bytes = 256 * 1024;
        pg8::EpiDown E{args.in[24], (const float*)(ws + WS_RGATE), ws + WS_XS};
        pg8::gemm_phase_f8<pg8::EpiDown, MoeOrder, true, true>(lds + RING_OFF, g, S, E);
    }
    } }
    GRID_BAR(9);

    if (IN(10)) { for (int rep_ = 0; rep_ < 1; ++rep_) { if (rep_) xcd_barrier(bar);
    PHASE_LOCALS();
    if (REPEAT_PHASE == 10) { phase_combine(args, vcu, G, wave, lane, (float*)(ws + WS_WGU)); xcd_barrier(bar); }
    phase_combine(args, vcu, G, wave, lane, args.out);
    } }
    GRID_BAR(10);

    if (TS_PHASE >= 0) {
        STAMP(11); xcd_barrier(bar);
        const unsigned long long t0 = __hip_atomic_load(ts + (TS_PHASE == 11 ? 0 : TS_PHASE), RLX_AGENT), t1 = __hip_atomic_load(ts + (TS_PHASE == 11 ? 11 : TS_PHASE + 1), RLX_AGENT);
        const float v = (float)(t1 - t0) * (TS_PHASE == 11 ? 1e-4f : 1e-3f);
        for (size_t i = (size_t)bx * 512 + threadIdx.x; i < (size_t)T * D; i += (size_t)G * 512) args.out[i] = v;
    }
#undef GRID_BAR
#undef IN
}

extern "C" void kernel_launch(void* const* d_in, const int* in_sizes, int n_in, void* d_out, int out_size, void* d_ws, size_t ws_size, hipStream_t stream) {
    static int grid = 0;
    if (grid == 0) {
        if (n_in != 25 || out_size != T * D || ws_size < WS_END) { fprintf(stderr, "kernel_launch: unexpected problem shape (n_in %d, out %d, ws %zu)\n", n_in, out_size, ws_size); grid = -1; return; }
        int dev = 0, cus = 0;
        if (hipGetDevice(&dev) != hipSuccess || hipDeviceGetAttribute(&cus, hipDeviceAttributeMultiprocessorCount, dev) != hipSuccess) { grid = -1; return; }
        if (hipFuncSetAttribute((const void*)mega_fwd, hipFuncAttributeMaxDynamicSharedMemorySize, LDS_BYTES) != hipSuccess) { fprintf(stderr, "kernel_launch: hipFuncSetAttribute failed\n"); grid = -1; return; }
        int per_cu = 0;
        if (hipOccupancyMaxActiveBlocksPerMultiprocessor(&per_cu, (const void*)mega_fwd, NWAVES * 64, LDS_BYTES) != hipSuccess || per_cu < 1) fprintf(stderr, "kernel_launch: occupancy query says %d\n", per_cu);
        (void)hipGetLastError();
        grid = cus;
        if (grid != 256) fprintf(stderr, "kernel_launch: built for 256 CUs, device has %d\n", grid);
    }
    if (grid < 0) return;
    if (hipMemsetAsync((char*)d_ws + WS_CTL, 0, CTL_ZERO_BYTES, stream) != hipSuccess) return;
    Args a{};
    for (int i = 0; i < 25; ++i) a.in[i] = (const float*)d_in[i];
    a.out = (float*)d_out; a.ws = (unsigned char*)d_ws;
#ifndef MK_PER_PHASE
#define MK_PER_PHASE 0
#endif
    if (MK_PER_PHASE) { for (int k = 0; k < 11; ++k) { a.ph_lo = k; a.ph_hi = k + 1; hipLaunchKernelGGL(mega_fwd, dim3(grid), dim3(NWAVES * 64), LDS_BYTES, stream, a); } }
    else { a.ph_lo = 0; a.ph_hi = 11; hipLaunchKernelGGL(mega_fwd, dim3(grid), dim3(NWAVES * 64), LDS_BYTES, stream, a); }
}
```

```cpp
#include <hip/hip_runtime.h>
#include <hip/hip_bf16.h>
#include <cstdio>
#include <cstdint>
#include <cmath>

namespace cfg {
constexpr int BATCH = 2, SEQ = 8192, T = BATCH * SEQ, D = 1024, NIN = 6656, NE = 32, NMEM = 256;
constexpr int MAXROWS = 65536 + NE * 256;
constexpr float EPS = 1e-6f;
constexpr float C2 = 0.125f * 1.4426950408889634f;
}

namespace pg8 {
#define PG8_LAS __attribute__((address_space(3)))
typedef unsigned short bf16_t;
typedef short bf16x8 __attribute__((ext_vector_type(8)));
typedef float f32x4 __attribute__((ext_vector_type(4)));
typedef unsigned u32x4 __attribute__((ext_vector_type(4)));
typedef unsigned u32x2 __attribute__((ext_vector_type(2)));
constexpr int BM = 256, BK = 64, HALF = 128, HTB = HALF * BK * 2  , STAGE_BYTES = 8 * HTB, NXCD = 8, WGM = 8;

__host__ __device__ __forceinline__ int lds_byte(int r, int c) { const int st = (r >> 4) * 2 + (c >> 5), rr = r & 15, cc = c & 31, ob = rr * 64 + cc * 2; return st * 1024 + (ob ^ (((ob >> 9) & 1) << 5)); }
__host__ __device__ __forceinline__ void stage_rc(int b, int& R, int& C) { const int st = b / 1024, sb = b % 1024, swz = sb ^ (((sb >> 9) & 1) << 5); R = (st >> 1) * 16 + swz / 64; C = (st & 1) * 32 + (swz % 64) / 2; }

struct Unit { int pm, pn, aux; const char* a; const char* b; };
struct Gemm { unsigned lda, ldb; int K; };

__device__ __forceinline__ void static_map(int L, int nM, int nN, int& pm, int& pn) {
    const int nwg = nM * nN; int wgid = L; { const int q = nwg / NXCD, r = nwg % NXCD, xcd = wgid % NXCD, off = wgid / NXCD; wgid = (xcd < r ? xcd * (q + 1) : r * (q + 1) + (xcd - r) * q) + off; }
    const int nig = WGM * nN, gid = wgid / nig, fm = gid * WGM, gsz = (nM - fm) < WGM ? (nM - fm) : WGM;
    pm = fm + ((wgid % nig) % gsz); pn = (wgid % nig) / gsz;
}

typedef float f32x2_cv __attribute__((ext_vector_type(2))); typedef __bf16 bf16x2_cv __attribute__((ext_vector_type(2)));
__device__ __forceinline__ unsigned cvt_pk_bf16(float lo, float hi) { f32x2_cv v = {lo, hi}; bf16x2_cv b = __builtin_convertvector(v, bf16x2_cv); return __builtin_bit_cast(unsigned, b); }
__device__ __forceinline__ u32x4 pack8(const f32x4 v0, const f32x4 v1) { u32x4 w; w.x = cvt_pk_bf16(v0[0], v0[1]); w.y = cvt_pk_bf16(v0[2], v0[3]); w.z = cvt_pk_bf16(v1[0], v1[1]); w.w = cvt_pk_bf16(v1[2], v1[3]); return w; }
__device__ __forceinline__ f32x4 unpk_lo(const u32x4 w) { return (f32x4){__uint_as_float(w.x << 16), __uint_as_float(w.x & 0xffff0000u), __uint_as_float(w.y << 16), __uint_as_float(w.y & 0xffff0000u)}; }
__device__ __forceinline__ f32x4 unpk_hi(const u32x4 w) { return (f32x4){__uint_as_float(w.z << 16), __uint_as_float(w.z & 0xffff0000u), __uint_as_float(w.w << 16), __uint_as_float(w.w & 0xffff0000u)}; }
__device__ __forceinline__ unsigned pk4_fp8(float a, float b, float c, float d) { int w = 0; w = __builtin_amdgcn_cvt_pk_fp8_f32(a, b, w, false); w = __builtin_amdgcn_cvt_pk_fp8_f32(c, d, w, true); return (unsigned)w; }
__device__ __forceinline__ float sigmoidf_fast(float z) { return __builtin_amdgcn_rcpf(1.0f + __builtin_amdgcn_exp2f(-1.4426950408889634f * z)); }

using cfg::T; using cfg::SEQ; using cfg::EPS;

struct EpiProj {
    static constexpr bool AFTER_DRAIN = false;
    bf16_t *Q, *K, *V, *U, *CB, *MQ, *GATES, *KVM; float* ssq; const float *gq, *gk, *rcos, *rsin;
    __device__ __forceinline__ bool keep(const Unit&) const { return false; }
    __device__ __forceinline__ void operator()(f32x4 (&acc)[2][2][4][2], const Unit& u, int wr, int wc, int fr, int fq) const {
        const int pn = u.pn; const int row0 = u.pm * BM + wr * 64 + fr;
        if (pn < 4) {
            const bool isk = pn >= 2; const float* g = isk ? gk : gq; bf16_t* dst = (isk ? K : Q) + (pn & 1) * 256 + wc * 64 + 8 * fq;
            const float post = isk ? 1.0f : cfg::C2;
            f32x4 ga[2][2];
#pragma unroll
            for (int bj = 0; bj < 2; ++bj)
#pragma unroll
                for (int n = 0; n < 2; ++n) ga[bj][n] = *(const f32x4*)(g + 32 * bj + 8 * fq + 4 * n);
#pragma unroll
            for (int ai = 0; ai < 2; ++ai)
#pragma unroll
                for (int m = 0; m < 4; ++m) {
                    const int row = row0 + ai * HALF + m * 16;
                    float ss = 0.f;
#pragma unroll
                    for (int bj = 0; bj < 2; ++bj)
#pragma unroll
                        for (int n = 0; n < 2; ++n) { const f32x4 x = acc[ai][bj][m][n]; ss += (x[0] * x[0] + x[1] * x[1]) + (x[2] * x[2] + x[3] * x[3]); }
                    ss += __shfl_xor(ss, 16); ss += __shfl_xor(ss, 32);
                    const float rinv = __builtin_amdgcn_rsqf(ss * (1.0f / 64.0f) + EPS) * post;
                    const int pos = row & (SEQ - 1);
                    f32x4 o1[2], o2[2];
#pragma unroll
                    for (int n = 0; n < 2; ++n) {
                        const f32x4 c = *(const f32x4*)(rcos + pos * 32 + 8 * fq + 4 * n), s = *(const f32x4*)(rsin + pos * 32 + 8 * fq + 4 * n);
                        const f32x4 x1 = acc[ai][0][m][n] * ga[0][n] * rinv, x2 = acc[ai][1][m][n] * ga[1][n] * rinv;
                        o1[n] = x1 * c - x2 * s; o2[n] = x2 * c + x1 * s;
                    }
                    *(u32x4*)(dst + (size_t)row * 512) = pack8(o1[0], o1[1]);
                    *(u32x4*)(dst + (size_t)row * 512 + 32) = pack8(o2[0], o2[1]);
                }
        } else if (pn >= 6 && pn < 10) {
            bf16_t* dst = U + (pn - 6) * 128 + wc * 32 + 8 * fq;
#pragma unroll
            for (int ai = 0; ai < 2; ++ai)
#pragma unroll
                for (int m = 0; m < 4; ++m) { const int row = row0 + ai * HALF + m * 16;
                    *(u32x4*)(dst + (size_t)row * 512) = pack8(acc[ai][0][m][0] * acc[ai][1][m][0], acc[ai][0][m][1] * acc[ai][1][m][1]); }
        } else if (pn >= 14 && pn < 26) {
            unsigned char* dst = (unsigned char*)GATES + ((size_t)(u.pm * 12 + (pn - 14)) << 16) + (((wr * 4 + wc) * 64 + fq * 16 + fr) << 3);
#pragma unroll
            for (int ai = 0; ai < 2; ++ai)
#pragma unroll
                for (int m = 0; m < 4; ++m) {
#pragma unroll
                    for (int bj = 0; bj < 2; ++bj) { const f32x4 v0 = acc[ai][bj][m][0], v1 = acc[ai][bj][m][1]; unsigned q[8];
#pragma unroll
                        for (int e = 0; e < 4; ++e) { q[e] = (unsigned)(sigmoidf_fast(v0[e]) * 255.0f + 0.5f); q[4 + e] = (unsigned)(sigmoidf_fast(v1[e]) * 255.0f + 0.5f); }
                        u32x2 w8; w8.x = q[0] | (q[1] << 8) | (q[2] << 16) | (q[3] << 24); w8.y = q[4] | (q[5] << 8) | (q[6] << 16) | (q[7] << 24);
                        *(u32x2*)(dst + ((((ai * 4 + m) * 2 + bj) * 512) << 3)) = w8; } }
        } else {
            bf16_t* dst; int ld, rsub = 0; const bool ismq = (pn == 12 || pn == 13);
            if (pn < 6) { dst = V + (pn - 4) * 256; ld = 512; } else if (pn < 12) { dst = CB + (pn - 10) * 256; ld = 512; }
            else if (pn < 14) { dst = MQ + (pn - 12) * 256; ld = 512; } else { dst = KVM + (pn - 26) * 256; ld = 1024; rsub = T; }
            dst += wc * 32 + 8 * fq;
#pragma unroll
            for (int ai = 0; ai < 2; ++ai)
#pragma unroll
                for (int m = 0; m < 4; ++m) { const int row = row0 + ai * HALF + m * 16 - rsub;
#pragma unroll
                    for (int bj = 0; bj < 2; ++bj) { const f32x4 v0 = acc[ai][bj][m][0], v1 = acc[ai][bj][m][1];
                        *(u32x4*)(dst + (size_t)row * ld + bj * HALF) = pack8(v0, v1);
                        if (ismq) { float ss = ((v0[0] * v0[0] + v0[1] * v0[1]) + (v0[2] * v0[2] + v0[3] * v0[3])) + ((v1[0] * v1[0] + v1[1] * v1[1]) + (v1[2] * v1[2] + v1[3] * v1[3]));
                            ss += __shfl_xor(ss, 16); ss += __shfl_xor(ss, 32);
                            if (fq == 0) ssq[(size_t)row * 16 + ((pn - 12) * 2 + bj) * 4 + wc] = ss; } } }
        }
    }
};

struct EpiGates8 {
    static constexpr bool AFTER_DRAIN = false, HAS_BIAS = false;
    unsigned char* GATES;
    __device__ __forceinline__ bool keep(const Unit&) const { return false; }
    __device__ __forceinline__ void bias(f32x4 (&nb)[2][2], const Unit&, int, int) const { nb[0][0] = nb[0][1] = nb[1][0] = nb[1][1] = (f32x4){0.f, 0.f, 0.f, 0.f}; }
    __device__ __forceinline__ void operator()(f32x4 (&acc)[2][2][4][2], const Unit& u, int wr, int wc, int fr, int fq) const {
        {
            float t_ = 0.75f; asm volatile("" : "+v"(t_)); const float half = ((__builtin_amdgcn_cvt_pk_u8_f32(t_, 0, 0u) & 255u) == 0u) ? 0.5f : 0.0f;
            unsigned char* dst = (unsigned char*)GATES + ((size_t)(u.pm * 12 + u.pn) << 16) + (((wr * 4 + wc) * 64 + fq * 16 + fr) << 3);
#pragma unroll
            for (int ai = 0; ai < 2; ++ai)
#pragma unroll
                for (int m = 0; m < 4; ++m) {
#pragma unroll
                    for (int bj = 0; bj < 2; ++bj) { const f32x4 v0 = acc[ai][bj][m][0], v1 = acc[ai][bj][m][1]; u32x2 w8 = {0u, 0u};
#pragma unroll
                        for (int e = 0; e < 4; ++e) {
                            w8.x = __builtin_amdgcn_cvt_pk_u8_f32(__builtin_amdgcn_rcpf(__builtin_fmaf(__builtin_amdgcn_exp2f(v0[e]), 1.0f / 255.0f, 1.0f / 255.0f)) + half, e, w8.x);
                            w8.y = __builtin_amdgcn_cvt_pk_u8_f32(__builtin_amdgcn_rcpf(__builtin_fmaf(__builtin_amdgcn_exp2f(v1[e]), 1.0f / 255.0f, 1.0f / 255.0f)) + half, e, w8.y); }
                        *(u32x2*)(dst + ((((ai * 4 + m) * 2 + bj) * 512) << 3)) = w8; } }
        }
    }
};

struct EpiMerge {
    static constexpr bool AFTER_DRAIN = false;
    const bf16_t* GATES; bf16_t* MERGED;
    __device__ __forceinline__ bool keep(const Unit& u) const { return u.aux < 2; }
    __device__ __forceinline__ void operator()(f32x4 (&acc)[2][2][4][2], const Unit& u, int wr, int wc, int fr, int fq) const {
        const int br = u.aux; const int row0 = u.pm * BM + wr * 64 + fr, col0 = u.pn * BM + wc * 32 + 8 * fq;
        const unsigned char* ga_p = (const unsigned char*)GATES + ((size_t)(u.pm * 12 + br * 4 + u.pn) << 16) + (((wr * 4 + wc) * 64 + fq * 16 + fr) << 3);
        const unsigned char* gb_p = ga_p + ((size_t)4 << 16);
        u32x2 gav[16], gbv[16];
#pragma unroll
        for (int i = 0; i < 16; ++i) gav[i] = __builtin_nontemporal_load((const u32x2*)(ga_p + ((i * 512) << 3)));
        if (br < 2) {
#pragma unroll
            for (int i = 0; i < 16; ++i) gbv[i] = __builtin_nontemporal_load((const u32x2*)(gb_p + ((i * 512) << 3))); }
        else {
#pragma unroll
            for (int i = 0; i < 16; ++i) gbv[i] = (u32x2){0u, 0u}; }
        __builtin_amdgcn_sched_barrier(0);
#pragma unroll
        for (int ai = 0; ai < 2; ++ai)
#pragma unroll
            for (int m = 0; m < 4; ++m) { const int row = row0 + ai * HALF + m * 16;
#pragma unroll
                for (int bj = 0; bj < 2; ++bj) { const u32x2 ga = gav[(ai * 4 + m) * 2 + bj];
                    f32x4 f0 = {(float)(ga.x & 255u), (float)((ga.x >> 8) & 255u), (float)((ga.x >> 16) & 255u), (float)(ga.x >> 24)}, f1 = {(float)(ga.y & 255u), (float)((ga.y >> 8) & 255u), (float)((ga.y >> 16) & 255u), (float)(ga.y >> 24)};
                    if (br < 2) { const u32x2 gb = gbv[(ai * 4 + m) * 2 + bj];
                        const f32x4 d0 = {(float)__builtin_elementwise_max(gb.x & 255u, 1u), (float)__builtin_elementwise_max((gb.x >> 8) & 255u, 1u), (float)__builtin_elementwise_max((gb.x >> 16) & 255u, 1u), (float)__builtin_elementwise_max(gb.x >> 24, 1u)};
                        const f32x4 d1 = {(float)__builtin_elementwise_max(gb.y & 255u, 1u), (float)__builtin_elementwise_max((gb.y >> 8) & 255u, 1u), (float)__builtin_elementwise_max((gb.y >> 16) & 255u, 1u), (float)__builtin_elementwise_max(gb.y >> 24, 1u)};
                        if (br == 1) {
#pragma unroll
                            for (int e = 0; e < 4; ++e) { f0[e] = __builtin_fmaxf(f0[e], 1.0f); f1[e] = __builtin_fmaxf(f1[e], 1.0f); } }
#pragma unroll
                        for (int e = 0; e < 4; ++e) { f0[e] *= __builtin_amdgcn_rcpf(d0[e]); f1[e] *= __builtin_amdgcn_rcpf(d1[e]); } }
                    else {
#pragma unroll
                        for (int e = 0; e < 4; ++e) { f0[e] = __builtin_fmaxf(f0[e], 1.0f) * (1.0f / 255.0f); f1[e] = __builtin_fmaxf(f1[e], 1.0f) * (1.0f / 255.0f); } }
                    acc[ai][bj][m][0] *= f0; acc[ai][bj][m][1] *= f1;
                    if (br == 2) *(u32x4*)(MERGED + (size_t)row * 1024 + col0 + bj * HALF) = pack8(acc[ai][bj][m][0], acc[ai][bj][m][1]);
                } }
    }
};

struct EpiResid {
    static constexpr bool AFTER_DRAIN = false;
    const float* base; float* out;
    __device__ __forceinline__ bool keep(const Unit&) const { return false; }
    __device__ __forceinline__ void operator()(f32x4 (&acc)[2][2][4][2], const Unit& u, int wr, int wc, int fr, int fq) const {
        const int row0 = u.pm * BM + wr * 64 + fr, col0 = u.pn * BM + wc * 32 + 8 * fq;
#pragma unroll
        for (int ai = 0; ai < 2; ++ai)
#pragma unroll
            for (int mp = 0; mp < 2; ++mp) {
                f32x4 xv[2][2][2];
#pragma unroll
                for (int mm = 0; mm < 2; ++mm) { const size_t off = (size_t)(row0 + ai * HALF + (2 * mp + mm) * 16) * 1024 + col0;
#pragma unroll
                    for (int bj = 0; bj < 2; ++bj)
#pragma unroll
                        for (int n = 0; n < 2; ++n) xv[mm][bj][n] = __builtin_nontemporal_load((const f32x4*)(base + off + bj * HALF + n * 4)); }
                __builtin_amdgcn_sched_barrier(0);
#pragma unroll
                for (int mm = 0; mm < 2; ++mm) { const int m = 2 * mp + mm; const size_t off = (size_t)(row0 + ai * HALF + m * 16) * 1024 + col0;
#pragma unroll
                    for (int bj = 0; bj < 2; ++bj)
#pragma unroll
                        for (int n = 0; n < 2; ++n) *(f32x4*)(out + off + bj * HALF + n * 4) = xv[mm][bj][n] + acc[ai][bj][m][n]; }
                __builtin_amdgcn_sched_barrier(0); }
    }
};

struct EpiSwiglu {
    static constexpr bool AFTER_DRAIN = false, HAS_BIAS = true;
    const float* bgu; unsigned char* ACT;
    __device__ __forceinline__ bool keep(const Unit&) const { return false; }
    __device__ __forceinline__ void bias(f32x4 (&nb)[2][2], const Unit& u, int wc, int fq) const {
        const int e_ = u.pn >> 3, ch0 = (u.pn & 7) * 128 + wc * 32 + 8 * fq;
#pragma unroll
        for (int n = 0; n < 2; ++n) { nb[0][n] = *(const f32x4*)(bgu + (size_t)e_ * 2048 + ch0 + 4 * n); nb[1][n] = *(const f32x4*)(bgu + (size_t)e_ * 2048 + 1024 + ch0 + 4 * n); } }
    __device__ __forceinline__ void operator()(f32x4 (&acc)[2][2][4][2], const Unit& u, int wr, int wc, int fr, int fq) const {
        const int e_ = u.pn >> 3, pnl = u.pn & 7; const int row0 = u.pm * BM + wr * 64 + fr, ch0 = pnl * 128 + wc * 32 + 8 * fq;
        (void)e_;
        const int odd = fq & 1; const int chs = ch0 - 8 * odd;
#pragma unroll
        for (int ai = 0; ai < 2; ++ai)
#pragma unroll
            for (int mp = 0; mp < 2; ++mp) { u32x2 w8[2];
#pragma unroll
                for (int mm = 0; mm < 2; ++mm) { const int m = 2 * mp + mm; f32x4 a[2];
#pragma unroll
                    for (int n = 0; n < 2; ++n) { const f32x4 g = acc[ai][0][m][n], uu = acc[ai][1][m][n];
#pragma unroll
                        for (int e = 0; e < 4; ++e) { const float gm = fminf(g[e], 7.0f), um = fminf(fmaxf(uu[e], -7.0f), 7.0f);
                            a[n][e] = (um + 1.0f) * (gm * sigmoidf_fast(1.702f * gm)); } }
                    w8[mm].x = pk4_fp8(a[0][0], a[0][1], a[0][2], a[0][3]); w8[mm].y = pk4_fp8(a[1][0], a[1][1], a[1][2], a[1][3]); }
                const auto rx = __builtin_amdgcn_permlane16_swap(w8[0].x, w8[1].x, false, false), ry = __builtin_amdgcn_permlane16_swap(w8[0].y, w8[1].y, false, false);
                const u32x4 v = {rx[0], ry[0], rx[1], ry[1]};
                *(u32x4*)(ACT + (size_t)(row0 + ai * HALF + (2 * mp + odd) * 16) * 1024 + chs) = v; }
    }
};

struct EpiDown {
    static constexpr bool AFTER_DRAIN = false, HAS_BIAS = true;
    const float* bd; const float* row_gate; unsigned char* YS;
    __device__ __forceinline__ bool keep(const Unit&) const { return false; }
    __device__ __forceinline__ void bias(f32x4 (&nb)[2][2], const Unit& u, int wc, int fq) const {
        const int e_ = u.pn >> 2, col0 = (u.pn & 3) * 256 + wc * 32 + 8 * fq;
#pragma unroll
        for (int bj = 0; bj < 2; ++bj)
#pragma unroll
            for (int n = 0; n < 2; ++n) nb[bj][n] = *(const f32x4*)(bd + (size_t)e_ * 1024 + col0 + bj * HALF + 4 * n); }
    __device__ __forceinline__ void operator()(f32x4 (&acc)[2][2][4][2], const Unit& u, int wr, int wc, int fr, int fq) const {
        const int e_ = u.pn >> 2, pnl = u.pn & 3; const int row0 = u.pm * BM + wr * 64 + fr, col0 = pnl * 256 + wc * 32 + 8 * fq;
        (void)e_;
        float rgv[8];
#pragma unroll
        for (int i = 0; i < 8; ++i) rgv[i] = row_gate[row0 + (i >> 2) * HALF + (i & 3) * 16];
        __builtin_amdgcn_sched_barrier(0);
        const int odd = fq & 1; const int cols = col0 - 8 * odd;
#pragma unroll
        for (int ai = 0; ai < 2; ++ai)
#pragma unroll
            for (int mp = 0; mp < 2; ++mp)
#pragma unroll
                for (int bj = 0; bj < 2; ++bj) { u32x2 w8[2];
#pragma unroll
                    for (int mm = 0; mm < 2; ++mm) { const int m = 2 * mp + mm; const float rg = rgv[ai * 4 + m] * 16.0f;
                        const f32x4 y0 = acc[ai][bj][m][0] * rg, y1 = acc[ai][bj][m][1] * rg;
                        w8[mm].x = pk4_fp8(y0[0], y0[1], y0[2], y0[3]); w8[mm].y = pk4_fp8(y1[0], y1[1], y1[2], y1[3]); }
                    const auto rx = __builtin_amdgcn_permlane16_swap(w8[0].x, w8[1].x, false, false), ry = __builtin_amdgcn_permlane16_swap(w8[0].y, w8[1].y, false, false);
                    const u32x4 v = {rx[0], ry[0], rx[1], ry[1]};
                    *(u32x4*)(YS + (size_t)(row0 + ai * HALF + (2 * mp + odd) * 16) * 1024 + cols + bj * HALF) = v; }
    }
};


constexpr int CONV_NSUB = 2 * (32768 + 16384);
struct ConvCtx {
    const float* wgu; const float* wdn; unsigned char* ogu; unsigned char* odn;
    int cw, nseq, jn;
    int sub;
    unsigned slot0;
};
struct ConvItem { const float* W; unsigned char* WT; int ldn, k0, n0, dst; };
__device__ __forceinline__ int conv_ip32(int r) { return 16 * ((r >> 2) & 1) + 4 * (r >> 3) + (r & 3); }
__device__ __forceinline__ ConvItem conv_decode(const ConvCtx& c, int s) {
    ConvItem d; const int it = s >> 1, hf = s & 1;
    if (it < 32768) { const int e = it >> 10, q = it & 1023, kb = q >> 6, nb = q & 63; const int L0 = 32 * nb, ch = L0 & 1023;
        d.W = c.wgu + (size_t)e * 1024 * 2048; d.ldn = 2048; d.k0 = 64 * kb + 32 * hf; d.n0 = L0; d.dst = e * 2048 + 256 * (ch >> 7) + 128 * (L0 >> 10) + 32 * ((ch >> 5) & 3); d.WT = c.ogu; }
    else { const int r = it - 32768, e = r >> 9, q = r & 511, kb = q >> 5, nb = q & 31;
        d.W = c.wdn + (size_t)e * 1024 * 1024; d.ldn = 1024; d.k0 = 64 * kb + 32 * hf; d.n0 = 32 * nb; d.dst = e * 1024 + 32 * nb; d.WT = c.odn; }
    return d;
}
__device__ __forceinline__ void conv_issue(const ConvCtx& c, PG8_LAS unsigned char* lds, unsigned slot, int lane_, int s) {
    int lane = lane_; asm volatile("" : "+v"(lane));
    const ConvItem d = conv_decode(c, s);
    const float* src = d.W + (size_t)(d.k0 + (lane >> 3)) * d.ldn + d.n0 + 4 * (lane & 7);
#pragma unroll
    for (int jj = 0; jj < 4; ++jj) __builtin_amdgcn_global_load_lds((const unsigned*)(src + (size_t)(8 * jj) * d.ldn), (PG8_LAS unsigned*)(lds + slot + jj * 1024), 16, 0, 2);
}
__device__ __forceinline__ void conv_finish(const ConvCtx& c, PG8_LAS unsigned char* lds, unsigned slot, int lane_, int s) {
    int lane = lane_; asm volatile("" : "+v"(lane));
    const ConvItem d = conv_decode(c, s);
    const int n = lane & 31, kh = lane >> 5;
    const PG8_LAS float* p = (const PG8_LAS float*)(lds + slot + kh * 2048 + n * 4);
    float v[16];
#pragma unroll
    for (int kk = 0; kk < 16; ++kk) v[kk] = p[kk * 32];
    asm volatile("s_waitcnt lgkmcnt(0)" ::: "memory");
    u32x4 o;
    o.x = pk4_fp8(32.f * v[0], 32.f * v[1], 32.f * v[2], 32.f * v[3]);   o.y = pk4_fp8(32.f * v[4], 32.f * v[5], 32.f * v[6], 32.f * v[7]);
    o.z = pk4_fp8(32.f * v[8], 32.f * v[9], 32.f * v[10], 32.f * v[11]); o.w = pk4_fp8(32.f * v[12], 32.f * v[13], 32.f * v[14], 32.f * v[15]);
    __builtin_nontemporal_store(o, (u32x4*)(d.WT + (size_t)(d.dst + conv_ip32(n)) * 1024 + d.k0 + 16 * kh));
}
template <class Epi, class Sched, bool ALIGN_EPI = false, bool SP2 = false, bool CONV = false>
__device__ __forceinline__ void gemm_phase(PG8_LAS unsigned char* lds, const Gemm g, const Sched& S, const Epi& E, ConvCtx* cx = nullptr) {
    int tid_ = threadIdx.x; asm volatile("" : "+v"(tid_));
    const int tid = tid_, wid = __builtin_amdgcn_readfirstlane(tid >> 6), lane = tid & 63, wr = wid >> 2, wc = wid & 3, fr = lane & 15, fq = lane >> 4;
    const int K = g.K, nt = K / BK;
    static_assert(!CONV || SP2, "CONV needs the SP2 loop");
    unsigned voffA[2], voffB[2];
#pragma unroll
    for (int i = 0; i < 2; ++i) { int R, C; stage_rc(tid * 16 + i * 8192, R, C);
        voffA[i] = (unsigned)R * g.lda + (unsigned)C * 2u; voffB[i] = (unsigned)R * g.ldb + (unsigned)C * 2u; }
    const size_t kstep = (size_t)(BK * 2);
    const size_t hstepA = (size_t)HALF * g.lda, hstepB = (size_t)HALF * g.ldb;
    const unsigned ldsw = (unsigned)wid * 1024u;
    const int aoff = lds_byte(wr * 64 + fr, fq * 8), boff = lds_byte(wc * 32 + fr, fq * 8);
#define PG8_SA(b, h) (((b) * 2 + (h)) * HTB)
#define PG8_SB(b, h) ((4 + (b) * 2 + (h)) * HTB)
#define PG8_STAGE(bufoff, gbase, voff) do { _Pragma("unroll") for (int _i = 0; _i < 2; ++_i) \
        __builtin_amdgcn_global_load_lds((const unsigned*)((const char*)(gbase) + (voff)[_i]), (PG8_LAS unsigned*)(lds + (bufoff) + ldsw + _i * 8192), 16, 0, 0); } while (0)
#define PG8_LDA(dst, b, h) do { _Pragma("unroll") for (int m = 0; m < 4; ++m) _Pragma("unroll") for (int k = 0; k < 2; ++k) dst[m][k] = *(const PG8_LAS bf16x8*)(lds + PG8_SA(b, h) + aoff + m * 2048 + k * 1024); } while (0)
#define PG8_LDB(dst, b, h) do { _Pragma("unroll") for (int n = 0; n < 2; ++n) _Pragma("unroll") for (int k = 0; k < 2; ++k) dst[n][k] = *(const PG8_LAS bf16x8*)(lds + PG8_SB(b, h) + boff + n * 2048 + k * 1024); } while (0)
#define PG8_MMA(ai, bj, At, Bt) do { __builtin_amdgcn_s_setprio(1); _Pragma("unroll") for (int m = 0; m < 4; ++m) _Pragma("unroll") for (int n = 0; n < 2; ++n) _Pragma("unroll") for (int k = 0; k < 2; ++k) \
        acc[ai][bj][m][n] = __builtin_amdgcn_mfma_f32_16x16x32_bf16(Bt[n][k], At[m][k], acc[ai][bj][m][n], 0, 0, 0); __builtin_amdgcn_s_setprio(0); } while (0)
#define PG8_WAIT_V(n) asm volatile("s_waitcnt vmcnt(" #n ")" ::: "memory")
#define PG8_WAIT_X(n_) do { if constexpr (CONV) { const int x_ = (n_); if (x_ == 5) asm volatile("s_waitcnt vmcnt(13)" ::: "memory"); else if (x_ == 4) asm volatile("s_waitcnt vmcnt(12)" ::: "memory"); \
        else if (x_ == 1) asm volatile("s_waitcnt vmcnt(9)" ::: "memory"); else asm volatile("s_waitcnt vmcnt(8)" ::: "memory"); } else asm volatile("s_waitcnt vmcnt(8)" ::: "memory"); } while (0)
#define PG8_WAIT_L(n) asm volatile("s_waitcnt lgkmcnt(" #n ")" ::: "memory")
#define PG8_BAR __builtin_amdgcn_s_barrier()
#define PG8_SCHED __builtin_amdgcn_sched_barrier(0)
    Unit cur, nxt; int ui = 0;
    if (!S.next(0, cur)) return;
    f32x4 acc[2][2][4][2];
#pragma unroll
    for (int a = 0; a < 2; ++a)
#pragma unroll
        for (int b = 0; b < 2; ++b)
#pragma unroll
            for (int m = 0; m < 4; ++m)
#pragma unroll
                for (int n = 0; n < 2; ++n) acc[a][b][m][n] = (f32x4){0.f, 0.f, 0.f, 0.f};
    bf16x8 At[4][2], B0[2][2], B1[2][2];
    const char* cA = cur.a; const char* cB = cur.b;
    S.a_ready(cur);
    if constexpr (SP2) {
        PG8_STAGE(PG8_SB(0, 0), cB, voffB); PG8_STAGE(PG8_SB(0, 1), cB + hstepB, voffB); PG8_STAGE(PG8_SA(0, 0), cA, voffA); PG8_STAGE(PG8_SA(0, 1), cA + hstepA, voffA);
        if (wr == 1) PG8_BAR;
        PG8_WAIT_V(2); PG8_BAR;
        PG8_STAGE(PG8_SB(1, 0), cB + kstep, voffB); PG8_STAGE(PG8_SA(1, 0), cA + kstep, voffA); PG8_STAGE(PG8_SB(1, 1), cB + hstepB + kstep, voffB);
        PG8_WAIT_V(6); PG8_BAR;
    } else {
        PG8_STAGE(PG8_SB(0, 0), cB, voffB); PG8_STAGE(PG8_SA(0, 0), cA, voffA); PG8_STAGE(PG8_SB(0, 1), cB + hstepB, voffB); PG8_STAGE(PG8_SA(0, 1), cA + hstepA, voffA);
        if (wr == 1) PG8_BAR;
        PG8_WAIT_V(4); PG8_BAR;
        PG8_STAGE(PG8_SB(1, 0), cB + kstep, voffB); PG8_STAGE(PG8_SA(1, 0), cA + kstep, voffA); PG8_STAGE(PG8_SB(1, 1), cB + hstepB + kstep, voffB);
        PG8_WAIT_V(6); PG8_BAR;
    }
    for (;;) {
        const bool has_next = S.next(ui + 1, nxt);
        const char* nA = has_next ? nxt.a : cA; const char* nB = has_next ? nxt.b : cB;
#pragma unroll 1
        for (int t = 0; t < nt; t += 2) {
            const bool last = (t == nt - 2);
            const char* a1 = cA + (size_t)(t + 1) * kstep;
            const char* a2 = last ? nA : cA + (size_t)(t + 2) * kstep; const char* b2 = last ? nB : cB + (size_t)(t + 2) * kstep;
            const char* a3 = a2 + kstep; const char* b3 = b2 + kstep;
            if (last && has_next) S.a_ready(nxt);
            if constexpr (SP2) {
            int cs_ = 0, cc_ = 0;
            if constexpr (CONV) { if (cx->sub >= 0) { conv_finish(*cx, lds, cx->slot0, lane, cx->sub); cx->sub = -1; cs_ = 1; } PG8_SCHED; }
            PG8_LDB(B0, 0, 0); PG8_LDB(B1, 0, 1); PG8_SCHED; PG8_LDA(At, 0, 0); PG8_STAGE(PG8_SA(1, 1), a1 + hstepA, voffA);
            if constexpr (CONV) { const int s_ = cx->cw + cx->nseq * cx->jn; if (s_ < CONV_NSUB) { conv_issue(*cx, lds, cx->slot0, lane, s_); cx->sub = s_; ++cx->jn; cc_ = 4; } }
            PG8_WAIT_X(cs_ + cc_); PG8_WAIT_L(0); PG8_BAR; PG8_MMA(0, 0, At, B0); PG8_MMA(0, 1, At, B1); PG8_BAR; PG8_SCHED;
            PG8_LDA(At, 0, 1); PG8_STAGE(PG8_SB(0, 0), b2, voffB); PG8_STAGE(PG8_SB(0, 1), b2 + hstepB, voffB); PG8_STAGE(PG8_SA(0, 0), a2, voffA);
            PG8_WAIT_X(cs_ + cc_); PG8_WAIT_L(0); PG8_BAR; PG8_MMA(1, 0, At, B0); PG8_MMA(1, 1, At, B1); PG8_BAR; PG8_SCHED;
            PG8_LDB(B0, 1, 0); PG8_LDB(B1, 1, 1); PG8_SCHED; PG8_LDA(At, 1, 0); PG8_STAGE(PG8_SA(0, 1), a2 + hstepA, voffA);
            PG8_WAIT_X(cc_); PG8_WAIT_L(0); PG8_BAR; PG8_MMA(0, 0, At, B0); PG8_MMA(0, 1, At, B1); PG8_BAR; PG8_SCHED;
            PG8_LDA(At, 1, 1); PG8_STAGE(PG8_SB(1, 0), b3, voffB); PG8_STAGE(PG8_SB(1, 1), b3 + hstepB, voffB); PG8_STAGE(PG8_SA(1, 0), a3, voffA);
            PG8_WAIT_V(8); PG8_WAIT_L(0); PG8_BAR; PG8_MMA(1, 0, At, B0); PG8_MMA(1, 1, At, B1); PG8_BAR; PG8_SCHED;
            } else {
            PG8_LDB(B0, 0, 0); PG8_SCHED; PG8_LDA(At, 0, 0); PG8_STAGE(PG8_SA(1, 1), a1 + hstepA, voffA);
            PG8_WAIT_L(8); PG8_BAR; PG8_WAIT_L(0); PG8_MMA(0, 0, At, B0); PG8_BAR; PG8_SCHED;
            PG8_LDB(B1, 0, 1); PG8_STAGE(PG8_SB(0, 0), b2, voffB);
            PG8_BAR; PG8_WAIT_L(0); PG8_MMA(0, 1, At, B1); PG8_BAR;
            PG8_LDA(At, 0, 1); PG8_STAGE(PG8_SA(0, 0), a2, voffA);
            PG8_BAR; PG8_WAIT_L(0); PG8_MMA(1, 0, At, B0); PG8_BAR; PG8_SCHED;
            PG8_STAGE(PG8_SB(0, 1), b2 + hstepB, voffB);
            PG8_WAIT_V(6); PG8_BAR; PG8_MMA(1, 1, At, B1); PG8_BAR;
            PG8_LDB(B0, 1, 0); PG8_SCHED; PG8_LDA(At, 1, 0); PG8_STAGE(PG8_SA(0, 1), a2 + hstepA, voffA);
            PG8_WAIT_L(8); PG8_BAR; PG8_WAIT_L(0); PG8_MMA(0, 0, At, B0); PG8_BAR; PG8_SCHED;
            PG8_LDB(B1, 1, 1); PG8_STAGE(PG8_SB(1, 0), b3, voffB);
            PG8_BAR; PG8_WAIT_L(0); PG8_MMA(0, 1, At, B1); PG8_BAR;
            PG8_LDA(At, 1, 1); PG8_STAGE(PG8_SA(1, 0), a3, voffA);
            PG8_BAR; PG8_WAIT_L(0); PG8_MMA(1, 0, At, B0); PG8_BAR; PG8_SCHED;
            PG8_STAGE(PG8_SB(1, 1), b3 + hstepB, voffB);
            PG8_WAIT_V(6); PG8_BAR; PG8_MMA(1, 1, At, B1); PG8_BAR;
            }
        }
        if constexpr (ALIGN_EPI) { if (wr == 0) PG8_BAR; }
        if constexpr (!Epi::AFTER_DRAIN) { E(acc, cur, wr, wc, fr, fq); S.done(cur); }
        if (!has_next) break;
        if (!E.keep(cur)) {
#pragma unroll
        for (int a = 0; a < 2; ++a)
#pragma unroll
            for (int b = 0; b < 2; ++b)
#pragma unroll
                for (int m = 0; m < 4; ++m)
#pragma unroll
                    for (int n = 0; n < 2; ++n) acc[a][b][m][n] = (f32x4){0.f, 0.f, 0.f, 0.f};
        }
        cur = nxt; cA = nA; cB = nB; ++ui;
        if constexpr (ALIGN_EPI) { if (wr == 1) PG8_BAR; }
    }
    PG8_WAIT_V(0);
    if constexpr (!ALIGN_EPI) { if (wr == 0) PG8_BAR; }
    PG8_BAR;
    if constexpr (Epi::AFTER_DRAIN) { E.fused(acc, cur, wr, wc, fr, fq, lds, wid, lane); S.done(cur); }
#undef PG8_SA
#undef PG8_SB
#undef PG8_STAGE
#undef PG8_LDA
#undef PG8_LDB
#undef PG8_MMA
#undef PG8_WAIT_V
#undef PG8_WAIT_X
#undef PG8_WAIT_L
#undef PG8_BAR
#undef PG8_SCHED
}

typedef unsigned u32x8 __attribute__((ext_vector_type(8))); typedef int i32x8 __attribute__((ext_vector_type(8)));
constexpr int F8_SCALE_W = 122, F8_SCALE_X = 127;
template <class Epi, class Sched, bool ALIGN_EPI = false, bool SP2 = false, bool CONV = false>
__device__ __forceinline__ void gemm_phase_f8(PG8_LAS unsigned char* lds, const Gemm g, const Sched& S, const Epi& E, ConvCtx* cx = nullptr) {
    int tid_ = threadIdx.x; asm volatile("" : "+v"(tid_));
    const int tid = tid_, wid = __builtin_amdgcn_readfirstlane(tid >> 6), lane = tid & 63, wr = wid >> 2, wc = wid & 3, fr = lane & 15, fq = lane >> 4;
    const int K = g.K, nt = K / BK;
    static_assert(!CONV || SP2, "CONV needs the SP2 loop");
    unsigned voffA[2], voffB[2];
#pragma unroll
    for (int i = 0; i < 2; ++i) { int R, C; stage_rc(tid * 16 + i * 8192, R, C);
        voffA[i] = (unsigned)R * g.lda + (unsigned)C * 2u; voffB[i] = (unsigned)R * g.ldb + (unsigned)C * 2u; }
    const size_t kstep = (size_t)(BK * 2);
    const size_t hstepA = (size_t)HALF * g.lda, hstepB = (size_t)HALF * g.ldb;
    const unsigned ldsw = (unsigned)wid * 1024u;
    const int aoff = lds_byte(wr * 64 + fr, fq * 8), boff = lds_byte(wc * 32 + fr, fq * 8);
#define PG8_SA(b, h) (((b) * 2 + (h)) * HTB)
#define PG8_SB(b, h) ((4 + (b) * 2 + (h)) * HTB)
#define PG8_STAGE(bufoff, gbase, voff) do { _Pragma("unroll") for (int _i = 0; _i < 2; ++_i) \
        __builtin_amdgcn_global_load_lds((const unsigned*)((const char*)(gbase) + (voff)[_i]), (PG8_LAS unsigned*)(lds + (bufoff) + ldsw + _i * 8192), 16, 0, 0); } while (0)
#define PG8_LDA(dst, b, h) do { _Pragma("unroll") for (int m = 0; m < 4; ++m) { const u32x4 lo_ = *(const PG8_LAS u32x4*)(lds + PG8_SA(b, h) + aoff + m * 2048), hi_ = *(const PG8_LAS u32x4*)(lds + PG8_SA(b, h) + aoff + m * 2048 + 1024); dst[m] = __builtin_shufflevector(lo_, hi_, 0, 1, 2, 3, 4, 5, 6, 7); } } while (0)
#define PG8_LDB(dst, b, h) do { _Pragma("unroll") for (int n = 0; n < 2; ++n) { const u32x4 lo_ = *(const PG8_LAS u32x4*)(lds + PG8_SB(b, h) + boff + n * 2048), hi_ = *(const PG8_LAS u32x4*)(lds + PG8_SB(b, h) + boff + n * 2048 + 1024); dst[n] = __builtin_shufflevector(lo_, hi_, 0, 1, 2, 3, 4, 5, 6, 7); } } while (0)
#define PG8_MMA(ai, bj, At, Bt) do { __builtin_amdgcn_s_setprio(1); _Pragma("unroll") for (int m = 0; m < 4; ++m) _Pragma("unroll") for (int n = 0; n < 2; ++n) \
        asm volatile("v_mfma_scale_f32_16x16x128_f8f6f4 %0, %1, %2, %0, %3, %4 op_sel_hi:[0,0,0]" : "+v"(acc[ai][bj][m][n]) : "v"(Bt[n]), "v"(At[m]), "v"(sc_w), "v"(sc_x)); __builtin_amdgcn_s_setprio(0); } while (0)
#define PG8_WAIT_V(n) asm volatile("s_waitcnt vmcnt(" #n ")" ::: "memory")
#define PG8_WAIT_X(n_) do { if constexpr (CONV) { const int x_ = (n_); if (x_ == 5) asm volatile("s_waitcnt vmcnt(13)" ::: "memory"); else if (x_ == 4) asm volatile("s_waitcnt vmcnt(12)" ::: "memory"); \
        else if (x_ == 1) asm volatile("s_waitcnt vmcnt(9)" ::: "memory"); else asm volatile("s_waitcnt vmcnt(8)" ::: "memory"); } else asm volatile("s_waitcnt vmcnt(8)" ::: "memory"); } while (0)
#define PG8_WAIT_L(n) asm volatile("s_waitcnt lgkmcnt(" #n ")" ::: "memory")
#define PG8_BAR __builtin_amdgcn_s_barrier()
#define PG8_SCHED __builtin_amdgcn_sched_barrier(0)
    Unit cur, nxt; int ui = 0;
    if (!S.next(0, cur)) return;
    f32x4 acc[2][2][4][2], nb[2][2];
    E.bias(nb, cur, wc, fq);
#pragma unroll
    for (int a = 0; a < 2; ++a)
#pragma unroll
        for (int b = 0; b < 2; ++b)
#pragma unroll
            for (int m = 0; m < 4; ++m)
#pragma unroll
                for (int n = 0; n < 2; ++n) acc[a][b][m][n] = nb[b][n];
    u32x8 At[4], B0[2], B1[2];
    int sc_w = F8_SCALE_W, sc_x = F8_SCALE_X; asm volatile("" : "+v"(sc_w), "+v"(sc_x));
    const char* cA = cur.a; const char* cB = cur.b;
    S.a_ready(cur);
    if constexpr (SP2) {
        PG8_STAGE(PG8_SB(0, 0), cB, voffB); PG8_STAGE(PG8_SB(0, 1), cB + hstepB, voffB); PG8_STAGE(PG8_SA(0, 0), cA, voffA); PG8_STAGE(PG8_SA(0, 1), cA + hstepA, voffA);
        if (wr == 1) PG8_BAR;
        PG8_WAIT_V(2); PG8_BAR;
        PG8_STAGE(PG8_SB(1, 0), cB + kstep, voffB); PG8_STAGE(PG8_SA(1, 0), cA + kstep, voffA); PG8_STAGE(PG8_SB(1, 1), cB + hstepB + kstep, voffB);
        PG8_WAIT_V(6); PG8_BAR;
    } else {
        PG8_STAGE(PG8_SB(0, 0), cB, voffB); PG8_STAGE(PG8_SA(0, 0), cA, voffA); PG8_STAGE(PG8_SB(0, 1), cB + hstepB, voffB); PG8_STAGE(PG8_SA(0, 1), cA + hstepA, voffA);
        if (wr == 1) PG8_BAR;
        PG8_WAIT_V(4); PG8_BAR;
        PG8_STAGE(PG8_SB(1, 0), cB + kstep, voffB); PG8_STAGE(PG8_SA(1, 0), cA + kstep, voffA); PG8_STAGE(PG8_SB(1, 1), cB + hstepB + kstep, voffB);
        PG8_WAIT_V(6); PG8_BAR;
    }
    for (;;) {
        const bool has_next = S.next(ui + 1, nxt);
        const char* nA = has_next ? nxt.a : cA; const char* nB = has_next ? nxt.b : cB;
        if (has_next) E.bias(nb, nxt, wc, fq);
#pragma unroll 1
        for (int t = 0; t < nt; t += 2) {
            const bool last = (t == nt - 2);
            const char* a1 = cA + (size_t)(t + 1) * kstep;
            const char* a2 = last ? nA : cA + (size_t)(t + 2) * kstep; const char* b2 = last ? nB : cB + (size_t)(t + 2) * kstep;
            const char* a3 = a2 + kstep; const char* b3 = b2 + kstep;
            if (last && has_next) S.a_ready(nxt);
            if constexpr (SP2) {
            int cs_ = 0, cc_ = 0;
            if constexpr (CONV) { if (cx->sub >= 0) { conv_finish(*cx, lds, cx->slot0, lane, cx->sub); cx->sub = -1; cs_ = 1; } PG8_SCHED; }
            PG8_LDB(B0, 0, 0); PG8_LDB(B1, 0, 1); PG8_SCHED; PG8_LDA(At, 0, 0); PG8_STAGE(PG8_SA(1, 1), a1 + hstepA, voffA);
            if constexpr (CONV) { const int s_ = cx->cw + cx->nseq * cx->jn; if (s_ < CONV_NSUB) { conv_issue(*cx, lds, cx->slot0, lane, s_); cx->sub = s_; ++cx->jn; cc_ = 4; } }
            PG8_WAIT_X(cs_ + cc_); PG8_WAIT_L(0); PG8_BAR; PG8_MMA(0, 0, At, B0); PG8_MMA(0, 1, At, B1); PG8_BAR; PG8_SCHED;
            PG8_LDA(At, 0, 1); PG8_STAGE(PG8_SB(0, 0), b2, voffB); PG8_STAGE(PG8_SB(0, 1), b2 + hstepB, voffB); PG8_STAGE(PG8_SA(0, 0), a2, voffA);
            PG8_WAIT_X(cs_ + cc_); PG8_WAIT_L(0); PG8_BAR; PG8_MMA(1, 0, At, B0); PG8_MMA(1, 1, At, B1); PG8_BAR; PG8_SCHED;
            PG8_LDB(B0, 1, 0); PG8_LDB(B1, 1, 1); PG8_SCHED; PG8_LDA(At, 1, 0); PG8_STAGE(PG8_SA(0, 1), a2 + hstepA, voffA);
            PG8_WAIT_X(cc_); PG8_WAIT_L(0); PG8_BAR; PG8_MMA(0, 0, At, B0); PG8_MMA(0, 1, At, B1); PG8_BAR; PG8_SCHED;
            PG8_LDA(At, 1, 1); PG8_STAGE(PG8_SB(1, 0), b3, voffB); PG8_STAGE(PG8_SB(1, 1), b3 + hstepB, voffB); PG8_STAGE(PG8_SA(1, 0), a3, voffA);
            PG8_WAIT_V(8); PG8_WAIT_L(0); PG8_BAR; PG8_MMA(1, 0, At, B0); PG8_MMA(1, 1, At, B1); PG8_BAR; PG8_SCHED;
            } else {
            PG8_LDB(B0, 0, 0); PG8_SCHED; PG8_LDA(At, 0, 0); PG8_STAGE(PG8_SA(1, 1), a1 + hstepA, voffA);
            PG8_WAIT_L(8); PG8_BAR; PG8_WAIT_L(0); PG8_MMA(0, 0, At, B0); PG8_BAR; PG8_SCHED;
            PG8_LDB(B1, 0, 1); PG8_STAGE(PG8_SB(0, 0), b2, voffB);
            PG8_BAR; PG8_WAIT_L(0); PG8_MMA(0, 1, At, B1); PG8_BAR;
            PG8_LDA(At, 0, 1); PG8_STAGE(PG8_SA(0, 0), a2, voffA);
            PG8_BAR; PG8_WAIT_L(0); PG8_MMA(1, 0, At, B0); PG8_BAR; PG8_SCHED;
            PG8_STAGE(PG8_SB(0, 1), b2 + hstepB, voffB);
            PG8_WAIT_V(6); PG8_BAR; PG8_MMA(1, 1, At, B1); PG8_BAR;
            PG8_LDB(B0, 1, 0); PG8_SCHED; PG8_LDA(At, 1, 0); PG8_STAGE(PG8_SA(0, 1), a2 + hstepA, voffA);
            PG8_WAIT_L(8); PG8_BAR; PG8_WAIT_L(0); PG8_MMA(0, 0, At, B0); PG8_BAR; PG8_SCHED;
            PG8_LDB(B1, 1, 1); PG8_STAGE(PG8_SB(1, 0), b3, voffB);
            PG8_BAR; PG8_WAIT_L(0); PG8_MMA(0, 1, At, B1); PG8_BAR;
            PG8_LDA(At, 1, 1); PG8_STAGE(PG8_SA(1, 0), a3, voffA);
            PG8_BAR; PG8_WAIT_L(0); PG8_MMA(1, 0, At, B0); PG8_BAR; PG8_SCHED;
            PG8_STAGE(PG8_SB(1, 1), b3 + hstepB, voffB);
            PG8_WAIT_V(6); PG8_BAR; PG8_MMA(1, 1, At, B1); PG8_BAR;
            }
        }
        if constexpr (ALIGN_EPI) { if (wr == 0) PG8_BAR; }
        if constexpr (Epi::HAS_BIAS) asm volatile("" : "+v"(nb[0][0]), "+v"(nb[0][1]), "+v"(nb[1][0]), "+v"(nb[1][1]));
        asm volatile("s_nop 15\n\ts_nop 15" ::: "memory");
        if constexpr (!Epi::AFTER_DRAIN) { E(acc, cur, wr, wc, fr, fq); S.done(cur); }
        if (!has_next) break;
        if (!E.keep(cur)) {
#pragma unroll
        for (int a = 0; a < 2; ++a)
#pragma unroll
            for (int b = 0; b < 2; ++b)
#pragma unroll
                for (int m = 0; m < 4; ++m)
#pragma unroll
                    for (int n = 0; n < 2; ++n) acc[a][b][m][n] = nb[b][n];
        }
        cur = nxt; cA = nA; cB = nB; ++ui;
        if constexpr (ALIGN_EPI) { if (wr == 1) PG8_BAR; }
    }
    PG8_WAIT_V(0);
    if constexpr (!ALIGN_EPI) { if (wr == 0) PG8_BAR; }
    PG8_BAR;
    if constexpr (Epi::AFTER_DRAIN) { E.fused(acc, cur, wr, wc, fr, fq, lds, wid, lane); S.done(cur); }
#undef PG8_SA
#undef PG8_SB
#undef PG8_STAGE
#undef PG8_LDA
#undef PG8_LDB
#undef PG8_MMA
#undef PG8_WAIT_V
#undef PG8_WAIT_X
#undef PG8_WAIT_L
#undef PG8_BAR
#undef PG8_SCHED
}
}

#include <hip/hip_bf16.h>
#include <cmath>
namespace attn_body {
using bf16=__hip_bfloat16;
using bf16x8=__attribute__((ext_vector_type(8)))short;
using s16x4=__attribute__((ext_vector_type(4)))short;
using f32x16=__attribute__((ext_vector_type(16)))float;
using u32x4=__attribute__((ext_vector_type(4)))unsigned;
constexpr int SEQ=8192,D=64; constexpr int QP=512,KP=512,VP=512,OP=1024;
constexpr int NW=8,QBLK=32,QB=QBLK*NW,KVBLK=64,NQB=SEQ/QB;
constexpr int ATTN_UNIT_ROWS=QB;
__device__ __forceinline__ int crow(int r,int hi){return (r&3)+8*(r>>2)+4*hi;}
#define SBAR() __builtin_amdgcn_sched_barrier(0)
__device__ __forceinline__ void cmask(f32x16&p0,f32x16&p1,int jb,int qrel,int hi){
  const float NEG=-INFINITY; (void)hi;
  if(jb>(qrel>>6)){
  #pragma unroll
  for(int r=0;r<16;++r){p0[r]=NEG;p1[r]=NEG;} }
}

constexpr int NSLOT=3, SLOTB=8192;
constexpr int LDS_K=0, LDS_V=NSLOT*SLOTB, LDS_WS=2*NSLOT*SLOTB, LDS_OST=LDS_WS+NW*64*4, LDS_BYTES=LDS_OST+NW*4096;
constexpr float C2=0.125f*1.4426950408889634f;
__device__ __forceinline__ void glds16(const void*gsrc,unsigned lds_dst){unsigned keep;
  asm volatile("s_mov_b32 %0, m0\n\ts_mov_b32 m0, %2\n\ts_nop 0\n\tglobal_load_lds_dwordx4 %1, off\n\ts_mov_b32 m0, %0":"=&s"(keep):"v"(gsrc),"s"(lds_dst):"memory");}
__device__ __forceinline__ float max3f(float a,float b,float c){float r;asm("v_max3_f32 %0, %1, %2, %3":"=v"(r):"v"(a),"v"(b),"v"(c));return r;}
__device__ __forceinline__ float max2f(float a,float b){float r;asm("v_max_f32_e32 %0, %1, %2":"=v"(r):"v"(a),"v"(b));return r;}
__device__ __forceinline__ float fadd_s(float a,float b){float r;asm("v_add_f32_e32 %0, %1, %2":"=v"(r):"v"(a),"v"(b));return r;}
__device__ __forceinline__ float fsub_s(float a,float b){float r;asm("v_sub_f32_e32 %0, %1, %2":"=v"(r):"v"(a),"v"(b));return r;}
typedef float f32x2_t __attribute__((ext_vector_type(2))); typedef __bf16 bf16x2_t __attribute__((ext_vector_type(2)));
__device__ __forceinline__ unsigned cvtpk_s(float lo,float hi){f32x2_t v={lo,hi};bf16x2_t b=__builtin_convertvector(v,bf16x2_t);return __builtin_bit_cast(unsigned,b);}
#define WAIT_BAR(N) asm volatile("s_waitcnt vmcnt(" #N ") lgkmcnt(0)\n\ts_barrier":::"memory")

__device__ __forceinline__ void qkt(f32x16&p0,f32x16&p1,const char*Kslot,const bf16x8*qr,const f32x16&negm,int r32,int hi){
  const char*kb=Kslot+hi*1024+r32*16;
  #pragma unroll
  for(int d0=0;d0<4;++d0){
    const bf16x8 b0=*reinterpret_cast<const bf16x8*>(kb+d0*2048);
    const bf16x8 b1=*reinterpret_cast<const bf16x8*>(kb+d0*2048+512);
    if(d0==0){p0=__builtin_amdgcn_mfma_f32_32x32x16_bf16(b0,qr[0],negm,0,0,0);p1=__builtin_amdgcn_mfma_f32_32x32x16_bf16(b1,qr[0],negm,0,0,0);}
    else{p0=__builtin_amdgcn_mfma_f32_32x32x16_bf16(b0,qr[d0],p0,0,0,0);p1=__builtin_amdgcn_mfma_f32_32x32x16_bf16(b1,qr[d0],p1,0,0,0);}}
}
typedef __attribute__((address_space(3))) const char* lds_cptr;
typedef short v4i16_t __attribute__((ext_vector_type(4)));
__device__ __forceinline__ void kload8(bf16x8*kf,lds_cptr kp){
  kf[0]=*(const __attribute__((address_space(3))) bf16x8*)(kp);      kf[1]=*(const __attribute__((address_space(3))) bf16x8*)(kp+512);
  kf[2]=*(const __attribute__((address_space(3))) bf16x8*)(kp+2048); kf[3]=*(const __attribute__((address_space(3))) bf16x8*)(kp+2560);
  kf[4]=*(const __attribute__((address_space(3))) bf16x8*)(kp+4096); kf[5]=*(const __attribute__((address_space(3))) bf16x8*)(kp+4608);
  kf[6]=*(const __attribute__((address_space(3))) bf16x8*)(kp+6144); kf[7]=*(const __attribute__((address_space(3))) bf16x8*)(kp+6656);
}
__device__ __forceinline__ void kload2(bf16x8*kf,lds_cptr kp,int j){ kf[2*j]=*(const __attribute__((address_space(3))) bf16x8*)(kp+j*2048); kf[2*j+1]=*(const __attribute__((address_space(3))) bf16x8*)(kp+j*2048+512); }
__device__ __forceinline__ s16x4 vtr(lds_cptr p){ return __builtin_bit_cast(s16x4,__builtin_amdgcn_ds_read_tr16_b64_v4i16((__attribute__((address_space(3))) v4i16_t*)p)); }
__device__ __forceinline__ float rowmax(const f32x16&p0,const f32x16&p1){
  float a=max3f(p0[0],p0[1],p1[0]),b=max3f(p0[2],p0[3],p1[1]);a=max3f(a,p1[2],p1[3]);
  #pragma unroll
  for(int r=4;r<16;r+=4){a=max3f(a,p0[r],p0[r+1]);b=max3f(b,p0[r+2],p0[r+3]);a=max3f(a,p1[r],p1[r+1]);b=max3f(b,p1[r+2],p1[r+3]);}
  const float m=max2f(a,b);
  auto rr=__builtin_amdgcn_permlane32_swap(__float_as_uint(m),__float_as_uint(m),false,false);
  return max2f(__uint_as_float(rr[0]),__uint_as_float(rr[1]));
}
__device__ __forceinline__ void pv(f32x16*o,int vb,bf16x8 pa0,bf16x8 pa1,bf16x8 pa2,bf16x8 pa3){
  #pragma unroll
  for(int d0=0;d0<2;++d0){s16x4 lo[4],hi[4];
    #pragma unroll
    for(int ks=0;ks<4;++ks){
      asm volatile("ds_read_b64_tr_b16 %0,%1 offset:%c2":"=&v"(lo[ks]):"v"(vb),"i"(d0*4096+ks*1024):"memory");
      asm volatile("ds_read_b64_tr_b16 %0,%1 offset:%c2":"=&v"(hi[ks]):"v"(vb),"i"(d0*4096+ks*1024+512):"memory");}
    asm volatile("s_waitcnt lgkmcnt(0)":::"memory");SBAR();
    #define PK(k) (bf16x8){lo[k][0],lo[k][1],lo[k][2],lo[k][3],hi[k][0],hi[k][1],hi[k][2],hi[k][3]}
    o[d0]=__builtin_amdgcn_mfma_f32_32x32x16_bf16(pa0,PK(0),o[d0],0,0,0);
    o[d0]=__builtin_amdgcn_mfma_f32_32x32x16_bf16(pa1,PK(1),o[d0],0,0,0);
    o[d0]=__builtin_amdgcn_mfma_f32_32x32x16_bf16(pa2,PK(2),o[d0],0,0,0);
    o[d0]=__builtin_amdgcn_mfma_f32_32x32x16_bf16(pa3,PK(3),o[d0],0,0,0);
    #undef PK
  }
}

#ifndef ATTN_STORE16
#define ATTN_STORE16(p,v) (*(u32x4*)(p)=(v))
#endif
template<int THRL> __device__ __forceinline__ void attn_unit(int qb,const bf16*Q,const bf16*__restrict__ K,const bf16*__restrict__ V,bf16*O,char*shm){
  int tid_=threadIdx.x; asm volatile("":"+v"(tid_)); const int tid=tid_,lane=tid&63,r32=lane&31,hi=lane>>5; const int wid=__builtin_amdgcn_readfirstlane(tid>>6);
  const int q0=qb*QB;
  const bf16*Qw=Q+(long)(q0+wid*QBLK)*QP;
  const bf16*Kh=K,*Vh=V;
  const unsigned lds0=(unsigned)(uintptr_t)shm;
  float*wsf=(float*)(shm+LDS_WS)+wid*64;
  const bf16*ksrc=Kh+(long)lane*KP+wid*8;
  const bf16*vsrc=Vh+(long)(16*(wid&3)+(lane>>2))*VP+(wid>>2)*32+(lane&3)*8;
  const unsigned kdst=lds0+LDS_K+wid*1024, vdst=lds0+LDS_V+wid*1024;
  #define DMA_K(t,slot) glds16(ksrc+(long)(t)*KVBLK*KP,(unsigned)__builtin_amdgcn_readfirstlane(kdst+(slot)))
  #define DMA_V(t,slot) glds16(vsrc+(long)(t)*KVBLK*VP,(unsigned)__builtin_amdgcn_readfirstlane(vdst+(slot)))
  const int vb0=(int)(lds0+LDS_V)+((lane>>4)&1)*32+(lane&3)*8+(4*hi+((lane&15)>>2))*64;
  const char*Kbase=shm+LDS_K; bf16x8 kf[8];
  const lds_cptr shm3=(lds_cptr)shm; const lds_cptr kp0=shm3+LDS_K+hi*1024+r32*16; const lds_cptr vp0=shm3+LDS_V+((lane>>4)&1)*32+(lane&3)*8+(4*hi+((lane&15)>>2))*64;
  const int NT=(q0+QB)/KVBLK;
  DMA_K(0,0);DMA_V(0,0);DMA_K(1,SLOTB);
  bf16x8 qr[4];
  #pragma unroll
  for(int d0=0;d0<4;++d0)qr[d0]=*reinterpret_cast<const bf16x8*>(&Qw[(long)r32*QP+d0*16+hi*8]);
  float mhat=0.f,l_reg=0.f;f32x16 o[2];o[0]=f32x16{};o[1]=f32x16{};f32x16 negm=f32x16{};asm volatile("":"+v"(negm));
  const int qrel=wid*QBLK+r32;
  #define CMASK(P0,P1,t) do{int jb_=(t)-(NT-4); if(jb_>=0)cmask(P0,P1,jb_,qrel,hi);}while(0)
  bool resc=false;
  #define START(P0,P1) do{ const float rm=rowmax(P0,P1); resc=false; \
    { const float dl=rm; mhat=fadd_s(mhat,dl); \
      _Pragma("unroll") for(int r=0;r<16;++r){P0[r]=fsub_s(P0[r],dl);P1[r]=fsub_s(P1[r],dl);} \
      _Pragma("unroll") for(int r=0;r<16;++r)negm[r]=-mhat; asm volatile("":"+v"(negm)); } \
    _Pragma("unroll") for(int r=0;r<16;++r)P0[r]=__builtin_amdgcn_exp2f(P0[r]); }while(0)
  #define RESC() do{ if(resc){ asm volatile("s_waitcnt lgkmcnt(0)":::"memory"); \
      _Pragma("unroll") for(int d_=0;d_<2;++d_) _Pragma("unroll") for(int r=0;r<16;++r)o[d_][r]*=wsf[crow(r,hi)]; } }while(0)
  f32x16 pA0,pA1,pB0,pB1;
  int sl_prev=0,sl_cur=0,sl_next=SLOTB;
  #define ROT() do{sl_prev=sl_cur;sl_cur=sl_next;sl_next=(sl_next==(NSLOT-1)*SLOTB)?0:sl_next+SLOTB;}while(0)
  DMA_K(2,2*SLOTB);
  WAIT_BAR(3);
  qkt(pA0,pA1,Kbase,qr,negm,r32,hi);asm volatile("s_nop 15\n\ts_nop 7":"+v"(pA0),"+v"(pA1));CMASK(pA0,pA1,0);
  START(pA0,pA1);
  _Pragma("unroll") for(int r=0;r<16;++r)pA1[r]=__builtin_amdgcn_exp2f(pA1[r]);
  WAIT_BAR(0);
  DMA_K(3,0);DMA_V(1,SLOTB);
  ROT();
  kload8(kf,kp0+sl_cur);
  WAIT_BAR(2);
  s16x4 vlo[8],vhi[8]; u32x4 pw0,pw1,pw2,pw3;
  #define PKW(P,B) cvtpk_s(P[B],P[B+1])
  #define PAF(k) __builtin_bit_cast(bf16x8,pw##k)
  #define VFR(i) (bf16x8){vlo[i][0],vlo[i][1],vlo[i][2],vlo[i][3],vhi[i][0],vhi[i][1],vhi[i][2],vhi[i][3]}
  #define PIN(x) asm volatile("":"+v"(x))
  #define MX3(a,b,c) __builtin_fmaxf(__builtin_fmaxf((a),(b)),(c))
  #define GAPA(MF,A0,A1,A2,A3,W0,W1,PW) do{ MF; sacc+=A0; sacc+=A1; sacc+=A2; sacc+=A3; PIN(sacc); W0; W1; PIN(PW); SBAR(); }while(0)
  #define EX(v) __builtin_amdgcn_exp2f(v)
  #define GAPB(MF,X,B) do{ MF; X[B]=EX(X[B]); X[B+1]=EX(X[B+1]); X[B+2]=EX(X[B+2]); X[B+3]=EX(X[B+3]); PIN(X); SBAR(); }while(0)
  #define VRD(i) do{ vlo[i]=vtr(vp_+(((i)>>2)*4096+((i)&3)*1024)); vhi[i]=vtr(vp_+(((i)>>2)*4096+((i)&3)*1024+512)); }while(0)
  #define KRD(G,j) do{ if(G){ kload2(kf,kp0+sl_next,j); SBAR(); } }while(0)
  #define STEP(C0,C1,P0,P1,t,GK,GV,GL) do{ SBAR(); \
    const lds_cptr vp_=vp0+sl_prev; \
    VRD(0); SBAR(); float sacc=(P0[0]+P0[1]); \
    GAPA(C0=__builtin_amdgcn_mfma_f32_32x32x16_bf16(kf[0],qr[0],negm,0,0,0), P0[2],P0[3],P0[4],P0[5],     pw0[0]=PKW(P0,0), pw0[1]=PKW(P0,2), pw0); \
    VRD(4); SBAR(); GAPA(C1=__builtin_amdgcn_mfma_f32_32x32x16_bf16(kf[1],qr[0],negm,0,0,0), P0[6],P0[7],P0[8],P0[9],     pw0[2]=PKW(P0,4), pw0[3]=PKW(P0,6), pw0); \
    VRD(1); SBAR(); GAPA(C0=__builtin_amdgcn_mfma_f32_32x32x16_bf16(kf[2],qr[1],C0,0,0,0),   P0[10],P0[11],P0[12],P0[13], pw1[0]=PKW(P0,8), pw1[1]=PKW(P0,10), pw1); \
    VRD(5); SBAR(); GAPA(C1=__builtin_amdgcn_mfma_f32_32x32x16_bf16(kf[3],qr[1],C1,0,0,0),   P0[14],P0[15],P1[0],P1[1],   pw1[2]=PKW(P0,12),pw1[3]=PKW(P0,14), pw1); \
    VRD(2); SBAR(); GAPA(C0=__builtin_amdgcn_mfma_f32_32x32x16_bf16(kf[4],qr[2],C0,0,0,0),   P1[2],P1[3],P1[4],P1[5],     pw2[0]=PKW(P1,0), pw2[1]=PKW(P1,2), pw2); \
    VRD(6); SBAR(); GAPA(C1=__builtin_amdgcn_mfma_f32_32x32x16_bf16(kf[5],qr[2],C1,0,0,0),   P1[6],P1[7],P1[8],P1[9],     pw2[2]=PKW(P1,4), pw2[3]=PKW(P1,6), pw2); \
    VRD(3); SBAR(); GAPA(C0=__builtin_amdgcn_mfma_f32_32x32x16_bf16(kf[6],qr[3],C0,0,0,0),   P1[10],P1[11],P1[12],P1[13], pw3[0]=PKW(P1,8), pw3[1]=PKW(P1,10), pw3); \
    VRD(7); SBAR(); GAPA(C1=__builtin_amdgcn_mfma_f32_32x32x16_bf16(kf[7],qr[3],C1,0,0,0),   P1[14],P1[15],0.f,0.f,       pw3[2]=PKW(P1,12),pw3[3]=PKW(P1,14), pw3); \
    l_reg+=sacc; \
    if(GK){DMA_K((t)+3,sl_cur);} if(GV){DMA_V((t)+1,sl_next);} \
    CMASK(C0,C1,t); \
    { float a=MX3(C0[0],C0[1],C1[0]),b=MX3(C0[2],C0[3],C1[1]); a=MX3(a,C1[2],C1[3]); \
      _Pragma("unroll") for(int r=4;r<16;r+=4){a=MX3(a,C0[r],C0[r+1]);b=MX3(b,C0[r+2],C0[r+3]);a=MX3(a,C1[r],C1[r+1]);b=MX3(b,C1[r+2],C1[r+3]);} \
      float rm=__builtin_fmaxf(a,b); { auto rr=__builtin_amdgcn_permlane32_swap(__float_as_uint(rm),__float_as_uint(rm),false,false); rm=__builtin_fmaxf(__uint_as_float(rr[0]),__uint_as_float(rr[1])); } \
      resc=false; \
      if(__builtin_expect(__any(rm>(float)THRL),0)){ const float dl=__builtin_fmaxf(rm,0.f); mhat+=dl; \
        _Pragma("unroll") for(int r=0;r<16;++r){C0[r]-=dl;C1[r]-=dl;} \
        _Pragma("unroll") for(int r=0;r<16;++r)negm[r]=-mhat; asm volatile("":"+v"(negm)); \
        const float f=__builtin_amdgcn_exp2f(-dl); l_reg*=f; if(hi==0)wsf[r32]=f; resc=true; } } \
    SBAR(); \
    GAPB(o[0]=__builtin_amdgcn_mfma_f32_32x32x16_bf16(PAF(0),VFR(0),o[0],0,0,0), C0,0); \
    GAPB(o[1]=__builtin_amdgcn_mfma_f32_32x32x16_bf16(PAF(0),VFR(4),o[1],0,0,0), C0,4); \
    KRD(GL,0); GAPB(o[0]=__builtin_amdgcn_mfma_f32_32x32x16_bf16(PAF(1),VFR(1),o[0],0,0,0), C0,8); \
    KRD(GL,1); GAPB(o[1]=__builtin_amdgcn_mfma_f32_32x32x16_bf16(PAF(1),VFR(5),o[1],0,0,0), C0,12); \
    KRD(GL,2); GAPB(o[0]=__builtin_amdgcn_mfma_f32_32x32x16_bf16(PAF(2),VFR(2),o[0],0,0,0), C1,0); \
    KRD(GL,3); GAPB(o[1]=__builtin_amdgcn_mfma_f32_32x32x16_bf16(PAF(2),VFR(6),o[1],0,0,0), C1,4); \
    GAPB(o[0]=__builtin_amdgcn_mfma_f32_32x32x16_bf16(PAF(3),VFR(3),o[0],0,0,0), C1,8); \
    GAPB(o[1]=__builtin_amdgcn_mfma_f32_32x32x16_bf16(PAF(3),VFR(7),o[1],0,0,0), C1,12); \
    }while(0)
  int t=1;
  #undef CMASK
  #define CMASK(P0,P1,t) do{}while(0)
  for(;t+5<NT;t+=2){
    STEP(pB0,pB1,pA0,pA1,t,true,true,true);     WAIT_BAR(2); RESC(); ROT();
    STEP(pA0,pA1,pB0,pB1,t+1,true,true,true);   WAIT_BAR(2); RESC(); ROT();
  }
  #undef CMASK
  #define CMASK(P0,P1,t) do{int jb_=(t)-(NT-4); if(jb_>=0)cmask(P0,P1,jb_,qrel,hi);}while(0)
  #define ENDW(tt) do{ if((tt)+3<NT){WAIT_BAR(2);} else if((tt)+2<NT){WAIT_BAR(1);} else {WAIT_BAR(0);} }while(0)
  for(;t+1<NT;t+=2){
    STEP(pB0,pB1,pA0,pA1,t,(t+3<NT),(t+1<NT),(t+1<NT));       ENDW(t);   RESC(); ROT();
    STEP(pA0,pA1,pB0,pB1,t+1,(t+4<NT),(t+2<NT),(t+2<NT));     ENDW(t+1); RESC(); ROT();
  }
  STEP(pB0,pB1,pA0,pA1,NT-1,false,false,false); RESC();
  { float sacc=pB0[0]+pB0[1]; _Pragma("unroll") for(int r=2;r<16;++r)sacc+=pB0[r]; _Pragma("unroll") for(int r=0;r<16;++r)sacc+=pB1[r]; l_reg+=sacc;
    pw0=(u32x4){PKW(pB0,0),PKW(pB0,2),PKW(pB0,4),PKW(pB0,6)};pw1=(u32x4){PKW(pB0,8),PKW(pB0,10),PKW(pB0,12),PKW(pB0,14)};pw2=(u32x4){PKW(pB1,0),PKW(pB1,2),PKW(pB1,4),PKW(pB1,6)};pw3=(u32x4){PKW(pB1,8),PKW(pB1,10),PKW(pB1,12),PKW(pB1,14)};
    SBAR(); pv(o,vb0+sl_cur,PAF(0),PAF(1),PAF(2),PAF(3)); }
  #undef PKW
  #undef PAF
  #undef VFR
  #undef PIN
  #undef MX3
  #undef GAPA
  #undef GAPB
  #undef EX
  #undef VRD
  #undef KRD
  #undef STEP
  #undef ENDW
  {auto rr=__builtin_amdgcn_permlane32_swap(__float_as_uint(l_reg),__float_as_uint(l_reg),false,false);l_reg=__uint_as_float(rr[0])+__uint_as_float(rr[1]);}
  if(hi==0)wsf[32+r32]=l_reg;asm volatile("s_waitcnt lgkmcnt(0)":::"memory");
  float rli[16];
  #pragma unroll
  for(int r=0;r<16;++r)rli[r]=__builtin_amdgcn_rcpf(wsf[32+crow(r,hi)]);
  bf16*Ow=O+(long)(q0+wid*QBLK)*OP;
  { bf16*stg=(bf16*)(shm+LDS_OST)+wid*2048;
    #pragma unroll
    for(int r=0;r<16;++r){const int orow=crow(r,hi);
      #pragma unroll
      for(int d0=0;d0<2;++d0)stg[orow*64+d0*32+r32]=__float2bfloat16(o[d0][r]*rli[r]);}
    asm volatile("s_waitcnt lgkmcnt(0)":::"memory");
    #pragma unroll
    for(int i=0;i<4;++i){const int row=i*8+(lane>>3),ch=lane&7; const u32x4 v=*(const u32x4*)(stg+row*64+ch*8); ATTN_STORE16(Ow+(long)row*OP+ch*8,v);} }
  asm volatile("s_waitcnt lgkmcnt(0)\n\ts_barrier":::"memory");
  #undef DMA_K
  #undef DMA_V
  #undef CMASK
  #undef START
  #undef RESC
  #undef ROT
}

constexpr int SLOTV=16384, L2_K=0, L2_V=NSLOT*SLOTB, L2_WS=L2_V+NSLOT*SLOTV, L2_BYTES=L2_WS+NW*64*4;
__device__ __forceinline__ void qkt0(f32x16&p0,f32x16&p1,const char*Kslot,const bf16x8*qr,int r32,int hi){
  const char*kb=Kslot+hi*1024+r32*16; const f32x16 z=f32x16{};
  #pragma unroll
  for(int d0=0;d0<4;++d0){
    const bf16x8 b0=*reinterpret_cast<const bf16x8*>(kb+d0*2048);
    const bf16x8 b1=*reinterpret_cast<const bf16x8*>(kb+d0*2048+512);
    if(d0==0){p0=__builtin_amdgcn_mfma_f32_32x32x16_bf16(b0,qr[0],z,0,0,0);p1=__builtin_amdgcn_mfma_f32_32x32x16_bf16(b1,qr[0],z,0,0,0);}
    else{p0=__builtin_amdgcn_mfma_f32_32x32x16_bf16(b0,qr[d0],p0,0,0,0);p1=__builtin_amdgcn_mfma_f32_32x32x16_bf16(b1,qr[d0],p1,0,0,0);}}
}
__device__ __forceinline__ void pv128(f32x16*o,int vb,bf16x8 pa0,bf16x8 pa1,bf16x8 pa2,bf16x8 pa3){
  #pragma unroll
  for(int d0=0;d0<4;++d0){s16x4 lo[4],hi[4];
    #pragma unroll
    for(int ks=0;ks<4;++ks){
      asm volatile("ds_read_b64_tr_b16 %0,%1 offset:%c2":"=&v"(lo[ks]):"v"(vb),"i"(d0*4096+ks*1024):"memory");
      asm volatile("ds_read_b64_tr_b16 %0,%1 offset:%c2":"=&v"(hi[ks]):"v"(vb),"i"(d0*4096+ks*1024+512):"memory");}
    asm volatile("s_waitcnt lgkmcnt(0)":::"memory");SBAR();
    #define PK(k) (bf16x8){lo[k][0],lo[k][1],lo[k][2],lo[k][3],hi[k][0],hi[k][1],hi[k][2],hi[k][3]}
    o[d0]=__builtin_amdgcn_mfma_f32_32x32x16_bf16(pa0,PK(0),o[d0],0,0,0);
    o[d0]=__builtin_amdgcn_mfma_f32_32x32x16_bf16(pa1,PK(1),o[d0],0,0,0);
    o[d0]=__builtin_amdgcn_mfma_f32_32x32x16_bf16(pa2,PK(2),o[d0],0,0,0);
    o[d0]=__builtin_amdgcn_mfma_f32_32x32x16_bf16(pa3,PK(3),o[d0],0,0,0);
    #undef PK
  }
}
template<int THRL> __device__ __forceinline__ void attn_unit128(int qb,const bf16*Q,const bf16*__restrict__ K,const bf16*__restrict__ V,bf16*O,char*shm,pg8::ConvCtx*cx){
  int tid_=threadIdx.x; asm volatile("":"+v"(tid_)); const int tid=tid_,lane=tid&63,r32=lane&31,hi=lane>>5; const int wid=__builtin_amdgcn_readfirstlane(tid>>6);
  const int q0=qb*QB;
  const bf16*Qw=Q+(long)(q0+wid*QBLK)*QP;
  const unsigned lds0=(unsigned)(uintptr_t)shm;
  float*wsf=(float*)(shm+L2_WS)+wid*64;
  const bf16*ksrc=K+(long)lane*KP+wid*8;
  const bf16*vsrc=V+(long)(16*(wid&3)+(lane>>2))*VP+(wid>>2)*32+(lane&3)*8;
  const unsigned kdst=lds0+L2_K+wid*1024, vdst=lds0+L2_V+wid*1024;
  #define DMA_K(t,slot) glds16(ksrc+(long)(t)*KVBLK*KP,(unsigned)__builtin_amdgcn_readfirstlane(kdst+(slot)))
  #define DMA_V(t,slot) do{ glds16(vsrc+(long)(t)*KVBLK*VP,(unsigned)__builtin_amdgcn_readfirstlane(vdst+2*(slot))); glds16(vsrc+64+(long)(t)*KVBLK*VP,(unsigned)__builtin_amdgcn_readfirstlane(vdst+2*(slot)+8192)); }while(0)
  const int vb0=(int)(lds0+L2_V)+((lane>>4)&1)*32+(lane&3)*8+(4*hi+((lane&15)>>2))*64;
  const char*Kbase=shm+L2_K; bf16x8 kf[8];
  const lds_cptr shm3=(lds_cptr)shm; const lds_cptr kp0=shm3+L2_K+hi*1024+r32*16; const lds_cptr vp0=shm3+L2_V+((lane>>4)&1)*32+(lane&3)*8+(4*hi+((lane&15)>>2))*64;
  const int NT=(q0+QB)/KVBLK;
  DMA_K(0,0);DMA_V(0,0);DMA_K(1,SLOTB);
  bf16x8 qr[4];
  #pragma unroll
  for(int d0=0;d0<4;++d0)qr[d0]=*reinterpret_cast<const bf16x8*>(&Qw[(long)r32*QP+d0*16+hi*8]);
  float l_reg=0.f;f32x16 o[4];
  ;o[0]=f32x16{};o[1]=f32x16{};o[2]=f32x16{};o[3]=f32x16{};
  const int qrel=wid*QBLK+r32;
  #define CMASK(P0,P1,t) do{int jb_=(t)-(NT-4); if(jb_>=0)cmask(P0,P1,jb_,qrel,hi);}while(0)
  #define RESC() do{}while(0)
  f32x16 pA0,pA1,pB0,pB1;
  int sl_prev=0,sl_cur=0,sl_next=SLOTB;
  #define ROT() do{sl_prev=sl_cur;sl_cur=sl_next;sl_next=(sl_next==(NSLOT-1)*SLOTB)?0:sl_next+SLOTB;}while(0)
  DMA_K(2,2*SLOTB);
  WAIT_BAR(4);
  qkt0(pA0,pA1,Kbase,qr,r32,hi);asm volatile("s_nop 15\n\ts_nop 7":"+v"(pA0),"+v"(pA1));CMASK(pA0,pA1,0);
  { _Pragma("unroll") for(int r=0;r<16;++r){pA0[r]=__builtin_amdgcn_exp2f(pA0[r]);pA1[r]=__builtin_amdgcn_exp2f(pA1[r]);} }
  WAIT_BAR(0);
  DMA_K(3,0);DMA_V(1,SLOTB);
  ROT();
  kload8(kf,kp0+sl_cur);
  WAIT_BAR(3);
  s16x4 vlo[8],vhi[8],vlo2[8],vhi2[8]; u32x4 pw0,pw1,pw2,pw3;
  #define PKW(P,B) cvtpk_s(P[B],P[B+1])
  #define PAF(k) __builtin_bit_cast(bf16x8,pw##k)
  #define VFR(i) (bf16x8){vlo[i][0],vlo[i][1],vlo[i][2],vlo[i][3],vhi[i][0],vhi[i][1],vhi[i][2],vhi[i][3]}
  #define VFR2(i) (bf16x8){vlo2[i][0],vlo2[i][1],vlo2[i][2],vlo2[i][3],vhi2[i][0],vhi2[i][1],vhi2[i][2],vhi2[i][3]}
  #define PIN(x) asm volatile("":"+v"(x))
  #define MX3(a,b,c) __builtin_fmaxf(__builtin_fmaxf((a),(b)),(c))
  #define GAPA(MF,A0,A1,A2,A3,W0,W1,PW) do{ MF; sacc+=A0; sacc+=A1; sacc+=A2; sacc+=A3; PIN(sacc); W0; W1; PIN(PW); SBAR(); }while(0)
  #define EX(v) __builtin_amdgcn_exp2f(v)
  #define GAPB(MF,X,B) do{ MF; X[B]=EX(X[B]); X[B+1]=EX(X[B+1]); PIN(X); SBAR(); }while(0)
  #define VRD(i) do{ vlo[i]=vtr(vp_+(((i)>>2)*4096+((i)&3)*1024)); vhi[i]=vtr(vp_+(((i)>>2)*4096+((i)&3)*1024+512)); }while(0)
  #define VRD2(i) do{ vlo2[i]=vtr(vp_+(8192+((i)>>2)*4096+((i)&3)*1024)); vhi2[i]=vtr(vp_+(8192+((i)>>2)*4096+((i)&3)*1024+512)); SBAR(); }while(0)
  #define KRD(G,j) do{ if(G){ kload2(kf,kp0+sl_next,j); SBAR(); } }while(0)
  #define MF32(a,b,c) __builtin_amdgcn_mfma_f32_32x32x16_bf16(a,b,c,0,0,0)
  #define STEP(C0,C1,P0,P1,t,GK,GV,GL) do{ SBAR(); \
    const lds_cptr vp_=vp0+2*sl_prev; const f32x16 z16_=f32x16{}; \
    VRD(0); SBAR(); float sacc=(P0[0]+P0[1]); \
    GAPA(C0=MF32(kf[0],qr[0],z16_), P0[2],P0[3],P0[4],P0[5],     pw0[0]=PKW(P0,0), pw0[1]=PKW(P0,2), pw0); \
    VRD(4); SBAR(); GAPA(C1=MF32(kf[1],qr[0],z16_), P0[6],P0[7],P0[8],P0[9],     pw0[2]=PKW(P0,4), pw0[3]=PKW(P0,6), pw0); \
    VRD(1); SBAR(); GAPA(C0=MF32(kf[2],qr[1],C0),   P0[10],P0[11],P0[12],P0[13], pw1[0]=PKW(P0,8), pw1[1]=PKW(P0,10), pw1); \
    VRD(5); SBAR(); GAPA(C1=MF32(kf[3],qr[1],C1),   P0[14],P0[15],P1[0],P1[1],   pw1[2]=PKW(P0,12),pw1[3]=PKW(P0,14), pw1); \
    VRD(2); SBAR(); GAPA(C0=MF32(kf[4],qr[2],C0),   P1[2],P1[3],P1[4],P1[5],     pw2[0]=PKW(P1,0), pw2[1]=PKW(P1,2), pw2); \
    VRD(6); SBAR(); GAPA(C1=MF32(kf[5],qr[2],C1),   P1[6],P1[7],P1[8],P1[9],     pw2[2]=PKW(P1,4), pw2[3]=PKW(P1,6), pw2); \
    VRD(3); SBAR(); GAPA(C0=MF32(kf[6],qr[3],C0),   P1[10],P1[11],P1[12],P1[13], pw3[0]=PKW(P1,8), pw3[1]=PKW(P1,10), pw3); \
    VRD(7); SBAR(); GAPA(C1=MF32(kf[7],qr[3],C1),   P1[14],P1[15],0.f,0.f,       pw3[2]=PKW(P1,12),pw3[3]=PKW(P1,14), pw3); \
    l_reg+=sacc; \
    if(GK){DMA_K((t)+3,sl_cur);} if(GV){DMA_V((t)+1,sl_next);} \
    CMASK(C0,C1,t); \
    SBAR(); \
    VRD2(0); GAPB(o[0]=MF32(PAF(0),VFR(0),o[0]), C0,0); \
    VRD2(4); GAPB(o[1]=MF32(PAF(0),VFR(4),o[1]), C0,2); \
    VRD2(1); GAPB(o[0]=MF32(PAF(1),VFR(1),o[0]), C0,4); \
    VRD2(5); GAPB(o[1]=MF32(PAF(1),VFR(5),o[1]), C0,6); \
    VRD2(2); GAPB(o[0]=MF32(PAF(2),VFR(2),o[0]), C0,8); \
    VRD2(6); GAPB(o[1]=MF32(PAF(2),VFR(6),o[1]), C0,10); \
    VRD2(3); GAPB(o[0]=MF32(PAF(3),VFR(3),o[0]), C0,12); \
    VRD2(7); GAPB(o[1]=MF32(PAF(3),VFR(7),o[1]), C0,14); \
    GAPB(o[2]=MF32(PAF(0),VFR2(0),o[2]), C1,0); \
    GAPB(o[3]=MF32(PAF(0),VFR2(4),o[3]), C1,2); \
    KRD(GL,0); GAPB(o[2]=MF32(PAF(1),VFR2(1),o[2]), C1,4); \
    KRD(GL,1); GAPB(o[3]=MF32(PAF(1),VFR2(5),o[3]), C1,6); \
    KRD(GL,2); GAPB(o[2]=MF32(PAF(2),VFR2(2),o[2]), C1,8); \
    KRD(GL,3); GAPB(o[3]=MF32(PAF(2),VFR2(6),o[3]), C1,10); \
    GAPB(o[2]=MF32(PAF(3),VFR2(3),o[2]), C1,12); \
    GAPB(o[3]=MF32(PAF(3),VFR2(7),o[3]), C1,14); \
    }while(0)
  int t=1;
  #undef CMASK
  #define CMASK(P0,P1,t) do{}while(0)
  for(;t+5<NT;t+=2){
    int cn=0;
    { PG8_LAS unsigned char* l3=(PG8_LAS unsigned char*)(__attribute__((address_space(3))) char*)shm3;
      if(cx->sub>=0){ pg8::conv_finish(*cx,l3,cx->slot0,lane,cx->sub); cx->sub=-1; cn+=1; }
      const int s_=cx->cw+cx->nseq*cx->jn; if(s_<pg8::CONV_NSUB){ pg8::conv_issue(*cx,l3,cx->slot0,lane,s_); cx->sub=s_; ++cx->jn; cn+=4; } }
    STEP(pB0,pB1,pA0,pA1,t,true,true,true);
    if(cn==5){WAIT_BAR(8);} else if(cn==4){WAIT_BAR(7);} else if(cn==1){WAIT_BAR(4);} else {WAIT_BAR(3);}
    RESC(); ROT();
    STEP(pA0,pA1,pB0,pB1,t+1,true,true,true);   WAIT_BAR(3); RESC(); ROT();
  }
  #undef CMASK
  #define CMASK(P0,P1,t) do{int jb_=(t)-(NT-4); if(jb_>=0)cmask(P0,P1,jb_,qrel,hi);}while(0)
  #define ENDW(tt) do{ if((tt)+3<NT){WAIT_BAR(3);} else if((tt)+2<NT){WAIT_BAR(2);} else {WAIT_BAR(0);} }while(0)
  for(;t+1<NT;t+=2){
    STEP(pB0,pB1,pA0,pA1,t,(t+3<NT),(t+1<NT),(t+1<NT));       ENDW(t);   RESC(); ROT();
    STEP(pA0,pA1,pB0,pB1,t+1,(t+4<NT),(t+2<NT),(t+2<NT));     ENDW(t+1); RESC(); ROT();
  }
  STEP(pB0,pB1,pA0,pA1,NT-1,false,false,false); RESC();
  { float sacc=pB0[0]+pB0[1]; _Pragma("unroll") for(int r=2;r<16;++r)sacc+=pB0[r]; _Pragma("unroll") for(int r=0;r<16;++r)sacc+=pB1[r]; l_reg+=sacc;
    pw0=(u32x4){PKW(pB0,0),PKW(pB0,2),PKW(pB0,4),PKW(pB0,6)};pw1=(u32x4){PKW(pB0,8),PKW(pB0,10),PKW(pB0,12),PKW(pB0,14)};pw2=(u32x4){PKW(pB1,0),PKW(pB1,2),PKW(pB1,4),PKW(pB1,6)};pw3=(u32x4){PKW(pB1,8),PKW(pB1,10),PKW(pB1,12),PKW(pB1,14)};
    SBAR(); pv128(o,vb0+2*sl_cur,PAF(0),PAF(1),PAF(2),PAF(3)); }
  #undef PKW
  #undef PAF
  #undef VFR
  #undef VFR2
  #undef PIN
  #undef MX3
  #undef GAPA
  #undef GAPB
  #undef EX
  #undef VRD
  #undef VRD2
  #undef KRD
  #undef MF32
  #undef STEP
  #undef ENDW
  {auto rr=__builtin_amdgcn_permlane32_swap(__float_as_uint(l_reg),__float_as_uint(l_reg),false,false);l_reg=__uint_as_float(rr[0])+__uint_as_float(rr[1]);}
  if(hi==0)wsf[32+r32]=l_reg;asm volatile("s_waitcnt lgkmcnt(0)":::"memory");
  float rli[16];
  #pragma unroll
  for(int r=0;r<16;++r)rli[r]=__builtin_amdgcn_rcpf(wsf[32+crow(r,hi)]);
  asm volatile("s_waitcnt lgkmcnt(0)\n\ts_barrier":::"memory");
  bf16*Ow=O+(long)(q0+wid*QBLK)*OP;
  { bf16*stg=(bf16*)(shm)+wid*4096;
    #pragma unroll
    for(int r=0;r<16;++r){const int orow=crow(r,hi);
      #pragma unroll
      for(int d0=0;d0<4;++d0)stg[orow*128+d0*32+r32]=__float2bfloat16(o[d0][r]*rli[r]);}
    asm volatile("s_waitcnt lgkmcnt(0)":::"memory");
    #pragma unroll
    for(int i=0;i<8;++i){const int row=i*4+(lane>>4),ch=lane&15; const u32x4 v=*(const u32x4*)(stg+row*128+ch*8); ATTN_STORE16(Ow+(long)row*OP+ch*8,v);} }
  asm volatile("s_waitcnt lgkmcnt(0)\n\ts_barrier":::"memory");
  #undef DMA_K
  #undef DMA_V
  #undef CMASK
  #undef RESC
  #undef ROT
}
constexpr int ATTN_LDS_BYTES=LDS_BYTES;
#undef SBAR
#undef WAIT_BAR
}
#ifndef REPEAT_PHASE
#define REPEAT_PHASE -1
#endif
constexpr int NWAVES = 8;
using cfg::T; using cfg::SEQ; using cfg::D; using cfg::NIN; using cfg::NE; using cfg::EPS; using cfg::MAXROWS;

constexpr size_t MiB = 1u << 20;
constexpr size_t WS_CTL = 0, CTL_ZERO_BYTES = 1 * MiB;
constexpr size_t WS_RCOS = 1 * MiB, WS_RSIN = 2 * MiB;
constexpr size_t WS_TKE = 3 * MiB, WS_TKP = WS_TKE + 256 * 1024, WS_TKG = WS_TKP + 256 * 1024, WS_TSLOT = WS_TKG + 256 * 1024;
constexpr size_t WS_RGATE = 4 * MiB;
constexpr size_t WS_BLKBASE = 4 * MiB + 512 * 1024;
constexpr size_t WS_SSQ = 5 * MiB;
constexpr size_t WS_WIN = 8 * MiB;
constexpr size_t WS_WBR = 23 * MiB;
constexpr size_t WS_WOUT = 26 * MiB;
constexpr size_t WS_WGU = 28 * MiB;
constexpr size_t WS_WDN = 156 * MiB;
constexpr size_t WS_HN = 220 * MiB;
constexpr size_t WS_KVM = 254 * MiB;
constexpr size_t WS_Q = 256 * MiB, WS_K = 272 * MiB, WS_V = 288 * MiB, WS_U = 304 * MiB, WS_CB = 320 * MiB, WS_MQ = 336 * MiB;
constexpr size_t WS_GATES = 352 * MiB;
constexpr size_t WS_OMAPS = 448 * MiB;
constexpr size_t WS_YALL = 480 * MiB;
constexpr size_t WS_MERGED = 528 * MiB;
constexpr size_t WS_H2 = 560 * MiB;
constexpr size_t WS_XS = 256 * MiB;
constexpr size_t WS_ACT = 400 * MiB;
constexpr size_t WS_HN8 = 576 * MiB;
constexpr size_t WS_WG8 = 592 * MiB;
constexpr size_t WS_END = 596 * MiB;
static_assert(WS_XS + (size_t)MAXROWS * 2048 <= WS_ACT && WS_ACT + (size_t)MAXROWS * 2048 <= WS_H2, "MoE overlays");
constexpr int CW_QUEUE = 1024;
constexpr int CW_GCNT = 64;
constexpr int CW_BAR = 4096;
constexpr int RING_OFF = 0, RING_BYTES = 131072;
constexpr int LDSCTL_OFF = RING_BYTES, MISC_OFF = LDSCTL_OFF + 320;
constexpr int L_PREFT = LDSCTL_OFF + 1024, L_PSTART = L_PREFT + 256, L_LCNT = L_PSTART + 256, L_LBASE = L_LCNT + 128;
constexpr int L_PART = LDSCTL_OFF + 8192;
constexpr int MOE_ETAB = (L_PART - L_PREFT) / 4;
constexpr int L_WSF = LDSCTL_OFF + 4096;
constexpr int LDS_BYTES = 163840;
constexpr int CONV_SLOTS = LDSCTL_OFF;

struct NoHooks { __device__ __forceinline__ void a_ready(const pg8::Unit&) const {} __device__ __forceinline__ void done(const pg8::Unit&) const {} };
struct ProjOrder : NoHooks {
    const char* A; const char* Bt; int G, c;
    __device__ __forceinline__ bool next(int i, pg8::Unit& u) const {
        const int L = i * G + c; int pm, pn;
        if (L < 64 * 14) pg8::static_map(L, 64, 14, pm, pn); else if (L < 64 * 14 + 8) { pm = 64 + ((L - 64 * 14) >> 2); pn = 26 + ((L - 64 * 14) & 3); } else return false;
        u.pm = pm; u.pn = pn; u.aux = 0; u.a = A + (size_t)pm * (256 * 2048); u.b = Bt + (size_t)pn * (256 * 2048); return true; }
};
struct GateOrder : NoHooks {
    const char* A; const char* Bt; int G, c;
    __device__ __forceinline__ bool next(int i, pg8::Unit& u) const {
        const int L = i * G + c; if (L >= 64 * 12) return false; int pm, pn; pg8::static_map(L, 64, 12, pm, pn);
        u.pm = pm; u.pn = pn; u.aux = 0; u.a = A + (size_t)pm * (256 * 1024); u.b = Bt + (size_t)pn * (256 * 1024); return true; }
};
struct MergeOrder : NoHooks {
    const char* Y; const char* Bt; int G, c;
    __device__ __forceinline__ bool next(int i, pg8::Unit& u) const {
        const int j = i / 3, br = i - 3 * j; const int L = j * G + c; if (L >= 256) return false; int pm, pn; pg8::static_map(L, 64, 4, pm, pn);
        u.pm = pm; u.pn = pn; u.aux = br; u.a = Y + (size_t)pm * (256 * 3072) + br * 1024; u.b = Bt + (size_t)(br * 1024 + pn * 256) * 1024; return true; }
};
struct OutOrder : NoHooks {
    const char* A; const char* Bt; int G, c;
    __device__ __forceinline__ bool next(int i, pg8::Unit& u) const {
        const int L = i * G + c; if (L >= 256) return false; int pm, pn; pg8::static_map(L, 64, 4, pm, pn);
        u.pm = pm; u.pn = pn; u.aux = 0; u.a = A + (size_t)pm * (256 * 2048); u.b = Bt + (size_t)pn * (256 * 2048); return true; }
};
struct MoeOrder : NoHooks {
    const char* A; const char* Bt; const volatile __attribute__((address_space(3))) int* prefT; int ncol, G, c; size_t tile_bytes;
    __device__ __forceinline__ bool next(int i, pg8::Unit& u) const {
        const int L = i * G + c; const int rt = L / ncol, pnl = L - rt * ncol; if (rt >= prefT[32]) return false;
        const int e = prefT[MOE_ETAB + rt];
        u.pm = rt; u.pn = e * ncol + pnl; u.aux = e; u.a = A + (size_t)rt * tile_bytes; u.b = Bt + (size_t)(e * ncol + pnl) * tile_bytes; return true; }
};

#define GAS __attribute__((address_space(1)))
#define LAS __attribute__((address_space(3)))
typedef unsigned short bf16;
typedef unsigned v4u __attribute__((ext_vector_type(4)));
typedef unsigned v2u __attribute__((ext_vector_type(2)));
typedef float f32x4 __attribute__((ext_vector_type(4)));
typedef float f32x16 __attribute__((ext_vector_type(16)));
typedef short bf16x8 __attribute__((ext_vector_type(8)));
typedef GAS unsigned gu32;
#define RLX_AGENT __ATOMIC_RELAXED, __HIP_MEMORY_SCOPE_AGENT
#define LDS_WAIT() asm volatile("s_waitcnt lgkmcnt(0)" ::: "memory")
#define VM_WAIT() asm volatile("s_waitcnt vmcnt(0)" ::: "memory")
__device__ __forceinline__ unsigned f2bf(float f) { unsigned u = __builtin_bit_cast(unsigned, f); return (u + 0x7fffu + ((u >> 16) & 1u)) >> 16; }
__device__ __forceinline__ unsigned pk2(float lo, float hi) { return f2bf(lo) | (f2bf(hi) << 16); }
__device__ __forceinline__ float bflo(unsigned w) { return __uint_as_float(w << 16); }
__device__ __forceinline__ float bfhi(unsigned w) { return __uint_as_float(w & 0xffff0000u); }
__device__ __forceinline__ float wave_sum(float v) {
#pragma unroll
    for (int o = 1; o < 64; o <<= 1) v += __shfl_xor(v, o);
    return v;
}

#define XB_TMO      128
#define XB_XCNT(j)  (256  + 64 * (j))
#define XB_XSUB(j)  (1280 + 64 * (j))
#define XB_XGEN(j)  (2304 + 64 * (j))
#define XB_TOP      3328
#define XB_TOPGEN   3392
#define XCD_BAR_WORDS 3456
#define XB_SPIN_CAP (1u << 18)

__device__ __forceinline__ unsigned xb_ld(unsigned* p)              { return __hip_atomic_load(p, __ATOMIC_RELAXED, __HIP_MEMORY_SCOPE_AGENT); }
__device__ __forceinline__ unsigned xb_add(unsigned* p, unsigned v) { return __hip_atomic_fetch_add(p, v, __ATOMIC_RELAXED, __HIP_MEMORY_SCOPE_AGENT); }
__device__ __forceinline__ unsigned xb_xcc_id() { return (unsigned)__builtin_amdgcn_s_getreg((3 << 11) | 20) & 0xFu; }
#define XB_SPIN(cond, bar) do { unsigned _sp = 0; while (cond) { __builtin_amdgcn_s_sleep(1); \
    if ((++_sp & 255u) == 0u) { if (xb_ld(&(bar)[XB_TMO])) break; if (_sp > XB_SPIN_CAP) { atomicAdd(&(bar)[XB_TMO], 1u); break; } } } } while (0)

struct XcdBarrier {
    unsigned* bar; unsigned x;
    volatile LAS unsigned* st;
};

__device__ __forceinline__ XcdBarrier xcd_barrier_post(unsigned* bar, volatile LAS unsigned* st) {
    XcdBarrier b; b.bar = bar; b.x = xb_xcc_id(); b.st = st;
    if (threadIdx.x == 0) (void)xb_add(&bar[XB_XCNT(b.x)], 1u);
    return b;
}
__device__ __forceinline__ void xcd_barrier_complete(unsigned* bar, unsigned x, unsigned& nloc, unsigned& nx) {
    const unsigned G = gridDim.x * gridDim.y * gridDim.z;
    unsigned sum, cnt, mine, sp = 0u;
    for (;;) {
        sum = 0u; cnt = 0u; mine = 0u;
#pragma unroll
        for (unsigned j = 0; j < 16; ++j) { const unsigned c = xb_ld(&bar[XB_XCNT(j)]); sum += c; cnt += (c > 0u) ? 1u : 0u; mine = (j == x) ? c : mine; }
        if (sum == G) break;
        __builtin_amdgcn_s_sleep(1);
        if ((++sp & 255u) == 0u) { if (xb_ld(&bar[XB_TMO])) break; if (sp > XB_SPIN_CAP) { atomicAdd(&bar[XB_TMO], 1u); break; } }
    }
    nloc = mine > 0u ? mine : 1u; nx = cnt > 0u ? cnt : 1u;
}

__device__ __forceinline__ void xcd_barrier(const XcdBarrier& b) {
    asm volatile("s_waitcnt vmcnt(0)" ::: "memory");
    __syncthreads();
    if (threadIdx.x == 0) {
        unsigned* bar = b.bar;
        __builtin_amdgcn_s_waitcnt(0);
        unsigned nloc = b.st[0], nx = b.st[1];
        if (nloc == 0u) { xcd_barrier_complete(bar, b.x, nloc, nx); b.st[0] = nloc; b.st[1] = nx; }
        const unsigned old = xb_add(&bar[XB_XSUB(b.x)], 1u);
        const unsigned gen = old / nloc;
        if (old + 1u == (gen + 1u) * nloc) {
            __builtin_amdgcn_fence(__ATOMIC_RELEASE, "agent");
            asm volatile("s_waitcnt vmcnt(0)" ::: "memory");
            const unsigned og = xb_add(&bar[XB_TOP], 1u);
            const unsigned tg = og / nx;
            if (og + 1u == (tg + 1u) * nx) xb_add(&bar[XB_TOPGEN], 1u);
            else XB_SPIN(xb_ld(&bar[XB_TOPGEN]) == tg, bar);
            __builtin_amdgcn_fence(__ATOMIC_ACQUIRE, "agent");
            xb_add(&bar[XB_XGEN(b.x)], 1u);
            asm volatile("s_waitcnt vmcnt(0)" ::: "memory");
        } else {
            XB_SPIN(xb_ld(&bar[XB_XGEN(b.x)]) == gen, bar);
            __builtin_amdgcn_fence(__ATOMIC_ACQUIRE, "agent");
            asm volatile("s_waitcnt vmcnt(0)" ::: "memory");
        }
    }
    __syncthreads();
}

struct Args { const float* in[25]; float* out; unsigned char* ws; int ph_lo, ph_hi; };
__device__ __forceinline__ int ip32(int r) { return 16 * ((r >> 2) & 1) + 4 * (r >> 3) + (r & 3); }
__device__ __forceinline__ void p0_transpose_item(const float* W, int ldn, int K, bf16* WT, int k0, int n0, int dst_row_base, bool perm, LAS float* scr, int lane) {
    float rr_[32];
#pragma unroll
    for (int i = 0; i < 32; ++i) rr_[i] = W[(size_t)(k0 + 2 * i + (lane >> 5)) * ldn + n0 + (lane & 31)];
#pragma unroll
    for (int i = 0; i < 32; ++i) scr[(2 * i + (lane >> 5)) * 33 + (lane & 31)] = rr_[i];
    LDS_WAIT(); asm volatile("" ::: "memory");
    const int c = lane & 7;
#pragma unroll
    for (int j = 0; j < 4; ++j) { const int n = (lane >> 3) + 8 * j; const LAS float* s = scr + (8 * c) * 33 + n;
        v4u o; o.x = pk2(s[0 * 33], s[1 * 33]); o.y = pk2(s[2 * 33], s[3 * 33]); o.z = pk2(s[4 * 33], s[5 * 33]); o.w = pk2(s[6 * 33], s[7 * 33]);
        *(GAS v4u*)(WT + (size_t)(dst_row_base + (perm ? ip32(n) : n)) * K + k0 + 8 * c) = o; }
    LDS_WAIT(); asm volatile("" ::: "memory");
}
__device__ __forceinline__ void p0_f8_load(float (&rr_)[32], const float* W, int ldn, int k0, int n0, int lane) {
#pragma unroll
    for (int i = 0; i < 8; ++i) { const f32x4 v = __builtin_nontemporal_load((const f32x4*)(W + (size_t)(k0 + 8 * i + (lane >> 3)) * ldn + n0 + (lane & 7) * 4));
        rr_[4 * i] = v.x; rr_[4 * i + 1] = v.y; rr_[4 * i + 2] = v.z; rr_[4 * i + 3] = v.w; }
}
__device__ __forceinline__ void p0_f8_finish(const float (&rr_)[32], int K, unsigned char* WT, int k0, int dst_row_base, LAS float* scr, int lane, const float S32) {
#pragma unroll
    for (int i = 0; i < 8; ++i) { LAS float* sp = scr + (8 * i + (lane >> 3)) * 33 + (lane & 7) * 4; sp[0] = rr_[4 * i]; sp[1] = rr_[4 * i + 1]; sp[2] = rr_[4 * i + 2]; sp[3] = rr_[4 * i + 3]; }
    LDS_WAIT(); asm volatile("" ::: "memory");
    const int n = lane >> 1, hf = lane & 1; const LAS float* s = scr + (32 * hf) * 33 + n;
    v4u o0, o1;
    o0.x = pg8::pk4_fp8(S32 * s[0 * 33], S32 * s[1 * 33], S32 * s[2 * 33], S32 * s[3 * 33]); o0.y = pg8::pk4_fp8(S32 * s[4 * 33], S32 * s[5 * 33], S32 * s[6 * 33], S32 * s[7 * 33]);
    o0.z = pg8::pk4_fp8(S32 * s[8 * 33], S32 * s[9 * 33], S32 * s[10 * 33], S32 * s[11 * 33]); o0.w = pg8::pk4_fp8(S32 * s[12 * 33], S32 * s[13 * 33], S32 * s[14 * 33], S32 * s[15 * 33]);
    o1.x = pg8::pk4_fp8(S32 * s[16 * 33], S32 * s[17 * 33], S32 * s[18 * 33], S32 * s[19 * 33]); o1.y = pg8::pk4_fp8(S32 * s[20 * 33], S32 * s[21 * 33], S32 * s[22 * 33], S32 * s[23 * 33]);
    o1.z = pg8::pk4_fp8(S32 * s[24 * 33], S32 * s[25 * 33], S32 * s[26 * 33], S32 * s[27 * 33]); o1.w = pg8::pk4_fp8(S32 * s[28 * 33], S32 * s[29 * 33], S32 * s[30 * 33], S32 * s[31 * 33]);
    GAS v4u* dp = (GAS v4u*)(WT + (size_t)(dst_row_base + ip32(n)) * K + k0 + 32 * hf);
    dp[0] = o0; dp[1] = o1;
    LDS_WAIT(); asm volatile("" ::: "memory");
}
__device__ __forceinline__ void conv_drain(pg8::ConvCtx& c, LAS unsigned char* lds, int wave, int lane) {
    asm volatile("s_waitcnt vmcnt(0)" ::: "memory");
    if (c.sub >= 0) { pg8::conv_finish(c, lds, c.slot0, lane, c.sub); c.sub = -1; }
    __syncthreads();
    const unsigned base = (unsigned)(RING_OFF + wave * 16384);
    int sub[4], aft[4];
#pragma unroll
    for (int i = 0; i < 4; ++i) { sub[i] = -1; aft[i] = 0; }
#pragma unroll
    for (int i = 0; i < 4; ++i) { const int s = c.cw + c.nseq * c.jn;
        if (s < pg8::CONV_NSUB) { pg8::conv_issue(c, lds, base + i * 4096, lane, s); sub[i] = s; ++c.jn;
#pragma unroll
            for (int k = 0; k < 4; ++k) aft[k] += 4;
            aft[i] = 0; } }
    for (;;) {
        bool any = false;
#pragma unroll
        for (int i = 0; i < 4; ++i) {
            if (sub[i] < 0) continue;
            any = true;
            const int a = aft[i];
            if (a >= 15) asm volatile("s_waitcnt vmcnt(15)" ::: "memory"); else if (a >= 12) asm volatile("s_waitcnt vmcnt(12)" ::: "memory");
            else if (a >= 8) asm volatile("s_waitcnt vmcnt(8)" ::: "memory"); else if (a >= 4) asm volatile("s_waitcnt vmcnt(4)" ::: "memory"); else asm volatile("s_waitcnt vmcnt(0)" ::: "memory");
            pg8::conv_finish(c, lds, base + i * 4096, lane, sub[i]); sub[i] = -1;
#pragma unroll
            for (int k = 0; k < 4; ++k) aft[k] += 1;
            const int s = c.cw + c.nseq * c.jn;
            if (s < pg8::CONV_NSUB) { pg8::conv_issue(c, lds, base + i * 4096, lane, s); sub[i] = s; ++c.jn;
#pragma unroll
                for (int k = 0; k < 4; ++k) aft[k] += 4;
                aft[i] = 0; }
        }
        if (!any) break;
    }
}
__device__ __forceinline__ int win_group_base(int L0) {
    if (L0 < 1024) { const int l = L0 & 255; return (L0 & ~255) + 128 * ((l >> 5) & 1) + 32 * (l >> 6); }
    if (L0 < 1536) return L0;
    if (L0 < 2048) return L0 - 1536 + 2560;
    if (L0 < 3072) { const int which = L0 >= 2560, ch = (L0 - 2048) & 511; return 256 * (6 + (ch >> 7)) + 128 * which + 32 * ((ch >> 5) & 3); }
    return L0;
}
__device__ __forceinline__ void rms_row_to_bf16(const float* xrow, const float* g, bf16* orow, int lane, unsigned char* orow8 = nullptr) {
    const GAS f32x4* xr = (const GAS f32x4*)xrow + lane; const GAS f32x4* gr = (const GAS f32x4*)g + lane;
    f32x4 v[4]; float s = 0.f;
#pragma unroll
    for (int j = 0; j < 4; ++j) { v[j] = xr[64 * j]; s += (v[j].x * v[j].x + v[j].y * v[j].y) + (v[j].z * v[j].z + v[j].w * v[j].w); }
    const float r = 1.0f / sqrtf(wave_sum(s) * (1.0f / 1024.0f) + EPS);
    GAS unsigned long long* o8 = (GAS unsigned long long*)orow + lane;
#pragma unroll
    for (int j = 0; j < 4; ++j) { const f32x4 gg = gr[64 * j]; o8[64 * j] = (unsigned long long)pk2(v[j].x * r * gg.x, v[j].y * r * gg.y) | ((unsigned long long)pk2(v[j].z * r * gg.z, v[j].w * r * gg.w) << 32);
        if (orow8) ((GAS unsigned*)orow8)[64 * j + lane] = pg8::pk4_fp8(v[j].x * r * gg.x, v[j].y * r * gg.y, v[j].z * r * gg.z, v[j].w * r * gg.w); }
}


__device__ __forceinline__ void p0_prologue(const Args& a, LAS unsigned char* lds, int vcu, int G, int wave, int lane, int tid) {
    LAS float* scr = (LAS float*)(lds + RING_OFF + wave * 16384);
    const int gw = vcu * NWAVES + wave, NGW = G * NWAVES;
    unsigned char* ws = a.ws;
    constexpr int I_IN = 16 * 112, I_G8 = 16 * 96, I_KV = 16 * 32, I_BR = 3 * 8 * 32, I_OUT = 16 * 32;
    constexpr int NITEMS = I_IN + I_G8 + I_KV + I_BR + I_OUT;
    for (int it = gw; it < NITEMS; it += NGW) {
        int r = it;
        if (r < I_IN) { const int kb = r / 112, nb = r % 112; p0_transpose_item(a.in[3], NIN, 1024, (bf16*)(ws + WS_WIN), 64 * kb, 32 * nb, win_group_base(32 * nb), true, scr, lane); continue; } r -= I_IN;
        if (r < I_G8) { const int kb = r / 96, nb = r % 96; float rr8[32]; p0_f8_load(rr8, a.in[3], NIN, 64 * kb, 3584 + 32 * nb, lane); p0_f8_finish(rr8, 1024, ws + WS_WG8, 64 * kb, 32 * nb, scr, lane, -32.0f * 1.4426950408889634f); continue; } r -= I_G8;
        if (r < I_KV) { const int kb = r / 32, nb = r % 32; p0_transpose_item(a.in[13], 1024, 1024, (bf16*)(ws + WS_WIN), 64 * kb, 32 * nb, 6656 + 32 * nb, true, scr, lane); continue; } r -= I_KV;
        if (r < I_BR) { const int br = r / 256, q = r % 256, kb = q / 32, nb = q % 32; p0_transpose_item(a.in[16] + (size_t)br * 512 * 1024, 1024, 512, (bf16*)(ws + WS_WBR), 64 * kb, 32 * nb, br * 1024 + 32 * nb, true, scr, lane); continue; } r -= I_BR;
        { const int kb = r / 32, nb = r % 32; p0_transpose_item(a.in[17], 1024, 1024, (bf16*)(ws + WS_WOUT), 64 * kb, 32 * nb, 32 * nb, true, scr, lane); }
    }
    bf16* HN = (bf16*)(ws + WS_HN);
    for (int m = gw; m < T + 512; m += NGW) {
        if (m < T) rms_row_to_bf16(a.in[0] + (size_t)m * D, a.in[2], HN + (size_t)m * D, lane, ws + WS_HN8 + (size_t)m * D);
        else rms_row_to_bf16(a.in[1] + (size_t)(m - T) * D, a.in[12], HN + (size_t)m * D, lane);
    }
    float* rc = (float*)(ws + WS_RCOS); float* rs = (float*)(ws + WS_RSIN);
    for (int i = gw * 64 + lane; i < SEQ * 32; i += NGW * 64) { const int pos = i >> 5, f = i & 31;
        const float inv_freq = 1.0f / powf(10000.0f, (float)(2 * f) / 64.0f); const float ang = (float)pos * inv_freq; rc[i] = cosf(ang); rs[i] = sinf(ang); }
}

__device__ __forceinline__ void phase_finish(const Args& a, int vcu, int G, int wave, int lane) {
    unsigned char* ws = a.ws; const int gw = vcu * NWAVES + wave, NGW = G * NWAVES;
    const bf16* OM = (const bf16*)(ws + WS_OMAPS); const bf16* U = (const bf16*)(ws + WS_U); const bf16* CB = (const bf16*)(ws + WS_CB); bf16* Y = (bf16*)(ws + WS_YALL);
    const float lam = expf(wave_sum(a.in[6][lane] * a.in[7][lane])) - expf(wave_sum(a.in[8][lane] * a.in[9][lane])) + 0.2f;
    const int hh = lane >> 4, c8 = (lane & 15) * 8;
    f32x4 gs0 = *(const f32x4*)(a.in[10] + c8), gs1 = *(const f32x4*)(a.in[10] + c8 + 4);
    f32x4 w0a = *(const f32x4*)(a.in[11] + lane * 8), w0b = *(const f32x4*)(a.in[11] + lane * 8 + 4);
    f32x4 w1a = *(const f32x4*)(a.in[11] + 512 + lane * 8), w1b = *(const f32x4*)(a.in[11] + 512 + lane * 8 + 4);
    f32x4 w2a = *(const f32x4*)(a.in[11] + 1024 + lane * 8), w2b = *(const f32x4*)(a.in[11] + 1024 + lane * 8 + 4);
    for (int t = gw; t < T; t += NGW) {
        {
            const v4u o0 = *(const v4u*)(OM + (size_t)t * 1024 + hh * 256 + c8), o1 = *(const v4u*)(OM + (size_t)t * 1024 + hh * 256 + 128 + c8);
            const f32x4 a0 = pg8::unpk_lo(o0) - lam * pg8::unpk_lo(o1), a1 = pg8::unpk_hi(o0) - lam * pg8::unpk_hi(o1);
            float ss = ((a0[0] * a0[0] + a0[1] * a0[1]) + (a0[2] * a0[2] + a0[3] * a0[3])) + ((a1[0] * a1[0] + a1[1] * a1[1]) + (a1[2] * a1[2] + a1[3] * a1[3]));
            ss += __shfl_xor(ss, 1); ss += __shfl_xor(ss, 2); ss += __shfl_xor(ss, 4); ss += __shfl_xor(ss, 8);
            const float r = 0.8f / sqrtf(ss * (1.0f / 128.0f) + EPS);
            *(v4u*)(Y + (size_t)t * 1536 + hh * 128 + c8) = pg8::pack8(a0 * gs0 * r, a1 * gs1 * r);
        }
        {
            const int s = t & (SEQ - 1); const v4u z = {0u, 0u, 0u, 0u};
            const v4u u0 = *(const v4u*)(U + (size_t)t * 512 + lane * 8);
            const v4u u1 = s >= 1 ? *(const v4u*)(U + (size_t)(t - 1) * 512 + lane * 8) : z;
            const v4u u2 = s >= 2 ? *(const v4u*)(U + (size_t)(t - 2) * 512 + lane * 8) : z;
            const v4u cb = *(const v4u*)(CB + (size_t)t * 512 + lane * 8);
            const f32x4 ya = pg8::unpk_lo(cb) * (w0a * pg8::unpk_lo(u2) + w1a * pg8::unpk_lo(u1) + w2a * pg8::unpk_lo(u0));
            const f32x4 yb = pg8::unpk_hi(cb) * (w0b * pg8::unpk_hi(u2) + w1b * pg8::unpk_hi(u1) + w2b * pg8::unpk_hi(u0));
            *(v4u*)(Y + (size_t)t * 1536 + 512 + lane * 8) = pg8::pack8(ya, yb);
        }
    }
}

#define DPPF(x, ctrl) __uint_as_float(__builtin_amdgcn_update_dpp(0u, __float_as_uint(x), (ctrl), 0xf, 0xf, false))
__device__ __forceinline__ float lane_xor32(float x, int lane) { auto r = __builtin_amdgcn_permlane32_swap(__float_as_uint(x), __float_as_uint(x), false, false); return __uint_as_float((lane & 32) ? r[0] : r[1]); }
__device__ __forceinline__ float lane_xor16(float x, int lane) { auto r = __builtin_amdgcn_permlane16_swap(__float_as_uint(x), __float_as_uint(x), false, false); return __uint_as_float((lane & 16) ? r[0] : r[1]); }
__device__ __forceinline__ float wave_sum_fast(float v, int lane) {
    v += DPPF(v, 0xb1); v += DPPF(v, 0x4e); v += DPPF(v, 0x141); v += DPPF(v, 0x140); v += lane_xor16(v, lane); v += lane_xor32(v, lane); return v; }
__device__ __forceinline__ void router_pick(float (&p)[32], int t, float bias, int lane_in, LAS unsigned char* lds, int* tk_e, int* tk_p, float* tk_g) {
    int lane = lane_in; asm volatile("" : "+v"(lane));
#define RSTEP(HN, MASK, XCHG) _Pragma("unroll") for (int i = 0; i < HN; ++i) { const bool up = (lane & MASK) != 0; const float keep = up ? p[i + HN] : p[i]; const float send = up ? p[i] : p[i + HN]; p[i] = keep + XCHG; }
    RSTEP(16, 32, lane_xor32(send, lane)) RSTEP(8, 16, lane_xor16(send, lane)) RSTEP(4, 8, DPPF(send, 0x140)) RSTEP(2, 4, DPPF(send, 0x141)) RSTEP(1, 2, DPPF(send, 0x4e))
#undef RSTEP
    const float logit = p[0] + DPPF(p[0], 0xb1) + bias;
    float val = (lane & 1) ? -INFINITY : logit;
    float tv[4]; int te[4];
#pragma unroll
    for (int r = 0; r < 4; ++r) {
        float m = val;
        m = fmaxf(m, DPPF(m, 0xb1)); m = fmaxf(m, DPPF(m, 0x4e)); m = fmaxf(m, DPPF(m, 0x141)); m = fmaxf(m, DPPF(m, 0x140)); m = fmaxf(m, lane_xor16(m, lane)); m = fmaxf(m, lane_xor32(m, lane));
        const unsigned long long bal = __ballot(val == m);
        const int first = __builtin_ctzll(bal);
        tv[r] = __uint_as_float(__builtin_amdgcn_readfirstlane(__float_as_uint(m))); te[r] = first >> 1;
        val = (lane == first) ? -INFINITY : val;
    }
    const float e1 = expf(tv[1] - tv[0]), e2 = expf(tv[2] - tv[0]), e3 = expf(tv[3] - tv[0]);
    const float is = 1.0f / (1.0f + e1 + e2 + e3);
    if (lane < 4) { const int e = (lane == 0) ? te[0] : (lane == 1) ? te[1] : (lane == 2) ? te[2] : te[3];
        const float gate = (lane == 0) ? is : (lane == 1) ? e1 * is : (lane == 2) ? e2 * is : e3 * is;
        const int lp = __hip_atomic_fetch_add((LAS int*)(lds + L_LCNT) + e, 1, __ATOMIC_RELAXED, __HIP_MEMORY_SCOPE_WORKGROUP);
        tk_e[t * 4 + lane] = e; tk_p[t * 4 + lane] = lp; tk_g[t * 4 + lane] = gate; }
}

__device__ __forceinline__ void phase_router(const Args& a, LAS unsigned char* lds, int vcu, int G, int wave, int lane, int tid, int dummy) {
    unsigned char* ws = a.ws; const int gw = vcu * NWAVES + wave, NGW = G * NWAVES;
    LAS float* Wt = (LAS float*)(lds + RING_OFF);
    volatile LAS int* lcnt = (volatile LAS int*)(lds + L_LCNT);
    const float* wr = a.in[19];
    const float* x1 = a.out;
    f32x4 vn[2][4];
#pragma unroll
    for (int q = 0; q < 2; ++q) { const GAS f32x4* xr = (const GAS f32x4*)(x1 + (size_t)(gw + q * NGW) * D) + lane;
#pragma unroll
        for (int j = 0; j < 4; ++j) vn[q][j] = xr[64 * j]; }
    { f32x4 wf[16];
#pragma unroll
      for (int i = 0; i < 16; ++i) wf[i] = *(const f32x4*)(wr + (size_t)(lane + 64 * i) * 32 + 4 * wave);
#pragma unroll
      for (int i = 0; i < 16; ++i) { const int d = lane + 64 * i;
          Wt[(4 * wave + 0) * 1024 + d] = wf[i].x; Wt[(4 * wave + 1) * 1024 + d] = wf[i].y; Wt[(4 * wave + 2) * 1024 + d] = wf[i].z; Wt[(4 * wave + 3) * 1024 + d] = wf[i].w; } }
    if (tid < 32) lcnt[tid] = 0;
    __syncthreads();
    const float* g = a.in[18]; unsigned char* H2 = ws + WS_H2;
    int* tk_e = (int*)(ws + WS_TKE); int* tk_p = (int*)(ws + WS_TKP); float* tk_g = (float*)(ws + WS_TKG);
    LAS unsigned char* ldsc = lds;
    const float bias = a.in[20][lane >> 1];
    const GAS f32x4* gr = (const GAS f32x4*)g + lane;
    for (int tb = gw; tb < T; tb += 2 * NGW) {
        f32x4 v[2][4];
#pragma unroll
        for (int q = 0; q < 2; ++q)
#pragma unroll
            for (int j = 0; j < 4; ++j) v[q][j] = vn[q][j];
        if (tb + 2 * NGW < T) {
#pragma unroll
            for (int q = 0; q < 2; ++q) { const GAS f32x4* xr = (const GAS f32x4*)(x1 + (size_t)(tb + 2 * NGW + q * NGW) * D) + lane;
#pragma unroll
                for (int j = 0; j < 4; ++j) vn[q][j] = xr[64 * j]; } }
#pragma unroll
        for (int q = 0; q < 2; ++q) { float s = 0.f;
#pragma unroll
            for (int j = 0; j < 4; ++j) s += (v[q][j].x * v[q][j].x + v[q][j].y * v[q][j].y) + (v[q][j].z * v[q][j].z + v[q][j].w * v[q][j].w);
            const float r = 1.0f / sqrtf(wave_sum_fast(s, lane) * (1.0f / 1024.0f) + EPS);
            GAS unsigned* o4 = (GAS unsigned*)(H2 + (size_t)(tb + q * NGW) * D) + lane;
#pragma unroll
            for (int j = 0; j < 4; ++j) { const f32x4 gg = gr[64 * j]; v[q][j].x *= r * gg.x; v[q][j].y *= r * gg.y; v[q][j].z *= r * gg.z; v[q][j].w *= r * gg.w;
                o4[64 * j] = pg8::pk4_fp8(v[q][j].x, v[q][j].y, v[q][j].z, v[q][j].w); } }
        float p0[32], p1[32];
#pragma unroll
        for (int e = 0; e < 32; ++e) { p0[e] = 0.f; p1[e] = 0.f; }
        for (int ps_ = 0; ps_ < (REPEAT_PHASE == 22 ? 2 : 1); ++ps_) {
        f32x4 w[4], wn[4];
        const LAS float* Wl = Wt + 4 * lane; asm volatile("" : "+v"(Wl));
#pragma unroll
        for (int j = 0; j < 4; ++j) w[j] = *(const LAS f32x4*)(Wl + 256 * j);
#pragma unroll
        for (int e = 0; e < 32; ++e) {
            if (e + 1 < 32) {
#pragma unroll
                for (int j = 0; j < 4; ++j) wn[j] = *(const LAS f32x4*)(Wl + (e + 1) * 1024 + 256 * j); }
            asm volatile("" ::: "memory"); __builtin_amdgcn_sched_barrier(0);
            { float a0 = 0.f, a1 = 0.f, b0 = 0.f, b1 = 0.f;
#pragma unroll
              for (int j = 0; j < 4; ++j) { a0 = fmaf(v[0][j].x, w[j].x, a0); a1 = fmaf(v[0][j].y, w[j].y, a1); a0 = fmaf(v[0][j].z, w[j].z, a0); a1 = fmaf(v[0][j].w, w[j].w, a1);
                                            b0 = fmaf(v[1][j].x, w[j].x, b0); b1 = fmaf(v[1][j].y, w[j].y, b1); b0 = fmaf(v[1][j].z, w[j].z, b0); b1 = fmaf(v[1][j].w, w[j].w, b1); }
              p0[e] += a0 + a1; p1[e] += b0 + b1; asm volatile("" : "+v"(p0[e]), "+v"(p1[e])); }
#pragma unroll
            for (int j = 0; j < 4; ++j) w[j] = wn[j];
        }
        }
        if (REPEAT_PHASE == 22) {
#pragma unroll
            for (int e = 0; e < 32; ++e) { p0[e] *= 0.5f; p1[e] *= 0.5f; } }
        router_pick(p0, tb, bias, lane, ldsc, tk_e, tk_p, tk_g);
        router_pick(p1, tb + NGW, bias, lane, ldsc, tk_e, tk_p, tk_g);
    }
    __syncthreads();
    if (tid < 32) ((int*)(ws + WS_BLKBASE))[(dummy ? 8192 : 0) + vcu * 32 + tid] = lcnt[tid];
    __syncthreads();
}

__device__ __forceinline__ void moe_plan(unsigned char* ws, LAS unsigned char* lds, int tid, int vcu, int G) {
    volatile LAS int* prefT = (volatile LAS int*)(lds + L_PREFT); volatile LAS int* pstart = (volatile LAS int*)(lds + L_PSTART); volatile LAS int* lbase = (volatile LAS int*)(lds + L_LBASE);
    volatile LAS int* part = (volatile LAS int*)(lds + L_PART);
    { const int e = tid & 31, pr = tid >> 5; const int* bc = (const int*)(ws + WS_BLKBASE); int tot = 0, pre = 0;
      for (int b = pr; b < G; b += 16) { const int c = bc[b * 32 + e]; tot += c; pre += (b < vcu) ? c : 0; }
      part[pr * 32 + e] = tot; part[512 + pr * 32 + e] = pre; }
    __syncthreads();
    if (tid < 64) { int nt = 0;
        if (tid < 32) { int tot = 0, pre = 0;
#pragma unroll
            for (int pr = 0; pr < 16; ++pr) { tot += part[pr * 32 + tid]; pre += part[512 + pr * 32 + tid]; }
            lbase[tid] = pre; nt = (tot + 255) >> 8; }
        int inc = nt;
#pragma unroll
        for (int o = 1; o < 32; o <<= 1) { const int y = __shfl_up(inc, o); if ((tid & 63) >= o) inc += y; }
        if (tid < 32) { prefT[tid] = inc - nt; pstart[tid] = (inc - nt) * 256; if (tid == 31) { prefT[32] = inc; pstart[32] = inc * 256; }
            if (vcu == 0) { int* gp = (int*)(ws + WS_BLKBASE) + 16384; gp[tid] = inc - nt; if (tid == 31) gp[32] = inc; } } }
    __syncthreads();
}
__device__ __forceinline__ void moe_plan_load(unsigned char* ws, LAS unsigned char* lds, int tid) {
    volatile LAS int* prefT = (volatile LAS int*)(lds + L_PREFT);
    if (tid < 33) prefT[tid] = ((const int*)(ws + WS_BLKBASE))[16384 + tid];
    __syncthreads();
    for (int rt = tid; rt < prefT[32]; rt += NWAVES * 64) { int e = 0; while (prefT[e + 1] <= rt) ++e; prefT[MOE_ETAB + rt] = e; }
    __syncthreads();
}

__device__ __forceinline__ void phase_dispatch(const Args& a, LAS unsigned char* lds, int vcu, int G, int wave, int lane, int tid) {
    unsigned char* ws = a.ws; const int gw = vcu * NWAVES + wave, NGW = G * NWAVES;
    volatile LAS int* pstart = (volatile LAS int*)(lds + L_PSTART); volatile LAS int* lbase = (volatile LAS int*)(lds + L_LBASE);
    moe_plan(ws, lds, tid, vcu, G);
    const unsigned char* H2 = ws + WS_H2; unsigned char* XS = ws + WS_XS;
    const int* tk_e = (const int*)(ws + WS_TKE); const int* tk_p = (const int*)(ws + WS_TKP); const float* tk_g = (const float*)(ws + WS_TKG);
    int* tslot = (int*)(ws + WS_TSLOT); float* rgate = (float*)(ws + WS_RGATE);
    for (int t = gw; t < T; t += NGW) {
        int slot = 0;
        if (lane < 4) { const int e = tk_e[t * 4 + lane]; slot = pstart[e] + lbase[e] + tk_p[t * 4 + lane]; rgate[slot] = tk_g[t * 4 + lane]; tslot[t * 4 + lane] = slot; }
        const v4u r0 = *(const v4u*)(H2 + (size_t)t * D + lane * 16);
#pragma unroll
        for (int k = 0; k < 4; ++k) { const int sk = __builtin_amdgcn_readlane(slot, k); *(v4u*)(XS + (size_t)sk * D + lane * 16) = r0; }
    }
}

__device__ __forceinline__ void phase_combine(const Args& a, int vcu, int G, int wave, int lane, float* dst_out) {
    unsigned char* ws = a.ws; const int gw = vcu * NWAVES + wave, NGW = G * NWAVES;
    const unsigned char* YS = ws + WS_XS; const int* tslot = (const int*)(ws + WS_TSLOT); float* out = a.out;
    for (int t = gw; t < T; t += NGW) {
        int slot = 0; if (lane < 4) slot = tslot[t * 4 + lane];
        const float* op = out + (size_t)t * D + lane * 16; f32x4 o[4];
#pragma unroll
        for (int j = 0; j < 4; ++j) o[j] = *(const f32x4*)(op + 4 * j);
#pragma unroll
        for (int k = 0; k < 4; ++k) { const int sk = __builtin_amdgcn_readlane(slot, k); const v4u y = *(const v4u*)(YS + (size_t)sk * D + lane * 16); const unsigned yw[4] = {y.x, y.y, y.z, y.w};
#pragma unroll
            for (int j = 0; j < 4; ++j) { const auto lo = __builtin_amdgcn_cvt_pk_f32_fp8((int)yw[j], false), hi = __builtin_amdgcn_cvt_pk_f32_fp8((int)yw[j], true);
                o[j][0] += lo[0] * 0.0625f; o[j][1] += lo[1] * 0.0625f; o[j][2] += hi[0] * 0.0625f; o[j][3] += hi[1] * 0.0625f; } }
        float* wp = dst_out + (size_t)t * D + lane * 16;
#pragma unroll
        for (int j = 0; j < 4; ++j) *(f32x4*)(wp + 4 * j) = o[j];
    }
}

__device__ __forceinline__ void memattn_unit(const Args& a, LAS unsigned char* lds, int b, int h, int qb, int wid, int lane, int tid) {
    unsigned char* ws = a.ws;
    const bf16* KVM = (const bf16*)(ws + WS_KVM); const bf16* MQ = (const bf16*)(ws + WS_MQ); const float* ssq = (const float*)(ws + WS_SSQ); bf16* Y = (bf16*)(ws + WS_YALL);
    LAS unsigned char* Ks = lds + RING_OFF;
    LAS unsigned char* Vs = lds + RING_OFF + 65536;
    const int r32 = lane & 31, hi = lane >> 5;
    const size_t qrow = (size_t)b * SEQ + (size_t)qb * 256 + wid * 32 + r32;
    bf16x8 qf[8];
#pragma unroll
    for (int ks = 0; ks < 8; ++ks) qf[ks] = *(const bf16x8*)(MQ + qrow * 512 + h * 128 + 16 * ks + 8 * hi);
    const f32x4 sq = *(const f32x4*)(ssq + qrow * 16 + h * 4);
    {
        const int m = tid >> 1, hf = tid & 1;
        const bf16* kr = KVM + (size_t)(b * 256 + m) * 1024 + h * 128 + hf * 64; const bf16* vr = kr + 512;
        v4u raw[8], vraw[8]; float ss = 0.f;
#pragma unroll
        for (int i = 0; i < 8; ++i) { raw[i] = *(const v4u*)(kr + 8 * i); vraw[i] = *(const v4u*)(vr + 8 * i); }
#pragma unroll
        for (int i = 0; i < 8; ++i) { const f32x4 x0 = pg8::unpk_lo(raw[i]), x1 = pg8::unpk_hi(raw[i]);
            ss += ((x0[0] * x0[0] + x0[1] * x0[1]) + (x0[2] * x0[2] + x0[3] * x0[3])) + ((x1[0] * x1[0] + x1[1] * x1[1]) + (x1[2] * x1[2] + x1[3] * x1[3])); }
        ss += __shfl_xor(ss, 1);
        const float r = 1.0f / sqrtf(ss * (1.0f / 128.0f) + EPS);
#pragma unroll
        for (int i = 0; i < 8; ++i) { const int d0 = hf * 64 + 8 * i; const f32x4 g0 = *(const f32x4*)(a.in[15] + d0) * *(const f32x4*)(a.in[14] + d0), g1 = *(const f32x4*)(a.in[15] + d0 + 4) * *(const f32x4*)(a.in[14] + d0 + 4);
            const int c = hf * 8 + i;
            *(LAS v4u*)(Ks + m * 256 + ((c ^ (m & 15)) << 4)) = pg8::pack8(pg8::unpk_lo(raw[i]) * g0 * r, pg8::unpk_hi(raw[i]) * g1 * r); }
        LAS unsigned char* vt = Vs + (m >> 6) * 16384 + ((m >> 4) & 3) * 1024 + (m & 15) * 64;
#pragma unroll
        for (int i = 0; i < 8; ++i) *(LAS v4u*)(vt + (2 * hf + (i >> 2)) * 4096 + (i & 3) * 16) = vraw[i];
    }
    __syncthreads();
    const float sc = (1.0f / sqrtf(((sq[0] + sq[1]) + (sq[2] + sq[3])) * (1.0f / 128.0f) + EPS)) * 0.08838834764831845f * 1.4426950408889634f;
    f32x16 o[4]; float l = 0.f;
#pragma unroll
    for (int d0 = 0; d0 < 4; ++d0) o[d0] = f32x16{};
    const int vb0 = (int)(unsigned)(uintptr_t)(lds + RING_OFF + 65536) + ((lane >> 4) & 1) * 32 + (lane & 3) * 8 + (4 * hi + ((lane & 15) >> 2)) * 64;
#pragma unroll 1
    for (int kt = 0; kt < 4; ++kt) {
        f32x16 p0 = f32x16{}, p1 = f32x16{};
#pragma unroll
        for (int ks = 0; ks < 8; ++ks) { const int c = 2 * ks + hi; const int k0 = 64 * kt + r32, k1 = k0 + 32;
            const bf16x8 f0 = *(const LAS bf16x8*)(Ks + k0 * 256 + ((c ^ (k0 & 15)) << 4)), f1 = *(const LAS bf16x8*)(Ks + k1 * 256 + ((c ^ (k1 & 15)) << 4));
            p0 = __builtin_amdgcn_mfma_f32_32x32x16_bf16(f0, qf[ks], p0, 0, 0, 0); p1 = __builtin_amdgcn_mfma_f32_32x32x16_bf16(f1, qf[ks], p1, 0, 0, 0); }
#pragma unroll
        for (int r = 0; r < 16; ++r) { p0[r] = __builtin_amdgcn_exp2f(p0[r] * sc); p1[r] = __builtin_amdgcn_exp2f(p1[r] * sc); l += p0[r] + p1[r]; }
        v4u pw[4];
        pw[0] = (v4u){pg8::cvt_pk_bf16(p0[0], p0[1]), pg8::cvt_pk_bf16(p0[2], p0[3]), pg8::cvt_pk_bf16(p0[4], p0[5]), pg8::cvt_pk_bf16(p0[6], p0[7])};
        pw[1] = (v4u){pg8::cvt_pk_bf16(p0[8], p0[9]), pg8::cvt_pk_bf16(p0[10], p0[11]), pg8::cvt_pk_bf16(p0[12], p0[13]), pg8::cvt_pk_bf16(p0[14], p0[15])};
        pw[2] = (v4u){pg8::cvt_pk_bf16(p1[0], p1[1]), pg8::cvt_pk_bf16(p1[2], p1[3]), pg8::cvt_pk_bf16(p1[4], p1[5]), pg8::cvt_pk_bf16(p1[6], p1[7])};
        pw[3] = (v4u){pg8::cvt_pk_bf16(p1[8], p1[9]), pg8::cvt_pk_bf16(p1[10], p1[11]), pg8::cvt_pk_bf16(p1[12], p1[13]), pg8::cvt_pk_bf16(p1[14], p1[15])};
        attn_body::pv128(o, vb0 + kt * 16384, __builtin_bit_cast(bf16x8, pw[0]), __builtin_bit_cast(bf16x8, pw[1]), __builtin_bit_cast(bf16x8, pw[2]), __builtin_bit_cast(bf16x8, pw[3]));
    }
    l += __shfl_xor(l, 32);
    LAS float* wsf = (LAS float*)(lds + L_WSF) + wid * 64;
    if (hi == 0) wsf[r32] = l;
    __syncthreads();
    LAS bf16* stg = (LAS bf16*)(lds + RING_OFF) + wid * 4096;
#pragma unroll
    for (int r = 0; r < 16; ++r) { const int orow = (r & 3) + 8 * (r >> 2) + 4 * hi; const float il = 1.0f / wsf[orow];
#pragma unroll
        for (int d0 = 0; d0 < 4; ++d0) stg[orow * 128 + d0 * 32 + r32] = (bf16)f2bf(o[d0][r] * il); }
    LDS_WAIT();
    bf16* Yw = Y + ((size_t)b * SEQ + (size_t)qb * 256 + wid * 32) * 1536 + 1024 + h * 128;
#pragma unroll
    for (int i = 0; i < 8; ++i) { const int row = i * 4 + (lane >> 4), ch = lane & 15; const v4u v = *(const LAS v4u*)(stg + row * 128 + ch * 8); *(v4u*)(Yw + (size_t)row * 1536 + ch * 8) = v; }
    __syncthreads();
}

__global__ void __launch_bounds__(NWAVES * 64, 2) mega_fwd(Args args) {
    extern __shared__ __attribute__((aligned(16))) unsigned char lds_raw[];
    LAS unsigned char* lds = (LAS unsigned char*)lds_raw;
    volatile LAS unsigned* MISC = (volatile LAS unsigned*)(lds + MISC_OFF);
    int tid = threadIdx.x, lane = tid & 63, wave = __builtin_amdgcn_readfirstlane(tid >> 6);
#define PHASE_LOCALS() do { tid = threadIdx.x; asm volatile("" : "+v"(tid)); lane = tid & 63; wave = __builtin_amdgcn_readfirstlane(tid >> 6); } while (0)
    const int G = gridDim.x; const int bx = blockIdx.x; const int vcu = (G % 8 == 0) ? (bx % 8) * (G / 8) + bx / 8 : bx;
    unsigned char* ws = args.ws;
    gu32* ctl = (gu32*)(ws + WS_CTL);
    for (int u = tid; u < (LDS_BYTES - LDSCTL_OFF) / 4; u += NWAVES * 64) ((LAS unsigned*)(lds + LDSCTL_OFF))[u] = 0u;
    __syncthreads();
    const int ph_lo = args.ph_lo, ph_hi = args.ph_hi;
    XcdBarrier bar; bar.bar = (unsigned*)(ctl + CW_BAR); bar.x = 0; bar.st = nullptr;
    if (ph_hi - ph_lo > 1) bar = xcd_barrier_post((unsigned*)(ctl + CW_BAR), MISC + 8);
#define IN(k) (ph_lo <= (k) && (k) < ph_hi)
#ifndef TS_PHASE
#define TS_PHASE -1
#endif
    unsigned long long* const ts = (unsigned long long*)(ws + WS_CTL + 512 * 1024);
#define STAMP(k) do { if (TS_PHASE >= 0 && bx == 0 && threadIdx.x == 0) ts[(k)] = __builtin_amdgcn_s_memrealtime(); } while (0)
#define GRID_BAR(k) do { if (IN(k) && IN((k) + 1)) xcd_barrier(bar); STAMP((k) + 1); } while (0)
    STAMP(0);

    if (IN(0)) { for (int rep_ = 0; rep_ < (REPEAT_PHASE == 0 ? 2 : 1); ++rep_) { if (rep_) xcd_barrier(bar);
    PHASE_LOCALS();
    p0_prologue(args, lds, vcu, G, wave, lane, tid);
    } }
    GRID_BAR(0);

    if (IN(1)) { for (int rep_ = 0; rep_ < (REPEAT_PHASE == 1 ? 2 : 1); ++rep_) { if (rep_) xcd_barrier(bar);
    PHASE_LOCALS();
    {
        pg8::Gemm g{2048u, 2048u, 1024};
        ProjOrder S; S.A = (const char*)(ws + WS_HN); S.Bt = (const char*)(ws + WS_WIN); S.G = G; S.c = bx;
        pg8::EpiProj E{(bf16*)(ws + WS_Q), (bf16*)(ws + WS_K), (bf16*)(ws + WS_V), (bf16*)(ws + WS_U), (bf16*)(ws + WS_CB), (bf16*)(ws + WS_MQ), (bf16*)(ws + WS_GATES), (bf16*)(ws + WS_KVM),
                       (float*)(ws + WS_SSQ), args.in[4], args.in[5], (const float*)(ws + WS_RCOS), (const float*)(ws + WS_RSIN)};
        pg8::gemm_phase<pg8::EpiProj, ProjOrder, true, true>(lds + RING_OFF, g, S, E);
        { pg8::Gemm g8{1024u, 1024u, 512}; GateOrder S8; S8.A = (const char*)(ws + WS_HN8); S8.Bt = (const char*)(ws + WS_WG8); S8.G = G; S8.c = bx;
          pg8::EpiGates8 E8{ws + WS_GATES};
          pg8::gemm_phase_f8<pg8::EpiGates8, GateOrder, true, true>(lds + RING_OFF, g8, S8, E8); }
    }
    } }
    GRID_BAR(1);

    if (IN(2)) { for (int rep_ = 0; rep_ < (REPEAT_PHASE == 2 ? 2 : 1); ++rep_) { if (rep_) xcd_barrier(bar);
    PHASE_LOCALS();
    {
        const int cmb = vcu >> 4, s = vcu & 15;
        const int b = cmb >> 3, h = (cmb >> 1) & 3, mp = cmb & 1;
        const attn_body::bf16* Qp = (const attn_body::bf16*)(ws + WS_Q) + (size_t)b * SEQ * 512 + (h * 2 + mp) * 64;
        const attn_body::bf16* Kp = (const attn_body::bf16*)(ws + WS_K) + (size_t)b * SEQ * 512 + (h * 2 + mp) * 64;
        const attn_body::bf16* Vp = (const attn_body::bf16*)(ws + WS_V) + (size_t)b * SEQ * 512 + h * 128;
        attn_body::bf16* Op = (attn_body::bf16*)(ws + WS_OMAPS) + (size_t)b * SEQ * 1024 + (h * 2 + mp) * 128;
        pg8::ConvCtx cx; cx.wgu = args.in[21]; cx.wdn = args.in[23]; cx.ogu = ws + WS_WGU; cx.odn = ws + WS_WDN; cx.cw = bx * NWAVES + wave; cx.nseq = NWAVES * G; cx.jn = 0;
        cx.sub = -1; cx.slot0 = (unsigned)(98304 + wave * 4096);
#pragma unroll 1
        for (int i = 0; i < 2; ++i) { const int qb = (i == 0) ? s : 31 - s;
            attn_body::attn_unit128<8>(qb, Qp, Kp, Vp, Op, (char*)lds_raw + RING_OFF, &cx); }
        conv_drain(cx, lds, wave, lane);
        __syncthreads();
        memattn_unit(args, lds, vcu >> 7, (vcu >> 5) & 3, vcu & 31, wave, lane, tid);
        if (REPEAT_PHASE == 21) memattn_unit(args, lds, vcu >> 7, (vcu >> 5) & 3, vcu & 31, wave, lane, tid);
    }
    } }
    GRID_BAR(2);

    if (IN(3)) { for (int rep_ = 0; rep_ < (REPEAT_PHASE == 3 ? 2 : 1); ++rep_) { if (rep_) xcd_barrier(bar);
    PHASE_LOCALS();
    phase_finish(args, vcu, G, wave, lane);
    } }
    GRID_BAR(3);

    if (REPEAT_PHASE == 20) { for (int i_ = 0; i_ < 10; ++i_) xcd_barrier(bar); }
    if (IN(4)) { for (int rep_ = 0; rep_ < (REPEAT_PHASE == 4 ? 2 : 1); ++rep_) { if (rep_) xcd_barrier(bar);
    PHASE_LOCALS();
    {
        pg8::Gemm g{3072u, 1024u, 512};
        MergeOrder S; S.Y = (const char*)(ws + WS_YALL); S.Bt = (const char*)(ws + WS_WBR); S.G = G; S.c = bx;
        pg8::EpiMerge E{(const bf16*)(ws + WS_GATES), (bf16*)(ws + WS_MERGED)};
        pg8::gemm_phase<pg8::EpiMerge, MergeOrder, true, true>(lds + RING_OFF, g, S, E);
    }
    } }
    GRID_BAR(4);

    if (IN(5)) { for (int rep_ = 0; rep_ < (REPEAT_PHASE == 5 ? 2 : 1); ++rep_) { if (rep_) xcd_barrier(bar);
    PHASE_LOCALS();
    {
        pg8::Gemm g{2048u, 2048u, 1024};
        OutOrder S; S.A = (const char*)(ws + WS_MERGED); S.Bt = (const char*)(ws + WS_WOUT); S.G = G; S.c = bx;
        pg8::EpiResid E{args.in[0], args.out};
        pg8::gemm_phase<pg8::EpiResid, OutOrder, false, true>(lds + RING_OFF, g, S, E);
    }
    } }
    GRID_BAR(5);

    if (IN(6)) { for (int rep_ = 0; rep_ < (REPEAT_PHASE == 6 ? 2 : 1); ++rep_) { if (rep_) xcd_barrier(bar);
    PHASE_LOCALS();
    phase_router(args, lds, vcu, G, wave, lane, tid, rep_ == 0 && REPEAT_PHASE == 6);
    } }
    GRID_BAR(6);

    if (IN(7)) { for (int rep_ = 0; rep_ < (REPEAT_PHASE == 7 ? 2 : 1); ++rep_) { if (rep_) xcd_barrier(bar);
    PHASE_LOCALS();
    phase_dispatch(args, lds, vcu, G, wave, lane, tid);
    } }
    GRID_BAR(7);

    if (IN(8)) { for (int rep_ = 0; rep_ < (REPEAT_PHASE == 8 ? 2 : 1); ++rep_) { if (rep_) xcd_barrier(bar);
    PHASE_LOCALS();
    {
        pg8::Gemm g{1024u, 1024u, 512};
        moe_plan_load(ws, lds, tid);
        MoeOrder S; S.A = (const char*)(ws + WS_XS); S.Bt = (const char*)(ws + WS_WGU); S.prefT = (const volatile LAS int*)(lds + L_PREFT); S.ncol = 8; S.G = G; S.c = vcu; S.tile_bytes = 256 * 1024;
        pg8::EpiSwiglu E{args.in[22], ws + WS_ACT};
        pg8::gemm_phase_f8<pg8::EpiSwiglu, MoeOrder, true, true>(lds + RING_OFF, g, S, E);
    }
    } }
    GRID_BAR(8);

    if (IN(9)) { for (int rep_ = 0; rep_ < (REPEAT_PHASE == 9 ? 2 : 1); ++rep_) { if (rep_) xcd_barrier(bar);
    PHASE_LOCALS();
    {
        pg8::Gemm g{1024u, 1024u, 512};
        moe_plan_load(ws, lds, tid);
        MoeOrder S; S.A = (const char*)(ws + WS_ACT); S.Bt = (const char*)(ws + WS_WDN); S.prefT = (const volatile LAS int*)(lds + L_PREFT); S.ncol = 4; S.G = G; S.c = vcu; S.tile_bytes = 256 * 1024;
        pg8::EpiDown E{args.in[24], (const float*)(ws + WS_RGATE), ws + WS_XS};
        pg8::gemm_phase_f8<pg8::EpiDown, MoeOrder, true, true>(lds + RING_OFF, g, S, E);
    }
    } }
    GRID_BAR(9);

    if (IN(10)) { for (int rep_ = 0; rep_ < 1; ++rep_) { if (rep_) xcd_barrier(bar);
    PHASE_LOCALS();
    if (REPEAT_PHASE == 10) { phase_combine(args, vcu, G, wave, lane, (float*)(ws + WS_WGU)); xcd_barrier(bar); }
    phase_combine(args, vcu, G, wave, lane, args.out);
    } }
    GRID_BAR(10);

    if (TS_PHASE >= 0) {
        STAMP(11); xcd_barrier(bar);
        const unsigned long long t0 = __hip_atomic_load(ts + (TS_PHASE == 11 ? 0 : TS_PHASE), RLX_AGENT), t1 = __hip_atomic_load(ts + (TS_PHASE == 11 ? 11 : TS_PHASE + 1), RLX_AGENT);
        const float v = (float)(t1 - t0) * (TS_PHASE == 11 ? 1e-4f : 1e-3f);
        for (size_t i = (size_t)bx * 512 + threadIdx.x; i < (size_t)T * D; i += (size_t)G * 512) args.out[i] = v;
    }
#undef GRID_BAR
#undef IN
}

extern "C" void kernel_launch(void* const* d_in, const int* in_sizes, int n_in, void* d_out, int out_size, void* d_ws, size_t ws_size, hipStream_t stream) {
    static int grid = 0;
    if (grid == 0) {
        if (n_in != 25 || out_size != T * D || ws_size < WS_END) { fprintf(stderr, "kernel_launch: unexpected problem shape (n_in %d, out %d, ws %zu)\n", n_in, out_size, ws_size); grid = -1; return; }
        int dev = 0, cus = 0;
        if (hipGetDevice(&dev) != hipSuccess || hipDeviceGetAttribute(&cus, hipDeviceAttributeMultiprocessorCount, dev) != hipSuccess) { grid = -1; return; }
        if (hipFuncSetAttribute((const void*)mega_fwd, hipFuncAttributeMaxDynamicSharedMemorySize, LDS_BYTES) != hipSuccess) { fprintf(stderr, "kernel_launch: hipFuncSetAttribute failed\n"); grid = -1; return; }
        int per_cu = 0;
        if (hipOccupancyMaxActiveBlocksPerMultiprocessor(&per_cu, (const void*)mega_fwd, NWAVES * 64, LDS_BYTES) != hipSuccess || per_cu < 1) fprintf(stderr, "kernel_launch: occupancy query says %d\n", per_cu);
        (void)hipGetLastError();
        grid = cus;
        if (grid != 256) fprintf(stderr, "kernel_launch: built for 256 CUs, device has %d\n", grid);
    }
    if (grid < 0) return;
    if (hipMemsetAsync((char*)d_ws + WS_CTL, 0, CTL_ZERO_BYTES, stream) != hipSuccess) return;
    Args a{};
    for (int i = 0; i < 25; ++i) a.in[i] = (const float*)d_in[i];
    a.out = (float*)d_out; a.ws = (unsigned char*)d_ws;
#ifndef MK_PER_PHASE
#define MK_PER_PHASE 0
#endif
    if (MK_PER_PHASE) { for (int k = 0; k < 11; ++k) { a.ph_lo = k; a.ph_hi = k + 1; hipLaunchKernelGGL(mega_fwd, dim3(grid), dim3(NWAVES * 64), LDS_BYTES, stream, a); } }
    else { a.ph_lo = 0; a.ph_hi = 11; hipLaunchKernelGGL(mega_fwd, dim3(grid), dim3(NWAVES * 64), LDS_BYTES, stream, a); }
}
```

```cpp
#include <hip/hip_runtime.h>
#include <hip/hip_bf16.h>
#include <cstdio>
#include <cstdint>
#include <cmath>

namespace cfg {
constexpr int BATCH = 2, SEQ = 8192, T = BATCH * SEQ, D = 1024, NIN = 6656, NE = 32, NMEM = 256;
constexpr int MAXROWS = 65536 + NE * 256;
constexpr float EPS = 1e-6f;
constexpr float C2 = 0.125f * 1.4426950408889634f;
}

namespace pg8 {
#define PG8_LAS __attribute__((address_space(3)))
typedef unsigned short bf16_t;
typedef short bf16x8 __attribute__((ext_vector_type(8)));
typedef float f32x4 __attribute__((ext_vector_type(4)));
typedef unsigned u32x4 __attribute__((ext_vector_type(4)));
typedef unsigned u32x2 __attribute__((ext_vector_type(2)));
constexpr int BM = 256, BK = 64, HALF = 128, HTB = HALF * BK * 2  , STAGE_BYTES = 8 * HTB, NXCD = 8, WGM = 8;

__host__ __device__ __forceinline__ int lds_byte(int r, int c) { const int st = (r >> 4) * 2 + (c >> 5), rr = r & 15, cc = c & 31, ob = rr * 64 + cc * 2; return st * 1024 + (ob ^ (((ob >> 9) & 1) << 5)); }
__host__ __device__ __forceinline__ void stage_rc(int b, int& R, int& C) { const int st = b / 1024, sb = b % 1024, swz = sb ^ (((sb >> 9) & 1) << 5); R = (st >> 1) * 16 + swz / 64; C = (st & 1) * 32 + (swz % 64) / 2; }

struct Unit { int pm, pn, aux; const char* a; const char* b; };
struct Gemm { unsigned lda, ldb; int K; };

__device__ __forceinline__ void static_map(int L, int nM, int nN, int& pm, int& pn) {
    const int nwg = nM * nN; int wgid = L; { const int q = nwg / NXCD, r = nwg % NXCD, xcd = wgid % NXCD, off = wgid / NXCD; wgid = (xcd < r ? xcd * (q + 1) : r * (q + 1) + (xcd - r) * q) + off; }
    const int nig = WGM * nN, gid = wgid / nig, fm = gid * WGM, gsz = (nM - fm) < WGM ? (nM - fm) : WGM;
    pm = fm + ((wgid % nig) % gsz); pn = (wgid % nig) / gsz;
}

typedef float f32x2_cv __attribute__((ext_vector_type(2))); typedef __bf16 bf16x2_cv __attribute__((ext_vector_type(2)));
__device__ __forceinline__ unsigned cvt_pk_bf16(float lo, float hi) { f32x2_cv v = {lo, hi}; bf16x2_cv b = __builtin_convertvector(v, bf16x2_cv); return __builtin_bit_cast(unsigned, b); }
__device__ __forceinline__ u32x4 pack8(const f32x4 v0, const f32x4 v1) { u32x4 w; w.x = cvt_pk_bf16(v0[0], v0[1]); w.y = cvt_pk_bf16(v0[2], v0[3]); w.z = cvt_pk_bf16(v1[0], v1[1]); w.w = cvt_pk_bf16(v1[2], v1[3]); return w; }
__device__ __forceinline__ f32x4 unpk_lo(const u32x4 w) { return (f32x4){__uint_as_float(w.x << 16), __uint_as_float(w.x & 0xffff0000u), __uint_as_float(w.y << 16), __uint_as_float(w.y & 0xffff0000u)}; }
__device__ __forceinline__ f32x4 unpk_hi(const u32x4 w) { return (f32x4){__uint_as_float(w.z << 16), __uint_as_float(w.z & 0xffff0000u), __uint_as_float(w.w << 16), __uint_as_float(w.w & 0xffff0000u)}; }
__device__ __forceinline__ unsigned pk4_fp8(float a, float b, float c, float d) { int w = 0; w = __builtin_amdgcn_cvt_pk_fp8_f32(a, b, w, false); w = __builtin_amdgcn_cvt_pk_fp8_f32(c, d, w, true); return (unsigned)w; }
__device__ __forceinline__ float sigmoidf_fast(float z) { return __builtin_amdgcn_rcpf(1.0f + __builtin_amdgcn_exp2f(-1.4426950408889634f * z)); }

using cfg::T; using cfg::SEQ; using cfg::EPS;

struct EpiProj {
    static constexpr bool AFTER_DRAIN = false;
    bf16_t *Q, *K, *V, *U, *CB, *MQ, *GATES, *KVM; float* ssq; const float *gq, *gk, *rcos, *rsin;
    __device__ __forceinline__ bool keep(const Unit&) const { return false; }
    __device__ __forceinline__ void operator()(f32x4 (&acc)[2][2][4][2], const Unit& u, int wr, int wc, int fr, int fq) const {
        const int pn = u.pn; const int row0 = u.pm * BM + wr * 64 + fr;
        if (pn < 4) {
            const bool isk = pn >= 2; const float* g = isk ? gk : gq; bf16_t* dst = (isk ? K : Q) + (pn & 1) * 256 + wc * 64 + 8 * fq;
            const float post = isk ? 1.0f : cfg::C2;
            f32x4 ga[2][2];
#pragma unroll
            for (int bj = 0; bj < 2; ++bj)
#pragma unroll
                for (int n = 0; n < 2; ++n) ga[bj][n] = *(const f32x4*)(g + 32 * bj + 8 * fq + 4 * n);
#pragma unroll
            for (int ai = 0; ai < 2; ++ai)
#pragma unroll
                for (int m = 0; m < 4; ++m) {
                    const int row = row0 + ai * HALF + m * 16;
                    float ss = 0.f;
#pragma unroll
                    for (int bj = 0; bj < 2; ++bj)
#pragma unroll
                        for (int n = 0; n < 2; ++n) { const f32x4 x = acc[ai][bj][m][n]; ss += (x[0] * x[0] + x[1] * x[1]) + (x[2] * x[2] + x[3] * x[3]); }
                    ss += __shfl_xor(ss, 16); ss += __shfl_xor(ss, 32);
                    const float rinv = __builtin_amdgcn_rsqf(ss * (1.0f / 64.0f) + EPS) * post;
                    const int pos = row & (SEQ - 1);
                    f32x4 o1[2], o2[2];
#pragma unroll
                    for (int n = 0; n < 2; ++n) {
                        const f32x4 c = *(const f32x4*)(rcos + pos * 32 + 8 * fq + 4 * n), s = *(const f32x4*)(rsin + pos * 32 + 8 * fq + 4 * n);
                        const f32x4 x1 = acc[ai][0][m][n] * ga[0][n] * rinv, x2 = acc[ai][1][m][n] * ga[1][n] * rinv;
                        o1[n] = x1 * c - x2 * s; o2[n] = x2 * c + x1 * s;
                    }
                    *(u32x4*)(dst + (size_t)row * 512) = pack8(o1[0], o1[1]);
                    *(u32x4*)(dst + (size_t)row * 512 + 32) = pack8(o2[0], o2[1]);
                }
        } else if (pn >= 6 && pn < 10) {
            bf16_t* dst = U + (pn - 6) * 128 + wc * 32 + 8 * fq;
#pragma unroll
            for (int ai = 0; ai < 2; ++ai)
#pragma unroll
                for (int m = 0; m < 4; ++m) { const int row = row0 + ai * HALF + m * 16;
                    *(u32x4*)(dst + (size_t)row * 512) = pack8(acc[ai][0][m][0] * acc[ai][1][m][0], acc[ai][0][m][1] * acc[ai][1][m][1]); }
        } else if (pn >= 14 && pn < 26) {
            unsigned char* dst = (unsigned char*)GATES + ((size_t)(u.pm * 12 + (pn - 14)) << 16) + (((wr * 4 + wc) * 64 + fq * 16 + fr) << 3);
#pragma unroll
            for (int ai = 0; ai < 2; ++ai)
#pragma unroll
                for (int m = 0; m < 4; ++m) {
#pragma unroll
                    for (int bj = 0; bj < 2; ++bj) { const f32x4 v0 = acc[ai][bj][m][0], v1 = acc[ai][bj][m][1]; unsigned q[8];
#pragma unroll
                        for (int e = 0; e < 4; ++e) { q[e] = (unsigned)(sigmoidf_fast(v0[e]) * 255.0f + 0.5f); q[4 + e] = (unsigned)(sigmoidf_fast(v1[e]) * 255.0f + 0.5f); }
                        u32x2 w8; w8.x = q[0] | (q[1] << 8) | (q[2] << 16) | (q[3] << 24); w8.y = q[4] | (q[5] << 8) | (q[6] << 16) | (q[7] << 24);
                        *(u32x2*)(dst + ((((ai * 4 + m) * 2 + bj) * 512) << 3)) = w8; } }
        } else {
            bf16_t* dst; int ld, rsub = 0; const bool ismq = (pn == 12 || pn == 13);
            if (pn < 6) { dst = V + (pn - 4) * 256; ld = 512; } else if (pn < 12) { dst = CB + (pn - 10) * 256; ld = 512; }
            else if (pn < 14) { dst = MQ + (pn - 12) * 256; ld = 512; } else { dst = KVM + (pn - 26) * 256; ld = 1024; rsub = T; }
            dst += wc * 32 + 8 * fq;
#pragma unroll
            for (int ai = 0; ai < 2; ++ai)
#pragma unroll
                for (int m = 0; m < 4; ++m) { const int row = row0 + ai * HALF + m * 16 - rsub;
#pragma unroll
                    for (int bj = 0; bj < 2; ++bj) { const f32x4 v0 = acc[ai][bj][m][0], v1 = acc[ai][bj][m][1];
                        *(u32x4*)(dst + (size_t)row * ld + bj * HALF) = pack8(v0, v1);
                        if (ismq) { float ss = ((v0[0] * v0[0] + v0[1] * v0[1]) + (v0[2] * v0[2] + v0[3] * v0[3])) + ((v1[0] * v1[0] + v1[1] * v1[1]) + (v1[2] * v1[2] + v1[3] * v1[3]));
                            ss += __shfl_xor(ss, 16); ss += __shfl_xor(ss, 32);
                            if (fq == 0) ssq[(size_t)row * 16 + ((pn - 12) * 2 + bj) * 4 + wc] = ss; } } }
        }
    }
};

struct EpiGates8 {
    static constexpr bool AFTER_DRAIN = false, HAS_BIAS = false;
    unsigned char* GATES;
    __device__ __forceinline__ bool keep(const Unit&) const { return false; }
    __device__ __forceinline__ void bias(f32x4 (&nb)[2][2], const Unit&, int, int) const { nb[0][0] = nb[0][1] = nb[1][0] = nb[1][1] = (f32x4){0.f, 0.f, 0.f, 0.f}; }
    __device__ __forceinline__ void operator()(f32x4 (&acc)[2][2][4][2], const Unit& u, int wr, int wc, int fr, int fq) const {
        {
            float t_ = 0.75f; asm volatile("" : "+v"(t_)); const float half = ((__builtin_amdgcn_cvt_pk_u8_f32(t_, 0, 0u) & 255u) == 0u) ? 0.5f : 0.0f;
            unsigned char* dst = (unsigned char*)GATES + ((size_t)(u.pm * 12 + u.pn) << 16) + (((wr * 4 + wc) * 64 + fq * 16 + fr) << 3);
#pragma unroll
            for (int ai = 0; ai < 2; ++ai)
#pragma unroll
                for (int m = 0; m < 4; ++m) {
#pragma unroll
                    for (int bj = 0; bj < 2; ++bj) { const f32x4 v0 = acc[ai][bj][m][0], v1 = acc[ai][bj][m][1]; u32x2 w8 = {0u, 0u};
#pragma unroll
                        for (int e = 0; e < 4; ++e) {
                            w8.x = __builtin_amdgcn_cvt_pk_u8_f32(__builtin_amdgcn_rcpf(__builtin_fmaf(__builtin_amdgcn_exp2f(v0[e]), 1.0f / 255.0f, 1.0f / 255.0f)) + half, e, w8.x);
                            w8.y = __builtin_amdgcn_cvt_pk_u8_f32(__builtin_amdgcn_rcpf(__builtin_fmaf(__builtin_amdgcn_exp2f(v1[e]), 1.0f / 255.0f, 1.0f / 255.0f)) + half, e, w8.y); }
                        *(u32x2*)(dst + ((((ai * 4 + m) * 2 + bj) * 512) << 3)) = w8; } }
        }
    }
};

struct EpiMerge {
    static constexpr bool AFTER_DRAIN = false;
    const bf16_t* GATES; bf16_t* MERGED;
    __device__ __forceinline__ bool keep(const Unit& u) const { return u.aux < 2; }
    __device__ __forceinline__ void operator()(f32x4 (&acc)[2][2][4][2], const Unit& u, int wr, int wc, int fr, int fq) const {
        const int br = u.aux; const int row0 = u.pm * BM + wr * 64 + fr, col0 = u.pn * BM + wc * 32 + 8 * fq;
        const unsigned char* ga_p = (const unsigned char*)GATES + ((size_t)(u.pm * 12 + br * 4 + u.pn) << 16) + (((wr * 4 + wc) * 64 + fq * 16 + fr) << 3);
        const unsigned char* gb_p = ga_p + ((size_t)4 << 16);
        u32x2 gav[16], gbv[16];
#pragma unroll
        for (int i = 0; i < 16; ++i) gav[i] = __builtin_nontemporal_load((const u32x2*)(ga_p + ((i * 512) << 3)));
        if (br < 2) {
#pragma unroll
            for (int i = 0; i < 16; ++i) gbv[i] = __builtin_nontemporal_load((const u32x2*)(gb_p + ((i * 512) << 3))); }
        else {
#pragma unroll
            for (int i = 0; i < 16; ++i) gbv[i] = (u32x2){0u, 0u}; }
        __builtin_amdgcn_sched_barrier(0);
#pragma unroll
        for (int ai = 0; ai < 2; ++ai)
#pragma unroll
            for (int m = 0; m < 4; ++m) { const int row = row0 + ai * HALF + m * 16;
#pragma unroll
                for (int bj = 0; bj < 2; ++bj) { const u32x2 ga = gav[(ai * 4 + m) * 2 + bj];
                    f32x4 f0 = {(float)(ga.x & 255u), (float)((ga.x >> 8) & 255u), (float)((ga.x >> 16) & 255u), (float)(ga.x >> 24)}, f1 = {(float)(ga.y & 255u), (float)((ga.y >> 8) & 255u), (float)((ga.y >> 16) & 255u), (float)(ga.y >> 24)};
                    if (br < 2) { const u32x2 gb = gbv[(ai * 4 + m) * 2 + bj];
                        const f32x4 d0 = {(float)__builtin_elementwise_max(gb.x & 255u, 1u), (float)__builtin_elementwise_max((gb.x >> 8) & 255u, 1u), (float)__builtin_elementwise_max((gb.x >> 16) & 255u, 1u), (float)__builtin_elementwise_max(gb.x >> 24, 1u)};
                        const f32x4 d1 = {(float)__builtin_elementwise_max(gb.y & 255u, 1u), (float)__builtin_elementwise_max((gb.y >> 8) & 255u, 1u), (float)__builtin_elementwise_max((gb.y >> 16) & 255u, 1u), (float)__builtin_elementwise_max(gb.y >> 24, 1u)};
                        if (br == 1) {
#pragma unroll
                            for (int e = 0; e < 4; ++e) { f0[e] = __builtin_fmaxf(f0[e], 1.0f); f1[e] = __builtin_fmaxf(f1[e], 1.0f); } }
#pragma unroll
                        for (int e = 0; e < 4; ++e) { f0[e] *= __builtin_amdgcn_rcpf(d0[e]); f1[e] *= __builtin_amdgcn_rcpf(d1[e]); } }
                    else {
#pragma unroll
                        for (int e = 0; e < 4; ++e) { f0[e] = __builtin_fmaxf(f0[e], 1.0f) * (1.0f / 255.0f); f1[e] = __builtin_fmaxf(f1[e], 1.0f) * (1.0f / 255.0f); } }
                    acc[ai][bj][m][0] *= f0; acc[ai][bj][m][1] *= f1;
                    if (br == 2) *(u32x4*)(MERGED + (size_t)row * 1024 + col0 + bj * HALF) = pack8(acc[ai][bj][m][0], acc[ai][bj][m][1]);
                } }
    }
};

struct EpiResid {
    static constexpr bool AFTER_DRAIN = false;
    const float* base; float* out;
    __device__ __forceinline__ bool keep(const Unit&) const { return false; }
    __device__ __forceinline__ void operator()(f32x4 (&acc)[2][2][4][2], const Unit& u, int wr, int wc, int fr, int fq) const {
        const int row0 = u.pm * BM + wr * 64 + fr, col0 = u.pn * BM + wc * 32 + 8 * fq;
#pragma unroll
        for (int ai = 0; ai < 2; ++ai)
#pragma unroll
            for (int mp = 0; mp < 2; ++mp) {
                f32x4 xv[2][2][2];
#pragma unroll
                for (int mm = 0; mm < 2; ++mm) { const size_t off = (size_t)(row0 + ai * HALF + (2 * mp + mm) * 16) * 1024 + col0;
#pragma unroll
                    for (int bj = 0; bj < 2; ++bj)
#pragma unroll
                        for (int n = 0; n < 2; ++n) xv[mm][bj][n] = __builtin_nontemporal_load((const f32x4*)(base + off + bj * HALF + n * 4)); }
                __builtin_amdgcn_sched_barrier(0);
#pragma unroll
                for (int mm = 0; mm < 2; ++mm) { const int m = 2 * mp + mm; const size_t off = (size_t)(row0 + ai * HALF + m * 16) * 1024 + col0;
#pragma unroll
                    for (int bj = 0; bj < 2; ++bj)
#pragma unroll
                        for (int n = 0; n < 2; ++n) *(f32x4*)(out + off + bj * HALF + n * 4) = xv[mm][bj][n] + acc[ai][bj][m][n]; }
                __builtin_amdgcn_sched_barrier(0); }
    }
};

struct EpiSwiglu {
    static constexpr bool AFTER_DRAIN = false, HAS_BIAS = true;
    const float* bgu; unsigned char* ACT;
    __device__ __forceinline__ bool keep(const Unit&) const { return false; }
    __device__ __forceinline__ void bias(f32x4 (&nb)[2][2], const Unit& u, int wc, int fq) const {
        const int e_ = u.pn >> 3, ch0 = (u.pn & 7) * 128 + wc * 32 + 8 * fq;
#pragma unroll
        for (int n = 0; n < 2; ++n) { nb[0][n] = *(const f32x4*)(bgu + (size_t)e_ * 2048 + ch0 + 4 * n); nb[1][n] = *(const f32x4*)(bgu + (size_t)e_ * 2048 + 1024 + ch0 + 4 * n); } }
    __device__ __forceinline__ void operator()(f32x4 (&acc)[2][2][4][2], const Unit& u, int wr, int wc, int fr, int fq) const {
        const int e_ = u.pn >> 3, pnl = u.pn & 7; const int row0 = u.pm * BM + wr * 64 + fr, ch0 = pnl * 128 + wc * 32 + 8 * fq;
        (void)e_;
        const int odd = fq & 1; const int chs = ch0 - 8 * odd;
#pragma unroll
        for (int ai = 0; ai < 2; ++ai)
#pragma unroll
            for (int mp = 0; mp < 2; ++mp) { u32x2 w8[2];
#pragma unroll
                for (int mm = 0; mm < 2; ++mm) { const int m = 2 * mp + mm; f32x4 a[2];
#pragma unroll
                    for (int n = 0; n < 2; ++n) { const f32x4 g = acc[ai][0][m][n], uu = acc[ai][1][m][n];
#pragma unroll
                        for (int e = 0; e < 4; ++e) { const float gm = fminf(g[e], 7.0f), um = fminf(fmaxf(uu[e], -7.0f), 7.0f);
                            a[n][e] = (um + 1.0f) * (gm * sigmoidf_fast(1.702f * gm)); } }
                    w8[mm].x = pk4_fp8(a[0][0], a[0][1], a[0][2], a[0][3]); w8[mm].y = pk4_fp8(a[1][0], a[1][1], a[1][2], a[1][3]); }
                const auto rx = __builtin_amdgcn_permlane16_swap(w8[0].x, w8[1].x, false, false), ry = __builtin_amdgcn_permlane16_swap(w8[0].y, w8[1].y, false, false);
                const u32x4 v = {rx[0], ry[0], rx[1], ry[1]};
                *(u32x4*)(ACT + (size_t)(row0 + ai * HALF + (2 * mp + odd) * 16) * 1024 + chs) = v; }
    }
};

struct EpiDown {
    static constexpr bool AFTER_DRAIN = false, HAS_BIAS = true;
    const float* bd; const float* row_gate; unsigned char* YS;
    __device__ __forceinline__ bool keep(const Unit&) const { return false; }
    __device__ __forceinline__ void bias(f32x4 (&nb)[2][2], const Unit& u, int wc, int fq) const {
        const int e_ = u.pn >> 2, col0 = (u.pn & 3) * 256 + wc * 32 + 8 * fq;
#pragma unroll
        for (int bj = 0; bj < 2; ++bj)
#pragma unroll
            for (int n = 0; n < 2; ++n) nb[bj][n] = *(const f32x4*)(bd + (size_t)e_ * 1024 + col0 + bj * HALF + 4 * n); }
    __device__ __forceinline__ void operator()(f32x4 (&acc)[2][2][4][2], const Unit& u, int wr, int wc, int fr, int fq) const {
        const int e_ = u.pn >> 2, pnl = u.pn & 3; const int row0 = u.pm * BM + wr * 64 + fr, col0 = pnl * 256 + wc * 32 + 8 * fq;
        (void)e_;
        float rgv[8];
#pragma unroll
        for (int i = 0; i < 8; ++i) rgv[i] = row_gate[row0 + (i >> 2) * HALF + (i & 3) * 16];
        __builtin_amdgcn_sched_barrier(0);
        const int odd = fq & 1; const int cols = col0 - 8 * odd;
#pragma unroll
        for (int ai = 0; ai < 2; ++ai)
#pragma unroll
            for (int mp = 0; mp < 2; ++mp)
#pragma unroll
                for (int bj = 0; bj < 2; ++bj) { u32x2 w8[2];
#pragma unroll
                    for (int mm = 0; mm < 2; ++mm) { const int m = 2 * mp + mm; const float rg = rgv[ai * 4 + m] * 16.0f;
                        const f32x4 y0 = acc[ai][bj][m][0] * rg, y1 = acc[ai][bj][m][1] * rg;
                        w8[mm].x = pk4_fp8(y0[0], y0[1], y0[2], y0[3]); w8[mm].y = pk4_fp8(y1[0], y1[1], y1[2], y1[3]); }
                    const auto rx = __builtin_amdgcn_permlane16_swap(w8[0].x, w8[1].x, false, false), ry = __builtin_amdgcn_permlane16_swap(w8[0].y, w8[1].y, false, false);
                    const u32x4 v = {rx[0], ry[0], rx[1], ry[1]};
                    *(u32x4*)(YS + (size_t)(row0 + ai * HALF + (2 * mp + odd) * 16) * 1024 + cols + bj * HALF) = v; }
    }
};


constexpr int CONV_NSUB = 2 * (32768 + 16384);
struct ConvCtx {
    const float* wgu; const float* wdn; unsigned char* ogu; unsigned char* odn;
    int cw, nseq, jn;
    int sub;
    unsigned slot0;
};
struct ConvItem { const float* W; unsigned char* WT; int ldn, k0, n0, dst; };
__device__ __forceinline__ int conv_ip32(int r) { return 16 * ((r >> 2) & 1) + 4 * (r >> 3) + (r & 3); }
__device__ __forceinline__ ConvItem conv_decode(const ConvCtx& c, int s) {
    ConvItem d; const int it = s >> 1, hf = s & 1;
    if (it < 32768) { const int e = it >> 10, q = it & 1023, kb = q >> 6, nb = q & 63; const int L0 = 32 * nb, ch = L0 & 1023;
        d.W = c.wgu + (size_t)e * 1024 * 2048; d.ldn = 2048; d.k0 = 64 * kb + 32 * hf; d.n0 = L0; d.dst = e * 2048 + 256 * (ch >> 7) + 128 * (L0 >> 10) + 32 * ((ch >> 5) & 3); d.WT = c.ogu; }
    else { const int r = it - 32768, e = r >> 9, q = r & 511, kb = q >> 5, nb = q & 31;
        d.W = c.wdn + (size_t)e * 1024 * 1024; d.ldn = 1024; d.k0 = 64 * kb + 32 * hf; d.n0 = 32 * nb; d.dst = e * 1024 + 32 * nb; d.WT = c.odn; }
    return d;
}
__device__ __forceinline__ void conv_issue(const ConvCtx& c, PG8_LAS unsigned char* lds, unsigned slot, int lane_, int s) {
    int lane = lane_; asm volatile("" : "+v"(lane));
    const ConvItem d = conv_decode(c, s);
    const float* src = d.W + (size_t)(d.k0 + (lane >> 3)) * d.ldn + d.n0 + 4 * (lane & 7);
#pragma unroll
    for (int jj = 0; jj < 4; ++jj) __builtin_amdgcn_global_load_lds((const unsigned*)(src + (size_t)(8 * jj) * d.ldn), (PG8_LAS unsigned*)(lds + slot + jj * 1024), 16, 0, 2);
}
__device__ __forceinline__ void conv_finish(const ConvCtx& c, PG8_LAS unsigned char* lds, unsigned slot, int lane_, int s) {
    int lane = lane_; asm volatile("" : "+v"(lane));
    const ConvItem d = conv_decode(c, s);
    const int n = lane & 31, kh = lane >> 5;
    const PG8_LAS float* p = (const PG8_LAS float*)(lds + slot + kh * 2048 + n * 4);
    float v[16];
#pragma unroll
    for (int kk = 0; kk < 16; ++kk) v[kk] = p[kk * 32];
    asm volatile("s_waitcnt lgkmcnt(0)" ::: "memory");
    u32x4 o;
    o.x = pk4_fp8(32.f * v[0], 32.f * v[1], 32.f * v[2], 32.f * v[3]);   o.y = pk4_fp8(32.f * v[4], 32.f * v[5], 32.f * v[6], 32.f * v[7]);
    o.z = pk4_fp8(32.f * v[8], 32.f * v[9], 32.f * v[10], 32.f * v[11]); o.w = pk4_fp8(32.f * v[12], 32.f * v[13], 32.f * v[14], 32.f * v[15]);
    __builtin_nontemporal_store(o, (u32x4*)(d.WT + (size_t)(d.dst + conv_ip32(n)) * 1024 + d.k0 + 16 * kh));
}
template <class Epi, class Sched, bool ALIGN_EPI = false, bool SP2 = false, bool CONV = false>
__device__ __forceinline__ void gemm_phase(PG8_LAS unsigned char* lds, const Gemm g, const Sched& S, const Epi& E, ConvCtx* cx = nullptr) {
    int tid_ = threadIdx.x; asm volatile("" : "+v"(tid_));
    const int tid = tid_, wid = __builtin_amdgcn_readfirstlane(tid >> 6), lane = tid & 63, wr = wid >> 2, wc = wid & 3, fr = lane & 15, fq = lane >> 4;
    const int K = g.K, nt = K / BK;
    static_assert(!CONV || SP2, "CONV needs the SP2 loop");
    unsigned voffA[2], voffB[2];
#pragma unroll
    for (int i = 0; i < 2; ++i) { int R, C; stage_rc(tid * 16 + i * 8192, R, C);
        voffA[i] = (unsigned)R * g.lda + (unsigned)C * 2u; voffB[i] = (unsigned)R * g.ldb + (unsigned)C * 2u; }
    const size_t kstep = (size_t)(BK * 2);
    const size_t hstepA = (size_t)HALF * g.lda, hstepB = (size_t)HALF * g.ldb;
    const unsigned ldsw = (unsigned)wid * 1024u;
    const int aoff = lds_byte(wr * 64 + fr, fq * 8), boff = lds_byte(wc * 32 + fr, fq * 8);
#define PG8_SA(b, h) (((b) * 2 + (h)) * HTB)
#define PG8_SB(b, h) ((4 + (b) * 2 + (h)) * HTB)
#define PG8_STAGE(bufoff, gbase, voff) do { _Pragma("unroll") for (int _i = 0; _i < 2; ++_i) \
        __builtin_amdgcn_global_load_lds((const unsigned*)((const char*)(gbase) + (voff)[_i]), (PG8_LAS unsigned*)(lds + (bufoff) + ldsw + _i * 8192), 16, 0, 0); } while (0)
#define PG8_LDA(dst, b, h) do { _Pragma("unroll") for (int m = 0; m < 4; ++m) _Pragma("unroll") for (int k = 0; k < 2; ++k) dst[m][k] = *(const PG8_LAS bf16x8*)(lds + PG8_SA(b, h) + aoff + m * 2048 + k * 1024); } while (0)
#define PG8_LDB(dst, b, h) do { _Pragma("unroll") for (int n = 0; n < 2; ++n) _Pragma("unroll") for (int k = 0; k < 2; ++k) dst[n][k] = *(const PG8_LAS bf16x8*)(lds + PG8_SB(b, h) + boff + n * 2048 + k * 1024); } while (0)
#define PG8_MMA(ai, bj, At, Bt) do { __builtin_amdgcn_s_setprio(1); _Pragma("unroll") for (int m = 0; m < 4; ++m) _Pragma("unroll") for (int n = 0; n < 2; ++n) _Pragma("unroll") for (int k = 0; k < 2; ++k) \
        acc[ai][bj][m][n] = __builtin_amdgcn_mfma_f32_16x16x32_bf16(Bt[n][k], At[m][k], acc[ai][bj][m][n], 0, 0, 0); __builtin_amdgcn_s_setprio(0); } while (0)
#define PG8_WAIT_V(n) asm volatile("s_waitcnt vmcnt(" #n ")" ::: "memory")
#define PG8_WAIT_X(n_) do { if constexpr (CONV) { const int x_ = (n_); if (x_ == 5) asm volatile("s_waitcnt vmcnt(13)" ::: "memory"); else if (x_ == 4) asm volatile("s_waitcnt vmcnt(12)" ::: "memory"); \
        else if (x_ == 1) asm volatile("s_waitcnt vmcnt(9)" ::: "memory"); else asm volatile("s_waitcnt vmcnt(8)" ::: "memory"); } else asm volatile("s_waitcnt vmcnt(8)" ::: "memory"); } while (0)
#define PG8_WAIT_L(n) asm volatile("s_waitcnt lgkmcnt(" #n ")" ::: "memory")
#define PG8_BAR __builtin_amdgcn_s_barrier()
#define PG8_SCHED __builtin_amdgcn_sched_barrier(0)
    Unit cur, nxt; int ui = 0;
    if (!S.next(0, cur)) return;
    f32x4 acc[2][2][4][2];
#pragma unroll
    for (int a = 0; a < 2; ++a)
#pragma unroll
        for (int b = 0; b < 2; ++b)
#pragma unroll
            for (int m = 0; m < 4; ++m)
#pragma unroll
                for (int n = 0; n < 2; ++n) acc[a][b][m][n] = (f32x4){0.f, 0.f, 0.f, 0.f};
    bf16x8 At[4][2], B0[2][2], B1[2][2];
    const char* cA = cur.a; const char* cB = cur.b;
    S.a_ready(cur);
    if constexpr (SP2) {
        PG8_STAGE(PG8_SB(0, 0), cB, voffB); PG8_STAGE(PG8_SB(0, 1), cB + hstepB, voffB); PG8_STAGE(PG8_SA(0, 0), cA, voffA); PG8_STAGE(PG8_SA(0, 1), cA + hstepA, voffA);
        if (wr == 1) PG8_BAR;
        PG8_WAIT_V(2); PG8_BAR;
        PG8_STAGE(PG8_SB(1, 0), cB + kstep, voffB); PG8_STAGE(PG8_SA(1, 0), cA + kstep, voffA); PG8_STAGE(PG8_SB(1, 1), cB + hstepB + kstep, voffB);
        PG8_WAIT_V(6); PG8_BAR;
    } else {
        PG8_STAGE(PG8_SB(0, 0), cB, voffB); PG8_STAGE(PG8_SA(0, 0), cA, voffA); PG8_STAGE(PG8_SB(0, 1), cB + hstepB, voffB); PG8_STAGE(PG8_SA(0, 1), cA + hstepA, voffA);
        if (wr == 1) PG8_BAR;
        PG8_WAIT_V(4); PG8_BAR;
        PG8_STAGE(PG8_SB(1, 0), cB + kstep, voffB); PG8_STAGE(PG8_SA(1, 0), cA + kstep, voffA); PG8_STAGE(PG8_SB(1, 1), cB + hstepB + kstep, voffB);
        PG8_WAIT_V(6); PG8_BAR;
    }
    for (;;) {
        const bool has_next = S.next(ui + 1, nxt);
        const char* nA = has_next ? nxt.a : cA; const char* nB = has_next ? nxt.b : cB;
#pragma unroll 1
        for (int t = 0; t < nt; t += 2) {
            const bool last = (t == nt - 2);
            const char* a1 = cA + (size_t)(t + 1) * kstep;
            const char* a2 = last ? nA : cA + (size_t)(t + 2) * kstep; const char* b2 = last ? nB : cB + (size_t)(t + 2) * kstep;
            const char* a3 = a2 + kstep; const char* b3 = b2 + kstep;
            if (last && has_next) S.a_ready(nxt);
            if constexpr (SP2) {
            int cs_ = 0, cc_ = 0;
            if constexpr (CONV) { if (cx->sub >= 0) { conv_finish(*cx, lds, cx->slot0, lane, cx->sub); cx->sub = -1; cs_ = 1; } PG8_SCHED; }
            PG8_LDB(B0, 0, 0); PG8_LDB(B1, 0, 1); PG8_SCHED; PG8_LDA(At, 0, 0); PG8_STAGE(PG8_SA(1, 1), a1 + hstepA, voffA);
            if constexpr (CONV) { const int s_ = cx->cw + cx->nseq * cx->jn; if (s_ < CONV_NSUB) { conv_issue(*cx, lds, cx->slot0, lane, s_); cx->sub = s_; ++cx->jn; cc_ = 4; } }
            PG8_WAIT_X(cs_ + cc_); PG8_WAIT_L(0); PG8_BAR; PG8_MMA(0, 0, At, B0); PG8_MMA(0, 1, At, B1); PG8_BAR; PG8_SCHED;
            PG8_LDA(At, 0, 1); PG8_STAGE(PG8_SB(0, 0), b2, voffB); PG8_STAGE(PG8_SB(0, 1), b2 + hstepB, voffB); PG8_STAGE(PG8_SA(0, 0), a2, voffA);
            PG8_WAIT_X(cs_ + cc_); PG8_WAIT_L(0); PG8_BAR; PG8_MMA(1, 0, At, B0); PG8_MMA(1, 1, At, B1); PG8_BAR; PG8_SCHED;
            PG8_LDB(B0, 1, 0); PG8_LDB(B1, 1, 1); PG8_SCHED; PG8_LDA(At, 1, 0); PG8_STAGE(PG8_SA(0, 1), a2 + hstepA, voffA);
            PG8_WAIT_X(cc_); PG8_WAIT_L(0); PG8_BAR; PG8_MMA(0, 0, At, B0); PG8_MMA(0, 1, At, B1); PG8_BAR; PG8_SCHED;
            PG8_LDA(At, 1, 1); PG8_STAGE(PG8_SB(1, 0), b3, voffB); PG8_STAGE(PG8_SB(1, 1), b3 + hstepB, voffB); PG8_STAGE(PG8_SA(1, 0), a3, voffA);
            PG8_WAIT_V(8); PG8_WAIT_L(0); PG8_BAR; PG8_MMA(1, 0, At, B0); PG8_MMA(1, 1, At, B1); PG8_BAR; PG8_SCHED;
            } else {
            PG8_LDB(B0, 0, 0); PG8_SCHED; PG8_LDA(At, 0, 0); PG8_STAGE(PG8_SA(1, 1), a1 + hstepA, voffA);
            PG8_WAIT_L(8); PG8_BAR; PG8_WAIT_L(0); PG8_MMA(0, 0, At, B0); PG8_BAR; PG8_SCHED;
            PG8_LDB(B1, 0, 1); PG8_STAGE(PG8_SB(0, 0), b2, voffB);
            PG8_BAR; PG8_WAIT_L(0); PG8_MMA(0, 1, At, B1); PG8_BAR;
            PG8_LDA(At, 0, 1); PG8_STAGE(PG8_SA(0, 0), a2, voffA);
            PG8_BAR; PG8_WAIT_L(0); PG8_MMA(1, 0, At, B0); PG8_BAR; PG8_SCHED;
            PG8_STAGE(PG8_SB(0, 1), b2 + hstepB, voffB);
            PG8_WAIT_V(6); PG8_BAR; PG8_MMA(1, 1, At, B1); PG8_BAR;
            PG8_LDB(B0, 1, 0); PG8_SCHED; PG8_LDA(At, 1, 0); PG8_STAGE(PG8_SA(0, 1), a2 + hstepA, voffA);
            PG8_WAIT_L(8); PG8_BAR; PG8_WAIT_L(0); PG8_MMA(0, 0, At, B0); PG8_BAR; PG8_SCHED;
            PG8_LDB(B1, 1, 1); PG8_STAGE(PG8_SB(1, 0), b3, voffB);
            PG8_BAR; PG8_WAIT_L(0); PG8_MMA(0, 1, At, B1); PG8_BAR;
            PG8_LDA(At, 1, 1); PG8_STAGE(PG8_SA(1, 0), a3, voffA);
            PG8_BAR; PG8_WAIT_L(0); PG8_MMA(1, 0, At, B0); PG8_BAR; PG8_SCHED;
            PG8_STAGE(PG8_SB(1, 1), b3 + hstepB, voffB);
            PG8_WAIT_V(6); PG8_BAR; PG8_MMA(1, 1, At, B1); PG8_BAR;
            }
        }
        if constexpr (ALIGN_EPI) { if (wr == 0) PG8_BAR; }
        if constexpr (!Epi::AFTER_DRAIN) { E(acc, cur, wr, wc, fr, fq); S.done(cur); }
        if (!has_next) break;
        if (!E.keep(cur)) {
#pragma unroll
        for (int a = 0; a < 2; ++a)
#pragma unroll
            for (int b = 0; b < 2; ++b)
#pragma unroll
                for (int m = 0; m < 4; ++m)
#pragma unroll
                    for (int n = 0; n < 2; ++n) acc[a][b][m][n] = (f32x4){0.f, 0.f, 0.f, 0.f};
        }
        cur = nxt; cA = nA; cB = nB; ++ui;
        if constexpr (ALIGN_EPI) { if (wr == 1) PG8_BAR; }
    }
    PG8_WAIT_V(0);
    if constexpr (!ALIGN_EPI) { if (wr == 0) PG8_BAR; }
    PG8_BAR;
    if constexpr (Epi::AFTER_DRAIN) { E.fused(acc, cur, wr, wc, fr, fq, lds, wid, lane); S.done(cur); }
#undef PG8_SA
#undef PG8_SB
#undef PG8_STAGE
#undef PG8_LDA
#undef PG8_LDB
#undef PG8_MMA
#undef PG8_WAIT_V
#undef PG8_WAIT_X
#undef PG8_WAIT_L
#undef PG8_BAR
#undef PG8_SCHED
}

typedef unsigned u32x8 __attribute__((ext_vector_type(8))); typedef int i32x8 __attribute__((ext_vector_type(8)));
constexpr int F8_SCALE_W = 122, F8_SCALE_X = 127;
template <class Epi, class Sched, bool ALIGN_EPI = false, bool SP2 = false, bool CONV = false>
__device__ __forceinline__ void gemm_phase_f8(PG8_LAS unsigned char* lds, const Gemm g, const Sched& S, const Epi& E, ConvCtx* cx = nullptr) {
    int tid_ = threadIdx.x; asm volatile("" : "+v"(tid_));
    const int tid = tid_, wid = __builtin_amdgcn_readfirstlane(tid >> 6), lane = tid & 63, wr = wid >> 2, wc = wid & 3, fr = lane & 15, fq = lane >> 4;
    const int K = g.K, nt = K / BK;
    static_assert(!CONV || SP2, "CONV needs the SP2 loop");
    unsigned voffA[2], voffB[2];
#pragma unroll
    for (int i = 0; i < 2; ++i) { int R, C; stage_rc(tid * 16 + i * 8192, R, C);
        voffA[i] = (unsigned)R * g.lda + (unsigned)C * 2u; voffB[i] = (unsigned)R * g.ldb + (unsigned)C * 2u; }
    const size_t kstep = (size_t)(BK * 2);
    const size_t hstepA = (size_t)HALF * g.lda, hstepB = (size_t)HALF * g.ldb;
    const unsigned ldsw = (unsigned)wid * 1024u;
    const int aoff = lds_byte(wr * 64 + fr, fq * 8), boff = lds_byte(wc * 32 + fr, fq * 8);
#define PG8_SA(b, h) (((b) * 2 + (h)) * HTB)
#define PG8_SB(b, h) ((4 + (b) * 2 + (h)) * HTB)
#define PG8_STAGE(bufoff, gbase, voff) do { _Pragma("unroll") for (int _i = 0; _i < 2; ++_i) \
        __builtin_amdgcn_global_load_lds((const unsigned*)((const char*)(gbase) + (voff)[_i]), (PG8_LAS unsigned*)(lds + (bufoff) + ldsw + _i * 8192), 16, 0, 0); } while (0)
#define PG8_LDA(dst, b, h) do { _Pragma("unroll") for (int m = 0; m < 4; ++m) { const u32x4 lo_ = *(const PG8_LAS u32x4*)(lds + PG8_SA(b, h) + aoff + m * 2048), hi_ = *(const PG8_LAS u32x4*)(lds + PG8_SA(b, h) + aoff + m * 2048 + 1024); dst[m] = __builtin_shufflevector(lo_, hi_, 0, 1, 2, 3, 4, 5, 6, 7); } } while (0)
#define PG8_LDB(dst, b, h) do { _Pragma("unroll") for (int n = 0; n < 2; ++n) { const u32x4 lo_ = *(const PG8_LAS u32x4*)(lds + PG8_SB(b, h) + boff + n * 2048), hi_ = *(const PG8_LAS u32x4*)(lds + PG8_SB(b, h) + boff + n * 2048 + 1024); dst[n] = __builtin_shufflevector(lo_, hi_, 0, 1, 2, 3, 4, 5, 6, 7); } } while (0)
#define PG8_MMA(ai, bj, At, Bt) do { __builtin_amdgcn_s_setprio(1); _Pragma("unroll") for (int m = 0; m < 4; ++m) _Pragma("unroll") for (int n = 0; n < 2; ++n) \
        asm volatile("v_mfma_scale_f32_16x16x128_f8f6f4 %0, %1, %2, %0, %3, %4 op_sel_hi:[0,0,0]" : "+v"(acc[ai][bj][m][n]) : "v"(Bt[n]), "v"(At[m]), "v"(sc_w), "v"(sc_x)); __builtin_amdgcn_s_setprio(0); } while (0)
#define PG8_WAIT_V(n) asm volatile("s_waitcnt vmcnt(" #n ")" ::: "memory")
#define PG8_WAIT_X(n_) do { if constexpr (CONV) { const int x_ = (n_); if (x_ == 5) asm volatile("s_waitcnt vmcnt(13)" ::: "memory"); else if (x_ == 4) asm volatile("s_waitcnt vmcnt(12)" ::: "memory"); \
        else if (x_ == 1) asm volatile("s_waitcnt vmcnt(9)" ::: "memory"); else asm volatile("s_waitcnt vmcnt(8)" ::: "memory"); } else asm volatile("s_waitcnt vmcnt(8)" ::: "memory"); } while (0)
#define PG8_WAIT_L(n) asm volatile("s_waitcnt lgkmcnt(" #n ")" ::: "memory")
#define PG8_BAR __builtin_amdgcn_s_barrier()
#define PG8_SCHED __builtin_amdgcn_sched_barrier(0)
    Unit cur, nxt; int ui = 0;
    if (!S.next(0, cur)) return;
    f32x4 acc[2][2][4][2], nb[2][2];
    E.bias(nb, cur, wc, fq);
#pragma unroll
    for (int a = 0; a < 2; ++a)
#pragma unroll
        for (int b = 0; b < 2; ++b)
#pragma unroll
            for (int m = 0; m < 4; ++m)
#pragma unroll
                for (int n = 0; n < 2; ++n) acc[a][b][m][n] = nb[b][n];
    u32x8 At[4], B0[2], B1[2];
    int sc_w = F8_SCALE_W, sc_x = F8_SCALE_X; asm volatile("" : "+v"(sc_w), "+v"(sc_x));
    const char* cA = cur.a; const char* cB = cur.b;
    S.a_ready(cur);
    if constexpr (SP2) {
        PG8_STAGE(PG8_SB(0, 0), cB, voffB); PG8_STAGE(PG8_SB(0, 1), cB + hstepB, voffB); PG8_STAGE(PG8_SA(0, 0), cA, voffA); PG8_STAGE(PG8_SA(0, 1), cA + hstepA, voffA);
        if (wr == 1) PG8_BAR;
        PG8_WAIT_V(2); PG8_BAR;
        PG8_STAGE(PG8_SB(1, 0), cB + kstep, voffB); PG8_STAGE(PG8_SA(1, 0), cA + kstep, voffA); PG8_STAGE(PG8_SB(1, 1), cB + hstepB + kstep, voffB);
        PG8_WAIT_V(6); PG8_BAR;
    } else {
        PG8_STAGE(PG8_SB(0, 0), cB, voffB); PG8_STAGE(PG8_SA(0, 0), cA, voffA); PG8_STAGE(PG8_SB(0, 1), cB + hstepB, voffB); PG8_STAGE(PG8_SA(0, 1), cA + hstepA, voffA);
        if (wr == 1) PG8_BAR;
        PG8_WAIT_V(4); PG8_BAR;
        PG8_STAGE(PG8_SB(1, 0), cB + kstep, voffB); PG8_STAGE(PG8_SA(1, 0), cA + kstep, voffA); PG8_STAGE(PG8_SB(1, 1), cB + hstepB + kstep, voffB);
        PG8_WAIT_V(6); PG8_BAR;
    }
    for (;;) {
        const bool has_next = S.next(ui + 1, nxt);
        const char* nA = has_next ? nxt.a : cA; const char* nB = has_next ? nxt.b : cB;
        if (has_next) E.bias(nb, nxt, wc, fq);
#pragma unroll 1
        for (int t = 0; t < nt; t += 2) {
            const bool last = (t == nt - 2);
            const char* a1 = cA + (size_t)(t + 1) * kstep;
            const char* a2 = last ? nA : cA + (size_t)(t + 2) * kstep; const char* b2 = last ? nB : cB + (size_t)(t + 2) * kstep;
            const char* a3 = a2 + kstep; const char* b3 = b2 + kstep;
            if (last && has_next) S.a_ready(nxt);
            if constexpr (SP2) {
            int cs_ = 0, cc_ = 0;
            if constexpr (CONV) { if (cx->sub >= 0) { conv_finish(*cx, lds, cx->slot0, lane, cx->sub); cx->sub = -1; cs_ = 1; } PG8_SCHED; }
            PG8_LDB(B0, 0, 0); PG8_LDB(B1, 0, 1); PG8_SCHED; PG8_LDA(At, 0, 0); PG8_STAGE(PG8_SA(1, 1), a1 + hstepA, voffA);
            if constexpr (CONV) { const int s_ = cx->cw + cx->nseq * cx->jn; if (s_ < CONV_NSUB) { conv_issue(*cx, lds, cx->slot0, lane, s_); cx->sub = s_; ++cx->jn; cc_ = 4; } }
            PG8_WAIT_X(cs_ + cc_); PG8_WAIT_L(0); PG8_BAR; PG8_MMA(0, 0, At, B0); PG8_MMA(0, 1, At, B1); PG8_BAR; PG8_SCHED;
            PG8_LDA(At, 0, 1); PG8_STAGE(PG8_SB(0, 0), b2, voffB); PG8_STAGE(PG8_SB(0, 1), b2 + hstepB, voffB); PG8_STAGE(PG8_SA(0, 0), a2, voffA);
            PG8_WAIT_X(cs_ + cc_); PG8_WAIT_L(0); PG8_BAR; PG8_MMA(1, 0, At, B0); PG8_MMA(1, 1, At, B1); PG8_BAR; PG8_SCHED;
            PG8_LDB(B0, 1, 0); PG8_LDB(B1, 1, 1); PG8_SCHED; PG8_LDA(At, 1, 0); PG8_STAGE(PG8_SA(0, 1), a2 + hstepA, voffA);
            PG8_WAIT_X(cc_); PG8_WAIT_L(0); PG8_BAR; PG8_MMA(0, 0, At, B0); PG8_MMA(0, 1, At, B1); PG8_BAR; PG8_SCHED;
            PG8_LDA(At, 1, 1); PG8_STAGE(PG8_SB(1, 0), b3, voffB); PG8_STAGE(PG8_SB(1, 1), b3 + hstepB, voffB); PG8_STAGE(PG8_SA(1, 0), a3, voffA);
            PG8_WAIT_V(8); PG8_WAIT_L(0); PG8_BAR; PG8_MMA(1, 0, At, B0); PG8_MMA(1, 1, At, B1); PG8_BAR; PG8_SCHED;
            } else {
            PG8_LDB(B0, 0, 0); PG8_SCHED; PG8_LDA(At, 0, 0); PG8_STAGE(PG8_SA(1, 1), a1 + hstepA, voffA);
            PG8_WAIT_L(8); PG8_BAR; PG8_WAIT_L(0); PG8_MMA(0, 0, At, B0); PG8_BAR; PG8_SCHED;
            PG8_LDB(B1, 0, 1); PG8_STAGE(PG8_SB(0, 0), b2, voffB);
            PG8_BAR; PG8_WAIT_L(0); PG8_MMA(0, 1, At, B1); PG8_BAR;
            PG8_LDA(At, 0, 1); PG8_STAGE(PG8_SA(0, 0), a2, voffA);
            PG8_BAR; PG8_WAIT_L(0); PG8_MMA(1, 0, At, B0); PG8_BAR; PG8_SCHED;
            PG8_STAGE(PG8_SB(0, 1), b2 + hstepB, voffB);
            PG8_WAIT_V(6); PG8_BAR; PG8_MMA(1, 1, At, B1); PG8_BAR;
            PG8_LDB(B0, 1, 0); PG8_SCHED; PG8_LDA(At, 1, 0); PG8_STAGE(PG8_SA(0, 1), a2 + hstepA, voffA);
            PG8_WAIT_L(8); PG8_BAR; PG8_WAIT_L(0); PG8_MMA(0, 0, At, B0); PG8_BAR; PG8_SCHED;
            PG8_LDB(B1, 1, 1); PG8_STAGE(PG8_SB(1, 0), b3, voffB);
            PG8_BAR; PG8_WAIT_L(0); PG8_MMA(0, 1, At, B1); PG8_BAR;
            PG8_LDA(At, 1, 1); PG8_STAGE(PG8_SA(1, 0), a3, voffA);
            PG8_BAR; PG8_WAIT_L(0); PG8_MMA(1, 0, At, B0); PG8_BAR; PG8_SCHED;
            PG8_STAGE(PG8_SB(1, 1), b3 + hstepB, voffB);
            PG8_WAIT_V(6); PG8_BAR; PG8_MMA(1, 1, At, B1); PG8_BAR;
            }
        }
        if constexpr (ALIGN_EPI) { if (wr == 0) PG8_BAR; }
        if constexpr (Epi::HAS_BIAS) asm volatile("" : "+v"(nb[0][0]), "+v"(nb[0][1]), "+v"(nb[1][0]), "+v"(nb[1][1]));
        asm volatile("s_nop 15\n\ts_nop 15" ::: "memory");
        if constexpr (!Epi::AFTER_DRAIN) { E(acc, cur, wr, wc, fr, fq); S.done(cur); }
        if (!has_next) break;
        if (!E.keep(cur)) {
#pragma unroll
        for (int a = 0; a < 2; ++a)
#pragma unroll
            for (int b = 0; b < 2; ++b)
#pragma unroll
                for (int m = 0; m < 4; ++m)
#pragma unroll
                    for (int n = 0; n < 2; ++n) acc[a][b][m][n] = nb[b][n];
        }
        cur = nxt; cA = nA; cB = nB; ++ui;
        if constexpr (ALIGN_EPI) { if (wr == 1) PG8_BAR; }
    }
    PG8_WAIT_V(0);
    if constexpr (!ALIGN_EPI) { if (wr == 0) PG8_BAR; }
    PG8_BAR;
    if constexpr (Epi::AFTER_DRAIN) { E.fused(acc, cur, wr, wc, fr, fq, lds, wid, lane); S.done(cur); }
#undef PG8_SA
#undef PG8_SB
#undef PG8_STAGE
#undef PG8_LDA
#undef PG8_LDB
#undef PG8_MMA
#undef PG8_WAIT_V
#undef PG8_WAIT_X
#undef PG8_WAIT_L
#undef PG8_BAR
#undef PG8_SCHED
}
}

#include <hip/hip_bf16.h>
#include <cmath>
namespace attn_body {
using bf16=__hip_bfloat16;
using bf16x8=__attribute__((ext_vector_type(8)))short;
using s16x4=__attribute__((ext_vector_type(4)))short;
using f32x16=__attribute__((ext_vector_type(16)))float;
using u32x4=__attribute__((ext_vector_type(4)))unsigned;
constexpr int SEQ=8192,D=64; constexpr int QP=512,KP=512,VP=512,OP=1024;
constexpr int NW=8,QBLK=32,QB=QBLK*NW,KVBLK=64,NQB=SEQ/QB;
constexpr int ATTN_UNIT_ROWS=QB;
__device__ __forceinline__ int crow(int r,int hi){return (r&3)+8*(r>>2)+4*hi;}
#define SBAR() __builtin_amdgcn_sched_barrier(0)
__device__ __forceinline__ void cmask(f32x16&p0,f32x16&p1,int jb,int qrel,int hi){
  const float NEG=-INFINITY; (void)hi;
  if(jb>(qrel>>6)){
  #pragma unroll
  for(int r=0;r<16;++r){p0[r]=NEG;p1[r]=NEG;} }
}

constexpr int NSLOT=3, SLOTB=8192;
constexpr int LDS_K=0, LDS_V=NSLOT*SLOTB, LDS_WS=2*NSLOT*SLOTB, LDS_OST=LDS_WS+NW*64*4, LDS_BYTES=LDS_OST+NW*4096;
constexpr float C2=0.125f*1.4426950408889634f;
__device__ __forceinline__ void glds16(const void*gsrc,unsigned lds_dst){unsigned keep;
  asm volatile("s_mov_b32 %0, m0\n\ts_mov_b32 m0, %2\n\ts_nop 0\n\tglobal_load_lds_dwordx4 %1, off\n\ts_mov_b32 m0, %0":"=&s"(keep):"v"(gsrc),"s"(lds_dst):"memory");}
__device__ __forceinline__ float max3f(float a,float b,float c){float r;asm("v_max3_f32 %0, %1, %2, %3":"=v"(r):"v"(a),"v"(b),"v"(c));return r;}
__device__ __forceinline__ float max2f(float a,float b){float r;asm("v_max_f32_e32 %0, %1, %2":"=v"(r):"v"(a),"v"(b));return r;}
__device__ __forceinline__ float fadd_s(float a,float b){float r;asm("v_add_f32_e32 %0, %1, %2":"=v"(r):"v"(a),"v"(b));return r;}
__device__ __forceinline__ float fsub_s(float a,float b){float r;asm("v_sub_f32_e32 %0, %1, %2":"=v"(r):"v"(a),"v"(b));return r;}
typedef float f32x2_t __attribute__((ext_vector_type(2))); typedef __bf16 bf16x2_t __attribute__((ext_vector_type(2)));
__device__ __forceinline__ unsigned cvtpk_s(float lo,float hi){f32x2_t v={lo,hi};bf16x2_t b=__builtin_convertvector(v,bf16x2_t);return __builtin_bit_cast(unsigned,b);}
#define WAIT_BAR(N) asm volatile("s_waitcnt vmcnt(" #N ") lgkmcnt(0)\n\ts_barrier":::"memory")

__device__ __forceinline__ void qkt(f32x16&p0,f32x16&p1,const char*Kslot,const bf16x8*qr,const f32x16&negm,int r32,int hi){
  const char*kb=Kslot+hi*1024+r32*16;
  #pragma unroll
  for(int d0=0;d0<4;++d0){
    const bf16x8 b0=*reinterpret_cast<const bf16x8*>(kb+d0*2048);
    const bf16x8 b1=*reinterpret_cast<const bf16x8*>(kb+d0*2048+512);
    if(d0==0){p0=__builtin_amdgcn_mfma_f32_32x32x16_bf16(b0,qr[0],negm,0,0,0);p1=__builtin_amdgcn_mfma_f32_32x32x16_bf16(b1,qr[0],negm,0,0,0);}
    else{p0=__builtin_amdgcn_mfma_f32_32x32x16_bf16(b0,qr[d0],p0,0,0,0);p1=__builtin_amdgcn_mfma_f32_32x32x16_bf16(b1,qr[d0],p1,0,0,0);}}
}
typedef __attribute__((address_space(3))) const char* lds_cptr;
typedef short v4i16_t __attribute__((ext_vector_type(4)));
__device__ __forceinline__ void kload8(bf16x8*kf,lds_cptr kp){
  kf[0]=*(const __attribute__((address_space(3))) bf16x8*)(kp);      kf[1]=*(const __attribute__((address_space(3))) bf16x8*)(kp+512);
  kf[2]=*(const __attribute__((address_space(3))) bf16x8*)(kp+2048); kf[3]=*(const __attribute__((address_space(3))) bf16x8*)(kp+2560);
  kf[4]=*(const __attribute__((address_space(3))) bf16x8*)(kp+4096); kf[5]=*(const __attribute__((address_space(3))) bf16x8*)(kp+4608);
  kf[6]=*(const __attribute__((address_space(3))) bf16x8*)(kp+6144); kf[7]=*(const __attribute__((address_space(3))) bf16x8*)(kp+6656);
}
__device__ __forceinline__ void kload2(bf16x8*kf,lds_cptr kp,int j){ kf[2*j]=*(const __attribute__((address_space(3))) bf16x8*)(kp+j*2048); kf[2*j+1]=*(const __attribute__((address_space(3))) bf16x8*)(kp+j*2048+512); }
__device__ __forceinline__ s16x4 vtr(lds_cptr p){ return __builtin_bit_cast(s16x4,__builtin_amdgcn_ds_read_tr16_b64_v4i16((__attribute__((address_space(3))) v4i16_t*)p)); }
__device__ __forceinline__ float rowmax(const f32x16&p0,const f32x16&p1){
  float a=max3f(p0[0],p0[1],p1[0]),b=max3f(p0[2],p0[3],p1[1]);a=max3f(a,p1[2],p1[3]);
  #pragma unroll
  for(int r=4;r<16;r+=4){a=max3f(a,p0[r],p0[r+1]);b=max3f(b,p0[r+2],p0[r+3]);a=max3f(a,p1[r],p1[r+1]);b=max3f(b,p1[r+2],p1[r+3]);}
  const float m=max2f(a,b);
  auto rr=__builtin_amdgcn_permlane32_swap(__float_as_uint(m),__float_as_uint(m),false,false);
  return max2f(__uint_as_float(rr[0]),__uint_as_float(rr[1]));
}
__device__ __forceinline__ void pv(f32x16*o,int vb,bf16x8 pa0,bf16x8 pa1,bf16x8 pa2,bf16x8 pa3){
  #pragma unroll
  for(int d0=0;d0<2;++d0){s16x4 lo[4],hi[4];
    #pragma unroll
    for(int ks=0;ks<4;++ks){
      asm volatile("ds_read_b64_tr_b16 %0,%1 offset:%c2":"=&v"(lo[ks]):"v"(vb),"i"(d0*4096+ks*1024):"memory");
      asm volatile("ds_read_b64_tr_b16 %0,%1 offset:%c2":"=&v"(hi[ks]):"v"(vb),"i"(d0*4096+ks*1024+512):"memory");}
    asm volatile("s_waitcnt lgkmcnt(0)":::"memory");SBAR();
    #define PK(k) (bf16x8){lo[k][0],lo[k][1],lo[k][2],lo[k][3],hi[k][0],hi[k][1],hi[k][2],hi[k][3]}
    o[d0]=__builtin_amdgcn_mfma_f32_32x32x16_bf16(pa0,PK(0),o[d0],0,0,0);
    o[d0]=__builtin_amdgcn_mfma_f32_32x32x16_bf16(pa1,PK(1),o[d0],0,0,0);
    o[d0]=__builtin_amdgcn_mfma_f32_32x32x16_bf16(pa2,PK(2),o[d0],0,0,0);
    o[d0]=__builtin_amdgcn_mfma_f32_32x32x16_bf16(pa3,PK(3),o[d0],0,0,0);
    #undef PK
  }
}

#ifndef ATTN_STORE16
#define ATTN_STORE16(p,v) (*(u32x4*)(p)=(v))
#endif
template<int THRL> __device__ __forceinline__ void attn_unit(int qb,const bf16*Q,const bf16*__restrict__ K,const bf16*__restrict__ V,bf16*O,char*shm){
  int tid_=threadIdx.x; asm volatile("":"+v"(tid_)); const int tid=tid_,lane=tid&63,r32=lane&31,hi=lane>>5; const int wid=__builtin_amdgcn_readfirstlane(tid>>6);
  const int q0=qb*QB;
  const bf16*Qw=Q+(long)(q0+wid*QBLK)*QP;
  const bf16*Kh=K,*Vh=V;
  const unsigned lds0=(unsigned)(uintptr_t)shm;
  float*wsf=(float*)(shm+LDS_WS)+wid*64;
  const bf16*ksrc=Kh+(long)lane*KP+wid*8;
  const bf16*vsrc=Vh+(long)(16*(wid&3)+(lane>>2))*VP+(wid>>2)*32+(lane&3)*8;
  const unsigned kdst=lds0+LDS_K+wid*1024, vdst=lds0+LDS_V+wid*1024;
  #define DMA_K(t,slot) glds16(ksrc+(long)(t)*KVBLK*KP,(unsigned)__builtin_amdgcn_readfirstlane(kdst+(slot)))
  #define DMA_V(t,slot) glds16(vsrc+(long)(t)*KVBLK*VP,(unsigned)__builtin_amdgcn_readfirstlane(vdst+(slot)))
  const int vb0=(int)(lds0+LDS_V)+((lane>>4)&1)*32+(lane&3)*8+(4*hi+((lane&15)>>2))*64;
  const char*Kbase=shm+LDS_K; bf16x8 kf[8];
  const lds_cptr shm3=(lds_cptr)shm; const lds_cptr kp0=shm3+LDS_K+hi*1024+r32*16; const lds_cptr vp0=shm3+LDS_V+((lane>>4)&1)*32+(lane&3)*8+(4*hi+((lane&15)>>2))*64;
  const int NT=(q0+QB)/KVBLK;
  DMA_K(0,0);DMA_V(0,0);DMA_K(1,SLOTB);
  bf16x8 qr[4];
  #pragma unroll
  for(int d0=0;d0<4;++d0)qr[d0]=*reinterpret_cast<const bf16x8*>(&Qw[(long)r32*QP+d0*16+hi*8]);
  float mhat=0.f,l_reg=0.f;f32x16 o[2];o[0]=f32x16{};o[1]=f32x16{};f32x16 negm=f32x16{};asm volatile("":"+v"(negm));
  const int qrel=wid*QBLK+r32;
  #define CMASK(P0,P1,t) do{int jb_=(t)-(NT-4); if(jb_>=0)cmask(P0,P1,jb_,qrel,hi);}while(0)
  bool resc=false;
  #define START(P0,P1) do{ const float rm=rowmax(P0,P1); resc=false; \
    { const float dl=rm; mhat=fadd_s(mhat,dl); \
      _Pragma("unroll") for(int r=0;r<16;++r){P0[r]=fsub_s(P0[r],dl);P1[r]=fsub_s(P1[r],dl);} \
      _Pragma("unroll") for(int r=0;r<16;++r)negm[r]=-mhat; asm volatile("":"+v"(negm)); } \
    _Pragma("unroll") for(int r=0;r<16;++r)P0[r]=__builtin_amdgcn_exp2f(P0[r]); }while(0)
  #define RESC() do{ if(resc){ asm volatile("s_waitcnt lgkmcnt(0)":::"memory"); \
      _Pragma("unroll") for(int d_=0;d_<2;++d_) _Pragma("unroll") for(int r=0;r<16;++r)o[d_][r]*=wsf[crow(r,hi)]; } }while(0)
  f32x16 pA0,pA1,pB0,pB1;
  int sl_prev=0,sl_cur=0,sl_next=SLOTB;
  #define ROT() do{sl_prev=sl_cur;sl_cur=sl_next;sl_next=(sl_next==(NSLOT-1)*SLOTB)?0:sl_next+SLOTB;}while(0)
  DMA_K(2,2*SLOTB);
  WAIT_BAR(3);
  qkt(pA0,pA1,Kbase,qr,negm,r32,hi);asm volatile("s_nop 15\n\ts_nop 7":"+v"(pA0),"+v"(pA1));CMASK(pA0,pA1,0);
  START(pA0,pA1);
  _Pragma("unroll") for(int r=0;r<16;++r)pA1[r]=__builtin_amdgcn_exp2f(pA1[r]);
  WAIT_BAR(0);
  DMA_K(3,0);DMA_V(1,SLOTB);
  ROT();
  kload8(kf,kp0+sl_cur);
  WAIT_BAR(2);
  s16x4 vlo[8],vhi[8]; u32x4 pw0,pw1,pw2,pw3;
  #define PKW(P,B) cvtpk_s(P[B],P[B+1])
  #define PAF(k) __builtin_bit_cast(bf16x8,pw##k)
  #define VFR(i) (bf16x8){vlo[i][0],vlo[i][1],vlo[i][2],vlo[i][3],vhi[i][0],vhi[i][1],vhi[i][2],vhi[i][3]}
  #define PIN(x) asm volatile("":"+v"(x))
  #define MX3(a,b,c) __builtin_fmaxf(__builtin_fmaxf((a),(b)),(c))
  #define GAPA(MF,A0,A1,A2,A3,W0,W1,PW) do{ MF; sacc+=A0; sacc+=A1; sacc+=A2; sacc+=A3; PIN(sacc); W0; W1; PIN(PW); SBAR(); }while(0)
  #define EX(v) __builtin_amdgcn_exp2f(v)
  #define GAPB(MF,X,B) do{ MF; X[B]=EX(X[B]); X[B+1]=EX(X[B+1]); X[B+2]=EX(X[B+2]); X[B+3]=EX(X[B+3]); PIN(X); SBAR(); }while(0)
  #define VRD(i) do{ vlo[i]=vtr(vp_+(((i)>>2)*4096+((i)&3)*1024)); vhi[i]=vtr(vp_+(((i)>>2)*4096+((i)&3)*1024+512)); }while(0)
  #define KRD(G,j) do{ if(G){ kload2(kf,kp0+sl_next,j); SBAR(); } }while(0)
  #define STEP(C0,C1,P0,P1,t,GK,GV,GL) do{ SBAR(); \
    const lds_cptr vp_=vp0+sl_prev; \
    VRD(0); SBAR(); float sacc=(P0[0]+P0[1]); \
    GAPA(C0=__builtin_amdgcn_mfma_f32_32x32x16_bf16(kf[0],qr[0],negm,0,0,0), P0[2],P0[3],P0[4],P0[5],     pw0[0]=PKW(P0,0), pw0[1]=PKW(P0,2), pw0); \
    VRD(4); SBAR(); GAPA(C1=__builtin_amdgcn_mfma_f32_32x32x16_bf16(kf[1],qr[0],negm,0,0,0), P0[6],P0[7],P0[8],P0[9],     pw0[2]=PKW(P0,4), pw0[3]=PKW(P0,6), pw0); \
    VRD(1); SBAR(); GAPA(C0=__builtin_amdgcn_mfma_f32_32x32x16_bf16(kf[2],qr[1],C0,0,0,0),   P0[10],P0[11],P0[12],P0[13], pw1[0]=PKW(P0,8), pw1[1]=PKW(P0,10), pw1); \
    VRD(5); SBAR(); GAPA(C1=__builtin_amdgcn_mfma_f32_32x32x16_bf16(kf[3],qr[1],C1,0,0,0),   P0[14],P0[15],P1[0],P1[1],   pw1[2]=PKW(P0,12),pw1[3]=PKW(P0,14), pw1); \
    VRD(2); SBAR(); GAPA(C0=__builtin_amdgcn_mfma_f32_32x32x16_bf16(kf[4],qr[2],C0,0,0,0),   P1[2],P1[3],P1[4],P1[5],     pw2[0]=PKW(P1,0), pw2[1]=PKW(P1,2), pw2); \
    VRD(6); SBAR(); GAPA(C1=__builtin_amdgcn_mfma_f32_32x32x16_bf16(kf[5],qr[2],C1,0,0,0),   P1[6],P1[7],P1[8],P1[9],     pw2[2]=PKW(P1,4), pw2[3]=PKW(P1,6), pw2); \
    VRD(3); SBAR(); GAPA(C0=__builtin_amdgcn_mfma_f32_32x32x16_bf16(kf[6],qr[3],C0,0,0,0),   P1[10],P1[11],P1[12],P1[13], pw3[0]=PKW(P1,8), pw3[1]=PKW(P1,10), pw3); \
    VRD(7); SBAR(); GAPA(C1=__builtin_amdgcn_mfma_f32_32x32x16_bf16(kf[7],qr[3],C1,0,0,0),   P1[14],P1[15],0.f,0.f,       pw3[2]=PKW(P1,12),pw3[3]=PKW(P1,14), pw3); \
    l_reg+=sacc; \
    if(GK){DMA_K((t)+3,sl_cur);} if(GV){DMA_V((t)+1,sl_next);} \
    CMASK(C0,C1,t); \
    { float a=MX3(C0[0],C0[1],C1[0]),b=MX3(C0[2],C0[3],C1[1]); a=MX3(a,C1[2],C1[3]); \
      _Pragma("unroll") for(int r=4;r<16;r+=4){a=MX3(a,C0[r],C0[r+1]);b=MX3(b,C0[r+2],C0[r+3]);a=MX3(a,C1[r],C1[r+1]);b=MX3(b,C1[r+2],C1[r+3]);} \
      float rm=__builtin_fmaxf(a,b); { auto rr=__builtin_amdgcn_permlane32_swap(__float_as_uint(rm),__float_as_uint(rm),false,false); rm=__builtin_fmaxf(__uint_as_float(rr[0]),__uint_as_float(rr[1])); } \
      resc=false; \
      if(__builtin_expect(__any(rm>(float)THRL),0)){ const float dl=__builtin_fmaxf(rm,0.f); mhat+=dl; \
        _Pragma("unroll") for(int r=0;r<16;++r){C0[r]-=dl;C1[r]-=dl;} \
        _Pragma("unroll") for(int r=0;r<16;++r)negm[r]=-mhat; asm volatile("":"+v"(negm)); \
        const float f=__builtin_amdgcn_exp2f(-dl); l_reg*=f; if(hi==0)wsf[r32]=f; resc=true; } } \
    SBAR(); \
    GAPB(o[0]=__builtin_amdgcn_mfma_f32_32x32x16_bf16(PAF(0),VFR(0),o[0],0,0,0), C0,0); \
    GAPB(o[1]=__builtin_amdgcn_mfma_f32_32x32x16_bf16(PAF(0),VFR(4),o[1],0,0,0), C0,4); \
    KRD(GL,0); GAPB(o[0]=__builtin_amdgcn_mfma_f32_32x32x16_bf16(PAF(1),VFR(1),o[0],0,0,0), C0,8); \
    KRD(GL,1); GAPB(o[1]=__builtin_amdgcn_mfma_f32_32x32x16_bf16(PAF(1),VFR(5),o[1],0,0,0), C0,12); \
    KRD(GL,2); GAPB(o[0]=__builtin_amdgcn_mfma_f32_32x32x16_bf16(PAF(2),VFR(2),o[0],0,0,0), C1,0); \
    KRD(GL,3); GAPB(o[1]=__builtin_amdgcn_mfma_f32_32x32x16_bf16(PAF(2),VFR(6),o[1],0,0,0), C1,4); \
    GAPB(o[0]=__builtin_amdgcn_mfma_f32_32x32x16_bf16(PAF(3),VFR(3),o[0],0,0,0), C1,8); \
    GAPB(o[1]=__builtin_amdgcn_mfma_f32_32x32x16_bf16(PAF(3),VFR(7),o[1],0,0,0), C1,12); \
    }while(0)
  int t=1;
  #undef CMASK
  #define CMASK(P0,P1,t) do{}while(0)
  for(;t+5<NT;t+=2){
    STEP(pB0,pB1,pA0,pA1,t,true,true,true);     WAIT_BAR(2); RESC(); ROT();
    STEP(pA0,pA1,pB0,pB1,t+1,true,true,true);   WAIT_BAR(2); RESC(); ROT();
  }
  #undef CMASK
  #define CMASK(P0,P1,t) do{int jb_=(t)-(NT-4); if(jb_>=0)cmask(P0,P1,jb_,qrel,hi);}while(0)
  #define ENDW(tt) do{ if((tt)+3<NT){WAIT_BAR(2);} else if((tt)+2<NT){WAIT_BAR(1);} else {WAIT_BAR(0);} }while(0)
  for(;t+1<NT;t+=2){
    STEP(pB0,pB1,pA0,pA1,t,(t+3<NT),(t+1<NT),(t+1<NT));       ENDW(t);   RESC(); ROT();
    STEP(pA0,pA1,pB0,pB1,t+1,(t+4<NT),(t+2<NT),(t+2<NT));     ENDW(t+1); RESC(); ROT();
  }
  STEP(pB0,pB1,pA0,pA1,NT-1,false,false,false); RESC();
  { float sacc=pB0[0]+pB0[1]; _Pragma("unroll") for(int r=2;r<16;++r)sacc+=pB0[r]; _Pragma("unroll") for(int r=0;r<16;++r)sacc+=pB1[r]; l_reg+=sacc;
    pw0=(u32x4){PKW(pB0,0),PKW(pB0,2),PKW(pB0,4),PKW(pB0,6)};pw1=(u32x4){PKW(pB0,8),PKW(pB0,10),PKW(pB0,12),PKW(pB0,14)};pw2=(u32x4){PKW(pB1,0),PKW(pB1,2),PKW(pB1,4),PKW(pB1,6)};pw3=(u32x4){PKW(pB1,8),PKW(pB1,10),PKW(pB1,12),PKW(pB1,14)};
    SBAR(); pv(o,vb0+sl_cur,PAF(0),PAF(1),PAF(2),PAF(3)); }
  #undef PKW
  #undef PAF
  #undef VFR
  #undef PIN
  #undef MX3
  #undef GAPA
  #undef GAPB
  #undef EX
  #undef VRD
  #undef KRD
  #undef STEP
  #undef ENDW
  {auto rr=__builtin_amdgcn_permlane32_swap(__float_as_uint(l_reg),__float_as_uint(l_reg),false,false);l_reg=__uint_as_float(rr[0])+__uint_as_float(rr[1]);}
  if(hi==0)wsf[32+r32]=l_reg;asm volatile("s_waitcnt lgkmcnt(0)":::"memory");
  float rli[16];
  #pragma unroll
  for(int r=0;r<16;++r)rli[r]=__builtin_amdgcn_rcpf(wsf[32+crow(r,hi)]);
  bf16*Ow=O+(long)(q0+wid*QBLK)*OP;
  { bf16*stg=(bf16*)(shm+LDS_OST)+wid*2048;
    #pragma unroll
    for(int r=0;r<16;++r){const int orow=crow(r,hi);
      #pragma unroll
      for(int d0=0;d0<2;++d0)stg[orow*64+d0*32+r32]=__float2bfloat16(o[d0][r]*rli[r]);}
    asm volatile("s_waitcnt lgkmcnt(0)":::"memory");
    #pragma unroll
    for(int i=0;i<4;++i){const int row=i*8+(lane>>3),ch=lane&7; const u32x4 v=*(const u32x4*)(stg+row*64+ch*8); ATTN_STORE16(Ow+(long)row*OP+ch*8,v);} }
  asm volatile("s_waitcnt lgkmcnt(0)\n\ts_barrier":::"memory");
  #undef DMA_K
  #undef DMA_V
  #undef CMASK
  #undef START
  #undef RESC
  #undef ROT
}

constexpr int SLOTV=16384, L2_K=0, L2_V=NSLOT*SLOTB, L2_WS=L2_V+NSLOT*SLOTV, L2_BYTES=L2_WS+NW*64*4;
__device__ __forceinline__ void qkt0(f32x16&p0,f32x16&p1,const char*Kslot,const bf16x8*qr,int r32,int hi){
  const char*kb=Kslot+hi*1024+r32*16; const f32x16 z=f32x16{};
  #pragma unroll
  for(int d0=0;d0<4;++d0){
    const bf16x8 b0=*reinterpret_cast<const bf16x8*>(kb+d0*2048);
    const bf16x8 b1=*reinterpret_cast<const bf16x8*>(kb+d0*2048+512);
    if(d0==0){p0=__builtin_amdgcn_mfma_f32_32x32x16_bf16(b0,qr[0],z,0,0,0);p1=__builtin_amdgcn_mfma_f32_32x32x16_bf16(b1,qr[0],z,0,0,0);}
    else{p0=__builtin_amdgcn_mfma_f32_32x32x16_bf16(b0,qr[d0],p0,0,0,0);p1=__builtin_amdgcn_mfma_f32_32x32x16_bf16(b1,qr[d0],p1,0,0,0);}}
}
__device__ __forceinline__ void pv128(f32x16*o,int vb,bf16x8 pa0,bf16x8 pa1,bf16x8 pa2,bf16x8 pa3){
  #pragma unroll
  for(int d0=0;d0<4;++d0){s16x4 lo[4],hi[4];
    #pragma unroll
    for(int ks=0;ks<4;++ks){
      asm volatile("ds_read_b64_tr_b16 %0,%1 offset:%c2":"=&v"(lo[ks]):"v"(vb),"i"(d0*4096+ks*1024):"memory");
      asm volatile("ds_read_b64_tr_b16 %0,%1 offset:%c2":"=&v"(hi[ks]):"v"(vb),"i"(d0*4096+ks*1024+512):"memory");}
    asm volatile("s_waitcnt lgkmcnt(0)":::"memory");SBAR();
    #define PK(k) (bf16x8){lo[k][0],lo[k][1],lo[k][2],lo[k][3],hi[k][0],hi[k][1],hi[k][2],hi[k][3]}
    o[d0]=__builtin_amdgcn_mfma_f32_32x32x16_bf16(pa0,PK(0),o[d0],0,0,0);
    o[d0]=__builtin_amdgcn_mfma_f32_32x32x16_bf16(pa1,PK(1),o[d0],0,0,0);
    o[d0]=__builtin_amdgcn_mfma_f32_32x32x16_bf16(pa2,PK(2),o[d0],0,0,0);
    o[d0]=__builtin_amdgcn_mfma_f32_32x32x16_bf16(pa3,PK(3),o[d0],0,0,0);
    #undef PK
  }
}
template<int THRL> __device__ __forceinline__ void attn_unit128(int qb,const bf16*Q,const bf16*__restrict__ K,const bf16*__restrict__ V,bf16*O,char*shm,pg8::ConvCtx*cx){
  int tid_=threadIdx.x; asm volatile("":"+v"(tid_)); const int tid=tid_,lane=tid&63,r32=lane&31,hi=lane>>5; const int wid=__builtin_amdgcn_readfirstlane(tid>>6);
  const int q0=qb*QB;
  const bf16*Qw=Q+(long)(q0+wid*QBLK)*QP;
  const unsigned lds0=(unsigned)(uintptr_t)shm;
  float*wsf=(float*)(shm+L2_WS)+wid*64;
  const bf16*ksrc=K+(long)lane*KP+wid*8;
  const bf16*vsrc=V+(long)(16*(wid&3)+(lane>>2))*VP+(wid>>2)*32+(lane&3)*8;
  const unsigned kdst=lds0+L2_K+wid*1024, vdst=lds0+L2_V+wid*1024;
  #define DMA_K(t,slot) glds16(ksrc+(long)(t)*KVBLK*KP,(unsigned)__builtin_amdgcn_readfirstlane(kdst+(slot)))
  #define DMA_V(t,slot) do{ glds16(vsrc+(long)(t)*KVBLK*VP,(unsigned)__builtin_amdgcn_readfirstlane(vdst+2*(slot))); glds16(vsrc+64+(long)(t)*KVBLK*VP,(unsigned)__builtin_amdgcn_readfirstlane(vdst+2*(slot)+8192)); }while(0)
  const int vb0=(int)(lds0+L2_V)+((lane>>4)&1)*32+(lane&3)*8+(4*hi+((lane&15)>>2))*64;
  const char*Kbase=shm+L2_K; bf16x8 kf[8];
  const lds_cptr shm3=(lds_cptr)shm; const lds_cptr kp0=shm3+L2_K+hi*1024+r32*16; const lds_cptr vp0=shm3+L2_V+((lane>>4)&1)*32+(lane&3)*8+(4*hi+((lane&15)>>2))*64;
  const int NT=(q0+QB)/KVBLK;
  DMA_K(0,0);DMA_V(0,0);DMA_K(1,SLOTB);
  bf16x8 qr[4];
  #pragma unroll
  for(int d0=0;d0<4;++d0)qr[d0]=*reinterpret_cast<const bf16x8*>(&Qw[(long)r32*QP+d0*16+hi*8]);
  float l_reg=0.f;f32x16 o[4];
  ;o[0]=f32x16{};o[1]=f32x16{};o[2]=f32x16{};o[3]=f32x16{};
  const int qrel=wid*QBLK+r32;
  #define CMASK(P0,P1,t) do{int jb_=(t)-(NT-4); if(jb_>=0)cmask(P0,P1,jb_,qrel,hi);}while(0)
  #define RESC() do{}while(0)
  f32x16 pA0,pA1,pB0,pB1;
  int sl_prev=0,sl_cur=0,sl_next=SLOTB;
  #define ROT() do{sl_prev=sl_cur;sl_cur=sl_next;sl_next=(sl_next==(NSLOT-1)*SLOTB)?0:sl_next+SLOTB;}while(0)
  DMA_K(2,2*SLOTB);
  WAIT_BAR(4);
  qkt0(pA0,pA1,Kbase,qr,r32,hi);asm volatile("s_nop 15\n\ts_nop 7":"+v"(pA0),"+v"(pA1));CMASK(pA0,pA1,0);
  { _Pragma("unroll") for(int r=0;r<16;++r){pA0[r]=__builtin_amdgcn_exp2f(pA0[r]);pA1[r]=__builtin_amdgcn_exp2f(pA1[r]);} }
  WAIT_BAR(0);
  DMA_K(3,0);DMA_V(1,SLOTB);
  ROT();
  kload8(kf,kp0+sl_cur);
  WAIT_BAR(3);
  s16x4 vlo[8],vhi[8],vlo2[8],vhi2[8]; u32x4 pw0,pw1,pw2,pw3;
  #define PKW(P,B) cvtpk_s(P[B],P[B+1])
  #define PAF(k) __builtin_bit_cast(bf16x8,pw##k)
  #define VFR(i) (bf16x8){vlo[i][0],vlo[i][1],vlo[i][2],vlo[i][3],vhi[i][0],vhi[i][1],vhi[i][2],vhi[i][3]}
  #define VFR2(i) (bf16x8){vlo2[i][0],vlo2[i][1],vlo2[i][2],vlo2[i][3],vhi2[i][0],vhi2[i][1],vhi2[i][2],vhi2[i][3]}
  #define PIN(x) asm volatile("":"+v"(x))
  #define MX3(a,b,c) __builtin_fmaxf(__builtin_fmaxf((a),(b)),(c))
  #define GAPA(MF,A0,A1,A2,A3,W0,W1,PW) do{ MF; sacc+=A0; sacc+=A1; sacc+=A2; sacc+=A3; PIN(sacc); W0; W1; PIN(PW); SBAR(); }while(0)
  #define EX(v) __builtin_amdgcn_exp2f(v)
  #define GAPB(MF,X,B) do{ MF; X[B]=EX(X[B]); X[B+1]=EX(X[B+1]); PIN(X); SBAR(); }while(0)
  #define VRD(i) do{ vlo[i]=vtr(vp_+(((i)>>2)*4096+((i)&3)*1024)); vhi[i]=vtr(vp_+(((i)>>2)*4096+((i)&3)*1024+512)); }while(0)
  #define VRD2(i) do{ vlo2[i]=vtr(vp_+(8192+((i)>>2)*4096+((i)&3)*1024)); vhi2[i]=vtr(vp_+(8192+((i)>>2)*4096+((i)&3)*1024+512)); SBAR(); }while(0)
  #define KRD(G,j) do{ if(G){ kload2(kf,kp0+sl_next,j); SBAR(); } }while(0)
  #define MF32(a,b,c) __builtin_amdgcn_mfma_f32_32x32x16_bf16(a,b,c,0,0,0)
  #define STEP(C0,C1,P0,P1,t,GK,GV,GL) do{ SBAR(); \
    const lds_cptr vp_=vp0+2*sl_prev; const f32x16 z16_=f32x16{}; \
    VRD(0); SBAR(); float sacc=(P0[0]+P0[1]); \
    GAPA(C0=MF32(kf[0],qr[0],z16_), P0[2],P0[3],P0[4],P0[5],     pw0[0]=PKW(P0,0), pw0[1]=PKW(P0,2), pw0); \
    VRD(4); SBAR(); GAPA(C1=MF32(kf[1],qr[0],z16_), P0[6],P0[7],P0[8],P0[9],     pw0[2]=PKW(P0,4), pw0[3]=PKW(P0,6), pw0); \
    VRD(1); SBAR(); GAPA(C0=MF32(kf[2],qr[1],C0),   P0[10],P0[11],P0[12],P0[13], pw1[0]=PKW(P0,8), pw1[1]=PKW(P0,10), pw1); \
    VRD(5); SBAR(); GAPA(C1=MF32(kf[3],qr[1],C1),   P0[14],P0[15],P1[0],P1[1],   pw1[2]=PKW(P0,12),pw1[3]=PKW(P0,14), pw1); \
    VRD(2); SBAR(); GAPA(C0=MF32(kf[4],qr[2],C0),   P1[2],P1[3],P1[4],P1[5],     pw2[0]=PKW(P1,0), pw2[1]=PKW(P1,2), pw2); \
    VRD(6); SBAR(); GAPA(C1=MF32(kf[5],qr[2],C1),   P1[6],P1[7],P1[8],P1[9],     pw2[2]=PKW(P1,4), pw2[3]=PKW(P1,6), pw2); \
    VRD(3); SBAR(); GAPA(C0=MF32(kf[6],qr[3],C0),   P1[10],P1[11],P1[12],P1[13], pw3[0]=PKW(P1,8), pw3[1]=PKW(P1,10), pw3); \
    VRD(7); SBAR(); GAPA(C1=MF32(kf[7],qr[3],C1),   P1[14],P1[15],0.f,0.f,       pw3[2]=PKW(P1,12),pw3[3]=PKW(P1,14), pw3); \
    l_reg+=sacc; \
    if(GK){DMA_K((t)+3,sl_cur);} if(GV){DMA_V((t)+1,sl_next);} \
    CMASK(C0,C1,t); \
    SBAR(); \
    VRD2(0); GAPB(o[0]=MF32(PAF(0),VFR(0),o[0]), C0,0); \
    VRD2(4); GAPB(o[1]=MF32(PAF(0),VFR(4),o[1]), C0,2); \
    VRD2(1); GAPB(o[0]=MF32(PAF(1),VFR(1),o[0]), C0,4); \
    VRD2(5); GAPB(o[1]=MF32(PAF(1),VFR(5),o[1]), C0,6); \
    VRD2(2); GAPB(o[0]=MF32(PAF(2),VFR(2),o[0]), C0,8); \
    VRD2(6); GAPB(o[1]=MF32(PAF(2),VFR(6),o[1]), C0,10); \
    VRD2(3); GAPB(o[0]=MF32(PAF(3),VFR(3),o[0]), C0,12); \
    VRD2(7); GAPB(o[1]=MF32(PAF(3),VFR(7),o[1]), C0,14); \
    GAPB(o[2]=MF32(PAF(0),VFR2(0),o[2]), C1,0); \
    GAPB(o[3]=MF32(PAF(0),VFR2(4),o[3]), C1,2); \
    KRD(GL,0); GAPB(o[2]=MF32(PAF(1),VFR2(1),o[2]), C1,4); \
    KRD(GL,1); GAPB(o[3]=MF32(PAF(1),VFR2(5),o[3]), C1,6); \
    KRD(GL,2); GAPB(o[2]=MF32(PAF(2),VFR2(2),o[2]), C1,8); \
    KRD(GL,3); GAPB(o[3]=MF32(PAF(2),VFR2(6),o[3]), C1,10); \
    GAPB(o[2]=MF32(PAF(3),VFR2(3),o[2]), C1,12); \
    GAPB(o[3]=MF32(PAF(3),VFR2(7),o[3]), C1,14); \
    }while(0)
  int t=1;
  #undef CMASK
  #define CMASK(P0,P1,t) do{}while(0)
  #define CONV_STEP(cn_) do{ PG8_LAS unsigned char* l3=(PG8_LAS unsigned char*)(__attribute__((address_space(3))) char*)shm3; \
      if(cx->sub>=0){ pg8::conv_finish(*cx,l3,cx->slot0,lane,cx->sub); cx->sub=-1; cn_+=1; } \
      const int s_=cx->cw+cx->nseq*cx->jn; if(s_<pg8::CONV_NSUB){ pg8::conv_issue(*cx,l3,cx->slot0,lane,s_); cx->sub=s_; ++cx->jn; cn_+=4; } }while(0)
  #define WAIT_CN(cn_) do{ if(cn_==5){WAIT_BAR(8);} else if(cn_==4){WAIT_BAR(7);} else if(cn_==1){WAIT_BAR(4);} else {WAIT_BAR(3);} }while(0)
  for(;t+5<NT;t+=2){
    int cn1=0,cn2=0;
    if(wid<4){ CONV_STEP(cn1); }
    STEP(pB0,pB1,pA0,pA1,t,true,true,true);     WAIT_CN(cn1); RESC(); ROT();
    if(wid>=4){ CONV_STEP(cn2); }
    STEP(pA0,pA1,pB0,pB1,t+1,true,true,true);   WAIT_CN(cn2); RESC(); ROT();
  }
  #undef CONV_STEP
  #undef WAIT_CN
  #undef CMASK
  #define CMASK(P0,P1,t) do{int jb_=(t)-(NT-4); if(jb_>=0)cmask(P0,P1,jb_,qrel,hi);}while(0)
  #define ENDW(tt) do{ if((tt)+3<NT){WAIT_BAR(3);} else if((tt)+2<NT){WAIT_BAR(2);} else {WAIT_BAR(0);} }while(0)
  for(;t+1<NT;t+=2){
    STEP(pB0,pB1,pA0,pA1,t,(t+3<NT),(t+1<NT),(t+1<NT));       ENDW(t);   RESC(); ROT();
    STEP(pA0,pA1,pB0,pB1,t+1,(t+4<NT),(t+2<NT),(t+2<NT));     ENDW(t+1); RESC(); ROT();
  }
  STEP(pB0,pB1,pA0,pA1,NT-1,false,false,false); RESC();
  { float sacc=pB0[0]+pB0[1]; _Pragma("unroll") for(int r=2;r<16;++r)sacc+=pB0[r]; _Pragma("unroll") for(int r=0;r<16;++r)sacc+=pB1[r]; l_reg+=sacc;
    pw0=(u32x4){PKW(pB0,0),PKW(pB0,2),PKW(pB0,4),PKW(pB0,6)};pw1=(u32x4){PKW(pB0,8),PKW(pB0,10),PKW(pB0,12),PKW(pB0,14)};pw2=(u32x4){PKW(pB1,0),PKW(pB1,2),PKW(pB1,4),PKW(pB1,6)};pw3=(u32x4){PKW(pB1,8),PKW(pB1,10),PKW(pB1,12),PKW(pB1,14)};
    SBAR(); pv128(o,vb0+2*sl_cur,PAF(0),PAF(1),PAF(2),PAF(3)); }
  #undef PKW
  #undef PAF
  #undef VFR
  #undef VFR2
  #undef PIN
  #undef MX3
  #undef GAPA
  #undef GAPB
  #undef EX
  #undef VRD
  #undef VRD2
  #undef KRD
  #undef MF32
  #undef STEP
  #undef ENDW
  {auto rr=__builtin_amdgcn_permlane32_swap(__float_as_uint(l_reg),__float_as_uint(l_reg),false,false);l_reg=__uint_as_float(rr[0])+__uint_as_float(rr[1]);}
  if(hi==0)wsf[32+r32]=l_reg;asm volatile("s_waitcnt lgkmcnt(0)":::"memory");
  float rli[16];
  #pragma unroll
  for(int r=0;r<16;++r)rli[r]=__builtin_amdgcn_rcpf(wsf[32+crow(r,hi)]);
  asm volatile("s_waitcnt lgkmcnt(0)\n\ts_barrier":::"memory");
  bf16*Ow=O+(long)(q0+wid*QBLK)*OP;
  { bf16*stg=(bf16*)(shm)+wid*4096;
    #pragma unroll
    for(int r=0;r<16;++r){const int orow=crow(r,hi);
      #pragma unroll
      for(int d0=0;d0<4;++d0)stg[orow*128+d0*32+r32]=__float2bfloat16(o[d0][r]*rli[r]);}
    asm volatile("s_waitcnt lgkmcnt(0)":::"memory");
    #pragma unroll
    for(int i=0;i<8;++i){const int row=i*4+(lane>>4),ch=lane&15; const u32x4 v=*(const u32x4*)(stg+row*128+ch*8); ATTN_STORE16(Ow+(long)row*OP+ch*8,v);} }
  asm volatile("s_waitcnt lgkmcnt(0)\n\ts_barrier":::"memory");
  #undef DMA_K
  #undef DMA_V
  #undef CMASK
  #undef RESC
  #undef ROT
}
constexpr int ATTN_LDS_BYTES=LDS_BYTES;
#undef SBAR
#undef WAIT_BAR
}
#ifndef REPEAT_PHASE
#define REPEAT_PHASE -1
#endif
constexpr int NWAVES = 8;
using cfg::T; using cfg::SEQ; using cfg::D; using cfg::NIN; using cfg::NE; using cfg::EPS; using cfg::MAXROWS;

constexpr size_t MiB = 1u << 20;
constexpr size_t WS_CTL = 0, CTL_ZERO_BYTES = 1 * MiB;
constexpr size_t WS_RCOS = 1 * MiB, WS_RSIN = 2 * MiB;
constexpr size_t WS_TKE = 3 * MiB, WS_TKP = WS_TKE + 256 * 1024, WS_TKG = WS_TKP + 256 * 1024, WS_TSLOT = WS_TKG + 256 * 1024;
constexpr size_t WS_RGATE = 4 * MiB;
constexpr size_t WS_BLKBASE = 4 * MiB + 512 * 1024;
constexpr size_t WS_SSQ = 5 * MiB;
constexpr size_t WS_WIN = 8 * MiB;
constexpr size_t WS_WBR = 23 * MiB;
constexpr size_t WS_WOUT = 26 * MiB;
constexpr size_t WS_WGU = 28 * MiB;
constexpr size_t WS_WDN = 156 * MiB;
constexpr size_t WS_HN = 220 * MiB;
constexpr size_t WS_KVM = 254 * MiB;
constexpr size_t WS_Q = 256 * MiB, WS_K = 272 * MiB, WS_V = 288 * MiB, WS_U = 304 * MiB, WS_CB = 320 * MiB, WS_MQ = 336 * MiB;
constexpr size_t WS_GATES = 352 * MiB;
constexpr size_t WS_OMAPS = 448 * MiB;
constexpr size_t WS_YALL = 480 * MiB;
constexpr size_t WS_MERGED = 528 * MiB;
constexpr size_t WS_H2 = 560 * MiB;
constexpr size_t WS_XS = 256 * MiB;
constexpr size_t WS_ACT = 400 * MiB;
constexpr size_t WS_HN8 = 576 * MiB;
constexpr size_t WS_WG8 = 592 * MiB;
constexpr size_t WS_END = 596 * MiB;
static_assert(WS_XS + (size_t)MAXROWS * 2048 <= WS_ACT && WS_ACT + (size_t)MAXROWS * 2048 <= WS_H2, "MoE overlays");
constexpr int CW_QUEUE = 1024;
constexpr int CW_GCNT = 64;
constexpr int CW_BAR = 4096;
constexpr int RING_OFF = 0, RING_BYTES = 131072;
constexpr int LDSCTL_OFF = RING_BYTES, MISC_OFF = LDSCTL_OFF + 320;
constexpr int L_PREFT = LDSCTL_OFF + 1024, L_PSTART = L_PREFT + 256, L_LCNT = L_PSTART + 256, L_LBASE = L_LCNT + 128;
constexpr int L_PART = LDSCTL_OFF + 8192;
constexpr int MOE_ETAB = (L_PART - L_PREFT) / 4;
constexpr int L_WSF = LDSCTL_OFF + 4096;
constexpr int LDS_BYTES = 163840;
constexpr int CONV_SLOTS = LDSCTL_OFF;

struct NoHooks { __device__ __forceinline__ void a_ready(const pg8::Unit&) const {} __device__ __forceinline__ void done(const pg8::Unit&) const {} };
struct ProjOrder : NoHooks {
    const char* A; const char* Bt; int G, c;
    __device__ __forceinline__ bool next(int i, pg8::Unit& u) const {
        const int L = i * G + c; int pm, pn;
        if (L < 64 * 14) pg8::static_map(L, 64, 14, pm, pn); else if (L < 64 * 14 + 8) { pm = 64 + ((L - 64 * 14) >> 2); pn = 26 + ((L - 64 * 14) & 3); } else return false;
        u.pm = pm; u.pn = pn; u.aux = 0; u.a = A + (size_t)pm * (256 * 2048); u.b = Bt + (size_t)pn * (256 * 2048); return true; }
};
struct GateOrder : NoHooks {
    const char* A; const char* Bt; int G, c;
    __device__ __forceinline__ bool next(int i, pg8::Unit& u) const {
        const int L = i * G + c; if (L >= 64 * 12) return false; int pm, pn; pg8::static_map(L, 64, 12, pm, pn);
        u.pm = pm; u.pn = pn; u.aux = 0; u.a = A + (size_t)pm * (256 * 1024); u.b = Bt + (size_t)pn * (256 * 1024); return true; }
};
struct MergeOrder : NoHooks {
    const char* Y; const char* Bt; int G, c;
    __device__ __forceinline__ bool next(int i, pg8::Unit& u) const {
        const int j = i / 3, br = i - 3 * j; const int L = j * G + c; if (L >= 256) return false; int pm, pn; pg8::static_map(L, 64, 4, pm, pn);
        u.pm = pm; u.pn = pn; u.aux = br; u.a = Y + (size_t)pm * (256 * 3072) + br * 1024; u.b = Bt + (size_t)(br * 1024 + pn * 256) * 1024; return true; }
};
struct OutOrder : NoHooks {
    const char* A; const char* Bt; int G, c;
    __device__ __forceinline__ bool next(int i, pg8::Unit& u) const {
        const int L = i * G + c; if (L >= 256) return false; int pm, pn; pg8::static_map(L, 64, 4, pm, pn);
        u.pm = pm; u.pn = pn; u.aux = 0; u.a = A + (size_t)pm * (256 * 2048); u.b = Bt + (size_t)pn * (256 * 2048); return true; }
};
struct MoeOrder : NoHooks {
    const char* A; const char* Bt; const volatile __attribute__((address_space(3))) int* prefT; int ncol, G, c; size_t tile_bytes;
    __device__ __forceinline__ bool next(int i, pg8::Unit& u) const {
        const int L = i * G + c; const int rt = L / ncol, pnl = L - rt * ncol; if (rt >= prefT[32]) return false;
        const int e = prefT[MOE_ETAB + rt];
        u.pm = rt; u.pn = e * ncol + pnl; u.aux = e; u.a = A + (size_t)rt * tile_bytes; u.b = Bt + (size_t)(e * ncol + pnl) * tile_bytes; return true; }
};

#define GAS __attribute__((address_space(1)))
#define LAS __attribute__((address_space(3)))
typedef unsigned short bf16;
typedef unsigned v4u __attribute__((ext_vector_type(4)));
typedef unsigned v2u __attribute__((ext_vector_type(2)));
typedef float f32x4 __attribute__((ext_vector_type(4)));
typedef float f32x16 __attribute__((ext_vector_type(16)));
typedef short bf16x8 __attribute__((ext_vector_type(8)));
typedef GAS unsigned gu32;
#define RLX_AGENT __ATOMIC_RELAXED, __HIP_MEMORY_SCOPE_AGENT
#define LDS_WAIT() asm volatile("s_waitcnt lgkmcnt(0)" ::: "memory")
#define VM_WAIT() asm volatile("s_waitcnt vmcnt(0)" ::: "memory")
__device__ __forceinline__ unsigned f2bf(float f) { unsigned u = __builtin_bit_cast(unsigned, f); return (u + 0x7fffu + ((u >> 16) & 1u)) >> 16; }
__device__ __forceinline__ unsigned pk2(float lo, float hi) { return f2bf(lo) | (f2bf(hi) << 16); }
__device__ __forceinline__ float bflo(unsigned w) { return __uint_as_float(w << 16); }
__device__ __forceinline__ float bfhi(unsigned w) { return __uint_as_float(w & 0xffff0000u); }
__device__ __forceinline__ float wave_sum(float v) {
#pragma unroll
    for (int o = 1; o < 64; o <<= 1) v += __shfl_xor(v, o);
    return v;
}

#define XB_TMO      128
#define XB_XCNT(j)  (256  + 64 * (j))
#define XB_XSUB(j)  (1280 + 64 * (j))
#define XB_XGEN(j)  (2304 + 64 * (j))
#define XB_TOP      3328
#define XB_TOPGEN   3392
#define XCD_BAR_WORDS 3456
#define XB_SPIN_CAP (1u << 18)

__device__ __forceinline__ unsigned xb_ld(unsigned* p)              { return __hip_atomic_load(p, __ATOMIC_RELAXED, __HIP_MEMORY_SCOPE_AGENT); }
__device__ __forceinline__ unsigned xb_add(unsigned* p, unsigned v) { return __hip_atomic_fetch_add(p, v, __ATOMIC_RELAXED, __HIP_MEMORY_SCOPE_AGENT); }
__device__ __forceinline__ unsigned xb_xcc_id() { return (unsigned)__builtin_amdgcn_s_getreg((3 << 11) | 20) & 0xFu; }
#define XB_SPIN(cond, bar) do { unsigned _sp = 0; while (cond) { __builtin_amdgcn_s_sleep(1); \
    if ((++_sp & 255u) == 0u) { if (xb_ld(&(bar)[XB_TMO])) break; if (_sp > XB_SPIN_CAP) { atomicAdd(&(bar)[XB_TMO], 1u); break; } } } } while (0)

struct XcdBarrier {
    unsigned* bar; unsigned x;
    volatile LAS unsigned* st;
};

__device__ __forceinline__ XcdBarrier xcd_barrier_post(unsigned* bar, volatile LAS unsigned* st) {
    XcdBarrier b; b.bar = bar; b.x = xb_xcc_id(); b.st = st;
    if (threadIdx.x == 0) (void)xb_add(&bar[XB_XCNT(b.x)], 1u);
    return b;
}
__device__ __forceinline__ void xcd_barrier_complete(unsigned* bar, unsigned x, unsigned& nloc, unsigned& nx) {
    const unsigned G = gridDim.x * gridDim.y * gridDim.z;
    unsigned sum, cnt, mine, sp = 0u;
    for (;;) {
        sum = 0u; cnt = 0u; mine = 0u;
#pragma unroll
        for (unsigned j = 0; j < 16; ++j) { const unsigned c = xb_ld(&bar[XB_XCNT(j)]); sum += c; cnt += (c > 0u) ? 1u : 0u; mine = (j == x) ? c : mine; }
        if (sum == G) break;
        __builtin_amdgcn_s_sleep(1);
        if ((++sp & 255u) == 0u) { if (xb_ld(&bar[XB_TMO])) break; if (sp > XB_SPIN_CAP) { atomicAdd(&bar[XB_TMO], 1u); break; } }
    }
    nloc = mine > 0u ? mine : 1u; nx = cnt > 0u ? cnt : 1u;
}

__device__ __forceinline__ void xcd_barrier(const XcdBarrier& b) {
    asm volatile("s_waitcnt vmcnt(0)" ::: "memory");
    __syncthreads();
    if (threadIdx.x == 0) {
        unsigned* bar = b.bar;
        __builtin_amdgcn_s_waitcnt(0);
        unsigned nloc = b.st[0], nx = b.st[1];
        if (nloc == 0u) { xcd_barrier_complete(bar, b.x, nloc, nx); b.st[0] = nloc; b.st[1] = nx; }
        const unsigned old = xb_add(&bar[XB_XSUB(b.x)], 1u);
        const unsigned gen = old / nloc;
        if (old + 1u == (gen + 1u) * nloc) {
            __builtin_amdgcn_fence(__ATOMIC_RELEASE, "agent");
            asm volatile("s_waitcnt vmcnt(0)" ::: "memory");
            const unsigned og = xb_add(&bar[XB_TOP], 1u);
            const unsigned tg = og / nx;
            if (og + 1u == (tg + 1u) * nx) xb_add(&bar[XB_TOPGEN], 1u);
            else XB_SPIN(xb_ld(&bar[XB_TOPGEN]) == tg, bar);
            __builtin_amdgcn_fence(__ATOMIC_ACQUIRE, "agent");
            xb_add(&bar[XB_XGEN(b.x)], 1u);
            asm volatile("s_waitcnt vmcnt(0)" ::: "memory");
        } else {
            XB_SPIN(xb_ld(&bar[XB_XGEN(b.x)]) == gen, bar);
            __builtin_amdgcn_fence(__ATOMIC_ACQUIRE, "agent");
            asm volatile("s_waitcnt vmcnt(0)" ::: "memory");
        }
    }
    __syncthreads();
}

struct Args { const float* in[25]; float* out; unsigned char* ws; int ph_lo, ph_hi; };
__device__ __forceinline__ int ip32(int r) { return 16 * ((r >> 2) & 1) + 4 * (r >> 3) + (r & 3); }
__device__ __forceinline__ void p0_transpose_item(const float* W, int ldn, int K, bf16* WT, int k0, int n0, int dst_row_base, bool perm, LAS float* scr, int lane) {
    float rr_[32];
#pragma unroll
    for (int i = 0; i < 32; ++i) rr_[i] = W[(size_t)(k0 + 2 * i + (lane >> 5)) * ldn + n0 + (lane & 31)];
#pragma unroll
    for (int i = 0; i < 32; ++i) scr[(2 * i + (lane >> 5)) * 33 + (lane & 31)] = rr_[i];
    LDS_WAIT(); asm volatile("" ::: "memory");
    const int c = lane & 7;
#pragma unroll
    for (int j = 0; j < 4; ++j) { const int n = (lane >> 3) + 8 * j; const LAS float* s = scr + (8 * c) * 33 + n;
        v4u o; o.x = pk2(s[0 * 33], s[1 * 33]); o.y = pk2(s[2 * 33], s[3 * 33]); o.z = pk2(s[4 * 33], s[5 * 33]); o.w = pk2(s[6 * 33], s[7 * 33]);
        *(GAS v4u*)(WT + (size_t)(dst_row_base + (perm ? ip32(n) : n)) * K + k0 + 8 * c) = o; }
    LDS_WAIT(); asm volatile("" ::: "memory");
}
__device__ __forceinline__ void p0_f8_load(float (&rr_)[32], const float* W, int ldn, int k0, int n0, int lane) {
#pragma unroll
    for (int i = 0; i < 8; ++i) { const f32x4 v = __builtin_nontemporal_load((const f32x4*)(W + (size_t)(k0 + 8 * i + (lane >> 3)) * ldn + n0 + (lane & 7) * 4));
        rr_[4 * i] = v.x; rr_[4 * i + 1] = v.y; rr_[4 * i + 2] = v.z; rr_[4 * i + 3] = v.w; }
}
__device__ __forceinline__ void p0_f8_finish(const float (&rr_)[32], int K, unsigned char* WT, int k0, int dst_row_base, LAS float* scr, int lane, const float S32) {
#pragma unroll
    for (int i = 0; i < 8; ++i) { LAS float* sp = scr + (8 * i + (lane >> 3)) * 33 + (lane & 7) * 4; sp[0] = rr_[4 * i]; sp[1] = rr_[4 * i + 1]; sp[2] = rr_[4 * i + 2]; sp[3] = rr_[4 * i + 3]; }
    LDS_WAIT(); asm volatile("" ::: "memory");
    const int n = lane >> 1, hf = lane & 1; const LAS float* s = scr + (32 * hf) * 33 + n;
    v4u o0, o1;
    o0.x = pg8::pk4_fp8(S32 * s[0 * 33], S32 * s[1 * 33], S32 * s[2 * 33], S32 * s[3 * 33]); o0.y = pg8::pk4_fp8(S32 * s[4 * 33], S32 * s[5 * 33], S32 * s[6 * 33], S32 * s[7 * 33]);
    o0.z = pg8::pk4_fp8(S32 * s[8 * 33], S32 * s[9 * 33], S32 * s[10 * 33], S32 * s[11 * 33]); o0.w = pg8::pk4_fp8(S32 * s[12 * 33], S32 * s[13 * 33], S32 * s[14 * 33], S32 * s[15 * 33]);
    o1.x = pg8::pk4_fp8(S32 * s[16 * 33], S32 * s[17 * 33], S32 * s[18 * 33], S32 * s[19 * 33]); o1.y = pg8::pk4_fp8(S32 * s[20 * 33], S32 * s[21 * 33], S32 * s[22 * 33], S32 * s[23 * 33]);
    o1.z = pg8::pk4_fp8(S32 * s[24 * 33], S32 * s[25 * 33], S32 * s[26 * 33], S32 * s[27 * 33]); o1.w = pg8::pk4_fp8(S32 * s[28 * 33], S32 * s[29 * 33], S32 * s[30 * 33], S32 * s[31 * 33]);
    GAS v4u* dp = (GAS v4u*)(WT + (size_t)(dst_row_base + ip32(n)) * K + k0 + 32 * hf);
    dp[0] = o0; dp[1] = o1;
    LDS_WAIT(); asm volatile("" ::: "memory");
}
__device__ __forceinline__ void conv_drain(pg8::ConvCtx& c, LAS unsigned char* lds, int wave, int lane) {
    asm volatile("s_waitcnt vmcnt(0)" ::: "memory");
    if (c.sub >= 0) { pg8::conv_finish(c, lds, c.slot0, lane, c.sub); c.sub = -1; }
    __syncthreads();
    const unsigned base = (unsigned)(RING_OFF + wave * 16384);
    int sub[4], aft[4];
#pragma unroll
    for (int i = 0; i < 4; ++i) { sub[i] = -1; aft[i] = 0; }
#pragma unroll
    for (int i = 0; i < 4; ++i) { const int s = c.cw + c.nseq * c.jn;
        if (s < pg8::CONV_NSUB) { pg8::conv_issue(c, lds, base + i * 4096, lane, s); sub[i] = s; ++c.jn;
#pragma unroll
            for (int k = 0; k < 4; ++k) aft[k] += 4;
            aft[i] = 0; } }
    for (;;) {
        bool any = false;
#pragma unroll
        for (int i = 0; i < 4; ++i) {
            if (sub[i] < 0) continue;
            any = true;
            const int a = aft[i];
            if (a >= 15) asm volatile("s_waitcnt vmcnt(15)" ::: "memory"); else if (a >= 12) asm volatile("s_waitcnt vmcnt(12)" ::: "memory");
            else if (a >= 8) asm volatile("s_waitcnt vmcnt(8)" ::: "memory"); else if (a >= 4) asm volatile("s_waitcnt vmcnt(4)" ::: "memory"); else asm volatile("s_waitcnt vmcnt(0)" ::: "memory");
            pg8::conv_finish(c, lds, base + i * 4096, lane, sub[i]); sub[i] = -1;
#pragma unroll
            for (int k = 0; k < 4; ++k) aft[k] += 1;
            const int s = c.cw + c.nseq * c.jn;
            if (s < pg8::CONV_NSUB) { pg8::conv_issue(c, lds, base + i * 4096, lane, s); sub[i] = s; ++c.jn;
#pragma unroll
                for (int k = 0; k < 4; ++k) aft[k] += 4;
                aft[i] = 0; }
        }
        if (!any) break;
    }
}
__device__ __forceinline__ int win_group_base(int L0) {
    if (L0 < 1024) { const int l = L0 & 255; return (L0 & ~255) + 128 * ((l >> 5) & 1) + 32 * (l >> 6); }
    if (L0 < 1536) return L0;
    if (L0 < 2048) return L0 - 1536 + 2560;
    if (L0 < 3072) { const int which = L0 >= 2560, ch = (L0 - 2048) & 511; return 256 * (6 + (ch >> 7)) + 128 * which + 32 * ((ch >> 5) & 3); }
    return L0;
}
__device__ __forceinline__ void rms_row_to_bf16(const float* xrow, const float* g, bf16* orow, int lane, unsigned char* orow8 = nullptr) {
    const GAS f32x4* xr = (const GAS f32x4*)xrow + lane; const GAS f32x4* gr = (const GAS f32x4*)g + lane;
    f32x4 v[4]; float s = 0.f;
#pragma unroll
    for (int j = 0; j < 4; ++j) { v[j] = xr[64 * j]; s += (v[j].x * v[j].x + v[j].y * v[j].y) + (v[j].z * v[j].z + v[j].w * v[j].w); }
    const float r = 1.0f / sqrtf(wave_sum(s) * (1.0f / 1024.0f) + EPS);
    GAS unsigned long long* o8 = (GAS unsigned long long*)orow + lane;
#pragma unroll
    for (int j = 0; j < 4; ++j) { const f32x4 gg = gr[64 * j]; o8[64 * j] = (unsigned long long)pk2(v[j].x * r * gg.x, v[j].y * r * gg.y) | ((unsigned long long)pk2(v[j].z * r * gg.z, v[j].w * r * gg.w) << 32);
        if (orow8) ((GAS unsigned*)orow8)[64 * j + lane] = pg8::pk4_fp8(v[j].x * r * gg.x, v[j].y * r * gg.y, v[j].z * r * gg.z, v[j].w * r * gg.w); }
}


__device__ __forceinline__ void p0_prologue(const Args& a, LAS unsigned char* lds, int vcu, int G, int wave, int lane, int tid) {
    LAS float* scr = (LAS float*)(lds + RING_OFF + wave * 16384);
    const int gw = vcu * NWAVES + wave, NGW = G * NWAVES;
    unsigned char* ws = a.ws;
    constexpr int I_IN = 16 * 112, I_G8 = 16 * 96, I_KV = 16 * 32, I_BR = 3 * 8 * 32, I_OUT = 16 * 32;
    constexpr int NITEMS = I_IN + I_G8 + I_KV + I_BR + I_OUT;
    for (int it = gw; it < NITEMS; it += NGW) {
        int r = it;
        if (r < I_IN) { const int kb = r / 112, nb = r % 112; p0_transpose_item(a.in[3], NIN, 1024, (bf16*)(ws + WS_WIN), 64 * kb, 32 * nb, win_group_base(32 * nb), true, scr, lane); continue; } r -= I_IN;
        if (r < I_G8) { const int kb = r / 96, nb = r % 96; float rr8[32]; p0_f8_load(rr8, a.in[3], NIN, 64 * kb, 3584 + 32 * nb, lane); p0_f8_finish(rr8, 1024, ws + WS_WG8, 64 * kb, 32 * nb, scr, lane, -32.0f * 1.4426950408889634f); continue; } r -= I_G8;
        if (r < I_KV) { const int kb = r / 32, nb = r % 32; p0_transpose_item(a.in[13], 1024, 1024, (bf16*)(ws + WS_WIN), 64 * kb, 32 * nb, 6656 + 32 * nb, true, scr, lane); continue; } r -= I_KV;
        if (r < I_BR) { const int br = r / 256, q = r % 256, kb = q / 32, nb = q % 32; p0_transpose_item(a.in[16] + (size_t)br * 512 * 1024, 1024, 512, (bf16*)(ws + WS_WBR), 64 * kb, 32 * nb, br * 1024 + 32 * nb, true, scr, lane); continue; } r -= I_BR;
        { const int kb = r / 32, nb = r % 32; p0_transpose_item(a.in[17], 1024, 1024, (bf16*)(ws + WS_WOUT), 64 * kb, 32 * nb, 32 * nb, true, scr, lane); }
    }
    bf16* HN = (bf16*)(ws + WS_HN);
    for (int m = gw; m < T + 512; m += NGW) {
        if (m < T) rms_row_to_bf16(a.in[0] + (size_t)m * D, a.in[2], HN + (size_t)m * D, lane, ws + WS_HN8 + (size_t)m * D);
        else rms_row_to_bf16(a.in[1] + (size_t)(m - T) * D, a.in[12], HN + (size_t)m * D, lane);
    }
    float* rc = (float*)(ws + WS_RCOS); float* rs = (float*)(ws + WS_RSIN);
    for (int i = gw * 64 + lane; i < SEQ * 32; i += NGW * 64) { const int pos = i >> 5, f = i & 31;
        const float inv_freq = 1.0f / powf(10000.0f, (float)(2 * f) / 64.0f); const float ang = (float)pos * inv_freq; rc[i] = cosf(ang); rs[i] = sinf(ang); }
}

__device__ __forceinline__ void phase_finish(const Args& a, int vcu, int G, int wave, int lane) {
    unsigned char* ws = a.ws; const int gw = vcu * NWAVES + wave, NGW = G * NWAVES;
    const bf16* OM = (const bf16*)(ws + WS_OMAPS); const bf16* U = (const bf16*)(ws + WS_U); const bf16* CB = (const bf16*)(ws + WS_CB); bf16* Y = (bf16*)(ws + WS_YALL);
    const float lam = expf(wave_sum(a.in[6][lane] * a.in[7][lane])) - expf(wave_sum(a.in[8][lane] * a.in[9][lane])) + 0.2f;
    const int hh = lane >> 4, c8 = (lane & 15) * 8;
    f32x4 gs0 = *(const f32x4*)(a.in[10] + c8), gs1 = *(const f32x4*)(a.in[10] + c8 + 4);
    f32x4 w0a = *(const f32x4*)(a.in[11] + lane * 8), w0b = *(const f32x4*)(a.in[11] + lane * 8 + 4);
    f32x4 w1a = *(const f32x4*)(a.in[11] + 512 + lane * 8), w1b = *(const f32x4*)(a.in[11] + 512 + lane * 8 + 4);
    f32x4 w2a = *(const f32x4*)(a.in[11] + 1024 + lane * 8), w2b = *(const f32x4*)(a.in[11] + 1024 + lane * 8 + 4);
    for (int t = gw; t < T; t += NGW) {
        {
            const v4u o0 = *(const v4u*)(OM + (size_t)t * 1024 + hh * 256 + c8), o1 = *(const v4u*)(OM + (size_t)t * 1024 + hh * 256 + 128 + c8);
            const f32x4 a0 = pg8::unpk_lo(o0) - lam * pg8::unpk_lo(o1), a1 = pg8::unpk_hi(o0) - lam * pg8::unpk_hi(o1);
            float ss = ((a0[0] * a0[0] + a0[1] * a0[1]) + (a0[2] * a0[2] + a0[3] * a0[3])) + ((a1[0] * a1[0] + a1[1] * a1[1]) + (a1[2] * a1[2] + a1[3] * a1[3]));
            ss += __shfl_xor(ss, 1); ss += __shfl_xor(ss, 2); ss += __shfl_xor(ss, 4); ss += __shfl_xor(ss, 8);
            const float r = 0.8f / sqrtf(ss * (1.0f / 128.0f) + EPS);
            *(v4u*)(Y + (size_t)t * 1536 + hh * 128 + c8) = pg8::pack8(a0 * gs0 * r, a1 * gs1 * r);
        }
        {
            const int s = t & (SEQ - 1); const v4u z = {0u, 0u, 0u, 0u};
            const v4u u0 = *(const v4u*)(U + (size_t)t * 512 + lane * 8);
            const v4u u1 = s >= 1 ? *(const v4u*)(U + (size_t)(t - 1) * 512 + lane * 8) : z;
            const v4u u2 = s >= 2 ? *(const v4u*)(U + (size_t)(t - 2) * 512 + lane * 8) : z;
            const v4u cb = *(const v4u*)(CB + (size_t)t * 512 + lane * 8);
            const f32x4 ya = pg8::unpk_lo(cb) * (w0a * pg8::unpk_lo(u2) + w1a * pg8::unpk_lo(u1) + w2a * pg8::unpk_lo(u0));
            const f32x4 yb = pg8::unpk_hi(cb) * (w0b * pg8::unpk_hi(u2) + w1b * pg8::unpk_hi(u1) + w2b * pg8::unpk_hi(u0));
            *(v4u*)(Y + (size_t)t * 1536 + 512 + lane * 8) = pg8::pack8(ya, yb);
        }
    }
}

#define DPPF(x, ctrl) __uint_as_float(__builtin_amdgcn_update_dpp(0u, __float_as_uint(x), (ctrl), 0xf, 0xf, false))
__device__ __forceinline__ float lane_xor32(float x, int lane) { auto r = __builtin_amdgcn_permlane32_swap(__float_as_uint(x), __float_as_uint(x), false, false); return __uint_as_float((lane & 32) ? r[0] : r[1]); }
__device__ __forceinline__ float lane_xor16(float x, int lane) { auto r = __builtin_amdgcn_permlane16_swap(__float_as_uint(x), __float_as_uint(x), false, false); return __uint_as_float((lane & 16) ? r[0] : r[1]); }
__device__ __forceinline__ float wave_sum_fast(float v, int lane) {
    v += DPPF(v, 0xb1); v += DPPF(v, 0x4e); v += DPPF(v, 0x141); v += DPPF(v, 0x140); v += lane_xor16(v, lane); v += lane_xor32(v, lane); return v; }
__device__ __forceinline__ void router_pick(float (&p)[32], int t, float bias, int lane_in, LAS unsigned char* lds, int* tk_e, int* tk_p, float* tk_g) {
    int lane = lane_in; asm volatile("" : "+v"(lane));
#define RSTEP(HN, MASK, XCHG) _Pragma("unroll") for (int i = 0; i < HN; ++i) { const bool up = (lane & MASK) != 0; const float keep = up ? p[i + HN] : p[i]; const float send = up ? p[i] : p[i + HN]; p[i] = keep + XCHG; }
    RSTEP(16, 32, lane_xor32(send, lane)) RSTEP(8, 16, lane_xor16(send, lane)) RSTEP(4, 8, DPPF(send, 0x140)) RSTEP(2, 4, DPPF(send, 0x141)) RSTEP(1, 2, DPPF(send, 0x4e))
#undef RSTEP
    const float logit = p[0] + DPPF(p[0], 0xb1) + bias;
    float val = (lane & 1) ? -INFINITY : logit;
    float tv[4]; int te[4];
#pragma unroll
    for (int r = 0; r < 4; ++r) {
        float m = val;
        m = fmaxf(m, DPPF(m, 0xb1)); m = fmaxf(m, DPPF(m, 0x4e)); m = fmaxf(m, DPPF(m, 0x141)); m = fmaxf(m, DPPF(m, 0x140)); m = fmaxf(m, lane_xor16(m, lane)); m = fmaxf(m, lane_xor32(m, lane));
        const unsigned long long bal = __ballot(val == m);
        const int first = __builtin_ctzll(bal);
        tv[r] = __uint_as_float(__builtin_amdgcn_readfirstlane(__float_as_uint(m))); te[r] = first >> 1;
        val = (lane == first) ? -INFINITY : val;
    }
    const float e1 = expf(tv[1] - tv[0]), e2 = expf(tv[2] - tv[0]), e3 = expf(tv[3] - tv[0]);
    const float is = 1.0f / (1.0f + e1 + e2 + e3);
    if (lane < 4) { const int e = (lane == 0) ? te[0] : (lane == 1) ? te[1] : (lane == 2) ? te[2] : te[3];
        const float gate = (lane == 0) ? is : (lane == 1) ? e1 * is : (lane == 2) ? e2 * is : e3 * is;
        const int lp = __hip_atomic_fetch_add((LAS int*)(lds + L_LCNT) + e, 1, __ATOMIC_RELAXED, __HIP_MEMORY_SCOPE_WORKGROUP);
        tk_e[t * 4 + lane] = e; tk_p[t * 4 + lane] = lp; tk_g[t * 4 + lane] = gate; }
}

__device__ __forceinline__ void phase_router(const Args& a, LAS unsigned char* lds, int vcu, int G, int wave, int lane, int tid, int dummy) {
    unsigned char* ws = a.ws; const int gw = vcu * NWAVES + wave, NGW = G * NWAVES;
    LAS float* Wt = (LAS float*)(lds + RING_OFF);
    volatile LAS int* lcnt = (volatile LAS int*)(lds + L_LCNT);
    const float* wr = a.in[19];
    const float* x1 = a.out;
    f32x4 vn[2][4];
#pragma unroll
    for (int q = 0; q < 2; ++q) { const GAS f32x4* xr = (const GAS f32x4*)(x1 + (size_t)(gw + q * NGW) * D) + lane;
#pragma unroll
        for (int j = 0; j < 4; ++j) vn[q][j] = xr[64 * j]; }
    { f32x4 wf[16];
#pragma unroll
      for (int i = 0; i < 16; ++i) wf[i] = *(const f32x4*)(wr + (size_t)(lane + 64 * i) * 32 + 4 * wave);
#pragma unroll
      for (int i = 0; i < 16; ++i) { const int d = lane + 64 * i;
          Wt[(4 * wave + 0) * 1024 + d] = wf[i].x; Wt[(4 * wave + 1) * 1024 + d] = wf[i].y; Wt[(4 * wave + 2) * 1024 + d] = wf[i].z; Wt[(4 * wave + 3) * 1024 + d] = wf[i].w; } }
    if (tid < 32) lcnt[tid] = 0;
    __syncthreads();
    const float* g = a.in[18]; unsigned char* H2 = ws + WS_H2;
    int* tk_e = (int*)(ws + WS_TKE); int* tk_p = (int*)(ws + WS_TKP); float* tk_g = (float*)(ws + WS_TKG);
    LAS unsigned char* ldsc = lds;
    const float bias = a.in[20][lane >> 1];
    const GAS f32x4* gr = (const GAS f32x4*)g + lane;
    for (int tb = gw; tb < T; tb += 2 * NGW) {
        f32x4 v[2][4];
#pragma unroll
        for (int q = 0; q < 2; ++q)
#pragma unroll
            for (int j = 0; j < 4; ++j) v[q][j] = vn[q][j];
        if (tb + 2 * NGW < T) {
#pragma unroll
            for (int q = 0; q < 2; ++q) { const GAS f32x4* xr = (const GAS f32x4*)(x1 + (size_t)(tb + 2 * NGW + q * NGW) * D) + lane;
#pragma unroll
                for (int j = 0; j < 4; ++j) vn[q][j] = xr[64 * j]; } }
#pragma unroll
        for (int q = 0; q < 2; ++q) { float s = 0.f;
#pragma unroll
            for (int j = 0; j < 4; ++j) s += (v[q][j].x * v[q][j].x + v[q][j].y * v[q][j].y) + (v[q][j].z * v[q][j].z + v[q][j].w * v[q][j].w);
            const float r = 1.0f / sqrtf(wave_sum_fast(s, lane) * (1.0f / 1024.0f) + EPS);
            GAS unsigned* o4 = (GAS unsigned*)(H2 + (size_t)(tb + q * NGW) * D) + lane;
#pragma unroll
            for (int j = 0; j < 4; ++j) { const f32x4 gg = gr[64 * j]; v[q][j].x *= r * gg.x; v[q][j].y *= r * gg.y; v[q][j].z *= r * gg.z; v[q][j].w *= r * gg.w;
                o4[64 * j] = pg8::pk4_fp8(v[q][j].x, v[q][j].y, v[q][j].z, v[q][j].w); } }
        float p0[32], p1[32];
#pragma unroll
        for (int e = 0; e < 32; ++e) { p0[e] = 0.f; p1[e] = 0.f; }
        for (int ps_ = 0; ps_ < (REPEAT_PHASE == 22 ? 2 : 1); ++ps_) {
        f32x4 w[4], wn[4];
        const LAS float* Wl = Wt + 4 * lane; asm volatile("" : "+v"(Wl));
#pragma unroll
        for (int j = 0; j < 4; ++j) w[j] = *(const LAS f32x4*)(Wl + 256 * j);
#pragma unroll
        for (int e = 0; e < 32; ++e) {
            if (e + 1 < 32) {
#pragma unroll
                for (int j = 0; j < 4; ++j) wn[j] = *(const LAS f32x4*)(Wl + (e + 1) * 1024 + 256 * j); }
            asm volatile("" ::: "memory"); __builtin_amdgcn_sched_barrier(0);
            { float a0 = 0.f, a1 = 0.f, b0 = 0.f, b1 = 0.f;
#pragma unroll
              for (int j = 0; j < 4; ++j) { a0 = fmaf(v[0][j].x, w[j].x, a0); a1 = fmaf(v[0][j].y, w[j].y, a1); a0 = fmaf(v[0][j].z, w[j].z, a0); a1 = fmaf(v[0][j].w, w[j].w, a1);
                                            b0 = fmaf(v[1][j].x, w[j].x, b0); b1 = fmaf(v[1][j].y, w[j].y, b1); b0 = fmaf(v[1][j].z, w[j].z, b0); b1 = fmaf(v[1][j].w, w[j].w, b1); }
              p0[e] += a0 + a1; p1[e] += b0 + b1; asm volatile("" : "+v"(p0[e]), "+v"(p1[e])); }
#pragma unroll
            for (int j = 0; j < 4; ++j) w[j] = wn[j];
        }
        }
        if (REPEAT_PHASE == 22) {
#pragma unroll
            for (int e = 0; e < 32; ++e) { p0[e] *= 0.5f; p1[e] *= 0.5f; } }
        router_pick(p0, tb, bias, lane, ldsc, tk_e, tk_p, tk_g);
        router_pick(p1, tb + NGW, bias, lane, ldsc, tk_e, tk_p, tk_g);
    }
    __syncthreads();
    if (tid < 32) ((int*)(ws + WS_BLKBASE))[(dummy ? 8192 : 0) + vcu * 32 + tid] = lcnt[tid];
    __syncthreads();
}

__device__ __forceinline__ void moe_plan(unsigned char* ws, LAS unsigned char* lds, int tid, int vcu, int G) {
    volatile LAS int* prefT = (volatile LAS int*)(lds + L_PREFT); volatile LAS int* pstart = (volatile LAS int*)(lds + L_PSTART); volatile LAS int* lbase = (volatile LAS int*)(lds + L_LBASE);
    volatile LAS int* part = (volatile LAS int*)(lds + L_PART);
    { const int e = tid & 31, pr = tid >> 5; const int* bc = (const int*)(ws + WS_BLKBASE); int tot = 0, pre = 0;
      for (int b = pr; b < G; b += 16) { const int c = bc[b * 32 + e]; tot += c; pre += (b < vcu) ? c : 0; }
      part[pr * 32 + e] = tot; part[512 + pr * 32 + e] = pre; }
    __syncthreads();
    if (tid < 64) { int nt = 0;
        if (tid < 32) { int tot = 0, pre = 0;
#pragma unroll
            for (int pr = 0; pr < 16; ++pr) { tot += part[pr * 32 + tid]; pre += part[512 + pr * 32 + tid]; }
            lbase[tid] = pre; nt = (tot + 255) >> 8; }
        int inc = nt;
#pragma unroll
        for (int o = 1; o < 32; o <<= 1) { const int y = __shfl_up(inc, o); if ((tid & 63) >= o) inc += y; }
        if (tid < 32) { prefT[tid] = inc - nt; pstart[tid] = (inc - nt) * 256; if (tid == 31) { prefT[32] = inc; pstart[32] = inc * 256; }
            if (vcu == 0) { int* gp = (int*)(ws + WS_BLKBASE) + 16384; gp[tid] = inc - nt; if (tid == 31) gp[32] = inc; } } }
    __syncthreads();
}
__device__ __forceinline__ void moe_plan_load(unsigned char* ws, LAS unsigned char* lds, int tid) {
    volatile LAS int* prefT = (volatile LAS int*)(lds + L_PREFT);
    if (tid < 33) prefT[tid] = ((const int*)(ws + WS_BLKBASE))[16384 + tid];
    __syncthreads();
    for (int rt = tid; rt < prefT[32]; rt += NWAVES * 64) { int e = 0; while (prefT[e + 1] <= rt) ++e; prefT[MOE_ETAB + rt] = e; }
    __syncthreads();
}

__device__ __forceinline__ void phase_dispatch(const Args& a, LAS unsigned char* lds, int vcu, int G, int wave, int lane, int tid) {
    unsigned char* ws = a.ws; const int gw = vcu * NWAVES + wave, NGW = G * NWAVES;
    volatile LAS int* pstart = (volatile LAS int*)(lds + L_PSTART); volatile LAS int* lbase = (volatile LAS int*)(lds + L_LBASE);
    moe_plan(ws, lds, tid, vcu, G);
    const unsigned char* H2 = ws + WS_H2; unsigned char* XS = ws + WS_XS;
    const int* tk_e = (const int*)(ws + WS_TKE); const int* tk_p = (const int*)(ws + WS_TKP); const float* tk_g = (const float*)(ws + WS_TKG);
    int* tslot = (int*)(ws + WS_TSLOT); float* rgate = (float*)(ws + WS_RGATE);
    for (int t = gw; t < T; t += NGW) {
        int slot = 0;
        if (lane < 4) { const int e = tk_e[t * 4 + lane]; slot = pstart[e] + lbase[e] + tk_p[t * 4 + lane]; rgate[slot] = tk_g[t * 4 + lane]; tslot[t * 4 + lane] = slot; }
        const v4u r0 = *(const v4u*)(H2 + (size_t)t * D + lane * 16);
#pragma unroll
        for (int k = 0; k < 4; ++k) { const int sk = __builtin_amdgcn_readlane(slot, k); *(v4u*)(XS + (size_t)sk * D + lane * 16) = r0; }
    }
}

__device__ __forceinline__ void phase_combine(const Args& a, int vcu, int G, int wave, int lane, float* dst_out) {
    unsigned char* ws = a.ws; const int gw = vcu * NWAVES + wave, NGW = G * NWAVES;
    const unsigned char* YS = ws + WS_XS; const int* tslot = (const int*)(ws + WS_TSLOT); float* out = a.out;
    for (int t = gw; t < T; t += NGW) {
        int slot = 0; if (lane < 4) slot = tslot[t * 4 + lane];
        const float* op = out + (size_t)t * D + lane * 16; f32x4 o[4];
#pragma unroll
        for (int j = 0; j < 4; ++j) o[j] = *(const f32x4*)(op + 4 * j);
#pragma unroll
        for (int k = 0; k < 4; ++k) { const int sk = __builtin_amdgcn_readlane(slot, k); const v4u y = *(const v4u*)(YS + (size_t)sk * D + lane * 16); const unsigned yw[4] = {y.x, y.y, y.z, y.w};
#pragma unroll
            for (int j = 0; j < 4; ++j) { const auto lo = __builtin_amdgcn_cvt_pk_f32_fp8((int)yw[j], false), hi = __builtin_amdgcn_cvt_pk_f32_fp8((int)yw[j], true);
                o[j][0] += lo[0] * 0.0625f; o[j][1] += lo[1] * 0.0625f; o[j][2] += hi[0] * 0.0625f; o[j][3] += hi[1] * 0.0625f; } }
        float* wp = dst_out + (size_t)t * D + lane * 16;
#pragma unroll
        for (int j = 0; j < 4; ++j) *(f32x4*)(wp + 4 * j) = o[j];
    }
}

__device__ __forceinline__ void memattn_unit(const Args& a, LAS unsigned char* lds, int b, int h, int qb, int wid, int lane, int tid) {
    unsigned char* ws = a.ws;
    const bf16* KVM = (const bf16*)(ws + WS_KVM); const bf16* MQ = (const bf16*)(ws + WS_MQ); const float* ssq = (const float*)(ws + WS_SSQ); bf16* Y = (bf16*)(ws + WS_YALL);
    LAS unsigned char* Ks = lds + RING_OFF;
    LAS unsigned char* Vs = lds + RING_OFF + 65536;
    const int r32 = lane & 31, hi = lane >> 5;
    const size_t qrow = (size_t)b * SEQ + (size_t)qb * 256 + wid * 32 + r32;
    bf16x8 qf[8];
#pragma unroll
    for (int ks = 0; ks < 8; ++ks) qf[ks] = *(const bf16x8*)(MQ + qrow * 512 + h * 128 + 16 * ks + 8 * hi);
    const f32x4 sq = *(const f32x4*)(ssq + qrow * 16 + h * 4);
    {
        const int m = tid >> 1, hf = tid & 1;
        const bf16* kr = KVM + (size_t)(b * 256 + m) * 1024 + h * 128 + hf * 64; const bf16* vr = kr + 512;
        v4u raw[8], vraw[8]; float ss = 0.f;
#pragma unroll
        for (int i = 0; i < 8; ++i) { raw[i] = *(const v4u*)(kr + 8 * i); vraw[i] = *(const v4u*)(vr + 8 * i); }
#pragma unroll
        for (int i = 0; i < 8; ++i) { const f32x4 x0 = pg8::unpk_lo(raw[i]), x1 = pg8::unpk_hi(raw[i]);
            ss += ((x0[0] * x0[0] + x0[1] * x0[1]) + (x0[2] * x0[2] + x0[3] * x0[3])) + ((x1[0] * x1[0] + x1[1] * x1[1]) + (x1[2] * x1[2] + x1[3] * x1[3])); }
        ss += __shfl_xor(ss, 1);
        const float r = 1.0f / sqrtf(ss * (1.0f / 128.0f) + EPS);
#pragma unroll
        for (int i = 0; i < 8; ++i) { const int d0 = hf * 64 + 8 * i; const f32x4 g0 = *(const f32x4*)(a.in[15] + d0) * *(const f32x4*)(a.in[14] + d0), g1 = *(const f32x4*)(a.in[15] + d0 + 4) * *(const f32x4*)(a.in[14] + d0 + 4);
            const int c = hf * 8 + i;
            *(LAS v4u*)(Ks + m * 256 + ((c ^ (m & 15)) << 4)) = pg8::pack8(pg8::unpk_lo(raw[i]) * g0 * r, pg8::unpk_hi(raw[i]) * g1 * r); }
        LAS unsigned char* vt = Vs + (m >> 6) * 16384 + ((m >> 4) & 3) * 1024 + (m & 15) * 64;
#pragma unroll
        for (int i = 0; i < 8; ++i) *(LAS v4u*)(vt + (2 * hf + (i >> 2)) * 4096 + (i & 3) * 16) = vraw[i];
    }
    __syncthreads();
    const float sc = (1.0f / sqrtf(((sq[0] + sq[1]) + (sq[2] + sq[3])) * (1.0f / 128.0f) + EPS)) * 0.08838834764831845f * 1.4426950408889634f;
    f32x16 o[4]; float l = 0.f;
#pragma unroll
    for (int d0 = 0; d0 < 4; ++d0) o[d0] = f32x16{};
    const int vb0 = (int)(unsigned)(uintptr_t)(lds + RING_OFF + 65536) + ((lane >> 4) & 1) * 32 + (lane & 3) * 8 + (4 * hi + ((lane & 15) >> 2)) * 64;
#pragma unroll 1
    for (int kt = 0; kt < 4; ++kt) {
        f32x16 p0 = f32x16{}, p1 = f32x16{};
#pragma unroll
        for (int ks = 0; ks < 8; ++ks) { const int c = 2 * ks + hi; const int k0 = 64 * kt + r32, k1 = k0 + 32;
            const bf16x8 f0 = *(const LAS bf16x8*)(Ks + k0 * 256 + ((c ^ (k0 & 15)) << 4)), f1 = *(const LAS bf16x8*)(Ks + k1 * 256 + ((c ^ (k1 & 15)) << 4));
            p0 = __builtin_amdgcn_mfma_f32_32x32x16_bf16(f0, qf[ks], p0, 0, 0, 0); p1 = __builtin_amdgcn_mfma_f32_32x32x16_bf16(f1, qf[ks], p1, 0, 0, 0); }
#pragma unroll
        for (int r = 0; r < 16; ++r) { p0[r] = __builtin_amdgcn_exp2f(p0[r] * sc); p1[r] = __builtin_amdgcn_exp2f(p1[r] * sc); l += p0[r] + p1[r]; }
        v4u pw[4];
        pw[0] = (v4u){pg8::cvt_pk_bf16(p0[0], p0[1]), pg8::cvt_pk_bf16(p0[2], p0[3]), pg8::cvt_pk_bf16(p0[4], p0[5]), pg8::cvt_pk_bf16(p0[6], p0[7])};
        pw[1] = (v4u){pg8::cvt_pk_bf16(p0[8], p0[9]), pg8::cvt_pk_bf16(p0[10], p0[11]), pg8::cvt_pk_bf16(p0[12], p0[13]), pg8::cvt_pk_bf16(p0[14], p0[15])};
        pw[2] = (v4u){pg8::cvt_pk_bf16(p1[0], p1[1]), pg8::cvt_pk_bf16(p1[2], p1[3]), pg8::cvt_pk_bf16(p1[4], p1[5]), pg8::cvt_pk_bf16(p1[6], p1[7])};
        pw[3] = (v4u){pg8::cvt_pk_bf16(p1[8], p1[9]), pg8::cvt_pk_bf16(p1[10], p1[11]), pg8::cvt_pk_bf16(p1[12], p1[13]), pg8::cvt_pk_bf16(p1[14], p1[15])};
        attn_body::pv128(o, vb0 + kt * 16384, __builtin_bit_cast(bf16x8, pw[0]), __builtin_bit_cast(bf16x8, pw[1]), __builtin_bit_cast(bf16x8, pw[2]), __builtin_bit_cast(bf16x8, pw[3]));
    }
    l += __shfl_xor(l, 32);
    LAS float* wsf = (LAS float*)(lds + L_WSF) + wid * 64;
    if (hi == 0) wsf[r32] = l;
    __syncthreads();
    LAS bf16* stg = (LAS bf16*)(lds + RING_OFF) + wid * 4096;
#pragma unroll
    for (int r = 0; r < 16; ++r) { const int orow = (r & 3) + 8 * (r >> 2) + 4 * hi; const float il = 1.0f / wsf[orow];
#pragma unroll
        for (int d0 = 0; d0 < 4; ++d0) stg[orow * 128 + d0 * 32 + r32] = (bf16)f2bf(o[d0][r] * il); }
    LDS_WAIT();
    bf16* Yw = Y + ((size_t)b * SEQ + (size_t)qb * 256 + wid * 32) * 1536 + 1024 + h * 128;
#pragma unroll
    for (int i = 0; i < 8; ++i) { const int row = i * 4 + (lane >> 4), ch = lane & 15; const v4u v = *(const LAS v4u*)(stg + row * 128 + ch * 8); *(v4u*)(Yw + (size_t)row * 1536 + ch * 8) = v; }
    __syncthreads();
}

__global__ void __launch_bounds__(NWAVES * 64, 2) mega_fwd(Args args) {
    extern __shared__ __attribute__((aligned(16))) unsigned char lds_raw[];
    LAS unsigned char* lds = (LAS unsigned char*)lds_raw;
    volatile LAS unsigned* MISC = (volatile LAS unsigned*)(lds + MISC_OFF);
    int tid = threadIdx.x, lane = tid & 63, wave = __builtin_amdgcn_readfirstlane(tid >> 6);
#define PHASE_LOCALS() do { tid = threadIdx.x; asm volatile("" : "+v"(tid)); lane = tid & 63; wave = __builtin_amdgcn_readfirstlane(tid >> 6); } while (0)
    const int G = gridDim.x; const int bx = blockIdx.x; const int vcu = (G % 8 == 0) ? (bx % 8) * (G / 8) + bx / 8 : bx;
    unsigned char* ws = args.ws;
    gu32* ctl = (gu32*)(ws + WS_CTL);
    for (int u = tid; u < (LDS_BYTES - LDSCTL_OFF) / 4; u += NWAVES * 64) ((LAS unsigned*)(lds + LDSCTL_OFF))[u] = 0u;
    __syncthreads();
    const int ph_lo = args.ph_lo, ph_hi = args.ph_hi;
    XcdBarrier bar; bar.bar = (unsigned*)(ctl + CW_BAR); bar.x = 0; bar.st = nullptr;
    if (ph_hi - ph_lo > 1) bar = xcd_barrier_post((unsigned*)(ctl + CW_BAR), MISC + 8);
#define IN(k) (ph_lo <= (k) && (k) < ph_hi)
#ifndef TS_PHASE
#define TS_PHASE -1
#endif
    unsigned long long* const ts = (unsigned long long*)(ws + WS_CTL + 512 * 1024);
#define STAMP(k) do { if (TS_PHASE >= 0 && bx == 0 && threadIdx.x == 0) ts[(k)] = __builtin_amdgcn_s_memrealtime(); } while (0)
#define GRID_BAR(k) do { if (IN(k) && IN((k) + 1)) xcd_barrier(bar); STAMP((k) + 1); } while (0)
    STAMP(0);

    if (IN(0)) { for (int rep_ = 0; rep_ < (REPEAT_PHASE == 0 ? 2 : 1); ++rep_) { if (rep_) xcd_barrier(bar);
    PHASE_LOCALS();
    p0_prologue(args, lds, vcu, G, wave, lane, tid);
    } }
    GRID_BAR(0);

    if (IN(1)) { for (int rep_ = 0; rep_ < (REPEAT_PHASE == 1 ? 2 : 1); ++rep_) { if (rep_) xcd_barrier(bar);
    PHASE_LOCALS();
    {
        pg8::Gemm g{2048u, 2048u, 1024};
        ProjOrder S; S.A = (const char*)(ws + WS_HN); S.Bt = (const char*)(ws + WS_WIN); S.G = G; S.c = bx;
        pg8::EpiProj E{(bf16*)(ws + WS_Q), (bf16*)(ws + WS_K), (bf16*)(ws + WS_V), (bf16*)(ws + WS_U), (bf16*)(ws + WS_CB), (bf16*)(ws + WS_MQ), (bf16*)(ws + WS_GATES), (bf16*)(ws + WS_KVM),
                       (float*)(ws + WS_SSQ), args.in[4], args.in[5], (const float*)(ws + WS_RCOS), (const float*)(ws + WS_RSIN)};
        pg8::gemm_phase<pg8::EpiProj, ProjOrder, true, true>(lds + RING_OFF, g, S, E);
        { pg8::Gemm g8{1024u, 1024u, 512}; GateOrder S8; S8.A = (const char*)(ws + WS_HN8); S8.Bt = (const char*)(ws + WS_WG8); S8.G = G; S8.c = bx;
          pg8::EpiGates8 E8{ws + WS_GATES};
          pg8::gemm_phase_f8<pg8::EpiGates8, GateOrder, true, true>(lds + RING_OFF, g8, S8, E8); }
    }
    } }
    GRID_BAR(1);

    if (IN(2)) { for (int rep_ = 0; rep_ < (REPEAT_PHASE == 2 ? 2 : 1); ++rep_) { if (rep_) xcd_barrier(bar);
    PHASE_LOCALS();
    {
        const int cmb = vcu >> 4, s = vcu & 15;
        const int b = cmb >> 3, h = (cmb >> 1) & 3, mp = cmb & 1;
        const attn_body::bf16* Qp = (const attn_body::bf16*)(ws + WS_Q) + (size_t)b * SEQ * 512 + (h * 2 + mp) * 64;
        const attn_body::bf16* Kp = (const attn_body::bf16*)(ws + WS_K) + (size_t)b * SEQ * 512 + (h * 2 + mp) * 64;
        const attn_body::bf16* Vp = (const attn_body::bf16*)(ws + WS_V) + (size_t)b * SEQ * 512 + h * 128;
        attn_body::bf16* Op = (attn_body::bf16*)(ws + WS_OMAPS) + (size_t)b * SEQ * 1024 + (h * 2 + mp) * 128;
        pg8::ConvCtx cx; cx.wgu = args.in[21]; cx.wdn = args.in[23]; cx.ogu = ws + WS_WGU; cx.odn = ws + WS_WDN; cx.cw = bx * NWAVES + wave; cx.nseq = NWAVES * G; cx.jn = 0;
        cx.sub = -1; cx.slot0 = (unsigned)(98304 + wave * 4096);
#pragma unroll 1
        for (int i = 0; i < 2; ++i) { const int qb = (i == 0) ? s : 31 - s;
            attn_body::attn_unit128<8>(qb, Qp, Kp, Vp, Op, (char*)lds_raw + RING_OFF, &cx); }
        conv_drain(cx, lds, wave, lane);
        __syncthreads();
        memattn_unit(args, lds, vcu >> 7, (vcu >> 5) & 3, vcu & 31, wave, lane, tid);
        if (REPEAT_PHASE == 21) memattn_unit(args, lds, vcu >> 7, (vcu >> 5) & 3, vcu & 31, wave, lane, tid);
    }
    } }
    GRID_BAR(2);

    if (IN(3)) { for (int rep_ = 0; rep_ < (REPEAT_PHASE == 3 ? 2 : 1); ++rep_) { if (rep_) xcd_barrier(bar);
    PHASE_LOCALS();
    phase_finish(args, vcu, G, wave, lane);
    } }
    GRID_BAR(3);

    if (REPEAT_PHASE == 20) { for (int i_ = 0; i_ < 10; ++i_) xcd_barrier(bar); }
    if (IN(4)) { for (int rep_ = 0; rep_ < (REPEAT_PHASE == 4 ? 2 : 1); ++rep_) { if (rep_) xcd_barrier(bar);
    PHASE_LOCALS();
    {
        pg8::Gemm g{3072u, 1024u, 512};
        MergeOrder S; S.Y = (const char*)(ws + WS_YALL); S.Bt = (const char*)(ws + WS_WBR); S.G = G; S.c = bx;
        pg8::EpiMerge E{(const bf16*)(ws + WS_GATES), (bf16*)(ws + WS_MERGED)};
        pg8::gemm_phase<pg8::EpiMerge, MergeOrder, true, true>(lds + RING_OFF, g, S, E);
    }
    } }
    GRID_BAR(4);

    if (IN(5)) { for (int rep_ = 0; rep_ < (REPEAT_PHASE == 5 ? 2 : 1); ++rep_) { if (rep_) xcd_barrier(bar);
    PHASE_LOCALS();
    {
        pg8::Gemm g{2048u, 2048u, 1024};
        OutOrder S; S.A = (const char*)(ws + WS_MERGED); S.Bt = (const char*)(ws + WS_WOUT); S.G = G; S.c = bx;
        pg8::EpiResid E{args.in[0], args.out};
        pg8::gemm_phase<pg8::EpiResid, OutOrder, false, true>(lds + RING_OFF, g, S, E);
    }
    } }
    GRID_BAR(5);

    if (IN(6)) { for (int rep_ = 0; rep_ < (REPEAT_PHASE == 6 ? 2 : 1); ++rep_) { if (rep_) xcd_barrier(bar);
    PHASE_LOCALS();
    phase_router(args, lds, vcu, G, wave, lane, tid, rep_ == 0 && REPEAT_PHASE == 6);
    } }
    GRID_BAR(6);

    if (IN(7)) { for (int rep_ = 0; rep_ < (REPEAT_PHASE == 7 ? 2 : 1); ++rep_) { if (rep_) xcd_barrier(bar);
    PHASE_LOCALS();
    phase_dispatch(args, lds, vcu, G, wave, lane, tid);
    } }
    GRID_BAR(7);

    if (IN(8)) { for (int rep_ = 0; rep_ < (REPEAT_PHASE == 8 ? 2 : 1); ++rep_) { if (rep_) xcd_barrier(bar);
    PHASE_LOCALS();
    {
        pg8::Gemm g{1024u, 1024u, 512};
        moe_plan_load(ws, lds, tid);
        MoeOrder S; S.A = (const char*)(ws + WS_XS); S.Bt = (const char*)(ws + WS_WGU); S.prefT = (const volatile LAS int*)(lds + L_PREFT); S.ncol = 8; S.G = G; S.c = vcu; S.tile_bytes = 256 * 1024;
        pg8::EpiSwiglu E{args.in[22], ws + WS_ACT};
        pg8::gemm_phase_f8<pg8::EpiSwiglu, MoeOrder, true, true>(lds + RING_OFF, g, S, E);
    }
    } }
    GRID_BAR(8);

    if (IN(9)) { for (int rep_ = 0; rep_ < (REPEAT_PHASE == 9 ? 2 : 1); ++rep_) { if (rep_) xcd_barrier(bar);
    PHASE_LOCALS();
    {
        pg8::Gemm g{1024u, 1024u, 512};
        moe_plan_load(ws, lds, tid);
        MoeOrder S; S.A = (const char*)(ws + WS_ACT); S.Bt = (const char*)(ws + WS_WDN); S.prefT = (const volatile LAS int*)(lds + L_PREFT); S.ncol = 4; S.G = G; S.c = vcu; S.tile_bytes = 256 * 1024;
        pg8::EpiDown E{args.in[24], (const float*)(ws + WS_RGATE), ws + WS_XS};
        pg8::gemm_phase_f8<pg8::EpiDown, MoeOrder, true, true>(lds + RING_OFF, g, S, E);
    }
    } }
    GRID_BAR(9);

    if (IN(10)) { for (int rep_ = 0; rep_ < 1; ++rep_) { if (rep_) xcd_barrier(bar);
    PHASE_LOCALS();
    if (REPEAT_PHASE == 10) { phase_combine(args, vcu, G, wave, lane, (float*)(ws + WS_WGU)); xcd_barrier(bar); }
    phase_combine(args, vcu, G, wave, lane, args.out);
    } }
    GRID_BAR(10);

    if (TS_PHASE >= 0) {
        STAMP(11); xcd_barrier(bar);
        const unsigned long long t0 = __hip_atomic_load(ts + (TS_PHASE == 11 ? 0 : TS_PHASE), RLX_AGENT), t1 = __hip_atomic_load(ts + (TS_PHASE == 11 ? 11 : TS_PHASE + 1), RLX_AGENT);
        const float v = (float)(t1 - t0) * (TS_PHASE == 11 ? 1e-4f : 1e-3f);
        for (size_t i = (size_t)bx * 512 + threadIdx.x; i < (size_t)T * D; i += (size_t)G * 512) args.out[i] = v;
    }
#undef GRID_BAR
#undef IN
}

extern "C" void kernel_launch(void* const* d_in, const int* in_sizes, int n_in, void* d_out, int out_size, void* d_ws, size_t ws_size, hipStream_t stream) {
    static int grid = 0;
    if (grid == 0) {
        if (n_in != 25 || out_size != T * D || ws_size < WS_END) { fprintf(stderr, "kernel_launch: unexpected problem shape (n_in %d, out %d, ws %zu)\n", n_in, out_size, ws_size); grid = -1; return; }
        int dev = 0, cus = 0;
        if (hipGetDevice(&dev) != hipSuccess || hipDeviceGetAttribute(&cus, hipDeviceAttributeMultiprocessorCount, dev) != hipSuccess) { grid = -1; return; }
        if (hipFuncSetAttribute((const void*)mega_fwd, hipFuncAttributeMaxDynamicSharedMemorySize, LDS_BYTES) != hipSuccess) { fprintf(stderr, "kernel_launch: hipFuncSetAttribute failed\n"); grid = -1; return; }
        int per_cu = 0;
        if (hipOccupancyMaxActiveBlocksPerMultiprocessor(&per_cu, (const void*)mega_fwd, NWAVES * 64, LDS_BYTES) != hipSuccess || per_cu < 1) fprintf(stderr, "kernel_launch: occupancy query says %d\n", per_cu);
        (void)hipGetLastError();
        grid = cus;
        if (grid != 256) fprintf(stderr, "kernel_launch: built for 256 CUs, device has %d\n", grid);
    }
    if (grid < 0) return;
    if (hipMemsetAsync((char*)d_ws + WS_CTL, 0, CTL_ZERO_BYTES, stream) != hipSuccess) return;
    Args a{};
    for (int i = 0; i < 25; ++i) a.in[i] = (const float*)d_in[i];
    a.out = (float*)d_out; a.ws = (unsigned char*)d_ws;
#ifndef MK_PER_PHASE
#define MK_PER_PHASE 0
#endif
    if (MK_PER_PHASE) { for (int k = 0; k < 11; ++k) { a.ph_lo = k; a.ph_hi = k + 1; hipLaunchKernelGGL(mega_fwd, dim3(grid), dim3(NWAVES * 64), LDS_BYTES, stream, a); } }
    else { a.ph_lo = 0; a.ph_hi = 11; hipLaunchKernelGGL(mega_fwd, dim3(grid), dim3(NWAVES * 64), LDS_BYTES, stream, a); }
}
```
